# Optimizing an MI355X kernel written in HIP

```python
import jax, jax.numpy as jnp
from jax import lax
import numpy as np

D_MODEL = 1024
BATCH = 2
SEQ = 16384
DEPTH = 2

GRID_W = 64
CTX_LEN = 256
N_MIXERS = 2
N_HGRN_LAYERS = (DEPTH + N_MIXERS - 1) // N_MIXERS
N_CONV_LAYERS = DEPTH // N_MIXERS
HGRN_DK = 128
HGRN_HEADS = D_MODEL // HGRN_DK
HGRN_DV = D_MODEL // HGRN_HEADS
HGRN_CHUNK = 64
CONV_WIDTH = 31
N_EXPERTS = 32
TOP_K = 4
D_EXPERT = D_MODEL
SWIGLU_ALPHA = 1.702
SWIGLU_LIMIT = 7.0
MOE_BLOCK = 256
EPS = 1e-6

kernel_name = "hybrid_hgrn2_conformer_moe_dit"


def rmsnorm(x, g):
    x32 = x.astype(jnp.float32)
    y = x32 * lax.rsqrt(jnp.mean(x32 * x32, axis=-1, keepdims=True) + EPS)
    return (y * g.astype(jnp.float32)).astype(x.dtype)


def layernorm(x, g, b):
    x32 = x.astype(jnp.float32)
    mu = jnp.mean(x32, axis=-1, keepdims=True)
    xc = x32 - mu
    y = xc * lax.rsqrt(jnp.mean(xc * xc, axis=-1, keepdims=True) + EPS)
    return (y * g.astype(jnp.float32) + b.astype(jnp.float32)).astype(x.dtype)


def ada_mods(cond, w, b):
    return jnp.split(jax.nn.silu(cond) @ w + b, 6, axis=-1)


def gla_chunk_scan(q, k, v, logf, s0):
    bsz, nh, length, dk = q.shape
    dv = v.shape[-1]
    nc = length // HGRN_CHUNK

    def to_chunks(t):
        return jnp.moveaxis(t.reshape(bsz, nh, nc, HGRN_CHUNK, t.shape[-1]), 2, 0)

    mask = jnp.tril(jnp.ones((HGRN_CHUNK, HGRN_CHUNK), dtype=bool))[:, :, None]

    def step(s, inp):
        qc, kc, vc, gc = inp
        bcum = jnp.cumsum(gc, axis=-2)
        diff = bcum[..., :, None, :] - bcum[..., None, :, :]
        decay = jnp.exp(jnp.where(mask, diff, -jnp.inf))
        a = jnp.einsum('bhtk,bhsk,bhtsk->bhts', qc, kc, decay)
        o = (jnp.einsum('bhts,bhsv->bhtv', a, vc)
             + jnp.einsum('bhtk,bhkv->bhtv', qc * jnp.exp(bcum), s))
        blast = bcum[..., -1:, :]
        s_new = (jnp.exp(blast[..., 0, :])[..., None] * s
                 + jnp.einsum('bhsk,bhsv->bhkv', kc * jnp.exp(blast - bcum), vc))
        return s_new, o

    s_fin, o = lax.scan(step, s0, (to_chunks(q), to_chunks(k), to_chunks(v), to_chunks(logf)))
    o = jnp.moveaxis(o, 0, 2).reshape(bsz, nh, length, dv)
    return o, s_fin


def hgrn2_mixer(h_lat, h_ctx, w_in, lb_fwd, lb_bwd, g_out, w_out, return_ctx):
    hk = HGRN_HEADS * HGRN_DK
    hv = HGRN_HEADS * HGRN_DV
    splits = [hk, hk + hv, 2 * hk + hv, 3 * hk + hv]

    def heads(t):
        return t.reshape(t.shape[0], t.shape[1], HGRN_HEADS, -1).transpose(0, 2, 1, 3)

    def project(h):
        p = (h @ w_in).astype(jnp.float32)
        q, i, zf, zb, g = jnp.split(p, splits, axis=-1)
        f_f = lb_fwd + (1.0 - lb_fwd) * jax.nn.sigmoid(zf)
        f_b = lb_bwd + (1.0 - lb_bwd) * jax.nn.sigmoid(zb)
        return heads(q), heads(i), heads(f_f), heads(f_b), g

    def flip(t):
        return jnp.flip(t, axis=2)

    def scan_both(q, i, f_f, f_b, s_f, s_b):
        o_f, s_f_new = gla_chunk_scan(q, 1.0 - f_f, i, jnp.log(f_f), s_f)
        o_b, s_b_new = gla_chunk_scan(flip(q), flip(1.0 - f_b), flip(i), flip(jnp.log(f_b)), s_b)
        return o_f + flip(o_b), s_f_new, s_b_new

    def readout(o, g, dtype):
        o = o * lax.rsqrt(jnp.mean(o * o, axis=-1, keepdims=True) + EPS)
        o = o * g_out.astype(jnp.float32).reshape(HGRN_HEADS, HGRN_DV)[None, :, None, :]
        o = o.transpose(0, 2, 1, 3).reshape(o.shape[0], o.shape[2], hv)
        return (o * jax.nn.silu(g)).astype(dtype) @ w_out

    bsz = h_lat.shape[0]
    s0 = jnp.zeros((bsz, HGRN_HEADS, HGRN_DK, HGRN_DV), jnp.float32)
    qc, ic, ffc, fbc, gc = project(h_ctx)
    o_ctx, s_ctx_f, s_ctx_b = scan_both(qc, ic, ffc, fbc, s0, s0)
    ql, il, ffl, fbl, gl = project(h_lat)
    o_lat, _, _ = scan_both(ql, il, ffl, fbl, s_ctx_f, s_ctx_b)
    y_lat = readout(o_lat, gl, h_lat.dtype)
    y_ctx = readout(o_ctx, gc, h_ctx.dtype) if return_ctx else None
    return y_lat, y_ctx


def dwconv_latent(u, w_dw):
    bsz, length, d = u.shape
    rows = length // GRID_W
    grid = u.reshape(bsz, rows, GRID_W, d)
    half = d // 2
    dn = ('NHWC', 'HWIO', 'NHWC')
    horiz = lax.conv_general_dilated(grid[..., :half], w_dw[:, :half].reshape(1, CONV_WIDTH, 1, half),
                                     (1, 1), 'SAME', dimension_numbers=dn, feature_group_count=half)
    vert = lax.conv_general_dilated(grid[..., half:], w_dw[:, half:].reshape(CONV_WIDTH, 1, 1, d - half),
                                    (1, 1), 'SAME', dimension_numbers=dn, feature_group_count=d - half)
    return jnp.concatenate([horiz, vert], axis=-1).reshape(bsz, length, d)


def dwconv_seq(u, w_dw):
    d = u.shape[-1]
    return lax.conv_general_dilated(u, w_dw.reshape(CONV_WIDTH, 1, d), (1,), 'SAME',
                                    dimension_numbers=('NWC', 'WIO', 'NWC'), feature_group_count=d)


def conformer_conv(h, dwconv, w_in, b_in, w_dw, b_dw, g_ln, b_ln, w_out, b_out):
    a, gt = jnp.split(h @ w_in + b_in, 2, axis=-1)
    u = a * jax.nn.sigmoid(gt)
    z = dwconv(u, w_dw) + b_dw
    z = jax.nn.silu(layernorm(z, g_ln, b_ln))
    return z @ w_out + b_out


def moe_ffn(x, w_r, b_r, w1, b1, w2, b2):
    shp = x.shape
    xf = x.reshape(-1, shp[-1])
    n = xf.shape[0]
    nk = n * TOP_K
    logits = (xf @ w_r + b_r).astype(jnp.float32)
    top_val, top_idx = lax.top_k(logits, TOP_K)
    gates = jax.nn.softmax(top_val, axis=-1)
    e_flat = top_idx.reshape(-1)
    w_flat = gates.reshape(-1)
    tok_flat = jnp.arange(nk, dtype=jnp.int32) // TOP_K
    order = jnp.argsort(e_flat, stable=True)
    e_sorted = e_flat[order]
    sizes = jnp.bincount(e_flat, length=N_EXPERTS)
    group_start = jnp.cumsum(sizes) - sizes
    padded = (sizes + MOE_BLOCK - 1) // MOE_BLOCK * MOE_BLOCK
    padded_end = jnp.cumsum(padded)
    padded_start = padded_end - padded
    dest = padded_start[e_sorted] + jnp.arange(nk, dtype=jnp.int32) - group_start[e_sorted]
    n_blocks = -(-(nk + N_EXPERTS * (MOE_BLOCK - 1)) // MOE_BLOCK)
    cap = n_blocks * MOE_BLOCK
    buf_tok = jnp.zeros((cap,), jnp.int32).at[dest].set(tok_flat[order])
    buf_w = jnp.zeros((cap,), jnp.float32).at[dest].set(w_flat[order])
    block_e = jnp.minimum(jnp.searchsorted(padded_end, jnp.arange(n_blocks) * MOE_BLOCK, side='right'),
                          N_EXPERTS - 1)

    def expert_block(args):
        tok_b, e = args
        xb = xf[tok_b]
        gate, up = jnp.split(xb @ w1[e] + b1[e], 2, axis=-1)
        gate = jnp.minimum(gate, SWIGLU_LIMIT)
        up = jnp.clip(up, -SWIGLU_LIMIT, SWIGLU_LIMIT)
        act = (up + 1.0) * gate * jax.nn.sigmoid(SWIGLU_ALPHA * gate)
        return act @ w2[e] + b2[e]

    out = lax.map(expert_block, (buf_tok.reshape(n_blocks, MOE_BLOCK), block_e))
    out = out.reshape(cap, shp[-1]) * buf_w[:, None].astype(out.dtype)
    y = jax.ops.segment_sum(out, buf_tok, num_segments=n)
    return y.reshape(shp)


def setup_inputs(seed: int = 0) -> dict:
    key = jax.random.key(seed)
    ks = iter(jax.random.split(key, 32))
    d = D_MODEL
    hk = HGRN_HEADS * HGRN_DK
    hv = HGRN_HEADS * HGRN_DV
    nh, ncv = N_HGRN_LAYERS, N_CONV_LAYERS

    def nrm(shape, scale):
        return jax.random.normal(next(ks), shape, jnp.float32) * scale

    def gain(shape):
        return 1.0 + nrm(shape, 0.02)

    return {
        "x": nrm((BATCH, SEQ, d), 1.0),
        "c": nrm((BATCH, d), 1.0),
        "ctx": nrm((BATCH, CTX_LEN, d), 1.0),
        "c_ctx": nrm((d,), 1.0),
        "w_ada": nrm((DEPTH, d, 6 * d), 0.5 * d ** -0.5),
        "b_ada": nrm((DEPTH, 6 * d), 0.02),
        "g_mix": gain((DEPTH, d)),
        "g_ffn": gain((DEPTH, d)),
        "w_hgrn_in": nrm((nh, d, 3 * hk + 2 * hv), d ** -0.5),
        "hgrn_gamma": nrm((2, nh + 1, hk), 0.5),
        "g_hgrn_out": gain((nh, hv)),
        "w_hgrn_out": nrm((nh, hv, d), hv ** -0.5),
        "w_cv_in": nrm((ncv, d, 2 * d), d ** -0.5),
        "b_cv_in": nrm((ncv, 2 * d), 0.02),
        "w_cv_dw": nrm((ncv, CONV_WIDTH, d), CONV_WIDTH ** -0.5),
        "b_cv_dw": nrm((ncv, d), 0.02),
        "g_cv_ln": gain((ncv, d)),
        "b_cv_ln": nrm((ncv, d), 0.02),
        "w_cv_out": nrm((ncv, d, d), d ** -0.5),
        "b_cv_out": nrm((ncv, d), 0.02),
        "w_router": nrm((DEPTH, d, N_EXPERTS), d ** -0.5),
        "b_router": nrm((DEPTH, N_EXPERTS), 0.01),
        "w_exp_in": nrm((DEPTH, N_EXPERTS, d, 2 * D_EXPERT), d ** -0.5),
        "b_exp_in": nrm((DEPTH, N_EXPERTS, 2 * D_EXPERT), 0.01),
        "w_exp_out": nrm((DEPTH, N_EXPERTS, D_EXPERT, d), D_EXPERT ** -0.5),
        "b_exp_out": nrm((DEPTH, N_EXPERTS, d), 0.01),
        "g_final": gain((d,)),
    }


def reference(x, c, ctx, c_ctx, w_ada, b_ada, g_mix, g_ffn, w_hgrn_in, hgrn_gamma, g_hgrn_out,
              w_hgrn_out, w_cv_in, b_cv_in, w_cv_dw, b_cv_dw, g_cv_ln, b_cv_ln, w_cv_out, b_cv_out,
              w_router, b_router, w_exp_in, b_exp_in, w_exp_out, b_exp_out, g_final):
    lb_all = jnp.cumsum(jax.nn.softmax(hgrn_gamma.astype(jnp.float32), axis=1), axis=1)
    ctx_s = ctx
    for l in range(DEPTH):
        mixer = l % N_MIXERS
        j = l // N_MIXERS
        ctx_later = any(m % N_MIXERS == 0 for m in range(l + 1, DEPTH))
        sh_m, sc_m, gt_m, sh_f, sc_f, gt_f = [m[:, None, :] for m in ada_mods(c, w_ada[l], b_ada[l])]
        h_lat = rmsnorm(x, g_mix[l]) * (1.0 + sc_m) + sh_m
        if mixer == 0 or ctx_later:
            csh_m, csc_m, cgt_m, csh_f, csc_f, cgt_f = ada_mods(c_ctx, w_ada[l], b_ada[l])
            h_ctx = rmsnorm(ctx_s, g_mix[l]) * (1.0 + csc_m) + csh_m
        if mixer == 0:
            y_lat, y_ctx = hgrn2_mixer(h_lat, h_ctx, w_hgrn_in[j], lb_all[0, j], lb_all[1, j],
                                       g_hgrn_out[j], w_hgrn_out[j], ctx_later)
        else:
            conv_p = (w_cv_in[j], b_cv_in[j], w_cv_dw[j], b_cv_dw[j], g_cv_ln[j], b_cv_ln[j],
                      w_cv_out[j], b_cv_out[j])
            y_lat = conformer_conv(h_lat, dwconv_latent, *conv_p)
            y_ctx = conformer_conv(h_ctx, dwconv_seq, *conv_p) if ctx_later else None
        x = x + gt_m * y_lat
        hf_lat = rmsnorm(x, g_ffn[l]) * (1.0 + sc_f) + sh_f
        moe_p = (w_router[l], b_router[l], w_exp_in[l], b_exp_in[l], w_exp_out[l], b_exp_out[l])
        if ctx_later:
            ctx_s = ctx_s + cgt_m * y_ctx
            hf_ctx = rmsnorm(ctx_s, g_ffn[l]) * (1.0 + csc_f) + csh_f
            n_lat = hf_lat.shape[0] * hf_lat.shape[1]
            y_all = moe_ffn(jnp.concatenate([hf_lat.reshape(-1, D_MODEL), hf_ctx.reshape(-1, D_MODEL)], axis=0),
                            *moe_p)
            x = x + gt_f * y_all[:n_lat].reshape(x.shape)
            ctx_s = ctx_s + cgt_f * y_all[n_lat:].reshape(ctx_s.shape)
        else:
            x = x + gt_f * moe_ffn(hf_lat, *moe_p)
    return rmsnorm(x, g_final)
```

```cpp
#include <hip/hip_runtime.h>
#include <cstdio>
#include <cstdint>

namespace pg8 {
#define PG8_LAS __attribute__((address_space(3)))
typedef unsigned short bf16_t;
typedef short bf16x8 __attribute__((ext_vector_type(8)));
typedef float f32x4 __attribute__((ext_vector_type(4)));
typedef unsigned u32x4 __attribute__((ext_vector_type(4)));
typedef unsigned u32x2 __attribute__((ext_vector_type(2)));
typedef int i32x4 __attribute__((ext_vector_type(4)));
typedef int i32x8 __attribute__((ext_vector_type(8)));
constexpr int BM = 256, BK = 64, HALF = 128, HTB = HALF * BK * 2  , STAGE_BYTES = 8 * HTB, NXCD = 8, WGM = 8;

__host__ __device__ __forceinline__ int lds_byte(int r, int c) { const int st = (r >> 4) * 2 + (c >> 5), rr = r & 15, cc = c & 31, ob = rr * 64 + cc * 2; return st * 1024 + (ob ^ (((ob >> 9) & 1) << 5)); }
__host__ __device__ __forceinline__ void stage_rc(int b, int& R, int& C) { const int st = b / 1024, sb = b % 1024, swz = sb ^ (((sb >> 9) & 1) << 5); R = (st >> 1) * 16 + swz / 64; C = (st & 1) * 32 + (swz % 64) / 2; }
__host__ __device__ __forceinline__ int perm32(int rho) { const int n = rho >> 4, i = rho & 15; return 8 * (i >> 2) + 4 * n + (i & 3); }

struct Unit { int pm, pn, e; };
struct Gemm { const bf16_t* A; const bf16_t* Bt; int K; size_t estride; const PG8_LAS unsigned short* tt; };

struct TileOrder {
    int nM, nN, nwg, G, c; const PG8_LAS int* tile_e;
    __device__ __forceinline__ void init(int nM_, int nN_, int G_, int c_, const PG8_LAS int* te) { nM = nM_; nN = nN_; nwg = nM * nN; G = G_; c = c_; tile_e = te; }
    __device__ __forceinline__ bool next(int i, Unit& u) const {
        const long L = (long)i * G + c; if (L >= nwg) return false;
        int wgid = (int)L; { const int q = nwg / NXCD, r = nwg % NXCD, xcd = wgid % NXCD, off = wgid / NXCD; wgid = (xcd < r ? xcd * (q + 1) : r * (q + 1) + (xcd - r) * q) + off; }
        const int nig = WGM * nN, gid = wgid / nig, fm = gid * WGM, gsz = (nM - fm) < WGM ? (nM - fm) : WGM;
        u.pm = fm + ((wgid % nig) % gsz); u.pn = (wgid % nig) / gsz;
        u.e = tile_e ? __builtin_amdgcn_readfirstlane(tile_e[u.pm]) : 0; return true;
    }
    __device__ __forceinline__ void a_ready(const Unit&) const {}
    __device__ __forceinline__ void done(const Unit&) const {}
};

struct OneUnit {
    int pm, pn;
    __device__ __forceinline__ bool next(int i, Unit& u) const { if (i != 0) return false; u.pm = pm; u.pn = pn; u.e = 0; return true; }
    __device__ __forceinline__ void a_ready(const Unit&) const {}
    __device__ __forceinline__ void done(const Unit&) const {}
};

__device__ __forceinline__ unsigned cvt_pk_bf16(float lo, float hi) { unsigned r; asm volatile("v_cvt_pk_bf16_f32 %0, %1, %2" : "=v"(r) : "v"(lo), "v"(hi)); return r; }
__device__ __forceinline__ float fsigmoid(float x) { return __builtin_amdgcn_rcpf(1.0f + __expf(-x)); }


struct EpiHgrnIn {
    static constexpr bool PERM = true, AFTER_DRAIN = false;
    bf16_t* Q; size_t qstride; _Float16* LFF; size_t lfstride; const float* gamma; int mode;
    static __device__ __forceinline__ f32x4 vexp2(f32x4 t) { f32x4 e; e[0] = __builtin_amdgcn_exp2f(t[0]); e[1] = __builtin_amdgcn_exp2f(t[1]); e[2] = __builtin_amdgcn_exp2f(t[2]); e[3] = __builtin_amdgcn_exp2f(t[3]); return e; }
    static __device__ __forceinline__ f32x4 vrcp(f32x4 d) { f32x4 r; r[0] = __builtin_amdgcn_rcpf(d[0]); r[1] = __builtin_amdgcn_rcpf(d[1]); r[2] = __builtin_amdgcn_rcpf(d[2]); r[3] = __builtin_amdgcn_rcpf(d[3]); return r; }
    static __device__ __forceinline__ f32x4 vlog2(f32x4 d) { f32x4 r; r[0] = __builtin_amdgcn_logf(d[0]); r[1] = __builtin_amdgcn_logf(d[1]); r[2] = __builtin_amdgcn_logf(d[2]); r[3] = __builtin_amdgcn_logf(d[3]); return r; }
    __device__ __forceinline__ void operator()(const f32x4 (&acc)[2][2][4][2], const Unit& u, int wr, int wc, int fr, int fq) const {
        const int sg_ = u.pn >> 2, seg = mode == 0 ? sg_ : (mode == 1 ? (sg_ < 2 ? sg_ : 4) : 2 + sg_), cb = (u.pn & 3) * 256 + wc * 32 + 8 * fq;
        const int row0 = u.pm * BM + wr * 64 + fr;
        if (seg == 2 || seg == 3) {
            _Float16* O = LFF + (size_t)(seg - 2) * lfstride; const float* g0 = gamma + (seg - 2) * 2048 + cb;
            f32x4 lb[2][2];
#pragma unroll
            for (int bj = 0; bj < 2; ++bj)
#pragma unroll
                for (int n = 0; n < 2; ++n) { const f32x4 d = *(const f32x4*)(g0 + bj * HALF + 4 * n) - *(const f32x4*)(g0 + 1024 + bj * HALF + 4 * n);
                    lb[bj][n] = vrcp(vexp2(d * -1.4426950408889634f) + 1.0f); }
#pragma unroll
            for (int ai = 0; ai < 2; ++ai)
#pragma unroll
                for (int m = 0; m < 4; ++m) { _Float16* rowp = O + (size_t)(row0 + ai * HALF + m * 16) * 1024 + cb;
#pragma unroll
                    for (int bj = 0; bj < 2; ++bj) { typedef _Float16 h16x8 __attribute__((ext_vector_type(8))); h16x8 o;
#pragma unroll
                        for (int n = 0; n < 2; ++n) { const f32x4 sg = vrcp(vexp2(acc[ai][bj][m][n] * -1.4426950408889634f) + 1.0f);
                            const f32x4 lf = vlog2(lb[bj][n] + (1.0f - lb[bj][n]) * sg) * 0.6931471805599453f;
                            o[4 * n + 0] = (_Float16)lf[0]; o[4 * n + 1] = (_Float16)lf[1]; o[4 * n + 2] = (_Float16)lf[2]; o[4 * n + 3] = (_Float16)lf[3]; }
                        *(h16x8*)(rowp + bj * HALF) = o; } }
        } else {
            bf16_t* O = Q + (size_t)(seg - (seg >> 2) * 2) * qstride;
#pragma unroll
            for (int ai = 0; ai < 2; ++ai)
#pragma unroll
                for (int m = 0; m < 4; ++m) { bf16_t* rowp = O + (size_t)(row0 + ai * HALF + m * 16) * 1024 + cb;
#pragma unroll
                    for (int bj = 0; bj < 2; ++bj) { f32x4 v0 = acc[ai][bj][m][0], v1 = acc[ai][bj][m][1];
                        if (seg == 4) { v0 = v0 * vrcp(vexp2(v0 * -1.4426950408889634f) + 1.0f); v1 = v1 * vrcp(vexp2(v1 * -1.4426950408889634f) + 1.0f); }
                        u32x4 w; w.x = cvt_pk_bf16(v0[0], v0[1]); w.y = cvt_pk_bf16(v0[2], v0[3]); w.z = cvt_pk_bf16(v1[0], v1[1]); w.w = cvt_pk_bf16(v1[2], v1[3]);
                        *(u32x4*)(rowp + bj * HALF) = w; } }
        }
    }
};
template <bool BASE16, bool OUT16> struct EpiResGate {
    static constexpr bool PERM = false, AFTER_DRAIN = false;
    const void* base; void* out; const float* gate; int gate_bstride; int rows_per_batch; const float* bias;
    __device__ __forceinline__ void operator()(const f32x4 (&acc)[2][2][4][2], const Unit& u, int wr, int wc, int fr, int fq) const {
        const int row0 = u.pm * BM + wr * 64 + fr, col0 = u.pn * BM + wc * 32 + 4 * fq;
        const float* gv_ = gate + (size_t)((u.pm * BM) / rows_per_batch) * gate_bstride;
        f32x4 gv[2][2], bv[2][2];
#pragma unroll
        for (int bj = 0; bj < 2; ++bj)
#pragma unroll
            for (int n = 0; n < 2; ++n) { gv[bj][n] = *(const f32x4*)(gv_ + col0 + bj * HALF + n * 16); bv[bj][n] = bias ? *(const f32x4*)(bias + col0 + bj * HALF + n * 16) : (f32x4){0.f, 0.f, 0.f, 0.f}; }
#pragma unroll
        for (int ai = 0; ai < 2; ++ai)
#pragma unroll
            for (int m = 0; m < 4; ++m) { const size_t off = (size_t)(row0 + ai * HALF + m * 16) * 1024 + col0;
#pragma unroll
                for (int bj = 0; bj < 2; ++bj)
#pragma unroll
                    for (int n = 0; n < 2; ++n) { const size_t o = off + bj * HALF + n * 16; f32x4 bs;
                        if constexpr (BASE16) { const u32x2 w = *(const u32x2*)((const bf16_t*)base + o); bs = (f32x4){__builtin_bit_cast(float, w.x << 16), __builtin_bit_cast(float, w.x & 0xffff0000u), __builtin_bit_cast(float, w.y << 16), __builtin_bit_cast(float, w.y & 0xffff0000u)}; }
                        else bs = *(const f32x4*)((const float*)base + o);
                        const f32x4 r = bs + gv[bj][n] * (acc[ai][bj][m][n] + bv[bj][n]);
                        if constexpr (OUT16) *(u32x2*)((bf16_t*)out + o) = (u32x2){cvt_pk_bf16(r[0], r[1]), cvt_pk_bf16(r[2], r[3])};
                        else *(f32x4*)((float*)out + o) = r; } }
    }
};
template <int MODE, bool OUT8 = false, int OSCALE = 1> struct EpiPair {
    static constexpr bool PERM = true, AFTER_DRAIN = false;
    bf16_t* O; const float* bias0;
    static __device__ __forceinline__ f32x4 vsig(f32x4 x, float negscale) {
        const f32x4 t = x * negscale; f32x4 e; e[0] = __builtin_amdgcn_exp2f(t[0]); e[1] = __builtin_amdgcn_exp2f(t[1]); e[2] = __builtin_amdgcn_exp2f(t[2]); e[3] = __builtin_amdgcn_exp2f(t[3]);
        const f32x4 d = e + 1.0f; f32x4 r; r[0] = __builtin_amdgcn_rcpf(d[0]); r[1] = __builtin_amdgcn_rcpf(d[1]); r[2] = __builtin_amdgcn_rcpf(d[2]); r[3] = __builtin_amdgcn_rcpf(d[3]); return r; }
    __device__ __forceinline__ void operator()(const f32x4 (&acc)[2][2][4][2], const Unit& u, int wr, int wc, int fr, int fq) const {
        const float* bias = bias0 + (MODE == 0 ? (size_t)u.e * 2048 : 0);
        const int row0 = u.pm * BM + wr * 64 + fr, cg = u.pn * HALF + wc * 32 + 8 * fq;
        f32x4 b0[2], b1[2];
#pragma unroll
        for (int n = 0; n < 2; ++n) { b0[n] = *(const f32x4*)(bias + cg + 4 * n); b1[n] = *(const f32x4*)(bias + 1024 + cg + 4 * n); }
#pragma unroll
        for (int ai = 0; ai < 2; ++ai)
#pragma unroll
            for (int m = 0; m < 4; ++m) { bf16_t* rowp = O + (size_t)(row0 + ai * HALF + m * 16) * 1024 + cg; f32x4 r[2];
#pragma unroll
                for (int n = 0; n < 2; ++n) { const f32x4 g = acc[ai][0][m][n] + b0[n], up = acc[ai][1][m][n] + b1[n];
                    if (MODE == 0) { const f32x4 gg = __builtin_elementwise_min(g, (f32x4){7.0f, 7.0f, 7.0f, 7.0f});
                        const f32x4 uu = __builtin_elementwise_min(__builtin_elementwise_max(up, (f32x4){-7.0f, -7.0f, -7.0f, -7.0f}), (f32x4){7.0f, 7.0f, 7.0f, 7.0f});
                        r[n] = (uu * (float)OSCALE + (float)OSCALE) * (gg * vsig(gg, -1.702f * 1.4426950408889634f)); }
                    else r[n] = (g * (float)OSCALE) * vsig(up, -1.4426950408889634f); }
                if constexpr (OUT8) {
                    int w0 = 0, w1 = 0;
                    w0 = __builtin_amdgcn_cvt_pk_fp8_f32(r[0][0], r[0][1], w0, false); w0 = __builtin_amdgcn_cvt_pk_fp8_f32(r[0][2], r[0][3], w0, true);
                    w1 = __builtin_amdgcn_cvt_pk_fp8_f32(r[1][0], r[1][1], w1, false); w1 = __builtin_amdgcn_cvt_pk_fp8_f32(r[1][2], r[1][3], w1, true);
                    *(u32x2*)((unsigned char*)O + (size_t)(row0 + ai * HALF + m * 16) * 1024 + cg) = (u32x2){(unsigned)w0, (unsigned)w1};
                } else {
                u32x4 w; w.x = cvt_pk_bf16(r[0][0], r[0][1]); w.y = cvt_pk_bf16(r[0][2], r[0][3]); w.z = cvt_pk_bf16(r[1][0], r[1][1]); w.w = cvt_pk_bf16(r[1][2], r[1][3]);
                *(u32x4*)rowp = w; } }
    }
};
template <bool OUT8, int OSCALE> struct EpiMoeOut {
    static constexpr bool PERM = true, AFTER_DRAIN = false;
    bf16_t* O; const float* bias0;
    __device__ __forceinline__ void operator()(const f32x4 (&acc)[2][2][4][2], const Unit& u, int wr, int wc, int fr, int fq) const {
        const float* bias = bias0 + (size_t)u.e * 1024;
        const int row0 = u.pm * BM + wr * 64 + fr, col0 = u.pn * BM + wc * 32 + 8 * fq;
        f32x4 bv[2][2];
#pragma unroll
        for (int bj = 0; bj < 2; ++bj)
#pragma unroll
            for (int n = 0; n < 2; ++n) bv[bj][n] = *(const f32x4*)(bias + col0 + bj * HALF + 4 * n);
#pragma unroll
        for (int ai = 0; ai < 2; ++ai)
#pragma unroll
            for (int m = 0; m < 4; ++m) { const int r = row0 + ai * HALF + m * 16;
#pragma unroll
                for (int bj = 0; bj < 2; ++bj) { const f32x4 v0 = acc[ai][bj][m][0] + bv[bj][0], v1 = acc[ai][bj][m][1] + bv[bj][1];
                    if constexpr (OUT8) { const f32x4 lim = (f32x4){448.0f, 448.0f, 448.0f, 448.0f};
                        const f32x4 s0 = __builtin_elementwise_min(__builtin_elementwise_max(v0 * (float)OSCALE, -lim), lim), s1 = __builtin_elementwise_min(__builtin_elementwise_max(v1 * (float)OSCALE, -lim), lim); int w0 = 0, w1 = 0;
                        w0 = __builtin_amdgcn_cvt_pk_fp8_f32(s0[0], s0[1], w0, false); w0 = __builtin_amdgcn_cvt_pk_fp8_f32(s0[2], s0[3], w0, true);
                        w1 = __builtin_amdgcn_cvt_pk_fp8_f32(s1[0], s1[1], w1, false); w1 = __builtin_amdgcn_cvt_pk_fp8_f32(s1[2], s1[3], w1, true);
                        *(u32x2*)((unsigned char*)O + (size_t)r * 1024 + col0 + bj * HALF) = (u32x2){(unsigned)w0, (unsigned)w1};
                    } else { u32x4 w; w.x = cvt_pk_bf16(v0[0], v0[1]); w.y = cvt_pk_bf16(v0[2], v0[3]); w.z = cvt_pk_bf16(v1[0], v1[1]); w.w = cvt_pk_bf16(v1[2], v1[3]);
                        *(u32x4*)(O + (size_t)r * 1024 + col0 + bj * HALF) = w; } } }
    }
};

template <class Epi, class Sched, bool ALIGN_EPI = false, bool SP2 = false, bool F8 = false, int SCW = 0x7F7F7F7F, int SCA = 0x7F7F7F7F, bool GATHER = false>
__device__ __forceinline__ void gemm_phase(PG8_LAS unsigned char* lds, const Gemm g, const Sched& S, const Epi& E) {
    const int tid = threadIdx.x, wid = __builtin_amdgcn_readfirstlane(tid >> 6), lane = tid & 63, wr = wid >> 2, wc = wid & 3, fr = lane & 15, fq = lane >> 4;
    const int K = g.K, nt = K / BK;
    unsigned voffA[2], voffB[2]; int stR[2], stC[2];
#pragma unroll
    for (int i = 0; i < 2; ++i) { int R, C; stage_rc(tid * 16 + i * 8192, R, C); const int Rb = Epi::PERM ? ((R & ~31) + perm32(R & 31)) : R; stR[i] = R; stC[i] = C;
        voffA[i] = (unsigned)(R * K + C) * 2u; voffB[i] = (unsigned)(Rb * K + C) * 2u; }
    const size_t kstep = (size_t)(BK * 2);
    const size_t hstep = (size_t)HALF * K * 2;
    const size_t tstep = 2 * hstep;
    unsigned vc[2][2], vn[2][2];
#pragma unroll
    for (int h = 0; h < 2; ++h)
#pragma unroll
        for (int i = 0; i < 2; ++i) {
            if constexpr (GATHER) vc[h][i] = (unsigned)g.tt[h * HALF + stR[i]] * (unsigned)(K * 2) + (unsigned)stC[i] * 2u;
            else vc[h][i] = voffA[i] + (unsigned)h * (unsigned)hstep;
            vn[h][i] = vc[h][i]; }
    const unsigned ldsw = (unsigned)wid * 1024u;
    const int aoff = lds_byte(wr * 64 + fr, fq * 8), boff = lds_byte(wc * 32 + fr, fq * 8);
#define PG8_SA(b, h) (((b) * 2 + (h)) * HTB)
#define PG8_SB(b, h) ((4 + (b) * 2 + (h)) * HTB)
#define PG8_STAGE(bufoff, gbase, voff) do { _Pragma("unroll") for (int _i = 0; _i < 2; ++_i) \
        __builtin_amdgcn_global_load_lds((const unsigned*)((const char*)(gbase) + (voff)[_i]), (PG8_LAS unsigned*)(lds + (bufoff) + ldsw + _i * 8192), 16, 0, 0); } while (0)
#define PG8_LDA(dst, b, h) do { _Pragma("unroll") for (int m = 0; m < 4; ++m) _Pragma("unroll") for (int k = 0; k < 2; ++k) dst[m][k] = *(const PG8_LAS bf16x8*)(lds + PG8_SA(b, h) + aoff + m * 2048 + k * 1024); } while (0)
#define PG8_LDB(dst, b, h) do { _Pragma("unroll") for (int n = 0; n < 2; ++n) _Pragma("unroll") for (int k = 0; k < 2; ++k) dst[n][k] = *(const PG8_LAS bf16x8*)(lds + PG8_SB(b, h) + boff + n * 2048 + k * 1024); } while (0)
#define PG8_MMA(ai, bj, At, Bt) do { __builtin_amdgcn_s_setprio(1); \
        if constexpr (!F8) { _Pragma("unroll") for (int m = 0; m < 4; ++m) _Pragma("unroll") for (int n = 0; n < 2; ++n) _Pragma("unroll") for (int k = 0; k < 2; ++k) \
            acc[ai][bj][m][n] = __builtin_amdgcn_mfma_f32_16x16x32_bf16(Bt[n][k], At[m][k], acc[ai][bj][m][n], 0, 0, 0); } \
        else { const int scw_ = SCW, sca_ = SCA; _Pragma("unroll") for (int m = 0; m < 4; ++m) _Pragma("unroll") for (int n = 0; n < 2; ++n) { \
            const i32x8 wf_ = __builtin_shufflevector(__builtin_bit_cast(i32x4, Bt[n][0]), __builtin_bit_cast(i32x4, Bt[n][1]), 0, 1, 2, 3, 4, 5, 6, 7); \
            const i32x8 af_ = __builtin_shufflevector(__builtin_bit_cast(i32x4, At[m][0]), __builtin_bit_cast(i32x4, At[m][1]), 0, 1, 2, 3, 4, 5, 6, 7); \
            asm volatile("v_mfma_scale_f32_16x16x128_f8f6f4 %0, %1, %2, %0, %3, %4 op_sel_hi:[0,0,0]" : "+v"(acc[ai][bj][m][n]) : "v"(wf_), "v"(af_), "v"(scw_), "v"(sca_)); } } \
        __builtin_amdgcn_s_setprio(0); } while (0)
#define PG8_WAIT_V(n) asm volatile("s_waitcnt vmcnt(" #n ")" ::: "memory")
#define PG8_WAIT_L(n) asm volatile("s_waitcnt lgkmcnt(" #n ")" ::: "memory")
#define PG8_BAR __builtin_amdgcn_s_barrier()
#define PG8_SCHED __builtin_amdgcn_sched_barrier(0)
    Unit cur, nxt; int ui = 0;
    if (!S.next(0, cur)) return;
    f32x4 acc[2][2][4][2];
#pragma unroll
    for (int a = 0; a < 2; ++a)
#pragma unroll
        for (int b = 0; b < 2; ++b)
#pragma unroll
            for (int m = 0; m < 4; ++m)
#pragma unroll
                for (int n = 0; n < 2; ++n) acc[a][b][m][n] = (f32x4){0.f, 0.f, 0.f, 0.f};
    bf16x8 At[4][2], B0[2][2], B1[2][2];
    const char* cA = (const char*)g.A + (GATHER ? (size_t)0 : (size_t)cur.pm * tstep); const char* cB = (const char*)g.Bt + (size_t)cur.e * g.estride + (size_t)cur.pn * tstep;
    S.a_ready(cur);
    if constexpr (SP2) {
        PG8_STAGE(PG8_SB(0, 0), cB, voffB); PG8_STAGE(PG8_SB(0, 1), cB + hstep, voffB); PG8_STAGE(PG8_SA(0, 0), cA, vc[0]); PG8_STAGE(PG8_SA(0, 1), cA, vc[1]);
        if (wr == 1) PG8_BAR;
        PG8_WAIT_V(2); PG8_BAR;
        PG8_STAGE(PG8_SB(1, 0), cB + kstep, voffB); PG8_STAGE(PG8_SA(1, 0), cA + kstep, vc[0]); PG8_STAGE(PG8_SB(1, 1), cB + hstep + kstep, voffB);
        PG8_WAIT_V(6); PG8_BAR;
    } else {
        PG8_STAGE(PG8_SB(0, 0), cB, voffB); PG8_STAGE(PG8_SA(0, 0), cA, vc[0]); PG8_STAGE(PG8_SB(0, 1), cB + hstep, voffB); PG8_STAGE(PG8_SA(0, 1), cA, vc[1]);
        if (wr == 1) PG8_BAR;
        PG8_WAIT_V(4); PG8_BAR;
        PG8_STAGE(PG8_SB(1, 0), cB + kstep, voffB); PG8_STAGE(PG8_SA(1, 0), cA + kstep, vc[0]); PG8_STAGE(PG8_SB(1, 1), cB + hstep + kstep, voffB);
        PG8_WAIT_V(6); PG8_BAR;
    }
    for (;;) {
        const bool has_next = S.next(ui + 1, nxt);
        if constexpr (GATHER) { if (has_next) {
#pragma unroll
            for (int h = 0; h < 2; ++h)
#pragma unroll
                for (int i = 0; i < 2; ++i) vn[h][i] = (unsigned)g.tt[(ui + 1) * BM + h * HALF + stR[i]] * (unsigned)(K * 2) + (unsigned)stC[i] * 2u; } }
        const char* nA = (has_next && !GATHER) ? (const char*)g.A + (size_t)nxt.pm * tstep : cA; const char* nB = has_next ? (const char*)g.Bt + (size_t)nxt.e * g.estride + (size_t)nxt.pn * tstep : cB;
        for (int t = 0; t < nt; t += 2) {
            const bool last = (t == nt - 2);
            unsigned vs[2][2];
#pragma unroll
            for (int h = 0; h < 2; ++h)
#pragma unroll
                for (int i = 0; i < 2; ++i) vs[h][i] = (GATHER && last) ? vn[h][i] : vc[h][i];
            const char* a1 = cA + (size_t)(t + 1) * kstep;
            const char* a2 = last ? nA : cA + (size_t)(t + 2) * kstep; const char* b2 = last ? nB : cB + (size_t)(t + 2) * kstep;
            const char* a3 = a2 + kstep; const char* b3 = b2 + kstep;
            if (last && has_next) S.a_ready(nxt);
            if constexpr (SP2) {
            PG8_LDB(B0, 0, 0); PG8_LDB(B1, 0, 1); PG8_SCHED; PG8_LDA(At, 0, 0); PG8_STAGE(PG8_SA(1, 1), a1, vc[1]);
            PG8_WAIT_V(8); PG8_WAIT_L(0); PG8_BAR; PG8_MMA(0, 0, At, B0); PG8_MMA(0, 1, At, B1); PG8_BAR; PG8_SCHED;
            PG8_LDA(At, 0, 1); PG8_STAGE(PG8_SB(0, 0), b2, voffB); PG8_STAGE(PG8_SB(0, 1), b2 + hstep, voffB); PG8_STAGE(PG8_SA(0, 0), a2, vs[0]);
            PG8_WAIT_V(8); PG8_WAIT_L(0); PG8_BAR; PG8_MMA(1, 0, At, B0); PG8_MMA(1, 1, At, B1); PG8_BAR; PG8_SCHED;
            PG8_LDB(B0, 1, 0); PG8_LDB(B1, 1, 1); PG8_SCHED; PG8_LDA(At, 1, 0); PG8_STAGE(PG8_SA(0, 1), a2, vs[1]);
            PG8_WAIT_V(8); PG8_WAIT_L(0); PG8_BAR; PG8_MMA(0, 0, At, B0); PG8_MMA(0, 1, At, B1); PG8_BAR; PG8_SCHED;
            PG8_LDA(At, 1, 1); PG8_STAGE(PG8_SB(1, 0), b3, voffB); PG8_STAGE(PG8_SB(1, 1), b3 + hstep, voffB); PG8_STAGE(PG8_SA(1, 0), a3, vs[0]);
            PG8_WAIT_V(8); PG8_WAIT_L(0); PG8_BAR; PG8_MMA(1, 0, At, B0); PG8_MMA(1, 1, At, B1); PG8_BAR; PG8_SCHED;
            } else {
            PG8_LDB(B0, 0, 0); PG8_SCHED; PG8_LDA(At, 0, 0); PG8_STAGE(PG8_SA(1, 1), a1, vc[1]);
            PG8_WAIT_L(8); PG8_BAR; PG8_WAIT_L(0); PG8_MMA(0, 0, At, B0); PG8_BAR; PG8_SCHED;
            PG8_LDB(B1, 0, 1); PG8_STAGE(PG8_SB(0, 0), b2, voffB);
            PG8_BAR; PG8_WAIT_L(0); PG8_MMA(0, 1, At, B1); PG8_BAR;
            PG8_LDA(At, 0, 1); PG8_STAGE(PG8_SA(0, 0), a2, vs[0]);
            PG8_BAR; PG8_WAIT_L(0); PG8_MMA(1, 0, At, B0); PG8_BAR; PG8_SCHED;
            PG8_STAGE(PG8_SB(0, 1), b2 + hstep, voffB);
            PG8_WAIT_V(6); PG8_BAR; PG8_MMA(1, 1, At, B1); PG8_BAR;
            PG8_LDB(B0, 1, 0); PG8_SCHED; PG8_LDA(At, 1, 0); PG8_STAGE(PG8_SA(0, 1), a2, vs[1]);
            PG8_WAIT_L(8); PG8_BAR; PG8_WAIT_L(0); PG8_MMA(0, 0, At, B0); PG8_BAR; PG8_SCHED;
            PG8_LDB(B1, 1, 1); PG8_STAGE(PG8_SB(1, 0), b3, voffB);
            PG8_BAR; PG8_WAIT_L(0); PG8_MMA(0, 1, At, B1); PG8_BAR;
            PG8_LDA(At, 1, 1); PG8_STAGE(PG8_SA(1, 0), a3, vs[0]);
            PG8_BAR; PG8_WAIT_L(0); PG8_MMA(1, 0, At, B0); PG8_BAR; PG8_SCHED;
            PG8_STAGE(PG8_SB(1, 1), b3 + hstep, voffB);
            PG8_WAIT_V(6); PG8_BAR; PG8_MMA(1, 1, At, B1); PG8_BAR;
            }
        }
        if constexpr (ALIGN_EPI) { if (wr == 0) PG8_BAR; }
        if constexpr (!Epi::AFTER_DRAIN) { E(acc, cur, wr, wc, fr, fq); S.done(cur); }
        if (!has_next) break;
#pragma unroll
        for (int a = 0; a < 2; ++a)
#pragma unroll
            for (int b = 0; b < 2; ++b)
#pragma unroll
                for (int m = 0; m < 4; ++m)
#pragma unroll
                    for (int n = 0; n < 2; ++n) acc[a][b][m][n] = (f32x4){0.f, 0.f, 0.f, 0.f};
        cur = nxt; cA = nA; cB = nB; ++ui;
        if constexpr (GATHER) {
#pragma unroll
            for (int h = 0; h < 2; ++h)
#pragma unroll
                for (int i = 0; i < 2; ++i) vc[h][i] = vn[h][i]; }
        if constexpr (ALIGN_EPI) { if (wr == 1) PG8_BAR; }
    }
    PG8_WAIT_V(0);
    if constexpr (!ALIGN_EPI) { if (wr == 0) PG8_BAR; }
    PG8_BAR;
    if constexpr (Epi::AFTER_DRAIN) { E.fused(acc, cur, wr, wc, fr, fq, lds, wid, lane); S.done(cur); }
#undef PG8_SA
#undef PG8_SB
#undef PG8_STAGE
#undef PG8_LDA
#undef PG8_LDB
#undef PG8_MMA
#undef PG8_WAIT_V
#undef PG8_WAIT_L
#undef PG8_BAR
#undef PG8_SCHED
}
}


constexpr int D = 1024, NBATCH = 2, SEQ = 16384, NTOK = NBATCH * SEQ, CTXL = 256, NCTX = NBATCH * CTXL, MROWS = NTOK + NCTX;
constexpr int NHEAD = 8, DK = 128, NE = 32, TOPK = 4, CONVW = 31, GRIDW = 64, GRIDR = SEQ / GRIDW;
constexpr int NWAVES = 8, NTHR = NWAVES * 64;
constexpr int MAXTILES = 544;
constexpr float EPS = 1e-6f;
enum { I_X = 0, I_C, I_CTX, I_CCTX, I_WADA, I_BADA, I_GMIX, I_GFFN, I_WHIN, I_HGAMMA, I_GHOUT, I_WHOUT, I_WCVIN, I_BCVIN, I_WCVDW, I_BCVDW, I_GCVLN, I_BCVLN, I_WCVOUT, I_BCVOUT,
       I_WR, I_BR, I_WE1, I_BE1, I_WE2, I_BE2, I_GFINAL, N_IN };

constexpr size_t MiB = 1u << 20;
constexpr size_t WS_CTL = 0, CTL_ZERO_BYTES = 1 * MiB;
constexpr size_t WS_MODS = 1 * MiB;
constexpr size_t WS_TOPE = 2 * MiB, WS_TOPW = 2 * MiB + 512 * 1024, WS_POS = 3 * MiB, WS_BCNT = 3 * MiB + 512 * 1024, WS_TILEE = WS_BCNT + 64 * 1024, WS_SLOTW = 4 * MiB;
constexpr size_t WS_SP = 5 * MiB, WS_SD = 8 * MiB;
constexpr size_t WS_WIN = 48 * MiB, WS_WOUT = 58 * MiB, WS_WCVIN = 60 * MiB, WS_WCVOUT = 64 * MiB, WS_W1 = 66 * MiB, WS_W2 = 322 * MiB;
constexpr size_t WS_X = 450 * MiB;
constexpr size_t WS_H = 578 * MiB;
constexpr size_t WS_Q = 644 * MiB, WS_V = 709 * MiB, WS_SG = 774 * MiB, WS_LFF = 839 * MiB, WS_LFB = 969 * MiB, WS_OF = 1099 * MiB, WS_OB = 1227 * MiB, WS_YIN = 1355 * MiB;
constexpr size_t WS_AS = 1419 * MiB, WS_ACT = 1555 * MiB, WS_YS = 1691 * MiB, WS_END = 1963 * MiB;
#ifndef F8_IN
#define F8_IN 0
#endif
#ifndef SPLIT_IN
#define SPLIT_IN 1
#endif
#ifndef F8_Y
#define F8_Y 1
#endif
constexpr int YSCALE = 16;
#ifndef F8_MISC
#define F8_MISC 1
#endif
constexpr size_t WS_H8 = WS_OF + 64 * MiB;
constexpr size_t WS_WIN8 = WS_WIN + 6 * MiB;
constexpr size_t WS_STOK = WS_AS;
constexpr int CW_MODF = 3200;
constexpr int CW_FLAT = 3072;
constexpr int CW_GCNT = 2048;
constexpr float W8SCALE = 64.0f;
constexpr size_t WS_U = WS_Q, WS_ZP = WS_V, WS_Z = WS_SG;
constexpr int CW_BAR = 4096;

constexpr int RING_OFF = 0, RING_BYTES = 131072;
constexpr int LDSCTL_OFF = 139264, MISC_OFF = LDSCTL_OFF + 320, EXTRA_OFF = LDSCTL_OFF + 1024;
constexpr int LDS_BYTES = 155648;

#define LAS __attribute__((address_space(3)))
typedef unsigned short bf16;
typedef unsigned v4u __attribute__((ext_vector_type(4)));
typedef unsigned v2u __attribute__((ext_vector_type(2)));
typedef float f32x4 __attribute__((ext_vector_type(4)));
typedef int v4i __attribute__((ext_vector_type(4)));
#define LDS_WAIT() asm volatile("s_waitcnt lgkmcnt(0)" ::: "memory")
#define VM_WAIT() asm volatile("s_waitcnt vmcnt(0)" ::: "memory")
__device__ __forceinline__ unsigned f2bf(float f) { unsigned u = __builtin_bit_cast(unsigned, f); return (u + 0x7fffu + ((u >> 16) & 1u)) >> 16; }
__device__ __forceinline__ unsigned pk2(float lo, float hi) { return f2bf(lo) | (f2bf(hi) << 16); }
__device__ __forceinline__ float bf_lo(unsigned u) { return __builtin_bit_cast(float, u << 16); }
__device__ __forceinline__ float bf_hi(unsigned u) { return __builtin_bit_cast(float, u & 0xffff0000u); }
__device__ __forceinline__ float bf2f(bf16 h) { return __builtin_bit_cast(float, ((unsigned)h) << 16); }
__device__ __forceinline__ float fsig(float x) { return __builtin_amdgcn_rcpf(1.0f + __expf(-x)); }
__device__ __forceinline__ float wave_sum(float v) {
#pragma unroll
    for (int o = 1; o < 64; o <<= 1) v += __shfl_xor(v, o);
    return v;
}

__device__ __forceinline__ float sat8(float x) { return __builtin_amdgcn_fmed3f(x, -448.0f, 448.0f); }
__device__ __forceinline__ unsigned pk4_fp8(float a, float b, float c, float d) { int w = 0; w = __builtin_amdgcn_cvt_pk_fp8_f32(sat8(a), sat8(b), w, false); w = __builtin_amdgcn_cvt_pk_fp8_f32(sat8(c), sat8(d), w, true); return (unsigned)w; }
template <bool OUT8> __device__ __forceinline__ void store_row4(void* orow, int lane, int j, f32x4 y, float scale) {
    if constexpr (OUT8) ((unsigned*)orow)[lane + 64 * j] = pk4_fp8(y.x * scale, y.y * scale, y.z * scale, y.w * scale);
    else { v2u w; w.x = pk2(y.x, y.y); w.y = pk2(y.z, y.w); ((v2u*)orow)[lane + 64 * j] = w; }
}

#define XB_TMO      128
#define XB_XCNT(j)  (256  + 64 * (j))
#define XB_XSUB(j)  (1280 + 64 * (j))
#define XB_XGEN(j)  (2304 + 64 * (j))
#define XB_TOP      3328
#define XB_TOPGEN   3392
#define XCD_BAR_WORDS 3456
#define XB_SPIN_CAP (1u << 18)

__device__ __forceinline__ unsigned xb_ld(unsigned* p)              { return __hip_atomic_load(p, __ATOMIC_RELAXED, __HIP_MEMORY_SCOPE_AGENT); }
__device__ __forceinline__ unsigned xb_add(unsigned* p, unsigned v) { return __hip_atomic_fetch_add(p, v, __ATOMIC_RELAXED, __HIP_MEMORY_SCOPE_AGENT); }
__device__ __forceinline__ unsigned xb_xcc_id() { return (unsigned)__builtin_amdgcn_s_getreg((3 << 11) | 20) & 0xFu; }
#define XB_SPIN(cond, bar) do { unsigned _sp = 0; while (cond) { __builtin_amdgcn_s_sleep(1); \
    if ((++_sp & 255u) == 0u) { if (xb_ld(&(bar)[XB_TMO])) break; if (_sp > XB_SPIN_CAP) { atomicAdd(&(bar)[XB_TMO], 1u); break; } } } } while (0)

struct XcdBarrier {
    unsigned* bar; unsigned x;
    volatile LAS unsigned* st;
};

__device__ __forceinline__ XcdBarrier xcd_barrier_post(unsigned* bar, volatile LAS unsigned* st) {
    XcdBarrier b; b.bar = bar; b.x = xb_xcc_id(); b.st = st;
    if (threadIdx.x == 0) (void)xb_add(&bar[XB_XCNT(b.x)], 1u);
    return b;
}
__device__ __forceinline__ void xcd_barrier_complete(unsigned* bar, unsigned x, unsigned& nloc, unsigned& nx) {
    const unsigned G = gridDim.x * gridDim.y * gridDim.z;
    unsigned sum, cnt, mine, sp = 0u;
    for (;;) {
        sum = 0u; cnt = 0u; mine = 0u;
#pragma unroll
        for (unsigned j = 0; j < 16; ++j) { const unsigned c = xb_ld(&bar[XB_XCNT(j)]); sum += c; cnt += (c > 0u) ? 1u : 0u; mine = (j == x) ? c : mine; }
        if (sum == G) break;
        __builtin_amdgcn_s_sleep(1);
        if ((++sp & 255u) == 0u) { if (xb_ld(&bar[XB_TMO])) break; if (sp > XB_SPIN_CAP) { atomicAdd(&bar[XB_TMO], 1u); break; } }
    }
    nloc = mine > 0u ? mine : 1u; nx = cnt > 0u ? cnt : 1u;
}

__device__ __forceinline__ void xcd_barrier(const XcdBarrier& b) {
    asm volatile("s_waitcnt vmcnt(0)" ::: "memory");
    __syncthreads();
    if (threadIdx.x == 0) {
        unsigned* bar = b.bar;
        __builtin_amdgcn_s_waitcnt(0);
        unsigned nloc = b.st[0], nx = b.st[1];
        if (nloc == 0u) { xcd_barrier_complete(bar, b.x, nloc, nx); b.st[0] = nloc; b.st[1] = nx; }
        const unsigned old = xb_add(&bar[XB_XSUB(b.x)], 1u);
        const unsigned gen = old / nloc;
        if (old + 1u == (gen + 1u) * nloc) {
            __builtin_amdgcn_fence(__ATOMIC_RELEASE, "agent");
            asm volatile("s_waitcnt vmcnt(0)" ::: "memory");
            const unsigned og = xb_add(&bar[XB_TOP], 1u);
            const unsigned tg = og / nx;
            if (og + 1u == (tg + 1u) * nx) xb_add(&bar[XB_TOPGEN], 1u);
            else XB_SPIN(xb_ld(&bar[XB_TOPGEN]) == tg, bar);
            __builtin_amdgcn_fence(__ATOMIC_ACQUIRE, "agent");
            xb_add(&bar[XB_XGEN(b.x)], 1u);
            asm volatile("s_waitcnt vmcnt(0)" ::: "memory");
        } else {
            XB_SPIN(xb_ld(&bar[XB_XGEN(b.x)]) == gen, bar);
            __builtin_amdgcn_fence(__ATOMIC_ACQUIRE, "agent");
            asm volatile("s_waitcnt vmcnt(0)" ::: "memory");
        }
    }
    __syncthreads();
}

struct Args { const float* in[N_IN]; float* out; unsigned char* ws; int ph_lo, ph_hi, li, pad; };

__device__ __forceinline__ void p_mods(const Args& a, LAS unsigned char* lds, int tid, int lane, int wave) {
    LAS float* sc = (LAS float*)lds;
    LAS float* part = sc + 3 * D;
    float* MODS = (float*)(a.ws + WS_MODS);
    for (int i = tid; i < 3 * D; i += NTHR) { const int r = i >> 10, k = i & 1023; const float v = r < 2 ? a.in[I_C][r * D + k] : a.in[I_CCTX][k]; sc[i] = v * fsig(v); }
    __syncthreads();
    for (int item = blockIdx.x; item < 2 * 96; item += gridDim.x) {
        const int l = item / 96, cb = item % 96;
        const float* W = a.in[I_WADA] + (size_t)l * D * 6 * D + cb * 64 + lane;
        float a0 = 0.f, a1 = 0.f, a2 = 0.f;
#pragma unroll 16
        for (int kk = 0; kk < 128; ++kk) { const int k = wave * 128 + kk; const float w = W[(size_t)k * (6 * D)]; a0 += sc[k] * w; a1 += sc[D + k] * w; a2 += sc[2 * D + k] * w; }
        part[(wave * 3 + 0) * 64 + lane] = a0; part[(wave * 3 + 1) * 64 + lane] = a1; part[(wave * 3 + 2) * 64 + lane] = a2;
        __syncthreads();
        if (tid < 192) { const int r = tid >> 6, ln = tid & 63; float s = 0.f;
#pragma unroll
            for (int w = 0; w < 8; ++w) s += part[(w * 3 + r) * 64 + ln];
            __hip_atomic_store(&MODS[(size_t)(l * 3 + r) * (6 * D) + cb * 64 + ln], s + a.in[I_BADA][l * 6 * D + cb * 64 + ln], __ATOMIC_RELAXED, __HIP_MEMORY_SCOPE_AGENT); }
        asm volatile("s_waitcnt vmcnt(0)" ::: "memory");
        __syncthreads();
        if (item < 32 && tid == 0) (void)__hip_atomic_fetch_add((unsigned*)(a.ws + WS_CTL) + CW_MODF, 1u, __ATOMIC_RELAXED, __HIP_MEMORY_SCOPE_AGENT);
    }
}
__device__ __forceinline__ void wait_mods0(const Args& a, int tid) {
    if (tid == 0) { unsigned* f = (unsigned*)(a.ws + WS_CTL) + CW_MODF; unsigned sp = 0;
        while (__hip_atomic_load(f, __ATOMIC_RELAXED, __HIP_MEMORY_SCOPE_AGENT) < 32u) { __builtin_amdgcn_s_sleep(2); if (++sp > (1u << 22)) break; }
        __builtin_amdgcn_fence(__ATOMIC_ACQUIRE, "agent");
        asm volatile("s_waitcnt vmcnt(0)" ::: "memory"); }
    __syncthreads();
}
template <bool OUT8> __device__ __forceinline__ void transpose_item(const float* W, int K, int N, bf16* WT, bool paired, LAS float* scr, int item, int lane, int row_adj = 0) {
    const int nblk = N / 32, kb = item / nblk, nb = item % nblk, k0 = 64 * kb, n0 = 32 * nb;
    int d0 = n0 + row_adj; if (paired) { const int half = n0 >> 10, c = n0 & 1023; d0 = (c >> 7) * 256 + half * 128 + (c & 127); }
    float t[32];
#pragma unroll
    for (int i = 0; i < 32; ++i) { const int kk = 2 * i + (lane >> 5); t[i] = __builtin_nontemporal_load(&W[(size_t)(k0 + kk) * N + n0 + (lane & 31)]); }
#pragma unroll
    for (int i = 0; i < 32; ++i) { const int kk = 2 * i + (lane >> 5); scr[kk * 33 + (lane & 31)] = t[i]; }
    LDS_WAIT(); asm volatile("" ::: "memory");
    const int c = lane & 7;
#pragma unroll
    for (int j = 0; j < 4; ++j) { const int n = (lane >> 3) + 8 * j; const LAS float* s = scr + (8 * c) * 33 + n;
        if constexpr (OUT8) {
            int w0 = 0, w1 = 0;
            w0 = __builtin_amdgcn_cvt_pk_fp8_f32(s[0 * 33] * W8SCALE, s[1 * 33] * W8SCALE, w0, false); w0 = __builtin_amdgcn_cvt_pk_fp8_f32(s[2 * 33] * W8SCALE, s[3 * 33] * W8SCALE, w0, true);
            w1 = __builtin_amdgcn_cvt_pk_fp8_f32(s[4 * 33] * W8SCALE, s[5 * 33] * W8SCALE, w1, false); w1 = __builtin_amdgcn_cvt_pk_fp8_f32(s[6 * 33] * W8SCALE, s[7 * 33] * W8SCALE, w1, true);
            *(v2u*)((unsigned char*)WT + (size_t)(d0 + n) * K + k0 + 8 * c) = (v2u){(unsigned)w0, (unsigned)w1};
        } else {
        v4u o; o.x = pk2(s[0 * 33], s[1 * 33]); o.y = pk2(s[2 * 33], s[3 * 33]); o.z = pk2(s[4 * 33], s[5 * 33]); o.w = pk2(s[6 * 33], s[7 * 33]);
        *(v4u*)(WT + (size_t)(d0 + n) * K + k0 + 8 * c) = o; } }
    LDS_WAIT(); asm volatile("" ::: "memory");
}
__device__ __forceinline__ void p_weights(const Args& a, LAS unsigned char* lds, int lane, int wave) {
    LAS float* scr = (LAS float*)(lds + RING_OFF + wave * 16384);
    const int gw = blockIdx.x * NWAVES + wave, NGW = gridDim.x * NWAVES;
    constexpr int I_IN = 16 * 160, I_SQ = 16 * 32, I_CV = 16 * 64, I_E1 = 64 * 1024, I_E2 = 64 * 512;
    constexpr int NITEMS = I_IN + I_SQ + I_CV + I_SQ + I_E1 + I_E2;
    unsigned char* ws = a.ws;
    for (int it = (gridDim.x == 256 ? I_E1 + I_E2 : 0) + gw; it < NITEMS; it += NGW) {
        int r = it;
        if (r < I_E1) { const int mi = r >> 10; transpose_item<true>(a.in[I_WE1] + (size_t)mi * D * 2 * D, D, 2 * D, (bf16*)(ws + WS_W1 + (size_t)mi * 2 * D * D), true, scr, r & 1023, lane); continue; } r -= I_E1;
        if (r < I_E2) { const int mi = r >> 9; transpose_item<true>(a.in[I_WE2] + (size_t)mi * D * D, D, D, (bf16*)(ws + WS_W2 + (size_t)mi * D * D), false, scr, r & 511, lane); continue; } r -= I_E2;
        if (r < I_IN) {
            if (SPLIT_IN) { const int sgm = ((r % 160) * 32) >> 10;
                if (sgm == 2 || sgm == 3) transpose_item<true>(a.in[I_WHIN], D, 5 * D, (bf16*)(ws + WS_WIN8), false, scr, r, lane, -2 * D);
                else transpose_item<false>(a.in[I_WHIN], D, 5 * D, (bf16*)(ws + WS_WIN), false, scr, r, lane, sgm == 4 ? -2 * D : 0);
            } else transpose_item<F8_IN != 0>(a.in[I_WHIN], D, 5 * D, (bf16*)(ws + WS_WIN), false, scr, r, lane);
            continue; } r -= I_IN;
        if (r < I_SQ) { transpose_item<F8_MISC != 0>(a.in[I_WHOUT], D, D, (bf16*)(ws + WS_WOUT), false, scr, r, lane); continue; } r -= I_SQ;
        if (r < I_CV) { transpose_item<F8_MISC != 0>(a.in[I_WCVIN], D, 2 * D, (bf16*)(ws + WS_WCVIN), true, scr, r, lane); continue; } r -= I_CV;
        transpose_item<F8_MISC != 0>(a.in[I_WCVOUT], D, D, (bf16*)(ws + WS_WCVOUT), false, scr, r, lane);
    }
}
constexpr int CV_WAVES = 7, CV_L0 = 32 * 512 + 32 * 256, CV_ALL = 2 * CV_L0;
__device__ __forceinline__ void transpose_item64(const float* W, int K, int N, unsigned char* WT, bool paired, LAS float* scr, int item, int lane) {
    const int nblk = N / 64, kb = item / nblk, nb = item % nblk, k0 = 64 * kb, n0 = 64 * nb;
    int d0 = n0; if (paired) { const int half = n0 >> 10, c = n0 & 1023; d0 = (c >> 7) * 256 + half * 128 + (c & 127); }
    float t[64];
#pragma unroll
    for (int i = 0; i < 64; ++i) t[i] = __builtin_nontemporal_load(&W[(size_t)(k0 + i) * N + n0 + lane]);
#pragma unroll
    for (int i = 0; i < 64; ++i) scr[i * 65 + lane] = t[i];
    LDS_WAIT(); asm volatile("" ::: "memory");
    const int c = lane & 3;
#pragma unroll
    for (int j = 0; j < 4; ++j) { const int n = (lane >> 2) + 16 * j; const LAS float* s = scr + (16 * c) * 65 + n;
        v4u o;
        o.x = pk4_fp8(s[0 * 65] * W8SCALE, s[1 * 65] * W8SCALE, s[2 * 65] * W8SCALE, s[3 * 65] * W8SCALE); o.y = pk4_fp8(s[4 * 65] * W8SCALE, s[5 * 65] * W8SCALE, s[6 * 65] * W8SCALE, s[7 * 65] * W8SCALE);
        o.z = pk4_fp8(s[8 * 65] * W8SCALE, s[9 * 65] * W8SCALE, s[10 * 65] * W8SCALE, s[11 * 65] * W8SCALE); o.w = pk4_fp8(s[12 * 65] * W8SCALE, s[13 * 65] * W8SCALE, s[14 * 65] * W8SCALE, s[15 * 65] * W8SCALE);
        *(v4u*)(WT + (size_t)(d0 + n) * K + k0 + 16 * c) = o; }
    LDS_WAIT(); asm volatile("" ::: "memory");
}
__device__ __forceinline__ void cv_do_item(const Args& a, LAS float* scr, int g, int lane) {
    const int l = g >= CV_L0 ? 1 : 0; const int r = g - l * CV_L0;
    if (r < 32 * 512) { const int mi = l * 32 + (r >> 9); transpose_item64(a.in[I_WE1] + (size_t)mi * D * 2 * D, D, 2 * D, a.ws + WS_W1 + (size_t)mi * 2 * D * D, true, scr, r & 511, lane); }
    else { const int r2 = r - 32 * 512; const int mi = l * 32 + (r2 >> 8); transpose_item64(a.in[I_WE2] + (size_t)mi * D * D, D, D, a.ws + WS_W2 + (size_t)mi * D * D, false, scr, r2 & 255, lane); }
}
__device__ __forceinline__ void cv_finish(const Args& a, LAS unsigned char* lds, int wave, int lane, int& cv_n, int limit) {
    if (gridDim.x == 256 && wave >= 1 && wave <= CV_WAVES) {
        const int ww = blockIdx.x * CV_WAVES + (wave - 1), NW = 256 * CV_WAVES; LAS float* scr = (LAS float*)(lds + RING_OFF + wave * 16640);
        for (;;) { const int g = cv_n * NW + ww; if (g >= limit) break; cv_do_item(a, scr, g, lane); ++cv_n; }
    }
}
__device__ __forceinline__ void xcd_barrier_work(const XcdBarrier& b, const Args& a, LAS unsigned char* lds, int wave, int lane, int& cv_n, volatile LAS unsigned* flag, unsigned seq) {
    asm volatile("s_waitcnt vmcnt(0)" ::: "memory");
    __syncthreads();
    if (wave == 0) {
        if (threadIdx.x == 0) {
            unsigned* bar = b.bar;
            __builtin_amdgcn_s_waitcnt(0);
            unsigned nloc = b.st[0], nx = b.st[1];
            if (nloc == 0u) { xcd_barrier_complete(bar, b.x, nloc, nx); b.st[0] = nloc; b.st[1] = nx; }
            const unsigned old = xb_add(&bar[XB_XSUB(b.x)], 1u);
            const unsigned gen = old / nloc;
            if (old + 1u == (gen + 1u) * nloc) {
                __builtin_amdgcn_fence(__ATOMIC_RELEASE, "agent");
                asm volatile("s_waitcnt vmcnt(0)" ::: "memory");
                const unsigned og = xb_add(&bar[XB_TOP], 1u);
                const unsigned tg = og / nx;
                if (og + 1u == (tg + 1u) * nx) xb_add(&bar[XB_TOPGEN], 1u);
                else XB_SPIN(xb_ld(&bar[XB_TOPGEN]) == tg, bar);
                __builtin_amdgcn_fence(__ATOMIC_ACQUIRE, "agent");
                xb_add(&bar[XB_XGEN(b.x)], 1u);
                asm volatile("s_waitcnt vmcnt(0)" ::: "memory");
            } else {
                XB_SPIN(xb_ld(&bar[XB_XGEN(b.x)]) == gen, bar);
                __builtin_amdgcn_fence(__ATOMIC_ACQUIRE, "agent");
                asm volatile("s_waitcnt vmcnt(0)" ::: "memory");
            }
            flag[0] = seq;
        }
    } else if (gridDim.x == 256 && wave <= CV_WAVES) {
        const int ww = blockIdx.x * CV_WAVES + (wave - 1), NW = 256 * CV_WAVES; LAS float* scr = (LAS float*)(lds + RING_OFF + wave * 16640);
        for (;;) { const int g = cv_n * NW + ww; if (g >= CV_ALL) break; if (flag[0] == seq) break; cv_do_item(a, scr, g, lane); ++cv_n; }
        asm volatile("s_waitcnt vmcnt(0)" ::: "memory");
    }
    __syncthreads();
}
__device__ __forceinline__ void flat_barrier_work(unsigned* cnt, const Args& a, LAS unsigned char* lds, int wave, int lane, int& cv_n, volatile LAS unsigned* flag, unsigned seq) {
    asm volatile("s_waitcnt vmcnt(0)" ::: "memory");
    __syncthreads();
    if (wave == 0) {
        if (threadIdx.x == 0) {
            __builtin_amdgcn_s_waitcnt(0);
            __builtin_amdgcn_fence(__ATOMIC_RELEASE, "agent");
            asm volatile("s_waitcnt vmcnt(0)" ::: "memory");
            (void)__hip_atomic_fetch_add(cnt, 1u, __ATOMIC_RELAXED, __HIP_MEMORY_SCOPE_AGENT);
            const unsigned target = gridDim.x * seq; unsigned sp = 0;
            while (__hip_atomic_load(cnt, __ATOMIC_RELAXED, __HIP_MEMORY_SCOPE_AGENT) < target) { __builtin_amdgcn_s_sleep(1); if (++sp > (1u << 22)) break; }
            __builtin_amdgcn_fence(__ATOMIC_ACQUIRE, "agent");
            asm volatile("s_waitcnt vmcnt(0)" ::: "memory");
            flag[0] = seq;
        }
    } else if (gridDim.x == 256 && wave <= CV_WAVES) {
        const int ww = blockIdx.x * CV_WAVES + (wave - 1), NW = 256 * CV_WAVES; LAS float* scr = (LAS float*)(lds + RING_OFF + wave * 16640);
        for (;;) { const int g = cv_n * NW + ww; if (g >= CV_ALL) break; if (flag[0] == seq) break; cv_do_item(a, scr, g, lane); ++cv_n; }
        asm volatile("s_waitcnt vmcnt(0)" ::: "memory");
    }
    __syncthreads();
}
template <bool OUT8> __device__ __forceinline__ void norm_mod_store(f32x4 (&v)[4], const float* g, const float* sc, const float* sh, void* orow, int lane) {
    float s = 0.f;
#pragma unroll
    for (int j = 0; j < 4; ++j) s += (v[j].x * v[j].x + v[j].y * v[j].y) + (v[j].z * v[j].z + v[j].w * v[j].w);
    const float r = 1.0f / sqrtf(wave_sum(s) * (1.0f / D) + EPS);
#pragma unroll
    for (int j = 0; j < 4; ++j) { const f32x4 gg = ((const f32x4*)g)[lane + 64 * j], ss = ((const f32x4*)sc)[lane + 64 * j], hh = ((const f32x4*)sh)[lane + 64 * j];
        const f32x4 y = (v[j] * r * gg) * (ss + 1.0f) + hh; v[j] = y;
        store_row4<OUT8>(orow, lane, j, y, 1.0f); }
}
__device__ __forceinline__ void p_norm0(const Args& a, int lane, int gw, int NGW, int m_begin, int m_end) {
    const float* MODS = (const float*)(a.ws + WS_MODS); bf16* H = (bf16*)(a.ws + WS_H);
    for (int m0 = m_begin + gw * 2; m0 < m_end; m0 += NGW * 2) {
        f32x4 v[2][4]; int rr[2];
#pragma unroll
        for (int r = 0; r < 2; ++r) { const int m = m0 + r; const float* xr;
            if (m < NTOK) { xr = a.in[I_X] + (size_t)m * D; rr[r] = m / SEQ; } else { xr = a.in[I_CTX] + (size_t)(m - NTOK) * D; rr[r] = 2; }
#pragma unroll
            for (int j = 0; j < 4; ++j) v[r][j] = __builtin_nontemporal_load(&((const f32x4*)xr)[lane + 64 * j]); }
#pragma unroll
        for (int r = 0; r < 2; ++r) { const float* md = MODS + (size_t)rr[r] * 6 * D;
            norm_mod_store<F8_IN != 0>(v[r], a.in[I_GMIX], md + 1 * D, md + 0 * D, (unsigned char*)H + (size_t)(m0 + r) * D * (F8_IN ? 1 : 2), lane);
            if (SPLIT_IN) {
#pragma unroll
                for (int j = 0; j < 4; ++j) store_row4<true>(a.ws + WS_H8 + (size_t)(m0 + r) * D, lane, j, v[r][j], 1.0f); } }
    }
}
__device__ __forceinline__ void p_scan_naive(const Args& a, LAS unsigned char* lds, int tid) {
    LAS float* sf = (LAS float*)lds;
    LAS float* sq = sf + 64 * 128;
    LAS float* sv = sq + 64 * 128;
    LAS float* so = sv + 64 * 16;
    const bf16* Q = (const bf16*)(a.ws + WS_Q); const bf16* V = (const bf16*)(a.ws + WS_V);
    const int vl = tid >> 5, kq = tid & 31;
    for (int unit = blockIdx.x; unit < 256; unit += gridDim.x) {
        const int chain = unit >> 3, vb = unit & 7, b = chain >> 4, h = (chain >> 1) & 7, dir = chain & 1;
        const float* LF = (const float*)(a.ws + (dir ? WS_LFB : WS_LFF)); float* O = (float*)(a.ws + (dir ? WS_OB : WS_OF));
        float S0 = 0.f, S1 = 0.f, S2 = 0.f, S3 = 0.f;
        for (int blk = 0; blk < 260; ++blk) {
            const bool isctx = blk < 4; int base, step;
            if (!dir) { base = isctx ? (NTOK + b * CTXL + blk * 64) : (b * SEQ + (blk - 4) * 64); step = 1; }
            else { base = isctx ? (NTOK + b * CTXL + CTXL - 1 - blk * 64) : (b * SEQ + SEQ - 1 - (blk - 4) * 64); step = -1; }
            for (int e = tid; e < 64 * 128; e += NTHR) { const int i = e >> 7, k = e & 127; const size_t off = (size_t)(base + step * i) * D + h * DK + k; sf[e] = __expf(LF[off]); sq[e] = bf2f(Q[off]); }
            for (int e = tid; e < 64 * 16; e += NTHR) { const int i = e >> 4, vv = e & 15; sv[e] = bf2f(V[(size_t)(base + step * i) * D + h * DK + vb * 16 + vv]); }
            __syncthreads();
            for (int i = 0; i < 64; ++i) {
                const f32x4 f = *(const LAS f32x4*)(sf + i * 128 + kq * 4), q = *(const LAS f32x4*)(sq + i * 128 + kq * 4); const float vv = sv[i * 16 + vl];
                S0 = f.x * S0 + (1.0f - f.x) * vv; S1 = f.y * S1 + (1.0f - f.y) * vv; S2 = f.z * S2 + (1.0f - f.z) * vv; S3 = f.w * S3 + (1.0f - f.w) * vv;
                float p = (S0 * q.x + S1 * q.y) + (S2 * q.z + S3 * q.w);
                p += __shfl_xor(p, 1); p += __shfl_xor(p, 2); p += __shfl_xor(p, 4); p += __shfl_xor(p, 8); p += __shfl_xor(p, 16);
                if (kq == 0) so[i * 16 + vl] = p;
            }
            __syncthreads();
            if (!isctx) for (int e = tid; e < 64 * 16; e += NTHR) { const int i = e >> 4, vv = e & 15; O[(size_t)(base + step * i) * D + h * DK + vb * 16 + vv] = so[e]; }
            __syncthreads();
        }
    }
}
constexpr int SC_QT = 0, SC_KU = 4352, SC_KB = 8704, SC_VT = 12800, SC_ET = 16896, SC_SUB = 17408, SC_BUF = 4 * SC_SUB;
constexpr int NSLOT = 17;
typedef short s16x4 __attribute__((ext_vector_type(4)));
typedef short s16x8 __attribute__((ext_vector_type(8)));
struct ScanUnit { int h, rowbase, sgn, nchunks, chain, slot; };
__device__ __forceinline__ ScanUnit scan_unit(int b, int h, int dir, int slot) {
    ScanUnit u; u.h = h; u.sgn = dir ? -1 : 1; u.chain = (b * NHEAD + h) * 2 + dir; u.slot = slot;
    if (slot == 0) { u.rowbase = NTOK + b * CTXL + (dir ? CTXL - 1 : 0); u.nchunks = CTXL / 64; }
    else { const int so = (slot - 1) * 1024; u.rowbase = b * SEQ + (dir ? SEQ - 1 - so : so); u.nchunks = 16; }
    return u;
}
typedef float f32x2_t __attribute__((ext_vector_type(2)));
typedef __bf16 bf16x2_t __attribute__((ext_vector_type(2)));
__device__ __forceinline__ unsigned cvtpk(float lo, float hi) { const f32x2_t f = {lo, hi}; return __builtin_bit_cast(unsigned, __builtin_convertvector(f, bf16x2_t)); }
template <bool FULL> __device__ __forceinline__ void scan_load(const ScanUnit& u, int pos0, const bf16* LF, const bf16* Q, const bf16* V, int k, int i, unsigned (&lf)[16], unsigned (&qr)[16], unsigned (&vr)[16]) {
#pragma unroll
    for (int t = 0; t < 16; ++t) {
        const unsigned o = (unsigned)(u.rowbase + u.sgn * (pos0 + 16 * i + t)) * D + u.h * DK + k;
        lf[t] = LF[o]; vr[t] = V[o]; if (FULL) qr[t] = Q[o];
    }
}
template <bool FULL> __device__ __forceinline__ float scan_prep(LAS unsigned char* buf, int k, int i, const unsigned (&lfr)[16], const unsigned (&qr)[16], const unsigned (&vr)[16]) {
    LAS unsigned char* sb = buf + i * SC_SUB;
    float f[16], pre[16], suf[16]; float T = 0.f;
#pragma unroll
    for (int t = 0; t < 16; ++t) { const float lf = (float)__builtin_bit_cast(_Float16, (unsigned short)lfr[t]); T += lf; f[t] = __builtin_amdgcn_exp2f(lf * 1.4426950408889634f); }
    pre[0] = f[0];
#pragma unroll
    for (int t = 1; t < 16; ++t) pre[t] = pre[t - 1] * f[t];
    suf[15] = 1.0f;
#pragma unroll
    for (int t = 14; t >= 0; --t) suf[t] = suf[t + 1] * f[t + 1];
    unsigned kbw[8], vtw[8];
#pragma unroll
    for (int t = 0; t < 16; t += 2) {
        const float kk0 = 1.0f - f[t], kk1 = 1.0f - f[t + 1];
        kbw[t >> 1] = cvtpk(kk0 * suf[t], kk1 * suf[t + 1]);
        vtw[t >> 1] = vr[t] | (vr[t + 1] << 16);
        if (FULL) {
            const unsigned qq = cvtpk(__builtin_bit_cast(float, qr[t] << 16) * pre[t], __builtin_bit_cast(float, qr[t + 1] << 16) * pre[t + 1]);
            const unsigned ku = cvtpk(kk0 * __builtin_amdgcn_rcpf(fmaxf(pre[t], 1e-30f)), kk1 * __builtin_amdgcn_rcpf(fmaxf(pre[t + 1], 1e-30f)));
            *(LAS bf16*)(sb + SC_QT + t * 272 + 2 * k) = (bf16)(qq & 0xffffu); *(LAS bf16*)(sb + SC_QT + (t + 1) * 272 + 2 * k) = (bf16)(qq >> 16);
            *(LAS bf16*)(sb + SC_KU + t * 272 + 2 * k) = (bf16)(ku & 0xffffu); *(LAS bf16*)(sb + SC_KU + (t + 1) * 272 + 2 * k) = (bf16)(ku >> 16);
        }
    }
    *(LAS v4u*)(sb + SC_KB + k * 32) = (v4u){kbw[0], kbw[1], kbw[2], kbw[3]}; *(LAS v4u*)(sb + SC_KB + k * 32 + 16) = (v4u){kbw[4], kbw[5], kbw[6], kbw[7]};
    *(LAS v4u*)(sb + SC_VT + k * 32) = (v4u){vtw[0], vtw[1], vtw[2], vtw[3]}; *(LAS v4u*)(sb + SC_VT + k * 32 + 16) = (v4u){vtw[4], vtw[5], vtw[6], vtw[7]};
    *(LAS float*)(sb + SC_ET + 4 * k) = pre[15];
    return T;
}
__device__ __forceinline__ f32x4 mfma_k16(s16x4 a, s16x4 b, f32x4 c) {
    const v2u av = __builtin_bit_cast(v2u, a), bv = __builtin_bit_cast(v2u, b);
    return __builtin_amdgcn_mfma_f32_16x16x32_bf16(__builtin_bit_cast(s16x8, (v4u){av.x, av.y, 0u, 0u}), __builtin_bit_cast(s16x8, (v4u){bv.x, bv.y, 0u, 0u}), c, 0, 0, 0);
}
template <bool FULL> __device__ __forceinline__ void scan_compute2(const LAS unsigned char* buf, int wq, int lane, f32x4 (&S)[2][8], bf16* Ocol, const ScanUnit& u, int pos0) {
    const int fr = lane & 15, g = lane >> 4;
#pragma unroll 1
    for (int i = 0; i < 2; ++i) {
        const LAS unsigned char* sb = buf + i * SC_SUB;
        const s16x4 vt0 = *(const LAS s16x4*)(sb + SC_VT + (32 * wq + fr) * 32 + 8 * g), vt1 = *(const LAS s16x4*)(sb + SC_VT + (32 * wq + 16 + fr) * 32 + 8 * g);
        s16x8 ka[4], qa[4]; f32x4 et[8]; s16x4 kb[8];
        if (FULL) {
#pragma unroll
            for (int c = 0; c < 4; ++c) { ka[c] = *(const LAS s16x8*)(sb + SC_KU + fr * 272 + (32 * c + 8 * g) * 2); qa[c] = *(const LAS s16x8*)(sb + SC_QT + fr * 272 + (32 * c + 8 * g) * 2); }
        }
#pragma unroll
        for (int j = 0; j < 8; ++j) { et[j] = *(const LAS f32x4*)(sb + SC_ET + (32 * (j >> 1) + 8 * g + 4 * (j & 1)) * 4); kb[j] = *(const LAS s16x4*)(sb + SC_KB + (32 * (j >> 1) + 8 * (fr >> 2) + 4 * (j & 1) + (fr & 3)) * 32 + 8 * g); }
        __builtin_amdgcn_sched_barrier(0);
        if (FULL) {
            f32x4 aT = (f32x4){0.f, 0.f, 0.f, 0.f};
#pragma unroll
            for (int c = 0; c < 4; ++c) aT = __builtin_amdgcn_mfma_f32_16x16x32_bf16(ka[c], qa[c], aT, 0, 0, 0);
#pragma unroll
            for (int r = 0; r < 4; ++r) if (4 * g + r > fr) aT[r] = 0.f;
            const s16x4 ab = __builtin_bit_cast(s16x4, (v2u){cvtpk(aT[0], aT[1]), cvtpk(aT[2], aT[3])});
            f32x4 o0 = mfma_k16(vt0, ab, (f32x4){0.f, 0.f, 0.f, 0.f}), o1 = mfma_k16(vt1, ab, (f32x4){0.f, 0.f, 0.f, 0.f});
#pragma unroll
            for (int c = 0; c < 4; ++c) {
                const v4u s0 = (v4u){cvtpk(S[0][2 * c][0], S[0][2 * c][1]), cvtpk(S[0][2 * c][2], S[0][2 * c][3]), cvtpk(S[0][2 * c + 1][0], S[0][2 * c + 1][1]), cvtpk(S[0][2 * c + 1][2], S[0][2 * c + 1][3])};
                const v4u s1 = (v4u){cvtpk(S[1][2 * c][0], S[1][2 * c][1]), cvtpk(S[1][2 * c][2], S[1][2 * c][3]), cvtpk(S[1][2 * c + 1][0], S[1][2 * c + 1][1]), cvtpk(S[1][2 * c + 1][2], S[1][2 * c + 1][3])};
                o0 = __builtin_amdgcn_mfma_f32_16x16x32_bf16(__builtin_bit_cast(s16x8, s0), qa[c], o0, 0, 0, 0);
                o1 = __builtin_amdgcn_mfma_f32_16x16x32_bf16(__builtin_bit_cast(s16x8, s1), qa[c], o1, 0, 0, 0);
            }
            bf16* orow = Ocol + (size_t)(u.rowbase + u.sgn * (pos0 + 16 * i + fr)) * D;
            *(v2u*)orow = (v2u){cvtpk(o0[0], o0[1]), cvtpk(o0[2], o0[3])}; *(v2u*)(orow + 16) = (v2u){cvtpk(o1[0], o1[1]), cvtpk(o1[2], o1[3])};
        }
#pragma unroll
        for (int j = 0; j < 8; ++j) { S[0][j] = mfma_k16(kb[j], vt0, S[0][j] * et[j]); S[1][j] = mfma_k16(kb[j], vt1, S[1][j] * et[j]); }
    }
}
template <bool FULL> __device__ __forceinline__ void scan_pair(const Args& a, LAS unsigned char* lds, const ScanUnit& uA, const ScanUnit& uB, int tid, int lane, int wave) {
    const int grp = wave >> 2, wq = wave & 3, t = tid & 255, k = t & 127, i0 = t >> 7;
    ScanUnit u; u.h = grp ? uB.h : uA.h; u.rowbase = grp ? uB.rowbase : uA.rowbase; u.sgn = grp ? uB.sgn : uA.sgn; u.nchunks = grp ? uB.nchunks : uA.nchunks; u.chain = grp ? uB.chain : uA.chain; u.slot = grp ? uB.slot : uA.slot;
    LAS unsigned char* buf = lds + grp * SC_BUF;
    const int dir = u.sgn < 0;
    const bf16* LF = (const bf16*)(a.ws + (dir ? WS_LFB : WS_LFF)); const bf16* Q = (const bf16*)(a.ws + WS_Q); const bf16* V = (const bf16*)(a.ws + WS_V);
    f32x4* SD = (f32x4*)(a.ws + WS_SD) + (size_t)u.chain * NSLOT * 4096; float* SP = (float*)(a.ws + WS_SP) + (size_t)u.chain * NSLOT * DK;
    const int g = lane >> 4;
    bf16* Ocol = (bf16*)(a.ws + (dir ? WS_OB : WS_OF)) + u.h * DK + 32 * wq + 4 * g;
    f32x4 S[2][8];
#pragma unroll
    for (int vb = 0; vb < 2; ++vb)
#pragma unroll
        for (int j = 0; j < 8; ++j) S[vb][j] = (f32x4){0.f, 0.f, 0.f, 0.f};
    if (FULL) {
        for (int s = 0; s < u.slot; ++s) {
            const f32x4* d = SD + (size_t)s * 4096 + (wq * 16) * 64 + lane; const float* pp = SP + s * DK + 8 * g;
#pragma unroll
            for (int j = 0; j < 8; ++j) { const f32x4 pv = *(const f32x4*)(pp + 32 * (j >> 1) + 4 * (j & 1)); const f32x4 ev = (f32x4){__expf(pv.x), __expf(pv.y), __expf(pv.z), __expf(pv.w)};
                S[0][j] = S[0][j] * ev + d[j * 64]; S[1][j] = S[1][j] * ev + d[(8 + j) * 64]; }
        }
    }
    unsigned lf[16], q[16], v[16]; float psum = 0.f;
    const int nsteps = u.nchunks * 2;
    scan_load<FULL>(u, 0, LF, Q, V, k, i0, lf, q, v);
    constexpr int NST = 32;
    if (grp == 1) __syncthreads();
    for (int c = 0; c < NST; ++c) {
        if (c < nsteps) psum += scan_prep<FULL>(buf, k, i0, lf, q, v);
        __syncthreads();
        if (c < nsteps) {
            const int cn = (c + 1 < nsteps) ? c + 1 : c;
            scan_load<FULL>(u, cn * 32, LF, Q, V, k, i0, lf, q, v);
            scan_compute2<FULL>(buf, wq, lane, S, Ocol, u, c * 32);
        }
        __syncthreads();
    }
    if (grp == 0) __syncthreads();
    if (!FULL) {
        f32x4* d = SD + (size_t)u.slot * 4096 + (wq * 16) * 64 + lane;
#pragma unroll
        for (int j = 0; j < 8; ++j) { d[j * 64] = S[0][j]; d[(8 + j) * 64] = S[1][j]; }
        LAS float* ps = (LAS float*)(lds + EXTRA_OFF + 2560);
        ps[(grp * 2 + i0) * 128 + k] = psum;
        __syncthreads();
        if (t < 128) SP[u.slot * DK + t] = ps[(grp * 2) * 128 + t] + ps[(grp * 2 + 1) * 128 + t];
        __syncthreads();
    }
}
__device__ __forceinline__ void p_scan_a(const Args& a, LAS unsigned char* lds, int tid, int lane, int wave) {
    for (int it = blockIdx.x; it < 256; it += gridDim.x) {
        const int b = it >> 7, h = (it >> 4) & 7, seg = it & 15;
        const ScanUnit uA = scan_unit(b, h, 0, seg == 15 ? 0 : 1 + seg);
        const ScanUnit uB = scan_unit(b, h, 1, seg == 0 ? 0 : 16 - seg);
        scan_pair<false>(a, lds, uA, uB, tid, lane, wave);
    }
}
__device__ __forceinline__ void p_scan_c(const Args& a, LAS unsigned char* lds, int tid, int lane, int wave) {
    for (int it = blockIdx.x; it < 256; it += gridDim.x) {
        const int b = it >> 7, h = (it >> 4) & 7, seg = it & 15;
        const ScanUnit uA = scan_unit(b, h, 0, 1 + seg), uB = scan_unit(b, h, 1, 16 - seg);
        scan_pair<true>(a, lds, uA, uB, tid, lane, wave);
    }
}
__device__ __forceinline__ void p_readout(const Args& a, int lane, int wave) {
    const int gw = blockIdx.x * NWAVES + wave, NGW = gridDim.x * NWAVES;
    const bf16* OF = (const bf16*)(a.ws + WS_OF); const bf16* OB = (const bf16*)(a.ws + WS_OB); const bf16* SG = (const bf16*)(a.ws + WS_SG); bf16* Y = (bf16*)(a.ws + WS_YIN);
    for (int m0 = gw * 2; m0 < NTOK; m0 += NGW * 2) {
        f32x4 o[2][4]; v2u sg[2][4];
#pragma unroll
        for (int r = 0; r < 2; ++r)
#pragma unroll
            for (int j = 0; j < 4; ++j) { const size_t m = m0 + r; const v2u a_ = ((const v2u*)(OF + m * D))[lane + 64 * j], b_ = ((const v2u*)(OB + m * D))[lane + 64 * j];
                o[r][j] = (f32x4){bf_lo(a_.x) + bf_lo(b_.x), bf_hi(a_.x) + bf_hi(b_.x), bf_lo(a_.y) + bf_lo(b_.y), bf_hi(a_.y) + bf_hi(b_.y)}; sg[r][j] = ((const v2u*)(SG + m * D))[lane + 64 * j]; }
#pragma unroll
        for (int r = 0; r < 2; ++r)
#pragma unroll
            for (int j = 0; j < 4; ++j) { const f32x4 oo = o[r][j];
                float s = (oo.x * oo.x + oo.y * oo.y) + (oo.z * oo.z + oo.w * oo.w);
                s += __shfl_xor(s, 1); s += __shfl_xor(s, 2); s += __shfl_xor(s, 4); s += __shfl_xor(s, 8); s += __shfl_xor(s, 16);
                const float rs = 1.0f / sqrtf(s * (1.0f / DK) + EPS);
                const f32x4 gg = ((const f32x4*)a.in[I_GHOUT])[lane + 64 * j];
                store_row4<F8_MISC != 0>((unsigned char*)Y + (size_t)(m0 + r) * D * (F8_MISC ? 1 : 2), lane, j,
                    (f32x4){oo.x * rs * gg.x * bf_lo(sg[r][j].x), oo.y * rs * gg.y * bf_hi(sg[r][j].x), oo.z * rs * gg.z * bf_lo(sg[r][j].y), oo.w * rs * gg.w * bf_hi(sg[r][j].y)}, 4.0f); }
    }
}
__device__ __forceinline__ void p_router(const Args& a, LAS unsigned char* lds, int l, int tid, int lane, int wave) {
    typedef _Float16 h16x8 __attribute__((ext_vector_type(8))); typedef _Float16 h16x4 __attribute__((ext_vector_type(4)));
    constexpr int PITCH = 2064, WT_OFF = 0, TILE_OFF = 32 * PITCH, P_OFF = TILE_OFF + 16 * PITCH;
    LAS int* s_cnt = (LAS int*)(lds + EXTRA_OFF);
    LAS int* s_gb = s_cnt + 32;
    LAS int* s_sel = (LAS int*)(lds + EXTRA_OFF + 2560);
    unsigned* GCNT = (unsigned*)(a.ws + WS_CTL) + CW_GCNT + l * 32;
    const float* WR = a.in[I_WR] + (size_t)l * D * NE; const float* BR = a.in[I_BR] + l * NE;
    for (int i = tid; i < D * NE; i += NTHR) *(LAS _Float16*)(lds + WT_OFF + (i & 31) * PITCH + (i >> 5) * 2) = (_Float16)WR[i];
    const bf16* X = (const bf16*)(a.ws + WS_X); unsigned char* H = a.ws + WS_H;
    const float* MODS = (const float*)(a.ws + WS_MODS);
    int* TOPS = (int*)(a.ws + WS_TOPE); float* TOPW = (float*)(a.ws + WS_TOPW); int* STOK = (int*)(a.ws + WS_STOK);
    const int fr = lane & 15, g = lane >> 4;
    LAS float* P = (LAS float*)(lds + P_OFF);
    for (int ch = blockIdx.x; ch < NTOK / 128; ch += gridDim.x) {
        if (tid < 32) s_cnt[tid] = 0;
        const int b = (ch * 128) / SEQ; const float* md = MODS + (size_t)(l * 3 + b) * 6 * D;
        v2u nx[2][4];
#pragma unroll
        for (int t = 0; t < 2; ++t)
#pragma unroll
            for (int j = 0; j < 4; ++j) nx[t][j] = ((const v2u*)(X + (size_t)(ch * 128 + 2 * wave + t) * D))[lane + 64 * j];
        for (int it = 0; it < 8; ++it) {
            const int tok0 = ch * 128 + it * 16 + 2 * wave;
            f32x4 hf[2][4];
#pragma unroll
            for (int t = 0; t < 2; ++t)
#pragma unroll
                for (int j = 0; j < 4; ++j) hf[t][j] = (f32x4){bf_lo(nx[t][j].x), bf_hi(nx[t][j].x), bf_lo(nx[t][j].y), bf_hi(nx[t][j].y)};
            if (it + 1 < 8) {
#pragma unroll
                for (int t = 0; t < 2; ++t)
#pragma unroll
                    for (int j = 0; j < 4; ++j) nx[t][j] = ((const v2u*)(X + (size_t)(tok0 + 16 + t) * D))[lane + 64 * j];
            }
#pragma unroll
            for (int t = 0; t < 2; ++t) {
                norm_mod_store<true>(hf[t], a.in[I_GFFN] + l * D, md + 4 * D, md + 3 * D, H + (size_t)(tok0 + t) * D, lane);
#pragma unroll
                for (int j = 0; j < 4; ++j) { const h16x4 hv = {(_Float16)hf[t][j].x, (_Float16)hf[t][j].y, (_Float16)hf[t][j].z, (_Float16)hf[t][j].w};
                    *(LAS h16x4*)(lds + TILE_OFF + (2 * wave + t) * PITCH + (4 * lane + 256 * j) * 2) = hv; }
            }
            __syncthreads();
            f32x4 acc0 = (f32x4){0.f, 0.f, 0.f, 0.f}, acc1 = acc0;
#pragma unroll
            for (int c = 0; c < 4; ++c) { const int kb = (128 * wave + 32 * c + 8 * g) * 2;
                const h16x8 av = *(const LAS h16x8*)(lds + TILE_OFF + fr * PITCH + kb);
                const h16x8 b0 = *(const LAS h16x8*)(lds + WT_OFF + fr * PITCH + kb), b1 = *(const LAS h16x8*)(lds + WT_OFF + (16 + fr) * PITCH + kb);
                acc0 = __builtin_amdgcn_mfma_f32_16x16x32_f16(av, b0, acc0, 0, 0, 0); acc1 = __builtin_amdgcn_mfma_f32_16x16x32_f16(av, b1, acc1, 0, 0, 0); }
#pragma unroll
            for (int r = 0; r < 4; ++r) { P[(wave * 16 + 4 * g + r) * 32 + fr] = acc0[r]; P[(wave * 16 + 4 * g + r) * 32 + 16 + fr] = acc1[r]; }
            __syncthreads();
            const int t = lane >> 5, e0 = lane & 31;
            float v0 = BR[e0];
#pragma unroll
            for (int w = 0; w < 8; ++w) v0 += P[(w * 16 + 2 * wave + t) * 32 + e0];
            float selv[4]; int seli[4];
#pragma unroll
            for (int r = 0; r < 4; ++r) {
                float bv = v0; int bi = e0;
#pragma unroll
                for (int o = 1; o < 32; o <<= 1) { const float ov = __shfl_xor(bv, o); const int oi = __shfl_xor(bi, o); if (ov > bv || (ov == bv && oi < bi)) { bv = ov; bi = oi; } }
                selv[r] = bv; seli[r] = bi;
                if (bi == e0) v0 = -INFINITY;
            }
            if ((lane & 31) == 0) {
                const float e1 = __expf(selv[1] - selv[0]), e2 = __expf(selv[2] - selv[0]), e3 = __expf(selv[3] - selv[0]); const float inv = 1.0f / (1.0f + e1 + e2 + e3);
                *(f32x4*)(TOPW + (size_t)(tok0 + t) * 4) = (f32x4){inv, e1 * inv, e2 * inv, e3 * inv};
#pragma unroll
                for (int r = 0; r < 4; ++r) s_sel[(it * 16 + 2 * wave + t) * 4 + r] = (seli[r] << 16) | __hip_atomic_fetch_add(&s_cnt[seli[r]], 1, __ATOMIC_RELAXED, __HIP_MEMORY_SCOPE_WORKGROUP);
            }
        }
        __syncthreads();
        if (tid < 32) s_gb[tid] = (int)__hip_atomic_fetch_add(GCNT + tid, (unsigned)s_cnt[tid], __ATOMIC_RELAXED, __HIP_MEMORY_SCOPE_AGENT);
        __syncthreads();
        { const int sv = s_sel[tid], e = sv >> 16, vi = s_gb[e] + (sv & 0xffff); TOPS[(size_t)ch * 512 + tid] = e * NTOK + vi; STOK[(size_t)e * NTOK + vi] = ch * 128 + (tid >> 2); }
        __syncthreads();
    }
}
__device__ __forceinline__ void moe_tables(const Args& a, LAS unsigned char* lds, int l, int tid) {
    LAS int* s_tb = (LAS int*)(lds + EXTRA_OFF + 256); LAS int* s_ce = s_tb + 40; LAS int* tab = (LAS int*)(lds + EXTRA_OFF + 640);
    const unsigned* GCNT = (const unsigned*)(a.ws + WS_CTL) + CW_GCNT + l * 32;
    if (tid < 32) s_ce[tid] = (int)__hip_atomic_load(GCNT + tid, __ATOMIC_RELAXED, __HIP_MEMORY_SCOPE_AGENT);
    __syncthreads();
    if (tid == 0) { int run = 0; for (int e = 0; e < 32; ++e) { s_tb[e] = run; run += (s_ce[e] + 255) >> 8; } s_tb[32] = run; }
    __syncthreads();
    if (tid < 32) { const int t0 = s_tb[tid], t1 = s_tb[tid + 1]; for (int t = t0; t < t1; ++t) tab[t] = tid; }
    __syncthreads();
}
template <bool FINAL> __device__ __forceinline__ void p_combine(const Args& a, LAS unsigned char* lds, int l, int lane, int wave) {
    const int gw = blockIdx.x * NWAVES + wave, NGW = gridDim.x * NWAVES;
    bf16* X = (bf16*)(a.ws + WS_X); const bf16* YS = (const bf16*)(a.ws + WS_YS); const int* TOPS = (const int*)(a.ws + WS_TOPE); const float* TOPW = (const float*)(a.ws + WS_TOPW);
    const LAS int* s_tb = (const LAS int*)(lds + EXTRA_OFF + 256);
    const float* MODS = (const float*)(a.ws + WS_MODS); bf16* H = (bf16*)(a.ws + WS_H);
    for (int m0 = gw * 2; m0 < NTOK; m0 += NGW * 2) {
        const int b = m0 / SEQ; const float* gt = MODS + (size_t)(l * 3 + b) * 6 * D + 5 * D;
        f32x4 v[2][4]; v2u y[2][4][4]; f32x4 tw[2];
#pragma unroll
        for (int r = 0; r < 2; ++r) { v4i ps = *(const v4i*)(TOPS + (size_t)(m0 + r) * 4); tw[r] = *(const f32x4*)(TOPW + (size_t)(m0 + r) * 4);
#pragma unroll
            for (int k = 0; k < 4; ++k) { const int e = ps[k] >> 15; ps[k] = s_tb[e] * 256 + (ps[k] & (NTOK - 1)); }
#pragma unroll
            for (int j = 0; j < 4; ++j) { const v2u xx = ((const v2u*)(X + (size_t)(m0 + r) * D))[lane + 64 * j]; v[r][j] = (f32x4){bf_lo(xx.x), bf_hi(xx.x), bf_lo(xx.y), bf_hi(xx.y)};
#pragma unroll
                for (int k = 0; k < 4; ++k) {
                    if (F8_Y) { y[r][j][k].x = ((const unsigned*)((const unsigned char*)YS + (size_t)ps[k] * D))[lane + 64 * j]; y[r][j][k].y = 0u; }
                    else y[r][j][k] = ((const v2u*)(YS + (size_t)ps[k] * D))[lane + 64 * j]; } } }
#pragma unroll
        for (int r = 0; r < 2; ++r) { const int m = m0 + r;
#pragma unroll
            for (int j = 0; j < 4; ++j) { f32x4 s = (f32x4){0.f, 0.f, 0.f, 0.f};
#pragma unroll
                for (int k = 0; k < 4; ++k) {
                    if (F8_Y) { const int w = (int)y[r][j][k].x; const f32x2_t lo = __builtin_amdgcn_cvt_pk_f32_fp8(w, false), hi = __builtin_amdgcn_cvt_pk_f32_fp8(w, true);
                        s += (f32x4){lo.x, lo.y, hi.x, hi.y} * (tw[r][k] * (1.0f / YSCALE)); }
                    else s += (f32x4){bf_lo(y[r][j][k].x), bf_hi(y[r][j][k].x), bf_lo(y[r][j][k].y), bf_hi(y[r][j][k].y)} * tw[r][k]; }
                v[r][j] = v[r][j] + ((const f32x4*)gt)[lane + 64 * j] * s; }
            if (!FINAL) {
#pragma unroll
                for (int j = 0; j < 4; ++j) ((v2u*)(X + (size_t)m * D))[lane + 64 * j] = (v2u){pk2(v[r][j].x, v[r][j].y), pk2(v[r][j].z, v[r][j].w)};
                const float* md = MODS + (size_t)((l + 1) * 3 + b) * 6 * D;
                norm_mod_store<F8_MISC != 0>(v[r], a.in[I_GMIX] + (l + 1) * D, md + 1 * D, md + 0 * D, (unsigned char*)H + (size_t)m * D * (F8_MISC ? 1 : 2), lane);
            } else {
                float s = 0.f;
#pragma unroll
                for (int j = 0; j < 4; ++j) s += (v[r][j].x * v[r][j].x + v[r][j].y * v[r][j].y) + (v[r][j].z * v[r][j].z + v[r][j].w * v[r][j].w);
                const float rs = 1.0f / sqrtf(wave_sum(s) * (1.0f / D) + EPS);
#pragma unroll
                for (int j = 0; j < 4; ++j) __builtin_nontemporal_store(v[r][j] * rs * ((const f32x4*)a.in[I_GFINAL])[lane + 64 * j], &((f32x4*)(a.out + (size_t)m * D))[lane + 64 * j]);
            }
        }
    }
}
__device__ __forceinline__ void p_dwconv(const Args& a, int tid) {
    const bf16* U = (const bf16*)(a.ws + WS_U); bf16* ZP = (bf16*)(a.ws + WS_ZP);
    const float* WDW = a.in[I_WCVDW]; const float* BDW = a.in[I_BCVDW];
    const int half = tid >> 8, cp = tid & 255;
    for (int unit = blockIdx.x; unit < 2048; unit += gridDim.x) {
        const int hu = unit * 2 + half;
        int c, len, p0; size_t base, stride;
        if (hu < 2048) { c = 2 * cp; len = GRIDW; p0 = (hu & 3) * 16; base = (size_t)(hu >> 2) * GRIDW * D; stride = D; }
        else { const int v = hu - 2048; const int b = v >> 10, w = (v >> 4) & 63; c = 512 + 2 * cp; len = GRIDR; p0 = (v & 15) * 16; base = ((size_t)b * SEQ + w) * D; stride = (size_t)GRIDW * D; }
        float w0[CONVW], w1[CONVW];
#pragma unroll
        for (int j = 0; j < CONVW; ++j) { w0[j] = WDW[j * D + c]; w1[j] = WDW[j * D + c + 1]; }
        const float bb0 = BDW[c], bb1 = BDW[c + 1];
        float i0[46], i1[46];
#pragma unroll
        for (int i = 0; i < 46; ++i) { const int pp = p0 - 15 + i; unsigned u = 0u; if (pp >= 0 && pp < len) u = *(const unsigned*)(U + base + (size_t)pp * stride + c); i0[i] = bf_lo(u); i1[i] = bf_hi(u); }
#pragma unroll
        for (int i = 0; i < 16; ++i) { float a0 = bb0, a1 = bb1;
#pragma unroll
            for (int j = 0; j < CONVW; ++j) { a0 += i0[i + j] * w0[j]; a1 += i1[i + j] * w1[j]; }
            *(unsigned*)(ZP + base + (size_t)(p0 + i) * stride + c) = pk2(a0, a1); }
    }
}
__device__ __forceinline__ void p_ln_silu(const Args& a, int lane, int wave) {
    const int gw = blockIdx.x * NWAVES + wave, NGW = gridDim.x * NWAVES;
    const bf16* ZP = (const bf16*)(a.ws + WS_ZP); bf16* Z = (bf16*)(a.ws + WS_Z);
    for (int m0 = gw * 2; m0 < NTOK; m0 += NGW * 2) {
        v2u y[2][4];
#pragma unroll
        for (int r = 0; r < 2; ++r)
#pragma unroll
            for (int j = 0; j < 4; ++j) y[r][j] = ((const v2u*)(ZP + (size_t)(m0 + r) * D))[lane + 64 * j];
#pragma unroll
        for (int r = 0; r < 2; ++r) {
            f32x4 v[4]; float s = 0.f;
#pragma unroll
            for (int j = 0; j < 4; ++j) { v[j] = (f32x4){bf_lo(y[r][j].x), bf_hi(y[r][j].x), bf_lo(y[r][j].y), bf_hi(y[r][j].y)}; s += (v[j].x + v[j].y) + (v[j].z + v[j].w); }
            const float mean = wave_sum(s) * (1.0f / D); float s2 = 0.f;
#pragma unroll
            for (int j = 0; j < 4; ++j) { v[j] = v[j] - mean; s2 += (v[j].x * v[j].x + v[j].y * v[j].y) + (v[j].z * v[j].z + v[j].w * v[j].w); }
            const float rstd = 1.0f / sqrtf(wave_sum(s2) * (1.0f / D) + EPS);
#pragma unroll
            for (int j = 0; j < 4; ++j) { const f32x4 gg = ((const f32x4*)a.in[I_GCVLN])[lane + 64 * j], bb = ((const f32x4*)a.in[I_BCVLN])[lane + 64 * j];
                f32x4 yy = v[j] * rstd * gg + bb; yy.x *= fsig(yy.x); yy.y *= fsig(yy.y); yy.z *= fsig(yy.z); yy.w *= fsig(yy.w);
                store_row4<F8_MISC != 0>((unsigned char*)Z + (size_t)(m0 + r) * D * (F8_MISC ? 1 : 2), lane, j, yy, 4.0f); }
        }
    }
}


enum { PH_PRO = 0, PH_NORM0, PH_INPROJ, PH_SCANA, PH_SCANC, PH_READOUT, PH_OUTPROJ, PH_ROUTER0, PH_G1_0, PH_G2_0, PH_COMB0, PH_CVIN, PH_DWCONV, PH_LN, PH_CVOUT, PH_ROUTER1, PH_G1_1, PH_G2_1, PH_FINAL, NPH };
#ifndef REPMASK
#define REPMASK 0ull
#endif
#ifndef SCAN_NAIVE
#define SCAN_NAIVE 0
#endif
__global__ void __launch_bounds__(NTHR, 2) fwd_kernel(Args args) {
    extern __shared__ __attribute__((aligned(16))) unsigned char lds_raw[];
    LAS unsigned char* lds = (LAS unsigned char*)lds_raw;
    const int tid = threadIdx.x, lane = tid & 63, wave = __builtin_amdgcn_readfirstlane(tid >> 6);
    const int G = gridDim.x, bid = blockIdx.x;
    unsigned char* ws = args.ws;
    for (int u = tid; u < (LDS_BYTES - LDSCTL_OFF) / 4; u += NTHR) ((LAS unsigned*)(lds + LDSCTL_OFF))[u] = 0u;
    __syncthreads();
    volatile LAS unsigned* MISC = (volatile LAS unsigned*)(lds + MISC_OFF);
    XcdBarrier bar = xcd_barrier_post((unsigned*)(ws + WS_CTL) + CW_BAR + args.li * XCD_BAR_WORDS, MISC + 8);
    const int lo = args.ph_lo, hi = args.ph_hi;
#define IN(k) (lo <= (k) && (k) < hi)
    int cv_n = 0; unsigned bseq = 0;
#ifndef FLAT_BARRIER
#define FLAT_BARRIER 0
#endif
#define SEAM(k) do { if (IN(k) && IN((k) + 1)) { ++bseq; if (FLAT_BARRIER) flat_barrier_work((unsigned*)(ws + WS_CTL) + CW_FLAT, args, lds, wave, lane, cv_n, MISC + 12, bseq); else xcd_barrier_work(bar, args, lds, wave, lane, cv_n, MISC + 12, bseq); } } while (0)
#define PHASE(k, ...) if (IN(k)) { __VA_ARGS__; if ((REPMASK >> (k)) & 1ull) { __syncthreads(); __VA_ARGS__; } } SEAM(k);
    typedef pg8::bf16_t pbf;

    const bool merge_pro = false && (G >= 32) && IN(PH_PRO) && IN(PH_NORM0);
    if (IN(PH_PRO)) { p_mods(args, lds, tid, lane, wave); p_weights(args, lds, lane, wave); if (merge_pro) wait_mods0(args, tid); }
    if (!merge_pro) SEAM(PH_PRO);
    const bool ctx_early = SPLIT_IN && (G == 256);
    PHASE(PH_NORM0, {
        if (ctx_early && bid < 24) {
            const int cb = bid / 12, cj = bid % 12;
            p_norm0(args, lane, wave, NWAVES, NTOK + cb * CTXL, NTOK + cb * CTXL + CTXL);
            VM_WAIT(); __syncthreads();
            if (cj < 8) {
                pg8::Gemm g{(const pbf*)(ws + WS_H8), (const pbf*)(ws + WS_WIN8), D / 2, 0};
                pg8::OneUnit S1{NTOK / 256 + cb, cj};
                pg8::EpiHgrnIn E{(pbf*)(ws + WS_Q), (WS_V - WS_Q) / 2, (_Float16*)(ws + WS_LFF), (WS_LFB - WS_LFF) / 2, args.in[I_HGAMMA], 2};
                pg8::gemm_phase<pg8::EpiHgrnIn, pg8::OneUnit, true, true, true, 0x79797979, 0x7F7F7F7F>(lds + RING_OFF, g, S1, E);
            } else {
                pg8::Gemm g{(const pbf*)(ws + WS_H), (const pbf*)(ws + WS_WIN), D, 0};
                pg8::OneUnit S1{NTOK / 256 + cb, 4 + (cj - 8)};
                pg8::EpiHgrnIn E{(pbf*)(ws + WS_Q), (WS_V - WS_Q) / 2, (_Float16*)(ws + WS_LFF), (WS_LFB - WS_LFF) / 2, args.in[I_HGAMMA], 1};
                pg8::gemm_phase<pg8::EpiHgrnIn, pg8::OneUnit, true, true, false>(lds + RING_OFF, g, S1, E);
            }
        } else if (ctx_early) p_norm0(args, lane, (bid - 24) * NWAVES + wave, (G - 24) * NWAVES, 0, NTOK);
        else p_norm0(args, lane, bid * NWAVES + wave, G * NWAVES, 0, MROWS);
    })
    PHASE(PH_INPROJ, {
        static_assert(WS_V - WS_Q == WS_SG - WS_V, "Q|V|SG equally spaced");
        if (SPLIT_IN) {
            const int nMi = ctx_early ? NTOK / 256 : MROWS / 256;
            {
                pg8::Gemm g{(const pbf*)(ws + WS_H8), (const pbf*)(ws + WS_WIN8), D / 2, 0};
                pg8::TileOrder S; S.init(nMi, 2 * D / 256, G, bid, nullptr);
                pg8::EpiHgrnIn E{(pbf*)(ws + WS_Q), (WS_V - WS_Q) / 2, (_Float16*)(ws + WS_LFF), (WS_LFB - WS_LFF) / 2, args.in[I_HGAMMA], 2};
                pg8::gemm_phase<pg8::EpiHgrnIn, pg8::TileOrder, true, true, true, 0x79797979, 0x7F7F7F7F>(lds + RING_OFF, g, S, E);
            }
            {
                pg8::Gemm g{(const pbf*)(ws + WS_H), (const pbf*)(ws + WS_WIN), D, 0};
                pg8::TileOrder S; S.init(nMi, 3 * D / 256, G, bid, nullptr);
                pg8::EpiHgrnIn E{(pbf*)(ws + WS_Q), (WS_V - WS_Q) / 2, (_Float16*)(ws + WS_LFF), (WS_LFB - WS_LFF) / 2, args.in[I_HGAMMA], 1};
                pg8::gemm_phase<pg8::EpiHgrnIn, pg8::TileOrder, true, true, false>(lds + RING_OFF, g, S, E);
            }
        } else {
            pg8::Gemm g{(const pbf*)(ws + WS_H), (const pbf*)(ws + WS_WIN), F8_IN ? D / 2 : D, 0};
            pg8::TileOrder S; S.init(MROWS / 256, 5 * D / 256, G, bid, nullptr);
            pg8::EpiHgrnIn E{(pbf*)(ws + WS_Q), (WS_V - WS_Q) / 2, (_Float16*)(ws + WS_LFF), (WS_LFB - WS_LFF) / 2, args.in[I_HGAMMA], 0};
            pg8::gemm_phase<pg8::EpiHgrnIn, pg8::TileOrder, true, true, F8_IN != 0, 0x79797979, 0x7F7F7F7F>(lds + RING_OFF, g, S, E);
        }
    })
#if SCAN_NAIVE
    PHASE(PH_SCANA, { p_scan_naive(args, lds, tid); })
    PHASE(PH_SCANC, { })
#else
    PHASE(PH_SCANA, { p_scan_a(args, lds, tid, lane, wave); })
    PHASE(PH_SCANC, { p_scan_c(args, lds, tid, lane, wave); })
#endif
    PHASE(PH_READOUT, { p_readout(args, lane, wave); })
    PHASE(PH_OUTPROJ, {
        pg8::Gemm g{(const pbf*)(ws + WS_YIN), (const pbf*)(ws + WS_WOUT), F8_MISC ? D / 2 : D, 0};
        pg8::TileOrder S; S.init(NTOK / 256, D / 256, G, bid, nullptr);
        pg8::EpiResGate<false, true> E{args.in[I_X], (void*)(ws + WS_X), (const float*)(ws + WS_MODS) + 2 * D, 6 * D, SEQ, nullptr};
        pg8::gemm_phase<pg8::EpiResGate<false, true>, pg8::TileOrder, true, true, F8_MISC != 0, 0x79797979, 0x7D7D7D7D>(lds + RING_OFF, g, S, E);
    })
#define MOE_PHASES(l, pb) \
    if (IN(pb + 0)) { p_router(args, lds, l, tid, lane, wave); cv_finish(args, lds, wave, lane, cv_n, (l + 1) * CV_L0); } SEAM(pb + 0); \
    if (IN(pb + 1) || IN(pb + 2) || IN(pb + 3)) { \
        moe_tables(args, lds, l, tid); \
        LAS int* tab = (LAS int*)(lds + EXTRA_OFF + 640); \
        const LAS int* s_tb = (const LAS int*)(lds + EXTRA_OFF + 256); const LAS int* s_ce = s_tb + 40; \
        const int ntiles = __builtin_amdgcn_readfirstlane(s_tb[32]); \
        PHASE(pb + 1, { \
            LAS unsigned short* tt = (LAS unsigned short*)(lds + EXTRA_OFF + 2816);     \
            pg8::TileOrder S; S.init(ntiles, 2 * D / 256, G, bid, tab); \
            { const int* STOK = (const int*)(ws + WS_STOK); pg8::Unit uu; for (int i = 0; S.next(i, uu); ++i) if (tid < 256) { const int vi = (uu.pm - s_tb[uu.e]) * 256 + tid; tt[i * 256 + tid] = vi < s_ce[uu.e] ? (unsigned short)STOK[(size_t)uu.e * NTOK + vi] : (unsigned short)0; } } \
            __syncthreads(); \
            pg8::Gemm g{(const pbf*)(ws + WS_H), (const pbf*)(ws + WS_W1 + (size_t)l * NE * 2 * D * D), D / 2, (size_t)2 * D * D, tt};   \
            pg8::EpiPair<0, true, 4> E{(pbf*)(ws + WS_ACT), args.in[I_BE1] + (size_t)l * NE * 2 * D}; \
            pg8::gemm_phase<pg8::EpiPair<0, true, 4>, pg8::TileOrder, true, true, true, 0x79797979, 0x7F7F7F7F, true>(lds + RING_OFF, g, S, E); \
        }) \
        PHASE(pb + 2, { \
            pg8::Gemm g{(const pbf*)(ws + WS_ACT), (const pbf*)(ws + WS_W2 + (size_t)l * NE * D * D), D / 2, (size_t)D * D}; \
            pg8::TileOrder S; S.init(ntiles, D / 256, G, bid, tab); \
            pg8::EpiMoeOut<F8_Y != 0, YSCALE> E{(pbf*)(ws + WS_YS), args.in[I_BE2] + (size_t)l * NE * D}; \
            pg8::gemm_phase<pg8::EpiMoeOut<F8_Y != 0, YSCALE>, pg8::TileOrder, true, true, true, 0x79797979, 0x7D7D7D7D>(lds + RING_OFF, g, S, E);   \
        }) \
    }
    MOE_PHASES(0, PH_ROUTER0)
    PHASE(PH_COMB0, { p_combine<false>(args, lds, 0, lane, wave); })
    PHASE(PH_CVIN, {
        pg8::Gemm g{(const pbf*)(ws + WS_H), (const pbf*)(ws + WS_WCVIN), F8_MISC ? D / 2 : D, 0};
        pg8::TileOrder S; S.init(NTOK / 256, 2 * D / 256, G, bid, nullptr);
        pg8::EpiPair<1> E{(pbf*)(ws + WS_U), args.in[I_BCVIN]};
        pg8::gemm_phase<pg8::EpiPair<1>, pg8::TileOrder, true, true, F8_MISC != 0, 0x79797979, 0x7F7F7F7F>(lds + RING_OFF, g, S, E);
    })
    PHASE(PH_DWCONV, { p_dwconv(args, tid); })
    PHASE(PH_LN, { p_ln_silu(args, lane, wave); })
    PHASE(PH_CVOUT, {
        pg8::Gemm g{(const pbf*)(ws + WS_Z), (const pbf*)(ws + WS_WCVOUT), F8_MISC ? D / 2 : D, 0};
        pg8::TileOrder S; S.init(NTOK / 256, D / 256, G, bid, nullptr);
        pg8::EpiResGate<true, true> E{(const void*)(ws + WS_X), (void*)(ws + WS_X), (const float*)(ws + WS_MODS) + 3 * 6 * D + 2 * D, 6 * D, SEQ, args.in[I_BCVOUT]};
        pg8::gemm_phase<pg8::EpiResGate<true, true>, pg8::TileOrder, true, true, F8_MISC != 0, 0x79797979, 0x7D7D7D7D>(lds + RING_OFF, g, S, E);
    })
    MOE_PHASES(1, PH_ROUTER1)
    if (IN(PH_FINAL)) { p_combine<true>(args, lds, 1, lane, wave); }
#undef MOE_PHASES
#undef PHASE
#undef IN
#undef SEAM
}

extern "C" void kernel_launch(void* const* d_in, const int* in_sizes, int n_in, void* d_out, int out_size, void* d_ws, size_t ws_size, hipStream_t stream) {
    static int grid = 0;
    if (grid == 0) {
        if (n_in != N_IN || in_sizes[0] != NTOK * D || out_size != NTOK * D || ws_size < WS_END) { fprintf(stderr, "kernel_launch: unexpected shapes / workspace (n_in %d, in0 %d, out %d, ws %zu, need %zu); nothing launched\n", n_in, n_in > 0 ? in_sizes[0] : -1, out_size, ws_size, (size_t)WS_END); grid = -1; return; }
        int dev = 0, cus = 0, per_cu = 0;
        if (hipGetDevice(&dev) != hipSuccess || hipDeviceGetAttribute(&cus, hipDeviceAttributeMultiprocessorCount, dev) != hipSuccess) { grid = -1; return; }
        if (hipFuncSetAttribute((const void*)fwd_kernel, hipFuncAttributeMaxDynamicSharedMemorySize, LDS_BYTES) != hipSuccess) { fprintf(stderr, "kernel_launch: hipFuncSetAttribute failed\n"); grid = -1; return; }
        if (hipOccupancyMaxActiveBlocksPerMultiprocessor(&per_cu, (const void*)fwd_kernel, NTHR, LDS_BYTES) != hipSuccess || per_cu < 1) { fprintf(stderr, "kernel_launch: occupancy query reports %d workgroups per CU\n", per_cu); }
        (void)hipGetLastError();
        grid = cus;
    }
    if (grid < 0) return;
    if (hipMemsetAsync((char*)d_ws + WS_CTL, 0, CTL_ZERO_BYTES, stream) != hipSuccess) return;
#ifdef DIAG_MEMSET
    (void)hipMemsetAsync((char*)d_ws + WS_SP, 0, (WS_WIN - WS_SP), stream); (void)hipMemsetAsync((char*)d_ws + WS_OF, 0, (WS_YIN - WS_OF), stream);
#endif
    Args a{};
    for (int i = 0; i < N_IN; ++i) a.in[i] = (const float*)d_in[i];
    a.out = (float*)d_out; a.ws = (unsigned char*)d_ws; a.pad = 0;
#ifndef MK_CUTS
    a.ph_lo = 0; a.ph_hi = NPH; a.li = 0;
    hipLaunchKernelGGL(fwd_kernel, dim3(grid), dim3(NTHR), LDS_BYTES, stream, a);
#else
    const int cuts[] = {MK_CUTS};
    const int nc = (int)(sizeof(cuts) / sizeof(cuts[0]));
    for (int li = 0; li + 1 < nc; ++li) { a.ph_lo = cuts[li]; a.ph_hi = cuts[li + 1]; a.li = li; hipLaunchKernelGGL(fwd_kernel, dim3(grid), dim3(NTHR), LDS_BYTES, stream, a); }
#endif
}
```

```cpp
#include <hip/hip_runtime.h>
#include <cstdio>
#include <cstdint>

namespace pg8 {
#define PG8_LAS __attribute__((address_space(3)))
typedef unsigned short bf16_t;
typedef short bf16x8 __attribute__((ext_vector_type(8)));
typedef float f32x4 __attribute__((ext_vector_type(4)));
typedef unsigned u32x4 __attribute__((ext_vector_type(4)));
typedef unsigned u32x2 __attribute__((ext_vector_type(2)));
typedef int i32x4 __attribute__((ext_vector_type(4)));
typedef int i32x8 __attribute__((ext_vector_type(8)));
constexpr int BM = 256, BK = 64, HALF = 128, HTB = HALF * BK * 2  , STAGE_BYTES = 8 * HTB, NXCD = 8, WGM = 8;

__host__ __device__ __forceinline__ int lds_byte(int r, int c) { const int st = (r >> 4) * 2 + (c >> 5), rr = r & 15, cc = c & 31, ob = rr * 64 + cc * 2; return st * 1024 + (ob ^ (((ob >> 9) & 1) << 5)); }
__host__ __device__ __forceinline__ void stage_rc(int b, int& R, int& C) { const int st = b / 1024, sb = b % 1024, swz = sb ^ (((sb >> 9) & 1) << 5); R = (st >> 1) * 16 + swz / 64; C = (st & 1) * 32 + (swz % 64) / 2; }
__host__ __device__ __forceinline__ int perm32(int rho) { const int n = rho >> 4, i = rho & 15; return 8 * (i >> 2) + 4 * n + (i & 3); }

struct Unit { int pm, pn, e; };
struct Gemm { const bf16_t* A; const bf16_t* Bt; int K; size_t estride; const PG8_LAS unsigned short* tt; };

struct TileOrder {
    int nM, nN, nwg, G, c; const PG8_LAS int* tile_e;
    __device__ __forceinline__ void init(int nM_, int nN_, int G_, int c_, const PG8_LAS int* te) { nM = nM_; nN = nN_; nwg = nM * nN; G = G_; c = c_; tile_e = te; }
    __device__ __forceinline__ bool next(int i, Unit& u) const {
        const long L = (long)i * G + c; if (L >= nwg) return false;
        int wgid = (int)L; { const int q = nwg / NXCD, r = nwg % NXCD, xcd = wgid % NXCD, off = wgid / NXCD; wgid = (xcd < r ? xcd * (q + 1) : r * (q + 1) + (xcd - r) * q) + off; }
        const int nig = WGM * nN, gid = wgid / nig, fm = gid * WGM, gsz = (nM - fm) < WGM ? (nM - fm) : WGM;
        u.pm = fm + ((wgid % nig) % gsz); u.pn = (wgid % nig) / gsz;
        u.e = tile_e ? __builtin_amdgcn_readfirstlane(tile_e[u.pm]) : 0; return true;
    }
    static constexpr bool PUBLISH = false;
    __device__ __forceinline__ void a_ready(const Unit&, int) const {}
    __device__ __forceinline__ void done(const Unit&) const {}
    __device__ __forceinline__ void publish(int, int) const {}
};

struct MoeOrder : TileOrder {
    static constexpr bool PUBLISH = true;
    unsigned* cnt; unsigned rdy; int mode;
    __device__ __forceinline__ void publish(int pm, int lane) const {
        if (mode == 0 && lane == 0) (void)__hip_atomic_fetch_add(cnt + 32 * pm, 1u, __ATOMIC_RELAXED, __HIP_MEMORY_SCOPE_AGENT);
    }
    __device__ __forceinline__ void a_ready(const Unit& u, int i) const {
        if (mode != 1 || ((rdy >> i) & 1u)) return;
        if (__builtin_amdgcn_readfirstlane(threadIdx.x >> 6) == 0) {
            unsigned sp = 0;
            while (__hip_atomic_load(cnt + 32 * u.pm, __ATOMIC_RELAXED, __HIP_MEMORY_SCOPE_AGENT) < 64u) { __builtin_amdgcn_s_sleep(1); if (++sp > (1u << 20)) break; }
            __builtin_amdgcn_fence(__ATOMIC_ACQUIRE, "agent");
            asm volatile("s_waitcnt vmcnt(0)" ::: "memory");
        }
        __builtin_amdgcn_s_barrier();
    }
};

struct OneUnit {
    int pm, pn;
    __device__ __forceinline__ bool next(int i, Unit& u) const { if (i != 0) return false; u.pm = pm; u.pn = pn; u.e = 0; return true; }
    static constexpr bool PUBLISH = false;
    __device__ __forceinline__ void a_ready(const Unit&, int) const {}
    __device__ __forceinline__ void done(const Unit&) const {}
    __device__ __forceinline__ void publish(int, int) const {}
};

__device__ __forceinline__ unsigned cvt_pk_bf16(float lo, float hi) { unsigned r; asm volatile("v_cvt_pk_bf16_f32 %0, %1, %2" : "=v"(r) : "v"(lo), "v"(hi)); return r; }
__device__ __forceinline__ float fsigmoid(float x) { return __builtin_amdgcn_rcpf(1.0f + __expf(-x)); }


struct EpiHgrnIn {
    static constexpr bool PERM = true, AFTER_DRAIN = false;
    bf16_t* Q; size_t qstride; _Float16* LFF; size_t lfstride; const float* gamma; int mode;
    static __device__ __forceinline__ f32x4 vexp2(f32x4 t) { f32x4 e; e[0] = __builtin_amdgcn_exp2f(t[0]); e[1] = __builtin_amdgcn_exp2f(t[1]); e[2] = __builtin_amdgcn_exp2f(t[2]); e[3] = __builtin_amdgcn_exp2f(t[3]); return e; }
    static __device__ __forceinline__ f32x4 vrcp(f32x4 d) { f32x4 r; r[0] = __builtin_amdgcn_rcpf(d[0]); r[1] = __builtin_amdgcn_rcpf(d[1]); r[2] = __builtin_amdgcn_rcpf(d[2]); r[3] = __builtin_amdgcn_rcpf(d[3]); return r; }
    static __device__ __forceinline__ f32x4 vlog2(f32x4 d) { f32x4 r; r[0] = __builtin_amdgcn_logf(d[0]); r[1] = __builtin_amdgcn_logf(d[1]); r[2] = __builtin_amdgcn_logf(d[2]); r[3] = __builtin_amdgcn_logf(d[3]); return r; }
    __device__ __forceinline__ void operator()(const f32x4 (&acc)[2][2][4][2], const Unit& u, int wr, int wc, int fr, int fq) const {
        const int sg_ = u.pn >> 2, seg = mode == 0 ? sg_ : (mode == 1 ? (sg_ < 2 ? sg_ : 4) : 2 + sg_), cb = (u.pn & 3) * 256 + wc * 32 + 8 * fq;
        const int row0 = u.pm * BM + wr * 64 + fr;
        if (seg == 2 || seg == 3) {
            _Float16* O = LFF + (size_t)(seg - 2) * lfstride; const float* g0 = gamma + (seg - 2) * 2048 + cb;
            f32x4 lb[2][2];
#pragma unroll
            for (int bj = 0; bj < 2; ++bj)
#pragma unroll
                for (int n = 0; n < 2; ++n) { const f32x4 d = *(const f32x4*)(g0 + bj * HALF + 4 * n) - *(const f32x4*)(g0 + 1024 + bj * HALF + 4 * n);
                    lb[bj][n] = vrcp(vexp2(d * -1.4426950408889634f) + 1.0f); }
#pragma unroll
            for (int ai = 0; ai < 2; ++ai)
#pragma unroll
                for (int m = 0; m < 4; ++m) { _Float16* rowp = O + (size_t)(row0 + ai * HALF + m * 16) * 1024 + cb;
#pragma unroll
                    for (int bj = 0; bj < 2; ++bj) { typedef _Float16 h16x8 __attribute__((ext_vector_type(8))); h16x8 o;
#pragma unroll
                        for (int n = 0; n < 2; ++n) { const f32x4 sg = vrcp(vexp2(acc[ai][bj][m][n] * -1.4426950408889634f) + 1.0f);
                            const f32x4 lf = vlog2(lb[bj][n] + (1.0f - lb[bj][n]) * sg) * 0.6931471805599453f;
                            o[4 * n + 0] = (_Float16)lf[0]; o[4 * n + 1] = (_Float16)lf[1]; o[4 * n + 2] = (_Float16)lf[2]; o[4 * n + 3] = (_Float16)lf[3]; }
                        *(h16x8*)(rowp + bj * HALF) = o; } }
        } else {
            bf16_t* O = Q + (size_t)(seg - (seg >> 2) * 2) * qstride;
#pragma unroll
            for (int ai = 0; ai < 2; ++ai)
#pragma unroll
                for (int m = 0; m < 4; ++m) { bf16_t* rowp = O + (size_t)(row0 + ai * HALF + m * 16) * 1024 + cb;
#pragma unroll
                    for (int bj = 0; bj < 2; ++bj) { f32x4 v0 = acc[ai][bj][m][0], v1 = acc[ai][bj][m][1];
                        if (seg == 4) { v0 = v0 * vrcp(vexp2(v0 * -1.4426950408889634f) + 1.0f); v1 = v1 * vrcp(vexp2(v1 * -1.4426950408889634f) + 1.0f); }
                        u32x4 w; w.x = cvt_pk_bf16(v0[0], v0[1]); w.y = cvt_pk_bf16(v0[2], v0[3]); w.z = cvt_pk_bf16(v1[0], v1[1]); w.w = cvt_pk_bf16(v1[2], v1[3]);
                        *(u32x4*)(rowp + bj * HALF) = w; } }
        }
    }
};
template <bool BASE16, bool OUT16> struct EpiResGate {
    static constexpr bool PERM = false, AFTER_DRAIN = false;
    const void* base; void* out; const float* gate; int gate_bstride; int rows_per_batch; const float* bias;
    __device__ __forceinline__ void operator()(const f32x4 (&acc)[2][2][4][2], const Unit& u, int wr, int wc, int fr, int fq) const {
        const int row0 = u.pm * BM + wr * 64 + fr, col0 = u.pn * BM + wc * 32 + 4 * fq;
        const float* gv_ = gate + (size_t)((u.pm * BM) / rows_per_batch) * gate_bstride;
        f32x4 gv[2][2], bv[2][2];
#pragma unroll
        for (int bj = 0; bj < 2; ++bj)
#pragma unroll
            for (int n = 0; n < 2; ++n) { gv[bj][n] = *(const f32x4*)(gv_ + col0 + bj * HALF + n * 16); bv[bj][n] = bias ? *(const f32x4*)(bias + col0 + bj * HALF + n * 16) : (f32x4){0.f, 0.f, 0.f, 0.f}; }
#pragma unroll
        for (int ai = 0; ai < 2; ++ai)
#pragma unroll
            for (int m = 0; m < 4; ++m) { const size_t off = (size_t)(row0 + ai * HALF + m * 16) * 1024 + col0;
#pragma unroll
                for (int bj = 0; bj < 2; ++bj)
#pragma unroll
                    for (int n = 0; n < 2; ++n) { const size_t o = off + bj * HALF + n * 16; f32x4 bs;
                        if constexpr (BASE16) { const u32x2 w = *(const u32x2*)((const bf16_t*)base + o); bs = (f32x4){__builtin_bit_cast(float, w.x << 16), __builtin_bit_cast(float, w.x & 0xffff0000u), __builtin_bit_cast(float, w.y << 16), __builtin_bit_cast(float, w.y & 0xffff0000u)}; }
                        else bs = *(const f32x4*)((const float*)base + o);
                        const f32x4 r = bs + gv[bj][n] * (acc[ai][bj][m][n] + bv[bj][n]);
                        if constexpr (OUT16) *(u32x2*)((bf16_t*)out + o) = (u32x2){cvt_pk_bf16(r[0], r[1]), cvt_pk_bf16(r[2], r[3])};
                        else *(f32x4*)((float*)out + o) = r; } }
    }
};
template <int MODE, bool OUT8 = false, int OSCALE = 1, bool WT = false> struct EpiPair {
    static constexpr bool PERM = true, AFTER_DRAIN = false;
    bf16_t* O; const float* bias0;
    static __device__ __forceinline__ f32x4 vsig(f32x4 x, float negscale) {
        const f32x4 t = x * negscale; f32x4 e; e[0] = __builtin_amdgcn_exp2f(t[0]); e[1] = __builtin_amdgcn_exp2f(t[1]); e[2] = __builtin_amdgcn_exp2f(t[2]); e[3] = __builtin_amdgcn_exp2f(t[3]);
        const f32x4 d = e + 1.0f; f32x4 r; r[0] = __builtin_amdgcn_rcpf(d[0]); r[1] = __builtin_amdgcn_rcpf(d[1]); r[2] = __builtin_amdgcn_rcpf(d[2]); r[3] = __builtin_amdgcn_rcpf(d[3]); return r; }
    __device__ __forceinline__ void operator()(const f32x4 (&acc)[2][2][4][2], const Unit& u, int wr, int wc, int fr, int fq) const {
        const float* bias = bias0 + (MODE == 0 ? (size_t)u.e * 2048 : 0);
        const int row0 = u.pm * BM + wr * 64 + fr, cg = u.pn * HALF + wc * 32 + 8 * fq;
        f32x4 b0[2], b1[2];
#pragma unroll
        for (int n = 0; n < 2; ++n) { b0[n] = *(const f32x4*)(bias + cg + 4 * n); b1[n] = *(const f32x4*)(bias + 1024 + cg + 4 * n); }
#pragma unroll
        for (int ai = 0; ai < 2; ++ai)
#pragma unroll
            for (int m = 0; m < 4; ++m) { bf16_t* rowp = O + (size_t)(row0 + ai * HALF + m * 16) * 1024 + cg; f32x4 r[2];
#pragma unroll
                for (int n = 0; n < 2; ++n) { const f32x4 g = acc[ai][0][m][n] + b0[n], up = acc[ai][1][m][n] + b1[n];
                    if (MODE == 0) { const f32x4 gg = __builtin_elementwise_min(g, (f32x4){7.0f, 7.0f, 7.0f, 7.0f});
                        const f32x4 uu = __builtin_elementwise_min(__builtin_elementwise_max(up, (f32x4){-7.0f, -7.0f, -7.0f, -7.0f}), (f32x4){7.0f, 7.0f, 7.0f, 7.0f});
                        r[n] = (uu * (float)OSCALE + (float)OSCALE) * (gg * vsig(gg, -1.702f * 1.4426950408889634f)); }
                    else r[n] = (g * (float)OSCALE) * vsig(up, -1.4426950408889634f); }
                if constexpr (OUT8) {
                    int w0 = 0, w1 = 0;
                    w0 = __builtin_amdgcn_cvt_pk_fp8_f32(r[0][0], r[0][1], w0, false); w0 = __builtin_amdgcn_cvt_pk_fp8_f32(r[0][2], r[0][3], w0, true);
                    w1 = __builtin_amdgcn_cvt_pk_fp8_f32(r[1][0], r[1][1], w1, false); w1 = __builtin_amdgcn_cvt_pk_fp8_f32(r[1][2], r[1][3], w1, true);
                    if constexpr (WT) __hip_atomic_store((unsigned long long*)((unsigned char*)O + (size_t)(row0 + ai * HALF + m * 16) * 1024 + cg), ((unsigned long long)(unsigned)w1 << 32) | (unsigned)w0, __ATOMIC_RELAXED, __HIP_MEMORY_SCOPE_AGENT);
                    else *(u32x2*)((unsigned char*)O + (size_t)(row0 + ai * HALF + m * 16) * 1024 + cg) = (u32x2){(unsigned)w0, (unsigned)w1};
                } else {
                u32x4 w; w.x = cvt_pk_bf16(r[0][0], r[0][1]); w.y = cvt_pk_bf16(r[0][2], r[0][3]); w.z = cvt_pk_bf16(r[1][0], r[1][1]); w.w = cvt_pk_bf16(r[1][2], r[1][3]);
                *(u32x4*)rowp = w; } }
    }
};
template <bool OUT8, int OSCALE> struct EpiMoeOut {
    static constexpr bool PERM = true, AFTER_DRAIN = false;
    bf16_t* O; const float* bias0;
    __device__ __forceinline__ void operator()(const f32x4 (&acc)[2][2][4][2], const Unit& u, int wr, int wc, int fr, int fq) const {
        const float* bias = bias0 + (size_t)u.e * 1024;
        const int row0 = u.pm * BM + wr * 64 + fr, col0 = u.pn * BM + wc * 32 + 8 * fq;
        f32x4 bv[2][2];
#pragma unroll
        for (int bj = 0; bj < 2; ++bj)
#pragma unroll
            for (int n = 0; n < 2; ++n) bv[bj][n] = *(const f32x4*)(bias + col0 + bj * HALF + 4 * n);
#pragma unroll
        for (int ai = 0; ai < 2; ++ai)
#pragma unroll
            for (int m = 0; m < 4; ++m) { const int r = row0 + ai * HALF + m * 16;
#pragma unroll
                for (int bj = 0; bj < 2; ++bj) { const f32x4 v0 = acc[ai][bj][m][0] + bv[bj][0], v1 = acc[ai][bj][m][1] + bv[bj][1];
                    if constexpr (OUT8) { const f32x4 lim = (f32x4){448.0f, 448.0f, 448.0f, 448.0f};
                        const f32x4 s0 = __builtin_elementwise_min(__builtin_elementwise_max(v0 * (float)OSCALE, -lim), lim), s1 = __builtin_elementwise_min(__builtin_elementwise_max(v1 * (float)OSCALE, -lim), lim); int w0 = 0, w1 = 0;
                        w0 = __builtin_amdgcn_cvt_pk_fp8_f32(s0[0], s0[1], w0, false); w0 = __builtin_amdgcn_cvt_pk_fp8_f32(s0[2], s0[3], w0, true);
                        w1 = __builtin_amdgcn_cvt_pk_fp8_f32(s1[0], s1[1], w1, false); w1 = __builtin_amdgcn_cvt_pk_fp8_f32(s1[2], s1[3], w1, true);
                        *(u32x2*)((unsigned char*)O + (size_t)r * 1024 + col0 + bj * HALF) = (u32x2){(unsigned)w0, (unsigned)w1};
                    } else { u32x4 w; w.x = cvt_pk_bf16(v0[0], v0[1]); w.y = cvt_pk_bf16(v0[2], v0[3]); w.z = cvt_pk_bf16(v1[0], v1[1]); w.w = cvt_pk_bf16(v1[2], v1[3]);
                        *(u32x4*)(O + (size_t)r * 1024 + col0 + bj * HALF) = w; } } }
    }
};

template <class Epi, class Sched, bool ALIGN_EPI = false, bool SP2 = false, bool F8 = false, int SCW = 0x7F7F7F7F, int SCA = 0x7F7F7F7F, bool GATHER = false>
__device__ __forceinline__ void gemm_phase(PG8_LAS unsigned char* lds, const Gemm g, const Sched& S, const Epi& E) {
    const int tid = threadIdx.x, wid = __builtin_amdgcn_readfirstlane(tid >> 6), lane = tid & 63, wr = wid >> 2, wc = wid & 3, fr = lane & 15, fq = lane >> 4;
    const int K = g.K, nt = K / BK;
    unsigned voffA[2], voffB[2]; int stR[2], stC[2];
#pragma unroll
    for (int i = 0; i < 2; ++i) { int R, C; stage_rc(tid * 16 + i * 8192, R, C); const int Rb = Epi::PERM ? ((R & ~31) + perm32(R & 31)) : R; stR[i] = R; stC[i] = C;
        voffA[i] = (unsigned)(R * K + C) * 2u; voffB[i] = (unsigned)(Rb * K + C) * 2u; }
    const size_t kstep = (size_t)(BK * 2);
    const size_t hstep = (size_t)HALF * K * 2;
    const size_t tstep = 2 * hstep;
    unsigned vc[2][2], vn[2][2];
#pragma unroll
    for (int h = 0; h < 2; ++h)
#pragma unroll
        for (int i = 0; i < 2; ++i) {
            if constexpr (GATHER) vc[h][i] = (unsigned)g.tt[h * HALF + stR[i]] * (unsigned)(K * 2) + (unsigned)stC[i] * 2u;
            else vc[h][i] = voffA[i] + (unsigned)h * (unsigned)hstep;
            vn[h][i] = vc[h][i]; }
    const unsigned ldsw = (unsigned)wid * 1024u;
    const int aoff = lds_byte(wr * 64 + fr, fq * 8), boff = lds_byte(wc * 32 + fr, fq * 8);
#define PG8_SA(b, h) (((b) * 2 + (h)) * HTB)
#define PG8_SB(b, h) ((4 + (b) * 2 + (h)) * HTB)
#define PG8_STAGE(bufoff, gbase, voff) do { _Pragma("unroll") for (int _i = 0; _i < 2; ++_i) \
        __builtin_amdgcn_global_load_lds((const unsigned*)((const char*)(gbase) + (voff)[_i]), (PG8_LAS unsigned*)(lds + (bufoff) + ldsw + _i * 8192), 16, 0, 0); } while (0)
#define PG8_LDA(dst, b, h) do { _Pragma("unroll") for (int m = 0; m < 4; ++m) _Pragma("unroll") for (int k = 0; k < 2; ++k) dst[m][k] = *(const PG8_LAS bf16x8*)(lds + PG8_SA(b, h) + aoff + m * 2048 + k * 1024); } while (0)
#define PG8_LDB(dst, b, h) do { _Pragma("unroll") for (int n = 0; n < 2; ++n) _Pragma("unroll") for (int k = 0; k < 2; ++k) dst[n][k] = *(const PG8_LAS bf16x8*)(lds + PG8_SB(b, h) + boff + n * 2048 + k * 1024); } while (0)
#define PG8_MMA(ai, bj, At, Bt) do { __builtin_amdgcn_s_setprio(1); \
        if constexpr (!F8) { _Pragma("unroll") for (int m = 0; m < 4; ++m) _Pragma("unroll") for (int n = 0; n < 2; ++n) _Pragma("unroll") for (int k = 0; k < 2; ++k) \
            acc[ai][bj][m][n] = __builtin_amdgcn_mfma_f32_16x16x32_bf16(Bt[n][k], At[m][k], acc[ai][bj][m][n], 0, 0, 0); } \
        else { const int scw_ = SCW, sca_ = SCA; _Pragma("unroll") for (int m = 0; m < 4; ++m) _Pragma("unroll") for (int n = 0; n < 2; ++n) { \
            const i32x8 wf_ = __builtin_shufflevector(__builtin_bit_cast(i32x4, Bt[n][0]), __builtin_bit_cast(i32x4, Bt[n][1]), 0, 1, 2, 3, 4, 5, 6, 7); \
            const i32x8 af_ = __builtin_shufflevector(__builtin_bit_cast(i32x4, At[m][0]), __builtin_bit_cast(i32x4, At[m][1]), 0, 1, 2, 3, 4, 5, 6, 7); \
            asm volatile("v_mfma_scale_f32_16x16x128_f8f6f4 %0, %1, %2, %0, %3, %4 op_sel_hi:[0,0,0]" : "+v"(acc[ai][bj][m][n]) : "v"(wf_), "v"(af_), "v"(scw_), "v"(sca_)); } } \
        __builtin_amdgcn_s_setprio(0); } while (0)
#define PG8_WAIT_V(n) asm volatile("s_waitcnt vmcnt(" #n ")" ::: "memory")
#define PG8_WAIT_L(n) asm volatile("s_waitcnt lgkmcnt(" #n ")" ::: "memory")
#define PG8_BAR __builtin_amdgcn_s_barrier()
#define PG8_SCHED __builtin_amdgcn_sched_barrier(0)
    Unit cur, nxt; int ui = 0, ppm = 0;
    if (!S.next(0, cur)) return;
    f32x4 acc[2][2][4][2];
#pragma unroll
    for (int a = 0; a < 2; ++a)
#pragma unroll
        for (int b = 0; b < 2; ++b)
#pragma unroll
            for (int m = 0; m < 4; ++m)
#pragma unroll
                for (int n = 0; n < 2; ++n) acc[a][b][m][n] = (f32x4){0.f, 0.f, 0.f, 0.f};
    bf16x8 At[4][2], B0[2][2], B1[2][2];
    const char* cA = (const char*)g.A + (GATHER ? (size_t)0 : (size_t)cur.pm * tstep); const char* cB = (const char*)g.Bt + (size_t)cur.e * g.estride + (size_t)cur.pn * tstep;
    S.a_ready(cur, 0);
    if constexpr (SP2) {
        PG8_STAGE(PG8_SB(0, 0), cB, voffB); PG8_STAGE(PG8_SB(0, 1), cB + hstep, voffB); PG8_STAGE(PG8_SA(0, 0), cA, vc[0]); PG8_STAGE(PG8_SA(0, 1), cA, vc[1]);
        if (wr == 1) PG8_BAR;
        PG8_WAIT_V(2); PG8_BAR;
        PG8_STAGE(PG8_SB(1, 0), cB + kstep, voffB); PG8_STAGE(PG8_SA(1, 0), cA + kstep, vc[0]); PG8_STAGE(PG8_SB(1, 1), cB + hstep + kstep, voffB);
        PG8_WAIT_V(6); PG8_BAR;
    } else {
        PG8_STAGE(PG8_SB(0, 0), cB, voffB); PG8_STAGE(PG8_SA(0, 0), cA, vc[0]); PG8_STAGE(PG8_SB(0, 1), cB + hstep, voffB); PG8_STAGE(PG8_SA(0, 1), cA, vc[1]);
        if (wr == 1) PG8_BAR;
        PG8_WAIT_V(4); PG8_BAR;
        PG8_STAGE(PG8_SB(1, 0), cB + kstep, voffB); PG8_STAGE(PG8_SA(1, 0), cA + kstep, vc[0]); PG8_STAGE(PG8_SB(1, 1), cB + hstep + kstep, voffB);
        PG8_WAIT_V(6); PG8_BAR;
    }
    for (;;) {
        const bool has_next = S.next(ui + 1, nxt);
        if constexpr (GATHER) { if (has_next) {
#pragma unroll
            for (int h = 0; h < 2; ++h)
#pragma unroll
                for (int i = 0; i < 2; ++i) vn[h][i] = (unsigned)g.tt[(ui + 1) * BM + h * HALF + stR[i]] * (unsigned)(K * 2) + (unsigned)stC[i] * 2u; } }
        const char* nA = (has_next && !GATHER) ? (const char*)g.A + (size_t)nxt.pm * tstep : cA; const char* nB = has_next ? (const char*)g.Bt + (size_t)nxt.e * g.estride + (size_t)nxt.pn * tstep : cB;
        for (int t = 0; t < nt; t += 2) {
            const bool last = (t == nt - 2);
            unsigned vs[2][2];
#pragma unroll
            for (int h = 0; h < 2; ++h)
#pragma unroll
                for (int i = 0; i < 2; ++i) vs[h][i] = (GATHER && last) ? vn[h][i] : vc[h][i];
            const char* a1 = cA + (size_t)(t + 1) * kstep;
            const char* a2 = last ? nA : cA + (size_t)(t + 2) * kstep; const char* b2 = last ? nB : cB + (size_t)(t + 2) * kstep;
            const char* a3 = a2 + kstep; const char* b3 = b2 + kstep;
            if (last && has_next) S.a_ready(nxt, ui + 1);
            if constexpr (Sched::PUBLISH) { if (t == 2 && ui > 0) S.publish(ppm, lane); }
            if constexpr (SP2) {
            PG8_LDB(B0, 0, 0); PG8_LDB(B1, 0, 1); PG8_SCHED; PG8_LDA(At, 0, 0); PG8_STAGE(PG8_SA(1, 1), a1, vc[1]);
            PG8_WAIT_V(8); PG8_WAIT_L(0); PG8_BAR; PG8_MMA(0, 0, At, B0); PG8_MMA(0, 1, At, B1); PG8_BAR; PG8_SCHED;
            PG8_LDA(At, 0, 1); PG8_STAGE(PG8_SB(0, 0), b2, voffB); PG8_STAGE(PG8_SB(0, 1), b2 + hstep, voffB); PG8_STAGE(PG8_SA(0, 0), a2, vs[0]);
            PG8_WAIT_V(8); PG8_WAIT_L(0); PG8_BAR; PG8_MMA(1, 0, At, B0); PG8_MMA(1, 1, At, B1); PG8_BAR; PG8_SCHED;
            PG8_LDB(B0, 1, 0); PG8_LDB(B1, 1, 1); PG8_SCHED; PG8_LDA(At, 1, 0); PG8_STAGE(PG8_SA(0, 1), a2, vs[1]);
            PG8_WAIT_V(8); PG8_WAIT_L(0); PG8_BAR; PG8_MMA(0, 0, At, B0); PG8_MMA(0, 1, At, B1); PG8_BAR; PG8_SCHED;
            PG8_LDA(At, 1, 1); PG8_STAGE(PG8_SB(1, 0), b3, voffB); PG8_STAGE(PG8_SB(1, 1), b3 + hstep, voffB); PG8_STAGE(PG8_SA(1, 0), a3, vs[0]);
            PG8_WAIT_V(8); PG8_WAIT_L(0); PG8_BAR; PG8_MMA(1, 0, At, B0); PG8_MMA(1, 1, At, B1); PG8_BAR; PG8_SCHED;
            } else {
            PG8_LDB(B0, 0, 0); PG8_SCHED; PG8_LDA(At, 0, 0); PG8_STAGE(PG8_SA(1, 1), a1, vc[1]);
            PG8_WAIT_L(8); PG8_BAR; PG8_WAIT_L(0); PG8_MMA(0, 0, At, B0); PG8_BAR; PG8_SCHED;
            PG8_LDB(B1, 0, 1); PG8_STAGE(PG8_SB(0, 0), b2, voffB);
            PG8_BAR; PG8_WAIT_L(0); PG8_MMA(0, 1, At, B1); PG8_BAR;
            PG8_LDA(At, 0, 1); PG8_STAGE(PG8_SA(0, 0), a2, vs[0]);
            PG8_BAR; PG8_WAIT_L(0); PG8_MMA(1, 0, At, B0); PG8_BAR; PG8_SCHED;
            PG8_STAGE(PG8_SB(0, 1), b2 + hstep, voffB);
            PG8_WAIT_V(6); PG8_BAR; PG8_MMA(1, 1, At, B1); PG8_BAR;
            PG8_LDB(B0, 1, 0); PG8_SCHED; PG8_LDA(At, 1, 0); PG8_STAGE(PG8_SA(0, 1), a2, vs[1]);
            PG8_WAIT_L(8); PG8_BAR; PG8_WAIT_L(0); PG8_MMA(0, 0, At, B0); PG8_BAR; PG8_SCHED;
            PG8_LDB(B1, 1, 1); PG8_STAGE(PG8_SB(1, 0), b3, voffB);
            PG8_BAR; PG8_WAIT_L(0); PG8_MMA(0, 1, At, B1); PG8_BAR;
            PG8_LDA(At, 1, 1); PG8_STAGE(PG8_SA(1, 0), a3, vs[0]);
            PG8_BAR; PG8_WAIT_L(0); PG8_MMA(1, 0, At, B0); PG8_BAR; PG8_SCHED;
            PG8_STAGE(PG8_SB(1, 1), b3 + hstep, voffB);
            PG8_WAIT_V(6); PG8_BAR; PG8_MMA(1, 1, At, B1); PG8_BAR;
            }
        }
        if constexpr (ALIGN_EPI) { if (wr == 0) PG8_BAR; }
        if constexpr (!Epi::AFTER_DRAIN) { E(acc, cur, wr, wc, fr, fq); S.done(cur); ppm = cur.pm; }
        if (!has_next) break;
#pragma unroll
        for (int a = 0; a < 2; ++a)
#pragma unroll
            for (int b = 0; b < 2; ++b)
#pragma unroll
                for (int m = 0; m < 4; ++m)
#pragma unroll
                    for (int n = 0; n < 2; ++n) acc[a][b][m][n] = (f32x4){0.f, 0.f, 0.f, 0.f};
        cur = nxt; cA = nA; cB = nB; ++ui;
        if constexpr (GATHER) {
#pragma unroll
            for (int h = 0; h < 2; ++h)
#pragma unroll
                for (int i = 0; i < 2; ++i) vc[h][i] = vn[h][i]; }
        if constexpr (ALIGN_EPI) { if (wr == 1) PG8_BAR; }
    }
    PG8_WAIT_V(0); if constexpr (Sched::PUBLISH) S.publish(ppm, lane);
    if constexpr (!ALIGN_EPI) { if (wr == 0) PG8_BAR; }
    PG8_BAR;
    if constexpr (Epi::AFTER_DRAIN) { E.fused(acc, cur, wr, wc, fr, fq, lds, wid, lane); S.done(cur); }
#undef PG8_SA
#undef PG8_SB
#undef PG8_STAGE
#undef PG8_LDA
#undef PG8_LDB
#undef PG8_MMA
#undef PG8_WAIT_V
#undef PG8_WAIT_L
#undef PG8_BAR
#undef PG8_SCHED
}
}


constexpr int D = 1024, NBATCH = 2, SEQ = 16384, NTOK = NBATCH * SEQ, CTXL = 256, NCTX = NBATCH * CTXL, MROWS = NTOK + NCTX;
constexpr int NHEAD = 8, DK = 128, NE = 32, TOPK = 4, CONVW = 31, GRIDW = 64, GRIDR = SEQ / GRIDW;
constexpr int NWAVES = 8, NTHR = NWAVES * 64;
constexpr int MAXTILES = 544;
constexpr float EPS = 1e-6f;
enum { I_X = 0, I_C, I_CTX, I_CCTX, I_WADA, I_BADA, I_GMIX, I_GFFN, I_WHIN, I_HGAMMA, I_GHOUT, I_WHOUT, I_WCVIN, I_BCVIN, I_WCVDW, I_BCVDW, I_GCVLN, I_BCVLN, I_WCVOUT, I_BCVOUT,
       I_WR, I_BR, I_WE1, I_BE1, I_WE2, I_BE2, I_GFINAL, N_IN };

constexpr size_t MiB = 1u << 20;
constexpr size_t WS_CTL = 0, CTL_ZERO_BYTES = 1 * MiB;
constexpr size_t WS_MODS = 1 * MiB;
constexpr size_t WS_TOPE = 2 * MiB, WS_TOPW = 2 * MiB + 512 * 1024, WS_POS = 3 * MiB, WS_BCNT = 3 * MiB + 512 * 1024, WS_TILEE = WS_BCNT + 64 * 1024, WS_SLOTW = 4 * MiB;
constexpr size_t WS_SP = 5 * MiB, WS_SD = 8 * MiB;
constexpr size_t WS_WIN = 48 * MiB, WS_WOUT = 58 * MiB, WS_WCVIN = 60 * MiB, WS_WCVOUT = 64 * MiB, WS_W1 = 66 * MiB, WS_W2 = 322 * MiB;
constexpr size_t WS_X = 450 * MiB;
constexpr size_t WS_H = 578 * MiB;
constexpr size_t WS_Q = 644 * MiB, WS_V = 709 * MiB, WS_SG = 774 * MiB, WS_LFF = 839 * MiB, WS_LFB = 969 * MiB, WS_OF = 1099 * MiB, WS_OB = 1227 * MiB, WS_YIN = 1355 * MiB;
constexpr size_t WS_AS = 1419 * MiB, WS_ACT = 1555 * MiB, WS_YS = 1691 * MiB, WS_END = 1963 * MiB;
#ifndef F8_IN
#define F8_IN 0
#endif
#ifndef SPLIT_IN
#define SPLIT_IN 1
#endif
#ifndef F8_Y
#define F8_Y 1
#endif
constexpr int YSCALE = 16;
#ifndef F8_MISC
#define F8_MISC 1
#endif
constexpr size_t WS_H8 = WS_OF + 64 * MiB;
constexpr size_t WS_WIN8 = WS_WIN + 6 * MiB;
constexpr size_t WS_STOK = WS_AS;
constexpr int CW_MODF = 3200;
constexpr int CW_FLAT = 3072;
constexpr int CW_GCNT = 2048;
constexpr float W8SCALE = 64.0f;
constexpr size_t WS_U = WS_Q, WS_ZP = WS_V, WS_Z = WS_SG;
constexpr int CW_BAR = 4096;
constexpr int CW_TCNT = 65536;

constexpr int RING_OFF = 0, RING_BYTES = 131072;
constexpr int LDSCTL_OFF = 139264, MISC_OFF = LDSCTL_OFF + 320, EXTRA_OFF = LDSCTL_OFF + 1024;
constexpr int LDS_BYTES = 155648;

#define LAS __attribute__((address_space(3)))
typedef unsigned short bf16;
typedef unsigned v4u __attribute__((ext_vector_type(4)));
typedef unsigned v2u __attribute__((ext_vector_type(2)));
typedef float f32x4 __attribute__((ext_vector_type(4)));
typedef int v4i __attribute__((ext_vector_type(4)));
#define LDS_WAIT() asm volatile("s_waitcnt lgkmcnt(0)" ::: "memory")
#define VM_WAIT() asm volatile("s_waitcnt vmcnt(0)" ::: "memory")
__device__ __forceinline__ unsigned f2bf(float f) { unsigned u = __builtin_bit_cast(unsigned, f); return (u + 0x7fffu + ((u >> 16) & 1u)) >> 16; }
__device__ __forceinline__ unsigned pk2(float lo, float hi) { return f2bf(lo) | (f2bf(hi) << 16); }
__device__ __forceinline__ float bf_lo(unsigned u) { return __builtin_bit_cast(float, u << 16); }
__device__ __forceinline__ float bf_hi(unsigned u) { return __builtin_bit_cast(float, u & 0xffff0000u); }
__device__ __forceinline__ float bf2f(bf16 h) { return __builtin_bit_cast(float, ((unsigned)h) << 16); }
__device__ __forceinline__ float fsig(float x) { return __builtin_amdgcn_rcpf(1.0f + __expf(-x)); }
__device__ __forceinline__ float wave_sum(float v) {
#pragma unroll
    for (int o = 1; o < 64; o <<= 1) v += __shfl_xor(v, o);
    return v;
}

__device__ __forceinline__ float sat8(float x) { return __builtin_amdgcn_fmed3f(x, -448.0f, 448.0f); }
__device__ __forceinline__ unsigned pk4_fp8(float a, float b, float c, float d) { int w = 0; w = __builtin_amdgcn_cvt_pk_fp8_f32(sat8(a), sat8(b), w, false); w = __builtin_amdgcn_cvt_pk_fp8_f32(sat8(c), sat8(d), w, true); return (unsigned)w; }
template <bool OUT8> __device__ __forceinline__ void store_row4(void* orow, int lane, int j, f32x4 y, float scale) {
    if constexpr (OUT8) ((unsigned*)orow)[lane + 64 * j] = pk4_fp8(y.x * scale, y.y * scale, y.z * scale, y.w * scale);
    else { v2u w; w.x = pk2(y.x, y.y); w.y = pk2(y.z, y.w); ((v2u*)orow)[lane + 64 * j] = w; }
}

#define XB_TMO      128
#define XB_XCNT(j)  (256  + 64 * (j))
#define XB_XSUB(j)  (1280 + 64 * (j))
#define XB_XGEN(j)  (2304 + 64 * (j))
#define XB_TOP      3328
#define XB_TOPGEN   3392
#define XCD_BAR_WORDS 3456
#define XB_SPIN_CAP (1u << 18)

__device__ __forceinline__ unsigned xb_ld(unsigned* p)              { return __hip_atomic_load(p, __ATOMIC_RELAXED, __HIP_MEMORY_SCOPE_AGENT); }
__device__ __forceinline__ unsigned xb_add(unsigned* p, unsigned v) { return __hip_atomic_fetch_add(p, v, __ATOMIC_RELAXED, __HIP_MEMORY_SCOPE_AGENT); }
__device__ __forceinline__ unsigned xb_xcc_id() { return (unsigned)__builtin_amdgcn_s_getreg((3 << 11) | 20) & 0xFu; }
#define XB_SPIN(cond, bar) do { unsigned _sp = 0; while (cond) { __builtin_amdgcn_s_sleep(1); \
    if ((++_sp & 255u) == 0u) { if (xb_ld(&(bar)[XB_TMO])) break; if (_sp > XB_SPIN_CAP) { atomicAdd(&(bar)[XB_TMO], 1u); break; } } } } while (0)

struct XcdBarrier {
    unsigned* bar; unsigned x;
    volatile LAS unsigned* st;
};

__device__ __forceinline__ XcdBarrier xcd_barrier_post(unsigned* bar, volatile LAS unsigned* st) {
    XcdBarrier b; b.bar = bar; b.x = xb_xcc_id(); b.st = st;
    if (threadIdx.x == 0) (void)xb_add(&bar[XB_XCNT(b.x)], 1u);
    return b;
}
__device__ __forceinline__ void xcd_barrier_complete(unsigned* bar, unsigned x, unsigned& nloc, unsigned& nx) {
    const unsigned G = gridDim.x * gridDim.y * gridDim.z;
    unsigned sum, cnt, mine, sp = 0u;
    for (;;) {
        sum = 0u; cnt = 0u; mine = 0u;
#pragma unroll
        for (unsigned j = 0; j < 16; ++j) { const unsigned c = xb_ld(&bar[XB_XCNT(j)]); sum += c; cnt += (c > 0u) ? 1u : 0u; mine = (j == x) ? c : mine; }
        if (sum == G) break;
        __builtin_amdgcn_s_sleep(1);
        if ((++sp & 255u) == 0u) { if (xb_ld(&bar[XB_TMO])) break; if (sp > XB_SPIN_CAP) { atomicAdd(&bar[XB_TMO], 1u); break; } }
    }
    nloc = mine > 0u ? mine : 1u; nx = cnt > 0u ? cnt : 1u;
}

__device__ __forceinline__ void xcd_barrier(const XcdBarrier& b) {
    asm volatile("s_waitcnt vmcnt(0)" ::: "memory");
    __syncthreads();
    if (threadIdx.x == 0) {
        unsigned* bar = b.bar;
        __builtin_amdgcn_s_waitcnt(0);
        unsigned nloc = b.st[0], nx = b.st[1];
        if (nloc == 0u) { xcd_barrier_complete(bar, b.x, nloc, nx); b.st[0] = nloc; b.st[1] = nx; }
        const unsigned old = xb_add(&bar[XB_XSUB(b.x)], 1u);
        const unsigned gen = old / nloc;
        if (old + 1u == (gen + 1u) * nloc) {
            __builtin_amdgcn_fence(__ATOMIC_RELEASE, "agent");
            asm volatile("s_waitcnt vmcnt(0)" ::: "memory");
            const unsigned og = xb_add(&bar[XB_TOP], 1u);
            const unsigned tg = og / nx;
            if (og + 1u == (tg + 1u) * nx) xb_add(&bar[XB_TOPGEN], 1u);
            else XB_SPIN(xb_ld(&bar[XB_TOPGEN]) == tg, bar);
            __builtin_amdgcn_fence(__ATOMIC_ACQUIRE, "agent");
            xb_add(&bar[XB_XGEN(b.x)], 1u);
            asm volatile("s_waitcnt vmcnt(0)" ::: "memory");
        } else {
            XB_SPIN(xb_ld(&bar[XB_XGEN(b.x)]) == gen, bar);
            __builtin_amdgcn_fence(__ATOMIC_ACQUIRE, "agent");
            asm volatile("s_waitcnt vmcnt(0)" ::: "memory");
        }
    }
    __syncthreads();
}

struct Args { const float* in[N_IN]; float* out; unsigned char* ws; int ph_lo, ph_hi, li, pad; };

__device__ __forceinline__ void p_mods(const Args& a, LAS unsigned char* lds, int tid, int lane, int wave) {
    LAS float* sc = (LAS float*)lds;
    LAS float* part = sc + 3 * D;
    float* MODS = (float*)(a.ws + WS_MODS);
    for (int i = tid; i < 3 * D; i += NTHR) { const int r = i >> 10, k = i & 1023; const float v = r < 2 ? a.in[I_C][r * D + k] : a.in[I_CCTX][k]; sc[i] = v * fsig(v); }
    __syncthreads();
    for (int item = blockIdx.x; item < 2 * 96; item += gridDim.x) {
        const int l = item / 96, cb = item % 96;
        const float* W = a.in[I_WADA] + (size_t)l * D * 6 * D + cb * 64 + lane;
        float a0 = 0.f, a1 = 0.f, a2 = 0.f;
#pragma unroll 16
        for (int kk = 0; kk < 128; ++kk) { const int k = wave * 128 + kk; const float w = W[(size_t)k * (6 * D)]; a0 += sc[k] * w; a1 += sc[D + k] * w; a2 += sc[2 * D + k] * w; }
        part[(wave * 3 + 0) * 64 + lane] = a0; part[(wave * 3 + 1) * 64 + lane] = a1; part[(wave * 3 + 2) * 64 + lane] = a2;
        __syncthreads();
        if (tid < 192) { const int r = tid >> 6, ln = tid & 63; float s = 0.f;
#pragma unroll
            for (int w = 0; w < 8; ++w) s += part[(w * 3 + r) * 64 + ln];
            __hip_atomic_store(&MODS[(size_t)(l * 3 + r) * (6 * D) + cb * 64 + ln], s + a.in[I_BADA][l * 6 * D + cb * 64 + ln], __ATOMIC_RELAXED, __HIP_MEMORY_SCOPE_AGENT); }
        asm volatile("s_waitcnt vmcnt(0)" ::: "memory");
        __syncthreads();
        if (item < 32 && tid == 0) (void)__hip_atomic_fetch_add((unsigned*)(a.ws + WS_CTL) + CW_MODF, 1u, __ATOMIC_RELAXED, __HIP_MEMORY_SCOPE_AGENT);
    }
}
__device__ __forceinline__ void wait_mods0(const Args& a, int tid) {
    if (tid == 0) { unsigned* f = (unsigned*)(a.ws + WS_CTL) + CW_MODF; unsigned sp = 0;
        while (__hip_atomic_load(f, __ATOMIC_RELAXED, __HIP_MEMORY_SCOPE_AGENT) < 32u) { __builtin_amdgcn_s_sleep(2); if (++sp > (1u << 22)) break; }
        __builtin_amdgcn_fence(__ATOMIC_ACQUIRE, "agent");
        asm volatile("s_waitcnt vmcnt(0)" ::: "memory"); }
    __syncthreads();
}
template <bool OUT8> __device__ __forceinline__ void transpose_item(const float* W, int K, int N, bf16* WT, bool paired, LAS float* scr, int item, int lane, int row_adj = 0) {
    const int nblk = N / 32, kb = item / nblk, nb = item % nblk, k0 = 64 * kb, n0 = 32 * nb;
    int d0 = n0 + row_adj; if (paired) { const int half = n0 >> 10, c = n0 & 1023; d0 = (c >> 7) * 256 + half * 128 + (c & 127); }
    float t[32];
#pragma unroll
    for (int i = 0; i < 32; ++i) { const int kk = 2 * i + (lane >> 5); t[i] = __builtin_nontemporal_load(&W[(size_t)(k0 + kk) * N + n0 + (lane & 31)]); }
#pragma unroll
    for (int i = 0; i < 32; ++i) { const int kk = 2 * i + (lane >> 5); scr[kk * 33 + (lane & 31)] = t[i]; }
    LDS_WAIT(); asm volatile("" ::: "memory");
    const int c = lane & 7;
#pragma unroll
    for (int j = 0; j < 4; ++j) { const int n = (lane >> 3) + 8 * j; const LAS float* s = scr + (8 * c) * 33 + n;
        if constexpr (OUT8) {
            int w0 = 0, w1 = 0;
            w0 = __builtin_amdgcn_cvt_pk_fp8_f32(s[0 * 33] * W8SCALE, s[1 * 33] * W8SCALE, w0, false); w0 = __builtin_amdgcn_cvt_pk_fp8_f32(s[2 * 33] * W8SCALE, s[3 * 33] * W8SCALE, w0, true);
            w1 = __builtin_amdgcn_cvt_pk_fp8_f32(s[4 * 33] * W8SCALE, s[5 * 33] * W8SCALE, w1, false); w1 = __builtin_amdgcn_cvt_pk_fp8_f32(s[6 * 33] * W8SCALE, s[7 * 33] * W8SCALE, w1, true);
            *(v2u*)((unsigned char*)WT + (size_t)(d0 + n) * K + k0 + 8 * c) = (v2u){(unsigned)w0, (unsigned)w1};
        } else {
        v4u o; o.x = pk2(s[0 * 33], s[1 * 33]); o.y = pk2(s[2 * 33], s[3 * 33]); o.z = pk2(s[4 * 33], s[5 * 33]); o.w = pk2(s[6 * 33], s[7 * 33]);
        *(v4u*)(WT + (size_t)(d0 + n) * K + k0 + 8 * c) = o; } }
    LDS_WAIT(); asm volatile("" ::: "memory");
}
__device__ __forceinline__ void p_weights(const Args& a, LAS unsigned char* lds, int lane, int wave) {
    LAS float* scr = (LAS float*)(lds + RING_OFF + wave * 16384);
    const int gw = blockIdx.x * NWAVES + wave, NGW = gridDim.x * NWAVES;
    constexpr int I_IN = 16 * 160, I_SQ = 16 * 32, I_CV = 16 * 64, I_E1 = 64 * 1024, I_E2 = 64 * 512;
    constexpr int NITEMS = I_IN + I_SQ + I_CV + I_SQ + I_E1 + I_E2;
    unsigned char* ws = a.ws;
    for (int it = (gridDim.x == 256 ? I_E1 + I_E2 : 0) + gw; it < NITEMS; it += NGW) {
        int r = it;
        if (r < I_E1) { const int mi = r >> 10; transpose_item<true>(a.in[I_WE1] + (size_t)mi * D * 2 * D, D, 2 * D, (bf16*)(ws + WS_W1 + (size_t)mi * 2 * D * D), true, scr, r & 1023, lane); continue; } r -= I_E1;
        if (r < I_E2) { const int mi = r >> 9; transpose_item<true>(a.in[I_WE2] + (size_t)mi * D * D, D, D, (bf16*)(ws + WS_W2 + (size_t)mi * D * D), false, scr, r & 511, lane); continue; } r -= I_E2;
        if (r < I_IN) {
            if (SPLIT_IN) { const int sgm = ((r % 160) * 32) >> 10;
                if (sgm == 2 || sgm == 3) transpose_item<true>(a.in[I_WHIN], D, 5 * D, (bf16*)(ws + WS_WIN8), false, scr, r, lane, -2 * D);
                else transpose_item<false>(a.in[I_WHIN], D, 5 * D, (bf16*)(ws + WS_WIN), false, scr, r, lane, sgm == 4 ? -2 * D : 0);
            } else transpose_item<F8_IN != 0>(a.in[I_WHIN], D, 5 * D, (bf16*)(ws + WS_WIN), false, scr, r, lane);
            continue; } r -= I_IN;
        if (r < I_SQ) { transpose_item<F8_MISC != 0>(a.in[I_WHOUT], D, D, (bf16*)(ws + WS_WOUT), false, scr, r, lane); continue; } r -= I_SQ;
        if (r < I_CV) { transpose_item<F8_MISC != 0>(a.in[I_WCVIN], D, 2 * D, (bf16*)(ws + WS_WCVIN), true, scr, r, lane); continue; } r -= I_CV;
        transpose_item<F8_MISC != 0>(a.in[I_WCVOUT], D, D, (bf16*)(ws + WS_WCVOUT), false, scr, r, lane);
    }
}
constexpr int CV_WAVES = 7, CV_L0 = 32 * 512 + 32 * 256, CV_ALL = 2 * CV_L0;
__device__ __forceinline__ void transpose_item64(const float* W, int K, int N, unsigned char* WT, bool paired, LAS float* scr, int item, int lane) {
    const int nblk = N / 64, kb = item / nblk, nb = item % nblk, k0 = 64 * kb, n0 = 64 * nb;
    int d0 = n0; if (paired) { const int half = n0 >> 10, c = n0 & 1023; d0 = (c >> 7) * 256 + half * 128 + (c & 127); }
    float t[64];
#pragma unroll
    for (int i = 0; i < 64; ++i) t[i] = __builtin_nontemporal_load(&W[(size_t)(k0 + i) * N + n0 + lane]);
#pragma unroll
    for (int i = 0; i < 64; ++i) scr[i * 65 + lane] = t[i];
    LDS_WAIT(); asm volatile("" ::: "memory");
    const int c = lane & 3;
#pragma unroll
    for (int j = 0; j < 4; ++j) { const int n = (lane >> 2) + 16 * j; const LAS float* s = scr + (16 * c) * 65 + n;
        v4u o;
        o.x = pk4_fp8(s[0 * 65] * W8SCALE, s[1 * 65] * W8SCALE, s[2 * 65] * W8SCALE, s[3 * 65] * W8SCALE); o.y = pk4_fp8(s[4 * 65] * W8SCALE, s[5 * 65] * W8SCALE, s[6 * 65] * W8SCALE, s[7 * 65] * W8SCALE);
        o.z = pk4_fp8(s[8 * 65] * W8SCALE, s[9 * 65] * W8SCALE, s[10 * 65] * W8SCALE, s[11 * 65] * W8SCALE); o.w = pk4_fp8(s[12 * 65] * W8SCALE, s[13 * 65] * W8SCALE, s[14 * 65] * W8SCALE, s[15 * 65] * W8SCALE);
        *(v4u*)(WT + (size_t)(d0 + n) * K + k0 + 16 * c) = o; }
    LDS_WAIT(); asm volatile("" ::: "memory");
}
__device__ __forceinline__ void cv_do_item(const Args& a, LAS float* scr, int g, int lane) {
    const int l = g >= CV_L0 ? 1 : 0; const int r = g - l * CV_L0;
    if (r < 32 * 512) { const int mi = l * 32 + (r >> 9); transpose_item64(a.in[I_WE1] + (size_t)mi * D * 2 * D, D, 2 * D, a.ws + WS_W1 + (size_t)mi * 2 * D * D, true, scr, r & 511, lane); }
    else { const int r2 = r - 32 * 512; const int mi = l * 32 + (r2 >> 8); transpose_item64(a.in[I_WE2] + (size_t)mi * D * D, D, D, a.ws + WS_W2 + (size_t)mi * D * D, false, scr, r2 & 255, lane); }
}
__device__ __forceinline__ void cv_finish(const Args& a, LAS unsigned char* lds, int wave, int lane, int& cv_n, int limit) {
    if (gridDim.x == 256 && wave >= 1 && wave <= CV_WAVES) {
        const int ww = blockIdx.x * CV_WAVES + (wave - 1), NW = 256 * CV_WAVES; LAS float* scr = (LAS float*)(lds + RING_OFF + wave * 16640);
        for (;;) { const int g = cv_n * NW + ww; if (g >= limit) break; cv_do_item(a, scr, g, lane); ++cv_n; }
    }
}
__device__ __forceinline__ void xcd_barrier_work(const XcdBarrier& b, const Args& a, LAS unsigned char* lds, int wave, int lane, int& cv_n, volatile LAS unsigned* flag, unsigned seq) {
    asm volatile("s_waitcnt vmcnt(0)" ::: "memory");
    __syncthreads();
    if (wave == 0) {
        if (threadIdx.x == 0) {
            unsigned* bar = b.bar;
            __builtin_amdgcn_s_waitcnt(0);
            unsigned nloc = b.st[0], nx = b.st[1];
            if (nloc == 0u) { xcd_barrier_complete(bar, b.x, nloc, nx); b.st[0] = nloc; b.st[1] = nx; }
            const unsigned old = xb_add(&bar[XB_XSUB(b.x)], 1u);
            const unsigned gen = old / nloc;
            if (old + 1u == (gen + 1u) * nloc) {
                __builtin_amdgcn_fence(__ATOMIC_RELEASE, "agent");
                asm volatile("s_waitcnt vmcnt(0)" ::: "memory");
                const unsigned og = xb_add(&bar[XB_TOP], 1u);
                const unsigned tg = og / nx;
                if (og + 1u == (tg + 1u) * nx) xb_add(&bar[XB_TOPGEN], 1u);
                else XB_SPIN(xb_ld(&bar[XB_TOPGEN]) == tg, bar);
                __builtin_amdgcn_fence(__ATOMIC_ACQUIRE, "agent");
                xb_add(&bar[XB_XGEN(b.x)], 1u);
                asm volatile("s_waitcnt vmcnt(0)" ::: "memory");
            } else {
                XB_SPIN(xb_ld(&bar[XB_XGEN(b.x)]) == gen, bar);
                __builtin_amdgcn_fence(__ATOMIC_ACQUIRE, "agent");
                asm volatile("s_waitcnt vmcnt(0)" ::: "memory");
            }
            flag[0] = seq;
        }
    } else if (gridDim.x == 256 && wave <= CV_WAVES) {
        const int ww = blockIdx.x * CV_WAVES + (wave - 1), NW = 256 * CV_WAVES; LAS float* scr = (LAS float*)(lds + RING_OFF + wave * 16640);
        for (;;) { const int g = cv_n * NW + ww; if (g >= CV_ALL) break; if (flag[0] == seq) break; cv_do_item(a, scr, g, lane); ++cv_n; }
        asm volatile("s_waitcnt vmcnt(0)" ::: "memory");
    }
    __syncthreads();
}
__device__ __forceinline__ void flat_barrier_work(unsigned* cnt, const Args& a, LAS unsigned char* lds, int wave, int lane, int& cv_n, volatile LAS unsigned* flag, unsigned seq) {
    asm volatile("s_waitcnt vmcnt(0)" ::: "memory");
    __syncthreads();
    if (wave == 0) {
        if (threadIdx.x == 0) {
            __builtin_amdgcn_s_waitcnt(0);
            __builtin_amdgcn_fence(__ATOMIC_RELEASE, "agent");
            asm volatile("s_waitcnt vmcnt(0)" ::: "memory");
            (void)__hip_atomic_fetch_add(cnt, 1u, __ATOMIC_RELAXED, __HIP_MEMORY_SCOPE_AGENT);
            const unsigned target = gridDim.x * seq; unsigned sp = 0;
            while (__hip_atomic_load(cnt, __ATOMIC_RELAXED, __HIP_MEMORY_SCOPE_AGENT) < target) { __builtin_amdgcn_s_sleep(1); if (++sp > (1u << 22)) break; }
            __builtin_amdgcn_fence(__ATOMIC_ACQUIRE, "agent");
            asm volatile("s_waitcnt vmcnt(0)" ::: "memory");
            flag[0] = seq;
        }
    } else if (gridDim.x == 256 && wave <= CV_WAVES) {
        const int ww = blockIdx.x * CV_WAVES + (wave - 1), NW = 256 * CV_WAVES; LAS float* scr = (LAS float*)(lds + RING_OFF + wave * 16640);
        for (;;) { const int g = cv_n * NW + ww; if (g >= CV_ALL) break; if (flag[0] == seq) break; cv_do_item(a, scr, g, lane); ++cv_n; }
        asm volatile("s_waitcnt vmcnt(0)" ::: "memory");
    }
    __syncthreads();
}
template <bool OUT8> __device__ __forceinline__ void norm_mod_store(f32x4 (&v)[4], const float* g, const float* sc, const float* sh, void* orow, int lane) {
    float s = 0.f;
#pragma unroll
    for (int j = 0; j < 4; ++j) s += (v[j].x * v[j].x + v[j].y * v[j].y) + (v[j].z * v[j].z + v[j].w * v[j].w);
    const float r = 1.0f / sqrtf(wave_sum(s) * (1.0f / D) + EPS);
#pragma unroll
    for (int j = 0; j < 4; ++j) { const f32x4 gg = ((const f32x4*)g)[lane + 64 * j], ss = ((const f32x4*)sc)[lane + 64 * j], hh = ((const f32x4*)sh)[lane + 64 * j];
        const f32x4 y = (v[j] * r * gg) * (ss + 1.0f) + hh; v[j] = y;
        store_row4<OUT8>(orow, lane, j, y, 1.0f); }
}
__device__ __forceinline__ void p_norm0(const Args& a, int lane, int gw, int NGW, int m_begin, int m_end) {
    const float* MODS = (const float*)(a.ws + WS_MODS); bf16* H = (bf16*)(a.ws + WS_H);
    for (int m0 = m_begin + gw * 2; m0 < m_end; m0 += NGW * 2) {
        f32x4 v[2][4]; int rr[2];
#pragma unroll
        for (int r = 0; r < 2; ++r) { const int m = m0 + r; const float* xr;
            if (m < NTOK) { xr = a.in[I_X] + (size_t)m * D; rr[r] = m / SEQ; } else { xr = a.in[I_CTX] + (size_t)(m - NTOK) * D; rr[r] = 2; }
#pragma unroll
            for (int j = 0; j < 4; ++j) v[r][j] = __builtin_nontemporal_load(&((const f32x4*)xr)[lane + 64 * j]); }
#pragma unroll
        for (int r = 0; r < 2; ++r) { const float* md = MODS + (size_t)rr[r] * 6 * D;
            norm_mod_store<F8_IN != 0>(v[r], a.in[I_GMIX], md + 1 * D, md + 0 * D, (unsigned char*)H + (size_t)(m0 + r) * D * (F8_IN ? 1 : 2), lane);
            if (SPLIT_IN) {
#pragma unroll
                for (int j = 0; j < 4; ++j) store_row4<true>(a.ws + WS_H8 + (size_t)(m0 + r) * D, lane, j, v[r][j], 1.0f); } }
    }
}
__device__ __forceinline__ void p_scan_naive(const Args& a, LAS unsigned char* lds, int tid) {
    LAS float* sf = (LAS float*)lds;
    LAS float* sq = sf + 64 * 128;
    LAS float* sv = sq + 64 * 128;
    LAS float* so = sv + 64 * 16;
    const bf16* Q = (const bf16*)(a.ws + WS_Q); const bf16* V = (const bf16*)(a.ws + WS_V);
    const int vl = tid >> 5, kq = tid & 31;
    for (int unit = blockIdx.x; unit < 256; unit += gridDim.x) {
        const int chain = unit >> 3, vb = unit & 7, b = chain >> 4, h = (chain >> 1) & 7, dir = chain & 1;
        const float* LF = (const float*)(a.ws + (dir ? WS_LFB : WS_LFF)); float* O = (float*)(a.ws + (dir ? WS_OB : WS_OF));
        float S0 = 0.f, S1 = 0.f, S2 = 0.f, S3 = 0.f;
        for (int blk = 0; blk < 260; ++blk) {
            const bool isctx = blk < 4; int base, step;
            if (!dir) { base = isctx ? (NTOK + b * CTXL + blk * 64) : (b * SEQ + (blk - 4) * 64); step = 1; }
            else { base = isctx ? (NTOK + b * CTXL + CTXL - 1 - blk * 64) : (b * SEQ + SEQ - 1 - (blk - 4) * 64); step = -1; }
            for (int e = tid; e < 64 * 128; e += NTHR) { const int i = e >> 7, k = e & 127; const size_t off = (size_t)(base + step * i) * D + h * DK + k; sf[e] = __expf(LF[off]); sq[e] = bf2f(Q[off]); }
            for (int e = tid; e < 64 * 16; e += NTHR) { const int i = e >> 4, vv = e & 15; sv[e] = bf2f(V[(size_t)(base + step * i) * D + h * DK + vb * 16 + vv]); }
            __syncthreads();
            for (int i = 0; i < 64; ++i) {
                const f32x4 f = *(const LAS f32x4*)(sf + i * 128 + kq * 4), q = *(const LAS f32x4*)(sq + i * 128 + kq * 4); const float vv = sv[i * 16 + vl];
                S0 = f.x * S0 + (1.0f - f.x) * vv; S1 = f.y * S1 + (1.0f - f.y) * vv; S2 = f.z * S2 + (1.0f - f.z) * vv; S3 = f.w * S3 + (1.0f - f.w) * vv;
                float p = (S0 * q.x + S1 * q.y) + (S2 * q.z + S3 * q.w);
                p += __shfl_xor(p, 1); p += __shfl_xor(p, 2); p += __shfl_xor(p, 4); p += __shfl_xor(p, 8); p += __shfl_xor(p, 16);
                if (kq == 0) so[i * 16 + vl] = p;
            }
            __syncthreads();
            if (!isctx) for (int e = tid; e < 64 * 16; e += NTHR) { const int i = e >> 4, vv = e & 15; O[(size_t)(base + step * i) * D + h * DK + vb * 16 + vv] = so[e]; }
            __syncthreads();
        }
    }
}
constexpr int SC_QT = 0, SC_KU = 4352, SC_KB = 8704, SC_VT = 12800, SC_ET = 16896, SC_SUB = 17408, SC_BUF = 4 * SC_SUB;
constexpr int NSLOT = 17;
typedef short s16x4 __attribute__((ext_vector_type(4)));
typedef short s16x8 __attribute__((ext_vector_type(8)));
struct ScanUnit { int h, rowbase, sgn, nchunks, chain, slot; };
__device__ __forceinline__ ScanUnit scan_unit(int b, int h, int dir, int slot) {
    ScanUnit u; u.h = h; u.sgn = dir ? -1 : 1; u.chain = (b * NHEAD + h) * 2 + dir; u.slot = slot;
    if (slot == 0) { u.rowbase = NTOK + b * CTXL + (dir ? CTXL - 1 : 0); u.nchunks = CTXL / 64; }
    else { const int so = (slot - 1) * 1024; u.rowbase = b * SEQ + (dir ? SEQ - 1 - so : so); u.nchunks = 16; }
    return u;
}
typedef float f32x2_t __attribute__((ext_vector_type(2)));
typedef __bf16 bf16x2_t __attribute__((ext_vector_type(2)));
__device__ __forceinline__ unsigned cvtpk(float lo, float hi) { const f32x2_t f = {lo, hi}; return __builtin_bit_cast(unsigned, __builtin_convertvector(f, bf16x2_t)); }
template <bool FULL> __device__ __forceinline__ void scan_load(const ScanUnit& u, int pos0, const bf16* LF, const bf16* Q, const bf16* V, int k, int i, unsigned (&lf)[16], unsigned (&qr)[16], unsigned (&vr)[16]) {
#pragma unroll
    for (int t = 0; t < 16; ++t) {
        const unsigned o = (unsigned)(u.rowbase + u.sgn * (pos0 + 16 * i + t)) * D + u.h * DK + k;
        lf[t] = LF[o]; vr[t] = V[o]; if (FULL) qr[t] = Q[o];
    }
}
template <bool FULL> __device__ __forceinline__ float scan_prep(LAS unsigned char* buf, int k, int i, const unsigned (&lfr)[16], const unsigned (&qr)[16], const unsigned (&vr)[16]) {
    LAS unsigned char* sb = buf + i * SC_SUB;
    float f[16], pre[16], suf[16]; float T = 0.f;
#pragma unroll
    for (int t = 0; t < 16; ++t) { const float lf = (float)__builtin_bit_cast(_Float16, (unsigned short)lfr[t]); T += lf; f[t] = __builtin_amdgcn_exp2f(lf * 1.4426950408889634f); }
    pre[0] = f[0];
#pragma unroll
    for (int t = 1; t < 16; ++t) pre[t] = pre[t - 1] * f[t];
    suf[15] = 1.0f;
#pragma unroll
    for (int t = 14; t >= 0; --t) suf[t] = suf[t + 1] * f[t + 1];
    unsigned kbw[8], vtw[8];
#pragma unroll
    for (int t = 0; t < 16; t += 2) {
        const float kk0 = 1.0f - f[t], kk1 = 1.0f - f[t + 1];
        kbw[t >> 1] = cvtpk(kk0 * suf[t], kk1 * suf[t + 1]);
        vtw[t >> 1] = vr[t] | (vr[t + 1] << 16);
        if (FULL) {
            const unsigned qq = cvtpk(__builtin_bit_cast(float, qr[t] << 16) * pre[t], __builtin_bit_cast(float, qr[t + 1] << 16) * pre[t + 1]);
            const unsigned ku = cvtpk(kk0 * __builtin_amdgcn_rcpf(fmaxf(pre[t], 1e-30f)), kk1 * __builtin_amdgcn_rcpf(fmaxf(pre[t + 1], 1e-30f)));
            *(LAS bf16*)(sb + SC_QT + t * 272 + 2 * k) = (bf16)(qq & 0xffffu); *(LAS bf16*)(sb + SC_QT + (t + 1) * 272 + 2 * k) = (bf16)(qq >> 16);
            *(LAS bf16*)(sb + SC_KU + t * 272 + 2 * k) = (bf16)(ku & 0xffffu); *(LAS bf16*)(sb + SC_KU + (t + 1) * 272 + 2 * k) = (bf16)(ku >> 16);
        }
    }
    *(LAS v4u*)(sb + SC_KB + k * 32) = (v4u){kbw[0], kbw[1], kbw[2], kbw[3]}; *(LAS v4u*)(sb + SC_KB + k * 32 + 16) = (v4u){kbw[4], kbw[5], kbw[6], kbw[7]};
    *(LAS v4u*)(sb + SC_VT + k * 32) = (v4u){vtw[0], vtw[1], vtw[2], vtw[3]}; *(LAS v4u*)(sb + SC_VT + k * 32 + 16) = (v4u){vtw[4], vtw[5], vtw[6], vtw[7]};
    *(LAS float*)(sb + SC_ET + 4 * k) = pre[15];
    return T;
}
__device__ __forceinline__ f32x4 mfma_k16(s16x4 a, s16x4 b, f32x4 c) {
    const v2u av = __builtin_bit_cast(v2u, a), bv = __builtin_bit_cast(v2u, b);
    return __builtin_amdgcn_mfma_f32_16x16x32_bf16(__builtin_bit_cast(s16x8, (v4u){av.x, av.y, 0u, 0u}), __builtin_bit_cast(s16x8, (v4u){bv.x, bv.y, 0u, 0u}), c, 0, 0, 0);
}
template <bool FULL> __device__ __forceinline__ void scan_compute2(const LAS unsigned char* buf, int wq, int lane, f32x4 (&S)[2][8], bf16* Ocol, const ScanUnit& u, int pos0) {
    const int fr = lane & 15, g = lane >> 4;
#pragma unroll 1
    for (int i = 0; i < 2; ++i) {
        const LAS unsigned char* sb = buf + i * SC_SUB;
        const s16x4 vt0 = *(const LAS s16x4*)(sb + SC_VT + (32 * wq + fr) * 32 + 8 * g), vt1 = *(const LAS s16x4*)(sb + SC_VT + (32 * wq + 16 + fr) * 32 + 8 * g);
        s16x8 ka[4], qa[4]; f32x4 et[8]; s16x4 kb[8];
        if (FULL) {
#pragma unroll
            for (int c = 0; c < 4; ++c) { ka[c] = *(const LAS s16x8*)(sb + SC_KU + fr * 272 + (32 * c + 8 * g) * 2); qa[c] = *(const LAS s16x8*)(sb + SC_QT + fr * 272 + (32 * c + 8 * g) * 2); }
        }
#pragma unroll
        for (int j = 0; j < 8; ++j) { et[j] = *(const LAS f32x4*)(sb + SC_ET + (32 * (j >> 1) + 8 * g + 4 * (j & 1)) * 4); kb[j] = *(const LAS s16x4*)(sb + SC_KB + (32 * (j >> 1) + 8 * (fr >> 2) + 4 * (j & 1) + (fr & 3)) * 32 + 8 * g); }
        __builtin_amdgcn_sched_barrier(0);
        if (FULL) {
            f32x4 aT = (f32x4){0.f, 0.f, 0.f, 0.f};
#pragma unroll
            for (int c = 0; c < 4; ++c) aT = __builtin_amdgcn_mfma_f32_16x16x32_bf16(ka[c], qa[c], aT, 0, 0, 0);
#pragma unroll
            for (int r = 0; r < 4; ++r) if (4 * g + r > fr) aT[r] = 0.f;
            const s16x4 ab = __builtin_bit_cast(s16x4, (v2u){cvtpk(aT[0], aT[1]), cvtpk(aT[2], aT[3])});
            f32x4 o0 = mfma_k16(vt0, ab, (f32x4){0.f, 0.f, 0.f, 0.f}), o1 = mfma_k16(vt1, ab, (f32x4){0.f, 0.f, 0.f, 0.f});
#pragma unroll
            for (int c = 0; c < 4; ++c) {
                const v4u s0 = (v4u){cvtpk(S[0][2 * c][0], S[0][2 * c][1]), cvtpk(S[0][2 * c][2], S[0][2 * c][3]), cvtpk(S[0][2 * c + 1][0], S[0][2 * c + 1][1]), cvtpk(S[0][2 * c + 1][2], S[0][2 * c + 1][3])};
                const v4u s1 = (v4u){cvtpk(S[1][2 * c][0], S[1][2 * c][1]), cvtpk(S[1][2 * c][2], S[1][2 * c][3]), cvtpk(S[1][2 * c + 1][0], S[1][2 * c + 1][1]), cvtpk(S[1][2 * c + 1][2], S[1][2 * c + 1][3])};
                o0 = __builtin_amdgcn_mfma_f32_16x16x32_bf16(__builtin_bit_cast(s16x8, s0), qa[c], o0, 0, 0, 0);
                o1 = __builtin_amdgcn_mfma_f32_16x16x32_bf16(__builtin_bit_cast(s16x8, s1), qa[c], o1, 0, 0, 0);
            }
            bf16* orow = Ocol + (size_t)(u.rowbase + u.sgn * (pos0 + 16 * i + fr)) * D;
            *(v2u*)orow = (v2u){cvtpk(o0[0], o0[1]), cvtpk(o0[2], o0[3])}; *(v2u*)(orow + 16) = (v2u){cvtpk(o1[0], o1[1]), cvtpk(o1[2], o1[3])};
        }
#pragma unroll
        for (int j = 0; j < 8; ++j) { S[0][j] = mfma_k16(kb[j], vt0, S[0][j] * et[j]); S[1][j] = mfma_k16(kb[j], vt1, S[1][j] * et[j]); }
    }
}
template <bool FULL> __device__ __forceinline__ void scan_pair(const Args& a, LAS unsigned char* lds, const ScanUnit& uA, const ScanUnit& uB, int tid, int lane, int wave) {
    const int grp = wave >> 2, wq = wave & 3, t = tid & 255, k = t & 127, i0 = t >> 7;
    ScanUnit u; u.h = grp ? uB.h : uA.h; u.rowbase = grp ? uB.rowbase : uA.rowbase; u.sgn = grp ? uB.sgn : uA.sgn; u.nchunks = grp ? uB.nchunks : uA.nchunks; u.chain = grp ? uB.chain : uA.chain; u.slot = grp ? uB.slot : uA.slot;
    LAS unsigned char* buf = lds + grp * SC_BUF;
    const int dir = u.sgn < 0;
    const bf16* LF = (const bf16*)(a.ws + (dir ? WS_LFB : WS_LFF)); const bf16* Q = (const bf16*)(a.ws + WS_Q); const bf16* V = (const bf16*)(a.ws + WS_V);
    f32x4* SD = (f32x4*)(a.ws + WS_SD) + (size_t)u.chain * NSLOT * 4096; float* SP = (float*)(a.ws + WS_SP) + (size_t)u.chain * NSLOT * DK;
    const int g = lane >> 4;
    bf16* Ocol = (bf16*)(a.ws + (dir ? WS_OB : WS_OF)) + u.h * DK + 32 * wq + 4 * g;
    f32x4 S[2][8];
#pragma unroll
    for (int vb = 0; vb < 2; ++vb)
#pragma unroll
        for (int j = 0; j < 8; ++j) S[vb][j] = (f32x4){0.f, 0.f, 0.f, 0.f};
    if (FULL) {
        for (int s = 0; s < u.slot; ++s) {
            const f32x4* d = SD + (size_t)s * 4096 + (wq * 16) * 64 + lane; const float* pp = SP + s * DK + 8 * g;
#pragma unroll
            for (int j = 0; j < 8; ++j) { const f32x4 pv = *(const f32x4*)(pp + 32 * (j >> 1) + 4 * (j & 1)); const f32x4 ev = (f32x4){__expf(pv.x), __expf(pv.y), __expf(pv.z), __expf(pv.w)};
                S[0][j] = S[0][j] * ev + d[j * 64]; S[1][j] = S[1][j] * ev + d[(8 + j) * 64]; }
        }
    }
    unsigned lf[16], q[16], v[16]; float psum = 0.f;
    const int nsteps = u.nchunks * 2;
    scan_load<FULL>(u, 0, LF, Q, V, k, i0, lf, q, v);
    constexpr int NST = 32;
    if (grp == 1) __syncthreads();
    for (int c = 0; c < NST; ++c) {
        if (c < nsteps) psum += scan_prep<FULL>(buf, k, i0, lf, q, v);
        __syncthreads();
        if (c < nsteps) {
            const int cn = (c + 1 < nsteps) ? c + 1 : c;
            scan_load<FULL>(u, cn * 32, LF, Q, V, k, i0, lf, q, v);
            scan_compute2<FULL>(buf, wq, lane, S, Ocol, u, c * 32);
        }
        __syncthreads();
    }
    if (grp == 0) __syncthreads();
    if (!FULL) {
        f32x4* d = SD + (size_t)u.slot * 4096 + (wq * 16) * 64 + lane;
#pragma unroll
        for (int j = 0; j < 8; ++j) { d[j * 64] = S[0][j]; d[(8 + j) * 64] = S[1][j]; }
        LAS float* ps = (LAS float*)(lds + EXTRA_OFF + 2560);
        ps[(grp * 2 + i0) * 128 + k] = psum;
        __syncthreads();
        if (t < 128) SP[u.slot * DK + t] = ps[(grp * 2) * 128 + t] + ps[(grp * 2 + 1) * 128 + t];
        __syncthreads();
    }
}
__device__ __forceinline__ void p_scan_a(const Args& a, LAS unsigned char* lds, int tid, int lane, int wave) {
    for (int it = blockIdx.x; it < 256; it += gridDim.x) {
        const int b = it >> 7, h = (it >> 4) & 7, seg = it & 15;
        const ScanUnit uA = scan_unit(b, h, 0, seg == 15 ? 0 : 1 + seg);
        const ScanUnit uB = scan_unit(b, h, 1, seg == 0 ? 0 : 16 - seg);
        scan_pair<false>(a, lds, uA, uB, tid, lane, wave);
    }
}
__device__ __forceinline__ void p_scan_c(const Args& a, LAS unsigned char* lds, int tid, int lane, int wave) {
    for (int it = blockIdx.x; it < 256; it += gridDim.x) {
        const int b = it >> 7, h = (it >> 4) & 7, seg = it & 15;
        const ScanUnit uA = scan_unit(b, h, 0, 1 + seg), uB = scan_unit(b, h, 1, 16 - seg);
        scan_pair<true>(a, lds, uA, uB, tid, lane, wave);
    }
}
__device__ __forceinline__ void p_readout(const Args& a, int lane, int wave) {
    const int gw = blockIdx.x * NWAVES + wave, NGW = gridDim.x * NWAVES;
    const bf16* OF = (const bf16*)(a.ws + WS_OF); const bf16* OB = (const bf16*)(a.ws + WS_OB); const bf16* SG = (const bf16*)(a.ws + WS_SG); bf16* Y = (bf16*)(a.ws + WS_YIN);
    for (int m0 = gw * 2; m0 < NTOK; m0 += NGW * 2) {
        f32x4 o[2][4]; v2u sg[2][4];
#pragma unroll
        for (int r = 0; r < 2; ++r)
#pragma unroll
            for (int j = 0; j < 4; ++j) { const size_t m = m0 + r; const v2u a_ = ((const v2u*)(OF + m * D))[lane + 64 * j], b_ = ((const v2u*)(OB + m * D))[lane + 64 * j];
                o[r][j] = (f32x4){bf_lo(a_.x) + bf_lo(b_.x), bf_hi(a_.x) + bf_hi(b_.x), bf_lo(a_.y) + bf_lo(b_.y), bf_hi(a_.y) + bf_hi(b_.y)}; sg[r][j] = ((const v2u*)(SG + m * D))[lane + 64 * j]; }
#pragma unroll
        for (int r = 0; r < 2; ++r)
#pragma unroll
            for (int j = 0; j < 4; ++j) { const f32x4 oo = o[r][j];
                float s = (oo.x * oo.x + oo.y * oo.y) + (oo.z * oo.z + oo.w * oo.w);
                s += __shfl_xor(s, 1); s += __shfl_xor(s, 2); s += __shfl_xor(s, 4); s += __shfl_xor(s, 8); s += __shfl_xor(s, 16);
                const float rs = 1.0f / sqrtf(s * (1.0f / DK) + EPS);
                const f32x4 gg = ((const f32x4*)a.in[I_GHOUT])[lane + 64 * j];
                store_row4<F8_MISC != 0>((unsigned char*)Y + (size_t)(m0 + r) * D * (F8_MISC ? 1 : 2), lane, j,
                    (f32x4){oo.x * rs * gg.x * bf_lo(sg[r][j].x), oo.y * rs * gg.y * bf_hi(sg[r][j].x), oo.z * rs * gg.z * bf_lo(sg[r][j].y), oo.w * rs * gg.w * bf_hi(sg[r][j].y)}, 4.0f); }
    }
}
__device__ __forceinline__ void p_router(const Args& a, LAS unsigned char* lds, int l, int tid, int lane, int wave) {
    typedef _Float16 h16x8 __attribute__((ext_vector_type(8))); typedef _Float16 h16x4 __attribute__((ext_vector_type(4)));
    constexpr int PITCH = 2064, WT_OFF = 0, TILE_OFF = 32 * PITCH, P_OFF = TILE_OFF + 16 * PITCH;
    LAS int* s_cnt = (LAS int*)(lds + EXTRA_OFF);
    LAS int* s_gb = s_cnt + 32;
    LAS int* s_sel = (LAS int*)(lds + EXTRA_OFF + 2560);
    unsigned* GCNT = (unsigned*)(a.ws + WS_CTL) + CW_GCNT + l * 32;
    const float* WR = a.in[I_WR] + (size_t)l * D * NE; const float* BR = a.in[I_BR] + l * NE;
    for (int i = tid; i < D * NE; i += NTHR) *(LAS _Float16*)(lds + WT_OFF + (i & 31) * PITCH + (i >> 5) * 2) = (_Float16)WR[i];
    const bf16* X = (const bf16*)(a.ws + WS_X); unsigned char* H = a.ws + WS_H;
    const float* MODS = (const float*)(a.ws + WS_MODS);
    int* TOPS = (int*)(a.ws + WS_TOPE); float* TOPW = (float*)(a.ws + WS_TOPW); int* STOK = (int*)(a.ws + WS_STOK);
    const int fr = lane & 15, g = lane >> 4;
    LAS float* P = (LAS float*)(lds + P_OFF);
    for (int ch = blockIdx.x; ch < NTOK / 128; ch += gridDim.x) {
        if (tid < 32) s_cnt[tid] = 0;
        const int b = (ch * 128) / SEQ; const float* md = MODS + (size_t)(l * 3 + b) * 6 * D;
        v2u nx[2][4];
#pragma unroll
        for (int t = 0; t < 2; ++t)
#pragma unroll
            for (int j = 0; j < 4; ++j) nx[t][j] = ((const v2u*)(X + (size_t)(ch * 128 + 2 * wave + t) * D))[lane + 64 * j];
        for (int it = 0; it < 8; ++it) {
            const int tok0 = ch * 128 + it * 16 + 2 * wave;
            f32x4 hf[2][4];
#pragma unroll
            for (int t = 0; t < 2; ++t)
#pragma unroll
                for (int j = 0; j < 4; ++j) hf[t][j] = (f32x4){bf_lo(nx[t][j].x), bf_hi(nx[t][j].x), bf_lo(nx[t][j].y), bf_hi(nx[t][j].y)};
            if (it + 1 < 8) {
#pragma unroll
                for (int t = 0; t < 2; ++t)
#pragma unroll
                    for (int j = 0; j < 4; ++j) nx[t][j] = ((const v2u*)(X + (size_t)(tok0 + 16 + t) * D))[lane + 64 * j];
            }
#pragma unroll
            for (int t = 0; t < 2; ++t) {
                norm_mod_store<true>(hf[t], a.in[I_GFFN] + l * D, md + 4 * D, md + 3 * D, H + (size_t)(tok0 + t) * D, lane);
#pragma unroll
                for (int j = 0; j < 4; ++j) { const h16x4 hv = {(_Float16)hf[t][j].x, (_Float16)hf[t][j].y, (_Float16)hf[t][j].z, (_Float16)hf[t][j].w};
                    *(LAS h16x4*)(lds + TILE_OFF + (2 * wave + t) * PITCH + (4 * lane + 256 * j) * 2) = hv; }
            }
            __syncthreads();
            f32x4 acc0 = (f32x4){0.f, 0.f, 0.f, 0.f}, acc1 = acc0;
#pragma unroll
            for (int c = 0; c < 4; ++c) { const int kb = (128 * wave + 32 * c + 8 * g) * 2;
                const h16x8 av = *(const LAS h16x8*)(lds + TILE_OFF + fr * PITCH + kb);
                const h16x8 b0 = *(const LAS h16x8*)(lds + WT_OFF + fr * PITCH + kb), b1 = *(const LAS h16x8*)(lds + WT_OFF + (16 + fr) * PITCH + kb);
                acc0 = __builtin_amdgcn_mfma_f32_16x16x32_f16(av, b0, acc0, 0, 0, 0); acc1 = __builtin_amdgcn_mfma_f32_16x16x32_f16(av, b1, acc1, 0, 0, 0); }
#pragma unroll
            for (int r = 0; r < 4; ++r) { P[(wave * 16 + 4 * g + r) * 32 + fr] = acc0[r]; P[(wave * 16 + 4 * g + r) * 32 + 16 + fr] = acc1[r]; }
            __syncthreads();
            const int t = lane >> 5, e0 = lane & 31;
            float v0 = BR[e0];
#pragma unroll
            for (int w = 0; w < 8; ++w) v0 += P[(w * 16 + 2 * wave + t) * 32 + e0];
            float selv[4]; int seli[4];
#pragma unroll
            for (int r = 0; r < 4; ++r) {
                float bv = v0; int bi = e0;
#pragma unroll
                for (int o = 1; o < 32; o <<= 1) { const float ov = __shfl_xor(bv, o); const int oi = __shfl_xor(bi, o); if (ov > bv || (ov == bv && oi < bi)) { bv = ov; bi = oi; } }
                selv[r] = bv; seli[r] = bi;
                if (bi == e0) v0 = -INFINITY;
            }
            if ((lane & 31) == 0) {
                const float e1 = __expf(selv[1] - selv[0]), e2 = __expf(selv[2] - selv[0]), e3 = __expf(selv[3] - selv[0]); const float inv = 1.0f / (1.0f + e1 + e2 + e3);
                *(f32x4*)(TOPW + (size_t)(tok0 + t) * 4) = (f32x4){inv, e1 * inv, e2 * inv, e3 * inv};
#pragma unroll
                for (int r = 0; r < 4; ++r) s_sel[(it * 16 + 2 * wave + t) * 4 + r] = (seli[r] << 16) | __hip_atomic_fetch_add(&s_cnt[seli[r]], 1, __ATOMIC_RELAXED, __HIP_MEMORY_SCOPE_WORKGROUP);
            }
        }
        __syncthreads();
        if (tid < 32) s_gb[tid] = (int)__hip_atomic_fetch_add(GCNT + tid, (unsigned)s_cnt[tid], __ATOMIC_RELAXED, __HIP_MEMORY_SCOPE_AGENT);
        __syncthreads();
        { const int sv = s_sel[tid], e = sv >> 16, vi = s_gb[e] + (sv & 0xffff); TOPS[(size_t)ch * 512 + tid] = e * NTOK + vi; STOK[(size_t)e * NTOK + vi] = ch * 128 + (tid >> 2); }
        __syncthreads();
    }
}
__device__ __forceinline__ void moe_tables(const Args& a, LAS unsigned char* lds, int l, int tid) {
    LAS int* s_tb = (LAS int*)(lds + EXTRA_OFF + 256); LAS int* s_ce = s_tb + 40; LAS int* tab = (LAS int*)(lds + EXTRA_OFF + 640);
    const unsigned* GCNT = (const unsigned*)(a.ws + WS_CTL) + CW_GCNT + l * 32;
    if (tid < 32) s_ce[tid] = (int)__hip_atomic_load(GCNT + tid, __ATOMIC_RELAXED, __HIP_MEMORY_SCOPE_AGENT);
    __syncthreads();
    if (tid == 0) { int run = 0; for (int e = 0; e < 32; ++e) { s_tb[e] = run; run += (s_ce[e] + 255) >> 8; } s_tb[32] = run; }
    __syncthreads();
    if (tid < 32) { const int t0 = s_tb[tid], t1 = s_tb[tid + 1]; for (int t = t0; t < t1; ++t) tab[t] = tid; }
    __syncthreads();
}
template <bool FINAL> __device__ __forceinline__ void p_combine(const Args& a, LAS unsigned char* lds, int l, int lane, int wave) {
    const int gw = blockIdx.x * NWAVES + wave, NGW = gridDim.x * NWAVES;
    bf16* X = (bf16*)(a.ws + WS_X); const bf16* YS = (const bf16*)(a.ws + WS_YS); const int* TOPS = (const int*)(a.ws + WS_TOPE); const float* TOPW = (const float*)(a.ws + WS_TOPW);
    const LAS int* s_tb = (const LAS int*)(lds + EXTRA_OFF + 256);
    const float* MODS = (const float*)(a.ws + WS_MODS); bf16* H = (bf16*)(a.ws + WS_H);
    for (int m0 = gw * 2; m0 < NTOK; m0 += NGW * 2) {
        const int b = m0 / SEQ; const float* gt = MODS + (size_t)(l * 3 + b) * 6 * D + 5 * D;
        f32x4 v[2][4]; v2u y[2][4][4]; f32x4 tw[2];
#pragma unroll
        for (int r = 0; r < 2; ++r) { v4i ps = *(const v4i*)(TOPS + (size_t)(m0 + r) * 4); tw[r] = *(const f32x4*)(TOPW + (size_t)(m0 + r) * 4);
#pragma unroll
            for (int k = 0; k < 4; ++k) { const int e = ps[k] >> 15; ps[k] = s_tb[e] * 256 + (ps[k] & (NTOK - 1)); }
#pragma unroll
            for (int j = 0; j < 4; ++j) { const v2u xx = ((const v2u*)(X + (size_t)(m0 + r) * D))[lane + 64 * j]; v[r][j] = (f32x4){bf_lo(xx.x), bf_hi(xx.x), bf_lo(xx.y), bf_hi(xx.y)};
#pragma unroll
                for (int k = 0; k < 4; ++k) {
                    if (F8_Y) { y[r][j][k].x = ((const unsigned*)((const unsigned char*)YS + (size_t)ps[k] * D))[lane + 64 * j]; y[r][j][k].y = 0u; }
                    else y[r][j][k] = ((const v2u*)(YS + (size_t)ps[k] * D))[lane + 64 * j]; } } }
#pragma unroll
        for (int r = 0; r < 2; ++r) { const int m = m0 + r;
#pragma unroll
            for (int j = 0; j < 4; ++j) { f32x4 s = (f32x4){0.f, 0.f, 0.f, 0.f};
#pragma unroll
                for (int k = 0; k < 4; ++k) {
                    if (F8_Y) { const int w = (int)y[r][j][k].x; const f32x2_t lo = __builtin_amdgcn_cvt_pk_f32_fp8(w, false), hi = __builtin_amdgcn_cvt_pk_f32_fp8(w, true);
                        s += (f32x4){lo.x, lo.y, hi.x, hi.y} * (tw[r][k] * (1.0f / YSCALE)); }
                    else s += (f32x4){bf_lo(y[r][j][k].x), bf_hi(y[r][j][k].x), bf_lo(y[r][j][k].y), bf_hi(y[r][j][k].y)} * tw[r][k]; }
                v[r][j] = v[r][j] + ((const f32x4*)gt)[lane + 64 * j] * s; }
            if (!FINAL) {
#pragma unroll
                for (int j = 0; j < 4; ++j) ((v2u*)(X + (size_t)m * D))[lane + 64 * j] = (v2u){pk2(v[r][j].x, v[r][j].y), pk2(v[r][j].z, v[r][j].w)};
                const float* md = MODS + (size_t)((l + 1) * 3 + b) * 6 * D;
                norm_mod_store<F8_MISC != 0>(v[r], a.in[I_GMIX] + (l + 1) * D, md + 1 * D, md + 0 * D, (unsigned char*)H + (size_t)m * D * (F8_MISC ? 1 : 2), lane);
            } else {
                float s = 0.f;
#pragma unroll
                for (int j = 0; j < 4; ++j) s += (v[r][j].x * v[r][j].x + v[r][j].y * v[r][j].y) + (v[r][j].z * v[r][j].z + v[r][j].w * v[r][j].w);
                const float rs = 1.0f / sqrtf(wave_sum(s) * (1.0f / D) + EPS);
#pragma unroll
                for (int j = 0; j < 4; ++j) __builtin_nontemporal_store(v[r][j] * rs * ((const f32x4*)a.in[I_GFINAL])[lane + 64 * j], &((f32x4*)(a.out + (size_t)m * D))[lane + 64 * j]);
            }
        }
    }
}
__device__ __forceinline__ void p_dwconv(const Args& a, int tid) {
    const bf16* U = (const bf16*)(a.ws + WS_U); bf16* ZP = (bf16*)(a.ws + WS_ZP);
    const float* WDW = a.in[I_WCVDW]; const float* BDW = a.in[I_BCVDW];
    const int half = tid >> 8, cp = tid & 255;
    for (int unit = blockIdx.x; unit < 2048; unit += gridDim.x) {
        const int hu = unit * 2 + half;
        int c, len, p0; size_t base, stride;
        if (hu < 2048) { c = 2 * cp; len = GRIDW; p0 = (hu & 3) * 16; base = (size_t)(hu >> 2) * GRIDW * D; stride = D; }
        else { const int v = hu - 2048; const int b = v >> 10, w = (v >> 4) & 63; c = 512 + 2 * cp; len = GRIDR; p0 = (v & 15) * 16; base = ((size_t)b * SEQ + w) * D; stride = (size_t)GRIDW * D; }
        float w0[CONVW], w1[CONVW];
#pragma unroll
        for (int j = 0; j < CONVW; ++j) { w0[j] = WDW[j * D + c]; w1[j] = WDW[j * D + c + 1]; }
        const float bb0 = BDW[c], bb1 = BDW[c + 1];
        float i0[46], i1[46];
#pragma unroll
        for (int i = 0; i < 46; ++i) { const int pp = p0 - 15 + i; unsigned u = 0u; if (pp >= 0 && pp < len) u = *(const unsigned*)(U + base + (size_t)pp * stride + c); i0[i] = bf_lo(u); i1[i] = bf_hi(u); }
#pragma unroll
        for (int i = 0; i < 16; ++i) { float a0 = bb0, a1 = bb1;
#pragma unroll
            for (int j = 0; j < CONVW; ++j) { a0 += i0[i + j] * w0[j]; a1 += i1[i + j] * w1[j]; }
            *(unsigned*)(ZP + base + (size_t)(p0 + i) * stride + c) = pk2(a0, a1); }
    }
}
__device__ __forceinline__ void p_ln_silu(const Args& a, int lane, int wave) {
    const int gw = blockIdx.x * NWAVES + wave, NGW = gridDim.x * NWAVES;
    const bf16* ZP = (const bf16*)(a.ws + WS_ZP); bf16* Z = (bf16*)(a.ws + WS_Z);
    for (int m0 = gw * 2; m0 < NTOK; m0 += NGW * 2) {
        v2u y[2][4];
#pragma unroll
        for (int r = 0; r < 2; ++r)
#pragma unroll
            for (int j = 0; j < 4; ++j) y[r][j] = ((const v2u*)(ZP + (size_t)(m0 + r) * D))[lane + 64 * j];
#pragma unroll
        for (int r = 0; r < 2; ++r) {
            f32x4 v[4]; float s = 0.f;
#pragma unroll
            for (int j = 0; j < 4; ++j) { v[j] = (f32x4){bf_lo(y[r][j].x), bf_hi(y[r][j].x), bf_lo(y[r][j].y), bf_hi(y[r][j].y)}; s += (v[j].x + v[j].y) + (v[j].z + v[j].w); }
            const float mean = wave_sum(s) * (1.0f / D); float s2 = 0.f;
#pragma unroll
            for (int j = 0; j < 4; ++j) { v[j] = v[j] - mean; s2 += (v[j].x * v[j].x + v[j].y * v[j].y) + (v[j].z * v[j].z + v[j].w * v[j].w); }
            const float rstd = 1.0f / sqrtf(wave_sum(s2) * (1.0f / D) + EPS);
#pragma unroll
            for (int j = 0; j < 4; ++j) { const f32x4 gg = ((const f32x4*)a.in[I_GCVLN])[lane + 64 * j], bb = ((const f32x4*)a.in[I_BCVLN])[lane + 64 * j];
                f32x4 yy = v[j] * rstd * gg + bb; yy.x *= fsig(yy.x); yy.y *= fsig(yy.y); yy.z *= fsig(yy.z); yy.w *= fsig(yy.w);
                store_row4<F8_MISC != 0>((unsigned char*)Z + (size_t)(m0 + r) * D * (F8_MISC ? 1 : 2), lane, j, yy, 4.0f); }
        }
    }
}


enum { PH_PRO = 0, PH_NORM0, PH_INPROJ, PH_SCANA, PH_SCANC, PH_READOUT, PH_OUTPROJ, PH_ROUTER0, PH_G1_0, PH_G2_0, PH_COMB0, PH_CVIN, PH_DWCONV, PH_LN, PH_CVOUT, PH_ROUTER1, PH_G1_1, PH_G2_1, PH_FINAL, NPH };
#ifndef REPMASK
#define REPMASK 0ull
#endif
#ifndef SCAN_NAIVE
#define SCAN_NAIVE 0
#endif
__global__ void __launch_bounds__(NTHR, 2) fwd_kernel(Args args) {
    extern __shared__ __attribute__((aligned(16))) unsigned char lds_raw[];
    LAS unsigned char* lds = (LAS unsigned char*)lds_raw;
    const int tid = threadIdx.x, lane = tid & 63, wave = __builtin_amdgcn_readfirstlane(tid >> 6);
    const int G = gridDim.x, bid = blockIdx.x;
    unsigned char* ws = args.ws;
    for (int u = tid; u < (LDS_BYTES - LDSCTL_OFF) / 4; u += NTHR) ((LAS unsigned*)(lds + LDSCTL_OFF))[u] = 0u;
    __syncthreads();
    volatile LAS unsigned* MISC = (volatile LAS unsigned*)(lds + MISC_OFF);
    XcdBarrier bar = xcd_barrier_post((unsigned*)(ws + WS_CTL) + CW_BAR + args.li * XCD_BAR_WORDS, MISC + 8);
    const int lo = args.ph_lo, hi = args.ph_hi;
#define IN(k) (lo <= (k) && (k) < hi)
    int cv_n = 0; unsigned bseq = 0;
#ifndef FLAT_BARRIER
#define FLAT_BARRIER 0
#endif
#define SEAM(k) do { if (IN(k) && IN((k) + 1)) { ++bseq; if (FLAT_BARRIER) flat_barrier_work((unsigned*)(ws + WS_CTL) + CW_FLAT, args, lds, wave, lane, cv_n, MISC + 12, bseq); else xcd_barrier_work(bar, args, lds, wave, lane, cv_n, MISC + 12, bseq); } } while (0)
#define PHASE(k, ...) if (IN(k)) { __VA_ARGS__; if ((REPMASK >> (k)) & 1ull) { __syncthreads(); __VA_ARGS__; } } SEAM(k);
    typedef pg8::bf16_t pbf;

    const bool merge_pro = false && (G >= 32) && IN(PH_PRO) && IN(PH_NORM0);
    if (IN(PH_PRO)) { p_mods(args, lds, tid, lane, wave); p_weights(args, lds, lane, wave); if (merge_pro) wait_mods0(args, tid); }
    if (!merge_pro) SEAM(PH_PRO);
    const bool ctx_early = SPLIT_IN && (G == 256);
    PHASE(PH_NORM0, {
        if (ctx_early && bid < 24) {
            const int cb = bid / 12, cj = bid % 12;
            p_norm0(args, lane, wave, NWAVES, NTOK + cb * CTXL, NTOK + cb * CTXL + CTXL);
            VM_WAIT(); __syncthreads();
            if (cj < 8) {
                pg8::Gemm g{(const pbf*)(ws + WS_H8), (const pbf*)(ws + WS_WIN8), D / 2, 0};
                pg8::OneUnit S1{NTOK / 256 + cb, cj};
                pg8::EpiHgrnIn E{(pbf*)(ws + WS_Q), (WS_V - WS_Q) / 2, (_Float16*)(ws + WS_LFF), (WS_LFB - WS_LFF) / 2, args.in[I_HGAMMA], 2};
                pg8::gemm_phase<pg8::EpiHgrnIn, pg8::OneUnit, true, true, true, 0x79797979, 0x7F7F7F7F>(lds + RING_OFF, g, S1, E);
            } else {
                pg8::Gemm g{(const pbf*)(ws + WS_H), (const pbf*)(ws + WS_WIN), D, 0};
                pg8::OneUnit S1{NTOK / 256 + cb, 4 + (cj - 8)};
                pg8::EpiHgrnIn E{(pbf*)(ws + WS_Q), (WS_V - WS_Q) / 2, (_Float16*)(ws + WS_LFF), (WS_LFB - WS_LFF) / 2, args.in[I_HGAMMA], 1};
                pg8::gemm_phase<pg8::EpiHgrnIn, pg8::OneUnit, true, true, false>(lds + RING_OFF, g, S1, E);
            }
        } else if (ctx_early) p_norm0(args, lane, (bid - 24) * NWAVES + wave, (G - 24) * NWAVES, 0, NTOK);
        else p_norm0(args, lane, bid * NWAVES + wave, G * NWAVES, 0, MROWS);
    })
    PHASE(PH_INPROJ, {
        static_assert(WS_V - WS_Q == WS_SG - WS_V, "Q|V|SG equally spaced");
        if (SPLIT_IN) {
            const int nMi = ctx_early ? NTOK / 256 : MROWS / 256;
            {
                pg8::Gemm g{(const pbf*)(ws + WS_H8), (const pbf*)(ws + WS_WIN8), D / 2, 0};
                pg8::TileOrder S; S.init(nMi, 2 * D / 256, G, bid, nullptr);
                pg8::EpiHgrnIn E{(pbf*)(ws + WS_Q), (WS_V - WS_Q) / 2, (_Float16*)(ws + WS_LFF), (WS_LFB - WS_LFF) / 2, args.in[I_HGAMMA], 2};
                pg8::gemm_phase<pg8::EpiHgrnIn, pg8::TileOrder, true, true, true, 0x79797979, 0x7F7F7F7F>(lds + RING_OFF, g, S, E);
            }
            {
                pg8::Gemm g{(const pbf*)(ws + WS_H), (const pbf*)(ws + WS_WIN), D, 0};
                pg8::TileOrder S; S.init(nMi, 3 * D / 256, G, bid, nullptr);
                pg8::EpiHgrnIn E{(pbf*)(ws + WS_Q), (WS_V - WS_Q) / 2, (_Float16*)(ws + WS_LFF), (WS_LFB - WS_LFF) / 2, args.in[I_HGAMMA], 1};
                pg8::gemm_phase<pg8::EpiHgrnIn, pg8::TileOrder, true, true, false>(lds + RING_OFF, g, S, E);
            }
        } else {
            pg8::Gemm g{(const pbf*)(ws + WS_H), (const pbf*)(ws + WS_WIN), F8_IN ? D / 2 : D, 0};
            pg8::TileOrder S; S.init(MROWS / 256, 5 * D / 256, G, bid, nullptr);
            pg8::EpiHgrnIn E{(pbf*)(ws + WS_Q), (WS_V - WS_Q) / 2, (_Float16*)(ws + WS_LFF), (WS_LFB - WS_LFF) / 2, args.in[I_HGAMMA], 0};
            pg8::gemm_phase<pg8::EpiHgrnIn, pg8::TileOrder, true, true, F8_IN != 0, 0x79797979, 0x7F7F7F7F>(lds + RING_OFF, g, S, E);
        }
    })
#if SCAN_NAIVE
    PHASE(PH_SCANA, { p_scan_naive(args, lds, tid); })
    PHASE(PH_SCANC, { })
#else
    PHASE(PH_SCANA, { p_scan_a(args, lds, tid, lane, wave); })
    PHASE(PH_SCANC, { p_scan_c(args, lds, tid, lane, wave); })
#endif
    PHASE(PH_READOUT, { p_readout(args, lane, wave); })
    PHASE(PH_OUTPROJ, {
        pg8::Gemm g{(const pbf*)(ws + WS_YIN), (const pbf*)(ws + WS_WOUT), F8_MISC ? D / 2 : D, 0};
        pg8::TileOrder S; S.init(NTOK / 256, D / 256, G, bid, nullptr);
        pg8::EpiResGate<false, true> E{args.in[I_X], (void*)(ws + WS_X), (const float*)(ws + WS_MODS) + 2 * D, 6 * D, SEQ, nullptr};
        pg8::gemm_phase<pg8::EpiResGate<false, true>, pg8::TileOrder, true, true, F8_MISC != 0, 0x79797979, 0x7D7D7D7D>(lds + RING_OFF, g, S, E);
    })
#ifndef MOE_HANDOFF
#define MOE_HANDOFF 1
#endif
#define MOE_PHASES(l, pb) \
    if (IN(pb + 0)) { p_router(args, lds, l, tid, lane, wave); cv_finish(args, lds, wave, lane, cv_n, (l + 1) * CV_L0); } SEAM(pb + 0); \
    if (IN(pb + 1) || IN(pb + 2) || IN(pb + 3)) { \
        moe_tables(args, lds, l, tid); \
        LAS int* tab = (LAS int*)(lds + EXTRA_OFF + 640); \
        const LAS int* s_tb = (const LAS int*)(lds + EXTRA_OFF + 256); const LAS int* s_ce = s_tb + 40; \
        const int ntiles = __builtin_amdgcn_readfirstlane(s_tb[32]); \
        const bool hand = MOE_HANDOFF && (G == 256) && IN(pb + 1) && IN(pb + 2) && !((REPMASK >> (pb + 1)) & 3ull); \
        unsigned* tcnt = (unsigned*)(ws + WS_CTL) + CW_TCNT + l * 32768; \
        const int c2 = hand ? ((bid - ((((ntiles * 8) & 255) + 7) & ~7)) & 255) : bid;     \
        if (IN(pb + 1)) { \
            LAS unsigned short* tt = (LAS unsigned short*)(lds + EXTRA_OFF + 2816);     \
            pg8::MoeOrder S; S.init(ntiles, 2 * D / 256, G, bid, tab); S.cnt = tcnt; S.rdy = 0u; S.mode = hand ? 0 : 2; \
            { const int* STOK = (const int*)(ws + WS_STOK); pg8::Unit uu; for (int i = 0; S.next(i, uu); ++i) if (tid < 256) { const int vi = (uu.pm - s_tb[uu.e]) * 256 + tid; tt[i * 256 + tid] = vi < s_ce[uu.e] ? (unsigned short)STOK[(size_t)uu.e * NTOK + vi] : (unsigned short)0; } } \
            __syncthreads(); \
            pg8::Gemm g{(const pbf*)(ws + WS_H), (const pbf*)(ws + WS_W1 + (size_t)l * NE * 2 * D * D), D / 2, (size_t)2 * D * D, tt};   \
            pg8::EpiPair<0, true, 4, true> E{(pbf*)(ws + WS_ACT), args.in[I_BE1] + (size_t)l * NE * 2 * D}; \
            pg8::gemm_phase<pg8::EpiPair<0, true, 4, true>, pg8::MoeOrder, true, true, true, 0x79797979, 0x7F7F7F7F, true>(lds + RING_OFF, g, S, E); \
            if ((REPMASK >> (pb + 1)) & 1ull) { __syncthreads(); pg8::gemm_phase<pg8::EpiPair<0, true, 4, true>, pg8::MoeOrder, true, true, true, 0x79797979, 0x7F7F7F7F, true>(lds + RING_OFF, g, S, E); } \
        } \
        unsigned rdy = 0u; \
        if (hand) {                                                          \
            if (wave == 0) { \
                pg8::TileOrder T; T.init(ntiles, D / 256, G, c2, nullptr); pg8::Unit uu; const bool has = T.next(lane, uu); \
                const unsigned v = has ? __hip_atomic_load(tcnt + 32 * uu.pm, __ATOMIC_RELAXED, __HIP_MEMORY_SCOPE_AGENT) : 64u; \
                const unsigned long long m = __ballot(v >= 64u); \
                __builtin_amdgcn_fence(__ATOMIC_ACQUIRE, "agent"); asm volatile("s_waitcnt vmcnt(0)" ::: "memory"); \
                if (lane == 0) MISC[16] = (unsigned)m; \
            } \
            __syncthreads(); \
            rdy = __builtin_amdgcn_readfirstlane(MISC[16]); \
        } else SEAM(pb + 1); \
        PHASE(pb + 2, { \
            pg8::Gemm g{(const pbf*)(ws + WS_ACT), (const pbf*)(ws + WS_W2 + (size_t)l * NE * D * D), D / 2, (size_t)D * D}; \
            pg8::MoeOrder S; S.init(ntiles, D / 256, G, c2, tab); S.cnt = tcnt; S.rdy = rdy; S.mode = hand ? 1 : 2; \
            pg8::EpiMoeOut<F8_Y != 0, YSCALE> E{(pbf*)(ws + WS_YS), args.in[I_BE2] + (size_t)l * NE * D}; \
            pg8::gemm_phase<pg8::EpiMoeOut<F8_Y != 0, YSCALE>, pg8::MoeOrder, true, true, true, 0x79797979, 0x7D7D7D7D>(lds + RING_OFF, g, S, E);   \
        }) \
    }
    MOE_PHASES(0, PH_ROUTER0)
    PHASE(PH_COMB0, { p_combine<false>(args, lds, 0, lane, wave); })
    PHASE(PH_CVIN, {
        pg8::Gemm g{(const pbf*)(ws + WS_H), (const pbf*)(ws + WS_WCVIN), F8_MISC ? D / 2 : D, 0};
        pg8::TileOrder S; S.init(NTOK / 256, 2 * D / 256, G, bid, nullptr);
        pg8::EpiPair<1> E{(pbf*)(ws + WS_U), args.in[I_BCVIN]};
        pg8::gemm_phase<pg8::EpiPair<1>, pg8::TileOrder, true, true, F8_MISC != 0, 0x79797979, 0x7F7F7F7F>(lds + RING_OFF, g, S, E);
    })
    PHASE(PH_DWCONV, { p_dwconv(args, tid); })
    PHASE(PH_LN, { p_ln_silu(args, lane, wave); })
    PHASE(PH_CVOUT, {
        pg8::Gemm g{(const pbf*)(ws + WS_Z), (const pbf*)(ws + WS_WCVOUT), F8_MISC ? D / 2 : D, 0};
        pg8::TileOrder S; S.init(NTOK / 256, D / 256, G, bid, nullptr);
        pg8::EpiResGate<true, true> E{(const void*)(ws + WS_X), (void*)(ws + WS_X), (const float*)(ws + WS_MODS) + 3 * 6 * D + 2 * D, 6 * D, SEQ, args.in[I_BCVOUT]};
        pg8::gemm_phase<pg8::EpiResGate<true, true>, pg8::TileOrder, true, true, F8_MISC != 0, 0x79797979, 0x7D7D7D7D>(lds + RING_OFF, g, S, E);
    })
    MOE_PHASES(1, PH_ROUTER1)
    if (IN(PH_FINAL)) { p_combine<true>(args, lds, 1, lane, wave); }
#undef MOE_PHASES
#undef PHASE
#undef IN
#undef SEAM
}

extern "C" void kernel_launch(void* const* d_in, const int* in_sizes, int n_in, void* d_out, int out_size, void* d_ws, size_t ws_size, hipStream_t stream) {
    static int grid = 0;
    if (grid == 0) {
        if (n_in != N_IN || in_sizes[0] != NTOK * D || out_size != NTOK * D || ws_size < WS_END) { fprintf(stderr, "kernel_launch: unexpected shapes / workspace (n_in %d, in0 %d, out %d, ws %zu, need %zu); nothing launched\n", n_in, n_in > 0 ? in_sizes[0] : -1, out_size, ws_size, (size_t)WS_END); grid = -1; return; }
        int dev = 0, cus = 0, per_cu = 0;
        if (hipGetDevice(&dev) != hipSuccess || hipDeviceGetAttribute(&cus, hipDeviceAttributeMultiprocessorCount, dev) != hipSuccess) { grid = -1; return; }
        if (hipFuncSetAttribute((const void*)fwd_kernel, hipFuncAttributeMaxDynamicSharedMemorySize, LDS_BYTES) != hipSuccess) { fprintf(stderr, "kernel_launch: hipFuncSetAttribute failed\n"); grid = -1; return; }
        if (hipOccupancyMaxActiveBlocksPerMultiprocessor(&per_cu, (const void*)fwd_kernel, NTHR, LDS_BYTES) != hipSuccess || per_cu < 1) { fprintf(stderr, "kernel_launch: occupancy query reports %d workgroups per CU\n", per_cu); }
        (void)hipGetLastError();
        grid = cus;
    }
    if (grid < 0) return;
    if (hipMemsetAsync((char*)d_ws + WS_CTL, 0, CTL_ZERO_BYTES, stream) != hipSuccess) return;
#ifdef DIAG_MEMSET
    (void)hipMemsetAsync((char*)d_ws + WS_SP, 0, (WS_WIN - WS_SP), stream); (void)hipMemsetAsync((char*)d_ws + WS_OF, 0, (WS_YIN - WS_OF), stream);
#endif
    Args a{};
    for (int i = 0; i < N_IN; ++i) a.in[i] = (const float*)d_in[i];
    a.out = (float*)d_out; a.ws = (unsigned char*)d_ws; a.pad = 0;
#ifndef MK_CUTS
    a.ph_lo = 0; a.ph_hi = NPH; a.li = 0;
    hipLaunchKernelGGL(fwd_kernel, dim3(grid), dim3(NTHR), LDS_BYTES, stream, a);
#else
    const int cuts[] = {MK_CUTS};
    const int nc = (int)(sizeof(cuts) / sizeof(cuts[0]));
    for (int li = 0; li + 1 < nc; ++li) { a.ph_lo = cuts[li]; a.ph_hi = cuts[li + 1]; a.li = li; hipLaunchKernelGGL(fwd_kernel, dim3(grid), dim3(NTHR), LDS_BYTES, stream, a); }
#endif
}
```

```cpp
#include <hip/hip_runtime.h>
#include <cstdio>
#include <cstdint>

namespace pg8 {
#define PG8_LAS __attribute__((address_space(3)))
typedef unsigned short bf16_t;
typedef short bf16x8 __attribute__((ext_vector_type(8)));
typedef float f32x4 __attribute__((ext_vector_type(4)));
typedef unsigned u32x4 __attribute__((ext_vector_type(4)));
typedef unsigned u32x2 __attribute__((ext_vector_type(2)));
typedef int i32x4 __attribute__((ext_vector_type(4)));
typedef int i32x8 __attribute__((ext_vector_type(8)));
constexpr int BM = 256, BK = 64, HALF = 128, HTB = HALF * BK * 2  , STAGE_BYTES = 8 * HTB, NXCD = 8, WGM = 8;

__host__ __device__ __forceinline__ int lds_byte(int r, int c) { const int st = (r >> 4) * 2 + (c >> 5), rr = r & 15, cc = c & 31, ob = rr * 64 + cc * 2; return st * 1024 + (ob ^ (((ob >> 9) & 1) << 5)); }
__host__ __device__ __forceinline__ void stage_rc(int b, int& R, int& C) { const int st = b / 1024, sb = b % 1024, swz = sb ^ (((sb >> 9) & 1) << 5); R = (st >> 1) * 16 + swz / 64; C = (st & 1) * 32 + (swz % 64) / 2; }
__host__ __device__ __forceinline__ int perm32(int rho) { const int n = rho >> 4, i = rho & 15; return 8 * (i >> 2) + 4 * n + (i & 3); }

struct Unit { int pm, pn, e; };
struct Gemm { const bf16_t* A; const bf16_t* Bt; int K; size_t estride; const PG8_LAS unsigned short* tt; };

struct TileOrder {
    int nM, nN, nwg, G, c; const PG8_LAS int* tile_e;
    __device__ __forceinline__ void init(int nM_, int nN_, int G_, int c_, const PG8_LAS int* te) { nM = nM_; nN = nN_; nwg = nM * nN; G = G_; c = c_; tile_e = te; }
    __device__ __forceinline__ bool next(int i, Unit& u) const {
        const long L = (long)i * G + c; if (L >= nwg) return false;
        int wgid = (int)L; { const int q = nwg / NXCD, r = nwg % NXCD, xcd = wgid % NXCD, off = wgid / NXCD; wgid = (xcd < r ? xcd * (q + 1) : r * (q + 1) + (xcd - r) * q) + off; }
        const int nig = WGM * nN, gid = wgid / nig, fm = gid * WGM, gsz = (nM - fm) < WGM ? (nM - fm) : WGM;
        u.pm = fm + ((wgid % nig) % gsz); u.pn = (wgid % nig) / gsz;
        u.e = tile_e ? __builtin_amdgcn_readfirstlane(tile_e[u.pm]) : 0; return true;
    }
    static constexpr bool PUBLISH = false;
    __device__ __forceinline__ void a_ready(const Unit&, int) const {}
    __device__ __forceinline__ void done(const Unit&) const {}
    __device__ __forceinline__ void publish(int, int) const {}
};

struct MoeOrder : TileOrder {
    static constexpr bool PUBLISH = true;
    unsigned* cnt; unsigned rdy; int mode;
    __device__ __forceinline__ void publish(int pm, int lane) const {
        if (mode == 0 && lane == 0) (void)__hip_atomic_fetch_add(cnt + 32 * pm, 1u, __ATOMIC_RELAXED, __HIP_MEMORY_SCOPE_AGENT);
    }
    __device__ __forceinline__ void a_ready(const Unit& u, int i) const {
        if (mode != 1 || ((rdy >> i) & 1u)) return;
        if (__builtin_amdgcn_readfirstlane(threadIdx.x >> 6) == 0) {
            unsigned sp = 0;
            while (__hip_atomic_load(cnt + 32 * u.pm, __ATOMIC_RELAXED, __HIP_MEMORY_SCOPE_AGENT) < 64u) { __builtin_amdgcn_s_sleep(1); if (++sp > (1u << 20)) break; }
            __builtin_amdgcn_fence(__ATOMIC_ACQUIRE, "agent");
            asm volatile("s_waitcnt vmcnt(0)" ::: "memory");
        }
        __builtin_amdgcn_s_barrier();
    }
};

struct OneUnit {
    int pm, pn;
    __device__ __forceinline__ bool next(int i, Unit& u) const { if (i != 0) return false; u.pm = pm; u.pn = pn; u.e = 0; return true; }
    static constexpr bool PUBLISH = false;
    __device__ __forceinline__ void a_ready(const Unit&, int) const {}
    __device__ __forceinline__ void done(const Unit&) const {}
    __device__ __forceinline__ void publish(int, int) const {}
};

__device__ __forceinline__ unsigned cvt_pk_bf16(float lo, float hi) { unsigned r; asm volatile("v_cvt_pk_bf16_f32 %0, %1, %2" : "=v"(r) : "v"(lo), "v"(hi)); return r; }
__device__ __forceinline__ float fsigmoid(float x) { return __builtin_amdgcn_rcpf(1.0f + __expf(-x)); }


struct EpiHgrnIn {
    static constexpr bool PERM = true, AFTER_DRAIN = false;
    bf16_t* Q; size_t qstride; _Float16* LFF; size_t lfstride; const float* gamma; int mode;
    static __device__ __forceinline__ f32x4 vexp2(f32x4 t) { f32x4 e; e[0] = __builtin_amdgcn_exp2f(t[0]); e[1] = __builtin_amdgcn_exp2f(t[1]); e[2] = __builtin_amdgcn_exp2f(t[2]); e[3] = __builtin_amdgcn_exp2f(t[3]); return e; }
    static __device__ __forceinline__ f32x4 vrcp(f32x4 d) { f32x4 r; r[0] = __builtin_amdgcn_rcpf(d[0]); r[1] = __builtin_amdgcn_rcpf(d[1]); r[2] = __builtin_amdgcn_rcpf(d[2]); r[3] = __builtin_amdgcn_rcpf(d[3]); return r; }
    static __device__ __forceinline__ f32x4 vlog2(f32x4 d) { f32x4 r; r[0] = __builtin_amdgcn_logf(d[0]); r[1] = __builtin_amdgcn_logf(d[1]); r[2] = __builtin_amdgcn_logf(d[2]); r[3] = __builtin_amdgcn_logf(d[3]); return r; }
    __device__ __forceinline__ void operator()(const f32x4 (&acc)[2][2][4][2], const Unit& u, int wr, int wc, int fr, int fq) const {
        const int sg_ = u.pn >> 2, seg = mode == 0 ? sg_ : (mode == 1 ? (sg_ < 2 ? sg_ : 4) : 2 + sg_), cb = (u.pn & 3) * 256 + wc * 32 + 8 * fq;
        const int row0 = u.pm * BM + wr * 64 + fr;
        if (seg == 2 || seg == 3) {
            _Float16* O = LFF + (size_t)(seg - 2) * lfstride; const float* g0 = gamma + (seg - 2) * 2048 + cb;
            f32x4 lb[2][2];
#pragma unroll
            for (int bj = 0; bj < 2; ++bj)
#pragma unroll
                for (int n = 0; n < 2; ++n) { const f32x4 d = *(const f32x4*)(g0 + bj * HALF + 4 * n) - *(const f32x4*)(g0 + 1024 + bj * HALF + 4 * n);
                    lb[bj][n] = vrcp(vexp2(d * -1.4426950408889634f) + 1.0f); }
#pragma unroll
            for (int ai = 0; ai < 2; ++ai)
#pragma unroll
                for (int m = 0; m < 4; ++m) { _Float16* rowp = O + (size_t)(row0 + ai * HALF + m * 16) * 1024 + cb;
#pragma unroll
                    for (int bj = 0; bj < 2; ++bj) { typedef _Float16 h16x8 __attribute__((ext_vector_type(8))); h16x8 o;
#pragma unroll
                        for (int n = 0; n < 2; ++n) { const f32x4 sg = vrcp(vexp2(acc[ai][bj][m][n] * -1.4426950408889634f) + 1.0f);
                            const f32x4 lf = vlog2(lb[bj][n] + (1.0f - lb[bj][n]) * sg) * 0.6931471805599453f;
                            o[4 * n + 0] = (_Float16)lf[0]; o[4 * n + 1] = (_Float16)lf[1]; o[4 * n + 2] = (_Float16)lf[2]; o[4 * n + 3] = (_Float16)lf[3]; }
                        *(h16x8*)(rowp + bj * HALF) = o; } }
        } else {
            bf16_t* O = Q + (size_t)(seg - (seg >> 2) * 2) * qstride;
#pragma unroll
            for (int ai = 0; ai < 2; ++ai)
#pragma unroll
                for (int m = 0; m < 4; ++m) { bf16_t* rowp = O + (size_t)(row0 + ai * HALF + m * 16) * 1024 + cb;
#pragma unroll
                    for (int bj = 0; bj < 2; ++bj) { f32x4 v0 = acc[ai][bj][m][0], v1 = acc[ai][bj][m][1];
                        if (seg == 4) { v0 = v0 * vrcp(vexp2(v0 * -1.4426950408889634f) + 1.0f); v1 = v1 * vrcp(vexp2(v1 * -1.4426950408889634f) + 1.0f); }
                        u32x4 w; w.x = cvt_pk_bf16(v0[0], v0[1]); w.y = cvt_pk_bf16(v0[2], v0[3]); w.z = cvt_pk_bf16(v1[0], v1[1]); w.w = cvt_pk_bf16(v1[2], v1[3]);
                        *(u32x4*)(rowp + bj * HALF) = w; } }
        }
    }
};
template <bool BASE16, bool OUT16> struct EpiResGate {
    static constexpr bool PERM = false, AFTER_DRAIN = false;
    const void* base; void* out; const float* gate; int gate_bstride; int rows_per_batch; const float* bias;
    __device__ __forceinline__ void operator()(const f32x4 (&acc)[2][2][4][2], const Unit& u, int wr, int wc, int fr, int fq) const {
        const int row0 = u.pm * BM + wr * 64 + fr, col0 = u.pn * BM + wc * 32 + 4 * fq;
        const float* gv_ = gate + (size_t)((u.pm * BM) / rows_per_batch) * gate_bstride;
        f32x4 gv[2][2], bv[2][2];
#pragma unroll
        for (int bj = 0; bj < 2; ++bj)
#pragma unroll
            for (int n = 0; n < 2; ++n) { gv[bj][n] = *(const f32x4*)(gv_ + col0 + bj * HALF + n * 16); bv[bj][n] = bias ? *(const f32x4*)(bias + col0 + bj * HALF + n * 16) : (f32x4){0.f, 0.f, 0.f, 0.f}; }
#pragma unroll
        for (int ai = 0; ai < 2; ++ai)
#pragma unroll
            for (int m = 0; m < 4; ++m) { const size_t off = (size_t)(row0 + ai * HALF + m * 16) * 1024 + col0;
#pragma unroll
                for (int bj = 0; bj < 2; ++bj)
#pragma unroll
                    for (int n = 0; n < 2; ++n) { const size_t o = off + bj * HALF + n * 16; f32x4 bs;
                        if constexpr (BASE16) { const u32x2 w = *(const u32x2*)((const bf16_t*)base + o); bs = (f32x4){__builtin_bit_cast(float, w.x << 16), __builtin_bit_cast(float, w.x & 0xffff0000u), __builtin_bit_cast(float, w.y << 16), __builtin_bit_cast(float, w.y & 0xffff0000u)}; }
                        else bs = *(const f32x4*)((const float*)base + o);
                        const f32x4 r = bs + gv[bj][n] * (acc[ai][bj][m][n] + bv[bj][n]);
                        if constexpr (OUT16) *(u32x2*)((bf16_t*)out + o) = (u32x2){cvt_pk_bf16(r[0], r[1]), cvt_pk_bf16(r[2], r[3])};
                        else *(f32x4*)((float*)out + o) = r; } }
    }
};
template <int MODE, bool OUT8 = false, int OSCALE = 1, bool WT = false> struct EpiPair {
    static constexpr bool PERM = true, AFTER_DRAIN = false;
    bf16_t* O; const float* bias0;
    static __device__ __forceinline__ f32x4 vsig(f32x4 x, float negscale) {
        const f32x4 t = x * negscale; f32x4 e; e[0] = __builtin_amdgcn_exp2f(t[0]); e[1] = __builtin_amdgcn_exp2f(t[1]); e[2] = __builtin_amdgcn_exp2f(t[2]); e[3] = __builtin_amdgcn_exp2f(t[3]);
        const f32x4 d = e + 1.0f; f32x4 r; r[0] = __builtin_amdgcn_rcpf(d[0]); r[1] = __builtin_amdgcn_rcpf(d[1]); r[2] = __builtin_amdgcn_rcpf(d[2]); r[3] = __builtin_amdgcn_rcpf(d[3]); return r; }
    __device__ __forceinline__ void operator()(const f32x4 (&acc)[2][2][4][2], const Unit& u, int wr, int wc, int fr, int fq) const {
        const float* bias = bias0 + (MODE == 0 ? (size_t)u.e * 2048 : 0);
        const int row0 = u.pm * BM + wr * 64 + fr, cg = u.pn * HALF + wc * 32 + 8 * fq;
        f32x4 b0[2], b1[2];
#pragma unroll
        for (int n = 0; n < 2; ++n) { b0[n] = *(const f32x4*)(bias + cg + 4 * n); b1[n] = *(const f32x4*)(bias + 1024 + cg + 4 * n); }
#pragma unroll
        for (int ai = 0; ai < 2; ++ai)
#pragma unroll
            for (int m = 0; m < 4; ++m) { bf16_t* rowp = O + (size_t)(row0 + ai * HALF + m * 16) * 1024 + cg; f32x4 r[2];
#pragma unroll
                for (int n = 0; n < 2; ++n) { const f32x4 g = acc[ai][0][m][n] + b0[n], up = acc[ai][1][m][n] + b1[n];
                    if (MODE == 0) { const f32x4 gg = __builtin_elementwise_min(g, (f32x4){7.0f, 7.0f, 7.0f, 7.0f});
                        const f32x4 uu = __builtin_elementwise_min(__builtin_elementwise_max(up, (f32x4){-7.0f, -7.0f, -7.0f, -7.0f}), (f32x4){7.0f, 7.0f, 7.0f, 7.0f});
                        r[n] = (uu * (float)OSCALE + (float)OSCALE) * (gg * vsig(gg, -1.702f * 1.4426950408889634f)); }
                    else r[n] = (g * (float)OSCALE) * vsig(up, -1.4426950408889634f); }
                if constexpr (OUT8) {
                    int w0 = 0, w1 = 0;
                    w0 = __builtin_amdgcn_cvt_pk_fp8_f32(r[0][0], r[0][1], w0, false); w0 = __builtin_amdgcn_cvt_pk_fp8_f32(r[0][2], r[0][3], w0, true);
                    w1 = __builtin_amdgcn_cvt_pk_fp8_f32(r[1][0], r[1][1], w1, false); w1 = __builtin_amdgcn_cvt_pk_fp8_f32(r[1][2], r[1][3], w1, true);
                    if constexpr (WT) __hip_atomic_store((unsigned long long*)((unsigned char*)O + (size_t)(row0 + ai * HALF + m * 16) * 1024 + cg), ((unsigned long long)(unsigned)w1 << 32) | (unsigned)w0, __ATOMIC_RELAXED, __HIP_MEMORY_SCOPE_AGENT);
                    else *(u32x2*)((unsigned char*)O + (size_t)(row0 + ai * HALF + m * 16) * 1024 + cg) = (u32x2){(unsigned)w0, (unsigned)w1};
                } else {
                u32x4 w; w.x = cvt_pk_bf16(r[0][0], r[0][1]); w.y = cvt_pk_bf16(r[0][2], r[0][3]); w.z = cvt_pk_bf16(r[1][0], r[1][1]); w.w = cvt_pk_bf16(r[1][2], r[1][3]);
                *(u32x4*)rowp = w; } }
    }
};
template <bool OUT8, int OSCALE> struct EpiMoeOut {
    static constexpr bool PERM = true, AFTER_DRAIN = false;
    bf16_t* O; const float* bias0;
    __device__ __forceinline__ void operator()(const f32x4 (&acc)[2][2][4][2], const Unit& u, int wr, int wc, int fr, int fq) const {
        const float* bias = bias0 + (size_t)u.e * 1024;
        const int row0 = u.pm * BM + wr * 64 + fr, col0 = u.pn * BM + wc * 32 + 8 * fq;
        f32x4 bv[2][2];
#pragma unroll
        for (int bj = 0; bj < 2; ++bj)
#pragma unroll
            for (int n = 0; n < 2; ++n) bv[bj][n] = *(const f32x4*)(bias + col0 + bj * HALF + 4 * n);
#pragma unroll
        for (int ai = 0; ai < 2; ++ai)
#pragma unroll
            for (int m = 0; m < 4; ++m) { const int r = row0 + ai * HALF + m * 16;
#pragma unroll
                for (int bj = 0; bj < 2; ++bj) { const f32x4 v0 = acc[ai][bj][m][0] + bv[bj][0], v1 = acc[ai][bj][m][1] + bv[bj][1];
                    if constexpr (OUT8) { const f32x4 lim = (f32x4){448.0f, 448.0f, 448.0f, 448.0f};
                        const f32x4 s0 = __builtin_elementwise_min(__builtin_elementwise_max(v0 * (float)OSCALE, -lim), lim), s1 = __builtin_elementwise_min(__builtin_elementwise_max(v1 * (float)OSCALE, -lim), lim); int w0 = 0, w1 = 0;
                        w0 = __builtin_amdgcn_cvt_pk_fp8_f32(s0[0], s0[1], w0, false); w0 = __builtin_amdgcn_cvt_pk_fp8_f32(s0[2], s0[3], w0, true);
                        w1 = __builtin_amdgcn_cvt_pk_fp8_f32(s1[0], s1[1], w1, false); w1 = __builtin_amdgcn_cvt_pk_fp8_f32(s1[2], s1[3], w1, true);
                        *(u32x2*)((unsigned char*)O + (size_t)r * 1024 + col0 + bj * HALF) = (u32x2){(unsigned)w0, (unsigned)w1};
                    } else { u32x4 w; w.x = cvt_pk_bf16(v0[0], v0[1]); w.y = cvt_pk_bf16(v0[2], v0[3]); w.z = cvt_pk_bf16(v1[0], v1[1]); w.w = cvt_pk_bf16(v1[2], v1[3]);
                        *(u32x4*)(O + (size_t)r * 1024 + col0 + bj * HALF) = w; } } }
    }
};

template <class Epi, class Sched, bool ALIGN_EPI = false, bool SP2 = false, bool F8 = false, int SCW = 0x7F7F7F7F, int SCA = 0x7F7F7F7F, bool GATHER = false, int NS = 0>
__device__ __forceinline__ void gemm_phase(PG8_LAS unsigned char* lds, const Gemm g, const Sched& S, const Epi& E) {
    const int tid = threadIdx.x, wid = __builtin_amdgcn_readfirstlane(tid >> 6), lane = tid & 63, wr = wid >> 2, wc = wid & 3, fr = lane & 15, fq = lane >> 4;
    const int K = g.K, nt = K / BK;
    unsigned voffA[2], voffB[2]; int stR[2], stC[2];
#pragma unroll
    for (int i = 0; i < 2; ++i) { int R, C; stage_rc(tid * 16 + i * 8192, R, C); const int Rb = Epi::PERM ? ((R & ~31) + perm32(R & 31)) : R; stR[i] = R; stC[i] = C;
        voffA[i] = (unsigned)(R * K + C) * 2u; voffB[i] = (unsigned)(Rb * K + C) * 2u; }
    const size_t kstep = (size_t)(BK * 2);
    const size_t hstep = (size_t)HALF * K * 2;
    const size_t tstep = 2 * hstep;
    unsigned vc[2][2], vn[2][2];
#pragma unroll
    for (int h = 0; h < 2; ++h)
#pragma unroll
        for (int i = 0; i < 2; ++i) {
            if constexpr (GATHER) vc[h][i] = (unsigned)g.tt[h * HALF + stR[i]] * (unsigned)(K * 2) + (unsigned)stC[i] * 2u;
            else vc[h][i] = voffA[i] + (unsigned)h * (unsigned)hstep;
            vn[h][i] = vc[h][i]; }
    const unsigned ldsw = (unsigned)wid * 1024u;
    const int aoff = lds_byte(wr * 64 + fr, fq * 8), boff = lds_byte(wc * 32 + fr, fq * 8);
#define PG8_SA(b, h) (((b) * 2 + (h)) * HTB)
#define PG8_SB(b, h) ((4 + (b) * 2 + (h)) * HTB)
#define PG8_STAGE(bufoff, gbase, voff) do { _Pragma("unroll") for (int _i = 0; _i < 2; ++_i) \
        __builtin_amdgcn_global_load_lds((const unsigned*)((const char*)(gbase) + (voff)[_i]), (PG8_LAS unsigned*)(lds + (bufoff) + ldsw + _i * 8192), 16, 0, 0); } while (0)
#define PG8_LDA(dst, b, h) do { _Pragma("unroll") for (int m = 0; m < 4; ++m) _Pragma("unroll") for (int k = 0; k < 2; ++k) dst[m][k] = *(const PG8_LAS bf16x8*)(lds + PG8_SA(b, h) + aoff + m * 2048 + k * 1024); } while (0)
#define PG8_LDB(dst, b, h) do { _Pragma("unroll") for (int n = 0; n < 2; ++n) _Pragma("unroll") for (int k = 0; k < 2; ++k) dst[n][k] = *(const PG8_LAS bf16x8*)(lds + PG8_SB(b, h) + boff + n * 2048 + k * 1024); } while (0)
#define PG8_MMA(ai, bj, At, Bt) do { __builtin_amdgcn_s_setprio(1); \
        if constexpr (!F8) { _Pragma("unroll") for (int m = 0; m < 4; ++m) _Pragma("unroll") for (int n = 0; n < 2; ++n) _Pragma("unroll") for (int k = 0; k < 2; ++k) \
            acc[ai][bj][m][n] = __builtin_amdgcn_mfma_f32_16x16x32_bf16(Bt[n][k], At[m][k], acc[ai][bj][m][n], 0, 0, 0); } \
        else { const int scw_ = SCW, sca_ = SCA; _Pragma("unroll") for (int m = 0; m < 4; ++m) _Pragma("unroll") for (int n = 0; n < 2; ++n) { \
            const i32x8 wf_ = __builtin_shufflevector(__builtin_bit_cast(i32x4, Bt[n][0]), __builtin_bit_cast(i32x4, Bt[n][1]), 0, 1, 2, 3, 4, 5, 6, 7); \
            const i32x8 af_ = __builtin_shufflevector(__builtin_bit_cast(i32x4, At[m][0]), __builtin_bit_cast(i32x4, At[m][1]), 0, 1, 2, 3, 4, 5, 6, 7); \
            asm volatile("v_mfma_scale_f32_16x16x128_f8f6f4 %0, %1, %2, %0, %3, %4 op_sel_hi:[0,0,0]" : "+v"(acc[ai][bj][m][n]) : "v"(wf_), "v"(af_), "v"(scw_), "v"(sca_)); } } \
        __builtin_amdgcn_s_setprio(0); } while (0)
#define PG8_WAIT_V(n) asm volatile("s_waitcnt vmcnt(" #n ")" ::: "memory")
#define PG8_WAIT_VN(n) asm volatile("s_waitcnt vmcnt(%0)" :: "n"(n) : "memory")
#define PG8_WAIT_L(n) asm volatile("s_waitcnt lgkmcnt(" #n ")" ::: "memory")
#define PG8_BAR __builtin_amdgcn_s_barrier()
#define PG8_SCHED __builtin_amdgcn_sched_barrier(0)
    Unit cur, nxt; int ui = 0, ppm = 0;
    if (!S.next(0, cur)) return;
    f32x4 acc[2][2][4][2];
#pragma unroll
    for (int a = 0; a < 2; ++a)
#pragma unroll
        for (int b = 0; b < 2; ++b)
#pragma unroll
            for (int m = 0; m < 4; ++m)
#pragma unroll
                for (int n = 0; n < 2; ++n) acc[a][b][m][n] = (f32x4){0.f, 0.f, 0.f, 0.f};
    bf16x8 At[4][2], B0[2][2], B1[2][2];
    const char* cA = (const char*)g.A + (GATHER ? (size_t)0 : (size_t)cur.pm * tstep); const char* cB = (const char*)g.Bt + (size_t)cur.e * g.estride + (size_t)cur.pn * tstep;
    S.a_ready(cur, 0);
    if constexpr (SP2) {
        PG8_STAGE(PG8_SB(0, 0), cB, voffB); PG8_STAGE(PG8_SB(0, 1), cB + hstep, voffB); PG8_STAGE(PG8_SA(0, 0), cA, vc[0]); PG8_STAGE(PG8_SA(0, 1), cA, vc[1]);
        if (wr == 1) PG8_BAR;
        PG8_WAIT_V(2); PG8_BAR;
        PG8_STAGE(PG8_SB(1, 0), cB + kstep, voffB); PG8_STAGE(PG8_SA(1, 0), cA + kstep, vc[0]); PG8_STAGE(PG8_SB(1, 1), cB + hstep + kstep, voffB);
        PG8_WAIT_V(6); PG8_BAR;
    } else {
        PG8_STAGE(PG8_SB(0, 0), cB, voffB); PG8_STAGE(PG8_SA(0, 0), cA, vc[0]); PG8_STAGE(PG8_SB(0, 1), cB + hstep, voffB); PG8_STAGE(PG8_SA(0, 1), cA, vc[1]);
        if (wr == 1) PG8_BAR;
        PG8_WAIT_V(4); PG8_BAR;
        PG8_STAGE(PG8_SB(1, 0), cB + kstep, voffB); PG8_STAGE(PG8_SA(1, 0), cA + kstep, vc[0]); PG8_STAGE(PG8_SB(1, 1), cB + hstep + kstep, voffB);
        PG8_WAIT_V(6); PG8_BAR;
    }
    for (;;) {
        const bool has_next = S.next(ui + 1, nxt);
        if constexpr (GATHER) { if (has_next) {
#pragma unroll
            for (int h = 0; h < 2; ++h)
#pragma unroll
                for (int i = 0; i < 2; ++i) vn[h][i] = (unsigned)g.tt[(ui + 1) * BM + h * HALF + stR[i]] * (unsigned)(K * 2) + (unsigned)stC[i] * 2u; } }
        const char* nA = (has_next && !GATHER) ? (const char*)g.A + (size_t)nxt.pm * tstep : cA; const char* nB = has_next ? (const char*)g.Bt + (size_t)nxt.e * g.estride + (size_t)nxt.pn * tstep : cB;
        for (int t = 0; t < nt; t += 2) {
            const bool last = (t == nt - 2);
            unsigned vs[2][2];
#pragma unroll
            for (int h = 0; h < 2; ++h)
#pragma unroll
                for (int i = 0; i < 2; ++i) vs[h][i] = (GATHER && last) ? vn[h][i] : vc[h][i];
            const char* a1 = cA + (size_t)(t + 1) * kstep;
            const char* a2 = last ? nA : cA + (size_t)(t + 2) * kstep; const char* b2 = last ? nB : cB + (size_t)(t + 2) * kstep;
            const char* a3 = a2 + kstep; const char* b3 = b2 + kstep;
            if (last && has_next) S.a_ready(nxt, ui + 1);
            if constexpr (Sched::PUBLISH) { if (t == 2 && ui > 0) S.publish(ppm, lane); }
            if constexpr (SP2) {
            const bool rlx = (NS > 0) && (t == 0) && (ui > 0);
#define PG8_WAIT_V8R do { if constexpr (NS > 0) { PG8_WAIT_VN(8 + NS); if (!rlx) PG8_WAIT_V(8); } else PG8_WAIT_V(8); } while (0)
            PG8_LDB(B0, 0, 0); PG8_LDB(B1, 0, 1); PG8_SCHED; PG8_LDA(At, 0, 0); if (!rlx) PG8_STAGE(PG8_SA(1, 1), a1, vc[1]);
            PG8_WAIT_V8R; PG8_WAIT_L(0); PG8_BAR; PG8_MMA(0, 0, At, B0); PG8_MMA(0, 1, At, B1); PG8_BAR; PG8_SCHED;
            PG8_LDA(At, 0, 1); PG8_STAGE(PG8_SB(0, 0), b2, voffB); PG8_STAGE(PG8_SB(0, 1), b2 + hstep, voffB); PG8_STAGE(PG8_SA(0, 0), a2, vs[0]);
            PG8_WAIT_V8R; PG8_WAIT_L(0); PG8_BAR; PG8_MMA(1, 0, At, B0); PG8_MMA(1, 1, At, B1); PG8_BAR; PG8_SCHED;
            PG8_LDB(B0, 1, 0); PG8_LDB(B1, 1, 1); PG8_SCHED; PG8_LDA(At, 1, 0); PG8_STAGE(PG8_SA(0, 1), a2, vs[1]);
            PG8_WAIT_V8R; PG8_WAIT_L(0); PG8_BAR; PG8_MMA(0, 0, At, B0); PG8_MMA(0, 1, At, B1); PG8_BAR; PG8_SCHED;
            PG8_LDA(At, 1, 1); PG8_STAGE(PG8_SB(1, 0), b3, voffB); PG8_STAGE(PG8_SB(1, 1), b3 + hstep, voffB); PG8_STAGE(PG8_SA(1, 0), a3, vs[0]);
            PG8_WAIT_V(8); PG8_WAIT_L(0); PG8_BAR; PG8_MMA(1, 0, At, B0); PG8_MMA(1, 1, At, B1); PG8_BAR; PG8_SCHED;
            } else {
            PG8_LDB(B0, 0, 0); PG8_SCHED; PG8_LDA(At, 0, 0); PG8_STAGE(PG8_SA(1, 1), a1, vc[1]);
            PG8_WAIT_L(8); PG8_BAR; PG8_WAIT_L(0); PG8_MMA(0, 0, At, B0); PG8_BAR; PG8_SCHED;
            PG8_LDB(B1, 0, 1); PG8_STAGE(PG8_SB(0, 0), b2, voffB);
            PG8_BAR; PG8_WAIT_L(0); PG8_MMA(0, 1, At, B1); PG8_BAR;
            PG8_LDA(At, 0, 1); PG8_STAGE(PG8_SA(0, 0), a2, vs[0]);
            PG8_BAR; PG8_WAIT_L(0); PG8_MMA(1, 0, At, B0); PG8_BAR; PG8_SCHED;
            PG8_STAGE(PG8_SB(0, 1), b2 + hstep, voffB);
            PG8_WAIT_V(6); PG8_BAR; PG8_MMA(1, 1, At, B1); PG8_BAR;
            PG8_LDB(B0, 1, 0); PG8_SCHED; PG8_LDA(At, 1, 0); PG8_STAGE(PG8_SA(0, 1), a2, vs[1]);
            PG8_WAIT_L(8); PG8_BAR; PG8_WAIT_L(0); PG8_MMA(0, 0, At, B0); PG8_BAR; PG8_SCHED;
            PG8_LDB(B1, 1, 1); PG8_STAGE(PG8_SB(1, 0), b3, voffB);
            PG8_BAR; PG8_WAIT_L(0); PG8_MMA(0, 1, At, B1); PG8_BAR;
            PG8_LDA(At, 1, 1); PG8_STAGE(PG8_SA(1, 0), a3, vs[0]);
            PG8_BAR; PG8_WAIT_L(0); PG8_MMA(1, 0, At, B0); PG8_BAR; PG8_SCHED;
            PG8_STAGE(PG8_SB(1, 1), b3 + hstep, voffB);
            PG8_WAIT_V(6); PG8_BAR; PG8_MMA(1, 1, At, B1); PG8_BAR;
            }
        }
        if constexpr (ALIGN_EPI) { if (wr == 0) PG8_BAR; }
        if constexpr (NS > 0) { static_assert(SP2 && ALIGN_EPI, "NS needs SP2 and ALIGN_EPI"); if (has_next) PG8_STAGE(PG8_SA(1, 1), nA + kstep, vn[1]); }
        if constexpr (!Epi::AFTER_DRAIN) { E(acc, cur, wr, wc, fr, fq); S.done(cur); ppm = cur.pm; }
        if (!has_next) break;
#pragma unroll
        for (int a = 0; a < 2; ++a)
#pragma unroll
            for (int b = 0; b < 2; ++b)
#pragma unroll
                for (int m = 0; m < 4; ++m)
#pragma unroll
                    for (int n = 0; n < 2; ++n) acc[a][b][m][n] = (f32x4){0.f, 0.f, 0.f, 0.f};
        cur = nxt; cA = nA; cB = nB; ++ui;
        if constexpr (GATHER) {
#pragma unroll
            for (int h = 0; h < 2; ++h)
#pragma unroll
                for (int i = 0; i < 2; ++i) vc[h][i] = vn[h][i]; }
        if constexpr (ALIGN_EPI) { if (wr == 1) PG8_BAR; }
    }
    PG8_WAIT_V(0); if constexpr (Sched::PUBLISH) S.publish(ppm, lane);
    if constexpr (!ALIGN_EPI) { if (wr == 0) PG8_BAR; }
    PG8_BAR;
    if constexpr (Epi::AFTER_DRAIN) { E.fused(acc, cur, wr, wc, fr, fq, lds, wid, lane); S.done(cur); }
#undef PG8_SA
#undef PG8_SB
#undef PG8_STAGE
#undef PG8_LDA
#undef PG8_LDB
#undef PG8_MMA
#undef PG8_WAIT_V
#undef PG8_WAIT_VN
#undef PG8_WAIT_V8R
#undef PG8_WAIT_L
#undef PG8_BAR
#undef PG8_SCHED
}
}


constexpr int D = 1024, NBATCH = 2, SEQ = 16384, NTOK = NBATCH * SEQ, CTXL = 256, NCTX = NBATCH * CTXL, MROWS = NTOK + NCTX;
constexpr int NHEAD = 8, DK = 128, NE = 32, TOPK = 4, CONVW = 31, GRIDW = 64, GRIDR = SEQ / GRIDW;
constexpr int NWAVES = 8, NTHR = NWAVES * 64;
constexpr int MAXTILES = 544;
constexpr float EPS = 1e-6f;
enum { I_X = 0, I_C, I_CTX, I_CCTX, I_WADA, I_BADA, I_GMIX, I_GFFN, I_WHIN, I_HGAMMA, I_GHOUT, I_WHOUT, I_WCVIN, I_BCVIN, I_WCVDW, I_BCVDW, I_GCVLN, I_BCVLN, I_WCVOUT, I_BCVOUT,
       I_WR, I_BR, I_WE1, I_BE1, I_WE2, I_BE2, I_GFINAL, N_IN };

constexpr size_t MiB = 1u << 20;
constexpr size_t WS_CTL = 0, CTL_ZERO_BYTES = 1 * MiB;
constexpr size_t WS_MODS = 1 * MiB;
constexpr size_t WS_TOPE = 2 * MiB, WS_TOPW = 2 * MiB + 512 * 1024, WS_POS = 3 * MiB, WS_BCNT = 3 * MiB + 512 * 1024, WS_TILEE = WS_BCNT + 64 * 1024, WS_SLOTW = 4 * MiB;
constexpr size_t WS_SP = 5 * MiB, WS_SD = 8 * MiB;
constexpr size_t WS_WIN = 48 * MiB, WS_WOUT = 58 * MiB, WS_WCVIN = 60 * MiB, WS_WCVOUT = 64 * MiB, WS_W1 = 66 * MiB, WS_W2 = 322 * MiB;
constexpr size_t WS_X = 450 * MiB;
constexpr size_t WS_H = 578 * MiB;
constexpr size_t WS_Q = 644 * MiB, WS_V = 709 * MiB, WS_SG = 774 * MiB, WS_LFF = 839 * MiB, WS_LFB = 969 * MiB, WS_OF = 1099 * MiB, WS_OB = 1227 * MiB, WS_YIN = 1355 * MiB;
constexpr size_t WS_AS = 1419 * MiB, WS_ACT = 1555 * MiB, WS_YS = 1691 * MiB, WS_END = 1963 * MiB;
#ifndef F8_IN
#define F8_IN 0
#endif
#ifndef SPLIT_IN
#define SPLIT_IN 1
#endif
#ifndef F8_Y
#define F8_Y 1
#endif
constexpr int YSCALE = 16;
#ifndef F8_MISC
#define F8_MISC 1
#endif
constexpr size_t WS_H8 = WS_OF + 64 * MiB;
constexpr size_t WS_WIN8 = WS_WIN + 6 * MiB;
constexpr size_t WS_STOK = WS_AS;
constexpr int CW_MODF = 3200;
constexpr int CW_FLAT = 3072;
constexpr int CW_GCNT = 2048;
constexpr float W8SCALE = 64.0f;
constexpr size_t WS_U = WS_Q, WS_ZP = WS_V, WS_Z = WS_SG;
constexpr int CW_BAR = 4096;
constexpr int CW_TCNT = 65536;

constexpr int RING_OFF = 0, RING_BYTES = 131072;
constexpr int LDSCTL_OFF = 139264, MISC_OFF = LDSCTL_OFF + 320, EXTRA_OFF = LDSCTL_OFF + 1024;
constexpr int LDS_BYTES = 155648;

#define LAS __attribute__((address_space(3)))
typedef unsigned short bf16;
typedef unsigned v4u __attribute__((ext_vector_type(4)));
typedef unsigned v2u __attribute__((ext_vector_type(2)));
typedef float f32x4 __attribute__((ext_vector_type(4)));
typedef int v4i __attribute__((ext_vector_type(4)));
#define LDS_WAIT() asm volatile("s_waitcnt lgkmcnt(0)" ::: "memory")
#define VM_WAIT() asm volatile("s_waitcnt vmcnt(0)" ::: "memory")
__device__ __forceinline__ unsigned f2bf(float f) { unsigned u = __builtin_bit_cast(unsigned, f); return (u + 0x7fffu + ((u >> 16) & 1u)) >> 16; }
__device__ __forceinline__ unsigned pk2(float lo, float hi) { return f2bf(lo) | (f2bf(hi) << 16); }
__device__ __forceinline__ float bf_lo(unsigned u) { return __builtin_bit_cast(float, u << 16); }
__device__ __forceinline__ float bf_hi(unsigned u) { return __builtin_bit_cast(float, u & 0xffff0000u); }
__device__ __forceinline__ float bf2f(bf16 h) { return __builtin_bit_cast(float, ((unsigned)h) << 16); }
__device__ __forceinline__ float fsig(float x) { return __builtin_amdgcn_rcpf(1.0f + __expf(-x)); }
__device__ __forceinline__ float wave_sum(float v) {
#pragma unroll
    for (int o = 1; o < 64; o <<= 1) v += __shfl_xor(v, o);
    return v;
}

__device__ __forceinline__ float sat8(float x) { return __builtin_amdgcn_fmed3f(x, -448.0f, 448.0f); }
__device__ __forceinline__ unsigned pk4_fp8(float a, float b, float c, float d) { int w = 0; w = __builtin_amdgcn_cvt_pk_fp8_f32(sat8(a), sat8(b), w, false); w = __builtin_amdgcn_cvt_pk_fp8_f32(sat8(c), sat8(d), w, true); return (unsigned)w; }
template <bool OUT8> __device__ __forceinline__ void store_row4(void* orow, int lane, int j, f32x4 y, float scale) {
    if constexpr (OUT8) ((unsigned*)orow)[lane + 64 * j] = pk4_fp8(y.x * scale, y.y * scale, y.z * scale, y.w * scale);
    else { v2u w; w.x = pk2(y.x, y.y); w.y = pk2(y.z, y.w); ((v2u*)orow)[lane + 64 * j] = w; }
}

#define XB_TMO      128
#define XB_XCNT(j)  (256  + 64 * (j))
#define XB_XSUB(j)  (1280 + 64 * (j))
#define XB_XGEN(j)  (2304 + 64 * (j))
#define XB_TOP      3328
#define XB_TOPGEN   3392
#define XCD_BAR_WORDS 3456
#define XB_SPIN_CAP (1u << 18)

__device__ __forceinline__ unsigned xb_ld(unsigned* p)              { return __hip_atomic_load(p, __ATOMIC_RELAXED, __HIP_MEMORY_SCOPE_AGENT); }
__device__ __forceinline__ unsigned xb_add(unsigned* p, unsigned v) { return __hip_atomic_fetch_add(p, v, __ATOMIC_RELAXED, __HIP_MEMORY_SCOPE_AGENT); }
__device__ __forceinline__ unsigned xb_xcc_id() { return (unsigned)__builtin_amdgcn_s_getreg((3 << 11) | 20) & 0xFu; }
#define XB_SPIN(cond, bar) do { unsigned _sp = 0; while (cond) { __builtin_amdgcn_s_sleep(1); \
    if ((++_sp & 255u) == 0u) { if (xb_ld(&(bar)[XB_TMO])) break; if (_sp > XB_SPIN_CAP) { atomicAdd(&(bar)[XB_TMO], 1u); break; } } } } while (0)

struct XcdBarrier {
    unsigned* bar; unsigned x;
    volatile LAS unsigned* st;
};

__device__ __forceinline__ XcdBarrier xcd_barrier_post(unsigned* bar, volatile LAS unsigned* st) {
    XcdBarrier b; b.bar = bar; b.x = xb_xcc_id(); b.st = st;
    if (threadIdx.x == 0) (void)xb_add(&bar[XB_XCNT(b.x)], 1u);
    return b;
}
__device__ __forceinline__ void xcd_barrier_complete(unsigned* bar, unsigned x, unsigned& nloc, unsigned& nx) {
    const unsigned G = gridDim.x * gridDim.y * gridDim.z;
    unsigned sum, cnt, mine, sp = 0u;
    for (;;) {
        sum = 0u; cnt = 0u; mine = 0u;
#pragma unroll
        for (unsigned j = 0; j < 16; ++j) { const unsigned c = xb_ld(&bar[XB_XCNT(j)]); sum += c; cnt += (c > 0u) ? 1u : 0u; mine = (j == x) ? c : mine; }
        if (sum == G) break;
        __builtin_amdgcn_s_sleep(1);
        if ((++sp & 255u) == 0u) { if (xb_ld(&bar[XB_TMO])) break; if (sp > XB_SPIN_CAP) { atomicAdd(&bar[XB_TMO], 1u); break; } }
    }
    nloc = mine > 0u ? mine : 1u; nx = cnt > 0u ? cnt : 1u;
}

__device__ __forceinline__ void xcd_barrier(const XcdBarrier& b) {
    asm volatile("s_waitcnt vmcnt(0)" ::: "memory");
    __syncthreads();
    if (threadIdx.x == 0) {
        unsigned* bar = b.bar;
        __builtin_amdgcn_s_waitcnt(0);
        unsigned nloc = b.st[0], nx = b.st[1];
        if (nloc == 0u) { xcd_barrier_complete(bar, b.x, nloc, nx); b.st[0] = nloc; b.st[1] = nx; }
        const unsigned old = xb_add(&bar[XB_XSUB(b.x)], 1u);
        const unsigned gen = old / nloc;
        if (old + 1u == (gen + 1u) * nloc) {
            __builtin_amdgcn_fence(__ATOMIC_RELEASE, "agent");
            asm volatile("s_waitcnt vmcnt(0)" ::: "memory");
            const unsigned og = xb_add(&bar[XB_TOP], 1u);
            const unsigned tg = og / nx;
            if (og + 1u == (tg + 1u) * nx) xb_add(&bar[XB_TOPGEN], 1u);
            else XB_SPIN(xb_ld(&bar[XB_TOPGEN]) == tg, bar);
            __builtin_amdgcn_fence(__ATOMIC_ACQUIRE, "agent");
            xb_add(&bar[XB_XGEN(b.x)], 1u);
            asm volatile("s_waitcnt vmcnt(0)" ::: "memory");
        } else {
            XB_SPIN(xb_ld(&bar[XB_XGEN(b.x)]) == gen, bar);
            __builtin_amdgcn_fence(__ATOMIC_ACQUIRE, "agent");
            asm volatile("s_waitcnt vmcnt(0)" ::: "memory");
        }
    }
    __syncthreads();
}

struct Args { const float* in[N_IN]; float* out; unsigned char* ws; int ph_lo, ph_hi, li, pad; };

__device__ __forceinline__ void p_mods(const Args& a, LAS unsigned char* lds, int tid, int lane, int wave) {
    LAS float* sc = (LAS float*)lds;
    LAS float* part = sc + 3 * D;
    float* MODS = (float*)(a.ws + WS_MODS);
    for (int i = tid; i < 3 * D; i += NTHR) { const int r = i >> 10, k = i & 1023; const float v = r < 2 ? a.in[I_C][r * D + k] : a.in[I_CCTX][k]; sc[i] = v * fsig(v); }
    __syncthreads();
    for (int item = blockIdx.x; item < 2 * 96; item += gridDim.x) {
        const int l = item / 96, cb = item % 96;
        const float* W = a.in[I_WADA] + (size_t)l * D * 6 * D + cb * 64 + lane;
        float a0 = 0.f, a1 = 0.f, a2 = 0.f;
#pragma unroll 16
        for (int kk = 0; kk < 128; ++kk) { const int k = wave * 128 + kk; const float w = W[(size_t)k * (6 * D)]; a0 += sc[k] * w; a1 += sc[D + k] * w; a2 += sc[2 * D + k] * w; }
        part[(wave * 3 + 0) * 64 + lane] = a0; part[(wave * 3 + 1) * 64 + lane] = a1; part[(wave * 3 + 2) * 64 + lane] = a2;
        __syncthreads();
        if (tid < 192) { const int r = tid >> 6, ln = tid & 63; float s = 0.f;
#pragma unroll
            for (int w = 0; w < 8; ++w) s += part[(w * 3 + r) * 64 + ln];
            __hip_atomic_store(&MODS[(size_t)(l * 3 + r) * (6 * D) + cb * 64 + ln], s + a.in[I_BADA][l * 6 * D + cb * 64 + ln], __ATOMIC_RELAXED, __HIP_MEMORY_SCOPE_AGENT); }
        asm volatile("s_waitcnt vmcnt(0)" ::: "memory");
        __syncthreads();
        if (item < 32 && tid == 0) (void)__hip_atomic_fetch_add((unsigned*)(a.ws + WS_CTL) + CW_MODF, 1u, __ATOMIC_RELAXED, __HIP_MEMORY_SCOPE_AGENT);
    }
}
__device__ __forceinline__ void wait_mods0(const Args& a, int tid) {
    if (tid == 0) { unsigned* f = (unsigned*)(a.ws + WS_CTL) + CW_MODF; unsigned sp = 0;
        while (__hip_atomic_load(f, __ATOMIC_RELAXED, __HIP_MEMORY_SCOPE_AGENT) < 32u) { __builtin_amdgcn_s_sleep(2); if (++sp > (1u << 22)) break; }
        __builtin_amdgcn_fence(__ATOMIC_ACQUIRE, "agent");
        asm volatile("s_waitcnt vmcnt(0)" ::: "memory"); }
    __syncthreads();
}
template <bool OUT8> __device__ __forceinline__ void transpose_item(const float* W, int K, int N, bf16* WT, bool paired, LAS float* scr, int item, int lane, int row_adj = 0) {
    const int nblk = N / 32, kb = item / nblk, nb = item % nblk, k0 = 64 * kb, n0 = 32 * nb;
    int d0 = n0 + row_adj; if (paired) { const int half = n0 >> 10, c = n0 & 1023; d0 = (c >> 7) * 256 + half * 128 + (c & 127); }
    float t[32];
#pragma unroll
    for (int i = 0; i < 32; ++i) { const int kk = 2 * i + (lane >> 5); t[i] = __builtin_nontemporal_load(&W[(size_t)(k0 + kk) * N + n0 + (lane & 31)]); }
#pragma unroll
    for (int i = 0; i < 32; ++i) { const int kk = 2 * i + (lane >> 5); scr[kk * 33 + (lane & 31)] = t[i]; }
    LDS_WAIT(); asm volatile("" ::: "memory");
    const int c = lane & 7;
#pragma unroll
    for (int j = 0; j < 4; ++j) { const int n = (lane >> 3) + 8 * j; const LAS float* s = scr + (8 * c) * 33 + n;
        if constexpr (OUT8) {
            int w0 = 0, w1 = 0;
            w0 = __builtin_amdgcn_cvt_pk_fp8_f32(s[0 * 33] * W8SCALE, s[1 * 33] * W8SCALE, w0, false); w0 = __builtin_amdgcn_cvt_pk_fp8_f32(s[2 * 33] * W8SCALE, s[3 * 33] * W8SCALE, w0, true);
            w1 = __builtin_amdgcn_cvt_pk_fp8_f32(s[4 * 33] * W8SCALE, s[5 * 33] * W8SCALE, w1, false); w1 = __builtin_amdgcn_cvt_pk_fp8_f32(s[6 * 33] * W8SCALE, s[7 * 33] * W8SCALE, w1, true);
            *(v2u*)((unsigned char*)WT + (size_t)(d0 + n) * K + k0 + 8 * c) = (v2u){(unsigned)w0, (unsigned)w1};
        } else {
        v4u o; o.x = pk2(s[0 * 33], s[1 * 33]); o.y = pk2(s[2 * 33], s[3 * 33]); o.z = pk2(s[4 * 33], s[5 * 33]); o.w = pk2(s[6 * 33], s[7 * 33]);
        *(v4u*)(WT + (size_t)(d0 + n) * K + k0 + 8 * c) = o; } }
    LDS_WAIT(); asm volatile("" ::: "memory");
}
__device__ __forceinline__ void p_weights(const Args& a, LAS unsigned char* lds, int lane, int wave) {
    LAS float* scr = (LAS float*)(lds + RING_OFF + wave * 16384);
    const int gw = blockIdx.x * NWAVES + wave, NGW = gridDim.x * NWAVES;
    constexpr int I_IN = 16 * 160, I_SQ = 16 * 32, I_CV = 16 * 64, I_E1 = 64 * 1024, I_E2 = 64 * 512;
    constexpr int NITEMS = I_IN + I_SQ + I_CV + I_SQ + I_E1 + I_E2;
    unsigned char* ws = a.ws;
    for (int it = (gridDim.x == 256 ? I_E1 + I_E2 : 0) + gw; it < NITEMS; it += NGW) {
        int r = it;
        if (r < I_E1) { const int mi = r >> 10; transpose_item<true>(a.in[I_WE1] + (size_t)mi * D * 2 * D, D, 2 * D, (bf16*)(ws + WS_W1 + (size_t)mi * 2 * D * D), true, scr, r & 1023, lane); continue; } r -= I_E1;
        if (r < I_E2) { const int mi = r >> 9; transpose_item<true>(a.in[I_WE2] + (size_t)mi * D * D, D, D, (bf16*)(ws + WS_W2 + (size_t)mi * D * D), false, scr, r & 511, lane); continue; } r -= I_E2;
        if (r < I_IN) {
            if (SPLIT_IN) { const int sgm = ((r % 160) * 32) >> 10;
                if (sgm == 2 || sgm == 3) transpose_item<true>(a.in[I_WHIN], D, 5 * D, (bf16*)(ws + WS_WIN8), false, scr, r, lane, -2 * D);
                else transpose_item<false>(a.in[I_WHIN], D, 5 * D, (bf16*)(ws + WS_WIN), false, scr, r, lane, sgm == 4 ? -2 * D : 0);
            } else transpose_item<F8_IN != 0>(a.in[I_WHIN], D, 5 * D, (bf16*)(ws + WS_WIN), false, scr, r, lane);
            continue; } r -= I_IN;
        if (r < I_SQ) { transpose_item<F8_MISC != 0>(a.in[I_WHOUT], D, D, (bf16*)(ws + WS_WOUT), false, scr, r, lane); continue; } r -= I_SQ;
        if (r < I_CV) { transpose_item<F8_MISC != 0>(a.in[I_WCVIN], D, 2 * D, (bf16*)(ws + WS_WCVIN), true, scr, r, lane); continue; } r -= I_CV;
        transpose_item<F8_MISC != 0>(a.in[I_WCVOUT], D, D, (bf16*)(ws + WS_WCVOUT), false, scr, r, lane);
    }
}
constexpr int CV_WAVES = 7, CV_L0 = 32 * 512 + 32 * 256, CV_ALL = 2 * CV_L0;
__device__ __forceinline__ void transpose_item64(const float* W, int K, int N, unsigned char* WT, bool paired, LAS float* scr, int item, int lane) {
    const int nblk = N / 64, kb = item / nblk, nb = item % nblk, k0 = 64 * kb, n0 = 64 * nb;
    int d0 = n0; if (paired) { const int half = n0 >> 10, c = n0 & 1023; d0 = (c >> 7) * 256 + half * 128 + (c & 127); }
    float t[64];
#pragma unroll
    for (int i = 0; i < 64; ++i) t[i] = __builtin_nontemporal_load(&W[(size_t)(k0 + i) * N + n0 + lane]);
#pragma unroll
    for (int i = 0; i < 64; ++i) scr[i * 65 + lane] = t[i];
    LDS_WAIT(); asm volatile("" ::: "memory");
    const int c = lane & 3;
#pragma unroll
    for (int j = 0; j < 4; ++j) { const int n = (lane >> 2) + 16 * j; const LAS float* s = scr + (16 * c) * 65 + n;
        v4u o;
        o.x = pk4_fp8(s[0 * 65] * W8SCALE, s[1 * 65] * W8SCALE, s[2 * 65] * W8SCALE, s[3 * 65] * W8SCALE); o.y = pk4_fp8(s[4 * 65] * W8SCALE, s[5 * 65] * W8SCALE, s[6 * 65] * W8SCALE, s[7 * 65] * W8SCALE);
        o.z = pk4_fp8(s[8 * 65] * W8SCALE, s[9 * 65] * W8SCALE, s[10 * 65] * W8SCALE, s[11 * 65] * W8SCALE); o.w = pk4_fp8(s[12 * 65] * W8SCALE, s[13 * 65] * W8SCALE, s[14 * 65] * W8SCALE, s[15 * 65] * W8SCALE);
        *(v4u*)(WT + (size_t)(d0 + n) * K + k0 + 16 * c) = o; }
    LDS_WAIT(); asm volatile("" ::: "memory");
}
__device__ __forceinline__ void cv_do_item(const Args& a, LAS float* scr, int g, int lane) {
    const int l = g >= CV_L0 ? 1 : 0; const int r = g - l * CV_L0;
    if (r < 32 * 512) { const int mi = l * 32 + (r >> 9); transpose_item64(a.in[I_WE1] + (size_t)mi * D * 2 * D, D, 2 * D, a.ws + WS_W1 + (size_t)mi * 2 * D * D, true, scr, r & 511, lane); }
    else { const int r2 = r - 32 * 512; const int mi = l * 32 + (r2 >> 8); transpose_item64(a.in[I_WE2] + (size_t)mi * D * D, D, D, a.ws + WS_W2 + (size_t)mi * D * D, false, scr, r2 & 255, lane); }
}
__device__ __forceinline__ void cv_finish(const Args& a, LAS unsigned char* lds, int wave, int lane, int& cv_n, int limit) {
    if (gridDim.x == 256 && wave >= 1 && wave <= CV_WAVES) {
        const int ww = blockIdx.x * CV_WAVES + (wave - 1), NW = 256 * CV_WAVES; LAS float* scr = (LAS float*)(lds + RING_OFF + wave * 16640);
        for (;;) { const int g = cv_n * NW + ww; if (g >= limit) break; cv_do_item(a, scr, g, lane); ++cv_n; }
    }
}
__device__ __forceinline__ void xcd_barrier_work(const XcdBarrier& b, const Args& a, LAS unsigned char* lds, int wave, int lane, int& cv_n, volatile LAS unsigned* flag, unsigned seq) {
    asm volatile("s_waitcnt vmcnt(0)" ::: "memory");
    __syncthreads();
    if (wave == 0) {
        if (threadIdx.x == 0) {
            unsigned* bar = b.bar;
            __builtin_amdgcn_s_waitcnt(0);
            unsigned nloc = b.st[0], nx = b.st[1];
            if (nloc == 0u) { xcd_barrier_complete(bar, b.x, nloc, nx); b.st[0] = nloc; b.st[1] = nx; }
            const unsigned old = xb_add(&bar[XB_XSUB(b.x)], 1u);
            const unsigned gen = old / nloc;
            if (old + 1u == (gen + 1u) * nloc) {
                __builtin_amdgcn_fence(__ATOMIC_RELEASE, "agent");
                asm volatile("s_waitcnt vmcnt(0)" ::: "memory");
                const unsigned og = xb_add(&bar[XB_TOP], 1u);
                const unsigned tg = og / nx;
                if (og + 1u == (tg + 1u) * nx) xb_add(&bar[XB_TOPGEN], 1u);
                else XB_SPIN(xb_ld(&bar[XB_TOPGEN]) == tg, bar);
                __builtin_amdgcn_fence(__ATOMIC_ACQUIRE, "agent");
                xb_add(&bar[XB_XGEN(b.x)], 1u);
                asm volatile("s_waitcnt vmcnt(0)" ::: "memory");
            } else {
                XB_SPIN(xb_ld(&bar[XB_XGEN(b.x)]) == gen, bar);
                __builtin_amdgcn_fence(__ATOMIC_ACQUIRE, "agent");
                asm volatile("s_waitcnt vmcnt(0)" ::: "memory");
            }
            flag[0] = seq;
        }
    } else if (gridDim.x == 256 && wave <= CV_WAVES) {
        const int ww = blockIdx.x * CV_WAVES + (wave - 1), NW = 256 * CV_WAVES; LAS float* scr = (LAS float*)(lds + RING_OFF + wave * 16640);
        for (;;) { const int g = cv_n * NW + ww; if (g >= CV_ALL) break; if (flag[0] == seq) break; cv_do_item(a, scr, g, lane); ++cv_n; }
        asm volatile("s_waitcnt vmcnt(0)" ::: "memory");
    }
    __syncthreads();
}
__device__ __forceinline__ void flat_barrier_work(unsigned* cnt, const Args& a, LAS unsigned char* lds, int wave, int lane, int& cv_n, volatile LAS unsigned* flag, unsigned seq) {
    asm volatile("s_waitcnt vmcnt(0)" ::: "memory");
    __syncthreads();
    if (wave == 0) {
        if (threadIdx.x == 0) {
            __builtin_amdgcn_s_waitcnt(0);
            __builtin_amdgcn_fence(__ATOMIC_RELEASE, "agent");
            asm volatile("s_waitcnt vmcnt(0)" ::: "memory");
            (void)__hip_atomic_fetch_add(cnt, 1u, __ATOMIC_RELAXED, __HIP_MEMORY_SCOPE_AGENT);
            const unsigned target = gridDim.x * seq; unsigned sp = 0;
            while (__hip_atomic_load(cnt, __ATOMIC_RELAXED, __HIP_MEMORY_SCOPE_AGENT) < target) { __builtin_amdgcn_s_sleep(1); if (++sp > (1u << 22)) break; }
            __builtin_amdgcn_fence(__ATOMIC_ACQUIRE, "agent");
            asm volatile("s_waitcnt vmcnt(0)" ::: "memory");
            flag[0] = seq;
        }
    } else if (gridDim.x == 256 && wave <= CV_WAVES) {
        const int ww = blockIdx.x * CV_WAVES + (wave - 1), NW = 256 * CV_WAVES; LAS float* scr = (LAS float*)(lds + RING_OFF + wave * 16640);
        for (;;) { const int g = cv_n * NW + ww; if (g >= CV_ALL) break; if (flag[0] == seq) break; cv_do_item(a, scr, g, lane); ++cv_n; }
        asm volatile("s_waitcnt vmcnt(0)" ::: "memory");
    }
    __syncthreads();
}
template <bool OUT8> __device__ __forceinline__ void norm_mod_store(f32x4 (&v)[4], const float* g, const float* sc, const float* sh, void* orow, int lane) {
    float s = 0.f;
#pragma unroll
    for (int j = 0; j < 4; ++j) s += (v[j].x * v[j].x + v[j].y * v[j].y) + (v[j].z * v[j].z + v[j].w * v[j].w);
    const float r = 1.0f / sqrtf(wave_sum(s) * (1.0f / D) + EPS);
#pragma unroll
    for (int j = 0; j < 4; ++j) { const f32x4 gg = ((const f32x4*)g)[lane + 64 * j], ss = ((const f32x4*)sc)[lane + 64 * j], hh = ((const f32x4*)sh)[lane + 64 * j];
        const f32x4 y = (v[j] * r * gg) * (ss + 1.0f) + hh; v[j] = y;
        store_row4<OUT8>(orow, lane, j, y, 1.0f); }
}
__device__ __forceinline__ void p_norm0(const Args& a, int lane, int gw, int NGW, int m_begin, int m_end) {
    const float* MODS = (const float*)(a.ws + WS_MODS); bf16* H = (bf16*)(a.ws + WS_H);
    for (int m0 = m_begin + gw * 2; m0 < m_end; m0 += NGW * 2) {
        f32x4 v[2][4]; int rr[2];
#pragma unroll
        for (int r = 0; r < 2; ++r) { const int m = m0 + r; const float* xr;
            if (m < NTOK) { xr = a.in[I_X] + (size_t)m * D; rr[r] = m / SEQ; } else { xr = a.in[I_CTX] + (size_t)(m - NTOK) * D; rr[r] = 2; }
#pragma unroll
            for (int j = 0; j < 4; ++j) v[r][j] = __builtin_nontemporal_load(&((const f32x4*)xr)[lane + 64 * j]); }
#pragma unroll
        for (int r = 0; r < 2; ++r) { const float* md = MODS + (size_t)rr[r] * 6 * D;
            norm_mod_store<F8_IN != 0>(v[r], a.in[I_GMIX], md + 1 * D, md + 0 * D, (unsigned char*)H + (size_t)(m0 + r) * D * (F8_IN ? 1 : 2), lane);
            if (SPLIT_IN) {
#pragma unroll
                for (int j = 0; j < 4; ++j) store_row4<true>(a.ws + WS_H8 + (size_t)(m0 + r) * D, lane, j, v[r][j], 1.0f); } }
    }
}
__device__ __forceinline__ void p_scan_naive(const Args& a, LAS unsigned char* lds, int tid) {
    LAS float* sf = (LAS float*)lds;
    LAS float* sq = sf + 64 * 128;
    LAS float* sv = sq + 64 * 128;
    LAS float* so = sv + 64 * 16;
    const bf16* Q = (const bf16*)(a.ws + WS_Q); const bf16* V = (const bf16*)(a.ws + WS_V);
    const int vl = tid >> 5, kq = tid & 31;
    for (int unit = blockIdx.x; unit < 256; unit += gridDim.x) {
        const int chain = unit >> 3, vb = unit & 7, b = chain >> 4, h = (chain >> 1) & 7, dir = chain & 1;
        const float* LF = (const float*)(a.ws + (dir ? WS_LFB : WS_LFF)); float* O = (float*)(a.ws + (dir ? WS_OB : WS_OF));
        float S0 = 0.f, S1 = 0.f, S2 = 0.f, S3 = 0.f;
        for (int blk = 0; blk < 260; ++blk) {
            const bool isctx = blk < 4; int base, step;
            if (!dir) { base = isctx ? (NTOK + b * CTXL + blk * 64) : (b * SEQ + (blk - 4) * 64); step = 1; }
            else { base = isctx ? (NTOK + b * CTXL + CTXL - 1 - blk * 64) : (b * SEQ + SEQ - 1 - (blk - 4) * 64); step = -1; }
            for (int e = tid; e < 64 * 128; e += NTHR) { const int i = e >> 7, k = e & 127; const size_t off = (size_t)(base + step * i) * D + h * DK + k; sf[e] = __expf(LF[off]); sq[e] = bf2f(Q[off]); }
            for (int e = tid; e < 64 * 16; e += NTHR) { const int i = e >> 4, vv = e & 15; sv[e] = bf2f(V[(size_t)(base + step * i) * D + h * DK + vb * 16 + vv]); }
            __syncthreads();
            for (int i = 0; i < 64; ++i) {
                const f32x4 f = *(const LAS f32x4*)(sf + i * 128 + kq * 4), q = *(const LAS f32x4*)(sq + i * 128 + kq * 4); const float vv = sv[i * 16 + vl];
                S0 = f.x * S0 + (1.0f - f.x) * vv; S1 = f.y * S1 + (1.0f - f.y) * vv; S2 = f.z * S2 + (1.0f - f.z) * vv; S3 = f.w * S3 + (1.0f - f.w) * vv;
                float p = (S0 * q.x + S1 * q.y) + (S2 * q.z + S3 * q.w);
                p += __shfl_xor(p, 1); p += __shfl_xor(p, 2); p += __shfl_xor(p, 4); p += __shfl_xor(p, 8); p += __shfl_xor(p, 16);
                if (kq == 0) so[i * 16 + vl] = p;
            }
            __syncthreads();
            if (!isctx) for (int e = tid; e < 64 * 16; e += NTHR) { const int i = e >> 4, vv = e & 15; O[(size_t)(base + step * i) * D + h * DK + vb * 16 + vv] = so[e]; }
            __syncthreads();
        }
    }
}
constexpr int SC_QT = 0, SC_KU = 4352, SC_KB = 8704, SC_VT = 12800, SC_ET = 16896, SC_SUB = 17408, SC_BUF = 4 * SC_SUB;
constexpr int NSLOT = 17;
typedef short s16x4 __attribute__((ext_vector_type(4)));
typedef short s16x8 __attribute__((ext_vector_type(8)));
struct ScanUnit { int h, rowbase, sgn, nchunks, chain, slot; };
__device__ __forceinline__ ScanUnit scan_unit(int b, int h, int dir, int slot) {
    ScanUnit u; u.h = h; u.sgn = dir ? -1 : 1; u.chain = (b * NHEAD + h) * 2 + dir; u.slot = slot;
    if (slot == 0) { u.rowbase = NTOK + b * CTXL + (dir ? CTXL - 1 : 0); u.nchunks = CTXL / 64; }
    else { const int so = (slot - 1) * 1024; u.rowbase = b * SEQ + (dir ? SEQ - 1 - so : so); u.nchunks = 16; }
    return u;
}
typedef float f32x2_t __attribute__((ext_vector_type(2)));
typedef __bf16 bf16x2_t __attribute__((ext_vector_type(2)));
__device__ __forceinline__ unsigned cvtpk(float lo, float hi) { const f32x2_t f = {lo, hi}; return __builtin_bit_cast(unsigned, __builtin_convertvector(f, bf16x2_t)); }
template <bool FULL> __device__ __forceinline__ void scan_load(const ScanUnit& u, int pos0, const bf16* LF, const bf16* Q, const bf16* V, int k, int i, unsigned (&lf)[16], unsigned (&qr)[16], unsigned (&vr)[16]) {
#pragma unroll
    for (int t = 0; t < 16; ++t) {
        const unsigned o = (unsigned)(u.rowbase + u.sgn * (pos0 + 16 * i + t)) * D + u.h * DK + k;
        lf[t] = LF[o]; vr[t] = V[o]; if (FULL) qr[t] = Q[o];
    }
}
template <bool FULL> __device__ __forceinline__ float scan_prep(LAS unsigned char* buf, int k, int i, const unsigned (&lfr)[16], const unsigned (&qr)[16], const unsigned (&vr)[16]) {
    LAS unsigned char* sb = buf + i * SC_SUB;
    float f[16], pre[16], suf[16]; float T = 0.f;
#pragma unroll
    for (int t = 0; t < 16; ++t) { const float lf = (float)__builtin_bit_cast(_Float16, (unsigned short)lfr[t]); T += lf; f[t] = __builtin_amdgcn_exp2f(lf * 1.4426950408889634f); }
    pre[0] = f[0];
#pragma unroll
    for (int t = 1; t < 16; ++t) pre[t] = pre[t - 1] * f[t];
    suf[15] = 1.0f;
#pragma unroll
    for (int t = 14; t >= 0; --t) suf[t] = suf[t + 1] * f[t + 1];
    unsigned kbw[8], vtw[8];
#pragma unroll
    for (int t = 0; t < 16; t += 2) {
        const float kk0 = 1.0f - f[t], kk1 = 1.0f - f[t + 1];
        kbw[t >> 1] = cvtpk(kk0 * suf[t], kk1 * suf[t + 1]);
        vtw[t >> 1] = vr[t] | (vr[t + 1] << 16);
        if (FULL) {
            const unsigned qq = cvtpk(__builtin_bit_cast(float, qr[t] << 16) * pre[t], __builtin_bit_cast(float, qr[t + 1] << 16) * pre[t + 1]);
            const unsigned ku = cvtpk(kk0 * __builtin_amdgcn_rcpf(fmaxf(pre[t], 1e-30f)), kk1 * __builtin_amdgcn_rcpf(fmaxf(pre[t + 1], 1e-30f)));
            *(LAS bf16*)(sb + SC_QT + t * 272 + 2 * k) = (bf16)(qq & 0xffffu); *(LAS bf16*)(sb + SC_QT + (t + 1) * 272 + 2 * k) = (bf16)(qq >> 16);
            *(LAS bf16*)(sb + SC_KU + t * 272 + 2 * k) = (bf16)(ku & 0xffffu); *(LAS bf16*)(sb + SC_KU + (t + 1) * 272 + 2 * k) = (bf16)(ku >> 16);
        }
    }
    *(LAS v4u*)(sb + SC_KB + k * 32) = (v4u){kbw[0], kbw[1], kbw[2], kbw[3]}; *(LAS v4u*)(sb + SC_KB + k * 32 + 16) = (v4u){kbw[4], kbw[5], kbw[6], kbw[7]};
    *(LAS v4u*)(sb + SC_VT + k * 32) = (v4u){vtw[0], vtw[1], vtw[2], vtw[3]}; *(LAS v4u*)(sb + SC_VT + k * 32 + 16) = (v4u){vtw[4], vtw[5], vtw[6], vtw[7]};
    *(LAS float*)(sb + SC_ET + 4 * k) = pre[15];
    return T;
}
__device__ __forceinline__ f32x4 mfma_k16(s16x4 a, s16x4 b, f32x4 c) {
    const v2u av = __builtin_bit_cast(v2u, a), bv = __builtin_bit_cast(v2u, b);
    return __builtin_amdgcn_mfma_f32_16x16x32_bf16(__builtin_bit_cast(s16x8, (v4u){av.x, av.y, 0u, 0u}), __builtin_bit_cast(s16x8, (v4u){bv.x, bv.y, 0u, 0u}), c, 0, 0, 0);
}
template <bool FULL> __device__ __forceinline__ void scan_compute2(const LAS unsigned char* buf, int wq, int lane, f32x4 (&S)[2][8], bf16* Ocol, const ScanUnit& u, int pos0) {
    const int fr = lane & 15, g = lane >> 4;
#pragma unroll 1
    for (int i = 0; i < 2; ++i) {
        const LAS unsigned char* sb = buf + i * SC_SUB;
        const s16x4 vt0 = *(const LAS s16x4*)(sb + SC_VT + (32 * wq + fr) * 32 + 8 * g), vt1 = *(const LAS s16x4*)(sb + SC_VT + (32 * wq + 16 + fr) * 32 + 8 * g);
        s16x8 ka[4], qa[4]; f32x4 et[8]; s16x4 kb[8];
        if (FULL) {
#pragma unroll
            for (int c = 0; c < 4; ++c) { ka[c] = *(const LAS s16x8*)(sb + SC_KU + fr * 272 + (32 * c + 8 * g) * 2); qa[c] = *(const LAS s16x8*)(sb + SC_QT + fr * 272 + (32 * c + 8 * g) * 2); }
        }
#pragma unroll
        for (int j = 0; j < 8; ++j) { et[j] = *(const LAS f32x4*)(sb + SC_ET + (32 * (j >> 1) + 8 * g + 4 * (j & 1)) * 4); kb[j] = *(const LAS s16x4*)(sb + SC_KB + (32 * (j >> 1) + 8 * (fr >> 2) + 4 * (j & 1) + (fr & 3)) * 32 + 8 * g); }
        __builtin_amdgcn_sched_barrier(0);
        if (FULL) {
            f32x4 aT = (f32x4){0.f, 0.f, 0.f, 0.f};
#pragma unroll
            for (int c = 0; c < 4; ++c) aT = __builtin_amdgcn_mfma_f32_16x16x32_bf16(ka[c], qa[c], aT, 0, 0, 0);
#pragma unroll
            for (int r = 0; r < 4; ++r) if (4 * g + r > fr) aT[r] = 0.f;
            const s16x4 ab = __builtin_bit_cast(s16x4, (v2u){cvtpk(aT[0], aT[1]), cvtpk(aT[2], aT[3])});
            f32x4 o0 = mfma_k16(vt0, ab, (f32x4){0.f, 0.f, 0.f, 0.f}), o1 = mfma_k16(vt1, ab, (f32x4){0.f, 0.f, 0.f, 0.f});
#pragma unroll
            for (int c = 0; c < 4; ++c) {
                const v4u s0 = (v4u){cvtpk(S[0][2 * c][0], S[0][2 * c][1]), cvtpk(S[0][2 * c][2], S[0][2 * c][3]), cvtpk(S[0][2 * c + 1][0], S[0][2 * c + 1][1]), cvtpk(S[0][2 * c + 1][2], S[0][2 * c + 1][3])};
                const v4u s1 = (v4u){cvtpk(S[1][2 * c][0], S[1][2 * c][1]), cvtpk(S[1][2 * c][2], S[1][2 * c][3]), cvtpk(S[1][2 * c + 1][0], S[1][2 * c + 1][1]), cvtpk(S[1][2 * c + 1][2], S[1][2 * c + 1][3])};
                o0 = __builtin_amdgcn_mfma_f32_16x16x32_bf16(__builtin_bit_cast(s16x8, s0), qa[c], o0, 0, 0, 0);
                o1 = __builtin_amdgcn_mfma_f32_16x16x32_bf16(__builtin_bit_cast(s16x8, s1), qa[c], o1, 0, 0, 0);
            }
            bf16* orow = Ocol + (size_t)(u.rowbase + u.sgn * (pos0 + 16 * i + fr)) * D;
            *(v2u*)orow = (v2u){cvtpk(o0[0], o0[1]), cvtpk(o0[2], o0[3])}; *(v2u*)(orow + 16) = (v2u){cvtpk(o1[0], o1[1]), cvtpk(o1[2], o1[3])};
        }
#pragma unroll
        for (int j = 0; j < 8; ++j) { S[0][j] = mfma_k16(kb[j], vt0, S[0][j] * et[j]); S[1][j] = mfma_k16(kb[j], vt1, S[1][j] * et[j]); }
    }
}
template <bool FULL> __device__ __forceinline__ void scan_pair(const Args& a, LAS unsigned char* lds, const ScanUnit& uA, const ScanUnit& uB, int tid, int lane, int wave) {
    const int grp = wave >> 2, wq = wave & 3, t = tid & 255, k = t & 127, i0 = t >> 7;
    ScanUnit u; u.h = grp ? uB.h : uA.h; u.rowbase = grp ? uB.rowbase : uA.rowbase; u.sgn = grp ? uB.sgn : uA.sgn; u.nchunks = grp ? uB.nchunks : uA.nchunks; u.chain = grp ? uB.chain : uA.chain; u.slot = grp ? uB.slot : uA.slot;
    LAS unsigned char* buf = lds + grp * SC_BUF;
    const int dir = u.sgn < 0;
    const bf16* LF = (const bf16*)(a.ws + (dir ? WS_LFB : WS_LFF)); const bf16* Q = (const bf16*)(a.ws + WS_Q); const bf16* V = (const bf16*)(a.ws + WS_V);
    f32x4* SD = (f32x4*)(a.ws + WS_SD) + (size_t)u.chain * NSLOT * 4096; float* SP = (float*)(a.ws + WS_SP) + (size_t)u.chain * NSLOT * DK;
    const int g = lane >> 4;
    bf16* Ocol = (bf16*)(a.ws + (dir ? WS_OB : WS_OF)) + u.h * DK + 32 * wq + 4 * g;
    f32x4 S[2][8];
#pragma unroll
    for (int vb = 0; vb < 2; ++vb)
#pragma unroll
        for (int j = 0; j < 8; ++j) S[vb][j] = (f32x4){0.f, 0.f, 0.f, 0.f};
    if (FULL) {
        for (int s = 0; s < u.slot; ++s) {
            const f32x4* d = SD + (size_t)s * 4096 + (wq * 16) * 64 + lane; const float* pp = SP + s * DK + 8 * g;
#pragma unroll
            for (int j = 0; j < 8; ++j) { const f32x4 pv = *(const f32x4*)(pp + 32 * (j >> 1) + 4 * (j & 1)); const f32x4 ev = (f32x4){__expf(pv.x), __expf(pv.y), __expf(pv.z), __expf(pv.w)};
                S[0][j] = S[0][j] * ev + d[j * 64]; S[1][j] = S[1][j] * ev + d[(8 + j) * 64]; }
        }
    }
    unsigned lf[16], q[16], v[16]; float psum = 0.f;
    const int nsteps = u.nchunks * 2;
    scan_load<FULL>(u, 0, LF, Q, V, k, i0, lf, q, v);
    constexpr int NST = 32;
    if (grp == 1) __syncthreads();
    for (int c = 0; c < NST; ++c) {
        if (c < nsteps) psum += scan_prep<FULL>(buf, k, i0, lf, q, v);
        __syncthreads();
        if (c < nsteps) {
            const int cn = (c + 1 < nsteps) ? c + 1 : c;
            scan_load<FULL>(u, cn * 32, LF, Q, V, k, i0, lf, q, v);
            scan_compute2<FULL>(buf, wq, lane, S, Ocol, u, c * 32);
        }
        __syncthreads();
    }
    if (grp == 0) __syncthreads();
    if (!FULL) {
        f32x4* d = SD + (size_t)u.slot * 4096 + (wq * 16) * 64 + lane;
#pragma unroll
        for (int j = 0; j < 8; ++j) { d[j * 64] = S[0][j]; d[(8 + j) * 64] = S[1][j]; }
        LAS float* ps = (LAS float*)(lds + EXTRA_OFF + 2560);
        ps[(grp * 2 + i0) * 128 + k] = psum;
        __syncthreads();
        if (t < 128) SP[u.slot * DK + t] = ps[(grp * 2) * 128 + t] + ps[(grp * 2 + 1) * 128 + t];
        __syncthreads();
    }
}
__device__ __forceinline__ void p_scan_a(const Args& a, LAS unsigned char* lds, int tid, int lane, int wave) {
    for (int it = blockIdx.x; it < 256; it += gridDim.x) {
        const int b = it >> 7, h = (it >> 4) & 7, seg = it & 15;
        const ScanUnit uA = scan_unit(b, h, 0, seg == 15 ? 0 : 1 + seg);
        const ScanUnit uB = scan_unit(b, h, 1, seg == 0 ? 0 : 16 - seg);
        scan_pair<false>(a, lds, uA, uB, tid, lane, wave);
    }
}
__device__ __forceinline__ void p_scan_c(const Args& a, LAS unsigned char* lds, int tid, int lane, int wave) {
    for (int it = blockIdx.x; it < 256; it += gridDim.x) {
        const int b = it >> 7, h = (it >> 4) & 7, seg = it & 15;
        const ScanUnit uA = scan_unit(b, h, 0, 1 + seg), uB = scan_unit(b, h, 1, 16 - seg);
        scan_pair<true>(a, lds, uA, uB, tid, lane, wave);
    }
}
__device__ __forceinline__ void p_readout(const Args& a, int lane, int wave) {
    const int gw = blockIdx.x * NWAVES + wave, NGW = gridDim.x * NWAVES;
    const bf16* OF = (const bf16*)(a.ws + WS_OF); const bf16* OB = (const bf16*)(a.ws + WS_OB); const bf16* SG = (const bf16*)(a.ws + WS_SG); bf16* Y = (bf16*)(a.ws + WS_YIN);
    for (int m0 = gw * 2; m0 < NTOK; m0 += NGW * 2) {
        f32x4 o[2][4]; v2u sg[2][4];
#pragma unroll
        for (int r = 0; r < 2; ++r)
#pragma unroll
            for (int j = 0; j < 4; ++j) { const size_t m = m0 + r; const v2u a_ = ((const v2u*)(OF + m * D))[lane + 64 * j], b_ = ((const v2u*)(OB + m * D))[lane + 64 * j];
                o[r][j] = (f32x4){bf_lo(a_.x) + bf_lo(b_.x), bf_hi(a_.x) + bf_hi(b_.x), bf_lo(a_.y) + bf_lo(b_.y), bf_hi(a_.y) + bf_hi(b_.y)}; sg[r][j] = ((const v2u*)(SG + m * D))[lane + 64 * j]; }
#pragma unroll
        for (int r = 0; r < 2; ++r)
#pragma unroll
            for (int j = 0; j < 4; ++j) { const f32x4 oo = o[r][j];
                float s = (oo.x * oo.x + oo.y * oo.y) + (oo.z * oo.z + oo.w * oo.w);
                s += __shfl_xor(s, 1); s += __shfl_xor(s, 2); s += __shfl_xor(s, 4); s += __shfl_xor(s, 8); s += __shfl_xor(s, 16);
                const float rs = 1.0f / sqrtf(s * (1.0f / DK) + EPS);
                const f32x4 gg = ((const f32x4*)a.in[I_GHOUT])[lane + 64 * j];
                store_row4<F8_MISC != 0>((unsigned char*)Y + (size_t)(m0 + r) * D * (F8_MISC ? 1 : 2), lane, j,
                    (f32x4){oo.x * rs * gg.x * bf_lo(sg[r][j].x), oo.y * rs * gg.y * bf_hi(sg[r][j].x), oo.z * rs * gg.z * bf_lo(sg[r][j].y), oo.w * rs * gg.w * bf_hi(sg[r][j].y)}, 4.0f); }
    }
}
__device__ __forceinline__ void p_router(const Args& a, LAS unsigned char* lds, int l, int tid, int lane, int wave) {
    typedef _Float16 h16x8 __attribute__((ext_vector_type(8))); typedef _Float16 h16x4 __attribute__((ext_vector_type(4)));
    constexpr int PITCH = 2064, WT_OFF = 0, TILE_OFF = 32 * PITCH, P_OFF = TILE_OFF + 16 * PITCH;
    LAS int* s_cnt = (LAS int*)(lds + EXTRA_OFF);
    LAS int* s_gb = s_cnt + 32;
    LAS int* s_sel = (LAS int*)(lds + EXTRA_OFF + 2560);
    unsigned* GCNT = (unsigned*)(a.ws + WS_CTL) + CW_GCNT + l * 32;
    const float* WR = a.in[I_WR] + (size_t)l * D * NE; const float* BR = a.in[I_BR] + l * NE;
    for (int i = tid; i < D * NE; i += NTHR) *(LAS _Float16*)(lds + WT_OFF + (i & 31) * PITCH + (i >> 5) * 2) = (_Float16)WR[i];
    const bf16* X = (const bf16*)(a.ws + WS_X); unsigned char* H = a.ws + WS_H;
    const float* MODS = (const float*)(a.ws + WS_MODS);
    int* TOPS = (int*)(a.ws + WS_TOPE); float* TOPW = (float*)(a.ws + WS_TOPW); int* STOK = (int*)(a.ws + WS_STOK);
    const int fr = lane & 15, g = lane >> 4;
    LAS float* P = (LAS float*)(lds + P_OFF);
    for (int ch = blockIdx.x; ch < NTOK / 128; ch += gridDim.x) {
        if (tid < 32) s_cnt[tid] = 0;
        const int b = (ch * 128) / SEQ; const float* md = MODS + (size_t)(l * 3 + b) * 6 * D;
        v2u nx[2][4];
#pragma unroll
        for (int t = 0; t < 2; ++t)
#pragma unroll
            for (int j = 0; j < 4; ++j) nx[t][j] = ((const v2u*)(X + (size_t)(ch * 128 + 2 * wave + t) * D))[lane + 64 * j];
        for (int it = 0; it < 8; ++it) {
            const int tok0 = ch * 128 + it * 16 + 2 * wave;
            f32x4 hf[2][4];
#pragma unroll
            for (int t = 0; t < 2; ++t)
#pragma unroll
                for (int j = 0; j < 4; ++j) hf[t][j] = (f32x4){bf_lo(nx[t][j].x), bf_hi(nx[t][j].x), bf_lo(nx[t][j].y), bf_hi(nx[t][j].y)};
            if (it + 1 < 8) {
#pragma unroll
                for (int t = 0; t < 2; ++t)
#pragma unroll
                    for (int j = 0; j < 4; ++j) nx[t][j] = ((const v2u*)(X + (size_t)(tok0 + 16 + t) * D))[lane + 64 * j];
            }
#pragma unroll
            for (int t = 0; t < 2; ++t) {
                norm_mod_store<true>(hf[t], a.in[I_GFFN] + l * D, md + 4 * D, md + 3 * D, H + (size_t)(tok0 + t) * D, lane);
#pragma unroll
                for (int j = 0; j < 4; ++j) { const h16x4 hv = {(_Float16)hf[t][j].x, (_Float16)hf[t][j].y, (_Float16)hf[t][j].z, (_Float16)hf[t][j].w};
                    *(LAS h16x4*)(lds + TILE_OFF + (2 * wave + t) * PITCH + (4 * lane + 256 * j) * 2) = hv; }
            }
            __syncthreads();
            f32x4 acc0 = (f32x4){0.f, 0.f, 0.f, 0.f}, acc1 = acc0;
#pragma unroll
            for (int c = 0; c < 4; ++c) { const int kb = (128 * wave + 32 * c + 8 * g) * 2;
                const h16x8 av = *(const LAS h16x8*)(lds + TILE_OFF + fr * PITCH + kb);
                const h16x8 b0 = *(const LAS h16x8*)(lds + WT_OFF + fr * PITCH + kb), b1 = *(const LAS h16x8*)(lds + WT_OFF + (16 + fr) * PITCH + kb);
                acc0 = __builtin_amdgcn_mfma_f32_16x16x32_f16(av, b0, acc0, 0, 0, 0); acc1 = __builtin_amdgcn_mfma_f32_16x16x32_f16(av, b1, acc1, 0, 0, 0); }
#pragma unroll
            for (int r = 0; r < 4; ++r) { P[(wave * 16 + 4 * g + r) * 32 + fr] = acc0[r]; P[(wave * 16 + 4 * g + r) * 32 + 16 + fr] = acc1[r]; }
            __syncthreads();
            const int t = lane >> 5, e0 = lane & 31;
            float v0 = BR[e0];
#pragma unroll
            for (int w = 0; w < 8; ++w) v0 += P[(w * 16 + 2 * wave + t) * 32 + e0];
            float selv[4]; int seli[4];
#pragma unroll
            for (int r = 0; r < 4; ++r) {
                float bv = v0; int bi = e0;
#pragma unroll
                for (int o = 1; o < 32; o <<= 1) { const float ov = __shfl_xor(bv, o); const int oi = __shfl_xor(bi, o); if (ov > bv || (ov == bv && oi < bi)) { bv = ov; bi = oi; } }
                selv[r] = bv; seli[r] = bi;
                if (bi == e0) v0 = -INFINITY;
            }
            if ((lane & 31) == 0) {
                const float e1 = __expf(selv[1] - selv[0]), e2 = __expf(selv[2] - selv[0]), e3 = __expf(selv[3] - selv[0]); const float inv = 1.0f / (1.0f + e1 + e2 + e3);
                *(f32x4*)(TOPW + (size_t)(tok0 + t) * 4) = (f32x4){inv, e1 * inv, e2 * inv, e3 * inv};
#pragma unroll
                for (int r = 0; r < 4; ++r) s_sel[(it * 16 + 2 * wave + t) * 4 + r] = (seli[r] << 16) | __hip_atomic_fetch_add(&s_cnt[seli[r]], 1, __ATOMIC_RELAXED, __HIP_MEMORY_SCOPE_WORKGROUP);
            }
        }
        __syncthreads();
        if (tid < 32) s_gb[tid] = (int)__hip_atomic_fetch_add(GCNT + tid, (unsigned)s_cnt[tid], __ATOMIC_RELAXED, __HIP_MEMORY_SCOPE_AGENT);
        __syncthreads();
        { const int sv = s_sel[tid], e = sv >> 16, vi = s_gb[e] + (sv & 0xffff); TOPS[(size_t)ch * 512 + tid] = e * NTOK + vi; STOK[(size_t)e * NTOK + vi] = ch * 128 + (tid >> 2); }
        __syncthreads();
    }
}
__device__ __forceinline__ void moe_tables(const Args& a, LAS unsigned char* lds, int l, int tid) {
    LAS int* s_tb = (LAS int*)(lds + EXTRA_OFF + 256); LAS int* s_ce = s_tb + 40; LAS int* tab = (LAS int*)(lds + EXTRA_OFF + 640);
    const unsigned* GCNT = (const unsigned*)(a.ws + WS_CTL) + CW_GCNT + l * 32;
    if (tid < 32) s_ce[tid] = (int)__hip_atomic_load(GCNT + tid, __ATOMIC_RELAXED, __HIP_MEMORY_SCOPE_AGENT);
    __syncthreads();
    if (tid == 0) { int run = 0; for (int e = 0; e < 32; ++e) { s_tb[e] = run; run += (s_ce[e] + 255) >> 8; } s_tb[32] = run; }
    __syncthreads();
    if (tid < 32) { const int t0 = s_tb[tid], t1 = s_tb[tid + 1]; for (int t = t0; t < t1; ++t) tab[t] = tid; }
    __syncthreads();
}
template <bool FINAL> __device__ __forceinline__ void p_combine(const Args& a, LAS unsigned char* lds, int l, int lane, int wave) {
    const int gw = blockIdx.x * NWAVES + wave, NGW = gridDim.x * NWAVES;
    bf16* X = (bf16*)(a.ws + WS_X); const bf16* YS = (const bf16*)(a.ws + WS_YS); const int* TOPS = (const int*)(a.ws + WS_TOPE); const float* TOPW = (const float*)(a.ws + WS_TOPW);
    const LAS int* s_tb = (const LAS int*)(lds + EXTRA_OFF + 256);
    const float* MODS = (const float*)(a.ws + WS_MODS); bf16* H = (bf16*)(a.ws + WS_H);
    for (int m0 = gw * 2; m0 < NTOK; m0 += NGW * 2) {
        const int b = m0 / SEQ; const float* gt = MODS + (size_t)(l * 3 + b) * 6 * D + 5 * D;
        f32x4 v[2][4]; v2u y[2][4][4]; f32x4 tw[2];
#pragma unroll
        for (int r = 0; r < 2; ++r) { v4i ps = *(const v4i*)(TOPS + (size_t)(m0 + r) * 4); tw[r] = *(const f32x4*)(TOPW + (size_t)(m0 + r) * 4);
#pragma unroll
            for (int k = 0; k < 4; ++k) { const int e = ps[k] >> 15; ps[k] = s_tb[e] * 256 + (ps[k] & (NTOK - 1)); }
#pragma unroll
            for (int j = 0; j < 4; ++j) { const v2u xx = ((const v2u*)(X + (size_t)(m0 + r) * D))[lane + 64 * j]; v[r][j] = (f32x4){bf_lo(xx.x), bf_hi(xx.x), bf_lo(xx.y), bf_hi(xx.y)};
#pragma unroll
                for (int k = 0; k < 4; ++k) {
                    if (F8_Y) { y[r][j][k].x = ((const unsigned*)((const unsigned char*)YS + (size_t)ps[k] * D))[lane + 64 * j]; y[r][j][k].y = 0u; }
                    else y[r][j][k] = ((const v2u*)(YS + (size_t)ps[k] * D))[lane + 64 * j]; } } }
#pragma unroll
        for (int r = 0; r < 2; ++r) { const int m = m0 + r;
#pragma unroll
            for (int j = 0; j < 4; ++j) { f32x4 s = (f32x4){0.f, 0.f, 0.f, 0.f};
#pragma unroll
                for (int k = 0; k < 4; ++k) {
                    if (F8_Y) { const int w = (int)y[r][j][k].x; const f32x2_t lo = __builtin_amdgcn_cvt_pk_f32_fp8(w, false), hi = __builtin_amdgcn_cvt_pk_f32_fp8(w, true);
                        s += (f32x4){lo.x, lo.y, hi.x, hi.y} * (tw[r][k] * (1.0f / YSCALE)); }
                    else s += (f32x4){bf_lo(y[r][j][k].x), bf_hi(y[r][j][k].x), bf_lo(y[r][j][k].y), bf_hi(y[r][j][k].y)} * tw[r][k]; }
                v[r][j] = v[r][j] + ((const f32x4*)gt)[lane + 64 * j] * s; }
            if (!FINAL) {
#pragma unroll
                for (int j = 0; j < 4; ++j) ((v2u*)(X + (size_t)m * D))[lane + 64 * j] = (v2u){pk2(v[r][j].x, v[r][j].y), pk2(v[r][j].z, v[r][j].w)};
                const float* md = MODS + (size_t)((l + 1) * 3 + b) * 6 * D;
                norm_mod_store<F8_MISC != 0>(v[r], a.in[I_GMIX] + (l + 1) * D, md + 1 * D, md + 0 * D, (unsigned char*)H + (size_t)m * D * (F8_MISC ? 1 : 2), lane);
            } else {
                float s = 0.f;
#pragma unroll
                for (int j = 0; j < 4; ++j) s += (v[r][j].x * v[r][j].x + v[r][j].y * v[r][j].y) + (v[r][j].z * v[r][j].z + v[r][j].w * v[r][j].w);
                const float rs = 1.0f / sqrtf(wave_sum(s) * (1.0f / D) + EPS);
#pragma unroll
                for (int j = 0; j < 4; ++j) __builtin_nontemporal_store(v[r][j] * rs * ((const f32x4*)a.in[I_GFINAL])[lane + 64 * j], &((f32x4*)(a.out + (size_t)m * D))[lane + 64 * j]);
            }
        }
    }
}
__device__ __forceinline__ void p_dwconv(const Args& a, int tid) {
    const bf16* U = (const bf16*)(a.ws + WS_U); bf16* ZP = (bf16*)(a.ws + WS_ZP);
    const float* WDW = a.in[I_WCVDW]; const float* BDW = a.in[I_BCVDW];
    const int half = tid >> 8, cp = tid & 255;
    for (int unit = blockIdx.x; unit < 2048; unit += gridDim.x) {
        const int hu = unit * 2 + half;
        int c, len, p0; size_t base, stride;
        if (hu < 2048) { c = 2 * cp; len = GRIDW; p0 = (hu & 3) * 16; base = (size_t)(hu >> 2) * GRIDW * D; stride = D; }
        else { const int v = hu - 2048; const int b = v >> 10, w = (v >> 4) & 63; c = 512 + 2 * cp; len = GRIDR; p0 = (v & 15) * 16; base = ((size_t)b * SEQ + w) * D; stride = (size_t)GRIDW * D; }
        float w0[CONVW], w1[CONVW];
#pragma unroll
        for (int j = 0; j < CONVW; ++j) { w0[j] = WDW[j * D + c]; w1[j] = WDW[j * D + c + 1]; }
        const float bb0 = BDW[c], bb1 = BDW[c + 1];
        float i0[46], i1[46];
#pragma unroll
        for (int i = 0; i < 46; ++i) { const int pp = p0 - 15 + i; unsigned u = 0u; if (pp >= 0 && pp < len) u = *(const unsigned*)(U + base + (size_t)pp * stride + c); i0[i] = bf_lo(u); i1[i] = bf_hi(u); }
#pragma unroll
        for (int i = 0; i < 16; ++i) { float a0 = bb0, a1 = bb1;
#pragma unroll
            for (int j = 0; j < CONVW; ++j) { a0 += i0[i + j] * w0[j]; a1 += i1[i + j] * w1[j]; }
            *(unsigned*)(ZP + base + (size_t)(p0 + i) * stride + c) = pk2(a0, a1); }
    }
}
__device__ __forceinline__ void p_ln_silu(const Args& a, int lane, int wave) {
    const int gw = blockIdx.x * NWAVES + wave, NGW = gridDim.x * NWAVES;
    const bf16* ZP = (const bf16*)(a.ws + WS_ZP); bf16* Z = (bf16*)(a.ws + WS_Z);
    for (int m0 = gw * 2; m0 < NTOK; m0 += NGW * 2) {
        v2u y[2][4];
#pragma unroll
        for (int r = 0; r < 2; ++r)
#pragma unroll
            for (int j = 0; j < 4; ++j) y[r][j] = ((const v2u*)(ZP + (size_t)(m0 + r) * D))[lane + 64 * j];
#pragma unroll
        for (int r = 0; r < 2; ++r) {
            f32x4 v[4]; float s = 0.f;
#pragma unroll
            for (int j = 0; j < 4; ++j) { v[j] = (f32x4){bf_lo(y[r][j].x), bf_hi(y[r][j].x), bf_lo(y[r][j].y), bf_hi(y[r][j].y)}; s += (v[j].x + v[j].y) + (v[j].z + v[j].w); }
            const float mean = wave_sum(s) * (1.0f / D); float s2 = 0.f;
#pragma unroll
            for (int j = 0; j < 4; ++j) { v[j] = v[j] - mean; s2 += (v[j].x * v[j].x + v[j].y * v[j].y) + (v[j].z * v[j].z + v[j].w * v[j].w); }
            const float rstd = 1.0f / sqrtf(wave_sum(s2) * (1.0f / D) + EPS);
#pragma unroll
            for (int j = 0; j < 4; ++j) { const f32x4 gg = ((const f32x4*)a.in[I_GCVLN])[lane + 64 * j], bb = ((const f32x4*)a.in[I_BCVLN])[lane + 64 * j];
                f32x4 yy = v[j] * rstd * gg + bb; yy.x *= fsig(yy.x); yy.y *= fsig(yy.y); yy.z *= fsig(yy.z); yy.w *= fsig(yy.w);
                store_row4<F8_MISC != 0>((unsigned char*)Z + (size_t)(m0 + r) * D * (F8_MISC ? 1 : 2), lane, j, yy, 4.0f); }
        }
    }
}


enum { PH_PRO = 0, PH_NORM0, PH_INPROJ, PH_SCANA, PH_SCANC, PH_READOUT, PH_OUTPROJ, PH_ROUTER0, PH_G1_0, PH_G2_0, PH_COMB0, PH_CVIN, PH_DWCONV, PH_LN, PH_CVOUT, PH_ROUTER1, PH_G1_1, PH_G2_1, PH_FINAL, NPH };
#ifndef REPMASK
#define REPMASK 0ull
#endif
#ifndef SCAN_NAIVE
#define SCAN_NAIVE 0
#endif
__global__ void __launch_bounds__(NTHR, 2) fwd_kernel(Args args) {
    extern __shared__ __attribute__((aligned(16))) unsigned char lds_raw[];
    LAS unsigned char* lds = (LAS unsigned char*)lds_raw;
    const int tid = threadIdx.x, lane = tid & 63, wave = __builtin_amdgcn_readfirstlane(tid >> 6);
    const int G = gridDim.x, bid = blockIdx.x;
    unsigned char* ws = args.ws;
    for (int u = tid; u < (LDS_BYTES - LDSCTL_OFF) / 4; u += NTHR) ((LAS unsigned*)(lds + LDSCTL_OFF))[u] = 0u;
    __syncthreads();
    volatile LAS unsigned* MISC = (volatile LAS unsigned*)(lds + MISC_OFF);
    XcdBarrier bar = xcd_barrier_post((unsigned*)(ws + WS_CTL) + CW_BAR + args.li * XCD_BAR_WORDS, MISC + 8);
    const int lo = args.ph_lo, hi = args.ph_hi;
#define IN(k) (lo <= (k) && (k) < hi)
    int cv_n = 0; unsigned bseq = 0;
#ifndef FLAT_BARRIER
#define FLAT_BARRIER 0
#endif
#define SEAM(k) do { if (IN(k) && IN((k) + 1)) { ++bseq; if (FLAT_BARRIER) flat_barrier_work((unsigned*)(ws + WS_CTL) + CW_FLAT, args, lds, wave, lane, cv_n, MISC + 12, bseq); else xcd_barrier_work(bar, args, lds, wave, lane, cv_n, MISC + 12, bseq); } } while (0)
#define PHASE(k, ...) if (IN(k)) { __VA_ARGS__; if ((REPMASK >> (k)) & 1ull) { __syncthreads(); __VA_ARGS__; } } SEAM(k);
    typedef pg8::bf16_t pbf;

    const bool merge_pro = false && (G >= 32) && IN(PH_PRO) && IN(PH_NORM0);
    if (IN(PH_PRO)) { p_mods(args, lds, tid, lane, wave); p_weights(args, lds, lane, wave); if (merge_pro) wait_mods0(args, tid); }
    if (!merge_pro) SEAM(PH_PRO);
    const bool ctx_early = SPLIT_IN && (G == 256);
    PHASE(PH_NORM0, {
        if (ctx_early && bid < 24) {
            const int cb = bid / 12, cj = bid % 12;
            p_norm0(args, lane, wave, NWAVES, NTOK + cb * CTXL, NTOK + cb * CTXL + CTXL);
            VM_WAIT(); __syncthreads();
            if (cj < 8) {
                pg8::Gemm g{(const pbf*)(ws + WS_H8), (const pbf*)(ws + WS_WIN8), D / 2, 0};
                pg8::OneUnit S1{NTOK / 256 + cb, cj};
                pg8::EpiHgrnIn E{(pbf*)(ws + WS_Q), (WS_V - WS_Q) / 2, (_Float16*)(ws + WS_LFF), (WS_LFB - WS_LFF) / 2, args.in[I_HGAMMA], 2};
                pg8::gemm_phase<pg8::EpiHgrnIn, pg8::OneUnit, true, true, true, 0x79797979, 0x7F7F7F7F>(lds + RING_OFF, g, S1, E);
            } else {
                pg8::Gemm g{(const pbf*)(ws + WS_H), (const pbf*)(ws + WS_WIN), D, 0};
                pg8::OneUnit S1{NTOK / 256 + cb, 4 + (cj - 8)};
                pg8::EpiHgrnIn E{(pbf*)(ws + WS_Q), (WS_V - WS_Q) / 2, (_Float16*)(ws + WS_LFF), (WS_LFB - WS_LFF) / 2, args.in[I_HGAMMA], 1};
                pg8::gemm_phase<pg8::EpiHgrnIn, pg8::OneUnit, true, true, false>(lds + RING_OFF, g, S1, E);
            }
        } else if (ctx_early) p_norm0(args, lane, (bid - 24) * NWAVES + wave, (G - 24) * NWAVES, 0, NTOK);
        else p_norm0(args, lane, bid * NWAVES + wave, G * NWAVES, 0, MROWS);
    })
    PHASE(PH_INPROJ, {
        static_assert(WS_V - WS_Q == WS_SG - WS_V, "Q|V|SG equally spaced");
        if (SPLIT_IN) {
            const int nMi = ctx_early ? NTOK / 256 : MROWS / 256;
            {
                pg8::Gemm g{(const pbf*)(ws + WS_H8), (const pbf*)(ws + WS_WIN8), D / 2, 0};
                pg8::TileOrder S; S.init(nMi, 2 * D / 256, G, bid, nullptr);
                pg8::EpiHgrnIn E{(pbf*)(ws + WS_Q), (WS_V - WS_Q) / 2, (_Float16*)(ws + WS_LFF), (WS_LFB - WS_LFF) / 2, args.in[I_HGAMMA], 2};
                pg8::gemm_phase<pg8::EpiHgrnIn, pg8::TileOrder, true, true, true, 0x79797979, 0x7F7F7F7F>(lds + RING_OFF, g, S, E);
            }
            {
                pg8::Gemm g{(const pbf*)(ws + WS_H), (const pbf*)(ws + WS_WIN), D, 0};
                pg8::TileOrder S; S.init(nMi, 3 * D / 256, G, bid, nullptr);
                pg8::EpiHgrnIn E{(pbf*)(ws + WS_Q), (WS_V - WS_Q) / 2, (_Float16*)(ws + WS_LFF), (WS_LFB - WS_LFF) / 2, args.in[I_HGAMMA], 1};
                pg8::gemm_phase<pg8::EpiHgrnIn, pg8::TileOrder, true, true, false>(lds + RING_OFF, g, S, E);
            }
        } else {
            pg8::Gemm g{(const pbf*)(ws + WS_H), (const pbf*)(ws + WS_WIN), F8_IN ? D / 2 : D, 0};
            pg8::TileOrder S; S.init(MROWS / 256, 5 * D / 256, G, bid, nullptr);
            pg8::EpiHgrnIn E{(pbf*)(ws + WS_Q), (WS_V - WS_Q) / 2, (_Float16*)(ws + WS_LFF), (WS_LFB - WS_LFF) / 2, args.in[I_HGAMMA], 0};
            pg8::gemm_phase<pg8::EpiHgrnIn, pg8::TileOrder, true, true, F8_IN != 0, 0x79797979, 0x7F7F7F7F>(lds + RING_OFF, g, S, E);
        }
    })
#if SCAN_NAIVE
    PHASE(PH_SCANA, { p_scan_naive(args, lds, tid); })
    PHASE(PH_SCANC, { })
#else
    PHASE(PH_SCANA, { p_scan_a(args, lds, tid, lane, wave); })
    PHASE(PH_SCANC, { p_scan_c(args, lds, tid, lane, wave); })
#endif
    PHASE(PH_READOUT, { p_readout(args, lane, wave); })
    PHASE(PH_OUTPROJ, {
        pg8::Gemm g{(const pbf*)(ws + WS_YIN), (const pbf*)(ws + WS_WOUT), F8_MISC ? D / 2 : D, 0};
        pg8::TileOrder S; S.init(NTOK / 256, D / 256, G, bid, nullptr);
        pg8::EpiResGate<false, true> E{args.in[I_X], (void*)(ws + WS_X), (const float*)(ws + WS_MODS) + 2 * D, 6 * D, SEQ, nullptr};
        pg8::gemm_phase<pg8::EpiResGate<false, true>, pg8::TileOrder, true, true, F8_MISC != 0, 0x79797979, 0x7D7D7D7D>(lds + RING_OFF, g, S, E);
    })
#ifndef G1_NS
#define G1_NS 8
#endif
#ifndef MOE_HANDOFF
#define MOE_HANDOFF 1
#endif
#define MOE_PHASES(l, pb) \
    if (IN(pb + 0)) { p_router(args, lds, l, tid, lane, wave); cv_finish(args, lds, wave, lane, cv_n, (l + 1) * CV_L0); } SEAM(pb + 0); \
    if (IN(pb + 1) || IN(pb + 2) || IN(pb + 3)) { \
        moe_tables(args, lds, l, tid); \
        LAS int* tab = (LAS int*)(lds + EXTRA_OFF + 640); \
        const LAS int* s_tb = (const LAS int*)(lds + EXTRA_OFF + 256); const LAS int* s_ce = s_tb + 40; \
        const int ntiles = __builtin_amdgcn_readfirstlane(s_tb[32]); \
        const bool hand = MOE_HANDOFF && (G == 256) && IN(pb + 1) && IN(pb + 2) && !((REPMASK >> (pb + 1)) & 3ull); \
        unsigned* tcnt = (unsigned*)(ws + WS_CTL) + CW_TCNT + l * 32768; \
        const int c2 = hand ? ((bid - ((((ntiles * 8) & 255) + 7) & ~7)) & 255) : bid;     \
        if (IN(pb + 1)) { \
            LAS unsigned short* tt = (LAS unsigned short*)(lds + EXTRA_OFF + 2816);     \
            pg8::MoeOrder S; S.init(ntiles, 2 * D / 256, G, bid, tab); S.cnt = tcnt; S.rdy = 0u; S.mode = hand ? 0 : 2; \
            { const int* STOK = (const int*)(ws + WS_STOK); pg8::Unit uu; for (int i = 0; S.next(i, uu); ++i) if (tid < 256) { const int vi = (uu.pm - s_tb[uu.e]) * 256 + tid; tt[i * 256 + tid] = vi < s_ce[uu.e] ? (unsigned short)STOK[(size_t)uu.e * NTOK + vi] : (unsigned short)0; } } \
            __syncthreads(); \
            pg8::Gemm g{(const pbf*)(ws + WS_H), (const pbf*)(ws + WS_W1 + (size_t)l * NE * 2 * D * D), D / 2, (size_t)2 * D * D, tt};   \
            pg8::EpiPair<0, true, 4, true> E{(pbf*)(ws + WS_ACT), args.in[I_BE1] + (size_t)l * NE * 2 * D}; \
            pg8::gemm_phase<pg8::EpiPair<0, true, 4, true>, pg8::MoeOrder, true, true, true, 0x79797979, 0x7F7F7F7F, true, G1_NS>(lds + RING_OFF, g, S, E); \
            if ((REPMASK >> (pb + 1)) & 1ull) { __syncthreads(); pg8::gemm_phase<pg8::EpiPair<0, true, 4, true>, pg8::MoeOrder, true, true, true, 0x79797979, 0x7F7F7F7F, true, G1_NS>(lds + RING_OFF, g, S, E); } \
        } \
        unsigned rdy = 0u; \
        if (hand) {                                                          \
            if (wave == 0) { \
                pg8::TileOrder T; T.init(ntiles, D / 256, G, c2, nullptr); pg8::Unit uu; const bool has = T.next(lane, uu); \
                const unsigned v = has ? __hip_atomic_load(tcnt + 32 * uu.pm, __ATOMIC_RELAXED, __HIP_MEMORY_SCOPE_AGENT) : 64u; \
                const unsigned long long m = __ballot(v >= 64u); \
                __builtin_amdgcn_fence(__ATOMIC_ACQUIRE, "agent"); asm volatile("s_waitcnt vmcnt(0)" ::: "memory"); \
                if (lane == 0) MISC[16] = (unsigned)m; \
            } \
            __syncthreads(); \
            rdy = __builtin_amdgcn_readfirstlane(MISC[16]); \
        } else SEAM(pb + 1); \
        PHASE(pb + 2, { \
            pg8::Gemm g{(const pbf*)(ws + WS_ACT), (const pbf*)(ws + WS_W2 + (size_t)l * NE * D * D), D / 2, (size_t)D * D}; \
            pg8::MoeOrder S; S.init(ntiles, D / 256, G, c2, tab); S.cnt = tcnt; S.rdy = rdy; S.mode = hand ? 1 : 2; \
            pg8::EpiMoeOut<F8_Y != 0, YSCALE> E{(pbf*)(ws + WS_YS), args.in[I_BE2] + (size_t)l * NE * D}; \
            pg8::gemm_phase<pg8::EpiMoeOut<F8_Y != 0, YSCALE>, pg8::MoeOrder, true, true, true, 0x79797979, 0x7D7D7D7D>(lds + RING_OFF, g, S, E);   \
        }) \
    }
    MOE_PHASES(0, PH_ROUTER0)
    PHASE(PH_COMB0, { p_combine<false>(args, lds, 0, lane, wave); })
    PHASE(PH_CVIN, {
        pg8::Gemm g{(const pbf*)(ws + WS_H), (const pbf*)(ws + WS_WCVIN), F8_MISC ? D / 2 : D, 0};
        pg8::TileOrder S; S.init(NTOK / 256, 2 * D / 256, G, bid, nullptr);
        pg8::EpiPair<1> E{(pbf*)(ws + WS_U), args.in[I_BCVIN]};
        pg8::gemm_phase<pg8::EpiPair<1>, pg8::TileOrder, true, true, F8_MISC != 0, 0x79797979, 0x7F7F7F7F>(lds + RING_OFF, g, S, E);
    })
    PHASE(PH_DWCONV, { p_dwconv(args, tid); })
    PHASE(PH_LN, { p_ln_silu(args, lane, wave); })
    PHASE(PH_CVOUT, {
        pg8::Gemm g{(const pbf*)(ws + WS_Z), (const pbf*)(ws + WS_WCVOUT), F8_MISC ? D / 2 : D, 0};
        pg8::TileOrder S; S.init(NTOK / 256, D / 256, G, bid, nullptr);
        pg8::EpiResGate<true, true> E{(const void*)(ws + WS_X), (void*)(ws + WS_X), (const float*)(ws + WS_MODS) + 3 * 6 * D + 2 * D, 6 * D, SEQ, args.in[I_BCVOUT]};
        pg8::gemm_phase<pg8::EpiResGate<true, true>, pg8::TileOrder, true, true, F8_MISC != 0, 0x79797979, 0x7D7D7D7D>(lds + RING_OFF, g, S, E);
    })
    MOE_PHASES(1, PH_ROUTER1)
    if (IN(PH_FINAL)) { p_combine<true>(args, lds, 1, lane, wave); }
#undef MOE_PHASES
#undef PHASE
#undef IN
#undef SEAM
}

extern "C" void kernel_launch(void* const* d_in, const int* in_sizes, int n_in, void* d_out, int out_size, void* d_ws, size_t ws_size, hipStream_t stream) {
    static int grid = 0;
    if (grid == 0) {
        if (n_in != N_IN || in_sizes[0] != NTOK * D || out_size != NTOK * D || ws_size < WS_END) { fprintf(stderr, "kernel_launch: unexpected shapes / workspace (n_in %d, in0 %d, out %d, ws %zu, need %zu); nothing launched\n", n_in, n_in > 0 ? in_sizes[0] : -1, out_size, ws_size, (size_t)WS_END); grid = -1; return; }
        int dev = 0, cus = 0, per_cu = 0;
        if (hipGetDevice(&dev) != hipSuccess || hipDeviceGetAttribute(&cus, hipDeviceAttributeMultiprocessorCount, dev) != hipSuccess) { grid = -1; return; }
        if (hipFuncSetAttribute((const void*)fwd_kernel, hipFuncAttributeMaxDynamicSharedMemorySize, LDS_BYTES) != hipSuccess) { fprintf(stderr, "kernel_launch: hipFuncSetAttribute failed\n"); grid = -1; return; }
        if (hipOccupancyMaxActiveBlocksPerMultiprocessor(&per_cu, (const void*)fwd_kernel, NTHR, LDS_BYTES) != hipSuccess || per_cu < 1) { fprintf(stderr, "kernel_launch: occupancy query reports %d workgroups per CU\n", per_cu); }
        (void)hipGetLastError();
        grid = cus;
    }
    if (grid < 0) return;
    if (hipMemsetAsync((char*)d_ws + WS_CTL, 0, CTL_ZERO_BYTES, stream) != hipSuccess) return;
#ifdef DIAG_MEMSET
    (void)hipMemsetAsync((char*)d_ws + WS_SP, 0, (WS_WIN - WS_SP), stream); (void)hipMemsetAsync((char*)d_ws + WS_OF, 0, (WS_YIN - WS_OF), stream);
#endif
    Args a{};
    for (int i = 0; i < N_IN; ++i) a.in[i] = (const float*)d_in[i];
    a.out = (float*)d_out; a.ws = (unsigned char*)d_ws; a.pad = 0;
#ifndef MK_CUTS
    a.ph_lo = 0; a.ph_hi = NPH; a.li = 0;
    hipLaunchKernelGGL(fwd_kernel, dim3(grid), dim3(NTHR), LDS_BYTES, stream, a);
#else
    const int cuts[] = {MK_CUTS};
    const int nc = (int)(sizeof(cuts) / sizeof(cuts[0]));
    for (int li = 0; li + 1 < nc; ++li) { a.ph_lo = cuts[li]; a.ph_hi = cuts[li + 1]; a.li = li; hipLaunchKernelGGL(fwd_kernel, dim3(grid), dim3(NTHR), LDS_BYTES, stream, a); }
#endif
}
```

```cpp
#include <hip/hip_runtime.h>
#include <cstdio>
#include <cstdint>

namespace pg8 {
#define PG8_LAS __attribute__((address_space(3)))
typedef unsigned short bf16_t;
typedef short bf16x8 __attribute__((ext_vector_type(8)));
typedef float f32x4 __attribute__((ext_vector_type(4)));
typedef unsigned u32x4 __attribute__((ext_vector_type(4)));
typedef unsigned u32x2 __attribute__((ext_vector_type(2)));
typedef int i32x4 __attribute__((ext_vector_type(4)));
typedef int i32x8 __attribute__((ext_vector_type(8)));
constexpr int BM = 256, BK = 64, HALF = 128, HTB = HALF * BK * 2  , STAGE_BYTES = 8 * HTB, NXCD = 8, WGM = 8;

__host__ __device__ __forceinline__ int lds_byte(int r, int c) { const int st = (r >> 4) * 2 + (c >> 5), rr = r & 15, cc = c & 31, ob = rr * 64 + cc * 2; return st * 1024 + (ob ^ (((ob >> 9) & 1) << 5)); }
__host__ __device__ __forceinline__ void stage_rc(int b, int& R, int& C) { const int st = b / 1024, sb = b % 1024, swz = sb ^ (((sb >> 9) & 1) << 5); R = (st >> 1) * 16 + swz / 64; C = (st & 1) * 32 + (swz % 64) / 2; }
__host__ __device__ __forceinline__ int perm32(int rho) { const int n = rho >> 4, i = rho & 15; return 8 * (i >> 2) + 4 * n + (i & 3); }

struct Unit { int pm, pn, e; };
struct Gemm { const bf16_t* A; const bf16_t* Bt; int K; size_t estride; const PG8_LAS unsigned short* tt; };

struct TileOrder {
    int nM, nN, nwg, G, c; const PG8_LAS int* tile_e;
    __device__ __forceinline__ void init(int nM_, int nN_, int G_, int c_, const PG8_LAS int* te) { nM = nM_; nN = nN_; nwg = nM * nN; G = G_; c = c_; tile_e = te; }
    __device__ __forceinline__ bool next(int i, Unit& u) const {
        const long L = (long)i * G + c; if (L >= nwg) return false;
        int wgid = (int)L; { const int q = nwg / NXCD, r = nwg % NXCD, xcd = wgid % NXCD, off = wgid / NXCD; wgid = (xcd < r ? xcd * (q + 1) : r * (q + 1) + (xcd - r) * q) + off; }
        const int nig = WGM * nN, gid = wgid / nig, fm = gid * WGM, gsz = (nM - fm) < WGM ? (nM - fm) : WGM;
        u.pm = fm + ((wgid % nig) % gsz); u.pn = (wgid % nig) / gsz;
        u.e = tile_e ? __builtin_amdgcn_readfirstlane(tile_e[u.pm]) : 0; return true;
    }
    static constexpr bool PUBLISH = false;
    __device__ __forceinline__ void a_ready(const Unit&, int) const {}
    __device__ __forceinline__ void done(const Unit&) const {}
    __device__ __forceinline__ void publish(int, int) const {}
};

struct MoeOrder : TileOrder {
    static constexpr bool PUBLISH = true;
    unsigned* cnt; unsigned rdy; int mode, xl, rrot;
    __device__ __forceinline__ bool local(int i, int& pm, int& pn) const {
        const int v = c & 7, T0 = (v * nM) >> 3, Tv = (((v + 1) * nM) >> 3) - T0;
        const int Lx = i * 32 + rrot; if (Lx >= Tv * nN) return false;
        const int nig = WGM * nN, gid = Lx / nig, fm = gid * WGM, gsz = (Tv - fm) < WGM ? (Tv - fm) : WGM, w = Lx % nig;
        pm = T0 + fm + (w % gsz); pn = w / gsz; return true;
    }
    __device__ __forceinline__ bool next(int i, Unit& u) const {
        if (!xl) return TileOrder::next(i, u);
        int pm, pn; if (!local(i, pm, pn)) return false;
        u.pm = pm; u.pn = pn; u.e = __builtin_amdgcn_readfirstlane(tile_e[pm]); return true;
    }
    __device__ __forceinline__ void publish(int pm, int lane) const {
        if (mode == 0 && lane == 0) (void)__hip_atomic_fetch_add(cnt + 32 * pm, 1u, __ATOMIC_RELAXED, __HIP_MEMORY_SCOPE_AGENT);
    }
    __device__ __forceinline__ void a_ready(const Unit& u, int i) const {
        if (mode != 1 || ((rdy >> i) & 1u)) return;
        if (__builtin_amdgcn_readfirstlane(threadIdx.x >> 6) == 0) {
            unsigned sp = 0;
            while (__hip_atomic_load(cnt + 32 * u.pm, __ATOMIC_RELAXED, __HIP_MEMORY_SCOPE_AGENT) < 64u) { __builtin_amdgcn_s_sleep(1); if (++sp > (1u << 20)) break; }
            __builtin_amdgcn_fence(__ATOMIC_ACQUIRE, "agent");
            asm volatile("s_waitcnt vmcnt(0)" ::: "memory");
        }
        __builtin_amdgcn_s_barrier();
    }
};

struct OneUnit {
    int pm, pn;
    __device__ __forceinline__ bool next(int i, Unit& u) const { if (i != 0) return false; u.pm = pm; u.pn = pn; u.e = 0; return true; }
    static constexpr bool PUBLISH = false;
    __device__ __forceinline__ void a_ready(const Unit&, int) const {}
    __device__ __forceinline__ void done(const Unit&) const {}
    __device__ __forceinline__ void publish(int, int) const {}
};

__device__ __forceinline__ unsigned cvt_pk_bf16(float lo, float hi) { unsigned r; asm volatile("v_cvt_pk_bf16_f32 %0, %1, %2" : "=v"(r) : "v"(lo), "v"(hi)); return r; }
__device__ __forceinline__ float fsigmoid(float x) { return __builtin_amdgcn_rcpf(1.0f + __expf(-x)); }


struct EpiHgrnIn {
    static constexpr bool PERM = true, AFTER_DRAIN = false;
    bf16_t* Q; size_t qstride; _Float16* LFF; size_t lfstride; const float* gamma; int mode;
    static __device__ __forceinline__ f32x4 vexp2(f32x4 t) { f32x4 e; e[0] = __builtin_amdgcn_exp2f(t[0]); e[1] = __builtin_amdgcn_exp2f(t[1]); e[2] = __builtin_amdgcn_exp2f(t[2]); e[3] = __builtin_amdgcn_exp2f(t[3]); return e; }
    static __device__ __forceinline__ f32x4 vrcp(f32x4 d) { f32x4 r; r[0] = __builtin_amdgcn_rcpf(d[0]); r[1] = __builtin_amdgcn_rcpf(d[1]); r[2] = __builtin_amdgcn_rcpf(d[2]); r[3] = __builtin_amdgcn_rcpf(d[3]); return r; }
    static __device__ __forceinline__ f32x4 vlog2(f32x4 d) { f32x4 r; r[0] = __builtin_amdgcn_logf(d[0]); r[1] = __builtin_amdgcn_logf(d[1]); r[2] = __builtin_amdgcn_logf(d[2]); r[3] = __builtin_amdgcn_logf(d[3]); return r; }
    __device__ __forceinline__ void operator()(const f32x4 (&acc)[2][2][4][2], const Unit& u, int wr, int wc, int fr, int fq) const {
        const int sg_ = u.pn >> 2, seg = mode == 0 ? sg_ : (mode == 1 ? (sg_ < 2 ? sg_ : 4) : 2 + sg_), cb = (u.pn & 3) * 256 + wc * 32 + 8 * fq;
        const int row0 = u.pm * BM + wr * 64 + fr;
        if (seg == 2 || seg == 3) {
            _Float16* O = LFF + (size_t)(seg - 2) * lfstride; const float* g0 = gamma + (seg - 2) * 2048 + cb;
            f32x4 lb[2][2];
#pragma unroll
            for (int bj = 0; bj < 2; ++bj)
#pragma unroll
                for (int n = 0; n < 2; ++n) { const f32x4 d = *(const f32x4*)(g0 + bj * HALF + 4 * n) - *(const f32x4*)(g0 + 1024 + bj * HALF + 4 * n);
                    lb[bj][n] = vrcp(vexp2(d * -1.4426950408889634f) + 1.0f); }
#pragma unroll
            for (int ai = 0; ai < 2; ++ai)
#pragma unroll
                for (int m = 0; m < 4; ++m) { _Float16* rowp = O + (size_t)(row0 + ai * HALF + m * 16) * 1024 + cb;
#pragma unroll
                    for (int bj = 0; bj < 2; ++bj) { typedef _Float16 h16x8 __attribute__((ext_vector_type(8))); h16x8 o;
#pragma unroll
                        for (int n = 0; n < 2; ++n) { const f32x4 sg = vrcp(vexp2(acc[ai][bj][m][n] * -1.4426950408889634f) + 1.0f);
                            const f32x4 lf = vlog2(lb[bj][n] + (1.0f - lb[bj][n]) * sg) * 0.6931471805599453f;
                            o[4 * n + 0] = (_Float16)lf[0]; o[4 * n + 1] = (_Float16)lf[1]; o[4 * n + 2] = (_Float16)lf[2]; o[4 * n + 3] = (_Float16)lf[3]; }
                        *(h16x8*)(rowp + bj * HALF) = o; } }
        } else {
            bf16_t* O = Q + (size_t)(seg - (seg >> 2) * 2) * qstride;
#pragma unroll
            for (int ai = 0; ai < 2; ++ai)
#pragma unroll
                for (int m = 0; m < 4; ++m) { bf16_t* rowp = O + (size_t)(row0 + ai * HALF + m * 16) * 1024 + cb;
#pragma unroll
                    for (int bj = 0; bj < 2; ++bj) { f32x4 v0 = acc[ai][bj][m][0], v1 = acc[ai][bj][m][1];
                        if (seg == 4) { v0 = v0 * vrcp(vexp2(v0 * -1.4426950408889634f) + 1.0f); v1 = v1 * vrcp(vexp2(v1 * -1.4426950408889634f) + 1.0f); }
                        u32x4 w; w.x = cvt_pk_bf16(v0[0], v0[1]); w.y = cvt_pk_bf16(v0[2], v0[3]); w.z = cvt_pk_bf16(v1[0], v1[1]); w.w = cvt_pk_bf16(v1[2], v1[3]);
                        *(u32x4*)(rowp + bj * HALF) = w; } }
        }
    }
};
template <bool BASE16, bool OUT16> struct EpiResGate {
    static constexpr bool PERM = false, AFTER_DRAIN = false;
    const void* base; void* out; const float* gate; int gate_bstride; int rows_per_batch; const float* bias;
    __device__ __forceinline__ void operator()(const f32x4 (&acc)[2][2][4][2], const Unit& u, int wr, int wc, int fr, int fq) const {
        const int row0 = u.pm * BM + wr * 64 + fr, col0 = u.pn * BM + wc * 32 + 4 * fq;
        const float* gv_ = gate + (size_t)((u.pm * BM) / rows_per_batch) * gate_bstride;
        f32x4 gv[2][2], bv[2][2];
#pragma unroll
        for (int bj = 0; bj < 2; ++bj)
#pragma unroll
            for (int n = 0; n < 2; ++n) { gv[bj][n] = *(const f32x4*)(gv_ + col0 + bj * HALF + n * 16); bv[bj][n] = bias ? *(const f32x4*)(bias + col0 + bj * HALF + n * 16) : (f32x4){0.f, 0.f, 0.f, 0.f}; }
#pragma unroll
        for (int ai = 0; ai < 2; ++ai)
#pragma unroll
            for (int m = 0; m < 4; ++m) { const size_t off = (size_t)(row0 + ai * HALF + m * 16) * 1024 + col0;
#pragma unroll
                for (int bj = 0; bj < 2; ++bj)
#pragma unroll
                    for (int n = 0; n < 2; ++n) { const size_t o = off + bj * HALF + n * 16; f32x4 bs;
                        if constexpr (BASE16) { const u32x2 w = *(const u32x2*)((const bf16_t*)base + o); bs = (f32x4){__builtin_bit_cast(float, w.x << 16), __builtin_bit_cast(float, w.x & 0xffff0000u), __builtin_bit_cast(float, w.y << 16), __builtin_bit_cast(float, w.y & 0xffff0000u)}; }
                        else bs = *(const f32x4*)((const float*)base + o);
                        const f32x4 r = bs + gv[bj][n] * (acc[ai][bj][m][n] + bv[bj][n]);
                        if constexpr (OUT16) *(u32x2*)((bf16_t*)out + o) = (u32x2){cvt_pk_bf16(r[0], r[1]), cvt_pk_bf16(r[2], r[3])};
                        else *(f32x4*)((float*)out + o) = r; } }
    }
};
template <int MODE, bool OUT8 = false, int OSCALE = 1, bool WT = false> struct EpiPair {
    static constexpr bool PERM = true, AFTER_DRAIN = false;
    bf16_t* O; const float* bias0;
    static __device__ __forceinline__ f32x4 vsig(f32x4 x, float negscale) {
        const f32x4 t = x * negscale; f32x4 e; e[0] = __builtin_amdgcn_exp2f(t[0]); e[1] = __builtin_amdgcn_exp2f(t[1]); e[2] = __builtin_amdgcn_exp2f(t[2]); e[3] = __builtin_amdgcn_exp2f(t[3]);
        const f32x4 d = e + 1.0f; f32x4 r; r[0] = __builtin_amdgcn_rcpf(d[0]); r[1] = __builtin_amdgcn_rcpf(d[1]); r[2] = __builtin_amdgcn_rcpf(d[2]); r[3] = __builtin_amdgcn_rcpf(d[3]); return r; }
    __device__ __forceinline__ void operator()(const f32x4 (&acc)[2][2][4][2], const Unit& u, int wr, int wc, int fr, int fq) const {
        const float* bias = bias0 + (MODE == 0 ? (size_t)u.e * 2048 : 0);
        const int row0 = u.pm * BM + wr * 64 + fr, cg = u.pn * HALF + wc * 32 + 8 * fq;
        f32x4 b0[2], b1[2];
#pragma unroll
        for (int n = 0; n < 2; ++n) { b0[n] = *(const f32x4*)(bias + cg + 4 * n); b1[n] = *(const f32x4*)(bias + 1024 + cg + 4 * n); }
#pragma unroll
        for (int ai = 0; ai < 2; ++ai)
#pragma unroll
            for (int m = 0; m < 4; ++m) { bf16_t* rowp = O + (size_t)(row0 + ai * HALF + m * 16) * 1024 + cg; f32x4 r[2];
#pragma unroll
                for (int n = 0; n < 2; ++n) { const f32x4 g = acc[ai][0][m][n] + b0[n], up = acc[ai][1][m][n] + b1[n];
                    if (MODE == 0) { const f32x4 gg = __builtin_elementwise_min(g, (f32x4){7.0f, 7.0f, 7.0f, 7.0f});
                        const f32x4 uu = __builtin_elementwise_min(__builtin_elementwise_max(up, (f32x4){-7.0f, -7.0f, -7.0f, -7.0f}), (f32x4){7.0f, 7.0f, 7.0f, 7.0f});
                        r[n] = (uu * (float)OSCALE + (float)OSCALE) * (gg * vsig(gg, -1.702f * 1.4426950408889634f)); }
                    else r[n] = (g * (float)OSCALE) * vsig(up, -1.4426950408889634f); }
                if constexpr (OUT8) {
                    int w0 = 0, w1 = 0;
                    w0 = __builtin_amdgcn_cvt_pk_fp8_f32(r[0][0], r[0][1], w0, false); w0 = __builtin_amdgcn_cvt_pk_fp8_f32(r[0][2], r[0][3], w0, true);
                    w1 = __builtin_amdgcn_cvt_pk_fp8_f32(r[1][0], r[1][1], w1, false); w1 = __builtin_amdgcn_cvt_pk_fp8_f32(r[1][2], r[1][3], w1, true);
                    if constexpr (WT) __hip_atomic_store((unsigned long long*)((unsigned char*)O + (size_t)(row0 + ai * HALF + m * 16) * 1024 + cg), ((unsigned long long)(unsigned)w1 << 32) | (unsigned)w0, __ATOMIC_RELAXED, __HIP_MEMORY_SCOPE_AGENT);
                    else *(u32x2*)((unsigned char*)O + (size_t)(row0 + ai * HALF + m * 16) * 1024 + cg) = (u32x2){(unsigned)w0, (unsigned)w1};
                } else {
                u32x4 w; w.x = cvt_pk_bf16(r[0][0], r[0][1]); w.y = cvt_pk_bf16(r[0][2], r[0][3]); w.z = cvt_pk_bf16(r[1][0], r[1][1]); w.w = cvt_pk_bf16(r[1][2], r[1][3]);
                *(u32x4*)rowp = w; } }
    }
};
template <bool OUT8, int OSCALE> struct EpiMoeOut {
    static constexpr bool PERM = true, AFTER_DRAIN = false;
    bf16_t* O; const float* bias0;
    __device__ __forceinline__ void operator()(const f32x4 (&acc)[2][2][4][2], const Unit& u, int wr, int wc, int fr, int fq) const {
        const float* bias = bias0 + (size_t)u.e * 1024;
        const int row0 = u.pm * BM + wr * 64 + fr, col0 = u.pn * BM + wc * 32 + 8 * fq;
        f32x4 bv[2][2];
#pragma unroll
        for (int bj = 0; bj < 2; ++bj)
#pragma unroll
            for (int n = 0; n < 2; ++n) bv[bj][n] = *(const f32x4*)(bias + col0 + bj * HALF + 4 * n);
#pragma unroll
        for (int ai = 0; ai < 2; ++ai)
#pragma unroll
            for (int m = 0; m < 4; ++m) { const int r = row0 + ai * HALF + m * 16;
#pragma unroll
                for (int bj = 0; bj < 2; ++bj) { const f32x4 v0 = acc[ai][bj][m][0] + bv[bj][0], v1 = acc[ai][bj][m][1] + bv[bj][1];
                    if constexpr (OUT8) { const f32x4 lim = (f32x4){448.0f, 448.0f, 448.0f, 448.0f};
                        const f32x4 s0 = __builtin_elementwise_min(__builtin_elementwise_max(v0 * (float)OSCALE, -lim), lim), s1 = __builtin_elementwise_min(__builtin_elementwise_max(v1 * (float)OSCALE, -lim), lim); int w0 = 0, w1 = 0;
                        w0 = __builtin_amdgcn_cvt_pk_fp8_f32(s0[0], s0[1], w0, false); w0 = __builtin_amdgcn_cvt_pk_fp8_f32(s0[2], s0[3], w0, true);
                        w1 = __builtin_amdgcn_cvt_pk_fp8_f32(s1[0], s1[1], w1, false); w1 = __builtin_amdgcn_cvt_pk_fp8_f32(s1[2], s1[3], w1, true);
                        *(u32x2*)((unsigned char*)O + (size_t)r * 1024 + col0 + bj * HALF) = (u32x2){(unsigned)w0, (unsigned)w1};
                    } else { u32x4 w; w.x = cvt_pk_bf16(v0[0], v0[1]); w.y = cvt_pk_bf16(v0[2], v0[3]); w.z = cvt_pk_bf16(v1[0], v1[1]); w.w = cvt_pk_bf16(v1[2], v1[3]);
                        *(u32x4*)(O + (size_t)r * 1024 + col0 + bj * HALF) = w; } } }
    }
};

template <class Epi, class Sched, bool ALIGN_EPI = false, bool SP2 = false, bool F8 = false, int SCW = 0x7F7F7F7F, int SCA = 0x7F7F7F7F, bool GATHER = false, int NS = 0>
__device__ __forceinline__ void gemm_phase(PG8_LAS unsigned char* lds, const Gemm g, const Sched& S, const Epi& E) {
    const int tid = threadIdx.x, wid = __builtin_amdgcn_readfirstlane(tid >> 6), lane = tid & 63, wr = wid >> 2, wc = wid & 3, fr = lane & 15, fq = lane >> 4;
    const int K = g.K, nt = K / BK;
    unsigned voffA[2], voffB[2]; int stR[2], stC[2];
#pragma unroll
    for (int i = 0; i < 2; ++i) { int R, C; stage_rc(tid * 16 + i * 8192, R, C); const int Rb = Epi::PERM ? ((R & ~31) + perm32(R & 31)) : R; stR[i] = R; stC[i] = C;
        voffA[i] = (unsigned)(R * K + C) * 2u; voffB[i] = (unsigned)(Rb * K + C) * 2u; }
    const size_t kstep = (size_t)(BK * 2);
    const size_t hstep = (size_t)HALF * K * 2;
    const size_t tstep = 2 * hstep;
    unsigned vc[2][2], vn[2][2];
#pragma unroll
    for (int h = 0; h < 2; ++h)
#pragma unroll
        for (int i = 0; i < 2; ++i) {
            if constexpr (GATHER) vc[h][i] = (unsigned)g.tt[h * HALF + stR[i]] * (unsigned)(K * 2) + (unsigned)stC[i] * 2u;
            else vc[h][i] = voffA[i] + (unsigned)h * (unsigned)hstep;
            vn[h][i] = vc[h][i]; }
    const unsigned ldsw = (unsigned)wid * 1024u;
    const int aoff = lds_byte(wr * 64 + fr, fq * 8), boff = lds_byte(wc * 32 + fr, fq * 8);
#define PG8_SA(b, h) (((b) * 2 + (h)) * HTB)
#define PG8_SB(b, h) ((4 + (b) * 2 + (h)) * HTB)
#define PG8_STAGE(bufoff, gbase, voff) do { _Pragma("unroll") for (int _i = 0; _i < 2; ++_i) \
        __builtin_amdgcn_global_load_lds((const unsigned*)((const char*)(gbase) + (voff)[_i]), (PG8_LAS unsigned*)(lds + (bufoff) + ldsw + _i * 8192), 16, 0, 0); } while (0)
#define PG8_LDA(dst, b, h) do { _Pragma("unroll") for (int m = 0; m < 4; ++m) _Pragma("unroll") for (int k = 0; k < 2; ++k) dst[m][k] = *(const PG8_LAS bf16x8*)(lds + PG8_SA(b, h) + aoff + m * 2048 + k * 1024); } while (0)
#define PG8_LDB(dst, b, h) do { _Pragma("unroll") for (int n = 0; n < 2; ++n) _Pragma("unroll") for (int k = 0; k < 2; ++k) dst[n][k] = *(const PG8_LAS bf16x8*)(lds + PG8_SB(b, h) + boff + n * 2048 + k * 1024); } while (0)
#define PG8_MMA(ai, bj, At, Bt) do { __builtin_amdgcn_s_setprio(1); \
        if constexpr (!F8) { _Pragma("unroll") for (int m = 0; m < 4; ++m) _Pragma("unroll") for (int n = 0; n < 2; ++n) _Pragma("unroll") for (int k = 0; k < 2; ++k) \
            acc[ai][bj][m][n] = __builtin_amdgcn_mfma_f32_16x16x32_bf16(Bt[n][k], At[m][k], acc[ai][bj][m][n], 0, 0, 0); } \
        else { const int scw_ = SCW, sca_ = SCA; _Pragma("unroll") for (int m = 0; m < 4; ++m) _Pragma("unroll") for (int n = 0; n < 2; ++n) { \
            const i32x8 wf_ = __builtin_shufflevector(__builtin_bit_cast(i32x4, Bt[n][0]), __builtin_bit_cast(i32x4, Bt[n][1]), 0, 1, 2, 3, 4, 5, 6, 7); \
            const i32x8 af_ = __builtin_shufflevector(__builtin_bit_cast(i32x4, At[m][0]), __builtin_bit_cast(i32x4, At[m][1]), 0, 1, 2, 3, 4, 5, 6, 7); \
            asm volatile("v_mfma_scale_f32_16x16x128_f8f6f4 %0, %1, %2, %0, %3, %4 op_sel_hi:[0,0,0]" : "+v"(acc[ai][bj][m][n]) : "v"(wf_), "v"(af_), "v"(scw_), "v"(sca_)); } } \
        __builtin_amdgcn_s_setprio(0); } while (0)
#define PG8_WAIT_V(n) asm volatile("s_waitcnt vmcnt(" #n ")" ::: "memory")
#define PG8_WAIT_VN(n) asm volatile("s_waitcnt vmcnt(%0)" :: "n"(n) : "memory")
#define PG8_WAIT_L(n) asm volatile("s_waitcnt lgkmcnt(" #n ")" ::: "memory")
#define PG8_BAR __builtin_amdgcn_s_barrier()
#define PG8_SCHED __builtin_amdgcn_sched_barrier(0)
    Unit cur, nxt; int ui = 0, ppm = 0;
    if (!S.next(0, cur)) return;
    f32x4 acc[2][2][4][2];
#pragma unroll
    for (int a = 0; a < 2; ++a)
#pragma unroll
        for (int b = 0; b < 2; ++b)
#pragma unroll
            for (int m = 0; m < 4; ++m)
#pragma unroll
                for (int n = 0; n < 2; ++n) acc[a][b][m][n] = (f32x4){0.f, 0.f, 0.f, 0.f};
    bf16x8 At[4][2], B0[2][2], B1[2][2];
    const char* cA = (const char*)g.A + (GATHER ? (size_t)0 : (size_t)cur.pm * tstep); const char* cB = (const char*)g.Bt + (size_t)cur.e * g.estride + (size_t)cur.pn * tstep;
    S.a_ready(cur, 0);
    if constexpr (SP2) {
        PG8_STAGE(PG8_SB(0, 0), cB, voffB); PG8_STAGE(PG8_SB(0, 1), cB + hstep, voffB); PG8_STAGE(PG8_SA(0, 0), cA, vc[0]); PG8_STAGE(PG8_SA(0, 1), cA, vc[1]);
        if (wr == 1) PG8_BAR;
        PG8_WAIT_V(2); PG8_BAR;
        PG8_STAGE(PG8_SB(1, 0), cB + kstep, voffB); PG8_STAGE(PG8_SA(1, 0), cA + kstep, vc[0]); PG8_STAGE(PG8_SB(1, 1), cB + hstep + kstep, voffB);
        PG8_WAIT_V(6); PG8_BAR;
    } else {
        PG8_STAGE(PG8_SB(0, 0), cB, voffB); PG8_STAGE(PG8_SA(0, 0), cA, vc[0]); PG8_STAGE(PG8_SB(0, 1), cB + hstep, voffB); PG8_STAGE(PG8_SA(0, 1), cA, vc[1]);
        if (wr == 1) PG8_BAR;
        PG8_WAIT_V(4); PG8_BAR;
        PG8_STAGE(PG8_SB(1, 0), cB + kstep, voffB); PG8_STAGE(PG8_SA(1, 0), cA + kstep, vc[0]); PG8_STAGE(PG8_SB(1, 1), cB + hstep + kstep, voffB);
        PG8_WAIT_V(6); PG8_BAR;
    }
    for (;;) {
        const bool has_next = S.next(ui + 1, nxt);
        if constexpr (GATHER) { if (has_next) {
#pragma unroll
            for (int h = 0; h < 2; ++h)
#pragma unroll
                for (int i = 0; i < 2; ++i) vn[h][i] = (unsigned)g.tt[(ui + 1) * BM + h * HALF + stR[i]] * (unsigned)(K * 2) + (unsigned)stC[i] * 2u; } }
        const char* nA = (has_next && !GATHER) ? (const char*)g.A + (size_t)nxt.pm * tstep : cA; const char* nB = has_next ? (const char*)g.Bt + (size_t)nxt.e * g.estride + (size_t)nxt.pn * tstep : cB;
        for (int t = 0; t < nt; t += 2) {
            const bool last = (t == nt - 2);
            unsigned vs[2][2];
#pragma unroll
            for (int h = 0; h < 2; ++h)
#pragma unroll
                for (int i = 0; i < 2; ++i) vs[h][i] = (GATHER && last) ? vn[h][i] : vc[h][i];
            const char* a1 = cA + (size_t)(t + 1) * kstep;
            const char* a2 = last ? nA : cA + (size_t)(t + 2) * kstep; const char* b2 = last ? nB : cB + (size_t)(t + 2) * kstep;
            const char* a3 = a2 + kstep; const char* b3 = b2 + kstep;
            if (last && has_next) S.a_ready(nxt, ui + 1);
            if constexpr (Sched::PUBLISH) { if (t == 2 && ui > 0) S.publish(ppm, lane); }
            if constexpr (SP2) {
            const bool rlx = (NS > 0) && (t == 0) && (ui > 0);
#define PG8_WAIT_V8R do { if constexpr (NS > 0) { PG8_WAIT_VN(8 + NS); if (!rlx) PG8_WAIT_V(8); } else PG8_WAIT_V(8); } while (0)
            PG8_LDB(B0, 0, 0); PG8_LDB(B1, 0, 1); PG8_SCHED; PG8_LDA(At, 0, 0); if (!rlx) PG8_STAGE(PG8_SA(1, 1), a1, vc[1]);
            PG8_WAIT_V8R; PG8_WAIT_L(0); PG8_BAR; PG8_MMA(0, 0, At, B0); PG8_MMA(0, 1, At, B1); PG8_BAR; PG8_SCHED;
            PG8_LDA(At, 0, 1); PG8_STAGE(PG8_SB(0, 0), b2, voffB); PG8_STAGE(PG8_SB(0, 1), b2 + hstep, voffB); PG8_STAGE(PG8_SA(0, 0), a2, vs[0]);
            PG8_WAIT_V8R; PG8_WAIT_L(0); PG8_BAR; PG8_MMA(1, 0, At, B0); PG8_MMA(1, 1, At, B1); PG8_BAR; PG8_SCHED;
            PG8_LDB(B0, 1, 0); PG8_LDB(B1, 1, 1); PG8_SCHED; PG8_LDA(At, 1, 0); PG8_STAGE(PG8_SA(0, 1), a2, vs[1]);
            PG8_WAIT_V8R; PG8_WAIT_L(0); PG8_BAR; PG8_MMA(0, 0, At, B0); PG8_MMA(0, 1, At, B1); PG8_BAR; PG8_SCHED;
            PG8_LDA(At, 1, 1); PG8_STAGE(PG8_SB(1, 0), b3, voffB); PG8_STAGE(PG8_SB(1, 1), b3 + hstep, voffB); PG8_STAGE(PG8_SA(1, 0), a3, vs[0]);
            PG8_WAIT_V(8); PG8_WAIT_L(0); PG8_BAR; PG8_MMA(1, 0, At, B0); PG8_MMA(1, 1, At, B1); PG8_BAR; PG8_SCHED;
            } else {
            PG8_LDB(B0, 0, 0); PG8_SCHED; PG8_LDA(At, 0, 0); PG8_STAGE(PG8_SA(1, 1), a1, vc[1]);
            PG8_WAIT_L(8); PG8_BAR; PG8_WAIT_L(0); PG8_MMA(0, 0, At, B0); PG8_BAR; PG8_SCHED;
            PG8_LDB(B1, 0, 1); PG8_STAGE(PG8_SB(0, 0), b2, voffB);
            PG8_BAR; PG8_WAIT_L(0); PG8_MMA(0, 1, At, B1); PG8_BAR;
            PG8_LDA(At, 0, 1); PG8_STAGE(PG8_SA(0, 0), a2, vs[0]);
            PG8_BAR; PG8_WAIT_L(0); PG8_MMA(1, 0, At, B0); PG8_BAR; PG8_SCHED;
            PG8_STAGE(PG8_SB(0, 1), b2 + hstep, voffB);
            PG8_WAIT_V(6); PG8_BAR; PG8_MMA(1, 1, At, B1); PG8_BAR;
            PG8_LDB(B0, 1, 0); PG8_SCHED; PG8_LDA(At, 1, 0); PG8_STAGE(PG8_SA(0, 1), a2, vs[1]);
            PG8_WAIT_L(8); PG8_BAR; PG8_WAIT_L(0); PG8_MMA(0, 0, At, B0); PG8_BAR; PG8_SCHED;
            PG8_LDB(B1, 1, 1); PG8_STAGE(PG8_SB(1, 0), b3, voffB);
            PG8_BAR; PG8_WAIT_L(0); PG8_MMA(0, 1, At, B1); PG8_BAR;
            PG8_LDA(At, 1, 1); PG8_STAGE(PG8_SA(1, 0), a3, vs[0]);
            PG8_BAR; PG8_WAIT_L(0); PG8_MMA(1, 0, At, B0); PG8_BAR; PG8_SCHED;
            PG8_STAGE(PG8_SB(1, 1), b3 + hstep, voffB);
            PG8_WAIT_V(6); PG8_BAR; PG8_MMA(1, 1, At, B1); PG8_BAR;
            }
        }
        if constexpr (ALIGN_EPI) { if (wr == 0) PG8_BAR; }
        if constexpr (NS > 0) { static_assert(SP2 && ALIGN_EPI, "NS needs SP2 and ALIGN_EPI"); if (has_next) PG8_STAGE(PG8_SA(1, 1), nA + kstep, vn[1]); }
        if constexpr (!Epi::AFTER_DRAIN) { E(acc, cur, wr, wc, fr, fq); S.done(cur); ppm = cur.pm; }
        if (!has_next) break;
#pragma unroll
        for (int a = 0; a < 2; ++a)
#pragma unroll
            for (int b = 0; b < 2; ++b)
#pragma unroll
                for (int m = 0; m < 4; ++m)
#pragma unroll
                    for (int n = 0; n < 2; ++n) acc[a][b][m][n] = (f32x4){0.f, 0.f, 0.f, 0.f};
        cur = nxt; cA = nA; cB = nB; ++ui;
        if constexpr (GATHER) {
#pragma unroll
            for (int h = 0; h < 2; ++h)
#pragma unroll
                for (int i = 0; i < 2; ++i) vc[h][i] = vn[h][i]; }
        if constexpr (ALIGN_EPI) { if (wr == 1) PG8_BAR; }
    }
    PG8_WAIT_V(0); if constexpr (Sched::PUBLISH) S.publish(ppm, lane);
    if constexpr (!ALIGN_EPI) { if (wr == 0) PG8_BAR; }
    PG8_BAR;
    if constexpr (Epi::AFTER_DRAIN) { E.fused(acc, cur, wr, wc, fr, fq, lds, wid, lane); S.done(cur); }
#undef PG8_SA
#undef PG8_SB
#undef PG8_STAGE
#undef PG8_LDA
#undef PG8_LDB
#undef PG8_MMA
#undef PG8_WAIT_V
#undef PG8_WAIT_VN
#undef PG8_WAIT_V8R
#undef PG8_WAIT_L
#undef PG8_BAR
#undef PG8_SCHED
}
}


constexpr int D = 1024, NBATCH = 2, SEQ = 16384, NTOK = NBATCH * SEQ, CTXL = 256, NCTX = NBATCH * CTXL, MROWS = NTOK + NCTX;
constexpr int NHEAD = 8, DK = 128, NE = 32, TOPK = 4, CONVW = 31, GRIDW = 64, GRIDR = SEQ / GRIDW;
constexpr int NWAVES = 8, NTHR = NWAVES * 64;
constexpr int MAXTILES = 544;
constexpr float EPS = 1e-6f;
enum { I_X = 0, I_C, I_CTX, I_CCTX, I_WADA, I_BADA, I_GMIX, I_GFFN, I_WHIN, I_HGAMMA, I_GHOUT, I_WHOUT, I_WCVIN, I_BCVIN, I_WCVDW, I_BCVDW, I_GCVLN, I_BCVLN, I_WCVOUT, I_BCVOUT,
       I_WR, I_BR, I_WE1, I_BE1, I_WE2, I_BE2, I_GFINAL, N_IN };

constexpr size_t MiB = 1u << 20;
constexpr size_t WS_CTL = 0, CTL_ZERO_BYTES = 1 * MiB;
constexpr size_t WS_MODS = 1 * MiB;
constexpr size_t WS_TOPE = 2 * MiB, WS_TOPW = 2 * MiB + 512 * 1024, WS_POS = 3 * MiB, WS_BCNT = 3 * MiB + 512 * 1024, WS_TILEE = WS_BCNT + 64 * 1024, WS_SLOTW = 4 * MiB;
constexpr size_t WS_SP = 5 * MiB, WS_SD = 8 * MiB;
constexpr size_t WS_WIN = 48 * MiB, WS_WOUT = 58 * MiB, WS_WCVIN = 60 * MiB, WS_WCVOUT = 64 * MiB, WS_W1 = 66 * MiB, WS_W2 = 322 * MiB;
constexpr size_t WS_X = 450 * MiB;
constexpr size_t WS_H = 578 * MiB;
constexpr size_t WS_Q = 644 * MiB, WS_V = 709 * MiB, WS_SG = 774 * MiB, WS_LFF = 839 * MiB, WS_LFB = 969 * MiB, WS_OF = 1099 * MiB, WS_OB = 1227 * MiB, WS_YIN = 1355 * MiB;
constexpr size_t WS_AS = 1419 * MiB, WS_ACT = 1555 * MiB, WS_YS = 1691 * MiB, WS_END = 1963 * MiB;
#ifndef F8_IN
#define F8_IN 0
#endif
#ifndef SPLIT_IN
#define SPLIT_IN 1
#endif
#ifndef F8_Y
#define F8_Y 1
#endif
constexpr int YSCALE = 16;
#ifndef F8_MISC
#define F8_MISC 1
#endif
constexpr size_t WS_H8 = WS_OF + 64 * MiB;
constexpr size_t WS_WIN8 = WS_WIN + 6 * MiB;
constexpr size_t WS_STOK = WS_AS;
constexpr int CW_MODF = 3200;
constexpr int CW_FLAT = 3072;
constexpr int CW_GCNT = 2048;
constexpr float W8SCALE = 64.0f;
constexpr size_t WS_U = WS_Q, WS_ZP = WS_V, WS_Z = WS_SG;
constexpr int CW_BAR = 4096;
constexpr int CW_XMAP = 32768;
constexpr int CW_TCNT = 65536;

constexpr int RING_OFF = 0, RING_BYTES = 131072;
constexpr int LDSCTL_OFF = 139264, MISC_OFF = LDSCTL_OFF + 320, EXTRA_OFF = LDSCTL_OFF + 1024;
constexpr int LDS_BYTES = 155648;

#define LAS __attribute__((address_space(3)))
typedef unsigned short bf16;
typedef unsigned v4u __attribute__((ext_vector_type(4)));
typedef unsigned v2u __attribute__((ext_vector_type(2)));
typedef float f32x4 __attribute__((ext_vector_type(4)));
typedef int v4i __attribute__((ext_vector_type(4)));
#define LDS_WAIT() asm volatile("s_waitcnt lgkmcnt(0)" ::: "memory")
#define VM_WAIT() asm volatile("s_waitcnt vmcnt(0)" ::: "memory")
__device__ __forceinline__ unsigned f2bf(float f) { unsigned u = __builtin_bit_cast(unsigned, f); return (u + 0x7fffu + ((u >> 16) & 1u)) >> 16; }
__device__ __forceinline__ unsigned pk2(float lo, float hi) { return f2bf(lo) | (f2bf(hi) << 16); }
__device__ __forceinline__ float bf_lo(unsigned u) { return __builtin_bit_cast(float, u << 16); }
__device__ __forceinline__ float bf_hi(unsigned u) { return __builtin_bit_cast(float, u & 0xffff0000u); }
__device__ __forceinline__ float bf2f(bf16 h) { return __builtin_bit_cast(float, ((unsigned)h) << 16); }
__device__ __forceinline__ float fsig(float x) { return __builtin_amdgcn_rcpf(1.0f + __expf(-x)); }
__device__ __forceinline__ float wave_sum(float v) {
#pragma unroll
    for (int o = 1; o < 64; o <<= 1) v += __shfl_xor(v, o);
    return v;
}

__device__ __forceinline__ float sat8(float x) { return __builtin_amdgcn_fmed3f(x, -448.0f, 448.0f); }
__device__ __forceinline__ unsigned pk4_fp8(float a, float b, float c, float d) { int w = 0; w = __builtin_amdgcn_cvt_pk_fp8_f32(sat8(a), sat8(b), w, false); w = __builtin_amdgcn_cvt_pk_fp8_f32(sat8(c), sat8(d), w, true); return (unsigned)w; }
template <bool OUT8> __device__ __forceinline__ void store_row4(void* orow, int lane, int j, f32x4 y, float scale) {
    if constexpr (OUT8) ((unsigned*)orow)[lane + 64 * j] = pk4_fp8(y.x * scale, y.y * scale, y.z * scale, y.w * scale);
    else { v2u w; w.x = pk2(y.x, y.y); w.y = pk2(y.z, y.w); ((v2u*)orow)[lane + 64 * j] = w; }
}

#define XB_TMO      128
#define XB_XCNT(j)  (256  + 64 * (j))
#define XB_XSUB(j)  (1280 + 64 * (j))
#define XB_XGEN(j)  (2304 + 64 * (j))
#define XB_TOP      3328
#define XB_TOPGEN   3392
#define XCD_BAR_WORDS 3456
#define XB_SPIN_CAP (1u << 18)

__device__ __forceinline__ unsigned xb_ld(unsigned* p)              { return __hip_atomic_load(p, __ATOMIC_RELAXED, __HIP_MEMORY_SCOPE_AGENT); }
__device__ __forceinline__ unsigned xb_add(unsigned* p, unsigned v) { return __hip_atomic_fetch_add(p, v, __ATOMIC_RELAXED, __HIP_MEMORY_SCOPE_AGENT); }
__device__ __forceinline__ unsigned xb_xcc_id() { return (unsigned)__builtin_amdgcn_s_getreg((3 << 11) | 20) & 0xFu; }
#define XB_SPIN(cond, bar) do { unsigned _sp = 0; while (cond) { __builtin_amdgcn_s_sleep(1); \
    if ((++_sp & 255u) == 0u) { if (xb_ld(&(bar)[XB_TMO])) break; if (_sp > XB_SPIN_CAP) { atomicAdd(&(bar)[XB_TMO], 1u); break; } } } } while (0)

struct XcdBarrier {
    unsigned* bar; unsigned x;
    volatile LAS unsigned* st;
};

__device__ __forceinline__ XcdBarrier xcd_barrier_post(unsigned* bar, volatile LAS unsigned* st) {
    XcdBarrier b; b.bar = bar; b.x = xb_xcc_id(); b.st = st;
    if (threadIdx.x == 0) (void)xb_add(&bar[XB_XCNT(b.x)], 1u);
    return b;
}
__device__ __forceinline__ void xcd_barrier_complete(unsigned* bar, unsigned x, unsigned& nloc, unsigned& nx) {
    const unsigned G = gridDim.x * gridDim.y * gridDim.z;
    unsigned sum, cnt, mine, sp = 0u;
    for (;;) {
        sum = 0u; cnt = 0u; mine = 0u;
#pragma unroll
        for (unsigned j = 0; j < 16; ++j) { const unsigned c = xb_ld(&bar[XB_XCNT(j)]); sum += c; cnt += (c > 0u) ? 1u : 0u; mine = (j == x) ? c : mine; }
        if (sum == G) break;
        __builtin_amdgcn_s_sleep(1);
        if ((++sp & 255u) == 0u) { if (xb_ld(&bar[XB_TMO])) break; if (sp > XB_SPIN_CAP) { atomicAdd(&bar[XB_TMO], 1u); break; } }
    }
    nloc = mine > 0u ? mine : 1u; nx = cnt > 0u ? cnt : 1u;
}

__device__ __forceinline__ void xcd_barrier(const XcdBarrier& b) {
    asm volatile("s_waitcnt vmcnt(0)" ::: "memory");
    __syncthreads();
    if (threadIdx.x == 0) {
        unsigned* bar = b.bar;
        __builtin_amdgcn_s_waitcnt(0);
        unsigned nloc = b.st[0], nx = b.st[1];
        if (nloc == 0u) { xcd_barrier_complete(bar, b.x, nloc, nx); b.st[0] = nloc; b.st[1] = nx; }
        const unsigned old = xb_add(&bar[XB_XSUB(b.x)], 1u);
        const unsigned gen = old / nloc;
        if (old + 1u == (gen + 1u) * nloc) {
            __builtin_amdgcn_fence(__ATOMIC_RELEASE, "agent");
            asm volatile("s_waitcnt vmcnt(0)" ::: "memory");
            const unsigned og = xb_add(&bar[XB_TOP], 1u);
            const unsigned tg = og / nx;
            if (og + 1u == (tg + 1u) * nx) xb_add(&bar[XB_TOPGEN], 1u);
            else XB_SPIN(xb_ld(&bar[XB_TOPGEN]) == tg, bar);
            __builtin_amdgcn_fence(__ATOMIC_ACQUIRE, "agent");
            xb_add(&bar[XB_XGEN(b.x)], 1u);
            asm volatile("s_waitcnt vmcnt(0)" ::: "memory");
        } else {
            XB_SPIN(xb_ld(&bar[XB_XGEN(b.x)]) == gen, bar);
            __builtin_amdgcn_fence(__ATOMIC_ACQUIRE, "agent");
            asm volatile("s_waitcnt vmcnt(0)" ::: "memory");
        }
    }
    __syncthreads();
}

struct Args { const float* in[N_IN]; float* out; unsigned char* ws; int ph_lo, ph_hi, li, pad; };

__device__ __forceinline__ void p_mods(const Args& a, LAS unsigned char* lds, int tid, int lane, int wave) {
    LAS float* sc = (LAS float*)lds;
    LAS float* part = sc + 3 * D;
    float* MODS = (float*)(a.ws + WS_MODS);
    for (int i = tid; i < 3 * D; i += NTHR) { const int r = i >> 10, k = i & 1023; const float v = r < 2 ? a.in[I_C][r * D + k] : a.in[I_CCTX][k]; sc[i] = v * fsig(v); }
    __syncthreads();
    for (int item = blockIdx.x; item < 2 * 96; item += gridDim.x) {
        const int l = item / 96, cb = item % 96;
        const float* W = a.in[I_WADA] + (size_t)l * D * 6 * D + cb * 64 + lane;
        float a0 = 0.f, a1 = 0.f, a2 = 0.f;
#pragma unroll 16
        for (int kk = 0; kk < 128; ++kk) { const int k = wave * 128 + kk; const float w = W[(size_t)k * (6 * D)]; a0 += sc[k] * w; a1 += sc[D + k] * w; a2 += sc[2 * D + k] * w; }
        part[(wave * 3 + 0) * 64 + lane] = a0; part[(wave * 3 + 1) * 64 + lane] = a1; part[(wave * 3 + 2) * 64 + lane] = a2;
        __syncthreads();
        if (tid < 192) { const int r = tid >> 6, ln = tid & 63; float s = 0.f;
#pragma unroll
            for (int w = 0; w < 8; ++w) s += part[(w * 3 + r) * 64 + ln];
            __hip_atomic_store(&MODS[(size_t)(l * 3 + r) * (6 * D) + cb * 64 + ln], s + a.in[I_BADA][l * 6 * D + cb * 64 + ln], __ATOMIC_RELAXED, __HIP_MEMORY_SCOPE_AGENT); }
        asm volatile("s_waitcnt vmcnt(0)" ::: "memory");
        __syncthreads();
        if (item < 32 && tid == 0) (void)__hip_atomic_fetch_add((unsigned*)(a.ws + WS_CTL) + CW_MODF, 1u, __ATOMIC_RELAXED, __HIP_MEMORY_SCOPE_AGENT);
    }
}
__device__ __forceinline__ void wait_mods0(const Args& a, int tid) {
    if (tid == 0) { unsigned* f = (unsigned*)(a.ws + WS_CTL) + CW_MODF; unsigned sp = 0;
        while (__hip_atomic_load(f, __ATOMIC_RELAXED, __HIP_MEMORY_SCOPE_AGENT) < 32u) { __builtin_amdgcn_s_sleep(2); if (++sp > (1u << 22)) break; }
        __builtin_amdgcn_fence(__ATOMIC_ACQUIRE, "agent");
        asm volatile("s_waitcnt vmcnt(0)" ::: "memory"); }
    __syncthreads();
}
template <bool OUT8> __device__ __forceinline__ void transpose_item(const float* W, int K, int N, bf16* WT, bool paired, LAS float* scr, int item, int lane, int row_adj = 0) {
    const int nblk = N / 32, kb = item / nblk, nb = item % nblk, k0 = 64 * kb, n0 = 32 * nb;
    int d0 = n0 + row_adj; if (paired) { const int half = n0 >> 10, c = n0 & 1023; d0 = (c >> 7) * 256 + half * 128 + (c & 127); }
    float t[32];
#pragma unroll
    for (int i = 0; i < 32; ++i) { const int kk = 2 * i + (lane >> 5); t[i] = __builtin_nontemporal_load(&W[(size_t)(k0 + kk) * N + n0 + (lane & 31)]); }
#pragma unroll
    for (int i = 0; i < 32; ++i) { const int kk = 2 * i + (lane >> 5); scr[kk * 33 + (lane & 31)] = t[i]; }
    LDS_WAIT(); asm volatile("" ::: "memory");
    const int c = lane & 7;
#pragma unroll
    for (int j = 0; j < 4; ++j) { const int n = (lane >> 3) + 8 * j; const LAS float* s = scr + (8 * c) * 33 + n;
        if constexpr (OUT8) {
            int w0 = 0, w1 = 0;
            w0 = __builtin_amdgcn_cvt_pk_fp8_f32(s[0 * 33] * W8SCALE, s[1 * 33] * W8SCALE, w0, false); w0 = __builtin_amdgcn_cvt_pk_fp8_f32(s[2 * 33] * W8SCALE, s[3 * 33] * W8SCALE, w0, true);
            w1 = __builtin_amdgcn_cvt_pk_fp8_f32(s[4 * 33] * W8SCALE, s[5 * 33] * W8SCALE, w1, false); w1 = __builtin_amdgcn_cvt_pk_fp8_f32(s[6 * 33] * W8SCALE, s[7 * 33] * W8SCALE, w1, true);
            *(v2u*)((unsigned char*)WT + (size_t)(d0 + n) * K + k0 + 8 * c) = (v2u){(unsigned)w0, (unsigned)w1};
        } else {
        v4u o; o.x = pk2(s[0 * 33], s[1 * 33]); o.y = pk2(s[2 * 33], s[3 * 33]); o.z = pk2(s[4 * 33], s[5 * 33]); o.w = pk2(s[6 * 33], s[7 * 33]);
        *(v4u*)(WT + (size_t)(d0 + n) * K + k0 + 8 * c) = o; } }
    LDS_WAIT(); asm volatile("" ::: "memory");
}
__device__ __forceinline__ void p_weights(const Args& a, LAS unsigned char* lds, int lane, int wave) {
    LAS float* scr = (LAS float*)(lds + RING_OFF + wave * 16384);
    const int gw = blockIdx.x * NWAVES + wave, NGW = gridDim.x * NWAVES;
    constexpr int I_IN = 16 * 160, I_SQ = 16 * 32, I_CV = 16 * 64, I_E1 = 64 * 1024, I_E2 = 64 * 512;
    constexpr int NITEMS = I_IN + I_SQ + I_CV + I_SQ + I_E1 + I_E2;
    unsigned char* ws = a.ws;
    for (int it = (gridDim.x == 256 ? I_E1 + I_E2 : 0) + gw; it < NITEMS; it += NGW) {
        int r = it;
        if (r < I_E1) { const int mi = r >> 10; transpose_item<true>(a.in[I_WE1] + (size_t)mi * D * 2 * D, D, 2 * D, (bf16*)(ws + WS_W1 + (size_t)mi * 2 * D * D), true, scr, r & 1023, lane); continue; } r -= I_E1;
        if (r < I_E2) { const int mi = r >> 9; transpose_item<true>(a.in[I_WE2] + (size_t)mi * D * D, D, D, (bf16*)(ws + WS_W2 + (size_t)mi * D * D), false, scr, r & 511, lane); continue; } r -= I_E2;
        if (r < I_IN) {
            if (SPLIT_IN) { const int sgm = ((r % 160) * 32) >> 10;
                if (sgm == 2 || sgm == 3) transpose_item<true>(a.in[I_WHIN], D, 5 * D, (bf16*)(ws + WS_WIN8), false, scr, r, lane, -2 * D);
                else transpose_item<false>(a.in[I_WHIN], D, 5 * D, (bf16*)(ws + WS_WIN), false, scr, r, lane, sgm == 4 ? -2 * D : 0);
            } else transpose_item<F8_IN != 0>(a.in[I_WHIN], D, 5 * D, (bf16*)(ws + WS_WIN), false, scr, r, lane);
            continue; } r -= I_IN;
        if (r < I_SQ) { transpose_item<F8_MISC != 0>(a.in[I_WHOUT], D, D, (bf16*)(ws + WS_WOUT), false, scr, r, lane); continue; } r -= I_SQ;
        if (r < I_CV) { transpose_item<F8_MISC != 0>(a.in[I_WCVIN], D, 2 * D, (bf16*)(ws + WS_WCVIN), true, scr, r, lane); continue; } r -= I_CV;
        transpose_item<F8_MISC != 0>(a.in[I_WCVOUT], D, D, (bf16*)(ws + WS_WCVOUT), false, scr, r, lane);
    }
}
constexpr int CV_WAVES = 7, CV_L0 = 32 * 512 + 32 * 256, CV_ALL = 2 * CV_L0;
__device__ __forceinline__ void transpose_item64(const float* W, int K, int N, unsigned char* WT, bool paired, LAS float* scr, int item, int lane) {
    const int nblk = N / 64, kb = item / nblk, nb = item % nblk, k0 = 64 * kb, n0 = 64 * nb;
    int d0 = n0; if (paired) { const int half = n0 >> 10, c = n0 & 1023; d0 = (c >> 7) * 256 + half * 128 + (c & 127); }
    float t[64];
#pragma unroll
    for (int i = 0; i < 64; ++i) t[i] = __builtin_nontemporal_load(&W[(size_t)(k0 + i) * N + n0 + lane]);
#pragma unroll
    for (int i = 0; i < 64; ++i) scr[i * 65 + lane] = t[i];
    LDS_WAIT(); asm volatile("" ::: "memory");
    const int c = lane & 3;
#pragma unroll
    for (int j = 0; j < 4; ++j) { const int n = (lane >> 2) + 16 * j; const LAS float* s = scr + (16 * c) * 65 + n;
        v4u o;
        o.x = pk4_fp8(s[0 * 65] * W8SCALE, s[1 * 65] * W8SCALE, s[2 * 65] * W8SCALE, s[3 * 65] * W8SCALE); o.y = pk4_fp8(s[4 * 65] * W8SCALE, s[5 * 65] * W8SCALE, s[6 * 65] * W8SCALE, s[7 * 65] * W8SCALE);
        o.z = pk4_fp8(s[8 * 65] * W8SCALE, s[9 * 65] * W8SCALE, s[10 * 65] * W8SCALE, s[11 * 65] * W8SCALE); o.w = pk4_fp8(s[12 * 65] * W8SCALE, s[13 * 65] * W8SCALE, s[14 * 65] * W8SCALE, s[15 * 65] * W8SCALE);
        *(v4u*)(WT + (size_t)(d0 + n) * K + k0 + 16 * c) = o; }
    LDS_WAIT(); asm volatile("" ::: "memory");
}
__device__ __forceinline__ void cv_do_item(const Args& a, LAS float* scr, int g, int lane) {
    const int l = g >= CV_L0 ? 1 : 0; const int r = g - l * CV_L0;
    if (r < 32 * 512) { const int mi = l * 32 + (r >> 9); transpose_item64(a.in[I_WE1] + (size_t)mi * D * 2 * D, D, 2 * D, a.ws + WS_W1 + (size_t)mi * 2 * D * D, true, scr, r & 511, lane); }
    else { const int r2 = r - 32 * 512; const int mi = l * 32 + (r2 >> 8); transpose_item64(a.in[I_WE2] + (size_t)mi * D * D, D, D, a.ws + WS_W2 + (size_t)mi * D * D, false, scr, r2 & 255, lane); }
}
__device__ __forceinline__ void cv_finish(const Args& a, LAS unsigned char* lds, int wave, int lane, int& cv_n, int limit) {
    if (gridDim.x == 256 && wave >= 1 && wave <= CV_WAVES) {
        const int ww = blockIdx.x * CV_WAVES + (wave - 1), NW = 256 * CV_WAVES; LAS float* scr = (LAS float*)(lds + RING_OFF + wave * 16640);
        for (;;) { const int g = cv_n * NW + ww; if (g >= limit) break; cv_do_item(a, scr, g, lane); ++cv_n; }
    }
}
__device__ __forceinline__ void xcd_barrier_work(const XcdBarrier& b, const Args& a, LAS unsigned char* lds, int wave, int lane, int& cv_n, volatile LAS unsigned* flag, unsigned seq) {
    asm volatile("s_waitcnt vmcnt(0)" ::: "memory");
    __syncthreads();
    if (wave == 0) {
        if (threadIdx.x == 0) {
            unsigned* bar = b.bar;
            __builtin_amdgcn_s_waitcnt(0);
            unsigned nloc = b.st[0], nx = b.st[1];
            if (nloc == 0u) { xcd_barrier_complete(bar, b.x, nloc, nx); b.st[0] = nloc; b.st[1] = nx; }
            const unsigned old = xb_add(&bar[XB_XSUB(b.x)], 1u);
            const unsigned gen = old / nloc;
            if (old + 1u == (gen + 1u) * nloc) {
                __builtin_amdgcn_fence(__ATOMIC_RELEASE, "agent");
                asm volatile("s_waitcnt vmcnt(0)" ::: "memory");
                const unsigned og = xb_add(&bar[XB_TOP], 1u);
                const unsigned tg = og / nx;
                if (og + 1u == (tg + 1u) * nx) xb_add(&bar[XB_TOPGEN], 1u);
                else XB_SPIN(xb_ld(&bar[XB_TOPGEN]) == tg, bar);
                __builtin_amdgcn_fence(__ATOMIC_ACQUIRE, "agent");
                xb_add(&bar[XB_XGEN(b.x)], 1u);
                asm volatile("s_waitcnt vmcnt(0)" ::: "memory");
            } else {
                XB_SPIN(xb_ld(&bar[XB_XGEN(b.x)]) == gen, bar);
                __builtin_amdgcn_fence(__ATOMIC_ACQUIRE, "agent");
                asm volatile("s_waitcnt vmcnt(0)" ::: "memory");
            }
            flag[0] = seq;
        }
    } else if (gridDim.x == 256 && wave <= CV_WAVES) {
        const int ww = blockIdx.x * CV_WAVES + (wave - 1), NW = 256 * CV_WAVES; LAS float* scr = (LAS float*)(lds + RING_OFF + wave * 16640);
        for (;;) { const int g = cv_n * NW + ww; if (g >= CV_ALL) break; if (flag[0] == seq) break; cv_do_item(a, scr, g, lane); ++cv_n; }
        asm volatile("s_waitcnt vmcnt(0)" ::: "memory");
    }
    __syncthreads();
}
__device__ __forceinline__ void flat_barrier_work(unsigned* cnt, const Args& a, LAS unsigned char* lds, int wave, int lane, int& cv_n, volatile LAS unsigned* flag, unsigned seq) {
    asm volatile("s_waitcnt vmcnt(0)" ::: "memory");
    __syncthreads();
    if (wave == 0) {
        if (threadIdx.x == 0) {
            __builtin_amdgcn_s_waitcnt(0);
            __builtin_amdgcn_fence(__ATOMIC_RELEASE, "agent");
            asm volatile("s_waitcnt vmcnt(0)" ::: "memory");
            (void)__hip_atomic_fetch_add(cnt, 1u, __ATOMIC_RELAXED, __HIP_MEMORY_SCOPE_AGENT);
            const unsigned target = gridDim.x * seq; unsigned sp = 0;
            while (__hip_atomic_load(cnt, __ATOMIC_RELAXED, __HIP_MEMORY_SCOPE_AGENT) < target) { __builtin_amdgcn_s_sleep(1); if (++sp > (1u << 22)) break; }
            __builtin_amdgcn_fence(__ATOMIC_ACQUIRE, "agent");
            asm volatile("s_waitcnt vmcnt(0)" ::: "memory");
            flag[0] = seq;
        }
    } else if (gridDim.x == 256 && wave <= CV_WAVES) {
        const int ww = blockIdx.x * CV_WAVES + (wave - 1), NW = 256 * CV_WAVES; LAS float* scr = (LAS float*)(lds + RING_OFF + wave * 16640);
        for (;;) { const int g = cv_n * NW + ww; if (g >= CV_ALL) break; if (flag[0] == seq) break; cv_do_item(a, scr, g, lane); ++cv_n; }
        asm volatile("s_waitcnt vmcnt(0)" ::: "memory");
    }
    __syncthreads();
}
template <bool OUT8> __device__ __forceinline__ void norm_mod_store(f32x4 (&v)[4], const float* g, const float* sc, const float* sh, void* orow, int lane) {
    float s = 0.f;
#pragma unroll
    for (int j = 0; j < 4; ++j) s += (v[j].x * v[j].x + v[j].y * v[j].y) + (v[j].z * v[j].z + v[j].w * v[j].w);
    const float r = 1.0f / sqrtf(wave_sum(s) * (1.0f / D) + EPS);
#pragma unroll
    for (int j = 0; j < 4; ++j) { const f32x4 gg = ((const f32x4*)g)[lane + 64 * j], ss = ((const f32x4*)sc)[lane + 64 * j], hh = ((const f32x4*)sh)[lane + 64 * j];
        const f32x4 y = (v[j] * r * gg) * (ss + 1.0f) + hh; v[j] = y;
        store_row4<OUT8>(orow, lane, j, y, 1.0f); }
}
__device__ __forceinline__ void p_norm0(const Args& a, int lane, int gw, int NGW, int m_begin, int m_end) {
    const float* MODS = (const float*)(a.ws + WS_MODS); bf16* H = (bf16*)(a.ws + WS_H);
    for (int m0 = m_begin + gw * 2; m0 < m_end; m0 += NGW * 2) {
        f32x4 v[2][4]; int rr[2];
#pragma unroll
        for (int r = 0; r < 2; ++r) { const int m = m0 + r; const float* xr;
            if (m < NTOK) { xr = a.in[I_X] + (size_t)m * D; rr[r] = m / SEQ; } else { xr = a.in[I_CTX] + (size_t)(m - NTOK) * D; rr[r] = 2; }
#pragma unroll
            for (int j = 0; j < 4; ++j) v[r][j] = __builtin_nontemporal_load(&((const f32x4*)xr)[lane + 64 * j]); }
#pragma unroll
        for (int r = 0; r < 2; ++r) { const float* md = MODS + (size_t)rr[r] * 6 * D;
            norm_mod_store<F8_IN != 0>(v[r], a.in[I_GMIX], md + 1 * D, md + 0 * D, (unsigned char*)H + (size_t)(m0 + r) * D * (F8_IN ? 1 : 2), lane);
            if (SPLIT_IN) {
#pragma unroll
                for (int j = 0; j < 4; ++j) store_row4<true>(a.ws + WS_H8 + (size_t)(m0 + r) * D, lane, j, v[r][j], 1.0f); } }
    }
}
__device__ __forceinline__ void p_scan_naive(const Args& a, LAS unsigned char* lds, int tid) {
    LAS float* sf = (LAS float*)lds;
    LAS float* sq = sf + 64 * 128;
    LAS float* sv = sq + 64 * 128;
    LAS float* so = sv + 64 * 16;
    const bf16* Q = (const bf16*)(a.ws + WS_Q); const bf16* V = (const bf16*)(a.ws + WS_V);
    const int vl = tid >> 5, kq = tid & 31;
    for (int unit = blockIdx.x; unit < 256; unit += gridDim.x) {
        const int chain = unit >> 3, vb = unit & 7, b = chain >> 4, h = (chain >> 1) & 7, dir = chain & 1;
        const float* LF = (const float*)(a.ws + (dir ? WS_LFB : WS_LFF)); float* O = (float*)(a.ws + (dir ? WS_OB : WS_OF));
        float S0 = 0.f, S1 = 0.f, S2 = 0.f, S3 = 0.f;
        for (int blk = 0; blk < 260; ++blk) {
            const bool isctx = blk < 4; int base, step;
            if (!dir) { base = isctx ? (NTOK + b * CTXL + blk * 64) : (b * SEQ + (blk - 4) * 64); step = 1; }
            else { base = isctx ? (NTOK + b * CTXL + CTXL - 1 - blk * 64) : (b * SEQ + SEQ - 1 - (blk - 4) * 64); step = -1; }
            for (int e = tid; e < 64 * 128; e += NTHR) { const int i = e >> 7, k = e & 127; const size_t off = (size_t)(base + step * i) * D + h * DK + k; sf[e] = __expf(LF[off]); sq[e] = bf2f(Q[off]); }
            for (int e = tid; e < 64 * 16; e += NTHR) { const int i = e >> 4, vv = e & 15; sv[e] = bf2f(V[(size_t)(base + step * i) * D + h * DK + vb * 16 + vv]); }
            __syncthreads();
            for (int i = 0; i < 64; ++i) {
                const f32x4 f = *(const LAS f32x4*)(sf + i * 128 + kq * 4), q = *(const LAS f32x4*)(sq + i * 128 + kq * 4); const float vv = sv[i * 16 + vl];
                S0 = f.x * S0 + (1.0f - f.x) * vv; S1 = f.y * S1 + (1.0f - f.y) * vv; S2 = f.z * S2 + (1.0f - f.z) * vv; S3 = f.w * S3 + (1.0f - f.w) * vv;
                float p = (S0 * q.x + S1 * q.y) + (S2 * q.z + S3 * q.w);
                p += __shfl_xor(p, 1); p += __shfl_xor(p, 2); p += __shfl_xor(p, 4); p += __shfl_xor(p, 8); p += __shfl_xor(p, 16);
                if (kq == 0) so[i * 16 + vl] = p;
            }
            __syncthreads();
            if (!isctx) for (int e = tid; e < 64 * 16; e += NTHR) { const int i = e >> 4, vv = e & 15; O[(size_t)(base + step * i) * D + h * DK + vb * 16 + vv] = so[e]; }
            __syncthreads();
        }
    }
}
constexpr int SC_QT = 0, SC_KU = 4352, SC_KB = 8704, SC_VT = 12800, SC_ET = 16896, SC_SUB = 17408, SC_BUF = 4 * SC_SUB;
constexpr int NSLOT = 17;
typedef short s16x4 __attribute__((ext_vector_type(4)));
typedef short s16x8 __attribute__((ext_vector_type(8)));
struct ScanUnit { int h, rowbase, sgn, nchunks, chain, slot; };
__device__ __forceinline__ ScanUnit scan_unit(int b, int h, int dir, int slot) {
    ScanUnit u; u.h = h; u.sgn = dir ? -1 : 1; u.chain = (b * NHEAD + h) * 2 + dir; u.slot = slot;
    if (slot == 0) { u.rowbase = NTOK + b * CTXL + (dir ? CTXL - 1 : 0); u.nchunks = CTXL / 64; }
    else { const int so = (slot - 1) * 1024; u.rowbase = b * SEQ + (dir ? SEQ - 1 - so : so); u.nchunks = 16; }
    return u;
}
typedef float f32x2_t __attribute__((ext_vector_type(2)));
typedef __bf16 bf16x2_t __attribute__((ext_vector_type(2)));
__device__ __forceinline__ unsigned cvtpk(float lo, float hi) { const f32x2_t f = {lo, hi}; return __builtin_bit_cast(unsigned, __builtin_convertvector(f, bf16x2_t)); }
template <bool FULL> __device__ __forceinline__ void scan_load(const ScanUnit& u, int pos0, const bf16* LF, const bf16* Q, const bf16* V, int k, int i, unsigned (&lf)[16], unsigned (&qr)[16], unsigned (&vr)[16]) {
#pragma unroll
    for (int t = 0; t < 16; ++t) {
        const unsigned o = (unsigned)(u.rowbase + u.sgn * (pos0 + 16 * i + t)) * D + u.h * DK + k;
        lf[t] = LF[o]; vr[t] = V[o]; if (FULL) qr[t] = Q[o];
    }
}
template <bool FULL> __device__ __forceinline__ float scan_prep(LAS unsigned char* buf, int k, int i, const unsigned (&lfr)[16], const unsigned (&qr)[16], const unsigned (&vr)[16]) {
    LAS unsigned char* sb = buf + i * SC_SUB;
    float f[16], pre[16], suf[16]; float T = 0.f;
#pragma unroll
    for (int t = 0; t < 16; ++t) { const float lf = (float)__builtin_bit_cast(_Float16, (unsigned short)lfr[t]); T += lf; f[t] = __builtin_amdgcn_exp2f(lf * 1.4426950408889634f); }
    pre[0] = f[0];
#pragma unroll
    for (int t = 1; t < 16; ++t) pre[t] = pre[t - 1] * f[t];
    suf[15] = 1.0f;
#pragma unroll
    for (int t = 14; t >= 0; --t) suf[t] = suf[t + 1] * f[t + 1];
    unsigned kbw[8], vtw[8];
#pragma unroll
    for (int t = 0; t < 16; t += 2) {
        const float kk0 = 1.0f - f[t], kk1 = 1.0f - f[t + 1];
        kbw[t >> 1] = cvtpk(kk0 * suf[t], kk1 * suf[t + 1]);
        vtw[t >> 1] = vr[t] | (vr[t + 1] << 16);
        if (FULL) {
            const unsigned qq = cvtpk(__builtin_bit_cast(float, qr[t] << 16) * pre[t], __builtin_bit_cast(float, qr[t + 1] << 16) * pre[t + 1]);
            const unsigned ku = cvtpk(kk0 * __builtin_amdgcn_rcpf(fmaxf(pre[t], 1e-30f)), kk1 * __builtin_amdgcn_rcpf(fmaxf(pre[t + 1], 1e-30f)));
            *(LAS bf16*)(sb + SC_QT + t * 272 + 2 * k) = (bf16)(qq & 0xffffu); *(LAS bf16*)(sb + SC_QT + (t + 1) * 272 + 2 * k) = (bf16)(qq >> 16);
            *(LAS bf16*)(sb + SC_KU + t * 272 + 2 * k) = (bf16)(ku & 0xffffu); *(LAS bf16*)(sb + SC_KU + (t + 1) * 272 + 2 * k) = (bf16)(ku >> 16);
        }
    }
    *(LAS v4u*)(sb + SC_KB + k * 32) = (v4u){kbw[0], kbw[1], kbw[2], kbw[3]}; *(LAS v4u*)(sb + SC_KB + k * 32 + 16) = (v4u){kbw[4], kbw[5], kbw[6], kbw[7]};
    *(LAS v4u*)(sb + SC_VT + k * 32) = (v4u){vtw[0], vtw[1], vtw[2], vtw[3]}; *(LAS v4u*)(sb + SC_VT + k * 32 + 16) = (v4u){vtw[4], vtw[5], vtw[6], vtw[7]};
    *(LAS float*)(sb + SC_ET + 4 * k) = pre[15];
    return T;
}
__device__ __forceinline__ f32x4 mfma_k16(s16x4 a, s16x4 b, f32x4 c) {
    const v2u av = __builtin_bit_cast(v2u, a), bv = __builtin_bit_cast(v2u, b);
    return __builtin_amdgcn_mfma_f32_16x16x32_bf16(__builtin_bit_cast(s16x8, (v4u){av.x, av.y, 0u, 0u}), __builtin_bit_cast(s16x8, (v4u){bv.x, bv.y, 0u, 0u}), c, 0, 0, 0);
}
template <bool FULL> __device__ __forceinline__ void scan_compute2(const LAS unsigned char* buf, int wq, int lane, f32x4 (&S)[2][8], bf16* Ocol, const ScanUnit& u, int pos0) {
    const int fr = lane & 15, g = lane >> 4;
#pragma unroll 1
    for (int i = 0; i < 2; ++i) {
        const LAS unsigned char* sb = buf + i * SC_SUB;
        const s16x4 vt0 = *(const LAS s16x4*)(sb + SC_VT + (32 * wq + fr) * 32 + 8 * g), vt1 = *(const LAS s16x4*)(sb + SC_VT + (32 * wq + 16 + fr) * 32 + 8 * g);
        s16x8 ka[4], qa[4]; f32x4 et[8]; s16x4 kb[8];
        if (FULL) {
#pragma unroll
            for (int c = 0; c < 4; ++c) { ka[c] = *(const LAS s16x8*)(sb + SC_KU + fr * 272 + (32 * c + 8 * g) * 2); qa[c] = *(const LAS s16x8*)(sb + SC_QT + fr * 272 + (32 * c + 8 * g) * 2); }
        }
#pragma unroll
        for (int j = 0; j < 8; ++j) { et[j] = *(const LAS f32x4*)(sb + SC_ET + (32 * (j >> 1) + 8 * g + 4 * (j & 1)) * 4); kb[j] = *(const LAS s16x4*)(sb + SC_KB + (32 * (j >> 1) + 8 * (fr >> 2) + 4 * (j & 1) + (fr & 3)) * 32 + 8 * g); }
        __builtin_amdgcn_sched_barrier(0);
        if (FULL) {
            f32x4 aT = (f32x4){0.f, 0.f, 0.f, 0.f};
#pragma unroll
            for (int c = 0; c < 4; ++c) aT = __builtin_amdgcn_mfma_f32_16x16x32_bf16(ka[c], qa[c], aT, 0, 0, 0);
#pragma unroll
            for (int r = 0; r < 4; ++r) if (4 * g + r > fr) aT[r] = 0.f;
            const s16x4 ab = __builtin_bit_cast(s16x4, (v2u){cvtpk(aT[0], aT[1]), cvtpk(aT[2], aT[3])});
            f32x4 o0 = mfma_k16(vt0, ab, (f32x4){0.f, 0.f, 0.f, 0.f}), o1 = mfma_k16(vt1, ab, (f32x4){0.f, 0.f, 0.f, 0.f});
#pragma unroll
            for (int c = 0; c < 4; ++c) {
                const v4u s0 = (v4u){cvtpk(S[0][2 * c][0], S[0][2 * c][1]), cvtpk(S[0][2 * c][2], S[0][2 * c][3]), cvtpk(S[0][2 * c + 1][0], S[0][2 * c + 1][1]), cvtpk(S[0][2 * c + 1][2], S[0][2 * c + 1][3])};
                const v4u s1 = (v4u){cvtpk(S[1][2 * c][0], S[1][2 * c][1]), cvtpk(S[1][2 * c][2], S[1][2 * c][3]), cvtpk(S[1][2 * c + 1][0], S[1][2 * c + 1][1]), cvtpk(S[1][2 * c + 1][2], S[1][2 * c + 1][3])};
                o0 = __builtin_amdgcn_mfma_f32_16x16x32_bf16(__builtin_bit_cast(s16x8, s0), qa[c], o0, 0, 0, 0);
                o1 = __builtin_amdgcn_mfma_f32_16x16x32_bf16(__builtin_bit_cast(s16x8, s1), qa[c], o1, 0, 0, 0);
            }
            bf16* orow = Ocol + (size_t)(u.rowbase + u.sgn * (pos0 + 16 * i + fr)) * D;
            *(v2u*)orow = (v2u){cvtpk(o0[0], o0[1]), cvtpk(o0[2], o0[3])}; *(v2u*)(orow + 16) = (v2u){cvtpk(o1[0], o1[1]), cvtpk(o1[2], o1[3])};
        }
#pragma unroll
        for (int j = 0; j < 8; ++j) { S[0][j] = mfma_k16(kb[j], vt0, S[0][j] * et[j]); S[1][j] = mfma_k16(kb[j], vt1, S[1][j] * et[j]); }
    }
}
template <bool FULL> __device__ __forceinline__ void scan_pair(const Args& a, LAS unsigned char* lds, const ScanUnit& uA, const ScanUnit& uB, int tid, int lane, int wave) {
    const int grp = wave >> 2, wq = wave & 3, t = tid & 255, k = t & 127, i0 = t >> 7;
    ScanUnit u; u.h = grp ? uB.h : uA.h; u.rowbase = grp ? uB.rowbase : uA.rowbase; u.sgn = grp ? uB.sgn : uA.sgn; u.nchunks = grp ? uB.nchunks : uA.nchunks; u.chain = grp ? uB.chain : uA.chain; u.slot = grp ? uB.slot : uA.slot;
    LAS unsigned char* buf = lds + grp * SC_BUF;
    const int dir = u.sgn < 0;
    const bf16* LF = (const bf16*)(a.ws + (dir ? WS_LFB : WS_LFF)); const bf16* Q = (const bf16*)(a.ws + WS_Q); const bf16* V = (const bf16*)(a.ws + WS_V);
    f32x4* SD = (f32x4*)(a.ws + WS_SD) + (size_t)u.chain * NSLOT * 4096; float* SP = (float*)(a.ws + WS_SP) + (size_t)u.chain * NSLOT * DK;
    const int g = lane >> 4;
    bf16* Ocol = (bf16*)(a.ws + (dir ? WS_OB : WS_OF)) + u.h * DK + 32 * wq + 4 * g;
    f32x4 S[2][8];
#pragma unroll
    for (int vb = 0; vb < 2; ++vb)
#pragma unroll
        for (int j = 0; j < 8; ++j) S[vb][j] = (f32x4){0.f, 0.f, 0.f, 0.f};
    if (FULL) {
        for (int s = 0; s < u.slot; ++s) {
            const f32x4* d = SD + (size_t)s * 4096 + (wq * 16) * 64 + lane; const float* pp = SP + s * DK + 8 * g;
#pragma unroll
            for (int j = 0; j < 8; ++j) { const f32x4 pv = *(const f32x4*)(pp + 32 * (j >> 1) + 4 * (j & 1)); const f32x4 ev = (f32x4){__expf(pv.x), __expf(pv.y), __expf(pv.z), __expf(pv.w)};
                S[0][j] = S[0][j] * ev + d[j * 64]; S[1][j] = S[1][j] * ev + d[(8 + j) * 64]; }
        }
    }
    unsigned lf[16], q[16], v[16]; float psum = 0.f;
    const int nsteps = u.nchunks * 2;
    scan_load<FULL>(u, 0, LF, Q, V, k, i0, lf, q, v);
    constexpr int NST = 32;
    if (grp == 1) __syncthreads();
    for (int c = 0; c < NST; ++c) {
        if (c < nsteps) psum += scan_prep<FULL>(buf, k, i0, lf, q, v);
        __syncthreads();
        if (c < nsteps) {
            const int cn = (c + 1 < nsteps) ? c + 1 : c;
            scan_load<FULL>(u, cn * 32, LF, Q, V, k, i0, lf, q, v);
            scan_compute2<FULL>(buf, wq, lane, S, Ocol, u, c * 32);
        }
        __syncthreads();
    }
    if (grp == 0) __syncthreads();
    if (!FULL) {
        f32x4* d = SD + (size_t)u.slot * 4096 + (wq * 16) * 64 + lane;
#pragma unroll
        for (int j = 0; j < 8; ++j) { d[j * 64] = S[0][j]; d[(8 + j) * 64] = S[1][j]; }
        LAS float* ps = (LAS float*)(lds + EXTRA_OFF + 2560);
        ps[(grp * 2 + i0) * 128 + k] = psum;
        __syncthreads();
        if (t < 128) SP[u.slot * DK + t] = ps[(grp * 2) * 128 + t] + ps[(grp * 2 + 1) * 128 + t];
        __syncthreads();
    }
}
__device__ __forceinline__ void p_scan_a(const Args& a, LAS unsigned char* lds, int tid, int lane, int wave) {
    for (int it = blockIdx.x; it < 256; it += gridDim.x) {
        const int b = it >> 7, h = (it >> 4) & 7, seg = it & 15;
        const ScanUnit uA = scan_unit(b, h, 0, seg == 15 ? 0 : 1 + seg);
        const ScanUnit uB = scan_unit(b, h, 1, seg == 0 ? 0 : 16 - seg);
        scan_pair<false>(a, lds, uA, uB, tid, lane, wave);
    }
}
__device__ __forceinline__ void p_scan_c(const Args& a, LAS unsigned char* lds, int tid, int lane, int wave) {
    for (int it = blockIdx.x; it < 256; it += gridDim.x) {
        const int b = it >> 7, h = (it >> 4) & 7, seg = it & 15;
        const ScanUnit uA = scan_unit(b, h, 0, 1 + seg), uB = scan_unit(b, h, 1, 16 - seg);
        scan_pair<true>(a, lds, uA, uB, tid, lane, wave);
    }
}
__device__ __forceinline__ void p_readout(const Args& a, int lane, int wave) {
    const int gw = blockIdx.x * NWAVES + wave, NGW = gridDim.x * NWAVES;
    const bf16* OF = (const bf16*)(a.ws + WS_OF); const bf16* OB = (const bf16*)(a.ws + WS_OB); const bf16* SG = (const bf16*)(a.ws + WS_SG); bf16* Y = (bf16*)(a.ws + WS_YIN);
    for (int m0 = gw * 2; m0 < NTOK; m0 += NGW * 2) {
        f32x4 o[2][4]; v2u sg[2][4];
#pragma unroll
        for (int r = 0; r < 2; ++r)
#pragma unroll
            for (int j = 0; j < 4; ++j) { const size_t m = m0 + r; const v2u a_ = ((const v2u*)(OF + m * D))[lane + 64 * j], b_ = ((const v2u*)(OB + m * D))[lane + 64 * j];
                o[r][j] = (f32x4){bf_lo(a_.x) + bf_lo(b_.x), bf_hi(a_.x) + bf_hi(b_.x), bf_lo(a_.y) + bf_lo(b_.y), bf_hi(a_.y) + bf_hi(b_.y)}; sg[r][j] = ((const v2u*)(SG + m * D))[lane + 64 * j]; }
#pragma unroll
        for (int r = 0; r < 2; ++r)
#pragma unroll
            for (int j = 0; j < 4; ++j) { const f32x4 oo = o[r][j];
                float s = (oo.x * oo.x + oo.y * oo.y) + (oo.z * oo.z + oo.w * oo.w);
                s += __shfl_xor(s, 1); s += __shfl_xor(s, 2); s += __shfl_xor(s, 4); s += __shfl_xor(s, 8); s += __shfl_xor(s, 16);
                const float rs = 1.0f / sqrtf(s * (1.0f / DK) + EPS);
                const f32x4 gg = ((const f32x4*)a.in[I_GHOUT])[lane + 64 * j];
                store_row4<F8_MISC != 0>((unsigned char*)Y + (size_t)(m0 + r) * D * (F8_MISC ? 1 : 2), lane, j,
                    (f32x4){oo.x * rs * gg.x * bf_lo(sg[r][j].x), oo.y * rs * gg.y * bf_hi(sg[r][j].x), oo.z * rs * gg.z * bf_lo(sg[r][j].y), oo.w * rs * gg.w * bf_hi(sg[r][j].y)}, 4.0f); }
    }
}
__device__ __forceinline__ void p_router(const Args& a, LAS unsigned char* lds, int l, int tid, int lane, int wave) {
    typedef _Float16 h16x8 __attribute__((ext_vector_type(8))); typedef _Float16 h16x4 __attribute__((ext_vector_type(4)));
    constexpr int PITCH = 2064, WT_OFF = 0, TILE_OFF = 32 * PITCH, P_OFF = TILE_OFF + 16 * PITCH;
    LAS int* s_cnt = (LAS int*)(lds + EXTRA_OFF);
    LAS int* s_gb = s_cnt + 32;
    LAS int* s_sel = (LAS int*)(lds + EXTRA_OFF + 2560);
    unsigned* GCNT = (unsigned*)(a.ws + WS_CTL) + CW_GCNT + l * 32;
    const float* WR = a.in[I_WR] + (size_t)l * D * NE; const float* BR = a.in[I_BR] + l * NE;
    for (int i = tid; i < D * NE; i += NTHR) *(LAS _Float16*)(lds + WT_OFF + (i & 31) * PITCH + (i >> 5) * 2) = (_Float16)WR[i];
    const bf16* X = (const bf16*)(a.ws + WS_X); unsigned char* H = a.ws + WS_H;
    const float* MODS = (const float*)(a.ws + WS_MODS);
    int* TOPS = (int*)(a.ws + WS_TOPE); float* TOPW = (float*)(a.ws + WS_TOPW); int* STOK = (int*)(a.ws + WS_STOK);
    const int fr = lane & 15, g = lane >> 4;
    LAS float* P = (LAS float*)(lds + P_OFF);
    for (int ch = blockIdx.x; ch < NTOK / 128; ch += gridDim.x) {
        if (tid < 32) s_cnt[tid] = 0;
        const int b = (ch * 128) / SEQ; const float* md = MODS + (size_t)(l * 3 + b) * 6 * D;
        v2u nx[2][4];
#pragma unroll
        for (int t = 0; t < 2; ++t)
#pragma unroll
            for (int j = 0; j < 4; ++j) nx[t][j] = ((const v2u*)(X + (size_t)(ch * 128 + 2 * wave + t) * D))[lane + 64 * j];
        for (int it = 0; it < 8; ++it) {
            const int tok0 = ch * 128 + it * 16 + 2 * wave;
            f32x4 hf[2][4];
#pragma unroll
            for (int t = 0; t < 2; ++t)
#pragma unroll
                for (int j = 0; j < 4; ++j) hf[t][j] = (f32x4){bf_lo(nx[t][j].x), bf_hi(nx[t][j].x), bf_lo(nx[t][j].y), bf_hi(nx[t][j].y)};
            if (it + 1 < 8) {
#pragma unroll
                for (int t = 0; t < 2; ++t)
#pragma unroll
                    for (int j = 0; j < 4; ++j) nx[t][j] = ((const v2u*)(X + (size_t)(tok0 + 16 + t) * D))[lane + 64 * j];
            }
#pragma unroll
            for (int t = 0; t < 2; ++t) {
                norm_mod_store<true>(hf[t], a.in[I_GFFN] + l * D, md + 4 * D, md + 3 * D, H + (size_t)(tok0 + t) * D, lane);
#pragma unroll
                for (int j = 0; j < 4; ++j) { const h16x4 hv = {(_Float16)hf[t][j].x, (_Float16)hf[t][j].y, (_Float16)hf[t][j].z, (_Float16)hf[t][j].w};
                    *(LAS h16x4*)(lds + TILE_OFF + (2 * wave + t) * PITCH + (4 * lane + 256 * j) * 2) = hv; }
            }
            __syncthreads();
            f32x4 acc0 = (f32x4){0.f, 0.f, 0.f, 0.f}, acc1 = acc0;
#pragma unroll
            for (int c = 0; c < 4; ++c) { const int kb = (128 * wave + 32 * c + 8 * g) * 2;
                const h16x8 av = *(const LAS h16x8*)(lds + TILE_OFF + fr * PITCH + kb);
                const h16x8 b0 = *(const LAS h16x8*)(lds + WT_OFF + fr * PITCH + kb), b1 = *(const LAS h16x8*)(lds + WT_OFF + (16 + fr) * PITCH + kb);
                acc0 = __builtin_amdgcn_mfma_f32_16x16x32_f16(av, b0, acc0, 0, 0, 0); acc1 = __builtin_amdgcn_mfma_f32_16x16x32_f16(av, b1, acc1, 0, 0, 0); }
#pragma unroll
            for (int r = 0; r < 4; ++r) { P[(wave * 16 + 4 * g + r) * 32 + fr] = acc0[r]; P[(wave * 16 + 4 * g + r) * 32 + 16 + fr] = acc1[r]; }
            __syncthreads();
            const int t = lane >> 5, e0 = lane & 31;
            float v0 = BR[e0];
#pragma unroll
            for (int w = 0; w < 8; ++w) v0 += P[(w * 16 + 2 * wave + t) * 32 + e0];
            float selv[4]; int seli[4];
#pragma unroll
            for (int r = 0; r < 4; ++r) {
                float bv = v0; int bi = e0;
#pragma unroll
                for (int o = 1; o < 32; o <<= 1) { const float ov = __shfl_xor(bv, o); const int oi = __shfl_xor(bi, o); if (ov > bv || (ov == bv && oi < bi)) { bv = ov; bi = oi; } }
                selv[r] = bv; seli[r] = bi;
                if (bi == e0) v0 = -INFINITY;
            }
            if ((lane & 31) == 0) {
                const float e1 = __expf(selv[1] - selv[0]), e2 = __expf(selv[2] - selv[0]), e3 = __expf(selv[3] - selv[0]); const float inv = 1.0f / (1.0f + e1 + e2 + e3);
                *(f32x4*)(TOPW + (size_t)(tok0 + t) * 4) = (f32x4){inv, e1 * inv, e2 * inv, e3 * inv};
#pragma unroll
                for (int r = 0; r < 4; ++r) s_sel[(it * 16 + 2 * wave + t) * 4 + r] = (seli[r] << 16) | __hip_atomic_fetch_add(&s_cnt[seli[r]], 1, __ATOMIC_RELAXED, __HIP_MEMORY_SCOPE_WORKGROUP);
            }
        }
        __syncthreads();
        if (tid < 32) s_gb[tid] = (int)__hip_atomic_fetch_add(GCNT + tid, (unsigned)s_cnt[tid], __ATOMIC_RELAXED, __HIP_MEMORY_SCOPE_AGENT);
        __syncthreads();
        { const int sv = s_sel[tid], e = sv >> 16, vi = s_gb[e] + (sv & 0xffff); TOPS[(size_t)ch * 512 + tid] = e * NTOK + vi; STOK[(size_t)e * NTOK + vi] = ch * 128 + (tid >> 2); }
        __syncthreads();
    }
}
__device__ __forceinline__ void moe_tables(const Args& a, LAS unsigned char* lds, int l, int tid) {
    LAS int* s_tb = (LAS int*)(lds + EXTRA_OFF + 256); LAS int* s_ce = s_tb + 40; LAS int* tab = (LAS int*)(lds + EXTRA_OFF + 640);
    const unsigned* GCNT = (const unsigned*)(a.ws + WS_CTL) + CW_GCNT + l * 32;
    if (tid < 32) s_ce[tid] = (int)__hip_atomic_load(GCNT + tid, __ATOMIC_RELAXED, __HIP_MEMORY_SCOPE_AGENT);
    __syncthreads();
    if (tid == 0) { int run = 0; for (int e = 0; e < 32; ++e) { s_tb[e] = run; run += (s_ce[e] + 255) >> 8; } s_tb[32] = run; }
    __syncthreads();
    if (tid < 32) { const int t0 = s_tb[tid], t1 = s_tb[tid + 1]; for (int t = t0; t < t1; ++t) tab[t] = tid; }
    __syncthreads();
}
template <bool FINAL> __device__ __forceinline__ void p_combine(const Args& a, LAS unsigned char* lds, int l, int lane, int wave) {
    const int gw = blockIdx.x * NWAVES + wave, NGW = gridDim.x * NWAVES;
    bf16* X = (bf16*)(a.ws + WS_X); const bf16* YS = (const bf16*)(a.ws + WS_YS); const int* TOPS = (const int*)(a.ws + WS_TOPE); const float* TOPW = (const float*)(a.ws + WS_TOPW);
    const LAS int* s_tb = (const LAS int*)(lds + EXTRA_OFF + 256);
    const float* MODS = (const float*)(a.ws + WS_MODS); bf16* H = (bf16*)(a.ws + WS_H);
    for (int m0 = gw * 2; m0 < NTOK; m0 += NGW * 2) {
        const int b = m0 / SEQ; const float* gt = MODS + (size_t)(l * 3 + b) * 6 * D + 5 * D;
        f32x4 v[2][4]; v2u y[2][4][4]; f32x4 tw[2];
#pragma unroll
        for (int r = 0; r < 2; ++r) { v4i ps = *(const v4i*)(TOPS + (size_t)(m0 + r) * 4); tw[r] = *(const f32x4*)(TOPW + (size_t)(m0 + r) * 4);
#pragma unroll
            for (int k = 0; k < 4; ++k) { const int e = ps[k] >> 15; ps[k] = s_tb[e] * 256 + (ps[k] & (NTOK - 1)); }
#pragma unroll
            for (int j = 0; j < 4; ++j) { const v2u xx = ((const v2u*)(X + (size_t)(m0 + r) * D))[lane + 64 * j]; v[r][j] = (f32x4){bf_lo(xx.x), bf_hi(xx.x), bf_lo(xx.y), bf_hi(xx.y)};
#pragma unroll
                for (int k = 0; k < 4; ++k) {
                    if (F8_Y) { y[r][j][k].x = ((const unsigned*)((const unsigned char*)YS + (size_t)ps[k] * D))[lane + 64 * j]; y[r][j][k].y = 0u; }
                    else y[r][j][k] = ((const v2u*)(YS + (size_t)ps[k] * D))[lane + 64 * j]; } } }
#pragma unroll
        for (int r = 0; r < 2; ++r) { const int m = m0 + r;
#pragma unroll
            for (int j = 0; j < 4; ++j) { f32x4 s = (f32x4){0.f, 0.f, 0.f, 0.f};
#pragma unroll
                for (int k = 0; k < 4; ++k) {
                    if (F8_Y) { const int w = (int)y[r][j][k].x; const f32x2_t lo = __builtin_amdgcn_cvt_pk_f32_fp8(w, false), hi = __builtin_amdgcn_cvt_pk_f32_fp8(w, true);
                        s += (f32x4){lo.x, lo.y, hi.x, hi.y} * (tw[r][k] * (1.0f / YSCALE)); }
                    else s += (f32x4){bf_lo(y[r][j][k].x), bf_hi(y[r][j][k].x), bf_lo(y[r][j][k].y), bf_hi(y[r][j][k].y)} * tw[r][k]; }
                v[r][j] = v[r][j] + ((const f32x4*)gt)[lane + 64 * j] * s; }
            if (!FINAL) {
#pragma unroll
                for (int j = 0; j < 4; ++j) ((v2u*)(X + (size_t)m * D))[lane + 64 * j] = (v2u){pk2(v[r][j].x, v[r][j].y), pk2(v[r][j].z, v[r][j].w)};
                const float* md = MODS + (size_t)((l + 1) * 3 + b) * 6 * D;
                norm_mod_store<F8_MISC != 0>(v[r], a.in[I_GMIX] + (l + 1) * D, md + 1 * D, md + 0 * D, (unsigned char*)H + (size_t)m * D * (F8_MISC ? 1 : 2), lane);
            } else {
                float s = 0.f;
#pragma unroll
                for (int j = 0; j < 4; ++j) s += (v[r][j].x * v[r][j].x + v[r][j].y * v[r][j].y) + (v[r][j].z * v[r][j].z + v[r][j].w * v[r][j].w);
                const float rs = 1.0f / sqrtf(wave_sum(s) * (1.0f / D) + EPS);
#pragma unroll
                for (int j = 0; j < 4; ++j) __builtin_nontemporal_store(v[r][j] * rs * ((const f32x4*)a.in[I_GFINAL])[lane + 64 * j], &((f32x4*)(a.out + (size_t)m * D))[lane + 64 * j]);
            }
        }
    }
}
__device__ __forceinline__ void p_dwconv(const Args& a, int tid) {
    const bf16* U = (const bf16*)(a.ws + WS_U); bf16* ZP = (bf16*)(a.ws + WS_ZP);
    const float* WDW = a.in[I_WCVDW]; const float* BDW = a.in[I_BCVDW];
    const int half = tid >> 8, cp = tid & 255;
    for (int unit = blockIdx.x; unit < 2048; unit += gridDim.x) {
        const int hu = unit * 2 + half;
        int c, len, p0; size_t base, stride;
        if (hu < 2048) { c = 2 * cp; len = GRIDW; p0 = (hu & 3) * 16; base = (size_t)(hu >> 2) * GRIDW * D; stride = D; }
        else { const int v = hu - 2048; const int b = v >> 10, w = (v >> 4) & 63; c = 512 + 2 * cp; len = GRIDR; p0 = (v & 15) * 16; base = ((size_t)b * SEQ + w) * D; stride = (size_t)GRIDW * D; }
        float w0[CONVW], w1[CONVW];
#pragma unroll
        for (int j = 0; j < CONVW; ++j) { w0[j] = WDW[j * D + c]; w1[j] = WDW[j * D + c + 1]; }
        const float bb0 = BDW[c], bb1 = BDW[c + 1];
        float i0[46], i1[46];
#pragma unroll
        for (int i = 0; i < 46; ++i) { const int pp = p0 - 15 + i; unsigned u = 0u; if (pp >= 0 && pp < len) u = *(const unsigned*)(U + base + (size_t)pp * stride + c); i0[i] = bf_lo(u); i1[i] = bf_hi(u); }
#pragma unroll
        for (int i = 0; i < 16; ++i) { float a0 = bb0, a1 = bb1;
#pragma unroll
            for (int j = 0; j < CONVW; ++j) { a0 += i0[i + j] * w0[j]; a1 += i1[i + j] * w1[j]; }
            *(unsigned*)(ZP + base + (size_t)(p0 + i) * stride + c) = pk2(a0, a1); }
    }
}
__device__ __forceinline__ void p_ln_silu(const Args& a, int lane, int wave) {
    const int gw = blockIdx.x * NWAVES + wave, NGW = gridDim.x * NWAVES;
    const bf16* ZP = (const bf16*)(a.ws + WS_ZP); bf16* Z = (bf16*)(a.ws + WS_Z);
    for (int m0 = gw * 2; m0 < NTOK; m0 += NGW * 2) {
        v2u y[2][4];
#pragma unroll
        for (int r = 0; r < 2; ++r)
#pragma unroll
            for (int j = 0; j < 4; ++j) y[r][j] = ((const v2u*)(ZP + (size_t)(m0 + r) * D))[lane + 64 * j];
#pragma unroll
        for (int r = 0; r < 2; ++r) {
            f32x4 v[4]; float s = 0.f;
#pragma unroll
            for (int j = 0; j < 4; ++j) { v[j] = (f32x4){bf_lo(y[r][j].x), bf_hi(y[r][j].x), bf_lo(y[r][j].y), bf_hi(y[r][j].y)}; s += (v[j].x + v[j].y) + (v[j].z + v[j].w); }
            const float mean = wave_sum(s) * (1.0f / D); float s2 = 0.f;
#pragma unroll
            for (int j = 0; j < 4; ++j) { v[j] = v[j] - mean; s2 += (v[j].x * v[j].x + v[j].y * v[j].y) + (v[j].z * v[j].z + v[j].w * v[j].w); }
            const float rstd = 1.0f / sqrtf(wave_sum(s2) * (1.0f / D) + EPS);
#pragma unroll
            for (int j = 0; j < 4; ++j) { const f32x4 gg = ((const f32x4*)a.in[I_GCVLN])[lane + 64 * j], bb = ((const f32x4*)a.in[I_BCVLN])[lane + 64 * j];
                f32x4 yy = v[j] * rstd * gg + bb; yy.x *= fsig(yy.x); yy.y *= fsig(yy.y); yy.z *= fsig(yy.z); yy.w *= fsig(yy.w);
                store_row4<F8_MISC != 0>((unsigned char*)Z + (size_t)(m0 + r) * D * (F8_MISC ? 1 : 2), lane, j, yy, 4.0f); }
        }
    }
}


enum { PH_PRO = 0, PH_NORM0, PH_INPROJ, PH_SCANA, PH_SCANC, PH_READOUT, PH_OUTPROJ, PH_ROUTER0, PH_G1_0, PH_G2_0, PH_COMB0, PH_CVIN, PH_DWCONV, PH_LN, PH_CVOUT, PH_ROUTER1, PH_G1_1, PH_G2_1, PH_FINAL, NPH };
#ifndef REPMASK
#define REPMASK 0ull
#endif
#ifndef SCAN_NAIVE
#define SCAN_NAIVE 0
#endif
__global__ void __launch_bounds__(NTHR, 2) fwd_kernel(Args args) {
    extern __shared__ __attribute__((aligned(16))) unsigned char lds_raw[];
    LAS unsigned char* lds = (LAS unsigned char*)lds_raw;
    const int tid = threadIdx.x, lane = tid & 63, wave = __builtin_amdgcn_readfirstlane(tid >> 6);
    const int G = gridDim.x, bid = blockIdx.x;
    unsigned char* ws = args.ws;
    for (int u = tid; u < (LDS_BYTES - LDSCTL_OFF) / 4; u += NTHR) ((LAS unsigned*)(lds + LDSCTL_OFF))[u] = 0u;
    __syncthreads();
    volatile LAS unsigned* MISC = (volatile LAS unsigned*)(lds + MISC_OFF);
    XcdBarrier bar = xcd_barrier_post((unsigned*)(ws + WS_CTL) + CW_BAR + args.li * XCD_BAR_WORDS, MISC + 8);
    const int lo = args.ph_lo, hi = args.ph_hi;
    if (tid == 0) __hip_atomic_store((unsigned*)(ws + WS_CTL) + CW_XMAP + bid, xb_xcc_id() + 1u, __ATOMIC_RELAXED, __HIP_MEMORY_SCOPE_AGENT);
#define IN(k) (lo <= (k) && (k) < hi)
    int cv_n = 0; unsigned bseq = 0;
#ifndef FLAT_BARRIER
#define FLAT_BARRIER 0
#endif
#define SEAM(k) do { if (IN(k) && IN((k) + 1)) { ++bseq; if (FLAT_BARRIER) flat_barrier_work((unsigned*)(ws + WS_CTL) + CW_FLAT, args, lds, wave, lane, cv_n, MISC + 12, bseq); else xcd_barrier_work(bar, args, lds, wave, lane, cv_n, MISC + 12, bseq); } } while (0)
#define PHASE(k, ...) if (IN(k)) { __VA_ARGS__; if ((REPMASK >> (k)) & 1ull) { __syncthreads(); __VA_ARGS__; } } SEAM(k);
    typedef pg8::bf16_t pbf;

    const bool merge_pro = false && (G >= 32) && IN(PH_PRO) && IN(PH_NORM0);
    if (IN(PH_PRO)) { p_mods(args, lds, tid, lane, wave); p_weights(args, lds, lane, wave); if (merge_pro) wait_mods0(args, tid); }
    if (!merge_pro) SEAM(PH_PRO);
    const bool ctx_early = SPLIT_IN && (G == 256);
    PHASE(PH_NORM0, {
        if (ctx_early && bid < 24) {
            const int cb = bid / 12, cj = bid % 12;
            p_norm0(args, lane, wave, NWAVES, NTOK + cb * CTXL, NTOK + cb * CTXL + CTXL);
            VM_WAIT(); __syncthreads();
            if (cj < 8) {
                pg8::Gemm g{(const pbf*)(ws + WS_H8), (const pbf*)(ws + WS_WIN8), D / 2, 0};
                pg8::OneUnit S1{NTOK / 256 + cb, cj};
                pg8::EpiHgrnIn E{(pbf*)(ws + WS_Q), (WS_V - WS_Q) / 2, (_Float16*)(ws + WS_LFF), (WS_LFB - WS_LFF) / 2, args.in[I_HGAMMA], 2};
                pg8::gemm_phase<pg8::EpiHgrnIn, pg8::OneUnit, true, true, true, 0x79797979, 0x7F7F7F7F>(lds + RING_OFF, g, S1, E);
            } else {
                pg8::Gemm g{(const pbf*)(ws + WS_H), (const pbf*)(ws + WS_WIN), D, 0};
                pg8::OneUnit S1{NTOK / 256 + cb, 4 + (cj - 8)};
                pg8::EpiHgrnIn E{(pbf*)(ws + WS_Q), (WS_V - WS_Q) / 2, (_Float16*)(ws + WS_LFF), (WS_LFB - WS_LFF) / 2, args.in[I_HGAMMA], 1};
                pg8::gemm_phase<pg8::EpiHgrnIn, pg8::OneUnit, true, true, false>(lds + RING_OFF, g, S1, E);
            }
        } else if (ctx_early) p_norm0(args, lane, (bid - 24) * NWAVES + wave, (G - 24) * NWAVES, 0, NTOK);
        else p_norm0(args, lane, bid * NWAVES + wave, G * NWAVES, 0, MROWS);
    })
    PHASE(PH_INPROJ, {
        static_assert(WS_V - WS_Q == WS_SG - WS_V, "Q|V|SG equally spaced");
        if (SPLIT_IN) {
            const int nMi = ctx_early ? NTOK / 256 : MROWS / 256;
            {
                pg8::Gemm g{(const pbf*)(ws + WS_H8), (const pbf*)(ws + WS_WIN8), D / 2, 0};
                pg8::TileOrder S; S.init(nMi, 2 * D / 256, G, bid, nullptr);
                pg8::EpiHgrnIn E{(pbf*)(ws + WS_Q), (WS_V - WS_Q) / 2, (_Float16*)(ws + WS_LFF), (WS_LFB - WS_LFF) / 2, args.in[I_HGAMMA], 2};
                pg8::gemm_phase<pg8::EpiHgrnIn, pg8::TileOrder, true, true, true, 0x79797979, 0x7F7F7F7F>(lds + RING_OFF, g, S, E);
            }
            {
                pg8::Gemm g{(const pbf*)(ws + WS_H), (const pbf*)(ws + WS_WIN), D, 0};
                pg8::TileOrder S; S.init(nMi, 3 * D / 256, G, bid, nullptr);
                pg8::EpiHgrnIn E{(pbf*)(ws + WS_Q), (WS_V - WS_Q) / 2, (_Float16*)(ws + WS_LFF), (WS_LFB - WS_LFF) / 2, args.in[I_HGAMMA], 1};
                pg8::gemm_phase<pg8::EpiHgrnIn, pg8::TileOrder, true, true, false>(lds + RING_OFF, g, S, E);
            }
        } else {
            pg8::Gemm g{(const pbf*)(ws + WS_H), (const pbf*)(ws + WS_WIN), F8_IN ? D / 2 : D, 0};
            pg8::TileOrder S; S.init(MROWS / 256, 5 * D / 256, G, bid, nullptr);
            pg8::EpiHgrnIn E{(pbf*)(ws + WS_Q), (WS_V - WS_Q) / 2, (_Float16*)(ws + WS_LFF), (WS_LFB - WS_LFF) / 2, args.in[I_HGAMMA], 0};
            pg8::gemm_phase<pg8::EpiHgrnIn, pg8::TileOrder, true, true, F8_IN != 0, 0x79797979, 0x7F7F7F7F>(lds + RING_OFF, g, S, E);
        }
    })
#if SCAN_NAIVE
    PHASE(PH_SCANA, { p_scan_naive(args, lds, tid); })
    PHASE(PH_SCANC, { })
#else
    PHASE(PH_SCANA, { p_scan_a(args, lds, tid, lane, wave); })
    PHASE(PH_SCANC, { p_scan_c(args, lds, tid, lane, wave); })
#endif
    PHASE(PH_READOUT, { p_readout(args, lane, wave); })
    PHASE(PH_OUTPROJ, {
        pg8::Gemm g{(const pbf*)(ws + WS_YIN), (const pbf*)(ws + WS_WOUT), F8_MISC ? D / 2 : D, 0};
        pg8::TileOrder S; S.init(NTOK / 256, D / 256, G, bid, nullptr);
        pg8::EpiResGate<false, true> E{args.in[I_X], (void*)(ws + WS_X), (const float*)(ws + WS_MODS) + 2 * D, 6 * D, SEQ, nullptr};
        pg8::gemm_phase<pg8::EpiResGate<false, true>, pg8::TileOrder, true, true, F8_MISC != 0, 0x79797979, 0x7D7D7D7D>(lds + RING_OFF, g, S, E);
    })
#ifndef G1_NS
#define G1_NS 8
#endif
#ifndef MOE_HANDOFF
#define MOE_HANDOFF 1
#endif
#ifndef MOE_WT
#define MOE_WT 0
#endif
#define MOE_PHASES(l, pb) \
    if (IN(pb + 0)) { p_router(args, lds, l, tid, lane, wave); cv_finish(args, lds, wave, lane, cv_n, (l + 1) * CV_L0); } SEAM(pb + 0); \
    if (IN(pb + 1) || IN(pb + 2) || IN(pb + 3)) { \
        moe_tables(args, lds, l, tid); \
        LAS int* tab = (LAS int*)(lds + EXTRA_OFF + 640); \
        const LAS int* s_tb = (const LAS int*)(lds + EXTRA_OFF + 256); const LAS int* s_ce = s_tb + 40; \
        const int ntiles = __builtin_amdgcn_readfirstlane(s_tb[32]); \
        const bool hand = MOE_HANDOFF && (G == 256) && IN(pb + 1) && IN(pb + 2) && !((REPMASK >> (pb + 1)) & 3ull) && (MOE_WT || xmap_ok); \
        const int xl = (hand && !MOE_WT) ? 1 : 0; \
        unsigned* tcnt = (unsigned*)(ws + WS_CTL) + CW_TCNT + l * 32768; \
        const int c2 = (hand && MOE_WT) ? ((bid - ((((ntiles * 8) & 255) + 7) & ~7)) & 255) : bid;     \
        const int tv = (((bid & 7) + 1) * ntiles >> 3) - ((bid & 7) * ntiles >> 3);                   \
        if (IN(pb + 1)) { \
            LAS unsigned short* tt = (LAS unsigned short*)(lds + EXTRA_OFF + 2816);     \
            pg8::MoeOrder S; S.init(ntiles, 2 * D / 256, G, bid, tab); S.cnt = tcnt; S.rdy = 0u; S.mode = hand ? 0 : 2; S.xl = xl; S.rrot = bid >> 3; \
            { const int* STOK = (const int*)(ws + WS_STOK); pg8::Unit uu; for (int i = 0; S.next(i, uu); ++i) if (tid < 256) { const int vi = (uu.pm - s_tb[uu.e]) * 256 + tid; tt[i * 256 + tid] = vi < s_ce[uu.e] ? (unsigned short)STOK[(size_t)uu.e * NTOK + vi] : (unsigned short)0; } } \
            __syncthreads(); \
            pg8::Gemm g{(const pbf*)(ws + WS_H), (const pbf*)(ws + WS_W1 + (size_t)l * NE * 2 * D * D), D / 2, (size_t)2 * D * D, tt};   \
            pg8::EpiPair<0, true, 4, MOE_WT != 0> E{(pbf*)(ws + WS_ACT), args.in[I_BE1] + (size_t)l * NE * 2 * D}; \
            pg8::gemm_phase<pg8::EpiPair<0, true, 4, MOE_WT != 0>, pg8::MoeOrder, true, true, true, 0x79797979, 0x7F7F7F7F, true, MOE_WT ? G1_NS : 0>(lds + RING_OFF, g, S, E); \
            if ((REPMASK >> (pb + 1)) & 1ull) { __syncthreads(); pg8::gemm_phase<pg8::EpiPair<0, true, 4, MOE_WT != 0>, pg8::MoeOrder, true, true, true, 0x79797979, 0x7F7F7F7F, true, MOE_WT ? G1_NS : 0>(lds + RING_OFF, g, S, E); } \
        } \
        pg8::MoeOrder S2; S2.init(ntiles, D / 256, G, c2, tab); S2.cnt = tcnt; S2.rdy = 0u; S2.mode = hand ? 1 : 2; S2.xl = xl; S2.rrot = ((bid >> 3) - ((tv * 8) & 31)) & 31; \
        if (hand) {                                                          \
            if (wave == 0) { \
                int pm_ = 0, pn_ = 0; bool has; \
                if (xl) has = S2.local(lane, pm_, pn_); else { pg8::TileOrder T; T.init(ntiles, D / 256, G, c2, nullptr); pg8::Unit uu; has = T.next(lane, uu); pm_ = uu.pm; } \
                const unsigned v = has ? __hip_atomic_load(tcnt + 32 * pm_, __ATOMIC_RELAXED, __HIP_MEMORY_SCOPE_AGENT) : 64u; \
                const unsigned long long m = __ballot(v >= 64u); \
                __builtin_amdgcn_fence(__ATOMIC_ACQUIRE, "agent"); asm volatile("s_waitcnt vmcnt(0)" ::: "memory"); \
                if (lane == 0) MISC[16] = (unsigned)m; \
            } \
            __syncthreads(); \
            S2.rdy = __builtin_amdgcn_readfirstlane(MISC[16]); \
        } else SEAM(pb + 1); \
        PHASE(pb + 2, { \
            pg8::Gemm g{(const pbf*)(ws + WS_ACT), (const pbf*)(ws + WS_W2 + (size_t)l * NE * D * D), D / 2, (size_t)D * D}; \
            pg8::EpiMoeOut<F8_Y != 0, YSCALE> E{(pbf*)(ws + WS_YS), args.in[I_BE2] + (size_t)l * NE * D}; \
            pg8::gemm_phase<pg8::EpiMoeOut<F8_Y != 0, YSCALE>, pg8::MoeOrder, true, true, true, 0x79797979, 0x7D7D7D7D>(lds + RING_OFF, g, S2, E);   \
        }) \
    }
    bool xmap_ok = false;
    if (MOE_HANDOFF && !MOE_WT && G == 256 && lo == 0) {
        if (wave == 0) {
            const unsigned* xm = (const unsigned*)(ws + WS_CTL) + CW_XMAP; bool ok = true;
#pragma unroll
            for (int k = 0; k < 4; ++k) { const int b = lane + 64 * k; const unsigned mine = __hip_atomic_load(xm + b, __ATOMIC_RELAXED, __HIP_MEMORY_SCOPE_AGENT), cls = __hip_atomic_load(xm + (b & 7), __ATOMIC_RELAXED, __HIP_MEMORY_SCOPE_AGENT);
                ok = ok && mine != 0u && mine == cls; }
            const unsigned me = __hip_atomic_load(xm + (lane & 7), __ATOMIC_RELAXED, __HIP_MEMORY_SCOPE_AGENT);
#pragma unroll
            for (int j = 1; j < 8; ++j) { const unsigned other = (unsigned)__shfl((int)me, (lane + j) & 7); ok = ok && other != me; }
            const bool all_ok = __all(ok);
            if (lane == 0) MISC[17] = all_ok ? 1u : 0u;
        }
        __syncthreads();
        xmap_ok = __builtin_amdgcn_readfirstlane(MISC[17]) != 0u;
    }
    MOE_PHASES(0, PH_ROUTER0)
    PHASE(PH_COMB0, { p_combine<false>(args, lds, 0, lane, wave); })
    PHASE(PH_CVIN, {
        pg8::Gemm g{(const pbf*)(ws + WS_H), (const pbf*)(ws + WS_WCVIN), F8_MISC ? D / 2 : D, 0};
        pg8::TileOrder S; S.init(NTOK / 256, 2 * D / 256, G, bid, nullptr);
        pg8::EpiPair<1> E{(pbf*)(ws + WS_U), args.in[I_BCVIN]};
        pg8::gemm_phase<pg8::EpiPair<1>, pg8::TileOrder, true, true, F8_MISC != 0, 0x79797979, 0x7F7F7F7F>(lds + RING_OFF, g, S, E);
    })
    PHASE(PH_DWCONV, { p_dwconv(args, tid); })
    PHASE(PH_LN, { p_ln_silu(args, lane, wave); })
    PHASE(PH_CVOUT, {
        pg8::Gemm g{(const pbf*)(ws + WS_Z), (const pbf*)(ws + WS_WCVOUT), F8_MISC ? D / 2 : D, 0};
        pg8::TileOrder S; S.init(NTOK / 256, D / 256, G, bid, nullptr);
        pg8::EpiResGate<true, true> E{(const void*)(ws + WS_X), (void*)(ws + WS_X), (const float*)(ws + WS_MODS) + 3 * 6 * D + 2 * D, 6 * D, SEQ, args.in[I_BCVOUT]};
        pg8::gemm_phase<pg8::EpiResGate<true, true>, pg8::TileOrder, true, true, F8_MISC != 0, 0x79797979, 0x7D7D7D7D>(lds + RING_OFF, g, S, E);
    })
    MOE_PHASES(1, PH_ROUTER1)
    if (IN(PH_FINAL)) { p_combine<true>(args, lds, 1, lane, wave); }
#undef MOE_PHASES
#undef PHASE
#undef IN
#undef SEAM
}

extern "C" void kernel_launch(void* const* d_in, const int* in_sizes, int n_in, void* d_out, int out_size, void* d_ws, size_t ws_size, hipStream_t stream) {
    static int grid = 0;
    if (grid == 0) {
        if (n_in != N_IN || in_sizes[0] != NTOK * D || out_size != NTOK * D || ws_size < WS_END) { fprintf(stderr, "kernel_launch: unexpected shapes / workspace (n_in %d, in0 %d, out %d, ws %zu, need %zu); nothing launched\n", n_in, n_in > 0 ? in_sizes[0] : -1, out_size, ws_size, (size_t)WS_END); grid = -1; return; }
        int dev = 0, cus = 0, per_cu = 0;
        if (hipGetDevice(&dev) != hipSuccess || hipDeviceGetAttribute(&cus, hipDeviceAttributeMultiprocessorCount, dev) != hipSuccess) { grid = -1; return; }
        if (hipFuncSetAttribute((const void*)fwd_kernel, hipFuncAttributeMaxDynamicSharedMemorySize, LDS_BYTES) != hipSuccess) { fprintf(stderr, "kernel_launch: hipFuncSetAttribute failed\n"); grid = -1; return; }
        if (hipOccupancyMaxActiveBlocksPerMultiprocessor(&per_cu, (const void*)fwd_kernel, NTHR, LDS_BYTES) != hipSuccess || per_cu < 1) { fprintf(stderr, "kernel_launch: occupancy query reports %d workgroups per CU\n", per_cu); }
        (void)hipGetLastError();
        grid = cus;
    }
    if (grid < 0) return;
    if (hipMemsetAsync((char*)d_ws + WS_CTL, 0, CTL_ZERO_BYTES, stream) != hipSuccess) return;
#ifdef DIAG_MEMSET
    (void)hipMemsetAsync((char*)d_ws + WS_SP, 0, (WS_WIN - WS_SP), stream); (void)hipMemsetAsync((char*)d_ws + WS_OF, 0, (WS_YIN - WS_OF), stream);
#endif
    Args a{};
    for (int i = 0; i < N_IN; ++i) a.in[i] = (const float*)d_in[i];
    a.out = (float*)d_out; a.ws = (unsigned char*)d_ws; a.pad = 0;
#ifndef MK_CUTS
    a.ph_lo = 0; a.ph_hi = NPH; a.li = 0;
    hipLaunchKernelGGL(fwd_kernel, dim3(grid), dim3(NTHR), LDS_BYTES, stream, a);
#else
    const int cuts[] = {MK_CUTS};
    const int nc = (int)(sizeof(cuts) / sizeof(cuts[0]));
    for (int li = 0; li + 1 < nc; ++li) { a.ph_lo = cuts[li]; a.ph_hi = cuts[li + 1]; a.li = li; hipLaunchKernelGGL(fwd_kernel, dim3(grid), dim3(NTHR), LDS_BYTES, stream, a); }
#endif
}
```

```cpp
#include <hip/hip_runtime.h>
#include <cstdio>
#include <cstdint>
__device__ __forceinline__ void wg_sync_() { __builtin_amdgcn_fence(__ATOMIC_RELEASE, "workgroup"); __builtin_amdgcn_s_barrier(); __builtin_amdgcn_fence(__ATOMIC_ACQUIRE, "workgroup"); }
#define __syncthreads() wg_sync_()
#define __ballot(p) __builtin_amdgcn_ballot_w64((p) != 0)
#define __all(p) (__builtin_amdgcn_ballot_w64(!(p)) == 0ull)
#define __shfl(v, src) __builtin_amdgcn_ds_bpermute((int)(src) << 2, (int)(v))
#define __popcll(x) __builtin_popcountll(x)

namespace pg8 {
#define PG8_LAS __attribute__((address_space(3)))
typedef unsigned short bf16_t;
typedef short bf16x8 __attribute__((ext_vector_type(8)));
typedef float f32x4 __attribute__((ext_vector_type(4)));
typedef unsigned u32x4 __attribute__((ext_vector_type(4)));
typedef unsigned u32x2 __attribute__((ext_vector_type(2)));
typedef int i32x4 __attribute__((ext_vector_type(4)));
typedef int i32x8 __attribute__((ext_vector_type(8)));
#ifndef KL_PROBE
#define KL_PROBE 0
#endif
constexpr int KLP_LDS = 139264 + 320 + 4 * 28;
constexpr int BM = 256, BK = 64, HALF = 128, HTB = HALF * BK * 2  , STAGE_BYTES = 8 * HTB, NXCD = 8, WGM = 8;

__host__ __device__ __forceinline__ int lds_byte(int r, int c) { const int st = (r >> 4) * 2 + (c >> 5), rr = r & 15, cc = c & 31, ob = rr * 64 + cc * 2; return st * 1024 + (ob ^ (((ob >> 9) & 1) << 5)); }
__host__ __device__ __forceinline__ void stage_rc(int b, int& R, int& C) { const int st = b / 1024, sb = b % 1024, swz = sb ^ (((sb >> 9) & 1) << 5); R = (st >> 1) * 16 + swz / 64; C = (st & 1) * 32 + (swz % 64) / 2; }
__host__ __device__ __forceinline__ int perm32(int rho) { const int n = rho >> 4, i = rho & 15; return 8 * (i >> 2) + 4 * n + (i & 3); }

struct Unit { int pm, pn, e; };
struct Gemm { const bf16_t* A; const bf16_t* Bt; int K; size_t estride; const PG8_LAS unsigned short* tt; };

struct TileOrder {
    int nM, nN, nwg, G, c; const PG8_LAS int* tile_e;
    __device__ __forceinline__ void init(int nM_, int nN_, int G_, int c_, const PG8_LAS int* te) { nM = nM_; nN = nN_; nwg = nM * nN; G = G_; c = c_; tile_e = te; }
    __device__ __forceinline__ bool next(int i, Unit& u) const {
        const long L = (long)i * G + c; if (L >= nwg) return false;
        int wgid = (int)L; { const int q = nwg / NXCD, r = nwg % NXCD, xcd = wgid % NXCD, off = wgid / NXCD; wgid = (xcd < r ? xcd * (q + 1) : r * (q + 1) + (xcd - r) * q) + off; }
        const int nig = WGM * nN, gid = wgid / nig, fm = gid * WGM, gsz = (nM - fm) < WGM ? (nM - fm) : WGM;
        u.pm = fm + ((wgid % nig) % gsz); u.pn = (wgid % nig) / gsz;
        u.e = tile_e ? __builtin_amdgcn_readfirstlane(tile_e[u.pm]) : 0; return true;
    }
    static constexpr bool PUBLISH = false;
    __device__ __forceinline__ bool probe_on() const { return false; }
    __device__ __forceinline__ void a_ready(const Unit&, int) const {}
    __device__ __forceinline__ void done(const Unit&) const {}
    __device__ __forceinline__ void publish(int, int) const {}
};

struct MoeOrder {
    static constexpr bool PUBLISH = true;
    const PG8_LAS int* ut; int nu;
    unsigned* cnt; unsigned rdy; int mode;
    static __device__ __forceinline__ bool unit_of(int xl, int nM, int nN, int G, int c, int rrot, int i, int& pm, int& pn) {
        if (!xl) { TileOrder T; T.init(nM, nN, G, c, nullptr); Unit u; if (!T.next(i, u)) return false; pm = u.pm; pn = u.pn; return true; }
        const int v = c & 7, T0 = (v * nM) >> 3, Tv = (((v + 1) * nM) >> 3) - T0;
        const int Lx = i * 32 + rrot; if (Lx >= Tv * nN) return false;
        const int nig = WGM * nN, gid = Lx / nig, fm = gid * WGM, gsz = (Tv - fm) < WGM ? (Tv - fm) : WGM, w = Lx % nig;
        pm = T0 + fm + (w % gsz); pn = w / gsz; return true;
    }
    __device__ __forceinline__ bool next(int i, Unit& u) const {
        if (i >= nu) return false;
        const int v = __builtin_amdgcn_readfirstlane(ut[i]); u.pm = v & 0xFFFF; u.pn = (v >> 16) & 0xFF; u.e = (v >> 24) & 0xFF; return true;
    }
    __device__ __forceinline__ bool probe_on() const { return mode == 0; }
    __device__ __forceinline__ void done(const Unit&) const {}
    __device__ __forceinline__ void publish(int pm, int lane) const {
        if (mode == 0 && lane == 0) (void)__hip_atomic_fetch_add(cnt + 32 * pm, 1u, __ATOMIC_RELAXED, __HIP_MEMORY_SCOPE_AGENT);
    }
    __device__ __forceinline__ void a_ready(const Unit& u, int i) const {
        if (mode != 1 || ((rdy >> i) & 1u)) return;
        if (__builtin_amdgcn_readfirstlane(threadIdx.x >> 6) == 0) {
            unsigned sp = 0;
            while (__hip_atomic_load(cnt + 32 * u.pm, __ATOMIC_RELAXED, __HIP_MEMORY_SCOPE_AGENT) < 64u) { __builtin_amdgcn_s_sleep(1); if (++sp > (1u << 20)) break; }
            __builtin_amdgcn_fence(__ATOMIC_ACQUIRE, "agent");
            asm volatile("s_waitcnt vmcnt(0)" ::: "memory");
        }
        __builtin_amdgcn_s_barrier();
    }
};

struct OneUnit {
    int pm, pn;
    __device__ __forceinline__ bool next(int i, Unit& u) const { if (i != 0) return false; u.pm = pm; u.pn = pn; u.e = 0; return true; }
    static constexpr bool PUBLISH = false;
    __device__ __forceinline__ bool probe_on() const { return false; }
    __device__ __forceinline__ void a_ready(const Unit&, int) const {}
    __device__ __forceinline__ void done(const Unit&) const {}
    __device__ __forceinline__ void publish(int, int) const {}
};

__device__ __forceinline__ unsigned cvt_pk_bf16(float lo, float hi) { unsigned r; asm volatile("v_cvt_pk_bf16_f32 %0, %1, %2" : "=v"(r) : "v"(lo), "v"(hi)); return r; }
__device__ __forceinline__ float fsigmoid(float x) { return __builtin_amdgcn_rcpf(1.0f + __expf(-x)); }


struct EpiHgrnIn {
    static constexpr bool PERM = true, AFTER_DRAIN = false, LDS_BIAS = false;
    bf16_t* Q; size_t qstride; _Float16* LFF; size_t lfstride; const float* gamma; int mode;
    static __device__ __forceinline__ f32x4 vexp2(f32x4 t) { f32x4 e; e[0] = __builtin_amdgcn_exp2f(t[0]); e[1] = __builtin_amdgcn_exp2f(t[1]); e[2] = __builtin_amdgcn_exp2f(t[2]); e[3] = __builtin_amdgcn_exp2f(t[3]); return e; }
    static __device__ __forceinline__ f32x4 vrcp(f32x4 d) { f32x4 r; r[0] = __builtin_amdgcn_rcpf(d[0]); r[1] = __builtin_amdgcn_rcpf(d[1]); r[2] = __builtin_amdgcn_rcpf(d[2]); r[3] = __builtin_amdgcn_rcpf(d[3]); return r; }
    static __device__ __forceinline__ f32x4 vlog2(f32x4 d) { f32x4 r; r[0] = __builtin_amdgcn_logf(d[0]); r[1] = __builtin_amdgcn_logf(d[1]); r[2] = __builtin_amdgcn_logf(d[2]); r[3] = __builtin_amdgcn_logf(d[3]); return r; }
    __device__ __forceinline__ void operator()(const f32x4 (&acc)[2][2][4][2], const Unit& u, int wr, int wc, int fr, int fq) const {
        const int sg_ = u.pn >> 2, seg = mode == 0 ? sg_ : (mode == 1 ? (sg_ < 2 ? sg_ : 4) : 2 + sg_), cb = (u.pn & 3) * 256 + wc * 32 + 8 * fq;
        const int row0 = u.pm * BM + wr * 64 + fr;
        if (seg == 2 || seg == 3) {
            _Float16* O = LFF + (size_t)(seg - 2) * lfstride; const float* g0 = gamma + (seg - 2) * 2048 + cb;
            f32x4 lb[2][2];
#pragma unroll
            for (int bj = 0; bj < 2; ++bj)
#pragma unroll
                for (int n = 0; n < 2; ++n) { const f32x4 d = *(const f32x4*)(g0 + bj * HALF + 4 * n) - *(const f32x4*)(g0 + 1024 + bj * HALF + 4 * n);
                    lb[bj][n] = vrcp(vexp2(d * -1.4426950408889634f) + 1.0f); }
#pragma unroll
            for (int ai = 0; ai < 2; ++ai)
#pragma unroll
                for (int m = 0; m < 4; ++m) { _Float16* rowp = O + (size_t)(row0 + ai * HALF + m * 16) * 1024 + cb;
#pragma unroll
                    for (int bj = 0; bj < 2; ++bj) { typedef _Float16 h16x8 __attribute__((ext_vector_type(8))); h16x8 o;
#pragma unroll
                        for (int n = 0; n < 2; ++n) { const f32x4 sg = vrcp(vexp2(acc[ai][bj][m][n] * -1.4426950408889634f) + 1.0f);
                            const f32x4 lf = vlog2(lb[bj][n] + (1.0f - lb[bj][n]) * sg) * 0.6931471805599453f;
                            o[4 * n + 0] = (_Float16)lf[0]; o[4 * n + 1] = (_Float16)lf[1]; o[4 * n + 2] = (_Float16)lf[2]; o[4 * n + 3] = (_Float16)lf[3]; }
                        *(h16x8*)(rowp + bj * HALF) = o; } }
        } else {
            bf16_t* O = Q + (size_t)(seg - (seg >> 2) * 2) * qstride;
#pragma unroll
            for (int ai = 0; ai < 2; ++ai)
#pragma unroll
                for (int m = 0; m < 4; ++m) { bf16_t* rowp = O + (size_t)(row0 + ai * HALF + m * 16) * 1024 + cb;
#pragma unroll
                    for (int bj = 0; bj < 2; ++bj) { f32x4 v0 = acc[ai][bj][m][0], v1 = acc[ai][bj][m][1];
                        if (seg == 4) { v0 = v0 * vrcp(vexp2(v0 * -1.4426950408889634f) + 1.0f); v1 = v1 * vrcp(vexp2(v1 * -1.4426950408889634f) + 1.0f); }
                        u32x4 w; w.x = cvt_pk_bf16(v0[0], v0[1]); w.y = cvt_pk_bf16(v0[2], v0[3]); w.z = cvt_pk_bf16(v1[0], v1[1]); w.w = cvt_pk_bf16(v1[2], v1[3]);
                        *(u32x4*)(rowp + bj * HALF) = w; } }
        }
    }
};
template <bool B16> struct RawOf { typedef u32x4 T; };
template <> struct RawOf<true> { typedef u32x2 T; };
template <bool BASE16, bool OUT16> struct EpiResGate {
    static constexpr bool PERM = false, AFTER_DRAIN = false, LDS_BIAS = false;
    const void* base; void* out; const float* gate; int gate_bstride; int rows_per_batch; const float* bias;
    __device__ __forceinline__ void operator()(const f32x4 (&acc)[2][2][4][2], const Unit& u, int wr, int wc, int fr, int fq) const {
        const int row0 = u.pm * BM + wr * 64 + fr, col0 = u.pn * BM + wc * 32 + 4 * fq;
        const float* gv_ = gate + (size_t)((u.pm * BM) / rows_per_batch) * gate_bstride;
        f32x4 gv[2][2], bv[2][2];
#pragma unroll
        for (int bj = 0; bj < 2; ++bj)
#pragma unroll
            for (int n = 0; n < 2; ++n) { gv[bj][n] = *(const f32x4*)(gv_ + col0 + bj * HALF + n * 16); bv[bj][n] = bias ? *(const f32x4*)(bias + col0 + bj * HALF + n * 16) : (f32x4){0.f, 0.f, 0.f, 0.f}; }
        typedef typename RawOf<BASE16>::T raw_t;
        raw_t rb[2][8];
#define ERG_LOAD(b_, dst_) do { _Pragma("unroll") for (int mm = 0; mm < 2; ++mm) _Pragma("unroll") for (int bj = 0; bj < 2; ++bj) _Pragma("unroll") for (int n = 0; n < 2; ++n) { \
            const size_t o = (size_t)(row0 + ((b_) >> 1) * HALF + (2 * ((b_) & 1) + mm) * 16) * 1024 + col0 + bj * HALF + n * 16; \
            if constexpr (BASE16) dst_[mm * 4 + bj * 2 + n] = *(const raw_t*)((const bf16_t*)base + o); else dst_[mm * 4 + bj * 2 + n] = *(const raw_t*)((const float*)base + o); } } while (0)
        ERG_LOAD(0, rb[0]);
#pragma unroll
        for (int b = 0; b < 4; ++b) {
            if (b < 3) ERG_LOAD(b + 1, rb[(b + 1) & 1]);
            const int ai = b >> 1;
#pragma unroll
            for (int mm = 0; mm < 2; ++mm) { const int m = 2 * (b & 1) + mm;
#pragma unroll
                for (int bj = 0; bj < 2; ++bj)
#pragma unroll
                    for (int n = 0; n < 2; ++n) { const size_t o = (size_t)(row0 + ai * HALF + m * 16) * 1024 + col0 + bj * HALF + n * 16; f32x4 bs; const raw_t w = rb[b & 1][mm * 4 + bj * 2 + n];
                        if constexpr (BASE16) bs = (f32x4){__builtin_bit_cast(float, w[0] << 16), __builtin_bit_cast(float, w[0] & 0xffff0000u), __builtin_bit_cast(float, w[1] << 16), __builtin_bit_cast(float, w[1] & 0xffff0000u)};
                        else bs = __builtin_bit_cast(f32x4, w);
                        const f32x4 r = bs + gv[bj][n] * (acc[ai][bj][m][n] + bv[bj][n]);
                        if constexpr (OUT16) *(u32x2*)((bf16_t*)out + o) = (u32x2){cvt_pk_bf16(r[0], r[1]), cvt_pk_bf16(r[2], r[3])};
                        else *(f32x4*)((float*)out + o) = r; } }
        }
#undef ERG_LOAD
    }
};
template <int MODE, bool OUT8 = false, int OSCALE = 1, bool WT = false, bool LB = false> struct EpiPair {
    static constexpr bool PERM = true, AFTER_DRAIN = false, LDS_BIAS = LB;
    bf16_t* O; const float* bias0; const PG8_LAS float* lb;
    __device__ __forceinline__ void stage_bias(const Unit& u, int lane) const {
        const float* src = bias0 + (MODE == 0 ? (size_t)u.e * 2048 : 0) + (lane < 32 ? 0 : 1024 - 128) + u.pn * HALF + lane * 4;
        __builtin_amdgcn_global_load_lds((const unsigned*)src, (PG8_LAS unsigned*)lb, 16, 0, 0);
    }
    static __device__ __forceinline__ f32x4 vsig(f32x4 x, float negscale) {
        const f32x4 t = x * negscale; f32x4 e; e[0] = __builtin_amdgcn_exp2f(t[0]); e[1] = __builtin_amdgcn_exp2f(t[1]); e[2] = __builtin_amdgcn_exp2f(t[2]); e[3] = __builtin_amdgcn_exp2f(t[3]);
        const f32x4 d = e + 1.0f; f32x4 r; r[0] = __builtin_amdgcn_rcpf(d[0]); r[1] = __builtin_amdgcn_rcpf(d[1]); r[2] = __builtin_amdgcn_rcpf(d[2]); r[3] = __builtin_amdgcn_rcpf(d[3]); return r; }
    __device__ __forceinline__ void operator()(const f32x4 (&acc)[2][2][4][2], const Unit& u, int wr, int wc, int fr, int fq) const {
        const float* bias = bias0 + (MODE == 0 ? (size_t)u.e * 2048 : 0);
        const int row0 = u.pm * BM + wr * 64 + fr, cg = u.pn * HALF + wc * 32 + 8 * fq;
        f32x4 b0[2], b1[2];
#pragma unroll
        for (int n = 0; n < 2; ++n) {
            if constexpr (LB) { b0[n] = *(const PG8_LAS f32x4*)(lb + wc * 32 + 8 * fq + 4 * n); b1[n] = *(const PG8_LAS f32x4*)(lb + 128 + wc * 32 + 8 * fq + 4 * n); }
            else { b0[n] = *(const f32x4*)(bias + cg + 4 * n); b1[n] = *(const f32x4*)(bias + 1024 + cg + 4 * n); } }
#pragma unroll
        for (int ai = 0; ai < 2; ++ai)
#pragma unroll
            for (int m = 0; m < 4; ++m) { bf16_t* rowp = O + (size_t)(row0 + ai * HALF + m * 16) * 1024 + cg; f32x4 r[2];
#pragma unroll
                for (int n = 0; n < 2; ++n) { const f32x4 g = acc[ai][0][m][n] + b0[n], up = acc[ai][1][m][n] + b1[n];
                    if (MODE == 0) { const f32x4 gg = __builtin_elementwise_min(g, (f32x4){7.0f, 7.0f, 7.0f, 7.0f});
                        const f32x4 uu = __builtin_elementwise_min(__builtin_elementwise_max(up, (f32x4){-7.0f, -7.0f, -7.0f, -7.0f}), (f32x4){7.0f, 7.0f, 7.0f, 7.0f});
                        r[n] = (uu * (float)OSCALE + (float)OSCALE) * (gg * vsig(gg, -1.702f * 1.4426950408889634f)); }
                    else r[n] = (g * (float)OSCALE) * vsig(up, -1.4426950408889634f); }
                if constexpr (OUT8) {
                    int w0 = 0, w1 = 0;
                    w0 = __builtin_amdgcn_cvt_pk_fp8_f32(r[0][0], r[0][1], w0, false); w0 = __builtin_amdgcn_cvt_pk_fp8_f32(r[0][2], r[0][3], w0, true);
                    w1 = __builtin_amdgcn_cvt_pk_fp8_f32(r[1][0], r[1][1], w1, false); w1 = __builtin_amdgcn_cvt_pk_fp8_f32(r[1][2], r[1][3], w1, true);
                    if constexpr (WT) __hip_atomic_store((unsigned long long*)((unsigned char*)O + (size_t)(row0 + ai * HALF + m * 16) * 1024 + cg), ((unsigned long long)(unsigned)w1 << 32) | (unsigned)w0, __ATOMIC_RELAXED, __HIP_MEMORY_SCOPE_AGENT);
                    else *(u32x2*)((unsigned char*)O + (size_t)(row0 + ai * HALF + m * 16) * 1024 + cg) = (u32x2){(unsigned)w0, (unsigned)w1};
                } else {
                u32x4 w; w.x = cvt_pk_bf16(r[0][0], r[0][1]); w.y = cvt_pk_bf16(r[0][2], r[0][3]); w.z = cvt_pk_bf16(r[1][0], r[1][1]); w.w = cvt_pk_bf16(r[1][2], r[1][3]);
                *(u32x4*)rowp = w; } }
    }
};
template <bool OUT8, int OSCALE, bool LB = false> struct EpiMoeOut {
    static constexpr bool PERM = true, AFTER_DRAIN = false, LDS_BIAS = LB;
    bf16_t* O; const float* bias0; const PG8_LAS float* lb;
    __device__ __forceinline__ void stage_bias(const Unit& u, int lane) const {
        __builtin_amdgcn_global_load_lds((const unsigned*)(bias0 + (size_t)u.e * 1024 + u.pn * BM + lane * 4), (PG8_LAS unsigned*)lb, 16, 0, 0);
    }
    __device__ __forceinline__ void operator()(const f32x4 (&acc)[2][2][4][2], const Unit& u, int wr, int wc, int fr, int fq) const {
        const float* bias = bias0 + (size_t)u.e * 1024;
        const int row0 = u.pm * BM + wr * 64 + fr, col0 = u.pn * BM + wc * 32 + 8 * fq;
        f32x4 bv[2][2];
#pragma unroll
        for (int bj = 0; bj < 2; ++bj)
#pragma unroll
            for (int n = 0; n < 2; ++n) {
                if constexpr (LB) bv[bj][n] = *(const PG8_LAS f32x4*)(lb + wc * 32 + 8 * fq + bj * HALF + 4 * n);
                else bv[bj][n] = *(const f32x4*)(bias + col0 + bj * HALF + 4 * n); }
#pragma unroll
        for (int ai = 0; ai < 2; ++ai)
#pragma unroll
            for (int m = 0; m < 4; ++m) { const int r = row0 + ai * HALF + m * 16;
#pragma unroll
                for (int bj = 0; bj < 2; ++bj) { const f32x4 v0 = acc[ai][bj][m][0] + bv[bj][0], v1 = acc[ai][bj][m][1] + bv[bj][1];
                    if constexpr (OUT8) { const f32x4 lim = (f32x4){448.0f, 448.0f, 448.0f, 448.0f};
                        const f32x4 s0 = __builtin_elementwise_min(__builtin_elementwise_max(v0 * (float)OSCALE, -lim), lim), s1 = __builtin_elementwise_min(__builtin_elementwise_max(v1 * (float)OSCALE, -lim), lim); int w0 = 0, w1 = 0;
                        w0 = __builtin_amdgcn_cvt_pk_fp8_f32(s0[0], s0[1], w0, false); w0 = __builtin_amdgcn_cvt_pk_fp8_f32(s0[2], s0[3], w0, true);
                        w1 = __builtin_amdgcn_cvt_pk_fp8_f32(s1[0], s1[1], w1, false); w1 = __builtin_amdgcn_cvt_pk_fp8_f32(s1[2], s1[3], w1, true);
                        *(u32x2*)((unsigned char*)O + (size_t)r * 1024 + col0 + bj * HALF) = (u32x2){(unsigned)w0, (unsigned)w1};
                    } else { u32x4 w; w.x = cvt_pk_bf16(v0[0], v0[1]); w.y = cvt_pk_bf16(v0[2], v0[3]); w.z = cvt_pk_bf16(v1[0], v1[1]); w.w = cvt_pk_bf16(v1[2], v1[3]);
                        *(u32x4*)(O + (size_t)r * 1024 + col0 + bj * HALF) = w; } } }
    }
};

template <class Epi, class Sched, bool ALIGN_EPI = false, bool SP2 = false, bool F8 = false, int SCW = 0x7F7F7F7F, int SCA = 0x7F7F7F7F, bool GATHER = false, int NS = 0, bool ZC = F8>
__device__ __forceinline__ void gemm_phase(PG8_LAS unsigned char* lds, const Gemm g, const Sched& S, const Epi& E) {
    const int tid = threadIdx.x, wid = __builtin_amdgcn_readfirstlane(tid >> 6), lane = tid & 63, wr = wid >> 2, wc = wid & 3, fr = lane & 15, fq = lane >> 4;
    const int K = g.K, nt = K / BK;
    unsigned voffA[2], voffB[2]; int stR[2], stC[2];
#pragma unroll
    for (int i = 0; i < 2; ++i) { int R, C; stage_rc(tid * 16 + i * 8192, R, C); const int Rb = Epi::PERM ? ((R & ~31) + perm32(R & 31)) : R; stR[i] = R; stC[i] = C;
        voffA[i] = (unsigned)(R * K + C) * 2u; voffB[i] = (unsigned)(Rb * K + C) * 2u; }
    const size_t kstep = (size_t)(BK * 2);
    const size_t hstep = (size_t)HALF * K * 2;
    const size_t tstep = 2 * hstep;
    unsigned vc[2][2], vn[2][2];
#pragma unroll
    for (int h = 0; h < 2; ++h)
#pragma unroll
        for (int i = 0; i < 2; ++i) {
            if constexpr (GATHER) vc[h][i] = (unsigned)g.tt[h * HALF + stR[i]] * (unsigned)(K * 2) + (unsigned)stC[i] * 2u;
            else vc[h][i] = voffA[i] + (unsigned)h * (unsigned)hstep;
            vn[h][i] = vc[h][i]; }
    const unsigned ldsw = (unsigned)wid * 1024u;
    const int aoff = lds_byte(wr * 64 + fr, fq * 8), boff = lds_byte(wc * 32 + fr, fq * 8);
#define PG8_SA(b, h) (((b) * 2 + (h)) * HTB)
#define PG8_SB(b, h) ((4 + (b) * 2 + (h)) * HTB)
#define PG8_STAGE(bufoff, gbase, voff) do { _Pragma("unroll") for (int _i = 0; _i < 2; ++_i) \
        __builtin_amdgcn_global_load_lds((const unsigned*)((const char*)(gbase) + (voff)[_i]), (PG8_LAS unsigned*)(lds + (bufoff) + ldsw + _i * 8192), 16, 0, 0); } while (0)
#define PG8_LDA(dst, b, h) do { _Pragma("unroll") for (int m = 0; m < 4; ++m) _Pragma("unroll") for (int k = 0; k < 2; ++k) dst[m][k] = *(const PG8_LAS bf16x8*)(lds + PG8_SA(b, h) + aoff + m * 2048 + k * 1024); } while (0)
#define PG8_LDB(dst, b, h) do { _Pragma("unroll") for (int n = 0; n < 2; ++n) _Pragma("unroll") for (int k = 0; k < 2; ++k) dst[n][k] = *(const PG8_LAS bf16x8*)(lds + PG8_SB(b, h) + boff + n * 2048 + k * 1024); } while (0)
#define PG8_MMA(ai, bj, At, Bt) do { __builtin_amdgcn_s_setprio(1); \
        if constexpr (!F8) { _Pragma("unroll") for (int m = 0; m < 4; ++m) _Pragma("unroll") for (int n = 0; n < 2; ++n) _Pragma("unroll") for (int k = 0; k < 2; ++k) \
            acc[ai][bj][m][n] = __builtin_amdgcn_mfma_f32_16x16x32_bf16(Bt[n][k], At[m][k], acc[ai][bj][m][n], 0, 0, 0); } \
        else { const int scw_ = SCW, sca_ = SCA; _Pragma("unroll") for (int m = 0; m < 4; ++m) _Pragma("unroll") for (int n = 0; n < 2; ++n) { \
            const i32x8 wf_ = __builtin_shufflevector(__builtin_bit_cast(i32x4, Bt[n][0]), __builtin_bit_cast(i32x4, Bt[n][1]), 0, 1, 2, 3, 4, 5, 6, 7); \
            const i32x8 af_ = __builtin_shufflevector(__builtin_bit_cast(i32x4, At[m][0]), __builtin_bit_cast(i32x4, At[m][1]), 0, 1, 2, 3, 4, 5, 6, 7); \
            asm volatile("v_mfma_scale_f32_16x16x128_f8f6f4 %0, %1, %2, %0, %3, %4 op_sel_hi:[0,0,0]" : "+v"(acc[ai][bj][m][n]) : "v"(wf_), "v"(af_), "v"(scw_), "v"(sca_)); } } \
        __builtin_amdgcn_s_setprio(0); } while (0)
#define PG8_MMAZ(ai, bj, At, Bt) do { __builtin_amdgcn_s_setprio(1); \
        if constexpr (!F8) { _Pragma("unroll") for (int m = 0; m < 4; ++m) _Pragma("unroll") for (int n = 0; n < 2; ++n) { \
            acc[ai][bj][m][n] = __builtin_amdgcn_mfma_f32_16x16x32_bf16(Bt[n][0], At[m][0], (f32x4){0.f, 0.f, 0.f, 0.f}, 0, 0, 0); \
            acc[ai][bj][m][n] = __builtin_amdgcn_mfma_f32_16x16x32_bf16(Bt[n][1], At[m][1], acc[ai][bj][m][n], 0, 0, 0); } } \
        else { const int scw_ = SCW, sca_ = SCA; _Pragma("unroll") for (int m = 0; m < 4; ++m) _Pragma("unroll") for (int n = 0; n < 2; ++n) { \
            const i32x8 wf_ = __builtin_shufflevector(__builtin_bit_cast(i32x4, Bt[n][0]), __builtin_bit_cast(i32x4, Bt[n][1]), 0, 1, 2, 3, 4, 5, 6, 7); \
            const i32x8 af_ = __builtin_shufflevector(__builtin_bit_cast(i32x4, At[m][0]), __builtin_bit_cast(i32x4, At[m][1]), 0, 1, 2, 3, 4, 5, 6, 7); \
            asm volatile("v_mfma_scale_f32_16x16x128_f8f6f4 %0, %1, %2, 0, %3, %4 op_sel_hi:[0,0,0]" : "=&v"(acc[ai][bj][m][n]) : "v"(wf_), "v"(af_), "v"(scw_), "v"(sca_)); } } \
        __builtin_amdgcn_s_setprio(0); } while (0)
#define PG8_WAIT_V(n) asm volatile("s_waitcnt vmcnt(" #n ")" ::: "memory")
#define PG8_WAIT_VN(n) asm volatile("s_waitcnt vmcnt(%0)" :: "n"(n) : "memory")
#define PG8_WAIT_L(n) asm volatile("s_waitcnt lgkmcnt(" #n ")" ::: "memory")
#define PG8_BAR __builtin_amdgcn_s_barrier()
#define PG8_SCHED __builtin_amdgcn_sched_barrier(0)
    Unit cur, nxt; int ui = 0, ppm = 0;
    if (!S.next(0, cur)) return;
#if KL_PROBE
    if (Sched::PUBLISH && S.probe_on() && blockIdx.x == 0 && wid == 0) { const unsigned long long t0_ = __builtin_amdgcn_s_memtime(); if (lane == 0) { PG8_LAS unsigned* kp = (PG8_LAS unsigned*)(unsigned)KLP_LDS; kp[6] = (unsigned)t0_; kp[7] = (unsigned)(t0_ >> 32); } }
#endif
    static_assert(SP2, "this build keeps only the SP2 K-loop");
    f32x4 acc[2][2][4][2];
    if constexpr (!ZC) {
#pragma unroll
    for (int a = 0; a < 2; ++a)
#pragma unroll
        for (int b = 0; b < 2; ++b)
#pragma unroll
            for (int m = 0; m < 4; ++m)
#pragma unroll
                for (int n = 0; n < 2; ++n) acc[a][b][m][n] = (f32x4){0.f, 0.f, 0.f, 0.f};
    }
    bf16x8 At[4][2], B0[2][2], B1[2][2];
    const char* cA = (const char*)g.A + (GATHER ? (size_t)0 : (size_t)cur.pm * tstep); const char* cB = (const char*)g.Bt + (size_t)cur.e * g.estride + (size_t)cur.pn * tstep;
    S.a_ready(cur, 0);
    if constexpr (SP2) {
        PG8_STAGE(PG8_SB(0, 0), cB, voffB); PG8_STAGE(PG8_SB(0, 1), cB + hstep, voffB); PG8_STAGE(PG8_SA(0, 0), cA, vc[0]); PG8_STAGE(PG8_SA(0, 1), cA, vc[1]);
        if (wr == 1) PG8_BAR;
        PG8_WAIT_V(2); PG8_BAR;
        PG8_STAGE(PG8_SB(1, 0), cB + kstep, voffB); PG8_STAGE(PG8_SA(1, 0), cA + kstep, vc[0]); PG8_STAGE(PG8_SB(1, 1), cB + hstep + kstep, voffB);
        PG8_WAIT_V(6); PG8_BAR;
    } else {
        PG8_STAGE(PG8_SB(0, 0), cB, voffB); PG8_STAGE(PG8_SA(0, 0), cA, vc[0]); PG8_STAGE(PG8_SB(0, 1), cB + hstep, voffB); PG8_STAGE(PG8_SA(0, 1), cA, vc[1]);
        if (wr == 1) PG8_BAR;
        PG8_WAIT_V(4); PG8_BAR;
        PG8_STAGE(PG8_SB(1, 0), cB + kstep, voffB); PG8_STAGE(PG8_SA(1, 0), cA + kstep, vc[0]); PG8_STAGE(PG8_SB(1, 1), cB + hstep + kstep, voffB);
        PG8_WAIT_V(6); PG8_BAR;
    }
    for (;;) {
        const bool has_next = S.next(ui + 1, nxt);
        if constexpr (GATHER) { if (has_next) {
#pragma unroll
            for (int h = 0; h < 2; ++h)
#pragma unroll
                for (int i = 0; i < 2; ++i) vn[h][i] = (unsigned)g.tt[(ui + 1) * BM + h * HALF + stR[i]] * (unsigned)(K * 2) + (unsigned)stC[i] * 2u; } }
        const char* nA = (has_next && !GATHER) ? (const char*)g.A + (size_t)nxt.pm * tstep : cA; const char* nB = has_next ? (const char*)g.Bt + (size_t)nxt.e * g.estride + (size_t)nxt.pn * tstep : cB;
#if KL_PROBE
        if (Sched::PUBLISH && S.probe_on() && blockIdx.x == 0 && wid == 0) { const unsigned long long t0_ = __builtin_amdgcn_s_memtime(); if (lane == 0) { PG8_LAS unsigned* kp = (PG8_LAS unsigned*)(unsigned)KLP_LDS; kp[4] = (unsigned)t0_; kp[5] = (unsigned)(t0_ >> 32); } }
#endif
#define PG8_WAIT_V8R do { if constexpr (NS > 0) { PG8_WAIT_VN(8 + NS); if (!rlx) PG8_WAIT_V(8); } else PG8_WAIT_V(8); } while (0)
#define PG8_TRIP(MMAK_, FIRST_) { \
            const bool last = (t == nt - 2); \
            unsigned vs[2][2]; \
            _Pragma("unroll") for (int h = 0; h < 2; ++h) _Pragma("unroll") for (int i = 0; i < 2; ++i) vs[h][i] = (GATHER && last) ? vn[h][i] : vc[h][i]; \
            const char* a1 = cA + (size_t)(t + 1) * kstep;                                             \
            const char* a2 = last ? nA : cA + (size_t)(t + 2) * kstep; const char* b2 = last ? nB : cB + (size_t)(t + 2) * kstep;     \
            const char* a3 = a2 + kstep; const char* b3 = b2 + kstep;                                \
            if (last && has_next) S.a_ready(nxt, ui + 1); \
            if constexpr (Epi::LDS_BIAS) { if (last && wid == 0) E.stage_bias(cur, lane); }     \
            if constexpr (Sched::PUBLISH) { if (t == 2 && ui > 0) S.publish(ppm, lane); }     \
            const bool rlx = (NS > 0) && (FIRST_) && (ui > 0); \
              \
            PG8_LDB(B0, 0, 0); PG8_LDB(B1, 0, 1); PG8_SCHED; PG8_LDA(At, 0, 0); if (!rlx) PG8_STAGE(PG8_SA(1, 1), a1, vc[1]); \
            PG8_WAIT_V8R; PG8_WAIT_L(0); PG8_BAR; MMAK_(0, 0, At, B0); MMAK_(0, 1, At, B1); PG8_BAR; PG8_SCHED; \
              \
            PG8_LDA(At, 0, 1); PG8_STAGE(PG8_SB(0, 0), b2, voffB); PG8_STAGE(PG8_SB(0, 1), b2 + hstep, voffB); PG8_STAGE(PG8_SA(0, 0), a2, vs[0]); \
            PG8_WAIT_V8R; PG8_WAIT_L(0); PG8_BAR; MMAK_(1, 0, At, B0); MMAK_(1, 1, At, B1); PG8_BAR; PG8_SCHED; \
              \
            PG8_LDB(B0, 1, 0); PG8_LDB(B1, 1, 1); PG8_SCHED; PG8_LDA(At, 1, 0); PG8_STAGE(PG8_SA(0, 1), a2, vs[1]); \
            PG8_WAIT_V8R; PG8_WAIT_L(0); PG8_BAR; PG8_MMA(0, 0, At, B0); PG8_MMA(0, 1, At, B1); PG8_BAR; PG8_SCHED; \
              \
            PG8_LDA(At, 1, 1); PG8_STAGE(PG8_SB(1, 0), b3, voffB); PG8_STAGE(PG8_SB(1, 1), b3 + hstep, voffB); PG8_STAGE(PG8_SA(1, 0), a3, vs[0]); \
            PG8_WAIT_V(8); PG8_WAIT_L(0); PG8_BAR; PG8_MMA(1, 0, At, B0); PG8_MMA(1, 1, At, B1); PG8_BAR; PG8_SCHED; }
        if constexpr (ZC) {
            { const int t = 0; PG8_TRIP(PG8_MMAZ, true) }
            for (int t = 2; t < nt; t += 2) PG8_TRIP(PG8_MMA, false)
        } else {
            for (int t = 0; t < nt; t += 2) PG8_TRIP(PG8_MMA, t == 0)
        }
#if KL_PROBE
        if (Sched::PUBLISH && S.probe_on() && blockIdx.x == 0 && wid == 0) { const unsigned long long t1_ = __builtin_amdgcn_s_memtime(); if (lane == 0) { PG8_LAS unsigned* kp = (PG8_LAS unsigned*)(unsigned)KLP_LDS; const unsigned long long d = t1_ - (((unsigned long long)kp[5] << 32) | kp[4]); const unsigned long long acc_ = (((unsigned long long)kp[1] << 32) | kp[0]) + d; kp[0] = (unsigned)acc_; kp[1] = (unsigned)(acc_ >> 32); kp[2] += 1u; } }
#endif
        if constexpr (ALIGN_EPI) { if (wr == 0) PG8_BAR; }
        if constexpr (NS > 0) { static_assert(SP2 && ALIGN_EPI, "NS needs SP2 and ALIGN_EPI"); if (has_next) PG8_STAGE(PG8_SA(1, 1), nA + kstep, vn[1]); }
        if constexpr (!Epi::AFTER_DRAIN) { E(acc, cur, wr, wc, fr, fq); S.done(cur); ppm = cur.pm; }
        if (!has_next) break;
        if constexpr (!ZC) {
#pragma unroll
        for (int a = 0; a < 2; ++a)
#pragma unroll
            for (int b = 0; b < 2; ++b)
#pragma unroll
                for (int m = 0; m < 4; ++m)
#pragma unroll
                    for (int n = 0; n < 2; ++n) acc[a][b][m][n] = (f32x4){0.f, 0.f, 0.f, 0.f};
        }
        cur = nxt; cA = nA; cB = nB; ++ui;
        if constexpr (GATHER) {
#pragma unroll
            for (int h = 0; h < 2; ++h)
#pragma unroll
                for (int i = 0; i < 2; ++i) vc[h][i] = vn[h][i]; }
        if constexpr (ALIGN_EPI) { if (wr == 1) PG8_BAR; }
    }
#if KL_PROBE
    if (Sched::PUBLISH && S.probe_on() && blockIdx.x == 0 && wid == 0) { const unsigned long long t1_ = __builtin_amdgcn_s_memtime(); if (lane == 0) { PG8_LAS unsigned* kp = (PG8_LAS unsigned*)(unsigned)KLP_LDS; const unsigned long long d = t1_ - (((unsigned long long)kp[7] << 32) | kp[6]); const unsigned long long acc_ = (((unsigned long long)kp[9] << 32) | kp[8]) + d; kp[8] = (unsigned)acc_; kp[9] = (unsigned)(acc_ >> 32); } }
#endif
    PG8_WAIT_V(0); if constexpr (Sched::PUBLISH) S.publish(ppm, lane);
    if constexpr (!ALIGN_EPI) { if (wr == 0) PG8_BAR; }
    PG8_BAR;
    if constexpr (Epi::AFTER_DRAIN) { E.fused(acc, cur, wr, wc, fr, fq, lds, wid, lane); S.done(cur); }
#undef PG8_SA
#undef PG8_SB
#undef PG8_STAGE
#undef PG8_LDA
#undef PG8_LDB
#undef PG8_MMA
#undef PG8_MMAZ
#undef PG8_TRIP
#undef PG8_WAIT_V
#undef PG8_WAIT_VN
#undef PG8_WAIT_V8R
#undef PG8_WAIT_L
#undef PG8_BAR
#undef PG8_SCHED
}
}


constexpr int D = 1024, NBATCH = 2, SEQ = 16384, NTOK = NBATCH * SEQ, CTXL = 256, NCTX = NBATCH * CTXL, MROWS = NTOK + NCTX;
constexpr int NHEAD = 8, DK = 128, NE = 32, TOPK = 4, CONVW = 31, GRIDW = 64, GRIDR = SEQ / GRIDW;
constexpr int NWAVES = 8, NTHR = NWAVES * 64;
constexpr int MAXTILES = 544;
constexpr float EPS = 1e-6f;
enum { I_X = 0, I_C, I_CTX, I_CCTX, I_WADA, I_BADA, I_GMIX, I_GFFN, I_WHIN, I_HGAMMA, I_GHOUT, I_WHOUT, I_WCVIN, I_BCVIN, I_WCVDW, I_BCVDW, I_GCVLN, I_BCVLN, I_WCVOUT, I_BCVOUT,
       I_WR, I_BR, I_WE1, I_BE1, I_WE2, I_BE2, I_GFINAL, N_IN };

constexpr size_t MiB = 1u << 20;
constexpr size_t WS_CTL = 0, CTL_ZERO_BYTES = 1 * MiB;
constexpr size_t WS_MODS = 1 * MiB;
constexpr size_t WS_TOPE = 2 * MiB, WS_TOPW = 2 * MiB + 512 * 1024, WS_POS = 3 * MiB, WS_BCNT = 3 * MiB + 512 * 1024, WS_TILEE = WS_BCNT + 64 * 1024, WS_SLOTW = 4 * MiB;
constexpr size_t WS_SP = 5 * MiB, WS_SD = 8 * MiB;
constexpr size_t WS_WIN = 48 * MiB, WS_WOUT = 58 * MiB, WS_WCVIN = 60 * MiB, WS_WCVOUT = 64 * MiB, WS_W1 = 66 * MiB, WS_W2 = 322 * MiB;
constexpr size_t WS_X = 450 * MiB;
constexpr size_t WS_H = 578 * MiB;
constexpr size_t WS_Q = 644 * MiB, WS_V = 709 * MiB, WS_SG = 774 * MiB, WS_LFF = 839 * MiB, WS_LFB = 969 * MiB, WS_OF = 1099 * MiB, WS_OB = 1227 * MiB, WS_YIN = 1355 * MiB;
constexpr size_t WS_AS = 1419 * MiB, WS_ACT = 1555 * MiB, WS_YS = 1691 * MiB, WS_END = 1963 * MiB;
#ifndef F8_IN
#define F8_IN 0
#endif
#ifndef SPLIT_IN
#define SPLIT_IN 1
#endif
#ifndef TL_PROBE
#define TL_PROBE 0
#define TL_A (-1)
#define TL_B 0
#endif
#ifndef CVF_PROBE
#define CVF_PROBE 0
#endif
#ifndef G_F8
#define G_F8 1
#endif
#ifndef F8_Y
#define F8_Y 1
#endif
constexpr int YSCALE = 16;
#ifndef F8_MISC
#define F8_MISC 1
#endif
constexpr size_t WS_H8 = WS_OF + 64 * MiB;
constexpr size_t WS_WIN8 = WS_WIN + 6 * MiB;
constexpr size_t WS_STOK = WS_AS;
constexpr int CW_MODF = 3200;
constexpr int CW_FLAT = 3072;
constexpr int CW_GCNT = 2048;
constexpr float W8SCALE = 64.0f;
constexpr size_t WS_U = WS_Q, WS_ZP = WS_V, WS_Z = WS_SG;
constexpr int CW_BAR = 4096;
constexpr int CW_XMAP = 32768;
constexpr int CW_TCNT = 65536;

constexpr int RING_OFF = 0, RING_BYTES = 131072;
constexpr int LDSCTL_OFF = 139264, MISC_OFF = LDSCTL_OFF + 320, EXTRA_OFF = LDSCTL_OFF + 1024;
constexpr int LDS_BYTES = 155648;

#define LAS __attribute__((address_space(3)))
typedef unsigned short bf16;
typedef unsigned v4u __attribute__((ext_vector_type(4)));
typedef unsigned v2u __attribute__((ext_vector_type(2)));
typedef float f32x4 __attribute__((ext_vector_type(4)));
typedef int v4i __attribute__((ext_vector_type(4)));
#define LDS_WAIT() asm volatile("s_waitcnt lgkmcnt(0)" ::: "memory")
#define VM_WAIT() asm volatile("s_waitcnt vmcnt(0)" ::: "memory")
__device__ __forceinline__ unsigned f2bf(float f) { unsigned u = __builtin_bit_cast(unsigned, f); return (u + 0x7fffu + ((u >> 16) & 1u)) >> 16; }
__device__ __forceinline__ unsigned pk2(float lo, float hi) { return f2bf(lo) | (f2bf(hi) << 16); }
__device__ __forceinline__ float bf_lo(unsigned u) { return __builtin_bit_cast(float, u << 16); }
__device__ __forceinline__ float bf_hi(unsigned u) { return __builtin_bit_cast(float, u & 0xffff0000u); }
__device__ __forceinline__ float bf2f(bf16 h) { return __builtin_bit_cast(float, ((unsigned)h) << 16); }
__device__ __forceinline__ float fsig(float x) { return __builtin_amdgcn_rcpf(1.0f + __expf(-x)); }
__device__ __forceinline__ float wave_sum(float v) {
#define WS_DPP(x, ctrl) __builtin_bit_cast(float, __builtin_amdgcn_update_dpp(0, __builtin_bit_cast(int, x), ctrl, 0xF, 0xF, true))
    v += WS_DPP(v, 0xB1);
    v += WS_DPP(v, 0x4E);
    v += WS_DPP(v, 0x141);
    v += WS_DPP(v, 0x140);
#undef WS_DPP
    const int vi = __builtin_bit_cast(int, v);
    return (__builtin_bit_cast(float, __builtin_amdgcn_readlane(vi, 0)) + __builtin_bit_cast(float, __builtin_amdgcn_readlane(vi, 16)))
         + (__builtin_bit_cast(float, __builtin_amdgcn_readlane(vi, 32)) + __builtin_bit_cast(float, __builtin_amdgcn_readlane(vi, 48)));
}

__device__ __forceinline__ float half_sum(float v) {
#define WS_DPP(x, ctrl) __builtin_bit_cast(float, __builtin_amdgcn_update_dpp(0, __builtin_bit_cast(int, x), ctrl, 0xF, 0xF, true))
    v += WS_DPP(v, 0xB1); v += WS_DPP(v, 0x4E); v += WS_DPP(v, 0x141); v += WS_DPP(v, 0x140);
#undef WS_DPP
    return v + __shfl_xor(v, 16);
}
__device__ __forceinline__ float sat8(float x) { return __builtin_amdgcn_fmed3f(x, -448.0f, 448.0f); }
__device__ __forceinline__ unsigned pk4_fp8(float a, float b, float c, float d) { int w = 0; w = __builtin_amdgcn_cvt_pk_fp8_f32(sat8(a), sat8(b), w, false); w = __builtin_amdgcn_cvt_pk_fp8_f32(sat8(c), sat8(d), w, true); return (unsigned)w; }
template <bool OUT8> __device__ __forceinline__ void store_row4(void* orow, int lane, int j, f32x4 y, float scale) {
    if constexpr (OUT8) ((unsigned*)orow)[lane + 64 * j] = pk4_fp8(y.x * scale, y.y * scale, y.z * scale, y.w * scale);
    else { v2u w; w.x = pk2(y.x, y.y); w.y = pk2(y.z, y.w); ((v2u*)orow)[lane + 64 * j] = w; }
}

#define XB_TMO      128
#define XB_XCNT(j)  (256  + 64 * (j))
#define XB_XSUB(j)  (1280 + 64 * (j))
#define XB_XGEN(j)  (2304 + 64 * (j))
#define XB_TOP      3328
#define XB_TOPGEN   3392
#define XCD_BAR_WORDS 3456
#define XB_SPIN_CAP (1u << 18)

__device__ __forceinline__ unsigned xb_ld(unsigned* p)              { return __hip_atomic_load(p, __ATOMIC_RELAXED, __HIP_MEMORY_SCOPE_AGENT); }
__device__ __forceinline__ unsigned xb_add(unsigned* p, unsigned v) { return __hip_atomic_fetch_add(p, v, __ATOMIC_RELAXED, __HIP_MEMORY_SCOPE_AGENT); }
__device__ __forceinline__ unsigned xb_xcc_id() { return (unsigned)__builtin_amdgcn_s_getreg((3 << 11) | 20) & 0xFu; }
#define XB_SPIN(cond, bar) do { unsigned _sp = 0; while (cond) { __builtin_amdgcn_s_sleep(1); \
    if ((++_sp & 255u) == 0u) { if (xb_ld(&(bar)[XB_TMO])) break; if (_sp > XB_SPIN_CAP) { atomicAdd(&(bar)[XB_TMO], 1u); break; } } } } while (0)

struct XcdBarrier {
    unsigned* bar; unsigned x;
    volatile LAS unsigned* st;
};

__device__ __forceinline__ XcdBarrier xcd_barrier_post(unsigned* bar, volatile LAS unsigned* st) {
    XcdBarrier b; b.bar = bar; b.x = xb_xcc_id(); b.st = st;
    if (threadIdx.x == 0) (void)xb_add(&bar[XB_XCNT(b.x)], 1u);
    return b;
}
__device__ __forceinline__ void xcd_barrier_complete(unsigned* bar, unsigned x, unsigned& nloc, unsigned& nx) {
    const unsigned G = gridDim.x * gridDim.y * gridDim.z;
    unsigned sum, cnt, mine, sp = 0u;
    for (;;) {
        sum = 0u; cnt = 0u; mine = 0u;
#pragma unroll
        for (unsigned j = 0; j < 16; ++j) { const unsigned c = xb_ld(&bar[XB_XCNT(j)]); sum += c; cnt += (c > 0u) ? 1u : 0u; mine = (j == x) ? c : mine; }
        if (sum == G) break;
        __builtin_amdgcn_s_sleep(1);
        if ((++sp & 255u) == 0u) { if (xb_ld(&bar[XB_TMO])) break; if (sp > XB_SPIN_CAP) { atomicAdd(&bar[XB_TMO], 1u); break; } }
    }
    nloc = mine > 0u ? mine : 1u; nx = cnt > 0u ? cnt : 1u;
}

__device__ __forceinline__ void xcd_barrier(const XcdBarrier& b) {
    asm volatile("s_waitcnt vmcnt(0)" ::: "memory");
    __syncthreads();
    if (threadIdx.x == 0) {
        unsigned* bar = b.bar;
        __builtin_amdgcn_s_waitcnt(0);
        unsigned nloc = b.st[0], nx = b.st[1];
        if (nloc == 0u) { xcd_barrier_complete(bar, b.x, nloc, nx); b.st[0] = nloc; b.st[1] = nx; }
        const unsigned old = xb_add(&bar[XB_XSUB(b.x)], 1u);
        const unsigned gen = old / nloc;
        if (old + 1u == (gen + 1u) * nloc) {
            __builtin_amdgcn_fence(__ATOMIC_RELEASE, "agent");
            asm volatile("s_waitcnt vmcnt(0)" ::: "memory");
            const unsigned og = xb_add(&bar[XB_TOP], 1u);
            const unsigned tg = og / nx;
            if (og + 1u == (tg + 1u) * nx) xb_add(&bar[XB_TOPGEN], 1u);
            else XB_SPIN(xb_ld(&bar[XB_TOPGEN]) == tg, bar);
            __builtin_amdgcn_fence(__ATOMIC_ACQUIRE, "agent");
            xb_add(&bar[XB_XGEN(b.x)], 1u);
            asm volatile("s_waitcnt vmcnt(0)" ::: "memory");
        } else {
            XB_SPIN(xb_ld(&bar[XB_XGEN(b.x)]) == gen, bar);
            __builtin_amdgcn_fence(__ATOMIC_ACQUIRE, "agent");
            asm volatile("s_waitcnt vmcnt(0)" ::: "memory");
        }
    }
    __syncthreads();
}

struct Args { const float* in[N_IN]; float* out; unsigned char* ws; int ph_lo, ph_hi, li, pad; };

__device__ __forceinline__ void p_mods(const Args& a, LAS unsigned char* lds, int tid, int lane, int wave) {
    LAS float* sc = (LAS float*)lds;
    LAS float* part = sc + 3 * D;
    float* MODS = (float*)(a.ws + WS_MODS);
    for (int i = tid; i < 3 * D; i += NTHR) { const int r = i >> 10, k = i & 1023; const float v = r < 2 ? a.in[I_C][r * D + k] : a.in[I_CCTX][k]; sc[i] = v * fsig(v); }
    __syncthreads();
    for (int item = blockIdx.x; item < 2 * 96; item += gridDim.x) {
        const int l = item / 96, cb = item % 96;
        const float* W = a.in[I_WADA] + (size_t)l * D * 6 * D + cb * 64 + lane;
        float a0 = 0.f, a1 = 0.f, a2 = 0.f;
#pragma unroll 16
        for (int kk = 0; kk < 128; ++kk) { const int k = wave * 128 + kk; const float w = W[(size_t)k * (6 * D)]; a0 += sc[k] * w; a1 += sc[D + k] * w; a2 += sc[2 * D + k] * w; }
        part[(wave * 3 + 0) * 64 + lane] = a0; part[(wave * 3 + 1) * 64 + lane] = a1; part[(wave * 3 + 2) * 64 + lane] = a2;
        __syncthreads();
        if (tid < 192) { const int r = tid >> 6, ln = tid & 63; float s = 0.f;
#pragma unroll
            for (int w = 0; w < 8; ++w) s += part[(w * 3 + r) * 64 + ln];
            __hip_atomic_store(&MODS[(size_t)(l * 3 + r) * (6 * D) + cb * 64 + ln], s + a.in[I_BADA][l * 6 * D + cb * 64 + ln], __ATOMIC_RELAXED, __HIP_MEMORY_SCOPE_AGENT); }
        asm volatile("s_waitcnt vmcnt(0)" ::: "memory");
        __syncthreads();
        if (item < 32 && tid == 0) (void)__hip_atomic_fetch_add((unsigned*)(a.ws + WS_CTL) + CW_MODF, 1u, __ATOMIC_RELAXED, __HIP_MEMORY_SCOPE_AGENT);
    }
}
__device__ __forceinline__ void wait_mods0(const Args& a, int tid) {
    if (tid == 0) { unsigned* f = (unsigned*)(a.ws + WS_CTL) + CW_MODF; unsigned sp = 0;
        while (__hip_atomic_load(f, __ATOMIC_RELAXED, __HIP_MEMORY_SCOPE_AGENT) < 32u) { __builtin_amdgcn_s_sleep(2); if (++sp > (1u << 22)) break; }
        __builtin_amdgcn_fence(__ATOMIC_ACQUIRE, "agent");
        asm volatile("s_waitcnt vmcnt(0)" ::: "memory"); }
    __syncthreads();
}
template <bool OUT8> __device__ __forceinline__ void transpose_item(const float* W, int K, int N, bf16* WT, bool paired, LAS float* scr, int item, int lane, int row_adj = 0) {
    const int nblk = N / 32, kb = item / nblk, nb = item % nblk, k0 = 64 * kb, n0 = 32 * nb;
    int d0 = n0 + row_adj; if (paired) { const int half = n0 >> 10, c = n0 & 1023; d0 = (c >> 7) * 256 + half * 128 + (c & 127); }
    float t[32];
#pragma unroll
    for (int i = 0; i < 32; ++i) { const int kk = 2 * i + (lane >> 5); t[i] = __builtin_nontemporal_load(&W[(size_t)(k0 + kk) * N + n0 + (lane & 31)]); }
#pragma unroll
    for (int i = 0; i < 32; ++i) { const int kk = 2 * i + (lane >> 5); scr[kk * 33 + (lane & 31)] = t[i]; }
    LDS_WAIT(); asm volatile("" ::: "memory");
    const int c = lane & 7;
#pragma unroll
    for (int j = 0; j < 4; ++j) { const int n = (lane >> 3) + 8 * j; const LAS float* s = scr + (8 * c) * 33 + n;
        if constexpr (OUT8) {
            int w0 = 0, w1 = 0;
            w0 = __builtin_amdgcn_cvt_pk_fp8_f32(s[0 * 33] * W8SCALE, s[1 * 33] * W8SCALE, w0, false); w0 = __builtin_amdgcn_cvt_pk_fp8_f32(s[2 * 33] * W8SCALE, s[3 * 33] * W8SCALE, w0, true);
            w1 = __builtin_amdgcn_cvt_pk_fp8_f32(s[4 * 33] * W8SCALE, s[5 * 33] * W8SCALE, w1, false); w1 = __builtin_amdgcn_cvt_pk_fp8_f32(s[6 * 33] * W8SCALE, s[7 * 33] * W8SCALE, w1, true);
            *(v2u*)((unsigned char*)WT + (size_t)(d0 + n) * K + k0 + 8 * c) = (v2u){(unsigned)w0, (unsigned)w1};
        } else {
        v4u o; o.x = pk2(s[0 * 33], s[1 * 33]); o.y = pk2(s[2 * 33], s[3 * 33]); o.z = pk2(s[4 * 33], s[5 * 33]); o.w = pk2(s[6 * 33], s[7 * 33]);
        *(v4u*)(WT + (size_t)(d0 + n) * K + k0 + 8 * c) = o; } }
    LDS_WAIT(); asm volatile("" ::: "memory");
}
__device__ __forceinline__ void p_weights(const Args& a, LAS unsigned char* lds, int lane, int wave) {
    LAS float* scr = (LAS float*)(lds + RING_OFF + wave * 16384);
    const int gw = blockIdx.x * NWAVES + wave, NGW = gridDim.x * NWAVES;
    constexpr int I_IN = 16 * 160, I_SQ = 16 * 32, I_CV = 16 * 64, I_E1 = 64 * 1024, I_E2 = 64 * 512;
    constexpr int NITEMS = I_IN + I_SQ + I_CV + I_SQ + I_E1 + I_E2;
    unsigned char* ws = a.ws;
    const bool g256 = gridDim.x == 256, dbl = g256 && blockIdx.x >= 192;
    const int base = g256 ? I_E1 + I_E2 : 0, NV = g256 ? 2560 : NGW, vw = !g256 ? gw : (dbl ? 1536 + ((int)blockIdx.x - 192) * 16 + wave * 2 : gw);
    for (int n = 0;; ++n) {
        const int it = base + (dbl ? vw + (n & 1) + (n >> 1) * NV : vw + n * NV);
        if (it >= NITEMS) break;
        int r = it;
        if (r < I_E1) { const int mi = r >> 10; transpose_item<true>(a.in[I_WE1] + (size_t)mi * D * 2 * D, D, 2 * D, (bf16*)(ws + WS_W1 + (size_t)mi * 2 * D * D), true, scr, r & 1023, lane); continue; } r -= I_E1;
        if (r < I_E2) { const int mi = r >> 9; transpose_item<true>(a.in[I_WE2] + (size_t)mi * D * D, D, D, (bf16*)(ws + WS_W2 + (size_t)mi * D * D), false, scr, r & 511, lane); continue; } r -= I_E2;
        if (r < I_IN) {
            if (SPLIT_IN) { const int sgm = ((r % 160) * 32) >> 10;
                if (sgm == 2 || sgm == 3 || (G_F8 && sgm == 4)) transpose_item<true>(a.in[I_WHIN], D, 5 * D, (bf16*)(ws + WS_WIN8), false, scr, r, lane, -2 * D);
                else transpose_item<false>(a.in[I_WHIN], D, 5 * D, (bf16*)(ws + WS_WIN), false, scr, r, lane, sgm == 4 ? -2 * D : 0);
            } else transpose_item<F8_IN != 0>(a.in[I_WHIN], D, 5 * D, (bf16*)(ws + WS_WIN), false, scr, r, lane);
            continue; } r -= I_IN;
        if (r < I_SQ) { transpose_item<F8_MISC != 0>(a.in[I_WHOUT], D, D, (bf16*)(ws + WS_WOUT), false, scr, r, lane); continue; } r -= I_SQ;
        if (r < I_CV) { transpose_item<F8_MISC != 0>(a.in[I_WCVIN], D, 2 * D, (bf16*)(ws + WS_WCVIN), true, scr, r, lane); continue; } r -= I_CV;
        transpose_item<F8_MISC != 0>(a.in[I_WCVOUT], D, D, (bf16*)(ws + WS_WCVOUT), false, scr, r, lane);
    }
}
constexpr int CV_WAVES = 7, CV_L0 = 32 * 512 + 32 * 256, CV_ALL = 2 * CV_L0;
__device__ __forceinline__ void transpose_item64(const float* W, int K, int N, unsigned char* WT, bool paired, LAS float* scr, int item, int lane) {
    const int nblk = N / 64, kb = item / nblk, nb = item % nblk, k0 = 64 * kb, n0 = 64 * nb;
    int d0 = n0; if (paired) { const int half = n0 >> 10, c = n0 & 1023; d0 = (c >> 7) * 256 + half * 128 + (c & 127); }
    float t[64];
#pragma unroll
    for (int i = 0; i < 64; ++i) t[i] = __builtin_nontemporal_load(&W[(size_t)(k0 + i) * N + n0 + lane]);
#pragma unroll
    for (int i = 0; i < 64; ++i) scr[i * 65 + lane] = t[i];
    LDS_WAIT(); asm volatile("" ::: "memory");
    const int c = lane & 3;
#pragma unroll
    for (int j = 0; j < 4; ++j) { const int n = (lane >> 2) + 16 * j; const LAS float* s = scr + (16 * c) * 65 + n;
        v4u o;
        o.x = pk4_fp8(s[0 * 65] * W8SCALE, s[1 * 65] * W8SCALE, s[2 * 65] * W8SCALE, s[3 * 65] * W8SCALE); o.y = pk4_fp8(s[4 * 65] * W8SCALE, s[5 * 65] * W8SCALE, s[6 * 65] * W8SCALE, s[7 * 65] * W8SCALE);
        o.z = pk4_fp8(s[8 * 65] * W8SCALE, s[9 * 65] * W8SCALE, s[10 * 65] * W8SCALE, s[11 * 65] * W8SCALE); o.w = pk4_fp8(s[12 * 65] * W8SCALE, s[13 * 65] * W8SCALE, s[14 * 65] * W8SCALE, s[15 * 65] * W8SCALE);
        *(v4u*)(WT + (size_t)(d0 + n) * K + k0 + 16 * c) = o; }
    LDS_WAIT(); asm volatile("" ::: "memory");
}
__device__ __forceinline__ void cv_do_item(const Args& a, LAS float* scr, int g, int lane) {
    const int l = g >= CV_L0 ? 1 : 0; const int r = g - l * CV_L0;
    if (r < 32 * 512) { const int mi = l * 32 + (r >> 9); transpose_item64(a.in[I_WE1] + (size_t)mi * D * 2 * D, D, 2 * D, a.ws + WS_W1 + (size_t)mi * 2 * D * D, true, scr, r & 511, lane); }
    else { const int r2 = r - 32 * 512; const int mi = l * 32 + (r2 >> 8); transpose_item64(a.in[I_WE2] + (size_t)mi * D * D, D, D, a.ws + WS_W2 + (size_t)mi * D * D, false, scr, r2 & 255, lane); }
}
__device__ __forceinline__ void cv_finish(const Args& a, LAS unsigned char* lds, int wave, int lane, int& cv_n, int limit) {
    if (gridDim.x == 256 && wave >= 1 && wave <= CV_WAVES) {
        const int ww = blockIdx.x * CV_WAVES + (wave - 1), NW = 256 * CV_WAVES; LAS float* scr = (LAS float*)(lds + RING_OFF + wave * 16640);
#if CVF_PROBE
        const unsigned long long t0_ = __builtin_amdgcn_s_memrealtime();
#endif
        for (;;) { const int g = cv_n * NW + ww; if (g >= limit) break; cv_do_item(a, scr, g, lane); ++cv_n; }
#if CVF_PROBE
        if (blockIdx.x == 0 && wave == 1 && lane == 0) { asm volatile("s_waitcnt vmcnt(0)" ::: "memory"); ((volatile LAS unsigned*)(lds + MISC_OFF))[40] += (unsigned)(__builtin_amdgcn_s_memrealtime() - t0_); }
#endif
    }
}
__device__ __forceinline__ void xcd_barrier_work(const XcdBarrier& b, const Args& a, LAS unsigned char* lds, int wave, int lane, int& cv_n, volatile LAS unsigned* flag, unsigned seq) {
    asm volatile("s_waitcnt vmcnt(0)" ::: "memory");
    __syncthreads();
    if (wave == 0) {
        if (threadIdx.x == 0) {
            unsigned* bar = b.bar;
            __builtin_amdgcn_s_waitcnt(0);
            unsigned nloc = b.st[0], nx = b.st[1];
            if (nloc == 0u) { xcd_barrier_complete(bar, b.x, nloc, nx); b.st[0] = nloc; b.st[1] = nx; }
            const unsigned old = xb_add(&bar[XB_XSUB(b.x)], 1u);
            const unsigned gen = old / nloc;
            if (old + 1u == (gen + 1u) * nloc) {
                __builtin_amdgcn_fence(__ATOMIC_RELEASE, "agent");
                asm volatile("s_waitcnt vmcnt(0)" ::: "memory");
                const unsigned og = xb_add(&bar[XB_TOP], 1u);
                const unsigned tg = og / nx;
                if (og + 1u == (tg + 1u) * nx) xb_add(&bar[XB_TOPGEN], 1u);
                else XB_SPIN(xb_ld(&bar[XB_TOPGEN]) == tg, bar);
                __builtin_amdgcn_fence(__ATOMIC_ACQUIRE, "agent");
                xb_add(&bar[XB_XGEN(b.x)], 1u);
                asm volatile("s_waitcnt vmcnt(0)" ::: "memory");
            } else {
                XB_SPIN(xb_ld(&bar[XB_XGEN(b.x)]) == gen, bar);
                __builtin_amdgcn_fence(__ATOMIC_ACQUIRE, "agent");
                asm volatile("s_waitcnt vmcnt(0)" ::: "memory");
            }
            flag[0] = seq;
        }
    } else if (gridDim.x == 256 && wave <= CV_WAVES) {
        const int ww = blockIdx.x * CV_WAVES + (wave - 1), NW = 256 * CV_WAVES; LAS float* scr = (LAS float*)(lds + RING_OFF + wave * 16640);
        for (;;) { const int g = cv_n * NW + ww; if (g >= CV_ALL) break; if (flag[0] == seq) break; cv_do_item(a, scr, g, lane); ++cv_n; }
        asm volatile("s_waitcnt vmcnt(0)" ::: "memory");
    }
    __syncthreads();
}
__device__ __forceinline__ void flat_barrier_work(unsigned* cnt, const Args& a, LAS unsigned char* lds, int wave, int lane, int& cv_n, volatile LAS unsigned* flag, unsigned seq) {
    asm volatile("s_waitcnt vmcnt(0)" ::: "memory");
    __syncthreads();
    if (wave == 0) {
        if (threadIdx.x == 0) {
            __builtin_amdgcn_s_waitcnt(0);
            __builtin_amdgcn_fence(__ATOMIC_RELEASE, "agent");
            asm volatile("s_waitcnt vmcnt(0)" ::: "memory");
            (void)__hip_atomic_fetch_add(cnt, 1u, __ATOMIC_RELAXED, __HIP_MEMORY_SCOPE_AGENT);
            const unsigned target = gridDim.x * seq; unsigned sp = 0;
            while (__hip_atomic_load(cnt, __ATOMIC_RELAXED, __HIP_MEMORY_SCOPE_AGENT) < target) { __builtin_amdgcn_s_sleep(1); if (++sp > (1u << 22)) break; }
            __builtin_amdgcn_fence(__ATOMIC_ACQUIRE, "agent");
            asm volatile("s_waitcnt vmcnt(0)" ::: "memory");
            flag[0] = seq;
        }
    } else if (gridDim.x == 256 && wave <= CV_WAVES) {
        const int ww = blockIdx.x * CV_WAVES + (wave - 1), NW = 256 * CV_WAVES; LAS float* scr = (LAS float*)(lds + RING_OFF + wave * 16640);
        for (;;) { const int g = cv_n * NW + ww; if (g >= CV_ALL) break; if (flag[0] == seq) break; cv_do_item(a, scr, g, lane); ++cv_n; }
        asm volatile("s_waitcnt vmcnt(0)" ::: "memory");
    }
    __syncthreads();
}
template <bool OUT8> __device__ __forceinline__ void norm_mod_store(f32x4 (&v)[4], const float* g, const float* sc, const float* sh, void* orow, int lane) {
    float s = 0.f;
#pragma unroll
    for (int j = 0; j < 4; ++j) s += (v[j].x * v[j].x + v[j].y * v[j].y) + (v[j].z * v[j].z + v[j].w * v[j].w);
    const float r = 1.0f / sqrtf(wave_sum(s) * (1.0f / D) + EPS);
#pragma unroll
    for (int j = 0; j < 4; ++j) { const f32x4 gg = ((const f32x4*)g)[lane + 64 * j], ss = ((const f32x4*)sc)[lane + 64 * j], hh = ((const f32x4*)sh)[lane + 64 * j];
        const f32x4 y = (v[j] * r * gg) * (ss + 1.0f) + hh; v[j] = y;
        store_row4<OUT8>(orow, lane, j, y, 1.0f); }
}
__device__ __forceinline__ void p_norm0(const Args& a, int lane, int gw, int NGW, int m_begin, int m_end) {
    const float* MODS = (const float*)(a.ws + WS_MODS); bf16* H = (bf16*)(a.ws + WS_H);
    for (int m0 = m_begin + gw * 2; m0 < m_end; m0 += NGW * 2) {
        f32x4 v[2][4]; int rr[2];
#pragma unroll
        for (int r = 0; r < 2; ++r) { const int m = m0 + r; const float* xr;
            if (m < NTOK) { xr = a.in[I_X] + (size_t)m * D; rr[r] = m / SEQ; } else { xr = a.in[I_CTX] + (size_t)(m - NTOK) * D; rr[r] = 2; }
#pragma unroll
            for (int j = 0; j < 4; ++j) v[r][j] = __builtin_nontemporal_load(&((const f32x4*)xr)[lane + 64 * j]); }
#pragma unroll
        for (int r = 0; r < 2; ++r) { const float* md = MODS + (size_t)rr[r] * 6 * D;
            norm_mod_store<F8_IN != 0>(v[r], a.in[I_GMIX], md + 1 * D, md + 0 * D, (unsigned char*)H + (size_t)(m0 + r) * D * (F8_IN ? 1 : 2), lane);
            if (SPLIT_IN) {
#pragma unroll
                for (int j = 0; j < 4; ++j) store_row4<true>(a.ws + WS_H8 + (size_t)(m0 + r) * D, lane, j, v[r][j], 1.0f); } }
    }
}
__device__ __forceinline__ void p_scan_naive(const Args& a, LAS unsigned char* lds, int tid) {
    LAS float* sf = (LAS float*)lds;
    LAS float* sq = sf + 64 * 128;
    LAS float* sv = sq + 64 * 128;
    LAS float* so = sv + 64 * 16;
    const bf16* Q = (const bf16*)(a.ws + WS_Q); const bf16* V = (const bf16*)(a.ws + WS_V);
    const int vl = tid >> 5, kq = tid & 31;
    for (int unit = blockIdx.x; unit < 256; unit += gridDim.x) {
        const int chain = unit >> 3, vb = unit & 7, b = chain >> 4, h = (chain >> 1) & 7, dir = chain & 1;
        const float* LF = (const float*)(a.ws + (dir ? WS_LFB : WS_LFF)); float* O = (float*)(a.ws + (dir ? WS_OB : WS_OF));
        float S0 = 0.f, S1 = 0.f, S2 = 0.f, S3 = 0.f;
        for (int blk = 0; blk < 260; ++blk) {
            const bool isctx = blk < 4; int base, step;
            if (!dir) { base = isctx ? (NTOK + b * CTXL + blk * 64) : (b * SEQ + (blk - 4) * 64); step = 1; }
            else { base = isctx ? (NTOK + b * CTXL + CTXL - 1 - blk * 64) : (b * SEQ + SEQ - 1 - (blk - 4) * 64); step = -1; }
            for (int e = tid; e < 64 * 128; e += NTHR) { const int i = e >> 7, k = e & 127; const size_t off = (size_t)(base + step * i) * D + h * DK + k; sf[e] = __expf(LF[off]); sq[e] = bf2f(Q[off]); }
            for (int e = tid; e < 64 * 16; e += NTHR) { const int i = e >> 4, vv = e & 15; sv[e] = bf2f(V[(size_t)(base + step * i) * D + h * DK + vb * 16 + vv]); }
            __syncthreads();
            for (int i = 0; i < 64; ++i) {
                const f32x4 f = *(const LAS f32x4*)(sf + i * 128 + kq * 4), q = *(const LAS f32x4*)(sq + i * 128 + kq * 4); const float vv = sv[i * 16 + vl];
                S0 = f.x * S0 + (1.0f - f.x) * vv; S1 = f.y * S1 + (1.0f - f.y) * vv; S2 = f.z * S2 + (1.0f - f.z) * vv; S3 = f.w * S3 + (1.0f - f.w) * vv;
                float p = (S0 * q.x + S1 * q.y) + (S2 * q.z + S3 * q.w);
                p += __shfl_xor(p, 1); p += __shfl_xor(p, 2); p += __shfl_xor(p, 4); p += __shfl_xor(p, 8); p += __shfl_xor(p, 16);
                if (kq == 0) so[i * 16 + vl] = p;
            }
            __syncthreads();
            if (!isctx) for (int e = tid; e < 64 * 16; e += NTHR) { const int i = e >> 4, vv = e & 15; O[(size_t)(base + step * i) * D + h * DK + vb * 16 + vv] = so[e]; }
            __syncthreads();
        }
    }
}
constexpr int SC_QT = 0, SC_KU = 4352, SC_KB = 8704, SC_VT = 12800, SC_ET = 16896, SC_SUB = 17408, SC_BUF = 4 * SC_SUB;
constexpr int NSLOT = 17;
typedef short s16x4 __attribute__((ext_vector_type(4)));
typedef short s16x8 __attribute__((ext_vector_type(8)));
struct ScanUnit { int h, rowbase, sgn, nchunks, chain, slot; };
__device__ __forceinline__ ScanUnit scan_unit(int b, int h, int dir, int slot) {
    ScanUnit u; u.h = h; u.sgn = dir ? -1 : 1; u.chain = (b * NHEAD + h) * 2 + dir; u.slot = slot;
    if (slot == 0) { u.rowbase = NTOK + b * CTXL + (dir ? CTXL - 1 : 0); u.nchunks = CTXL / 64; }
    else { const int so = (slot - 1) * 1024; u.rowbase = b * SEQ + (dir ? SEQ - 1 - so : so); u.nchunks = 16; }
    return u;
}
typedef float f32x2_t __attribute__((ext_vector_type(2)));
typedef __bf16 bf16x2_t __attribute__((ext_vector_type(2)));
__device__ __forceinline__ unsigned cvtpk(float lo, float hi) { const f32x2_t f = {lo, hi}; return __builtin_bit_cast(unsigned, __builtin_convertvector(f, bf16x2_t)); }
template <bool FULL> __device__ __forceinline__ void scan_load(const ScanUnit& u, int pos0, const bf16* LF, const bf16* Q, const bf16* V, int k, int i, unsigned (&lf)[16], unsigned (&qr)[16], unsigned (&vr)[16]) {
#pragma unroll
    for (int t = 0; t < 16; ++t) {
        const unsigned o = (unsigned)(u.rowbase + u.sgn * (pos0 + 16 * i + t)) * D + u.h * DK + k;
        lf[t] = LF[o]; vr[t] = V[o]; if (FULL) qr[t] = Q[o];
    }
}
template <bool FULL> __device__ __forceinline__ float scan_prep(LAS unsigned char* buf, int k, int i, const unsigned (&lfr)[16], const unsigned (&qr)[16], const unsigned (&vr)[16]) {
    LAS unsigned char* sb = buf + i * SC_SUB;
    float f[16], pre[16], suf[16]; float T = 0.f;
#pragma unroll
    for (int t = 0; t < 16; ++t) { const float lf = (float)__builtin_bit_cast(_Float16, (unsigned short)lfr[t]); T += lf; f[t] = __builtin_amdgcn_exp2f(lf * 1.4426950408889634f); }
    pre[0] = f[0];
#pragma unroll
    for (int t = 1; t < 16; ++t) pre[t] = pre[t - 1] * f[t];
    suf[15] = 1.0f;
#pragma unroll
    for (int t = 14; t >= 0; --t) suf[t] = suf[t + 1] * f[t + 1];
    unsigned kbw[8], vtw[8];
#pragma unroll
    for (int t = 0; t < 16; t += 2) {
        const float kk0 = 1.0f - f[t], kk1 = 1.0f - f[t + 1];
        kbw[t >> 1] = cvtpk(kk0 * suf[t], kk1 * suf[t + 1]);
        vtw[t >> 1] = vr[t] | (vr[t + 1] << 16);
        if (FULL) {
            const unsigned qq = cvtpk(__builtin_bit_cast(float, qr[t] << 16) * pre[t], __builtin_bit_cast(float, qr[t + 1] << 16) * pre[t + 1]);
            const unsigned ku = cvtpk(kk0 * __builtin_amdgcn_rcpf(fmaxf(pre[t], 1e-30f)), kk1 * __builtin_amdgcn_rcpf(fmaxf(pre[t + 1], 1e-30f)));
            *(LAS bf16*)(sb + SC_QT + t * 272 + 2 * k) = (bf16)(qq & 0xffffu); *(LAS bf16*)(sb + SC_QT + (t + 1) * 272 + 2 * k) = (bf16)(qq >> 16);
            *(LAS bf16*)(sb + SC_KU + t * 272 + 2 * k) = (bf16)(ku & 0xffffu); *(LAS bf16*)(sb + SC_KU + (t + 1) * 272 + 2 * k) = (bf16)(ku >> 16);
        }
    }
    *(LAS v4u*)(sb + SC_KB + k * 32) = (v4u){kbw[0], kbw[1], kbw[2], kbw[3]}; *(LAS v4u*)(sb + SC_KB + k * 32 + 16) = (v4u){kbw[4], kbw[5], kbw[6], kbw[7]};
    *(LAS v4u*)(sb + SC_VT + k * 32) = (v4u){vtw[0], vtw[1], vtw[2], vtw[3]}; *(LAS v4u*)(sb + SC_VT + k * 32 + 16) = (v4u){vtw[4], vtw[5], vtw[6], vtw[7]};
    *(LAS float*)(sb + SC_ET + 4 * k) = pre[15];
    return T;
}
__device__ __forceinline__ f32x4 mfma_k16(s16x4 a, s16x4 b, f32x4 c) {
    const v2u av = __builtin_bit_cast(v2u, a), bv = __builtin_bit_cast(v2u, b);
    return __builtin_amdgcn_mfma_f32_16x16x32_bf16(__builtin_bit_cast(s16x8, (v4u){av.x, av.y, 0u, 0u}), __builtin_bit_cast(s16x8, (v4u){bv.x, bv.y, 0u, 0u}), c, 0, 0, 0);
}
template <bool FULL> __device__ __forceinline__ void scan_compute2(const LAS unsigned char* buf, int wq, int lane, f32x4 (&S)[2][8], bf16* Ocol, const ScanUnit& u, int pos0) {
    const int fr = lane & 15, g = lane >> 4;
#pragma unroll 1
    for (int i = 0; i < 2; ++i) {
        const LAS unsigned char* sb = buf + i * SC_SUB;
        const s16x4 vt0 = *(const LAS s16x4*)(sb + SC_VT + (32 * wq + fr) * 32 + 8 * g), vt1 = *(const LAS s16x4*)(sb + SC_VT + (32 * wq + 16 + fr) * 32 + 8 * g);
        s16x8 ka[4], qa[4]; f32x4 et[8]; s16x4 kb[8];
        if (FULL) {
#pragma unroll
            for (int c = 0; c < 4; ++c) { ka[c] = *(const LAS s16x8*)(sb + SC_KU + fr * 272 + (32 * c + 8 * g) * 2); qa[c] = *(const LAS s16x8*)(sb + SC_QT + fr * 272 + (32 * c + 8 * g) * 2); }
        }
#pragma unroll
        for (int j = 0; j < 8; ++j) { et[j] = *(const LAS f32x4*)(sb + SC_ET + (32 * (j >> 1) + 8 * g + 4 * (j & 1)) * 4); kb[j] = *(const LAS s16x4*)(sb + SC_KB + (32 * (j >> 1) + 8 * (fr >> 2) + 4 * (j & 1) + (fr & 3)) * 32 + 8 * g); }
        __builtin_amdgcn_sched_barrier(0);
        if (FULL) {
            f32x4 aT = (f32x4){0.f, 0.f, 0.f, 0.f};
#pragma unroll
            for (int c = 0; c < 4; ++c) aT = __builtin_amdgcn_mfma_f32_16x16x32_bf16(ka[c], qa[c], aT, 0, 0, 0);
#pragma unroll
            for (int r = 0; r < 4; ++r) if (4 * g + r > fr) aT[r] = 0.f;
            const s16x4 ab = __builtin_bit_cast(s16x4, (v2u){cvtpk(aT[0], aT[1]), cvtpk(aT[2], aT[3])});
            f32x4 o0 = mfma_k16(vt0, ab, (f32x4){0.f, 0.f, 0.f, 0.f}), o1 = mfma_k16(vt1, ab, (f32x4){0.f, 0.f, 0.f, 0.f});
#pragma unroll
            for (int c = 0; c < 4; ++c) {
                const v4u s0 = (v4u){cvtpk(S[0][2 * c][0], S[0][2 * c][1]), cvtpk(S[0][2 * c][2], S[0][2 * c][3]), cvtpk(S[0][2 * c + 1][0], S[0][2 * c + 1][1]), cvtpk(S[0][2 * c + 1][2], S[0][2 * c + 1][3])};
                const v4u s1 = (v4u){cvtpk(S[1][2 * c][0], S[1][2 * c][1]), cvtpk(S[1][2 * c][2], S[1][2 * c][3]), cvtpk(S[1][2 * c + 1][0], S[1][2 * c + 1][1]), cvtpk(S[1][2 * c + 1][2], S[1][2 * c + 1][3])};
                o0 = __builtin_amdgcn_mfma_f32_16x16x32_bf16(__builtin_bit_cast(s16x8, s0), qa[c], o0, 0, 0, 0);
                o1 = __builtin_amdgcn_mfma_f32_16x16x32_bf16(__builtin_bit_cast(s16x8, s1), qa[c], o1, 0, 0, 0);
            }
            bf16* orow = Ocol + (size_t)(u.rowbase + u.sgn * (pos0 + 16 * i + fr)) * D;
            *(v2u*)orow = (v2u){cvtpk(o0[0], o0[1]), cvtpk(o0[2], o0[3])}; *(v2u*)(orow + 16) = (v2u){cvtpk(o1[0], o1[1]), cvtpk(o1[2], o1[3])};
        }
#pragma unroll
        for (int j = 0; j < 8; ++j) { S[0][j] = mfma_k16(kb[j], vt0, S[0][j] * et[j]); S[1][j] = mfma_k16(kb[j], vt1, S[1][j] * et[j]); }
    }
}
template <bool FULL> __device__ __forceinline__ void scan_pair(const Args& a, LAS unsigned char* lds, const ScanUnit& uA, const ScanUnit& uB, int tid, int lane, int wave) {
    const int grp = wave >> 2, wq = wave & 3, t = tid & 255, k = t & 127, i0 = t >> 7;
    ScanUnit u; u.h = grp ? uB.h : uA.h; u.rowbase = grp ? uB.rowbase : uA.rowbase; u.sgn = grp ? uB.sgn : uA.sgn; u.nchunks = grp ? uB.nchunks : uA.nchunks; u.chain = grp ? uB.chain : uA.chain; u.slot = grp ? uB.slot : uA.slot;
    LAS unsigned char* buf = lds + grp * SC_BUF;
    const int dir = u.sgn < 0;
    const bf16* LF = (const bf16*)(a.ws + (dir ? WS_LFB : WS_LFF)); const bf16* Q = (const bf16*)(a.ws + WS_Q); const bf16* V = (const bf16*)(a.ws + WS_V);
    f32x4* SD = (f32x4*)(a.ws + WS_SD) + (size_t)u.chain * NSLOT * 4096; float* SP = (float*)(a.ws + WS_SP) + (size_t)u.chain * NSLOT * DK;
    const int g = lane >> 4;
    bf16* Ocol = (bf16*)(a.ws + (dir ? WS_OB : WS_OF)) + u.h * DK + 32 * wq + 4 * g;
    f32x4 S[2][8];
#pragma unroll
    for (int vb = 0; vb < 2; ++vb)
#pragma unroll
        for (int j = 0; j < 8; ++j) S[vb][j] = (f32x4){0.f, 0.f, 0.f, 0.f};
    if (FULL) {
        for (int s = 0; s < u.slot; ++s) {
            const f32x4* d = SD + (size_t)s * 4096 + (wq * 16) * 64 + lane; const float* pp = SP + s * DK + 8 * g;
#pragma unroll
            for (int j = 0; j < 8; ++j) { const f32x4 pv = *(const f32x4*)(pp + 32 * (j >> 1) + 4 * (j & 1)); const f32x4 ev = (f32x4){__expf(pv.x), __expf(pv.y), __expf(pv.z), __expf(pv.w)};
                S[0][j] = S[0][j] * ev + d[j * 64]; S[1][j] = S[1][j] * ev + d[(8 + j) * 64]; }
        }
    }
    unsigned lf[16], q[16], v[16]; float psum = 0.f;
    const int nsteps = u.nchunks * 2;
    scan_load<FULL>(u, 0, LF, Q, V, k, i0, lf, q, v);
    constexpr int NST = 32;
    if (grp == 1) __syncthreads();
    for (int c = 0; c < NST; ++c) {
        if (c < nsteps) psum += scan_prep<FULL>(buf, k, i0, lf, q, v);
        __syncthreads();
        if (c < nsteps) {
            const int cn = (c + 1 < nsteps) ? c + 1 : c;
            scan_load<FULL>(u, cn * 32, LF, Q, V, k, i0, lf, q, v);
            scan_compute2<FULL>(buf, wq, lane, S, Ocol, u, c * 32);
        }
        __syncthreads();
    }
    if (grp == 0) __syncthreads();
    if (!FULL) {
        f32x4* d = SD + (size_t)u.slot * 4096 + (wq * 16) * 64 + lane;
#pragma unroll
        for (int j = 0; j < 8; ++j) { d[j * 64] = S[0][j]; d[(8 + j) * 64] = S[1][j]; }
        LAS float* ps = (LAS float*)(lds + EXTRA_OFF + 2560);
        ps[(grp * 2 + i0) * 128 + k] = psum;
        __syncthreads();
        if (t < 128) SP[u.slot * DK + t] = ps[(grp * 2) * 128 + t] + ps[(grp * 2 + 1) * 128 + t];
        __syncthreads();
    }
}
__device__ __forceinline__ void p_scan_a(const Args& a, LAS unsigned char* lds, int tid, int lane, int wave) {
    for (int it = blockIdx.x; it < 256; it += gridDim.x) {
        const int b = it >> 7, h = (it >> 4) & 7, seg = it & 15;
        const ScanUnit uA = scan_unit(b, h, 0, seg == 15 ? 0 : 1 + seg);
        const ScanUnit uB = scan_unit(b, h, 1, seg == 0 ? 0 : 16 - seg);
        scan_pair<false>(a, lds, uA, uB, tid, lane, wave);
    }
}
__device__ __forceinline__ void p_scan_c(const Args& a, LAS unsigned char* lds, int tid, int lane, int wave) {
    for (int it = blockIdx.x; it < 256; it += gridDim.x) {
        const int b = it >> 7, h = (it >> 4) & 7, seg = it & 15;
        const ScanUnit uA = scan_unit(b, h, 0, 1 + seg), uB = scan_unit(b, h, 1, 16 - seg);
        scan_pair<true>(a, lds, uA, uB, tid, lane, wave);
    }
}
__device__ __forceinline__ void p_readout(const Args& a, int lane, int wave) {
    const int gw = blockIdx.x * NWAVES + wave, NGW = gridDim.x * NWAVES;
    const bf16* OF = (const bf16*)(a.ws + WS_OF); const bf16* OB = (const bf16*)(a.ws + WS_OB); const bf16* SG = (const bf16*)(a.ws + WS_SG); bf16* Y = (bf16*)(a.ws + WS_YIN);
    f32x4 gh[4];
#pragma unroll
    for (int j = 0; j < 4; ++j) gh[j] = ((const f32x4*)a.in[I_GHOUT])[lane + 64 * j];
    v2u ra[2][4], rb[2][4], sg[2][4];
    if (gw * 2 < NTOK) {
#pragma unroll
        for (int r = 0; r < 2; ++r)
#pragma unroll
            for (int j = 0; j < 4; ++j) { const size_t m = gw * 2 + r; ra[r][j] = ((const v2u*)(OF + m * D))[lane + 64 * j]; rb[r][j] = ((const v2u*)(OB + m * D))[lane + 64 * j]; sg[r][j] = ((const v2u*)(SG + m * D))[lane + 64 * j]; }
    }
    for (int m0 = gw * 2; m0 < NTOK; m0 += NGW * 2) {
        v2u na[2][4], nb[2][4], ns[2][4]; const int mn = m0 + NGW * 2;
#pragma unroll
        for (int r = 0; r < 2; ++r)
#pragma unroll
            for (int j = 0; j < 4; ++j) { const size_t m = (size_t)mn + r; const v2u z2 = (v2u){0u, 0u};
                na[r][j] = mn < NTOK ? ((const v2u*)(OF + m * D))[lane + 64 * j] : z2; nb[r][j] = mn < NTOK ? ((const v2u*)(OB + m * D))[lane + 64 * j] : z2; ns[r][j] = mn < NTOK ? ((const v2u*)(SG + m * D))[lane + 64 * j] : z2; }
#pragma unroll
        for (int r = 0; r < 2; ++r)
#pragma unroll
            for (int j = 0; j < 4; ++j) { const v2u a_ = ra[r][j], b_ = rb[r][j];
                const f32x4 oo = (f32x4){bf_lo(a_.x) + bf_lo(b_.x), bf_hi(a_.x) + bf_hi(b_.x), bf_lo(a_.y) + bf_lo(b_.y), bf_hi(a_.y) + bf_hi(b_.y)};
                float s = (oo.x * oo.x + oo.y * oo.y) + (oo.z * oo.z + oo.w * oo.w);
                s = half_sum(s);
                const float rs = 1.0f / sqrtf(s * (1.0f / DK) + EPS);
                store_row4<F8_MISC != 0>((unsigned char*)Y + (size_t)(m0 + r) * D * (F8_MISC ? 1 : 2), lane, j,
                    (f32x4){oo.x * rs * gh[j].x * bf_lo(sg[r][j].x), oo.y * rs * gh[j].y * bf_hi(sg[r][j].x), oo.z * rs * gh[j].z * bf_lo(sg[r][j].y), oo.w * rs * gh[j].w * bf_hi(sg[r][j].y)}, 4.0f); }
#pragma unroll
        for (int r = 0; r < 2; ++r)
#pragma unroll
            for (int j = 0; j < 4; ++j) { ra[r][j] = na[r][j]; rb[r][j] = nb[r][j]; sg[r][j] = ns[r][j]; }
    }
}
__device__ __forceinline__ void p_router(const Args& a, LAS unsigned char* lds, int l, int tid, int lane, int wave) {
    typedef _Float16 h16x8 __attribute__((ext_vector_type(8))); typedef _Float16 h16x4 __attribute__((ext_vector_type(4)));
    constexpr int PITCH = 2064, TILE_BYTES = 16 * PITCH, P_OFF = 2 * TILE_BYTES, P_BYTES = 8 * 16 * 32 * 4;
    LAS int* s_cnt = (LAS int*)(lds + EXTRA_OFF);
    LAS int* s_gb = s_cnt + 32;
    LAS int* s_sel = (LAS int*)(lds + EXTRA_OFF + 2560);
    unsigned* GCNT = (unsigned*)(a.ws + WS_CTL) + CW_GCNT + l * 32;
    const float* WR = a.in[I_WR] + (size_t)l * D * NE; const float* BR = a.in[I_BR] + l * NE;
    const bf16* X = (const bf16*)(a.ws + WS_X); unsigned char* H = a.ws + WS_H;
    const int fr = lane & 15, g = lane >> 4;
    v2u nx[2][4];
    if (blockIdx.x < NTOK / 128) {
#pragma unroll
        for (int t = 0; t < 2; ++t)
#pragma unroll
            for (int j = 0; j < 4; ++j) nx[t][j] = ((const v2u*)(X + (size_t)(blockIdx.x * 128 + 2 * wave + t) * D))[lane + 64 * j];
    }
    h16x8 wb0[4], wb1[4];
#pragma unroll
    for (int c = 0; c < 4; ++c)
#pragma unroll
        for (int i = 0; i < 8; ++i) { const float* wp = WR + (size_t)(128 * wave + 32 * c + 8 * g + i) * NE + fr; wb0[c][i] = (_Float16)wp[0]; wb1[c][i] = (_Float16)wp[16]; }
    const float* MODS = (const float*)(a.ws + WS_MODS);
    int* TOPS = (int*)(a.ws + WS_TOPE); float* TOPW = (float*)(a.ws + WS_TOPW); int* STOK = (int*)(a.ws + WS_STOK);
    for (int ch = blockIdx.x; ch < NTOK / 128; ch += gridDim.x) {
        if (tid < 32) s_cnt[tid] = 0;
        const int b = (ch * 128) / SEQ; const float* md = MODS + (size_t)(l * 3 + b) * 6 * D;
        if (ch != (int)blockIdx.x) {
#pragma unroll
        for (int t = 0; t < 2; ++t)
#pragma unroll
            for (int j = 0; j < 4; ++j) nx[t][j] = ((const v2u*)(X + (size_t)(ch * 128 + 2 * wave + t) * D))[lane + 64 * j];
        }
#define ROUTER_A(it_) do { const int tokA = ch * 128 + (it_) * 16 + 2 * wave; f32x4 hf[2][4]; \
            _Pragma("unroll") for (int t = 0; t < 2; ++t) _Pragma("unroll") for (int j = 0; j < 4; ++j) hf[t][j] = (f32x4){bf_lo(nx[t][j].x), bf_hi(nx[t][j].x), bf_lo(nx[t][j].y), bf_hi(nx[t][j].y)}; \
            if ((it_) + 1 < 8) { _Pragma("unroll") for (int t = 0; t < 2; ++t) _Pragma("unroll") for (int j = 0; j < 4; ++j) nx[t][j] = ((const v2u*)(X + (size_t)(tokA + 16 + t) * D))[lane + 64 * j]; } \
            _Pragma("unroll") for (int t = 0; t < 2; ++t) { \
                norm_mod_store<true>(hf[t], a.in[I_GFFN] + l * D, md + 4 * D, md + 3 * D, H + (size_t)(tokA + t) * D, lane); \
                _Pragma("unroll") for (int j = 0; j < 4; ++j) { const h16x4 hv = {(_Float16)hf[t][j].x, (_Float16)hf[t][j].y, (_Float16)hf[t][j].z, (_Float16)hf[t][j].w}; \
                    *(LAS h16x4*)(lds + ((it_) & 1) * TILE_BYTES + (2 * wave + t) * PITCH + (4 * lane + 256 * j) * 2) = hv; } } } while (0)
#define ROUTER_B(it_) do { f32x4 acc0 = (f32x4){0.f, 0.f, 0.f, 0.f}, acc1 = acc0; \
            _Pragma("unroll") for (int c = 0; c < 4; ++c) { const h16x8 av = *(const LAS h16x8*)(lds + ((it_) & 1) * TILE_BYTES + fr * PITCH + (128 * wave + 32 * c + 8 * g) * 2); \
                acc0 = __builtin_amdgcn_mfma_f32_16x16x32_f16(av, wb0[c], acc0, 0, 0, 0); acc1 = __builtin_amdgcn_mfma_f32_16x16x32_f16(av, wb1[c], acc1, 0, 0, 0); } \
            LAS float* Pw = (LAS float*)(lds + P_OFF + ((it_) & 1) * P_BYTES); \
            _Pragma("unroll") for (int r = 0; r < 4; ++r) { Pw[(wave * 16 + 4 * g + r) * 32 + fr] = acc0[r]; Pw[(wave * 16 + 4 * g + r) * 32 + 16 + fr] = acc1[r]; } } while (0)
#define ROUTER_C(it_) do { const int t = lane >> 5, e0 = lane & 31; const LAS float* Pr = (const LAS float*)(lds + P_OFF + ((it_) & 1) * P_BYTES); \
            float v0 = BR[e0]; \
            _Pragma("unroll") for (int w = 0; w < 8; ++w) v0 += Pr[(w * 16 + 2 * wave + t) * 32 + e0]; \
            float selv[4]; int seli[4]; \
            { const unsigned ub = __builtin_bit_cast(unsigned, v0); unsigned key = (ub & 0x80000000u) ? ~ub : (ub | 0x80000000u); key = (key & ~31u) | (unsigned)(31 - e0); \
              _Pragma("unroll") for (int r = 0; r < 4; ++r) { unsigned m = key, o; \
                  o = (unsigned)__builtin_amdgcn_update_dpp(0, (int)m, 0xB1, 0xF, 0xF, true); m = o > m ? o : m; \
                  o = (unsigned)__builtin_amdgcn_update_dpp(0, (int)m, 0x4E, 0xF, 0xF, true); m = o > m ? o : m; \
                  o = (unsigned)__builtin_amdgcn_update_dpp(0, (int)m, 0x141, 0xF, 0xF, true); m = o > m ? o : m; \
                  o = (unsigned)__builtin_amdgcn_update_dpp(0, (int)m, 0x140, 0xF, 0xF, true); m = o > m ? o : m; \
                  o = (unsigned)__shfl_xor((int)m, 16); m = o > m ? o : m; \
                  const int bi = 31 - (int)(m & 31u); seli[r] = bi; \
                  if (bi == e0) key = 0u; } \
              _Pragma("unroll") for (int r = 0; r < 4; ++r) selv[r] = __builtin_bit_cast(float, __builtin_amdgcn_ds_bpermute(((lane & 32) + seli[r]) << 2, __builtin_bit_cast(int, v0))); } \
            if ((lane & 31) == 0) { \
                const float e1 = __expf(selv[1] - selv[0]), e2 = __expf(selv[2] - selv[0]), e3 = __expf(selv[3] - selv[0]); const float inv = 1.0f / (1.0f + e1 + e2 + e3); \
                *(f32x4*)(TOPW + (size_t)(ch * 128 + (it_) * 16 + 2 * wave + t) * 4) = (f32x4){inv, e1 * inv, e2 * inv, e3 * inv}; \
                _Pragma("unroll") for (int r = 0; r < 4; ++r) s_sel[((it_) * 16 + 2 * wave + t) * 4 + r] = (seli[r] << 16) | __hip_atomic_fetch_add(&s_cnt[seli[r]], 1, __ATOMIC_RELAXED, __HIP_MEMORY_SCOPE_WORKGROUP); \
            } } while (0)
        ROUTER_A(0);
        for (int k = 0; k < 8; ++k) {
            __syncthreads();
            ROUTER_B(k);
            if (k > 0) ROUTER_C(k - 1);
            if (k < 7) ROUTER_A(k + 1);
        }
        __syncthreads();
        ROUTER_C(7);
#undef ROUTER_A
#undef ROUTER_B
#undef ROUTER_C
        __syncthreads();
        if (tid < 32) s_gb[tid] = (int)__hip_atomic_fetch_add(GCNT + tid, (unsigned)s_cnt[tid], __ATOMIC_RELAXED, __HIP_MEMORY_SCOPE_AGENT);
        __syncthreads();
        { const int sv = s_sel[tid], e = sv >> 16, vi = s_gb[e] + (sv & 0xffff); TOPS[(size_t)ch * 512 + tid] = e * NTOK + vi; STOK[(size_t)e * NTOK + vi] = ch * 128 + (tid >> 2); }
        __syncthreads();
    }
}
__device__ __forceinline__ void moe_tables(const Args& a, LAS unsigned char* lds, int l, int tid) {
    LAS int* s_tb = (LAS int*)(lds + EXTRA_OFF + 256); LAS int* s_ce = s_tb + 40; LAS int* tab = (LAS int*)(lds + EXTRA_OFF + 640);
    const unsigned* GCNT = (const unsigned*)(a.ws + WS_CTL) + CW_GCNT + l * 32;
    if (tid < 32) s_ce[tid] = (int)__hip_atomic_load(GCNT + tid, __ATOMIC_RELAXED, __HIP_MEMORY_SCOPE_AGENT);
    __syncthreads();
    if (tid == 0) { int run = 0; for (int e = 0; e < 32; ++e) { s_tb[e] = run; run += (s_ce[e] + 255) >> 8; } s_tb[32] = run; }
    __syncthreads();
    if (tid < 32) { const int t0 = s_tb[tid], t1 = s_tb[tid + 1]; for (int t = t0; t < t1; ++t) tab[t] = tid; }
    __syncthreads();
}
template <bool FINAL> __device__ __forceinline__ void p_combine(const Args& a, LAS unsigned char* lds, int l, int lane, int wave) {
    const int gw = blockIdx.x * NWAVES + wave, NGW = gridDim.x * NWAVES;
    bf16* X = (bf16*)(a.ws + WS_X); const bf16* YS = (const bf16*)(a.ws + WS_YS); const int* TOPS = (const int*)(a.ws + WS_TOPE); const float* TOPW = (const float*)(a.ws + WS_TOPW);
    const LAS int* s_tb = (const LAS int*)(lds + EXTRA_OFF + 256);
    const float* MODS = (const float*)(a.ws + WS_MODS); bf16* H = (bf16*)(a.ws + WS_H);
    const int S2 = NGW * 2;
    auto load_idx = [&](int m, v4i (&ps)[2], f32x4 (&tws)[2]) {
#pragma unroll
        for (int r = 0; r < 2; ++r) { ps[r] = *(const v4i*)(TOPS + (size_t)(m + r) * 4); tws[r] = *(const f32x4*)(TOPW + (size_t)(m + r) * 4); } };
    auto load_rows = [&](int m, v4i (&ps)[2], v2u (&xr_)[2][4], v2u (&y_)[2][4][4]) {
#pragma unroll
        for (int r = 0; r < 2; ++r) {
#pragma unroll
            for (int k = 0; k < 4; ++k) { const int e = ps[r][k] >> 15; ps[r][k] = s_tb[e] * 256 + (ps[r][k] & (NTOK - 1)); }
#pragma unroll
            for (int j = 0; j < 4; ++j) { xr_[r][j] = ((const v2u*)(X + (size_t)(m + r) * D))[lane + 64 * j];
#pragma unroll
                for (int k = 0; k < 4; ++k) {
                    if (F8_Y) { y_[r][j][k].x = ((const unsigned*)((const unsigned char*)YS + (size_t)ps[r][k] * D))[lane + 64 * j]; y_[r][j][k].y = 0u; }
                    else y_[r][j][k] = ((const v2u*)(YS + (size_t)ps[r][k] * D))[lane + 64 * j]; } } } };
    v2u xr[2][4]; v2u y[2][4][4]; f32x4 tw[2]; v4i nps[2]; f32x4 ntw[2];
    if (gw * 2 < NTOK) { v4i cps[2]; load_idx(gw * 2, cps, tw); load_rows(gw * 2, cps, xr, y); if (gw * 2 + S2 < NTOK) load_idx(gw * 2 + S2, nps, ntw); }
    for (int m0 = gw * 2; m0 < NTOK; m0 += S2) {
        const int b = m0 / SEQ; const float* gt = MODS + (size_t)(l * 3 + b) * 6 * D + 5 * D;
        const int mn = m0 + S2, mnn = m0 + 2 * S2;
        v2u xn[2][4]; v2u yn[2][4][4]; v4i pps[2]; f32x4 ptw[2];
        if (mn < NTOK) load_rows(mn, nps, xn, yn);
        if (mnn < NTOK) load_idx(mnn, pps, ptw);
        f32x4 v[2][4];
#pragma unroll
        for (int r = 0; r < 2; ++r)
#pragma unroll
            for (int j = 0; j < 4; ++j) v[r][j] = (f32x4){bf_lo(xr[r][j].x), bf_hi(xr[r][j].x), bf_lo(xr[r][j].y), bf_hi(xr[r][j].y)};
#pragma unroll
        for (int r = 0; r < 2; ++r) { const int m = m0 + r;
#pragma unroll
            for (int j = 0; j < 4; ++j) { f32x4 s = (f32x4){0.f, 0.f, 0.f, 0.f};
#pragma unroll
                for (int k = 0; k < 4; ++k) {
                    if (F8_Y) { const int w = (int)y[r][j][k].x; const f32x2_t lo = __builtin_amdgcn_cvt_pk_f32_fp8(w, false), hi = __builtin_amdgcn_cvt_pk_f32_fp8(w, true);
                        s += (f32x4){lo.x, lo.y, hi.x, hi.y} * (tw[r][k] * (1.0f / YSCALE)); }
                    else s += (f32x4){bf_lo(y[r][j][k].x), bf_hi(y[r][j][k].x), bf_lo(y[r][j][k].y), bf_hi(y[r][j][k].y)} * tw[r][k]; }
                v[r][j] = v[r][j] + ((const f32x4*)gt)[lane + 64 * j] * s; }
            if (!FINAL) {
#pragma unroll
                for (int j = 0; j < 4; ++j) ((v2u*)(X + (size_t)m * D))[lane + 64 * j] = (v2u){pk2(v[r][j].x, v[r][j].y), pk2(v[r][j].z, v[r][j].w)};
                const float* md = MODS + (size_t)((l + 1) * 3 + b) * 6 * D;
                norm_mod_store<F8_MISC != 0>(v[r], a.in[I_GMIX] + (l + 1) * D, md + 1 * D, md + 0 * D, (unsigned char*)H + (size_t)m * D * (F8_MISC ? 1 : 2), lane);
            } else {
                float s = 0.f;
#pragma unroll
                for (int j = 0; j < 4; ++j) s += (v[r][j].x * v[r][j].x + v[r][j].y * v[r][j].y) + (v[r][j].z * v[r][j].z + v[r][j].w * v[r][j].w);
                const float rs = 1.0f / sqrtf(wave_sum(s) * (1.0f / D) + EPS);
#pragma unroll
                for (int j = 0; j < 4; ++j) __builtin_nontemporal_store(v[r][j] * rs * ((const f32x4*)a.in[I_GFINAL])[lane + 64 * j], &((f32x4*)(a.out + (size_t)m * D))[lane + 64 * j]);
            }
        }
#pragma unroll
        for (int r = 0; r < 2; ++r) { tw[r] = ntw[r]; nps[r] = pps[r]; ntw[r] = ptw[r];
#pragma unroll
            for (int j = 0; j < 4; ++j) { xr[r][j] = xn[r][j];
#pragma unroll
                for (int k = 0; k < 4; ++k) y[r][j][k] = yn[r][j][k]; } }
    }
}
__device__ __forceinline__ void p_dwconv(const Args& a, int tid) {
    const bf16* U = (const bf16*)(a.ws + WS_U); bf16* ZP = (bf16*)(a.ws + WS_ZP);
    const float* WDW = a.in[I_WCVDW]; const float* BDW = a.in[I_BCVDW];
    const int half = tid >> 8, cp = tid & 255;
    typedef float f32x2v __attribute__((ext_vector_type(2)));
    auto line_of = [&](int unit, int& c, int& len, int& p0, size_t& base, size_t& stride) {
        const int hu = unit * 2 + half;
        if (hu < 2048) { c = 2 * cp; len = GRIDW; p0 = (hu & 3) * 16; base = (size_t)(hu >> 2) * GRIDW * D; stride = D; }
        else { const int v = hu - 2048; const int b = v >> 10, w = (v >> 4) & 63; c = 512 + 2 * cp; len = GRIDR; p0 = (v & 15) * 16; base = ((size_t)b * SEQ + w) * D; stride = (size_t)GRIDW * D; } };
    auto load_in = [&](int c, int len, int p0, size_t base, size_t stride, unsigned (&u)[46]) {
#pragma unroll
        for (int i = 0; i < 46; ++i) { const int pp = p0 - 15 + i; u[i] = (pp >= 0 && pp < len) ? *(const unsigned*)(U + base + (size_t)pp * stride + c) : 0u; } };
    int c, len, p0; size_t base, stride; unsigned u[46];
    f32x2v w2[CONVW]; f32x2v bb = (f32x2v){0.f, 0.f}; int wc = -1;
    if ((int)blockIdx.x < 2048) { line_of(blockIdx.x, c, len, p0, base, stride); load_in(c, len, p0, base, stride, u); }
    for (int unit = blockIdx.x; unit < 2048; unit += gridDim.x) {
        int cn = 0, lenn = 0, p0n = 0; size_t basen = 0, striden = 0; unsigned un[46]; const int nu = unit + gridDim.x;
        if (nu < 2048) { line_of(nu, cn, lenn, p0n, basen, striden); load_in(cn, lenn, p0n, basen, striden, un); }
        if (wc != c) { wc = c;
#pragma unroll
            for (int j = 0; j < CONVW; ++j) w2[j] = *(const f32x2v*)(WDW + j * D + c);
            bb = *(const f32x2v*)(BDW + c); }
        f32x2v in2[46];
#pragma unroll
        for (int i = 0; i < 46; ++i) in2[i] = (f32x2v){bf_lo(u[i]), bf_hi(u[i])};
#pragma unroll
        for (int i = 0; i < 16; ++i) { f32x2v acc2 = bb;
#pragma unroll
            for (int j = 0; j < CONVW; ++j) acc2 = __builtin_elementwise_fma(in2[i + j], w2[j], acc2);
            *(unsigned*)(ZP + base + (size_t)(p0 + i) * stride + c) = pk2(acc2.x, acc2.y); }
        c = cn; len = lenn; p0 = p0n; base = basen; stride = striden;
#pragma unroll
        for (int i = 0; i < 46; ++i) u[i] = un[i];
    }
}
__device__ __forceinline__ void p_ln_silu(const Args& a, int lane, int wave) {
    const int gw = blockIdx.x * NWAVES + wave, NGW = gridDim.x * NWAVES;
    const bf16* ZP = (const bf16*)(a.ws + WS_ZP); bf16* Z = (bf16*)(a.ws + WS_Z);
    f32x4 gg[4], bb[4];
#pragma unroll
    for (int j = 0; j < 4; ++j) { gg[j] = ((const f32x4*)a.in[I_GCVLN])[lane + 64 * j]; bb[j] = ((const f32x4*)a.in[I_BCVLN])[lane + 64 * j]; }
    v2u y[2][4];
    if (gw * 2 < NTOK) {
#pragma unroll
        for (int r = 0; r < 2; ++r)
#pragma unroll
            for (int j = 0; j < 4; ++j) y[r][j] = ((const v2u*)(ZP + (size_t)(gw * 2 + r) * D))[lane + 64 * j];
    }
    for (int m0 = gw * 2; m0 < NTOK; m0 += NGW * 2) {
        v2u yn[2][4]; const int mn = m0 + NGW * 2;
#pragma unroll
        for (int r = 0; r < 2; ++r)
#pragma unroll
            for (int j = 0; j < 4; ++j) yn[r][j] = mn < NTOK ? ((const v2u*)(ZP + (size_t)(mn + r) * D))[lane + 64 * j] : (v2u){0u, 0u};
#pragma unroll
        for (int r = 0; r < 2; ++r) {
            f32x4 v[4]; float s = 0.f;
#pragma unroll
            for (int j = 0; j < 4; ++j) { v[j] = (f32x4){bf_lo(y[r][j].x), bf_hi(y[r][j].x), bf_lo(y[r][j].y), bf_hi(y[r][j].y)}; s += (v[j].x + v[j].y) + (v[j].z + v[j].w); }
            const float mean = wave_sum(s) * (1.0f / D); float s2 = 0.f;
#pragma unroll
            for (int j = 0; j < 4; ++j) { v[j] = v[j] - mean; s2 += (v[j].x * v[j].x + v[j].y * v[j].y) + (v[j].z * v[j].z + v[j].w * v[j].w); }
            const float rstd = 1.0f / sqrtf(wave_sum(s2) * (1.0f / D) + EPS);
#pragma unroll
            for (int j = 0; j < 4; ++j) {
                f32x4 yy = v[j] * rstd * gg[j] + bb[j]; yy.x *= fsig(yy.x); yy.y *= fsig(yy.y); yy.z *= fsig(yy.z); yy.w *= fsig(yy.w);
                store_row4<F8_MISC != 0>((unsigned char*)Z + (size_t)(m0 + r) * D * (F8_MISC ? 1 : 2), lane, j, yy, 4.0f); }
        }
#pragma unroll
        for (int r = 0; r < 2; ++r)
#pragma unroll
            for (int j = 0; j < 4; ++j) y[r][j] = yn[r][j];
    }
}


enum { PH_PRO = 0, PH_NORM0, PH_INPROJ, PH_SCANA, PH_SCANC, PH_READOUT, PH_OUTPROJ, PH_ROUTER0, PH_G1_0, PH_G2_0, PH_COMB0, PH_CVIN, PH_DWCONV, PH_LN, PH_CVOUT, PH_ROUTER1, PH_G1_1, PH_G2_1, PH_FINAL, NPH };
#ifndef AEPI
#define AEPI 1
#endif
#ifndef REPMASK
#define REPMASK 0ull
#endif
#ifndef SCAN_NAIVE
#define SCAN_NAIVE 0
#endif
#if defined(__HIP_DEVICE_COMPILE__)
#define NO_PK_F32
#else
#define NO_PK_F32
#endif
__global__ void NO_PK_F32 __launch_bounds__(NTHR, 2) fwd_kernel(Args args) {
    extern __shared__ __attribute__((aligned(16))) unsigned char lds_raw[];
    LAS unsigned char* lds = (LAS unsigned char*)lds_raw;
    const int tid = threadIdx.x, lane = tid & 63, wave = __builtin_amdgcn_readfirstlane(tid >> 6);
    const int G = gridDim.x, bid = blockIdx.x;
    unsigned char* ws = args.ws;
    for (int u = tid; u < (LDS_BYTES - LDSCTL_OFF) / 4; u += NTHR) ((LAS unsigned*)(lds + LDSCTL_OFF))[u] = 0u;
    __syncthreads();
    volatile LAS unsigned* MISC = (volatile LAS unsigned*)(lds + MISC_OFF);
    XcdBarrier bar = xcd_barrier_post((unsigned*)(ws + WS_CTL) + CW_BAR + args.li * XCD_BAR_WORDS, MISC + 8);
    const int lo = args.ph_lo, hi = args.ph_hi;
    if (TL_PROBE && tid == 0) MISC[48] = (unsigned)__builtin_amdgcn_s_memrealtime();
    if (tid == 0) __hip_atomic_store((unsigned*)(ws + WS_CTL) + CW_XMAP + bid, xb_xcc_id() + 1u, __ATOMIC_RELAXED, __HIP_MEMORY_SCOPE_AGENT);
#define IN(k) (lo <= (k) && (k) < hi)
    int cv_n = 0; unsigned bseq = 0;
#ifndef FLAT_BARRIER
#define FLAT_BARRIER 0
#endif
#define SEAM(k) do { if (IN(k) && IN((k) + 1)) { ++bseq; if (FLAT_BARRIER) flat_barrier_work((unsigned*)(ws + WS_CTL) + CW_FLAT, args, lds, wave, lane, cv_n, MISC + 12, bseq); else xcd_barrier_work(bar, args, lds, wave, lane, cv_n, MISC + 12, bseq); \
        if (TL_PROBE && tid == 0) MISC[48 + (k) + 1] = (unsigned)__builtin_amdgcn_s_memrealtime(); } } while (0)
#define PHASE(k, ...) if (IN(k)) { __VA_ARGS__; if ((REPMASK >> (k)) & 1ull) { __syncthreads(); __VA_ARGS__; } } SEAM(k);
    typedef pg8::bf16_t pbf;

    const bool merge_pro = false && (G >= 32) && IN(PH_PRO) && IN(PH_NORM0);
    if (IN(PH_PRO)) { p_mods(args, lds, tid, lane, wave); p_weights(args, lds, lane, wave); if (merge_pro) wait_mods0(args, tid); }
    if (!merge_pro) SEAM(PH_PRO);
    const bool ctx_early = SPLIT_IN && (G == 256);
    PHASE(PH_NORM0, {
        if (ctx_early && bid < 24) {
            const int cb = bid / 12, cj = bid % 12;
            p_norm0(args, lane, wave, NWAVES, NTOK + cb * CTXL, NTOK + cb * CTXL + CTXL);
            VM_WAIT(); __syncthreads();
            if (cj < 8) {
                pg8::Gemm g{(const pbf*)(ws + WS_H8), (const pbf*)(ws + WS_WIN8), D / 2, 0};
                pg8::OneUnit S1{NTOK / 256 + cb, cj};
                pg8::EpiHgrnIn E{(pbf*)(ws + WS_Q), (WS_V - WS_Q) / 2, (_Float16*)(ws + WS_LFF), (WS_LFB - WS_LFF) / 2, args.in[I_HGAMMA], 2};
                pg8::gemm_phase<pg8::EpiHgrnIn, pg8::OneUnit, AEPI != 0, true, true, 0x79797979, 0x7F7F7F7F>(lds + RING_OFF, g, S1, E);
            } else {
                pg8::Gemm g{(const pbf*)(ws + WS_H), (const pbf*)(ws + WS_WIN), D, 0};
                pg8::OneUnit S1{NTOK / 256 + cb, 4 + (cj - 8)};
                pg8::EpiHgrnIn E{(pbf*)(ws + WS_Q), (WS_V - WS_Q) / 2, (_Float16*)(ws + WS_LFF), (WS_LFB - WS_LFF) / 2, args.in[I_HGAMMA], 1};
                pg8::gemm_phase<pg8::EpiHgrnIn, pg8::OneUnit, AEPI != 0, true, false>(lds + RING_OFF, g, S1, E);
            }
        } else if (ctx_early) p_norm0(args, lane, (bid - 24) * NWAVES + wave, (G - 24) * NWAVES, 0, NTOK);
        else p_norm0(args, lane, bid * NWAVES + wave, G * NWAVES, 0, MROWS);
    })
    PHASE(PH_INPROJ, {
        static_assert(WS_V - WS_Q == WS_SG - WS_V, "Q|V|SG equally spaced");
        if (SPLIT_IN) {
            const int nMi = ctx_early ? NTOK / 256 : MROWS / 256;
            {
                pg8::Gemm g{(const pbf*)(ws + WS_H8), (const pbf*)(ws + WS_WIN8), D / 2, 0};
                pg8::TileOrder S; S.init(nMi, (G_F8 ? 3 : 2) * D / 256, G, bid, nullptr);
                pg8::EpiHgrnIn E{(pbf*)(ws + WS_Q), (WS_V - WS_Q) / 2, (_Float16*)(ws + WS_LFF), (WS_LFB - WS_LFF) / 2, args.in[I_HGAMMA], 2};
                pg8::gemm_phase<pg8::EpiHgrnIn, pg8::TileOrder, AEPI != 0, true, true, 0x79797979, 0x7F7F7F7F>(lds + RING_OFF, g, S, E);
            }
            {
                pg8::Gemm g{(const pbf*)(ws + WS_H), (const pbf*)(ws + WS_WIN), D, 0};
                pg8::TileOrder S; S.init(nMi, (G_F8 ? 2 : 3) * D / 256, G, bid, nullptr);
                pg8::EpiHgrnIn E{(pbf*)(ws + WS_Q), (WS_V - WS_Q) / 2, (_Float16*)(ws + WS_LFF), (WS_LFB - WS_LFF) / 2, args.in[I_HGAMMA], 1};
                pg8::gemm_phase<pg8::EpiHgrnIn, pg8::TileOrder, AEPI != 0, true, false>(lds + RING_OFF, g, S, E);
            }
        } else {
            pg8::Gemm g{(const pbf*)(ws + WS_H), (const pbf*)(ws + WS_WIN), F8_IN ? D / 2 : D, 0};
            pg8::TileOrder S; S.init(MROWS / 256, 5 * D / 256, G, bid, nullptr);
            pg8::EpiHgrnIn E{(pbf*)(ws + WS_Q), (WS_V - WS_Q) / 2, (_Float16*)(ws + WS_LFF), (WS_LFB - WS_LFF) / 2, args.in[I_HGAMMA], 0};
            pg8::gemm_phase<pg8::EpiHgrnIn, pg8::TileOrder, AEPI != 0, true, F8_IN != 0, 0x79797979, 0x7F7F7F7F>(lds + RING_OFF, g, S, E);
        }
    })
#if SCAN_NAIVE
    PHASE(PH_SCANA, { p_scan_naive(args, lds, tid); })
    PHASE(PH_SCANC, { })
#else
    PHASE(PH_SCANA, { p_scan_a(args, lds, tid, lane, wave); })
    PHASE(PH_SCANC, { p_scan_c(args, lds, tid, lane, wave); })
#endif
    PHASE(PH_READOUT, { p_readout(args, lane, wave); })
    PHASE(PH_OUTPROJ, {
        pg8::Gemm g{(const pbf*)(ws + WS_YIN), (const pbf*)(ws + WS_WOUT), F8_MISC ? D / 2 : D, 0};
        pg8::TileOrder S; S.init(NTOK / 256, D / 256, G, bid, nullptr);
        pg8::EpiResGate<false, true> E{args.in[I_X], (void*)(ws + WS_X), (const float*)(ws + WS_MODS) + 2 * D, 6 * D, SEQ, nullptr};
        pg8::gemm_phase<pg8::EpiResGate<false, true>, pg8::TileOrder, AEPI != 0, true, F8_MISC != 0, 0x79797979, 0x7D7D7D7D>(lds + RING_OFF, g, S, E);
    })
#ifndef LDSB
#define LDSB 1
#endif
#ifndef XBAR_PROBE
#define XBAR_PROBE 0
#endif
#ifndef G2_NS
#define G2_NS 0
#endif
#ifndef G1_NS
#define G1_NS 0
#endif
#ifndef MOE_HANDOFF
#define MOE_HANDOFF 1
#endif
#ifndef MOE_WT
#define MOE_WT 0
#endif
#define MOE_PHASES(l, pb) \
    if (IN(pb + 0)) { p_router(args, lds, l, tid, lane, wave); cv_finish(args, lds, wave, lane, cv_n, (l + 1) * CV_L0); } SEAM(pb + 0); \
    if ((l) == 1) { if (XBAR_PROBE >= 1) SEAM(pb + 0); if (XBAR_PROBE >= 2) SEAM(pb + 0); if (XBAR_PROBE >= 3) SEAM(pb + 0); if (XBAR_PROBE >= 4) SEAM(pb + 0); }     \
    if (IN(pb + 1) || IN(pb + 2) || IN(pb + 3)) { \
        moe_tables(args, lds, l, tid); \
        LAS int* tab = (LAS int*)(lds + EXTRA_OFF + 640); \
        const LAS int* s_tb = (const LAS int*)(lds + EXTRA_OFF + 256); const LAS int* s_ce = s_tb + 40; \
        const int ntiles = __builtin_amdgcn_readfirstlane(s_tb[32]); \
        const bool hand = MOE_HANDOFF && (G == 256) && IN(pb + 1) && IN(pb + 2) && !((REPMASK >> (pb + 1)) & 3ull) && (MOE_WT || xmap_ok); \
        const int xl = (hand && !MOE_WT) ? 1 : 0; \
        unsigned* tcnt = (unsigned*)(ws + WS_CTL) + CW_TCNT + l * 32768; \
        const int c2 = (hand && MOE_WT) ? ((bid - ((((ntiles * 8) & 255) + 7) & ~7)) & 255) : bid;     \
        const int tv = (((bid & 7) + 1) * ntiles >> 3) - ((bid & 7) * ntiles >> 3);                   \
        LAS int* ut1 = (LAS int*)(lds + EXTRA_OFF + 13824); LAS int* ut2 = ut1 + 32;                  \
        if (wave == 0) { \
            int pm_ = 0, pn_ = 0; \
            const bool h1 = lane < 32 && pg8::MoeOrder::unit_of(xl, ntiles, 2 * D / 256, G, bid, bid >> 3, lane, pm_, pn_); \
            if (lane < 32) ut1[lane] = h1 ? (pm_ | (pn_ << 16) | (tab[pm_] << 24)) : 0; \
            const bool h2 = lane < 32 && pg8::MoeOrder::unit_of(xl, ntiles, D / 256, G, c2, ((bid >> 3) - ((tv * 8) & 31)) & 31, lane, pm_, pn_); \
            if (lane < 32) ut2[lane] = h2 ? (pm_ | (pn_ << 16) | (tab[pm_] << 24)) : 0; \
            const int n1 = __popcll(__ballot(h1)), n2 = __popcll(__ballot(h2)); \
            if (lane == 0) { ut1[64] = n1; ut1[65] = n2; } \
        } \
        __syncthreads(); \
        const int nu1 = __builtin_amdgcn_readfirstlane(ut1[64]), nu2 = __builtin_amdgcn_readfirstlane(ut1[65]); \
        if (IN(pb + 1)) { \
            LAS unsigned short* tt = (LAS unsigned short*)(lds + EXTRA_OFF + 2816);     \
            pg8::MoeOrder S; S.ut = ut1; S.nu = nu1; S.cnt = tcnt; S.rdy = 0u; S.mode = hand ? 0 : 2; \
            { const int* STOK = (const int*)(ws + WS_STOK); int tv_[10];                         \
              _Pragma("unroll") for (int n_ = 0; n_ < 10; ++n_) { const int idx = tid + NTHR * n_; tv_[n_] = 0; \
                  if (idx < nu1 * 256) { const int uw = ut1[idx >> 8], pm_ = uw & 0xFFFF, e_ = (uw >> 24) & 0xFF, vi = (pm_ - s_tb[e_]) * 256 + (idx & 255); if (vi < s_ce[e_]) tv_[n_] = STOK[(size_t)e_ * NTOK + vi]; } } \
              _Pragma("unroll") for (int n_ = 0; n_ < 10; ++n_) { const int idx = tid + NTHR * n_; if (idx < nu1 * 256) tt[idx] = (unsigned short)tv_[n_]; } } \
            __syncthreads(); \
            pg8::Gemm g{(const pbf*)(ws + WS_H), (const pbf*)(ws + WS_W1 + (size_t)l * NE * 2 * D * D), D / 2, (size_t)2 * D * D, tt};   \
            pg8::EpiPair<0, true, 4, MOE_WT != 0, LDSB != 0> E{(pbf*)(ws + WS_ACT), args.in[I_BE1] + (size_t)l * NE * 2 * D, (const LAS float*)(lds + EXTRA_OFF + 14336)}; \
            pg8::gemm_phase<pg8::EpiPair<0, true, 4, MOE_WT != 0, LDSB != 0>, pg8::MoeOrder, AEPI != 0, true, true, 0x79797979, 0x7F7F7F7F, true, G1_NS>(lds + RING_OFF, g, S, E); \
            if ((REPMASK >> (pb + 1)) & 1ull) { __syncthreads(); pg8::gemm_phase<pg8::EpiPair<0, true, 4, MOE_WT != 0, LDSB != 0>, pg8::MoeOrder, AEPI != 0, true, true, 0x79797979, 0x7F7F7F7F, true, G1_NS>(lds + RING_OFF, g, S, E); } \
        } \
        pg8::MoeOrder S2; S2.ut = ut2; S2.nu = nu2; S2.cnt = tcnt; S2.rdy = 0u; S2.mode = hand ? 1 : 2; \
        if (hand) {                                                          \
            if (wave == 0) { \
                const unsigned v = lane < nu2 ? __hip_atomic_load(tcnt + 32 * (ut2[lane & 31] & 0xFFFF), __ATOMIC_RELAXED, __HIP_MEMORY_SCOPE_AGENT) : 64u; \
                const unsigned long long m = __ballot(v >= 64u); \
                __builtin_amdgcn_fence(__ATOMIC_ACQUIRE, "agent"); asm volatile("s_waitcnt vmcnt(0)" ::: "memory"); \
                if (lane == 0) MISC[16] = (unsigned)m; \
            } \
            __syncthreads(); \
            S2.rdy = __builtin_amdgcn_readfirstlane(MISC[16]); \
        } else SEAM(pb + 1); \
        PHASE(pb + 2, { \
            pg8::Gemm g{(const pbf*)(ws + WS_ACT), (const pbf*)(ws + WS_W2 + (size_t)l * NE * D * D), D / 2, (size_t)D * D}; \
            pg8::EpiMoeOut<F8_Y != 0, YSCALE, LDSB != 0> E{(pbf*)(ws + WS_YS), args.in[I_BE2] + (size_t)l * NE * D, (const LAS float*)(lds + EXTRA_OFF + 14336)}; \
            pg8::gemm_phase<pg8::EpiMoeOut<F8_Y != 0, YSCALE, LDSB != 0>, pg8::MoeOrder, AEPI != 0, true, true, 0x79797979, 0x7D7D7D7D, false, G2_NS>(lds + RING_OFF, g, S2, E);   \
        }) \
    }
    bool xmap_ok = false;
    if (MOE_HANDOFF && !MOE_WT && G == 256 && lo == 0) {
        if (wave == 0) {
            const unsigned* xm = (const unsigned*)(ws + WS_CTL) + CW_XMAP; bool ok = true;
#pragma unroll
            for (int k = 0; k < 4; ++k) { const int b = lane + 64 * k; const unsigned mine = __hip_atomic_load(xm + b, __ATOMIC_RELAXED, __HIP_MEMORY_SCOPE_AGENT), cls = __hip_atomic_load(xm + (b & 7), __ATOMIC_RELAXED, __HIP_MEMORY_SCOPE_AGENT);
                ok = ok && mine != 0u && mine == cls; }
            const unsigned me = __hip_atomic_load(xm + (lane & 7), __ATOMIC_RELAXED, __HIP_MEMORY_SCOPE_AGENT);
#pragma unroll
            for (int j = 1; j < 8; ++j) { const unsigned other = (unsigned)__shfl((int)me, (lane + j) & 7); ok = ok && other != me; }
            const bool all_ok = __all(ok);
            if (lane == 0) MISC[17] = all_ok ? 1u : 0u;
        }
        __syncthreads();
        xmap_ok = __builtin_amdgcn_readfirstlane(MISC[17]) != 0u;
    }
    MOE_PHASES(0, PH_ROUTER0)
    PHASE(PH_COMB0, { p_combine<false>(args, lds, 0, lane, wave); })
    PHASE(PH_CVIN, {
        pg8::Gemm g{(const pbf*)(ws + WS_H), (const pbf*)(ws + WS_WCVIN), F8_MISC ? D / 2 : D, 0};
        pg8::TileOrder S; S.init(NTOK / 256, 2 * D / 256, G, bid, nullptr);
        pg8::EpiPair<1> E{(pbf*)(ws + WS_U), args.in[I_BCVIN]};
        pg8::gemm_phase<pg8::EpiPair<1>, pg8::TileOrder, AEPI != 0, true, F8_MISC != 0, 0x79797979, 0x7F7F7F7F>(lds + RING_OFF, g, S, E);
    })
    PHASE(PH_DWCONV, { p_dwconv(args, tid); })
    PHASE(PH_LN, { p_ln_silu(args, lane, wave); })
    PHASE(PH_CVOUT, {
        pg8::Gemm g{(const pbf*)(ws + WS_Z), (const pbf*)(ws + WS_WCVOUT), F8_MISC ? D / 2 : D, 0};
        pg8::TileOrder S; S.init(NTOK / 256, D / 256, G, bid, nullptr);
        pg8::EpiResGate<true, true> E{(const void*)(ws + WS_X), (void*)(ws + WS_X), (const float*)(ws + WS_MODS) + 3 * 6 * D + 2 * D, 6 * D, SEQ, args.in[I_BCVOUT]};
        pg8::gemm_phase<pg8::EpiResGate<true, true>, pg8::TileOrder, AEPI != 0, true, F8_MISC != 0, 0x79797979, 0x7D7D7D7D>(lds + RING_OFF, g, S, E);
    })
#ifndef CLK_PROBE
#define CLK_PROBE 0
#endif
#if CLK_PROBE
    if (bid == 0 && tid == 0) { const unsigned long long c = __builtin_amdgcn_s_memtime(), w = __builtin_amdgcn_s_memrealtime(); MISC[20] = (unsigned)c; MISC[21] = (unsigned)(c >> 32); MISC[22] = (unsigned)w; MISC[23] = (unsigned)(w >> 32); }
#endif
    MOE_PHASES(1, PH_ROUTER1)
#if CLK_PROBE
    if (bid == 0 && tid == 0) { const unsigned long long c = __builtin_amdgcn_s_memtime(), w = __builtin_amdgcn_s_memrealtime(); MISC[24] = (unsigned)c; MISC[25] = (unsigned)(c >> 32); MISC[26] = (unsigned)w; MISC[27] = (unsigned)(w >> 32); }
#endif
    if (IN(PH_FINAL)) { p_combine<true>(args, lds, 1, lane, wave); }
#if KL_PROBE
    static_assert(pg8::KLP_LDS == MISC_OFF + 4 * 28, "probe words");
    if (bid == 0 && tid == 0) {
        const unsigned long long kl = ((unsigned long long)MISC[29] << 32) | MISC[28]; const unsigned nun = MISC[30] ? MISC[30] : 1u;
        const unsigned long long tot = ((unsigned long long)MISC[37] << 32) | MISC[36];
        const unsigned long long ticks = KL_PROBE == 1 ? kl * 10ull / (8ull * nun) : (tot - kl) * 5ull / nun;
        const unsigned long long t_end = __builtin_amdgcn_s_memrealtime() + (ticks < 100000ull ? ticks : 100000ull);
        while (__builtin_amdgcn_s_memrealtime() < t_end) __builtin_amdgcn_s_sleep(8);
    }
#endif
#if TL_PROBE
    if (bid == 0 && tid == 0) { const unsigned ticks = MISC[48 + TL_B + 1] - MISC[48 + TL_A + 1]; const unsigned long long t_end = __builtin_amdgcn_s_memrealtime() + 2ull * (ticks < 200000u ? ticks : 200000u); while (__builtin_amdgcn_s_memrealtime() < t_end) __builtin_amdgcn_s_sleep(8); }
#endif
#if CVF_PROBE
    if (bid == 0 && tid == 0) { const unsigned long long t_end = __builtin_amdgcn_s_memrealtime() + 2ull * MISC[40]; while (__builtin_amdgcn_s_memrealtime() < t_end) __builtin_amdgcn_s_sleep(8); }
#endif
#if CLK_PROBE
    if (bid == 0 && tid == 0) {
        const unsigned long long c0 = ((unsigned long long)MISC[21] << 32) | MISC[20], w0 = ((unsigned long long)MISC[23] << 32) | MISC[22], c1 = ((unsigned long long)MISC[25] << 32) | MISC[24], w1 = ((unsigned long long)MISC[27] << 32) | MISC[26];
        const unsigned long long ticks = (c1 - c0) * 1000ull / (w1 - w0 + 1ull);
        const unsigned long long t_end = __builtin_amdgcn_s_memrealtime() + (ticks < 100000ull ? ticks : 100000ull);
        while (__builtin_amdgcn_s_memrealtime() < t_end) __builtin_amdgcn_s_sleep(8);
    }
#endif
#undef MOE_PHASES
#undef PHASE
#undef IN
#undef SEAM
}

extern "C" void kernel_launch(void* const* d_in, const int* in_sizes, int n_in, void* d_out, int out_size, void* d_ws, size_t ws_size, hipStream_t stream) {
    static int grid = 0;
    if (grid == 0) {
        if (n_in != N_IN || in_sizes[0] != NTOK * D || out_size != NTOK * D || ws_size < WS_END) { fprintf(stderr, "kernel_launch: unexpected shapes / workspace (n_in %d, in0 %d, out %d, ws %zu, need %zu); nothing launched\n", n_in, n_in > 0 ? in_sizes[0] : -1, out_size, ws_size, (size_t)WS_END); grid = -1; return; }
        int dev = 0, cus = 0, per_cu = 0;
        if (hipGetDevice(&dev) != hipSuccess || hipDeviceGetAttribute(&cus, hipDeviceAttributeMultiprocessorCount, dev) != hipSuccess) { grid = -1; return; }
        if (hipFuncSetAttribute((const void*)fwd_kernel, hipFuncAttributeMaxDynamicSharedMemorySize, LDS_BYTES) != hipSuccess) { fprintf(stderr, "kernel_launch: hipFuncSetAttribute failed\n"); grid = -1; return; }
        if (hipOccupancyMaxActiveBlocksPerMultiprocessor(&per_cu, (const void*)fwd_kernel, NTHR, LDS_BYTES) != hipSuccess || per_cu < 1) { fprintf(stderr, "kernel_launch: occupancy query reports %d workgroups per CU\n", per_cu); }
        (void)hipGetLastError();
        grid = cus;
    }
    if (grid < 0) return;
    if (hipMemsetAsync((char*)d_ws + WS_CTL, 0, CTL_ZERO_BYTES, stream) != hipSuccess) return;
#ifdef DIAG_MEMSET
    (void)hipMemsetAsync((char*)d_ws + WS_SP, 0, (WS_WIN - WS_SP), stream); (void)hipMemsetAsync((char*)d_ws + WS_OF, 0, (WS_YIN - WS_OF), stream);
#endif
    Args a{};
    for (int i = 0; i < N_IN; ++i) a.in[i] = (const float*)d_in[i];
    a.out = (float*)d_out; a.ws = (unsigned char*)d_ws; a.pad = 0;
#ifndef MK_CUTS
    a.ph_lo = 0; a.ph_hi = NPH; a.li = 0;
    hipLaunchKernelGGL(fwd_kernel, dim3(grid), dim3(NTHR), LDS_BYTES, stream, a);
#else
    const int cuts[] = {MK_CUTS};
    const int nc = (int)(sizeof(cuts) / sizeof(cuts[0]));
    for (int li = 0; li + 1 < nc; ++li) { a.ph_lo = cuts[li]; a.ph_hi = cuts[li + 1]; a.li = li; hipLaunchKernelGGL(fwd_kernel, dim3(grid), dim3(NTHR), LDS_BYTES, stream, a); }
#endif
}
```

```cpp
#include <hip/hip_runtime.h>
#include <cstdio>
#include <cstdint>
__device__ __forceinline__ void wg_sync_() { __builtin_amdgcn_fence(__ATOMIC_RELEASE, "workgroup"); __builtin_amdgcn_s_barrier(); __builtin_amdgcn_fence(__ATOMIC_ACQUIRE, "workgroup"); }
#define __syncthreads() wg_sync_()
#define __ballot(p) __builtin_amdgcn_ballot_w64((p) != 0)
#define __all(p) (__builtin_amdgcn_ballot_w64(!(p)) == 0ull)
#define __shfl(v, src) __builtin_amdgcn_ds_bpermute((int)(src) << 2, (int)(v))
#define __popcll(x) __builtin_popcountll(x)

namespace pg8 {
#define PG8_LAS __attribute__((address_space(3)))
typedef unsigned short bf16_t;
typedef short bf16x8 __attribute__((ext_vector_type(8)));
typedef float f32x4 __attribute__((ext_vector_type(4)));
typedef unsigned u32x4 __attribute__((ext_vector_type(4)));
typedef unsigned u32x2 __attribute__((ext_vector_type(2)));
typedef int i32x4 __attribute__((ext_vector_type(4)));
typedef int i32x8 __attribute__((ext_vector_type(8)));
#ifndef KL_PROBE
#define KL_PROBE 0
#endif
constexpr int KLP_LDS = 139264 + 320 + 4 * 28;
constexpr int BM = 256, BK = 64, HALF = 128, HTB = HALF * BK * 2  , STAGE_BYTES = 8 * HTB, NXCD = 8, WGM = 8;

__host__ __device__ __forceinline__ int lds_byte(int r, int c) { const int st = (r >> 4) * 2 + (c >> 5), rr = r & 15, cc = c & 31, ob = rr * 64 + cc * 2; return st * 1024 + (ob ^ (((ob >> 9) & 1) << 5)); }
__host__ __device__ __forceinline__ void stage_rc(int b, int& R, int& C) { const int st = b / 1024, sb = b % 1024, swz = sb ^ (((sb >> 9) & 1) << 5); R = (st >> 1) * 16 + swz / 64; C = (st & 1) * 32 + (swz % 64) / 2; }
__host__ __device__ __forceinline__ int perm32(int rho) { const int n = rho >> 4, i = rho & 15; return 8 * (i >> 2) + 4 * n + (i & 3); }

struct Unit { int pm, pn, e; };
struct Gemm { const bf16_t* A; const bf16_t* Bt; int K; size_t estride; const PG8_LAS unsigned short* tt; };

struct TileOrder {
    int nM, nN, nwg, G, c; const PG8_LAS int* tile_e;
    __device__ __forceinline__ void init(int nM_, int nN_, int G_, int c_, const PG8_LAS int* te) { nM = nM_; nN = nN_; nwg = nM * nN; G = G_; c = c_; tile_e = te; }
    __device__ __forceinline__ bool next(int i, Unit& u) const {
        const long L = (long)i * G + c; if (L >= nwg) return false;
        int wgid = (int)L; { const int q = nwg / NXCD, r = nwg % NXCD, xcd = wgid % NXCD, off = wgid / NXCD; wgid = (xcd < r ? xcd * (q + 1) : r * (q + 1) + (xcd - r) * q) + off; }
        const int nig = WGM * nN, gid = wgid / nig, fm = gid * WGM, gsz = (nM - fm) < WGM ? (nM - fm) : WGM;
        u.pm = fm + ((wgid % nig) % gsz); u.pn = (wgid % nig) / gsz;
        u.e = tile_e ? __builtin_amdgcn_readfirstlane(tile_e[u.pm]) : 0; return true;
    }
    static constexpr bool PUBLISH = false;
    __device__ __forceinline__ bool probe_on() const { return false; }
    __device__ __forceinline__ void a_ready(const Unit&, int) const {}
    __device__ __forceinline__ void done(const Unit&) const {}
    __device__ __forceinline__ void publish(int, int) const {}
};

struct MoeOrder {
    static constexpr bool PUBLISH = true;
    const PG8_LAS int* ut; int nu;
    unsigned* cnt; unsigned rdy; int mode;
    static __device__ __forceinline__ bool unit_of(int xl, int nM, int nN, int G, int c, int rrot, int i, int& pm, int& pn) {
        if (!xl) { TileOrder T; T.init(nM, nN, G, c, nullptr); Unit u; if (!T.next(i, u)) return false; pm = u.pm; pn = u.pn; return true; }
        const int v = c & 7, T0 = (v * nM) >> 3, Tv = (((v + 1) * nM) >> 3) - T0;
        const int Lx = i * 32 + rrot; if (Lx >= Tv * nN) return false;
        const int nig = WGM * nN, gid = Lx / nig, fm = gid * WGM, gsz = (Tv - fm) < WGM ? (Tv - fm) : WGM, w = Lx % nig;
        pm = T0 + fm + (w % gsz); pn = w / gsz; return true;
    }
    __device__ __forceinline__ bool next(int i, Unit& u) const {
        if (i >= nu) return false;
        const int v = __builtin_amdgcn_readfirstlane(ut[i]); u.pm = v & 0xFFFF; u.pn = (v >> 16) & 0xFF; u.e = (v >> 24) & 0xFF; return true;
    }
    __device__ __forceinline__ bool probe_on() const { return mode == 0; }
    __device__ __forceinline__ void done(const Unit&) const {}
    __device__ __forceinline__ void publish(int pm, int lane) const {
        if (mode == 0 && lane == 0) (void)__hip_atomic_fetch_add(cnt + 32 * pm, 1u, __ATOMIC_RELAXED, __HIP_MEMORY_SCOPE_AGENT);
    }
    __device__ __forceinline__ void a_ready(const Unit& u, int i) const {
        if (mode != 1 || ((rdy >> i) & 1u)) return;
        if (__builtin_amdgcn_readfirstlane(threadIdx.x >> 6) == 0) {
            unsigned sp = 0;
            while (__hip_atomic_load(cnt + 32 * u.pm, __ATOMIC_RELAXED, __HIP_MEMORY_SCOPE_AGENT) < 64u) { __builtin_amdgcn_s_sleep(1); if (++sp > (1u << 20)) break; }
            __builtin_amdgcn_fence(__ATOMIC_ACQUIRE, "agent");
            asm volatile("s_waitcnt vmcnt(0)" ::: "memory");
        }
        __builtin_amdgcn_s_barrier();
    }
};

struct OneUnit {
    int pm, pn;
    __device__ __forceinline__ bool next(int i, Unit& u) const { if (i != 0) return false; u.pm = pm; u.pn = pn; u.e = 0; return true; }
    static constexpr bool PUBLISH = false;
    __device__ __forceinline__ bool probe_on() const { return false; }
    __device__ __forceinline__ void a_ready(const Unit&, int) const {}
    __device__ __forceinline__ void done(const Unit&) const {}
    __device__ __forceinline__ void publish(int, int) const {}
};

__device__ __forceinline__ unsigned cvt_pk_bf16(float lo, float hi) { unsigned r; asm volatile("v_cvt_pk_bf16_f32 %0, %1, %2" : "=v"(r) : "v"(lo), "v"(hi)); return r; }
__device__ __forceinline__ float fsigmoid(float x) { return __builtin_amdgcn_rcpf(1.0f + __expf(-x)); }


struct EpiHgrnIn {
    static constexpr bool PERM = true, AFTER_DRAIN = false, LDS_BIAS = false;
    bf16_t* Q; size_t qstride; _Float16* LFF; size_t lfstride; const float* gamma; int mode;
    static __device__ __forceinline__ f32x4 vexp2(f32x4 t) { f32x4 e; e[0] = __builtin_amdgcn_exp2f(t[0]); e[1] = __builtin_amdgcn_exp2f(t[1]); e[2] = __builtin_amdgcn_exp2f(t[2]); e[3] = __builtin_amdgcn_exp2f(t[3]); return e; }
    static __device__ __forceinline__ f32x4 vrcp(f32x4 d) { f32x4 r; r[0] = __builtin_amdgcn_rcpf(d[0]); r[1] = __builtin_amdgcn_rcpf(d[1]); r[2] = __builtin_amdgcn_rcpf(d[2]); r[3] = __builtin_amdgcn_rcpf(d[3]); return r; }
    static __device__ __forceinline__ f32x4 vlog2(f32x4 d) { f32x4 r; r[0] = __builtin_amdgcn_logf(d[0]); r[1] = __builtin_amdgcn_logf(d[1]); r[2] = __builtin_amdgcn_logf(d[2]); r[3] = __builtin_amdgcn_logf(d[3]); return r; }
    __device__ __forceinline__ void operator()(const f32x4 (&acc)[2][2][4][2], const Unit& u, int wr, int wc, int fr, int fq) const {
        const int sg_ = u.pn >> 2, seg = mode == 0 ? sg_ : (mode == 1 ? (sg_ < 2 ? sg_ : 4) : 2 + sg_), cb = (u.pn & 3) * 256 + wc * 32 + 8 * fq;
        const int row0 = u.pm * BM + wr * 64 + fr;
        if (seg == 2 || seg == 3) {
            _Float16* O = LFF + (size_t)(seg - 2) * lfstride; const float* g0 = gamma + (seg - 2) * 2048 + cb;
            f32x4 lb[2][2];
#pragma unroll
            for (int bj = 0; bj < 2; ++bj)
#pragma unroll
                for (int n = 0; n < 2; ++n) { const f32x4 d = *(const f32x4*)(g0 + bj * HALF + 4 * n) - *(const f32x4*)(g0 + 1024 + bj * HALF + 4 * n);
                    lb[bj][n] = vrcp(vexp2(d * -1.4426950408889634f) + 1.0f); }
#pragma unroll
            for (int ai = 0; ai < 2; ++ai)
#pragma unroll
                for (int m = 0; m < 4; ++m) { _Float16* rowp = O + (size_t)(row0 + ai * HALF + m * 16) * 1024 + cb;
#pragma unroll
                    for (int bj = 0; bj < 2; ++bj) { typedef _Float16 h16x8 __attribute__((ext_vector_type(8))); h16x8 o;
#pragma unroll
                        for (int n = 0; n < 2; ++n) { const f32x4 sg = vrcp(vexp2(acc[ai][bj][m][n] * -1.4426950408889634f) + 1.0f);
                            const f32x4 lf = vlog2(lb[bj][n] + (1.0f - lb[bj][n]) * sg) * 0.6931471805599453f;
                            o[4 * n + 0] = (_Float16)lf[0]; o[4 * n + 1] = (_Float16)lf[1]; o[4 * n + 2] = (_Float16)lf[2]; o[4 * n + 3] = (_Float16)lf[3]; }
                        *(h16x8*)(rowp + bj * HALF) = o; } }
        } else {
            bf16_t* O = Q + (size_t)(seg - (seg >> 2) * 2) * qstride;
#pragma unroll
            for (int ai = 0; ai < 2; ++ai)
#pragma unroll
                for (int m = 0; m < 4; ++m) { bf16_t* rowp = O + (size_t)(row0 + ai * HALF + m * 16) * 1024 + cb;
#pragma unroll
                    for (int bj = 0; bj < 2; ++bj) { f32x4 v0 = acc[ai][bj][m][0], v1 = acc[ai][bj][m][1];
                        if (seg == 4) { v0 = v0 * vrcp(vexp2(v0 * -1.4426950408889634f) + 1.0f); v1 = v1 * vrcp(vexp2(v1 * -1.4426950408889634f) + 1.0f); }
                        u32x4 w; w.x = cvt_pk_bf16(v0[0], v0[1]); w.y = cvt_pk_bf16(v0[2], v0[3]); w.z = cvt_pk_bf16(v1[0], v1[1]); w.w = cvt_pk_bf16(v1[2], v1[3]);
                        *(u32x4*)(rowp + bj * HALF) = w; } }
        }
    }
};
template <bool B16> struct RawOf { typedef u32x4 T; };
template <> struct RawOf<true> { typedef u32x2 T; };
template <bool BASE16, bool OUT16> struct EpiResGate {
    static constexpr bool PERM = false, AFTER_DRAIN = false, LDS_BIAS = false;
    const void* base; void* out; const float* gate; int gate_bstride; int rows_per_batch; const float* bias;
    __device__ __forceinline__ void operator()(const f32x4 (&acc)[2][2][4][2], const Unit& u, int wr, int wc, int fr, int fq) const {
        const int row0 = u.pm * BM + wr * 64 + fr, col0 = u.pn * BM + wc * 32 + 4 * fq;
        const float* gv_ = gate + (size_t)((u.pm * BM) / rows_per_batch) * gate_bstride;
        f32x4 gv[2][2], bv[2][2];
#pragma unroll
        for (int bj = 0; bj < 2; ++bj)
#pragma unroll
            for (int n = 0; n < 2; ++n) { gv[bj][n] = *(const f32x4*)(gv_ + col0 + bj * HALF + n * 16); bv[bj][n] = bias ? *(const f32x4*)(bias + col0 + bj * HALF + n * 16) : (f32x4){0.f, 0.f, 0.f, 0.f}; }
        typedef typename RawOf<BASE16>::T raw_t;
        raw_t rb[2][8];
#define ERG_LOAD(b_, dst_) do { _Pragma("unroll") for (int mm = 0; mm < 2; ++mm) _Pragma("unroll") for (int bj = 0; bj < 2; ++bj) _Pragma("unroll") for (int n = 0; n < 2; ++n) { \
            const size_t o = (size_t)(row0 + ((b_) >> 1) * HALF + (2 * ((b_) & 1) + mm) * 16) * 1024 + col0 + bj * HALF + n * 16; \
            if constexpr (BASE16) dst_[mm * 4 + bj * 2 + n] = *(const raw_t*)((const bf16_t*)base + o); else dst_[mm * 4 + bj * 2 + n] = *(const raw_t*)((const float*)base + o); } } while (0)
        ERG_LOAD(0, rb[0]);
#pragma unroll
        for (int b = 0; b < 4; ++b) {
            if (b < 3) ERG_LOAD(b + 1, rb[(b + 1) & 1]);
            const int ai = b >> 1;
#pragma unroll
            for (int mm = 0; mm < 2; ++mm) { const int m = 2 * (b & 1) + mm;
#pragma unroll
                for (int bj = 0; bj < 2; ++bj)
#pragma unroll
                    for (int n = 0; n < 2; ++n) { const size_t o = (size_t)(row0 + ai * HALF + m * 16) * 1024 + col0 + bj * HALF + n * 16; f32x4 bs; const raw_t w = rb[b & 1][mm * 4 + bj * 2 + n];
                        if constexpr (BASE16) bs = (f32x4){__builtin_bit_cast(float, w[0] << 16), __builtin_bit_cast(float, w[0] & 0xffff0000u), __builtin_bit_cast(float, w[1] << 16), __builtin_bit_cast(float, w[1] & 0xffff0000u)};
                        else bs = __builtin_bit_cast(f32x4, w);
                        const f32x4 r = bs + gv[bj][n] * (acc[ai][bj][m][n] + bv[bj][n]);
                        if constexpr (OUT16) *(u32x2*)((bf16_t*)out + o) = (u32x2){cvt_pk_bf16(r[0], r[1]), cvt_pk_bf16(r[2], r[3])};
                        else *(f32x4*)((float*)out + o) = r; } }
        }
#undef ERG_LOAD
    }
};
template <int MODE, bool OUT8 = false, int OSCALE = 1, bool WT = false, bool LB = false> struct EpiPair {
    static constexpr bool PERM = true, AFTER_DRAIN = false, LDS_BIAS = LB;
    bf16_t* O; const float* bias0; const PG8_LAS float* lb;
    __device__ __forceinline__ void stage_bias(const Unit& u, int lane) const {
        const float* src = bias0 + (MODE == 0 ? (size_t)u.e * 2048 : 0) + (lane < 32 ? 0 : 1024 - 128) + u.pn * HALF + lane * 4;
        __builtin_amdgcn_global_load_lds((const unsigned*)src, (PG8_LAS unsigned*)lb, 16, 0, 0);
    }
    static __device__ __forceinline__ f32x4 vsig(f32x4 x, float negscale) {
        const f32x4 t = x * negscale; f32x4 e; e[0] = __builtin_amdgcn_exp2f(t[0]); e[1] = __builtin_amdgcn_exp2f(t[1]); e[2] = __builtin_amdgcn_exp2f(t[2]); e[3] = __builtin_amdgcn_exp2f(t[3]);
        const f32x4 d = e + 1.0f; f32x4 r; r[0] = __builtin_amdgcn_rcpf(d[0]); r[1] = __builtin_amdgcn_rcpf(d[1]); r[2] = __builtin_amdgcn_rcpf(d[2]); r[3] = __builtin_amdgcn_rcpf(d[3]); return r; }
    __device__ __forceinline__ void operator()(const f32x4 (&acc)[2][2][4][2], const Unit& u, int wr, int wc, int fr, int fq) const {
        const float* bias = bias0 + (MODE == 0 ? (size_t)u.e * 2048 : 0);
        const int row0 = u.pm * BM + wr * 64 + fr, cg = u.pn * HALF + wc * 32 + 8 * fq;
        f32x4 b0[2], b1[2];
#pragma unroll
        for (int n = 0; n < 2; ++n) {
            if constexpr (LB) { b0[n] = *(const PG8_LAS f32x4*)(lb + wc * 32 + 8 * fq + 4 * n); b1[n] = *(const PG8_LAS f32x4*)(lb + 128 + wc * 32 + 8 * fq + 4 * n); }
            else { b0[n] = *(const f32x4*)(bias + cg + 4 * n); b1[n] = *(const f32x4*)(bias + 1024 + cg + 4 * n); } }
#pragma unroll
        for (int ai = 0; ai < 2; ++ai)
#pragma unroll
            for (int m = 0; m < 4; ++m) { bf16_t* rowp = O + (size_t)(row0 + ai * HALF + m * 16) * 1024 + cg; f32x4 r[2];
#pragma unroll
                for (int n = 0; n < 2; ++n) { const f32x4 g = acc[ai][0][m][n] + b0[n], up = acc[ai][1][m][n] + b1[n];
                    if (MODE == 0) { const f32x4 gg = __builtin_elementwise_min(g, (f32x4){7.0f, 7.0f, 7.0f, 7.0f});
                        const f32x4 uu = __builtin_elementwise_min(__builtin_elementwise_max(up, (f32x4){-7.0f, -7.0f, -7.0f, -7.0f}), (f32x4){7.0f, 7.0f, 7.0f, 7.0f});
                        r[n] = (uu * (float)OSCALE + (float)OSCALE) * (gg * vsig(gg, -1.702f * 1.4426950408889634f)); }
                    else r[n] = (g * (float)OSCALE) * vsig(up, -1.4426950408889634f); }
                if constexpr (OUT8) {
                    int w0 = 0, w1 = 0;
                    w0 = __builtin_amdgcn_cvt_pk_fp8_f32(r[0][0], r[0][1], w0, false); w0 = __builtin_amdgcn_cvt_pk_fp8_f32(r[0][2], r[0][3], w0, true);
                    w1 = __builtin_amdgcn_cvt_pk_fp8_f32(r[1][0], r[1][1], w1, false); w1 = __builtin_amdgcn_cvt_pk_fp8_f32(r[1][2], r[1][3], w1, true);
                    if constexpr (WT) __hip_atomic_store((unsigned long long*)((unsigned char*)O + (size_t)(row0 + ai * HALF + m * 16) * 1024 + cg), ((unsigned long long)(unsigned)w1 << 32) | (unsigned)w0, __ATOMIC_RELAXED, __HIP_MEMORY_SCOPE_AGENT);
                    else *(u32x2*)((unsigned char*)O + (size_t)(row0 + ai * HALF + m * 16) * 1024 + cg) = (u32x2){(unsigned)w0, (unsigned)w1};
                } else {
                u32x4 w; w.x = cvt_pk_bf16(r[0][0], r[0][1]); w.y = cvt_pk_bf16(r[0][2], r[0][3]); w.z = cvt_pk_bf16(r[1][0], r[1][1]); w.w = cvt_pk_bf16(r[1][2], r[1][3]);
                *(u32x4*)rowp = w; } }
    }
};
template <bool OUT8, int OSCALE, bool LB = false> struct EpiMoeOut {
    static constexpr bool PERM = true, AFTER_DRAIN = false, LDS_BIAS = LB;
    bf16_t* O; const float* bias0; const PG8_LAS float* lb;
    __device__ __forceinline__ void stage_bias(const Unit& u, int lane) const {
        __builtin_amdgcn_global_load_lds((const unsigned*)(bias0 + (size_t)u.e * 1024 + u.pn * BM + lane * 4), (PG8_LAS unsigned*)lb, 16, 0, 0);
    }
    __device__ __forceinline__ void operator()(const f32x4 (&acc)[2][2][4][2], const Unit& u, int wr, int wc, int fr, int fq) const {
        const float* bias = bias0 + (size_t)u.e * 1024;
        const int row0 = u.pm * BM + wr * 64 + fr, col0 = u.pn * BM + wc * 32 + 8 * fq;
        f32x4 bv[2][2];
#pragma unroll
        for (int bj = 0; bj < 2; ++bj)
#pragma unroll
            for (int n = 0; n < 2; ++n) {
                if constexpr (LB) bv[bj][n] = *(const PG8_LAS f32x4*)(lb + wc * 32 + 8 * fq + bj * HALF + 4 * n);
                else bv[bj][n] = *(const f32x4*)(bias + col0 + bj * HALF + 4 * n); }
#pragma unroll
        for (int ai = 0; ai < 2; ++ai)
#pragma unroll
            for (int m = 0; m < 4; ++m) { const int r = row0 + ai * HALF + m * 16;
#pragma unroll
                for (int bj = 0; bj < 2; ++bj) { const f32x4 v0 = acc[ai][bj][m][0] + bv[bj][0], v1 = acc[ai][bj][m][1] + bv[bj][1];
                    if constexpr (OUT8) { const f32x4 lim = (f32x4){448.0f, 448.0f, 448.0f, 448.0f};
                        const f32x4 s0 = __builtin_elementwise_min(__builtin_elementwise_max(v0 * (float)OSCALE, -lim), lim), s1 = __builtin_elementwise_min(__builtin_elementwise_max(v1 * (float)OSCALE, -lim), lim); int w0 = 0, w1 = 0;
                        w0 = __builtin_amdgcn_cvt_pk_fp8_f32(s0[0], s0[1], w0, false); w0 = __builtin_amdgcn_cvt_pk_fp8_f32(s0[2], s0[3], w0, true);
                        w1 = __builtin_amdgcn_cvt_pk_fp8_f32(s1[0], s1[1], w1, false); w1 = __builtin_amdgcn_cvt_pk_fp8_f32(s1[2], s1[3], w1, true);
                        *(u32x2*)((unsigned char*)O + (size_t)r * 1024 + col0 + bj * HALF) = (u32x2){(unsigned)w0, (unsigned)w1};
                    } else { u32x4 w; w.x = cvt_pk_bf16(v0[0], v0[1]); w.y = cvt_pk_bf16(v0[2], v0[3]); w.z = cvt_pk_bf16(v1[0], v1[1]); w.w = cvt_pk_bf16(v1[2], v1[3]);
                        *(u32x4*)(O + (size_t)r * 1024 + col0 + bj * HALF) = w; } } }
    }
};

template <class Epi, class Sched, bool ALIGN_EPI = false, bool SP2 = false, bool F8 = false, int SCW = 0x7F7F7F7F, int SCA = 0x7F7F7F7F, bool GATHER = false, int NS = 0, bool ZC = F8>
__device__ __forceinline__ void gemm_phase(PG8_LAS unsigned char* lds, const Gemm g, const Sched& S, const Epi& E) {
    const int tid = threadIdx.x, wid = __builtin_amdgcn_readfirstlane(tid >> 6), lane = tid & 63, wr = wid >> 2, wc = wid & 3, fr = lane & 15, fq = lane >> 4;
    const int K = g.K, nt = K / BK;
    unsigned voffA[2], voffB[2]; int stR[2], stC[2];
#pragma unroll
    for (int i = 0; i < 2; ++i) { int R, C; stage_rc(tid * 16 + i * 8192, R, C); const int Rb = Epi::PERM ? ((R & ~31) + perm32(R & 31)) : R; stR[i] = R; stC[i] = C;
        voffA[i] = (unsigned)(R * K + C) * 2u; voffB[i] = (unsigned)(Rb * K + C) * 2u; }
    const size_t kstep = (size_t)(BK * 2);
    const size_t hstep = (size_t)HALF * K * 2;
    const size_t tstep = 2 * hstep;
    unsigned vc[2][2], vn[2][2];
#pragma unroll
    for (int h = 0; h < 2; ++h)
#pragma unroll
        for (int i = 0; i < 2; ++i) {
            if constexpr (GATHER) vc[h][i] = (unsigned)g.tt[h * HALF + stR[i]] * (unsigned)(K * 2) + (unsigned)stC[i] * 2u;
            else vc[h][i] = voffA[i] + (unsigned)h * (unsigned)hstep;
            vn[h][i] = vc[h][i]; }
    const unsigned ldsw = (unsigned)wid * 1024u;
    const int aoff = lds_byte(wr * 64 + fr, fq * 8), boff = lds_byte(wc * 32 + fr, fq * 8);
#define PG8_SA(b, h) (((b) * 2 + (h)) * HTB)
#define PG8_SB(b, h) ((4 + (b) * 2 + (h)) * HTB)
#define PG8_STAGE(bufoff, gbase, voff) do { _Pragma("unroll") for (int _i = 0; _i < 2; ++_i) \
        __builtin_amdgcn_global_load_lds((const unsigned*)((const char*)(gbase) + (voff)[_i]), (PG8_LAS unsigned*)(lds + (bufoff) + ldsw + _i * 8192), 16, 0, 0); } while (0)
#define PG8_LDA(dst, b, h) do { _Pragma("unroll") for (int m = 0; m < 4; ++m) _Pragma("unroll") for (int k = 0; k < 2; ++k) dst[m][k] = *(const PG8_LAS bf16x8*)(lds + PG8_SA(b, h) + aoff + m * 2048 + k * 1024); } while (0)
#define PG8_LDB(dst, b, h) do { _Pragma("unroll") for (int n = 0; n < 2; ++n) _Pragma("unroll") for (int k = 0; k < 2; ++k) dst[n][k] = *(const PG8_LAS bf16x8*)(lds + PG8_SB(b, h) + boff + n * 2048 + k * 1024); } while (0)
#define PG8_MMA(ai, bj, At, Bt) do { __builtin_amdgcn_s_setprio(1); \
        if constexpr (!F8) { _Pragma("unroll") for (int m = 0; m < 4; ++m) _Pragma("unroll") for (int n = 0; n < 2; ++n) _Pragma("unroll") for (int k = 0; k < 2; ++k) \
            acc[ai][bj][m][n] = __builtin_amdgcn_mfma_f32_16x16x32_bf16(Bt[n][k], At[m][k], acc[ai][bj][m][n], 0, 0, 0); } \
        else { const int scw_ = SCW, sca_ = SCA; _Pragma("unroll") for (int m = 0; m < 4; ++m) _Pragma("unroll") for (int n = 0; n < 2; ++n) { \
            const i32x8 wf_ = __builtin_shufflevector(__builtin_bit_cast(i32x4, Bt[n][0]), __builtin_bit_cast(i32x4, Bt[n][1]), 0, 1, 2, 3, 4, 5, 6, 7); \
            const i32x8 af_ = __builtin_shufflevector(__builtin_bit_cast(i32x4, At[m][0]), __builtin_bit_cast(i32x4, At[m][1]), 0, 1, 2, 3, 4, 5, 6, 7); \
            asm volatile("v_mfma_scale_f32_16x16x128_f8f6f4 %0, %1, %2, %0, %3, %4 op_sel_hi:[0,0,0]" : "+v"(acc[ai][bj][m][n]) : "v"(wf_), "v"(af_), "v"(scw_), "v"(sca_)); } } \
        __builtin_amdgcn_s_setprio(0); } while (0)
#define PG8_MMAZ(ai, bj, At, Bt) do { __builtin_amdgcn_s_setprio(1); \
        if constexpr (!F8) { _Pragma("unroll") for (int m = 0; m < 4; ++m) _Pragma("unroll") for (int n = 0; n < 2; ++n) { \
            acc[ai][bj][m][n] = __builtin_amdgcn_mfma_f32_16x16x32_bf16(Bt[n][0], At[m][0], (f32x4){0.f, 0.f, 0.f, 0.f}, 0, 0, 0); \
            acc[ai][bj][m][n] = __builtin_amdgcn_mfma_f32_16x16x32_bf16(Bt[n][1], At[m][1], acc[ai][bj][m][n], 0, 0, 0); } } \
        else { const int scw_ = SCW, sca_ = SCA; _Pragma("unroll") for (int m = 0; m < 4; ++m) _Pragma("unroll") for (int n = 0; n < 2; ++n) { \
            const i32x8 wf_ = __builtin_shufflevector(__builtin_bit_cast(i32x4, Bt[n][0]), __builtin_bit_cast(i32x4, Bt[n][1]), 0, 1, 2, 3, 4, 5, 6, 7); \
            const i32x8 af_ = __builtin_shufflevector(__builtin_bit_cast(i32x4, At[m][0]), __builtin_bit_cast(i32x4, At[m][1]), 0, 1, 2, 3, 4, 5, 6, 7); \
            asm volatile("v_mfma_scale_f32_16x16x128_f8f6f4 %0, %1, %2, 0, %3, %4 op_sel_hi:[0,0,0]" : "=&v"(acc[ai][bj][m][n]) : "v"(wf_), "v"(af_), "v"(scw_), "v"(sca_)); } } \
        __builtin_amdgcn_s_setprio(0); } while (0)
#define PG8_WAIT_V(n) asm volatile("s_waitcnt vmcnt(" #n ")" ::: "memory")
#define PG8_WAIT_VN(n) asm volatile("s_waitcnt vmcnt(%0)" :: "n"(n) : "memory")
#define PG8_WAIT_L(n) asm volatile("s_waitcnt lgkmcnt(" #n ")" ::: "memory")
#define PG8_BAR __builtin_amdgcn_s_barrier()
#define PG8_SCHED __builtin_amdgcn_sched_barrier(0)
    Unit cur, nxt; int ui = 0, ppm = 0;
    if (!S.next(0, cur)) return;
#if KL_PROBE
    if (Sched::PUBLISH && S.probe_on() && blockIdx.x == 0 && wid == 0) { const unsigned long long t0_ = __builtin_amdgcn_s_memtime(); if (lane == 0) { PG8_LAS unsigned* kp = (PG8_LAS unsigned*)(unsigned)KLP_LDS; kp[6] = (unsigned)t0_; kp[7] = (unsigned)(t0_ >> 32); } }
#endif
    static_assert(SP2, "this build keeps only the SP2 K-loop");
    f32x4 acc[2][2][4][2];
    if constexpr (!ZC) {
#pragma unroll
    for (int a = 0; a < 2; ++a)
#pragma unroll
        for (int b = 0; b < 2; ++b)
#pragma unroll
            for (int m = 0; m < 4; ++m)
#pragma unroll
                for (int n = 0; n < 2; ++n) acc[a][b][m][n] = (f32x4){0.f, 0.f, 0.f, 0.f};
    }
    bf16x8 At[4][2], B0[2][2], B1[2][2];
    const char* cA = (const char*)g.A + (GATHER ? (size_t)0 : (size_t)cur.pm * tstep); const char* cB = (const char*)g.Bt + (size_t)cur.e * g.estride + (size_t)cur.pn * tstep;
    S.a_ready(cur, 0);
    if constexpr (SP2) {
        PG8_STAGE(PG8_SB(0, 0), cB, voffB); PG8_STAGE(PG8_SB(0, 1), cB + hstep, voffB); PG8_STAGE(PG8_SA(0, 0), cA, vc[0]); PG8_STAGE(PG8_SA(0, 1), cA, vc[1]);
        if (wr == 1) PG8_BAR;
        PG8_WAIT_V(2); PG8_BAR;
        PG8_STAGE(PG8_SB(1, 0), cB + kstep, voffB); PG8_STAGE(PG8_SA(1, 0), cA + kstep, vc[0]); PG8_STAGE(PG8_SB(1, 1), cB + hstep + kstep, voffB);
        PG8_WAIT_V(6); PG8_BAR;
    } else {
        PG8_STAGE(PG8_SB(0, 0), cB, voffB); PG8_STAGE(PG8_SA(0, 0), cA, vc[0]); PG8_STAGE(PG8_SB(0, 1), cB + hstep, voffB); PG8_STAGE(PG8_SA(0, 1), cA, vc[1]);
        if (wr == 1) PG8_BAR;
        PG8_WAIT_V(4); PG8_BAR;
        PG8_STAGE(PG8_SB(1, 0), cB + kstep, voffB); PG8_STAGE(PG8_SA(1, 0), cA + kstep, vc[0]); PG8_STAGE(PG8_SB(1, 1), cB + hstep + kstep, voffB);
        PG8_WAIT_V(6); PG8_BAR;
    }
    for (;;) {
        const bool has_next = S.next(ui + 1, nxt);
        if constexpr (GATHER) { if (has_next) {
#pragma unroll
            for (int h = 0; h < 2; ++h)
#pragma unroll
                for (int i = 0; i < 2; ++i) vn[h][i] = (unsigned)g.tt[(ui + 1) * BM + h * HALF + stR[i]] * (unsigned)(K * 2) + (unsigned)stC[i] * 2u; } }
        const char* nA = (has_next && !GATHER) ? (const char*)g.A + (size_t)nxt.pm * tstep : cA; const char* nB = has_next ? (const char*)g.Bt + (size_t)nxt.e * g.estride + (size_t)nxt.pn * tstep : cB;
#if KL_PROBE
        if (Sched::PUBLISH && S.probe_on() && blockIdx.x == 0 && wid == 0) { const unsigned long long t0_ = __builtin_amdgcn_s_memtime(); if (lane == 0) { PG8_LAS unsigned* kp = (PG8_LAS unsigned*)(unsigned)KLP_LDS; kp[4] = (unsigned)t0_; kp[5] = (unsigned)(t0_ >> 32); } }
#endif
#define PG8_WAIT_V8R do { if constexpr (NS > 0) { PG8_WAIT_VN(8 + NS); if (!rlx) PG8_WAIT_V(8); } else PG8_WAIT_V(8); } while (0)
#define PG8_TRIP(MMAK_, FIRST_) { \
            const bool last = (t == nt - 2); \
            unsigned vs[2][2]; \
            _Pragma("unroll") for (int h = 0; h < 2; ++h) _Pragma("unroll") for (int i = 0; i < 2; ++i) vs[h][i] = (GATHER && last) ? vn[h][i] : vc[h][i]; \
            const char* a1 = cA + (size_t)(t + 1) * kstep;                                             \
            const char* a2 = last ? nA : cA + (size_t)(t + 2) * kstep; const char* b2 = last ? nB : cB + (size_t)(t + 2) * kstep;     \
            const char* a3 = a2 + kstep; const char* b3 = b2 + kstep;                                \
            if (last && has_next) S.a_ready(nxt, ui + 1); \
            if constexpr (Epi::LDS_BIAS) { if (last && wid == 0) E.stage_bias(cur, lane); }     \
            if constexpr (Sched::PUBLISH) { if (t == 2 && ui > 0) S.publish(ppm, lane); }     \
            const bool rlx = (NS > 0) && (FIRST_) && (ui > 0); \
              \
            PG8_LDB(B0, 0, 0); PG8_LDB(B1, 0, 1); PG8_SCHED; PG8_LDA(At, 0, 0); if (!rlx) PG8_STAGE(PG8_SA(1, 1), a1, vc[1]); \
            PG8_WAIT_V8R; PG8_WAIT_L(0); PG8_BAR; MMAK_(0, 0, At, B0); MMAK_(0, 1, At, B1); PG8_BAR; PG8_SCHED; \
              \
            PG8_LDA(At, 0, 1); PG8_STAGE(PG8_SB(0, 0), b2, voffB); PG8_STAGE(PG8_SB(0, 1), b2 + hstep, voffB); PG8_STAGE(PG8_SA(0, 0), a2, vs[0]); \
            PG8_WAIT_V8R; PG8_WAIT_L(0); PG8_BAR; MMAK_(1, 0, At, B0); MMAK_(1, 1, At, B1); PG8_BAR; PG8_SCHED; \
              \
            PG8_LDB(B0, 1, 0); PG8_LDB(B1, 1, 1); PG8_SCHED; PG8_LDA(At, 1, 0); PG8_STAGE(PG8_SA(0, 1), a2, vs[1]); \
            PG8_WAIT_V8R; PG8_WAIT_L(0); PG8_BAR; PG8_MMA(0, 0, At, B0); PG8_MMA(0, 1, At, B1); PG8_BAR; PG8_SCHED; \
              \
            PG8_LDA(At, 1, 1); PG8_STAGE(PG8_SB(1, 0), b3, voffB); PG8_STAGE(PG8_SB(1, 1), b3 + hstep, voffB); PG8_STAGE(PG8_SA(1, 0), a3, vs[0]); \
            PG8_WAIT_V(8); PG8_WAIT_L(0); PG8_BAR; PG8_MMA(1, 0, At, B0); PG8_MMA(1, 1, At, B1); PG8_BAR; PG8_SCHED; }
        if constexpr (ZC) {
            { const int t = 0; PG8_TRIP(PG8_MMAZ, true) }
            for (int t = 2; t < nt; t += 2) PG8_TRIP(PG8_MMA, false)
        } else {
            for (int t = 0; t < nt; t += 2) PG8_TRIP(PG8_MMA, t == 0)
        }
#if KL_PROBE
        if (Sched::PUBLISH && S.probe_on() && blockIdx.x == 0 && wid == 0) { const unsigned long long t1_ = __builtin_amdgcn_s_memtime(); if (lane == 0) { PG8_LAS unsigned* kp = (PG8_LAS unsigned*)(unsigned)KLP_LDS; const unsigned long long d = t1_ - (((unsigned long long)kp[5] << 32) | kp[4]); const unsigned long long acc_ = (((unsigned long long)kp[1] << 32) | kp[0]) + d; kp[0] = (unsigned)acc_; kp[1] = (unsigned)(acc_ >> 32); kp[2] += 1u; } }
#endif
        if constexpr (ALIGN_EPI) { if (wr == 0) PG8_BAR; }
        if constexpr (NS > 0) { static_assert(SP2 && ALIGN_EPI, "NS needs SP2 and ALIGN_EPI"); if (has_next) PG8_STAGE(PG8_SA(1, 1), nA + kstep, vn[1]); }
        if constexpr (!Epi::AFTER_DRAIN) { E(acc, cur, wr, wc, fr, fq); S.done(cur); ppm = cur.pm; }
        if (!has_next) break;
        if constexpr (!ZC) {
#pragma unroll
        for (int a = 0; a < 2; ++a)
#pragma unroll
            for (int b = 0; b < 2; ++b)
#pragma unroll
                for (int m = 0; m < 4; ++m)
#pragma unroll
                    for (int n = 0; n < 2; ++n) acc[a][b][m][n] = (f32x4){0.f, 0.f, 0.f, 0.f};
        }
        cur = nxt; cA = nA; cB = nB; ++ui;
        if constexpr (GATHER) {
#pragma unroll
            for (int h = 0; h < 2; ++h)
#pragma unroll
                for (int i = 0; i < 2; ++i) vc[h][i] = vn[h][i]; }
        if constexpr (ALIGN_EPI) { if (wr == 1) PG8_BAR; }
    }
#if KL_PROBE
    if (Sched::PUBLISH && S.probe_on() && blockIdx.x == 0 && wid == 0) { const unsigned long long t1_ = __builtin_amdgcn_s_memtime(); if (lane == 0) { PG8_LAS unsigned* kp = (PG8_LAS unsigned*)(unsigned)KLP_LDS; const unsigned long long d = t1_ - (((unsigned long long)kp[7] << 32) | kp[6]); const unsigned long long acc_ = (((unsigned long long)kp[9] << 32) | kp[8]) + d; kp[8] = (unsigned)acc_; kp[9] = (unsigned)(acc_ >> 32); } }
#endif
    PG8_WAIT_V(0); if constexpr (Sched::PUBLISH) S.publish(ppm, lane);
    if constexpr (!ALIGN_EPI) { if (wr == 0) PG8_BAR; }
    PG8_BAR;
    if constexpr (Epi::AFTER_DRAIN) { E.fused(acc, cur, wr, wc, fr, fq, lds, wid, lane); S.done(cur); }
#undef PG8_SA
#undef PG8_SB
#undef PG8_STAGE
#undef PG8_LDA
#undef PG8_LDB
#undef PG8_MMA
#undef PG8_MMAZ
#undef PG8_TRIP
#undef PG8_WAIT_V
#undef PG8_WAIT_VN
#undef PG8_WAIT_V8R
#undef PG8_WAIT_L
#undef PG8_BAR
#undef PG8_SCHED
}
}


constexpr int D = 1024, NBATCH = 2, SEQ = 16384, NTOK = NBATCH * SEQ, CTXL = 256, NCTX = NBATCH * CTXL, MROWS = NTOK + NCTX;
constexpr int NHEAD = 8, DK = 128, NE = 32, TOPK = 4, CONVW = 31, GRIDW = 64, GRIDR = SEQ / GRIDW;
constexpr int NWAVES = 8, NTHR = NWAVES * 64;
constexpr int MAXTILES = 544;
constexpr float EPS = 1e-6f;
enum { I_X = 0, I_C, I_CTX, I_CCTX, I_WADA, I_BADA, I_GMIX, I_GFFN, I_WHIN, I_HGAMMA, I_GHOUT, I_WHOUT, I_WCVIN, I_BCVIN, I_WCVDW, I_BCVDW, I_GCVLN, I_BCVLN, I_WCVOUT, I_BCVOUT,
       I_WR, I_BR, I_WE1, I_BE1, I_WE2, I_BE2, I_GFINAL, N_IN };

constexpr size_t MiB = 1u << 20;
constexpr size_t WS_CTL = 0, CTL_ZERO_BYTES = 1 * MiB;
constexpr size_t WS_MODS = 1 * MiB;
constexpr size_t WS_TOPE = 2 * MiB, WS_TOPW = 2 * MiB + 512 * 1024, WS_POS = 3 * MiB, WS_BCNT = 3 * MiB + 512 * 1024, WS_TILEE = WS_BCNT + 64 * 1024, WS_SLOTW = 4 * MiB;
constexpr size_t WS_SP = 5 * MiB, WS_SD = 8 * MiB;
constexpr size_t WS_WIN = 48 * MiB, WS_WOUT = 58 * MiB, WS_WCVIN = 60 * MiB, WS_WCVOUT = 64 * MiB, WS_W1 = 66 * MiB, WS_W2 = 322 * MiB;
constexpr size_t WS_X = 450 * MiB;
constexpr size_t WS_H = 578 * MiB;
constexpr size_t WS_Q = 644 * MiB, WS_V = 709 * MiB, WS_SG = 774 * MiB, WS_LFF = 839 * MiB, WS_LFB = 969 * MiB, WS_OF = 1099 * MiB, WS_OB = 1227 * MiB, WS_YIN = 1355 * MiB;
constexpr size_t WS_AS = 1419 * MiB, WS_ACT = 1555 * MiB, WS_YS = 1691 * MiB, WS_END = 1963 * MiB;
#ifndef F8_IN
#define F8_IN 0
#endif
#ifndef SPLIT_IN
#define SPLIT_IN 1
#endif
#ifndef TL_PROBE
#define TL_PROBE 0
#define TL_A (-1)
#define TL_B 0
#define TL_BODY 0
#endif
#ifndef CVF_PROBE
#define CVF_PROBE 0
#endif
#ifndef G_F8
#define G_F8 1
#endif
#ifndef F8_Y
#define F8_Y 1
#endif
constexpr int YSCALE = 16;
#ifndef F8_MISC
#define F8_MISC 1
#endif
constexpr size_t WS_H8 = WS_OF + 64 * MiB;
constexpr size_t WS_WIN8 = WS_WIN + 6 * MiB;
constexpr size_t WS_STOK = WS_AS;
constexpr int CW_MODF = 3200;
constexpr int CW_FLAT = 3072;
constexpr int CW_GCNT = 2048;
constexpr float W8SCALE = 64.0f;
constexpr size_t WS_U = WS_Q, WS_ZP = WS_V, WS_Z = WS_SG;
constexpr int CW_BAR = 4096;
constexpr int CW_XMAP = 32768;
constexpr int CW_TCNT = 65536;

constexpr int RING_OFF = 0, RING_BYTES = 131072;
constexpr int LDSCTL_OFF = 139264, MISC_OFF = LDSCTL_OFF + 320, EXTRA_OFF = LDSCTL_OFF + 1024;
constexpr int LDS_BYTES = 155648;

#define LAS __attribute__((address_space(3)))
typedef unsigned short bf16;
typedef unsigned v4u __attribute__((ext_vector_type(4)));
typedef unsigned v2u __attribute__((ext_vector_type(2)));
typedef float f32x4 __attribute__((ext_vector_type(4)));
typedef int v4i __attribute__((ext_vector_type(4)));
#define LDS_WAIT() asm volatile("s_waitcnt lgkmcnt(0)" ::: "memory")
#define VM_WAIT() asm volatile("s_waitcnt vmcnt(0)" ::: "memory")
__device__ __forceinline__ unsigned f2bf(float f) { unsigned u = __builtin_bit_cast(unsigned, f); return (u + 0x7fffu + ((u >> 16) & 1u)) >> 16; }
__device__ __forceinline__ unsigned pk2(float lo, float hi) { return f2bf(lo) | (f2bf(hi) << 16); }
__device__ __forceinline__ float bf_lo(unsigned u) { return __builtin_bit_cast(float, u << 16); }
__device__ __forceinline__ float bf_hi(unsigned u) { return __builtin_bit_cast(float, u & 0xffff0000u); }
__device__ __forceinline__ float bf2f(bf16 h) { return __builtin_bit_cast(float, ((unsigned)h) << 16); }
__device__ __forceinline__ float fsig(float x) { return __builtin_amdgcn_rcpf(1.0f + __expf(-x)); }
__device__ __forceinline__ float wave_sum(float v) {
#define WS_DPP(x, ctrl) __builtin_bit_cast(float, __builtin_amdgcn_update_dpp(0, __builtin_bit_cast(int, x), ctrl, 0xF, 0xF, true))
    v += WS_DPP(v, 0xB1);
    v += WS_DPP(v, 0x4E);
    v += WS_DPP(v, 0x141);
    v += WS_DPP(v, 0x140);
#undef WS_DPP
    const int vi = __builtin_bit_cast(int, v);
    return (__builtin_bit_cast(float, __builtin_amdgcn_readlane(vi, 0)) + __builtin_bit_cast(float, __builtin_amdgcn_readlane(vi, 16)))
         + (__builtin_bit_cast(float, __builtin_amdgcn_readlane(vi, 32)) + __builtin_bit_cast(float, __builtin_amdgcn_readlane(vi, 48)));
}

__device__ __forceinline__ float half_sum(float v) {
#define WS_DPP(x, ctrl) __builtin_bit_cast(float, __builtin_amdgcn_update_dpp(0, __builtin_bit_cast(int, x), ctrl, 0xF, 0xF, true))
    v += WS_DPP(v, 0xB1); v += WS_DPP(v, 0x4E); v += WS_DPP(v, 0x141); v += WS_DPP(v, 0x140);
#undef WS_DPP
    return v + __shfl_xor(v, 16);
}
__device__ __forceinline__ float sat8(float x) { return __builtin_amdgcn_fmed3f(x, -448.0f, 448.0f); }
__device__ __forceinline__ unsigned pk4_fp8(float a, float b, float c, float d) { int w = 0; w = __builtin_amdgcn_cvt_pk_fp8_f32(sat8(a), sat8(b), w, false); w = __builtin_amdgcn_cvt_pk_fp8_f32(sat8(c), sat8(d), w, true); return (unsigned)w; }
template <bool OUT8> __device__ __forceinline__ void store_row4(void* orow, int lane, int j, f32x4 y, float scale) {
    if constexpr (OUT8) ((unsigned*)orow)[lane + 64 * j] = pk4_fp8(y.x * scale, y.y * scale, y.z * scale, y.w * scale);
    else { v2u w; w.x = pk2(y.x, y.y); w.y = pk2(y.z, y.w); ((v2u*)orow)[lane + 64 * j] = w; }
}

#define XB_TMO      128
#define XB_XCNT(j)  (256  + 64 * (j))
#define XB_XSUB(j)  (1280 + 64 * (j))
#define XB_XGEN(j)  (2304 + 64 * (j))
#define XB_TOP      3328
#define XB_TOPGEN   3392
#define XCD_BAR_WORDS 3456
#define XB_SPIN_CAP (1u << 18)

__device__ __forceinline__ unsigned xb_ld(unsigned* p)              { return __hip_atomic_load(p, __ATOMIC_RELAXED, __HIP_MEMORY_SCOPE_AGENT); }
__device__ __forceinline__ unsigned xb_add(unsigned* p, unsigned v) { return __hip_atomic_fetch_add(p, v, __ATOMIC_RELAXED, __HIP_MEMORY_SCOPE_AGENT); }
__device__ __forceinline__ unsigned xb_xcc_id() { return (unsigned)__builtin_amdgcn_s_getreg((3 << 11) | 20) & 0xFu; }
#define XB_SPIN(cond, bar) do { unsigned _sp = 0; while (cond) { __builtin_amdgcn_s_sleep(1); \
    if ((++_sp & 255u) == 0u) { if (xb_ld(&(bar)[XB_TMO])) break; if (_sp > XB_SPIN_CAP) { atomicAdd(&(bar)[XB_TMO], 1u); break; } } } } while (0)

struct XcdBarrier {
    unsigned* bar; unsigned x;
    volatile LAS unsigned* st;
};

__device__ __forceinline__ XcdBarrier xcd_barrier_post(unsigned* bar, volatile LAS unsigned* st) {
    XcdBarrier b; b.bar = bar; b.x = xb_xcc_id(); b.st = st;
    if (threadIdx.x == 0) (void)xb_add(&bar[XB_XCNT(b.x)], 1u);
    return b;
}
__device__ __forceinline__ void xcd_barrier_complete(unsigned* bar, unsigned x, unsigned& nloc, unsigned& nx) {
    const unsigned G = gridDim.x * gridDim.y * gridDim.z;
    unsigned sum, cnt, mine, sp = 0u;
    for (;;) {
        sum = 0u; cnt = 0u; mine = 0u;
#pragma unroll
        for (unsigned j = 0; j < 16; ++j) { const unsigned c = xb_ld(&bar[XB_XCNT(j)]); sum += c; cnt += (c > 0u) ? 1u : 0u; mine = (j == x) ? c : mine; }
        if (sum == G) break;
        __builtin_amdgcn_s_sleep(1);
        if ((++sp & 255u) == 0u) { if (xb_ld(&bar[XB_TMO])) break; if (sp > XB_SPIN_CAP) { atomicAdd(&bar[XB_TMO], 1u); break; } }
    }
    nloc = mine > 0u ? mine : 1u; nx = cnt > 0u ? cnt : 1u;
}

__device__ __forceinline__ void xcd_barrier(const XcdBarrier& b) {
    asm volatile("s_waitcnt vmcnt(0)" ::: "memory");
    __syncthreads();
    if (threadIdx.x == 0) {
        unsigned* bar = b.bar;
        __builtin_amdgcn_s_waitcnt(0);
        unsigned nloc = b.st[0], nx = b.st[1];
        if (nloc == 0u) { xcd_barrier_complete(bar, b.x, nloc, nx); b.st[0] = nloc; b.st[1] = nx; }
        const unsigned old = xb_add(&bar[XB_XSUB(b.x)], 1u);
        const unsigned gen = old / nloc;
        if (old + 1u == (gen + 1u) * nloc) {
            __builtin_amdgcn_fence(__ATOMIC_RELEASE, "agent");
            asm volatile("s_waitcnt vmcnt(0)" ::: "memory");
            const unsigned og = xb_add(&bar[XB_TOP], 1u);
            const unsigned tg = og / nx;
            if (og + 1u == (tg + 1u) * nx) xb_add(&bar[XB_TOPGEN], 1u);
            else XB_SPIN(xb_ld(&bar[XB_TOPGEN]) == tg, bar);
            __builtin_amdgcn_fence(__ATOMIC_ACQUIRE, "agent");
            xb_add(&bar[XB_XGEN(b.x)], 1u);
            asm volatile("s_waitcnt vmcnt(0)" ::: "memory");
        } else {
            XB_SPIN(xb_ld(&bar[XB_XGEN(b.x)]) == gen, bar);
            __builtin_amdgcn_fence(__ATOMIC_ACQUIRE, "agent");
            asm volatile("s_waitcnt vmcnt(0)" ::: "memory");
        }
    }
    __syncthreads();
}

struct Args { const float* in[N_IN]; float* out; unsigned char* ws; int ph_lo, ph_hi, li, pad; };

__device__ __forceinline__ void p_mods(const Args& a, LAS unsigned char* lds, int tid, int lane, int wave) {
    LAS float* sc = (LAS float*)lds;
    LAS float* part = sc + 3 * D;
    float* MODS = (float*)(a.ws + WS_MODS);
    for (int i = tid; i < 3 * D; i += NTHR) { const int r = i >> 10, k = i & 1023; const float v = r < 2 ? a.in[I_C][r * D + k] : a.in[I_CCTX][k]; sc[i] = v * fsig(v); }
    __syncthreads();
    for (int item = blockIdx.x; item < 2 * 96; item += gridDim.x) {
        const int l = item / 96, cb = item % 96;
        const float* W = a.in[I_WADA] + (size_t)l * D * 6 * D + cb * 64 + lane;
        float a0 = 0.f, a1 = 0.f, a2 = 0.f;
#pragma unroll 16
        for (int kk = 0; kk < 128; ++kk) { const int k = wave * 128 + kk; const float w = W[(size_t)k * (6 * D)]; a0 += sc[k] * w; a1 += sc[D + k] * w; a2 += sc[2 * D + k] * w; }
        part[(wave * 3 + 0) * 64 + lane] = a0; part[(wave * 3 + 1) * 64 + lane] = a1; part[(wave * 3 + 2) * 64 + lane] = a2;
        __syncthreads();
        if (tid < 192) { const int r = tid >> 6, ln = tid & 63; float s = 0.f;
#pragma unroll
            for (int w = 0; w < 8; ++w) s += part[(w * 3 + r) * 64 + ln];
            __hip_atomic_store(&MODS[(size_t)(l * 3 + r) * (6 * D) + cb * 64 + ln], s + a.in[I_BADA][l * 6 * D + cb * 64 + ln], __ATOMIC_RELAXED, __HIP_MEMORY_SCOPE_AGENT); }
        asm volatile("s_waitcnt vmcnt(0)" ::: "memory");
        __syncthreads();
        if (item < 32 && tid == 0) (void)__hip_atomic_fetch_add((unsigned*)(a.ws + WS_CTL) + CW_MODF, 1u, __ATOMIC_RELAXED, __HIP_MEMORY_SCOPE_AGENT);
    }
}
__device__ __forceinline__ void wait_mods0(const Args& a, int tid) {
    if (tid == 0) { unsigned* f = (unsigned*)(a.ws + WS_CTL) + CW_MODF; unsigned sp = 0;
        while (__hip_atomic_load(f, __ATOMIC_RELAXED, __HIP_MEMORY_SCOPE_AGENT) < 32u) { __builtin_amdgcn_s_sleep(2); if (++sp > (1u << 22)) break; }
        __builtin_amdgcn_fence(__ATOMIC_ACQUIRE, "agent");
        asm volatile("s_waitcnt vmcnt(0)" ::: "memory"); }
    __syncthreads();
}
template <bool OUT8> __device__ __forceinline__ void transpose_item(const float* W, int K, int N, bf16* WT, bool paired, LAS float* scr, int item, int lane, int row_adj = 0) {
    const int nblk = N / 32, kb = item / nblk, nb = item % nblk, k0 = 64 * kb, n0 = 32 * nb;
    int d0 = n0 + row_adj; if (paired) { const int half = n0 >> 10, c = n0 & 1023; d0 = (c >> 7) * 256 + half * 128 + (c & 127); }
    float t[32];
#pragma unroll
    for (int i = 0; i < 32; ++i) { const int kk = 2 * i + (lane >> 5); t[i] = __builtin_nontemporal_load(&W[(size_t)(k0 + kk) * N + n0 + (lane & 31)]); }
#pragma unroll
    for (int i = 0; i < 32; ++i) { const int kk = 2 * i + (lane >> 5); scr[kk * 33 + (lane & 31)] = t[i]; }
    LDS_WAIT(); asm volatile("" ::: "memory");
    const int c = lane & 7;
#pragma unroll
    for (int j = 0; j < 4; ++j) { const int n = (lane >> 3) + 8 * j; const LAS float* s = scr + (8 * c) * 33 + n;
        if constexpr (OUT8) {
            int w0 = 0, w1 = 0;
            w0 = __builtin_amdgcn_cvt_pk_fp8_f32(s[0 * 33] * W8SCALE, s[1 * 33] * W8SCALE, w0, false); w0 = __builtin_amdgcn_cvt_pk_fp8_f32(s[2 * 33] * W8SCALE, s[3 * 33] * W8SCALE, w0, true);
            w1 = __builtin_amdgcn_cvt_pk_fp8_f32(s[4 * 33] * W8SCALE, s[5 * 33] * W8SCALE, w1, false); w1 = __builtin_amdgcn_cvt_pk_fp8_f32(s[6 * 33] * W8SCALE, s[7 * 33] * W8SCALE, w1, true);
            *(v2u*)((unsigned char*)WT + (size_t)(d0 + n) * K + k0 + 8 * c) = (v2u){(unsigned)w0, (unsigned)w1};
        } else {
        v4u o; o.x = pk2(s[0 * 33], s[1 * 33]); o.y = pk2(s[2 * 33], s[3 * 33]); o.z = pk2(s[4 * 33], s[5 * 33]); o.w = pk2(s[6 * 33], s[7 * 33]);
        *(v4u*)(WT + (size_t)(d0 + n) * K + k0 + 8 * c) = o; } }
    LDS_WAIT(); asm volatile("" ::: "memory");
}
__device__ __forceinline__ void p_weights(const Args& a, LAS unsigned char* lds, int lane, int wave) {
    LAS float* scr = (LAS float*)(lds + RING_OFF + wave * 16384);
    const int gw = blockIdx.x * NWAVES + wave, NGW = gridDim.x * NWAVES;
    constexpr int I_IN = 16 * 160, I_SQ = 16 * 32, I_CV = 16 * 64, I_E1 = 64 * 1024, I_E2 = 64 * 512;
    constexpr int NITEMS = I_IN + I_SQ + I_CV + I_SQ + I_E1 + I_E2;
    unsigned char* ws = a.ws;
    for (int it = (gridDim.x == 256 ? I_E1 + I_E2 : 0) + gw; it < NITEMS; it += NGW) {
        int r = it;
        if (r < I_E1) { const int mi = r >> 10; transpose_item<true>(a.in[I_WE1] + (size_t)mi * D * 2 * D, D, 2 * D, (bf16*)(ws + WS_W1 + (size_t)mi * 2 * D * D), true, scr, r & 1023, lane); continue; } r -= I_E1;
        if (r < I_E2) { const int mi = r >> 9; transpose_item<true>(a.in[I_WE2] + (size_t)mi * D * D, D, D, (bf16*)(ws + WS_W2 + (size_t)mi * D * D), false, scr, r & 511, lane); continue; } r -= I_E2;
        if (r < I_IN) {
            if (SPLIT_IN) { const int sgm = ((r % 160) * 32) >> 10;
                if (sgm == 2 || sgm == 3 || (G_F8 && sgm == 4)) transpose_item<true>(a.in[I_WHIN], D, 5 * D, (bf16*)(ws + WS_WIN8), false, scr, r, lane, -2 * D);
                else transpose_item<false>(a.in[I_WHIN], D, 5 * D, (bf16*)(ws + WS_WIN), false, scr, r, lane, sgm == 4 ? -2 * D : 0);
            } else transpose_item<F8_IN != 0>(a.in[I_WHIN], D, 5 * D, (bf16*)(ws + WS_WIN), false, scr, r, lane);
            continue; } r -= I_IN;
        if (r < I_SQ) { transpose_item<F8_MISC != 0>(a.in[I_WHOUT], D, D, (bf16*)(ws + WS_WOUT), false, scr, r, lane); continue; } r -= I_SQ;
        if (r < I_CV) { transpose_item<F8_MISC != 0>(a.in[I_WCVIN], D, 2 * D, (bf16*)(ws + WS_WCVIN), true, scr, r, lane); continue; } r -= I_CV;
        transpose_item<F8_MISC != 0>(a.in[I_WCVOUT], D, D, (bf16*)(ws + WS_WCVOUT), false, scr, r, lane);
    }
}
constexpr int CV_WAVES = 7, CV_L0 = 32 * 512 + 32 * 256, CV_ALL = 2 * CV_L0;
__device__ __forceinline__ void transpose_item64(const float* W, int K, int N, unsigned char* WT, bool paired, LAS float* scr, int item, int lane) {
    const int nblk = N / 64, kb = item / nblk, nb = item % nblk, k0 = 64 * kb, n0 = 64 * nb;
    int d0 = n0; if (paired) { const int half = n0 >> 10, c = n0 & 1023; d0 = (c >> 7) * 256 + half * 128 + (c & 127); }
    float t[64];
#pragma unroll
    for (int i = 0; i < 64; ++i) t[i] = __builtin_nontemporal_load(&W[(size_t)(k0 + i) * N + n0 + lane]);
#pragma unroll
    for (int i = 0; i < 64; ++i) scr[i * 65 + lane] = t[i];
    LDS_WAIT(); asm volatile("" ::: "memory");
    const int c = lane & 3;
#pragma unroll
    for (int j = 0; j < 4; ++j) { const int n = (lane >> 2) + 16 * j; const LAS float* s = scr + (16 * c) * 65 + n;
        v4u o;
        o.x = pk4_fp8(s[0 * 65] * W8SCALE, s[1 * 65] * W8SCALE, s[2 * 65] * W8SCALE, s[3 * 65] * W8SCALE); o.y = pk4_fp8(s[4 * 65] * W8SCALE, s[5 * 65] * W8SCALE, s[6 * 65] * W8SCALE, s[7 * 65] * W8SCALE);
        o.z = pk4_fp8(s[8 * 65] * W8SCALE, s[9 * 65] * W8SCALE, s[10 * 65] * W8SCALE, s[11 * 65] * W8SCALE); o.w = pk4_fp8(s[12 * 65] * W8SCALE, s[13 * 65] * W8SCALE, s[14 * 65] * W8SCALE, s[15 * 65] * W8SCALE);
        *(v4u*)(WT + (size_t)(d0 + n) * K + k0 + 16 * c) = o; }
    LDS_WAIT(); asm volatile("" ::: "memory");
}
__device__ __forceinline__ void cv_do_item(const Args& a, LAS float* scr, int g, int lane) {
    const int l = g >= CV_L0 ? 1 : 0; const int r = g - l * CV_L0;
    if (r < 32 * 512) { const int mi = l * 32 + (r >> 9); transpose_item64(a.in[I_WE1] + (size_t)mi * D * 2 * D, D, 2 * D, a.ws + WS_W1 + (size_t)mi * 2 * D * D, true, scr, r & 511, lane); }
    else { const int r2 = r - 32 * 512; const int mi = l * 32 + (r2 >> 8); transpose_item64(a.in[I_WE2] + (size_t)mi * D * D, D, D, a.ws + WS_W2 + (size_t)mi * D * D, false, scr, r2 & 255, lane); }
}
__device__ __forceinline__ void cv_finish(const Args& a, LAS unsigned char* lds, int wave, int lane, int& cv_n, int limit) {
    if (gridDim.x == 256 && wave >= 1 && wave <= CV_WAVES) {
        const int ww = blockIdx.x * CV_WAVES + (wave - 1), NW = 256 * CV_WAVES; LAS float* scr = (LAS float*)(lds + RING_OFF + wave * 16640);
#if CVF_PROBE
        const unsigned long long t0_ = __builtin_amdgcn_s_memrealtime();
#endif
        for (;;) { const int g = cv_n * NW + ww; if (g >= limit) break; cv_do_item(a, scr, g, lane); ++cv_n; }
#if CVF_PROBE
        if (blockIdx.x == 0 && wave == 1 && lane == 0) { asm volatile("s_waitcnt vmcnt(0)" ::: "memory"); ((volatile LAS unsigned*)(lds + MISC_OFF))[40] += (unsigned)(__builtin_amdgcn_s_memrealtime() - t0_); }
#endif
    }
}
__device__ __forceinline__ void xcd_barrier_work(const XcdBarrier& b, const Args& a, LAS unsigned char* lds, int wave, int lane, int& cv_n, volatile LAS unsigned* flag, unsigned seq) {
    asm volatile("s_waitcnt vmcnt(0)" ::: "memory");
    __syncthreads();
    if (wave == 0) {
        if (threadIdx.x == 0) {
            unsigned* bar = b.bar;
            __builtin_amdgcn_s_waitcnt(0);
            unsigned nloc = b.st[0], nx = b.st[1];
            if (nloc == 0u) { xcd_barrier_complete(bar, b.x, nloc, nx); b.st[0] = nloc; b.st[1] = nx; }
            const unsigned old = xb_add(&bar[XB_XSUB(b.x)], 1u);
            const unsigned gen = old / nloc;
            if (old + 1u == (gen + 1u) * nloc) {
                __builtin_amdgcn_fence(__ATOMIC_RELEASE, "agent");
                asm volatile("s_waitcnt vmcnt(0)" ::: "memory");
                const unsigned og = xb_add(&bar[XB_TOP], 1u);
                const unsigned tg = og / nx;
                if (og + 1u == (tg + 1u) * nx) xb_add(&bar[XB_TOPGEN], 1u);
                else XB_SPIN(xb_ld(&bar[XB_TOPGEN]) == tg, bar);
                __builtin_amdgcn_fence(__ATOMIC_ACQUIRE, "agent");
                xb_add(&bar[XB_XGEN(b.x)], 1u);
                asm volatile("s_waitcnt vmcnt(0)" ::: "memory");
            } else {
                XB_SPIN(xb_ld(&bar[XB_XGEN(b.x)]) == gen, bar);
                __builtin_amdgcn_fence(__ATOMIC_ACQUIRE, "agent");
                asm volatile("s_waitcnt vmcnt(0)" ::: "memory");
            }
            flag[0] = seq;
        }
    } else if (gridDim.x == 256 && wave <= CV_WAVES) {
        const int ww = blockIdx.x * CV_WAVES + (wave - 1), NW = 256 * CV_WAVES; LAS float* scr = (LAS float*)(lds + RING_OFF + wave * 16640);
        for (;;) { const int g = cv_n * NW + ww; if (g >= CV_ALL) break; if (flag[0] == seq) break; cv_do_item(a, scr, g, lane); ++cv_n; }
        asm volatile("s_waitcnt vmcnt(0)" ::: "memory");
    }
    __syncthreads();
}
__device__ __forceinline__ void flat_barrier_work(unsigned* cnt, const Args& a, LAS unsigned char* lds, int wave, int lane, int& cv_n, volatile LAS unsigned* flag, unsigned seq) {
    asm volatile("s_waitcnt vmcnt(0)" ::: "memory");
    __syncthreads();
    if (wave == 0) {
        if (threadIdx.x == 0) {
            __builtin_amdgcn_s_waitcnt(0);
            __builtin_amdgcn_fence(__ATOMIC_RELEASE, "agent");
            asm volatile("s_waitcnt vmcnt(0)" ::: "memory");
            (void)__hip_atomic_fetch_add(cnt, 1u, __ATOMIC_RELAXED, __HIP_MEMORY_SCOPE_AGENT);
            const unsigned target = gridDim.x * seq; unsigned sp = 0;
            while (__hip_atomic_load(cnt, __ATOMIC_RELAXED, __HIP_MEMORY_SCOPE_AGENT) < target) { __builtin_amdgcn_s_sleep(1); if (++sp > (1u << 22)) break; }
            __builtin_amdgcn_fence(__ATOMIC_ACQUIRE, "agent");
            asm volatile("s_waitcnt vmcnt(0)" ::: "memory");
            flag[0] = seq;
        }
    } else if (gridDim.x == 256 && wave <= CV_WAVES) {
        const int ww = blockIdx.x * CV_WAVES + (wave - 1), NW = 256 * CV_WAVES; LAS float* scr = (LAS float*)(lds + RING_OFF + wave * 16640);
        for (;;) { const int g = cv_n * NW + ww; if (g >= CV_ALL) break; if (flag[0] == seq) break; cv_do_item(a, scr, g, lane); ++cv_n; }
        asm volatile("s_waitcnt vmcnt(0)" ::: "memory");
    }
    __syncthreads();
}
template <bool OUT8> __device__ __forceinline__ void norm_mod_store(f32x4 (&v)[4], const float* g, const float* sc, const float* sh, void* orow, int lane) {
    float s = 0.f;
#pragma unroll
    for (int j = 0; j < 4; ++j) s += (v[j].x * v[j].x + v[j].y * v[j].y) + (v[j].z * v[j].z + v[j].w * v[j].w);
    const float r = 1.0f / sqrtf(wave_sum(s) * (1.0f / D) + EPS);
#pragma unroll
    for (int j = 0; j < 4; ++j) { const f32x4 gg = ((const f32x4*)g)[lane + 64 * j], ss = ((const f32x4*)sc)[lane + 64 * j], hh = ((const f32x4*)sh)[lane + 64 * j];
        const f32x4 y = (v[j] * r * gg) * (ss + 1.0f) + hh; v[j] = y;
        store_row4<OUT8>(orow, lane, j, y, 1.0f); }
}
__device__ __forceinline__ void p_norm0(const Args& a, int lane, int gw, int NGW, int m_begin, int m_end) {
    const float* MODS = (const float*)(a.ws + WS_MODS); bf16* H = (bf16*)(a.ws + WS_H);
    for (int m0 = m_begin + gw * 2; m0 < m_end; m0 += NGW * 2) {
        f32x4 v[2][4]; int rr[2];
#pragma unroll
        for (int r = 0; r < 2; ++r) { const int m = m0 + r; const float* xr;
            if (m < NTOK) { xr = a.in[I_X] + (size_t)m * D; rr[r] = m / SEQ; } else { xr = a.in[I_CTX] + (size_t)(m - NTOK) * D; rr[r] = 2; }
#pragma unroll
            for (int j = 0; j < 4; ++j) v[r][j] = __builtin_nontemporal_load(&((const f32x4*)xr)[lane + 64 * j]); }
#pragma unroll
        for (int r = 0; r < 2; ++r) { const float* md = MODS + (size_t)rr[r] * 6 * D;
            norm_mod_store<F8_IN != 0>(v[r], a.in[I_GMIX], md + 1 * D, md + 0 * D, (unsigned char*)H + (size_t)(m0 + r) * D * (F8_IN ? 1 : 2), lane);
            if (SPLIT_IN) {
#pragma unroll
                for (int j = 0; j < 4; ++j) store_row4<true>(a.ws + WS_H8 + (size_t)(m0 + r) * D, lane, j, v[r][j], 1.0f); } }
    }
}
__device__ __forceinline__ void p_scan_naive(const Args& a, LAS unsigned char* lds, int tid) {
    LAS float* sf = (LAS float*)lds;
    LAS float* sq = sf + 64 * 128;
    LAS float* sv = sq + 64 * 128;
    LAS float* so = sv + 64 * 16;
    const bf16* Q = (const bf16*)(a.ws + WS_Q); const bf16* V = (const bf16*)(a.ws + WS_V);
    const int vl = tid >> 5, kq = tid & 31;
    for (int unit = blockIdx.x; unit < 256; unit += gridDim.x) {
        const int chain = unit >> 3, vb = unit & 7, b = chain >> 4, h = (chain >> 1) & 7, dir = chain & 1;
        const float* LF = (const float*)(a.ws + (dir ? WS_LFB : WS_LFF)); float* O = (float*)(a.ws + (dir ? WS_OB : WS_OF));
        float S0 = 0.f, S1 = 0.f, S2 = 0.f, S3 = 0.f;
        for (int blk = 0; blk < 260; ++blk) {
            const bool isctx = blk < 4; int base, step;
            if (!dir) { base = isctx ? (NTOK + b * CTXL + blk * 64) : (b * SEQ + (blk - 4) * 64); step = 1; }
            else { base = isctx ? (NTOK + b * CTXL + CTXL - 1 - blk * 64) : (b * SEQ + SEQ - 1 - (blk - 4) * 64); step = -1; }
            for (int e = tid; e < 64 * 128; e += NTHR) { const int i = e >> 7, k = e & 127; const size_t off = (size_t)(base + step * i) * D + h * DK + k; sf[e] = __expf(LF[off]); sq[e] = bf2f(Q[off]); }
            for (int e = tid; e < 64 * 16; e += NTHR) { const int i = e >> 4, vv = e & 15; sv[e] = bf2f(V[(size_t)(base + step * i) * D + h * DK + vb * 16 + vv]); }
            __syncthreads();
            for (int i = 0; i < 64; ++i) {
                const f32x4 f = *(const LAS f32x4*)(sf + i * 128 + kq * 4), q = *(const LAS f32x4*)(sq + i * 128 + kq * 4); const float vv = sv[i * 16 + vl];
                S0 = f.x * S0 + (1.0f - f.x) * vv; S1 = f.y * S1 + (1.0f - f.y) * vv; S2 = f.z * S2 + (1.0f - f.z) * vv; S3 = f.w * S3 + (1.0f - f.w) * vv;
                float p = (S0 * q.x + S1 * q.y) + (S2 * q.z + S3 * q.w);
                p += __shfl_xor(p, 1); p += __shfl_xor(p, 2); p += __shfl_xor(p, 4); p += __shfl_xor(p, 8); p += __shfl_xor(p, 16);
                if (kq == 0) so[i * 16 + vl] = p;
            }
            __syncthreads();
            if (!isctx) for (int e = tid; e < 64 * 16; e += NTHR) { const int i = e >> 4, vv = e & 15; O[(size_t)(base + step * i) * D + h * DK + vb * 16 + vv] = so[e]; }
            __syncthreads();
        }
    }
}
constexpr int SC_QT = 0, SC_KU = 4352, SC_KB = 8704, SC_VT = 12800, SC_ET = 16896, SC_SUB = 17408, SC_BUF = 4 * SC_SUB;
constexpr int NSLOT = 17;
typedef short s16x4 __attribute__((ext_vector_type(4)));
typedef short s16x8 __attribute__((ext_vector_type(8)));
struct ScanUnit { int h, rowbase, sgn, nchunks, chain, slot; };
__device__ __forceinline__ ScanUnit scan_unit(int b, int h, int dir, int slot) {
    ScanUnit u; u.h = h; u.sgn = dir ? -1 : 1; u.chain = (b * NHEAD + h) * 2 + dir; u.slot = slot;
    if (slot == 0) { u.rowbase = NTOK + b * CTXL + (dir ? CTXL - 1 : 0); u.nchunks = CTXL / 64; }
    else { const int so = (slot - 1) * 1024; u.rowbase = b * SEQ + (dir ? SEQ - 1 - so : so); u.nchunks = 16; }
    return u;
}
typedef float f32x2_t __attribute__((ext_vector_type(2)));
typedef __bf16 bf16x2_t __attribute__((ext_vector_type(2)));
__device__ __forceinline__ unsigned cvtpk(float lo, float hi) { const f32x2_t f = {lo, hi}; return __builtin_bit_cast(unsigned, __builtin_convertvector(f, bf16x2_t)); }
template <bool FULL> __device__ __forceinline__ void scan_load(const ScanUnit& u, int pos0, const bf16* LF, const bf16* Q, const bf16* V, int k, int i, unsigned (&lf)[16], unsigned (&qr)[16], unsigned (&vr)[16]) {
#pragma unroll
    for (int t = 0; t < 16; ++t) {
        const unsigned o = (unsigned)(u.rowbase + u.sgn * (pos0 + 16 * i + t)) * D + u.h * DK + k;
        lf[t] = LF[o]; vr[t] = V[o]; if (FULL) qr[t] = Q[o];
    }
}
template <bool FULL> __device__ __forceinline__ float scan_prep(LAS unsigned char* buf, int k, int i, const unsigned (&lfr)[16], const unsigned (&qr)[16], const unsigned (&vr)[16]) {
    LAS unsigned char* sb = buf + i * SC_SUB;
    float f[16], pre[16], suf[16]; float T = 0.f;
#pragma unroll
    for (int t = 0; t < 16; ++t) { const float lf = (float)__builtin_bit_cast(_Float16, (unsigned short)lfr[t]); T += lf; f[t] = __builtin_amdgcn_exp2f(lf * 1.4426950408889634f); }
    pre[0] = f[0];
#pragma unroll
    for (int t = 1; t < 16; ++t) pre[t] = pre[t - 1] * f[t];
    suf[15] = 1.0f;
#pragma unroll
    for (int t = 14; t >= 0; --t) suf[t] = suf[t + 1] * f[t + 1];
    unsigned kbw[8], vtw[8], qqw[8], kuw[8];
#pragma unroll
    for (int t = 0; t < 16; t += 2) {
        const float kk0 = 1.0f - f[t], kk1 = 1.0f - f[t + 1];
        kbw[t >> 1] = cvtpk(kk0 * suf[t], kk1 * suf[t + 1]);
        vtw[t >> 1] = vr[t] | (vr[t + 1] << 16);
        if (FULL) {
            qqw[t >> 1] = cvtpk(__builtin_bit_cast(float, qr[t] << 16) * pre[t], __builtin_bit_cast(float, qr[t + 1] << 16) * pre[t + 1]);
            kuw[t >> 1] = cvtpk(kk0 * __builtin_amdgcn_rcpf(fmaxf(pre[t], 1e-30f)), kk1 * __builtin_amdgcn_rcpf(fmaxf(pre[t + 1], 1e-30f)));
        }
    }
    if (FULL) {
        const int rho = k ^ (((k >> 3) & 1) << 2);
        *(LAS v4u*)(sb + SC_QT + rho * 32) = (v4u){qqw[0], qqw[1], qqw[2], qqw[3]}; *(LAS v4u*)(sb + SC_QT + rho * 32 + 16) = (v4u){qqw[4], qqw[5], qqw[6], qqw[7]};
        *(LAS v4u*)(sb + SC_KU + rho * 32) = (v4u){kuw[0], kuw[1], kuw[2], kuw[3]}; *(LAS v4u*)(sb + SC_KU + rho * 32 + 16) = (v4u){kuw[4], kuw[5], kuw[6], kuw[7]};
    }
    *(LAS v4u*)(sb + SC_KB + k * 32) = (v4u){kbw[0], kbw[1], kbw[2], kbw[3]}; *(LAS v4u*)(sb + SC_KB + k * 32 + 16) = (v4u){kbw[4], kbw[5], kbw[6], kbw[7]};
    *(LAS v4u*)(sb + SC_VT + k * 32) = (v4u){vtw[0], vtw[1], vtw[2], vtw[3]}; *(LAS v4u*)(sb + SC_VT + k * 32 + 16) = (v4u){vtw[4], vtw[5], vtw[6], vtw[7]};
    *(LAS float*)(sb + SC_ET + 4 * k) = pre[15];
    return T;
}
__device__ __forceinline__ f32x4 mfma_k16(s16x4 a, s16x4 b, f32x4 c) {
    const v2u av = __builtin_bit_cast(v2u, a), bv = __builtin_bit_cast(v2u, b);
    return __builtin_amdgcn_mfma_f32_16x16x32_bf16(__builtin_bit_cast(s16x8, (v4u){av.x, av.y, 0u, 0u}), __builtin_bit_cast(s16x8, (v4u){bv.x, bv.y, 0u, 0u}), c, 0, 0, 0);
}
template <bool FULL> __device__ __forceinline__ void scan_compute2(const LAS unsigned char* buf, int wq, int lane, f32x4 (&S)[2][8], bf16* Ocol, const ScanUnit& u, int pos0) {
    const int fr = lane & 15, g = lane >> 4;
#pragma unroll 1
    for (int i = 0; i < 2; ++i) {
        const LAS unsigned char* sb = buf + i * SC_SUB;
        const s16x4 vt0 = *(const LAS s16x4*)(sb + SC_VT + (32 * wq + fr) * 32 + 8 * g), vt1 = *(const LAS s16x4*)(sb + SC_VT + (32 * wq + 16 + fr) * 32 + 8 * g);
        s16x8 ka[4], qa[4]; f32x4 et[8]; s16x4 kb[8];
        if (FULL) {
            const int q_ = (lane & 15) >> 2, p_ = lane & 3;
            const LAS unsigned char* b0_ = sb + (8 * g + q_) * 32 + p_ * 8 + 128 * (g & 1);
            const LAS unsigned char* b1_ = sb + (8 * g + q_) * 32 + p_ * 8 + 128 * (1 - (g & 1));
#pragma unroll
            for (int c = 0; c < 4; ++c) {
                const s16x4 k0_ = __builtin_amdgcn_ds_read_tr16_b64_v4i16((LAS s16x4*)(b0_ + SC_KU + 1024 * c)), k1_ = __builtin_amdgcn_ds_read_tr16_b64_v4i16((LAS s16x4*)(b1_ + SC_KU + 1024 * c));
                const s16x4 q0_ = __builtin_amdgcn_ds_read_tr16_b64_v4i16((LAS s16x4*)(b0_ + SC_QT + 1024 * c)), q1_ = __builtin_amdgcn_ds_read_tr16_b64_v4i16((LAS s16x4*)(b1_ + SC_QT + 1024 * c));
                ka[c] = __builtin_shufflevector(k0_, k1_, 0, 1, 2, 3, 4, 5, 6, 7); qa[c] = __builtin_shufflevector(q0_, q1_, 0, 1, 2, 3, 4, 5, 6, 7); }
        }
#pragma unroll
        for (int j = 0; j < 8; ++j) { et[j] = *(const LAS f32x4*)(sb + SC_ET + (32 * (j >> 1) + 8 * g + 4 * (j & 1)) * 4); kb[j] = *(const LAS s16x4*)(sb + SC_KB + (32 * (j >> 1) + 8 * (fr >> 2) + 4 * (j & 1) + (fr & 3)) * 32 + 8 * g); }
        __builtin_amdgcn_sched_barrier(0);
        if (FULL) {
            f32x4 aT = (f32x4){0.f, 0.f, 0.f, 0.f};
#pragma unroll
            for (int c = 0; c < 4; ++c) aT = __builtin_amdgcn_mfma_f32_16x16x32_bf16(ka[c], qa[c], aT, 0, 0, 0);
#pragma unroll
            for (int r = 0; r < 4; ++r) if (4 * g + r > fr) aT[r] = 0.f;
            const s16x4 ab = __builtin_bit_cast(s16x4, (v2u){cvtpk(aT[0], aT[1]), cvtpk(aT[2], aT[3])});
            f32x4 o0 = mfma_k16(vt0, ab, (f32x4){0.f, 0.f, 0.f, 0.f}), o1 = mfma_k16(vt1, ab, (f32x4){0.f, 0.f, 0.f, 0.f});
#pragma unroll
            for (int c = 0; c < 4; ++c) {
                const v4u s0 = (v4u){cvtpk(S[0][2 * c][0], S[0][2 * c][1]), cvtpk(S[0][2 * c][2], S[0][2 * c][3]), cvtpk(S[0][2 * c + 1][0], S[0][2 * c + 1][1]), cvtpk(S[0][2 * c + 1][2], S[0][2 * c + 1][3])};
                const v4u s1 = (v4u){cvtpk(S[1][2 * c][0], S[1][2 * c][1]), cvtpk(S[1][2 * c][2], S[1][2 * c][3]), cvtpk(S[1][2 * c + 1][0], S[1][2 * c + 1][1]), cvtpk(S[1][2 * c + 1][2], S[1][2 * c + 1][3])};
                o0 = __builtin_amdgcn_mfma_f32_16x16x32_bf16(__builtin_bit_cast(s16x8, s0), qa[c], o0, 0, 0, 0);
                o1 = __builtin_amdgcn_mfma_f32_16x16x32_bf16(__builtin_bit_cast(s16x8, s1), qa[c], o1, 0, 0, 0);
            }
            bf16* orow = Ocol + (size_t)(u.rowbase + u.sgn * (pos0 + 16 * i + fr)) * D;
            *(v2u*)orow = (v2u){cvtpk(o0[0], o0[1]), cvtpk(o0[2], o0[3])}; *(v2u*)(orow + 16) = (v2u){cvtpk(o1[0], o1[1]), cvtpk(o1[2], o1[3])};
        }
#pragma unroll
        for (int j = 0; j < 8; ++j) { S[0][j] = mfma_k16(kb[j], vt0, S[0][j] * et[j]); S[1][j] = mfma_k16(kb[j], vt1, S[1][j] * et[j]); }
    }
}
template <bool FULL> __device__ __forceinline__ void scan_pair(const Args& a, LAS unsigned char* lds, const ScanUnit& uA, const ScanUnit& uB, int tid, int lane, int wave) {
    const int grp = wave >> 2, wq = wave & 3, t = tid & 255, k = t & 127, i0 = t >> 7;
    ScanUnit u; u.h = grp ? uB.h : uA.h; u.rowbase = grp ? uB.rowbase : uA.rowbase; u.sgn = grp ? uB.sgn : uA.sgn; u.nchunks = grp ? uB.nchunks : uA.nchunks; u.chain = grp ? uB.chain : uA.chain; u.slot = grp ? uB.slot : uA.slot;
    LAS unsigned char* buf = lds + grp * SC_BUF;
    const int dir = u.sgn < 0;
    const bf16* LF = (const bf16*)(a.ws + (dir ? WS_LFB : WS_LFF)); const bf16* Q = (const bf16*)(a.ws + WS_Q); const bf16* V = (const bf16*)(a.ws + WS_V);
    f32x4* SD = (f32x4*)(a.ws + WS_SD) + (size_t)u.chain * NSLOT * 4096; float* SP = (float*)(a.ws + WS_SP) + (size_t)u.chain * NSLOT * DK;
    const int g = lane >> 4;
    bf16* Ocol = (bf16*)(a.ws + (dir ? WS_OB : WS_OF)) + u.h * DK + 32 * wq + 4 * g;
    f32x4 S[2][8];
#pragma unroll
    for (int vb = 0; vb < 2; ++vb)
#pragma unroll
        for (int j = 0; j < 8; ++j) S[vb][j] = (f32x4){0.f, 0.f, 0.f, 0.f};
    if (FULL) {
        for (int s = 0; s < u.slot; ++s) {
            const f32x4* d = SD + (size_t)s * 4096 + (wq * 16) * 64 + lane; const float* pp = SP + s * DK + 8 * g;
#pragma unroll
            for (int j = 0; j < 8; ++j) { const f32x4 pv = *(const f32x4*)(pp + 32 * (j >> 1) + 4 * (j & 1)); const f32x4 ev = (f32x4){__expf(pv.x), __expf(pv.y), __expf(pv.z), __expf(pv.w)};
                S[0][j] = S[0][j] * ev + d[j * 64]; S[1][j] = S[1][j] * ev + d[(8 + j) * 64]; }
        }
    }
    unsigned lf[16], q[16], v[16]; float psum = 0.f;
    const int nsteps = u.nchunks * 2;
    scan_load<FULL>(u, 0, LF, Q, V, k, i0, lf, q, v);
    constexpr int NST = 32;
    if (grp == 1) __syncthreads();
    for (int c = 0; c < NST; ++c) {
        if (c < nsteps) psum += scan_prep<FULL>(buf, k, i0, lf, q, v);
        __syncthreads();
        if (c < nsteps) {
            const int cn = (c + 1 < nsteps) ? c + 1 : c;
            scan_load<FULL>(u, cn * 32, LF, Q, V, k, i0, lf, q, v);
            scan_compute2<FULL>(buf, wq, lane, S, Ocol, u, c * 32);
        }
        __syncthreads();
    }
    if (grp == 0) __syncthreads();
    if (!FULL) {
        f32x4* d = SD + (size_t)u.slot * 4096 + (wq * 16) * 64 + lane;
#pragma unroll
        for (int j = 0; j < 8; ++j) { d[j * 64] = S[0][j]; d[(8 + j) * 64] = S[1][j]; }
        LAS float* ps = (LAS float*)(lds + EXTRA_OFF + 2560);
        ps[(grp * 2 + i0) * 128 + k] = psum;
        __syncthreads();
        if (t < 128) SP[u.slot * DK + t] = ps[(grp * 2) * 128 + t] + ps[(grp * 2 + 1) * 128 + t];
        __syncthreads();
    }
}
__device__ __forceinline__ void p_scan_a(const Args& a, LAS unsigned char* lds, int tid, int lane, int wave) {
    for (int it = blockIdx.x; it < 256; it += gridDim.x) {
        const int b = it >> 7, h = (it >> 4) & 7, seg = it & 15;
        const ScanUnit uA = scan_unit(b, h, 0, seg == 15 ? 0 : 1 + seg);
        const ScanUnit uB = scan_unit(b, h, 1, seg == 0 ? 0 : 16 - seg);
        scan_pair<false>(a, lds, uA, uB, tid, lane, wave);
    }
}
__device__ __forceinline__ void p_scan_c(const Args& a, LAS unsigned char* lds, int tid, int lane, int wave) {
    for (int it = blockIdx.x; it < 256; it += gridDim.x) {
        const int b = it >> 7, h = (it >> 4) & 7, seg = it & 15;
        const ScanUnit uA = scan_unit(b, h, 0, 1 + seg), uB = scan_unit(b, h, 1, 16 - seg);
        scan_pair<true>(a, lds, uA, uB, tid, lane, wave);
    }
}
__device__ __forceinline__ void p_readout(const Args& a, int lane, int wave) {
    const int gw = blockIdx.x * NWAVES + wave, NGW = gridDim.x * NWAVES;
    const bf16* OF = (const bf16*)(a.ws + WS_OF); const bf16* OB = (const bf16*)(a.ws + WS_OB); const bf16* SG = (const bf16*)(a.ws + WS_SG); bf16* Y = (bf16*)(a.ws + WS_YIN);
    f32x4 gh[4];
#pragma unroll
    for (int j = 0; j < 4; ++j) gh[j] = ((const f32x4*)a.in[I_GHOUT])[lane + 64 * j];
    v2u ra[2][4], rb[2][4], sg[2][4];
    if (gw * 2 < NTOK) {
#pragma unroll
        for (int r = 0; r < 2; ++r)
#pragma unroll
            for (int j = 0; j < 4; ++j) { const size_t m = gw * 2 + r; ra[r][j] = ((const v2u*)(OF + m * D))[lane + 64 * j]; rb[r][j] = ((const v2u*)(OB + m * D))[lane + 64 * j]; sg[r][j] = ((const v2u*)(SG + m * D))[lane + 64 * j]; }
    }
    for (int m0 = gw * 2; m0 < NTOK; m0 += NGW * 2) {
        v2u na[2][4], nb[2][4], ns[2][4]; const int mn = m0 + NGW * 2;
#pragma unroll
        for (int r = 0; r < 2; ++r)
#pragma unroll
            for (int j = 0; j < 4; ++j) { const size_t m = (size_t)mn + r; const v2u z2 = (v2u){0u, 0u};
                na[r][j] = mn < NTOK ? ((const v2u*)(OF + m * D))[lane + 64 * j] : z2; nb[r][j] = mn < NTOK ? ((const v2u*)(OB + m * D))[lane + 64 * j] : z2; ns[r][j] = mn < NTOK ? ((const v2u*)(SG + m * D))[lane + 64 * j] : z2; }
#pragma unroll
        for (int r = 0; r < 2; ++r)
#pragma unroll
            for (int j = 0; j < 4; ++j) { const v2u a_ = ra[r][j], b_ = rb[r][j];
                const f32x4 oo = (f32x4){bf_lo(a_.x) + bf_lo(b_.x), bf_hi(a_.x) + bf_hi(b_.x), bf_lo(a_.y) + bf_lo(b_.y), bf_hi(a_.y) + bf_hi(b_.y)};
                float s = (oo.x * oo.x + oo.y * oo.y) + (oo.z * oo.z + oo.w * oo.w);
                s = half_sum(s);
                const float rs = 1.0f / sqrtf(s * (1.0f / DK) + EPS);
                store_row4<F8_MISC != 0>((unsigned char*)Y + (size_t)(m0 + r) * D * (F8_MISC ? 1 : 2), lane, j,
                    (f32x4){oo.x * rs * gh[j].x * bf_lo(sg[r][j].x), oo.y * rs * gh[j].y * bf_hi(sg[r][j].x), oo.z * rs * gh[j].z * bf_lo(sg[r][j].y), oo.w * rs * gh[j].w * bf_hi(sg[r][j].y)}, 4.0f); }
#pragma unroll
        for (int r = 0; r < 2; ++r)
#pragma unroll
            for (int j = 0; j < 4; ++j) { ra[r][j] = na[r][j]; rb[r][j] = nb[r][j]; sg[r][j] = ns[r][j]; }
    }
}
__device__ __forceinline__ void p_router(const Args& a, LAS unsigned char* lds, int l, int tid, int lane, int wave) {
    typedef _Float16 h16x8 __attribute__((ext_vector_type(8))); typedef _Float16 h16x4 __attribute__((ext_vector_type(4)));
    constexpr int PITCH = 2064, TILE_BYTES = 16 * PITCH, P_OFF = 2 * TILE_BYTES, P_BYTES = 8 * 16 * 32 * 4;
    LAS int* s_cnt = (LAS int*)(lds + EXTRA_OFF);
    LAS int* s_gb = s_cnt + 32;
    LAS int* s_sel = (LAS int*)(lds + EXTRA_OFF + 2560);
    unsigned* GCNT = (unsigned*)(a.ws + WS_CTL) + CW_GCNT + l * 32;
    const float* WR = a.in[I_WR] + (size_t)l * D * NE; const float* BR = a.in[I_BR] + l * NE;
    const bf16* X = (const bf16*)(a.ws + WS_X); unsigned char* H = a.ws + WS_H;
    const int fr = lane & 15, g = lane >> 4;
    v2u nx[2][4];
    if (blockIdx.x < NTOK / 128) {
#pragma unroll
        for (int t = 0; t < 2; ++t)
#pragma unroll
            for (int j = 0; j < 4; ++j) nx[t][j] = ((const v2u*)(X + (size_t)(blockIdx.x * 128 + 2 * wave + t) * D))[lane + 64 * j];
    }
    h16x8 wb0[4], wb1[4];
#pragma unroll
    for (int c = 0; c < 4; ++c)
#pragma unroll
        for (int i = 0; i < 8; ++i) { const float* wp = WR + (size_t)(128 * wave + 32 * c + 8 * g + i) * NE + fr; wb0[c][i] = (_Float16)wp[0]; wb1[c][i] = (_Float16)wp[16]; }
    const float* MODS = (const float*)(a.ws + WS_MODS);
    int* TOPS = (int*)(a.ws + WS_TOPE); float* TOPW = (float*)(a.ws + WS_TOPW); int* STOK = (int*)(a.ws + WS_STOK);
    for (int ch = blockIdx.x; ch < NTOK / 128; ch += gridDim.x) {
        if (tid < 32) s_cnt[tid] = 0;
        const int b = (ch * 128) / SEQ; const float* md = MODS + (size_t)(l * 3 + b) * 6 * D;
        if (ch != (int)blockIdx.x) {
#pragma unroll
        for (int t = 0; t < 2; ++t)
#pragma unroll
            for (int j = 0; j < 4; ++j) nx[t][j] = ((const v2u*)(X + (size_t)(ch * 128 + 2 * wave + t) * D))[lane + 64 * j];
        }
#define ROUTER_A(it_) do { const int tokA = ch * 128 + (it_) * 16 + 2 * wave; f32x4 hf[2][4]; \
            _Pragma("unroll") for (int t = 0; t < 2; ++t) _Pragma("unroll") for (int j = 0; j < 4; ++j) hf[t][j] = (f32x4){bf_lo(nx[t][j].x), bf_hi(nx[t][j].x), bf_lo(nx[t][j].y), bf_hi(nx[t][j].y)}; \
            if ((it_) + 1 < 8) { _Pragma("unroll") for (int t = 0; t < 2; ++t) _Pragma("unroll") for (int j = 0; j < 4; ++j) nx[t][j] = ((const v2u*)(X + (size_t)(tokA + 16 + t) * D))[lane + 64 * j]; } \
            _Pragma("unroll") for (int t = 0; t < 2; ++t) { \
                norm_mod_store<true>(hf[t], a.in[I_GFFN] + l * D, md + 4 * D, md + 3 * D, H + (size_t)(tokA + t) * D, lane); \
                _Pragma("unroll") for (int j = 0; j < 4; ++j) { const h16x4 hv = {(_Float16)hf[t][j].x, (_Float16)hf[t][j].y, (_Float16)hf[t][j].z, (_Float16)hf[t][j].w}; \
                    *(LAS h16x4*)(lds + ((it_) & 1) * TILE_BYTES + (2 * wave + t) * PITCH + (4 * lane + 256 * j) * 2) = hv; } } } while (0)
#define ROUTER_B(it_) do { f32x4 acc0 = (f32x4){0.f, 0.f, 0.f, 0.f}, acc1 = acc0; \
            _Pragma("unroll") for (int c = 0; c < 4; ++c) { const h16x8 av = *(const LAS h16x8*)(lds + ((it_) & 1) * TILE_BYTES + fr * PITCH + (128 * wave + 32 * c + 8 * g) * 2); \
                acc0 = __builtin_amdgcn_mfma_f32_16x16x32_f16(av, wb0[c], acc0, 0, 0, 0); acc1 = __builtin_amdgcn_mfma_f32_16x16x32_f16(av, wb1[c], acc1, 0, 0, 0); } \
            LAS float* Pw = (LAS float*)(lds + P_OFF + ((it_) & 1) * P_BYTES); \
            _Pragma("unroll") for (int r = 0; r < 4; ++r) { Pw[(wave * 16 + 4 * g + r) * 32 + fr] = acc0[r]; Pw[(wave * 16 + 4 * g + r) * 32 + 16 + fr] = acc1[r]; } } while (0)
#define ROUTER_C(it_) do { const int t = lane >> 5, e0 = lane & 31; const LAS float* Pr = (const LAS float*)(lds + P_OFF + ((it_) & 1) * P_BYTES); \
            float v0 = BR[e0]; \
            _Pragma("unroll") for (int w = 0; w < 8; ++w) v0 += Pr[(w * 16 + 2 * wave + t) * 32 + e0]; \
            float selv[4]; int seli[4]; \
            { const unsigned ub = __builtin_bit_cast(unsigned, v0); unsigned key = (ub & 0x80000000u) ? ~ub : (ub | 0x80000000u); key = (key & ~31u) | (unsigned)(31 - e0); \
              _Pragma("unroll") for (int r = 0; r < 4; ++r) { unsigned m = key, o; \
                  o = (unsigned)__builtin_amdgcn_update_dpp(0, (int)m, 0xB1, 0xF, 0xF, true); m = o > m ? o : m; \
                  o = (unsigned)__builtin_amdgcn_update_dpp(0, (int)m, 0x4E, 0xF, 0xF, true); m = o > m ? o : m; \
                  o = (unsigned)__builtin_amdgcn_update_dpp(0, (int)m, 0x141, 0xF, 0xF, true); m = o > m ? o : m; \
                  o = (unsigned)__builtin_amdgcn_update_dpp(0, (int)m, 0x140, 0xF, 0xF, true); m = o > m ? o : m; \
                  o = (unsigned)__shfl_xor((int)m, 16); m = o > m ? o : m; \
                  const int bi = 31 - (int)(m & 31u); seli[r] = bi; \
                  if (bi == e0) key = 0u; } \
              _Pragma("unroll") for (int r = 0; r < 4; ++r) selv[r] = __builtin_bit_cast(float, __builtin_amdgcn_ds_bpermute(((lane & 32) + seli[r]) << 2, __builtin_bit_cast(int, v0))); } \
            if ((lane & 31) == 0) { \
                const float e1 = __expf(selv[1] - selv[0]), e2 = __expf(selv[2] - selv[0]), e3 = __expf(selv[3] - selv[0]); const float inv = 1.0f / (1.0f + e1 + e2 + e3); \
                *(f32x4*)(TOPW + (size_t)(ch * 128 + (it_) * 16 + 2 * wave + t) * 4) = (f32x4){inv, e1 * inv, e2 * inv, e3 * inv}; \
                _Pragma("unroll") for (int r = 0; r < 4; ++r) s_sel[((it_) * 16 + 2 * wave + t) * 4 + r] = (seli[r] << 16) | __hip_atomic_fetch_add(&s_cnt[seli[r]], 1, __ATOMIC_RELAXED, __HIP_MEMORY_SCOPE_WORKGROUP); \
            } } while (0)
        ROUTER_A(0);
        for (int k = 0; k < 8; ++k) {
            __syncthreads();
            ROUTER_B(k);
            if (k > 0) ROUTER_C(k - 1);
            if (k < 7) ROUTER_A(k + 1);
        }
        __syncthreads();
        ROUTER_C(7);
#undef ROUTER_A
#undef ROUTER_B
#undef ROUTER_C
        __syncthreads();
        if (tid < 32) s_gb[tid] = (int)__hip_atomic_fetch_add(GCNT + tid, (unsigned)s_cnt[tid], __ATOMIC_RELAXED, __HIP_MEMORY_SCOPE_AGENT);
        __syncthreads();
        { const int sv = s_sel[tid], e = sv >> 16, vi = s_gb[e] + (sv & 0xffff); TOPS[(size_t)ch * 512 + tid] = e * NTOK + vi; STOK[(size_t)e * NTOK + vi] = ch * 128 + (tid >> 2); }
        __syncthreads();
    }
}
__device__ __forceinline__ void moe_tables(const Args& a, LAS unsigned char* lds, int l, int tid) {
    LAS int* s_tb = (LAS int*)(lds + EXTRA_OFF + 256); LAS int* s_ce = s_tb + 40; LAS int* tab = (LAS int*)(lds + EXTRA_OFF + 640);
    const unsigned* GCNT = (const unsigned*)(a.ws + WS_CTL) + CW_GCNT + l * 32;
    if (tid < 32) s_ce[tid] = (int)__hip_atomic_load(GCNT + tid, __ATOMIC_RELAXED, __HIP_MEMORY_SCOPE_AGENT);
    __syncthreads();
    if (tid == 0) { int run = 0; for (int e = 0; e < 32; ++e) { s_tb[e] = run; run += (s_ce[e] + 255) >> 8; } s_tb[32] = run; }
    __syncthreads();
    if (tid < 32) { const int t0 = s_tb[tid], t1 = s_tb[tid + 1]; for (int t = t0; t < t1; ++t) tab[t] = tid; }
    __syncthreads();
}
template <bool FINAL> __device__ __forceinline__ void p_combine(const Args& a, LAS unsigned char* lds, int l, int lane, int wave) {
    const int gw = blockIdx.x * NWAVES + wave, NGW = gridDim.x * NWAVES;
    bf16* X = (bf16*)(a.ws + WS_X); const bf16* YS = (const bf16*)(a.ws + WS_YS); const int* TOPS = (const int*)(a.ws + WS_TOPE); const float* TOPW = (const float*)(a.ws + WS_TOPW);
    const LAS int* s_tb = (const LAS int*)(lds + EXTRA_OFF + 256);
    const float* MODS = (const float*)(a.ws + WS_MODS); bf16* H = (bf16*)(a.ws + WS_H);
    const int S2 = NGW * 2;
    auto load_idx = [&](int m, v4i (&ps)[2], f32x4 (&tws)[2]) {
#pragma unroll
        for (int r = 0; r < 2; ++r) { ps[r] = *(const v4i*)(TOPS + (size_t)(m + r) * 4); tws[r] = *(const f32x4*)(TOPW + (size_t)(m + r) * 4); } };
    auto load_rows = [&](int m, v4i (&ps)[2], v2u (&xr_)[2][4], v2u (&y_)[2][4][4]) {
#pragma unroll
        for (int r = 0; r < 2; ++r) {
#pragma unroll
            for (int k = 0; k < 4; ++k) { const int e = ps[r][k] >> 15; ps[r][k] = s_tb[e] * 256 + (ps[r][k] & (NTOK - 1)); }
#pragma unroll
            for (int j = 0; j < 4; ++j) { xr_[r][j] = ((const v2u*)(X + (size_t)(m + r) * D))[lane + 64 * j];
#pragma unroll
                for (int k = 0; k < 4; ++k) {
                    if (F8_Y) { y_[r][j][k].x = ((const unsigned*)((const unsigned char*)YS + (size_t)ps[r][k] * D))[lane + 64 * j]; y_[r][j][k].y = 0u; }
                    else y_[r][j][k] = ((const v2u*)(YS + (size_t)ps[r][k] * D))[lane + 64 * j]; } } } };
    v2u xr[2][4]; v2u y[2][4][4]; f32x4 tw[2]; v4i nps[2]; f32x4 ntw[2];
    if (gw * 2 < NTOK) { v4i cps[2]; load_idx(gw * 2, cps, tw); load_rows(gw * 2, cps, xr, y); if (gw * 2 + S2 < NTOK) load_idx(gw * 2 + S2, nps, ntw); }
    for (int m0 = gw * 2; m0 < NTOK; m0 += S2) {
        const int b = m0 / SEQ; const float* gt = MODS + (size_t)(l * 3 + b) * 6 * D + 5 * D;
        const int mn = m0 + S2, mnn = m0 + 2 * S2;
        v2u xn[2][4]; v2u yn[2][4][4]; v4i pps[2]; f32x4 ptw[2];
        if (mn < NTOK) load_rows(mn, nps, xn, yn);
        if (mnn < NTOK) load_idx(mnn, pps, ptw);
        f32x4 v[2][4];
#pragma unroll
        for (int r = 0; r < 2; ++r)
#pragma unroll
            for (int j = 0; j < 4; ++j) v[r][j] = (f32x4){bf_lo(xr[r][j].x), bf_hi(xr[r][j].x), bf_lo(xr[r][j].y), bf_hi(xr[r][j].y)};
#pragma unroll
        for (int r = 0; r < 2; ++r) { const int m = m0 + r;
#pragma unroll
            for (int j = 0; j < 4; ++j) { f32x4 s = (f32x4){0.f, 0.f, 0.f, 0.f};
#pragma unroll
                for (int k = 0; k < 4; ++k) {
                    if (F8_Y) { const int w = (int)y[r][j][k].x; const f32x2_t lo = __builtin_amdgcn_cvt_pk_f32_fp8(w, false), hi = __builtin_amdgcn_cvt_pk_f32_fp8(w, true);
                        s += (f32x4){lo.x, lo.y, hi.x, hi.y} * (tw[r][k] * (1.0f / YSCALE)); }
                    else s += (f32x4){bf_lo(y[r][j][k].x), bf_hi(y[r][j][k].x), bf_lo(y[r][j][k].y), bf_hi(y[r][j][k].y)} * tw[r][k]; }
                v[r][j] = v[r][j] + ((const f32x4*)gt)[lane + 64 * j] * s; }
            if (!FINAL) {
#pragma unroll
                for (int j = 0; j < 4; ++j) ((v2u*)(X + (size_t)m * D))[lane + 64 * j] = (v2u){pk2(v[r][j].x, v[r][j].y), pk2(v[r][j].z, v[r][j].w)};
                const float* md = MODS + (size_t)((l + 1) * 3 + b) * 6 * D;
                norm_mod_store<F8_MISC != 0>(v[r], a.in[I_GMIX] + (l + 1) * D, md + 1 * D, md + 0 * D, (unsigned char*)H + (size_t)m * D * (F8_MISC ? 1 : 2), lane);
            } else {
                float s = 0.f;
#pragma unroll
                for (int j = 0; j < 4; ++j) s += (v[r][j].x * v[r][j].x + v[r][j].y * v[r][j].y) + (v[r][j].z * v[r][j].z + v[r][j].w * v[r][j].w);
                const float rs = 1.0f / sqrtf(wave_sum(s) * (1.0f / D) + EPS);
#pragma unroll
                for (int j = 0; j < 4; ++j) __builtin_nontemporal_store(v[r][j] * rs * ((const f32x4*)a.in[I_GFINAL])[lane + 64 * j], &((f32x4*)(a.out + (size_t)m * D))[lane + 64 * j]);
            }
        }
#pragma unroll
        for (int r = 0; r < 2; ++r) { tw[r] = ntw[r]; nps[r] = pps[r]; ntw[r] = ptw[r];
#pragma unroll
            for (int j = 0; j < 4; ++j) { xr[r][j] = xn[r][j];
#pragma unroll
                for (int k = 0; k < 4; ++k) y[r][j][k] = yn[r][j][k]; } }
    }
}
__device__ __forceinline__ void p_dwconv(const Args& a, int tid) {
    const bf16* U = (const bf16*)(a.ws + WS_U); bf16* ZP = (bf16*)(a.ws + WS_ZP);
    const float* WDW = a.in[I_WCVDW]; const float* BDW = a.in[I_BCVDW];
    const int half = tid >> 8, cp = tid & 255;
    typedef float f32x2v __attribute__((ext_vector_type(2)));
    auto line_of = [&](int unit, int& c, int& len, int& p0, size_t& base, size_t& stride) {
        const int hu = unit * 2 + half;
        if (hu < 2048) { c = 2 * cp; len = GRIDW; p0 = (hu & 3) * 16; base = (size_t)(hu >> 2) * GRIDW * D; stride = D; }
        else { const int v = hu - 2048; const int b = v >> 10, w = (v >> 4) & 63; c = 512 + 2 * cp; len = GRIDR; p0 = (v & 15) * 16; base = ((size_t)b * SEQ + w) * D; stride = (size_t)GRIDW * D; } };
    auto load_in = [&](int c, int len, int p0, size_t base, size_t stride, unsigned (&u)[46]) {
#pragma unroll
        for (int i = 0; i < 46; ++i) { const int pp = p0 - 15 + i; u[i] = (pp >= 0 && pp < len) ? *(const unsigned*)(U + base + (size_t)pp * stride + c) : 0u; } };
    int c, len, p0; size_t base, stride; unsigned u[46];
    f32x2v w2[CONVW]; f32x2v bb = (f32x2v){0.f, 0.f}; int wc = -1;
    if ((int)blockIdx.x < 2048) { line_of(blockIdx.x, c, len, p0, base, stride); load_in(c, len, p0, base, stride, u); }
    for (int unit = blockIdx.x; unit < 2048; unit += gridDim.x) {
        int cn = 0, lenn = 0, p0n = 0; size_t basen = 0, striden = 0; unsigned un[46]; const int nu = unit + gridDim.x;
        if (nu < 2048) { line_of(nu, cn, lenn, p0n, basen, striden); load_in(cn, lenn, p0n, basen, striden, un); }
        if (wc != c) { wc = c;
#pragma unroll
            for (int j = 0; j < CONVW; ++j) w2[j] = *(const f32x2v*)(WDW + j * D + c);
            bb = *(const f32x2v*)(BDW + c); }
        f32x2v in2[46];
#pragma unroll
        for (int i = 0; i < 46; ++i) in2[i] = (f32x2v){bf_lo(u[i]), bf_hi(u[i])};
#pragma unroll
        for (int i = 0; i < 16; ++i) { f32x2v acc2 = bb;
#pragma unroll
            for (int j = 0; j < CONVW; ++j) acc2 = __builtin_elementwise_fma(in2[i + j], w2[j], acc2);
            *(unsigned*)(ZP + base + (size_t)(p0 + i) * stride + c) = pk2(acc2.x, acc2.y); }
        c = cn; len = lenn; p0 = p0n; base = basen; stride = striden;
#pragma unroll
        for (int i = 0; i < 46; ++i) u[i] = un[i];
    }
}
__device__ __forceinline__ void p_ln_silu(const Args& a, int lane, int wave) {
    const int gw = blockIdx.x * NWAVES + wave, NGW = gridDim.x * NWAVES;
    const bf16* ZP = (const bf16*)(a.ws + WS_ZP); bf16* Z = (bf16*)(a.ws + WS_Z);
    f32x4 gg[4], bb[4];
#pragma unroll
    for (int j = 0; j < 4; ++j) { gg[j] = ((const f32x4*)a.in[I_GCVLN])[lane + 64 * j]; bb[j] = ((const f32x4*)a.in[I_BCVLN])[lane + 64 * j]; }
    v2u y[2][4];
    if (gw * 2 < NTOK) {
#pragma unroll
        for (int r = 0; r < 2; ++r)
#pragma unroll
            for (int j = 0; j < 4; ++j) y[r][j] = ((const v2u*)(ZP + (size_t)(gw * 2 + r) * D))[lane + 64 * j];
    }
    for (int m0 = gw * 2; m0 < NTOK; m0 += NGW * 2) {
        v2u yn[2][4]; const int mn = m0 + NGW * 2;
#pragma unroll
        for (int r = 0; r < 2; ++r)
#pragma unroll
            for (int j = 0; j < 4; ++j) yn[r][j] = mn < NTOK ? ((const v2u*)(ZP + (size_t)(mn + r) * D))[lane + 64 * j] : (v2u){0u, 0u};
#pragma unroll
        for (int r = 0; r < 2; ++r) {
            f32x4 v[4]; float s = 0.f;
#pragma unroll
            for (int j = 0; j < 4; ++j) { v[j] = (f32x4){bf_lo(y[r][j].x), bf_hi(y[r][j].x), bf_lo(y[r][j].y), bf_hi(y[r][j].y)}; s += (v[j].x + v[j].y) + (v[j].z + v[j].w); }
            const float mean = wave_sum(s) * (1.0f / D); float s2 = 0.f;
#pragma unroll
            for (int j = 0; j < 4; ++j) { v[j] = v[j] - mean; s2 += (v[j].x * v[j].x + v[j].y * v[j].y) + (v[j].z * v[j].z + v[j].w * v[j].w); }
            const float rstd = 1.0f / sqrtf(wave_sum(s2) * (1.0f / D) + EPS);
#pragma unroll
            for (int j = 0; j < 4; ++j) {
                f32x4 yy = v[j] * rstd * gg[j] + bb[j]; yy.x *= fsig(yy.x); yy.y *= fsig(yy.y); yy.z *= fsig(yy.z); yy.w *= fsig(yy.w);
                store_row4<F8_MISC != 0>((unsigned char*)Z + (size_t)(m0 + r) * D * (F8_MISC ? 1 : 2), lane, j, yy, 4.0f); }
        }
#pragma unroll
        for (int r = 0; r < 2; ++r)
#pragma unroll
            for (int j = 0; j < 4; ++j) y[r][j] = yn[r][j];
    }
}


enum { PH_PRO = 0, PH_NORM0, PH_INPROJ, PH_SCANA, PH_SCANC, PH_READOUT, PH_OUTPROJ, PH_ROUTER0, PH_G1_0, PH_G2_0, PH_COMB0, PH_CVIN, PH_DWCONV, PH_LN, PH_CVOUT, PH_ROUTER1, PH_G1_1, PH_G2_1, PH_FINAL, NPH };
#ifndef AEPI
#define AEPI 1
#endif
#ifndef REPMASK
#define REPMASK 0ull
#endif
#ifndef SCAN_NAIVE
#define SCAN_NAIVE 0
#endif
#if defined(__HIP_DEVICE_COMPILE__)
#define NO_PK_F32
#else
#define NO_PK_F32
#endif
__global__ void NO_PK_F32 __launch_bounds__(NTHR, 2) fwd_kernel(Args args) {
    extern __shared__ __attribute__((aligned(16))) unsigned char lds_raw[];
    LAS unsigned char* lds = (LAS unsigned char*)lds_raw;
    const int tid = threadIdx.x, lane = tid & 63, wave = __builtin_amdgcn_readfirstlane(tid >> 6);
    const int G = gridDim.x, bid = blockIdx.x;
    unsigned char* ws = args.ws;
    for (int u = tid; u < (LDS_BYTES - LDSCTL_OFF) / 4; u += NTHR) ((LAS unsigned*)(lds + LDSCTL_OFF))[u] = 0u;
    __syncthreads();
    volatile LAS unsigned* MISC = (volatile LAS unsigned*)(lds + MISC_OFF);
    XcdBarrier bar = xcd_barrier_post((unsigned*)(ws + WS_CTL) + CW_BAR + args.li * XCD_BAR_WORDS, MISC + 8);
    const int lo = args.ph_lo, hi = args.ph_hi;
    if (TL_PROBE && tid == 0) MISC[48] = (unsigned)__builtin_amdgcn_s_memrealtime();
    if (tid == 0) __hip_atomic_store((unsigned*)(ws + WS_CTL) + CW_XMAP + bid, xb_xcc_id() + 1u, __ATOMIC_RELAXED, __HIP_MEMORY_SCOPE_AGENT);
#define IN(k) (lo <= (k) && (k) < hi)
    int cv_n = 0; unsigned bseq = 0;
#ifndef FLAT_BARRIER
#define FLAT_BARRIER 0
#endif
#define SEAM(k) do { if (IN(k) && IN((k) + 1)) { ++bseq; if (FLAT_BARRIER) flat_barrier_work((unsigned*)(ws + WS_CTL) + CW_FLAT, args, lds, wave, lane, cv_n, MISC + 12, bseq); else xcd_barrier_work(bar, args, lds, wave, lane, cv_n, MISC + 12, bseq); \
        if (TL_PROBE && tid == 0) MISC[48 + (k) + 1] = (unsigned)__builtin_amdgcn_s_memrealtime(); } } while (0)
#define PHASE(k, ...) if (IN(k)) { __VA_ARGS__; if ((REPMASK >> (k)) & 1ull) { __syncthreads(); __VA_ARGS__; } if (TL_PROBE && tid == 0) MISC[72 + (k)] = (unsigned)__builtin_amdgcn_s_memrealtime(); } SEAM(k);
    typedef pg8::bf16_t pbf;

    const bool merge_pro = false && (G >= 32) && IN(PH_PRO) && IN(PH_NORM0);
    if (IN(PH_PRO)) { p_mods(args, lds, tid, lane, wave); p_weights(args, lds, lane, wave); if (merge_pro) wait_mods0(args, tid); }
    if (!merge_pro) SEAM(PH_PRO);
    const bool ctx_early = SPLIT_IN && (G == 256);
    PHASE(PH_NORM0, {
        if (ctx_early && bid < 24) {
            const int cb = bid / 12, cj = bid % 12;
            p_norm0(args, lane, wave, NWAVES, NTOK + cb * CTXL, NTOK + cb * CTXL + CTXL);
            VM_WAIT(); __syncthreads();
            if (cj < 8) {
                pg8::Gemm g{(const pbf*)(ws + WS_H8), (const pbf*)(ws + WS_WIN8), D / 2, 0};
                pg8::OneUnit S1{NTOK / 256 + cb, cj};
                pg8::EpiHgrnIn E{(pbf*)(ws + WS_Q), (WS_V - WS_Q) / 2, (_Float16*)(ws + WS_LFF), (WS_LFB - WS_LFF) / 2, args.in[I_HGAMMA], 2};
                pg8::gemm_phase<pg8::EpiHgrnIn, pg8::OneUnit, AEPI != 0, true, true, 0x79797979, 0x7F7F7F7F>(lds + RING_OFF, g, S1, E);
            } else {
                pg8::Gemm g{(const pbf*)(ws + WS_H), (const pbf*)(ws + WS_WIN), D, 0};
                pg8::OneUnit S1{NTOK / 256 + cb, 4 + (cj - 8)};
                pg8::EpiHgrnIn E{(pbf*)(ws + WS_Q), (WS_V - WS_Q) / 2, (_Float16*)(ws + WS_LFF), (WS_LFB - WS_LFF) / 2, args.in[I_HGAMMA], 1};
                pg8::gemm_phase<pg8::EpiHgrnIn, pg8::OneUnit, AEPI != 0, true, false>(lds + RING_OFF, g, S1, E);
            }
        } else if (ctx_early) p_norm0(args, lane, (bid - 24) * NWAVES + wave, (G - 24) * NWAVES, 0, NTOK);
        else p_norm0(args, lane, bid * NWAVES + wave, G * NWAVES, 0, MROWS);
    })
    PHASE(PH_INPROJ, {
        static_assert(WS_V - WS_Q == WS_SG - WS_V, "Q|V|SG equally spaced");
        if (SPLIT_IN) {
            const int nMi = ctx_early ? NTOK / 256 : MROWS / 256;
            {
                pg8::Gemm g{(const pbf*)(ws + WS_H8), (const pbf*)(ws + WS_WIN8), D / 2, 0};
                pg8::TileOrder S; S.init(nMi, (G_F8 ? 3 : 2) * D / 256, G, bid, nullptr);
                pg8::EpiHgrnIn E{(pbf*)(ws + WS_Q), (WS_V - WS_Q) / 2, (_Float16*)(ws + WS_LFF), (WS_LFB - WS_LFF) / 2, args.in[I_HGAMMA], 2};
                pg8::gemm_phase<pg8::EpiHgrnIn, pg8::TileOrder, AEPI != 0, true, true, 0x79797979, 0x7F7F7F7F>(lds + RING_OFF, g, S, E);
            }
            {
                pg8::Gemm g{(const pbf*)(ws + WS_H), (const pbf*)(ws + WS_WIN), D, 0};
                pg8::TileOrder S; S.init(nMi, (G_F8 ? 2 : 3) * D / 256, G, bid, nullptr);
                pg8::EpiHgrnIn E{(pbf*)(ws + WS_Q), (WS_V - WS_Q) / 2, (_Float16*)(ws + WS_LFF), (WS_LFB - WS_LFF) / 2, args.in[I_HGAMMA], 1};
                pg8::gemm_phase<pg8::EpiHgrnIn, pg8::TileOrder, AEPI != 0, true, false>(lds + RING_OFF, g, S, E);
            }
        } else {
            pg8::Gemm g{(const pbf*)(ws + WS_H), (const pbf*)(ws + WS_WIN), F8_IN ? D / 2 : D, 0};
            pg8::TileOrder S; S.init(MROWS / 256, 5 * D / 256, G, bid, nullptr);
            pg8::EpiHgrnIn E{(pbf*)(ws + WS_Q), (WS_V - WS_Q) / 2, (_Float16*)(ws + WS_LFF), (WS_LFB - WS_LFF) / 2, args.in[I_HGAMMA], 0};
            pg8::gemm_phase<pg8::EpiHgrnIn, pg8::TileOrder, AEPI != 0, true, F8_IN != 0, 0x79797979, 0x7F7F7F7F>(lds + RING_OFF, g, S, E);
        }
    })
#if SCAN_NAIVE
    PHASE(PH_SCANA, { p_scan_naive(args, lds, tid); })
    PHASE(PH_SCANC, { })
#else
    PHASE(PH_SCANA, { p_scan_a(args, lds, tid, lane, wave); })
    PHASE(PH_SCANC, { p_scan_c(args, lds, tid, lane, wave); })
#endif
    PHASE(PH_READOUT, { p_readout(args, lane, wave); })
    PHASE(PH_OUTPROJ, {
        pg8::Gemm g{(const pbf*)(ws + WS_YIN), (const pbf*)(ws + WS_WOUT), F8_MISC ? D / 2 : D, 0};
        pg8::TileOrder S; S.init(NTOK / 256, D / 256, G, bid, nullptr);
        pg8::EpiResGate<false, true> E{args.in[I_X], (void*)(ws + WS_X), (const float*)(ws + WS_MODS) + 2 * D, 6 * D, SEQ, nullptr};
        pg8::gemm_phase<pg8::EpiResGate<false, true>, pg8::TileOrder, AEPI != 0, true, F8_MISC != 0, 0x79797979, 0x7D7D7D7D>(lds + RING_OFF, g, S, E);
    })
#ifndef LDSB
#define LDSB 1
#endif
#ifndef XBAR_PROBE
#define XBAR_PROBE 0
#endif
#ifndef G2_NS
#define G2_NS 0
#endif
#ifndef G1_NS
#define G1_NS 0
#endif
#ifndef MOE_HANDOFF
#define MOE_HANDOFF 1
#endif
#ifndef MOE_WT
#define MOE_WT 0
#endif
#define MOE_PHASES(l, pb) \
    if (IN(pb + 0)) { p_router(args, lds, l, tid, lane, wave); cv_finish(args, lds, wave, lane, cv_n, (l + 1) * CV_L0); } SEAM(pb + 0); \
    if ((l) == 1) { if (XBAR_PROBE >= 1) SEAM(pb + 0); if (XBAR_PROBE >= 2) SEAM(pb + 0); if (XBAR_PROBE >= 3) SEAM(pb + 0); if (XBAR_PROBE >= 4) SEAM(pb + 0); }     \
    if (IN(pb + 1) || IN(pb + 2) || IN(pb + 3)) { \
        moe_tables(args, lds, l, tid); \
        LAS int* tab = (LAS int*)(lds + EXTRA_OFF + 640); \
        const LAS int* s_tb = (const LAS int*)(lds + EXTRA_OFF + 256); const LAS int* s_ce = s_tb + 40; \
        const int ntiles = __builtin_amdgcn_readfirstlane(s_tb[32]); \
        const bool hand = MOE_HANDOFF && (G == 256) && IN(pb + 1) && IN(pb + 2) && !((REPMASK >> (pb + 1)) & 3ull) && (MOE_WT || xmap_ok); \
        const int xl = (hand && !MOE_WT) ? 1 : 0; \
        unsigned* tcnt = (unsigned*)(ws + WS_CTL) + CW_TCNT + l * 32768; \
        const int c2 = (hand && MOE_WT) ? ((bid - ((((ntiles * 8) & 255) + 7) & ~7)) & 255) : bid;     \
        const int tv = (((bid & 7) + 1) * ntiles >> 3) - ((bid & 7) * ntiles >> 3);                   \
        LAS int* ut1 = (LAS int*)(lds + EXTRA_OFF + 13824); LAS int* ut2 = ut1 + 32;                  \
        if (wave == 0) { \
            int pm_ = 0, pn_ = 0; \
            const bool h1 = lane < 32 && pg8::MoeOrder::unit_of(xl, ntiles, 2 * D / 256, G, bid, bid >> 3, lane, pm_, pn_); \
            if (lane < 32) ut1[lane] = h1 ? (pm_ | (pn_ << 16) | (tab[pm_] << 24)) : 0; \
            const bool h2 = lane < 32 && pg8::MoeOrder::unit_of(xl, ntiles, D / 256, G, c2, ((bid >> 3) - ((tv * 8) & 31)) & 31, lane, pm_, pn_); \
            if (lane < 32) ut2[lane] = h2 ? (pm_ | (pn_ << 16) | (tab[pm_] << 24)) : 0; \
            const int n1 = __popcll(__ballot(h1)), n2 = __popcll(__ballot(h2)); \
            if (lane == 0) { ut1[64] = n1; ut1[65] = n2; } \
        } \
        __syncthreads(); \
        const int nu1 = __builtin_amdgcn_readfirstlane(ut1[64]), nu2 = __builtin_amdgcn_readfirstlane(ut1[65]); \
        if (IN(pb + 1)) { \
            LAS unsigned short* tt = (LAS unsigned short*)(lds + EXTRA_OFF + 2816);     \
            pg8::MoeOrder S; S.ut = ut1; S.nu = nu1; S.cnt = tcnt; S.rdy = 0u; S.mode = hand ? 0 : 2; \
            { const int* STOK = (const int*)(ws + WS_STOK); int tv_[10];                         \
              _Pragma("unroll") for (int n_ = 0; n_ < 10; ++n_) { const int idx = tid + NTHR * n_; tv_[n_] = 0; \
                  if (idx < nu1 * 256) { const int uw = ut1[idx >> 8], pm_ = uw & 0xFFFF, e_ = (uw >> 24) & 0xFF, vi = (pm_ - s_tb[e_]) * 256 + (idx & 255); if (vi < s_ce[e_]) tv_[n_] = STOK[(size_t)e_ * NTOK + vi]; } } \
              _Pragma("unroll") for (int n_ = 0; n_ < 10; ++n_) { const int idx = tid + NTHR * n_; if (idx < nu1 * 256) tt[idx] = (unsigned short)tv_[n_]; } } \
            __syncthreads(); \
            pg8::Gemm g{(const pbf*)(ws + WS_H), (const pbf*)(ws + WS_W1 + (size_t)l * NE * 2 * D * D), D / 2, (size_t)2 * D * D, tt};   \
            pg8::EpiPair<0, true, 4, MOE_WT != 0, LDSB != 0> E{(pbf*)(ws + WS_ACT), args.in[I_BE1] + (size_t)l * NE * 2 * D, (const LAS float*)(lds + EXTRA_OFF + 14336)}; \
            pg8::gemm_phase<pg8::EpiPair<0, true, 4, MOE_WT != 0, LDSB != 0>, pg8::MoeOrder, AEPI != 0, true, true, 0x79797979, 0x7F7F7F7F, true, G1_NS>(lds + RING_OFF, g, S, E); \
            if ((REPMASK >> (pb + 1)) & 1ull) { __syncthreads(); pg8::gemm_phase<pg8::EpiPair<0, true, 4, MOE_WT != 0, LDSB != 0>, pg8::MoeOrder, AEPI != 0, true, true, 0x79797979, 0x7F7F7F7F, true, G1_NS>(lds + RING_OFF, g, S, E); } \
        } \
        pg8::MoeOrder S2; S2.ut = ut2; S2.nu = nu2; S2.cnt = tcnt; S2.rdy = 0u; S2.mode = hand ? 1 : 2; \
        if (hand) {                                                          \
            if (wave == 0) { \
                const unsigned v = lane < nu2 ? __hip_atomic_load(tcnt + 32 * (ut2[lane & 31] & 0xFFFF), __ATOMIC_RELAXED, __HIP_MEMORY_SCOPE_AGENT) : 64u; \
                const unsigned long long m = __ballot(v >= 64u); \
                __builtin_amdgcn_fence(__ATOMIC_ACQUIRE, "agent"); asm volatile("s_waitcnt vmcnt(0)" ::: "memory"); \
                if (lane == 0) MISC[16] = (unsigned)m; \
            } \
            __syncthreads(); \
            S2.rdy = __builtin_amdgcn_readfirstlane(MISC[16]); \
        } else SEAM(pb + 1); \
        PHASE(pb + 2, { \
            pg8::Gemm g{(const pbf*)(ws + WS_ACT), (const pbf*)(ws + WS_W2 + (size_t)l * NE * D * D), D / 2, (size_t)D * D}; \
            pg8::EpiMoeOut<F8_Y != 0, YSCALE, LDSB != 0> E{(pbf*)(ws + WS_YS), args.in[I_BE2] + (size_t)l * NE * D, (const LAS float*)(lds + EXTRA_OFF + 14336)}; \
            pg8::gemm_phase<pg8::EpiMoeOut<F8_Y != 0, YSCALE, LDSB != 0>, pg8::MoeOrder, AEPI != 0, true, true, 0x79797979, 0x7D7D7D7D, false, G2_NS>(lds + RING_OFF, g, S2, E);   \
        }) \
    }
    bool xmap_ok = false;
    if (MOE_HANDOFF && !MOE_WT && G == 256 && lo == 0) {
        if (wave == 0) {
            const unsigned* xm = (const unsigned*)(ws + WS_CTL) + CW_XMAP; bool ok = true;
#pragma unroll
            for (int k = 0; k < 4; ++k) { const int b = lane + 64 * k; const unsigned mine = __hip_atomic_load(xm + b, __ATOMIC_RELAXED, __HIP_MEMORY_SCOPE_AGENT), cls = __hip_atomic_load(xm + (b & 7), __ATOMIC_RELAXED, __HIP_MEMORY_SCOPE_AGENT);
                ok = ok && mine != 0u && mine == cls; }
            const unsigned me = __hip_atomic_load(xm + (lane & 7), __ATOMIC_RELAXED, __HIP_MEMORY_SCOPE_AGENT);
#pragma unroll
            for (int j = 1; j < 8; ++j) { const unsigned other = (unsigned)__shfl((int)me, (lane + j) & 7); ok = ok && other != me; }
            const bool all_ok = __all(ok);
            if (lane == 0) MISC[17] = all_ok ? 1u : 0u;
        }
        __syncthreads();
        xmap_ok = __builtin_amdgcn_readfirstlane(MISC[17]) != 0u;
    }
    MOE_PHASES(0, PH_ROUTER0)
    PHASE(PH_COMB0, { p_combine<false>(args, lds, 0, lane, wave); })
    PHASE(PH_CVIN, {
        pg8::Gemm g{(const pbf*)(ws + WS_H), (const pbf*)(ws + WS_WCVIN), F8_MISC ? D / 2 : D, 0};
        pg8::TileOrder S; S.init(NTOK / 256, 2 * D / 256, G, bid, nullptr);
        pg8::EpiPair<1> E{(pbf*)(ws + WS_U), args.in[I_BCVIN]};
        pg8::gemm_phase<pg8::EpiPair<1>, pg8::TileOrder, AEPI != 0, true, F8_MISC != 0, 0x79797979, 0x7F7F7F7F>(lds + RING_OFF, g, S, E);
    })
    PHASE(PH_DWCONV, { p_dwconv(args, tid); })
    PHASE(PH_LN, { p_ln_silu(args, lane, wave); })
    PHASE(PH_CVOUT, {
        pg8::Gemm g{(const pbf*)(ws + WS_Z), (const pbf*)(ws + WS_WCVOUT), F8_MISC ? D / 2 : D, 0};
        pg8::TileOrder S; S.init(NTOK / 256, D / 256, G, bid, nullptr);
        pg8::EpiResGate<true, true> E{(const void*)(ws + WS_X), (void*)(ws + WS_X), (const float*)(ws + WS_MODS) + 3 * 6 * D + 2 * D, 6 * D, SEQ, args.in[I_BCVOUT]};
        pg8::gemm_phase<pg8::EpiResGate<true, true>, pg8::TileOrder, AEPI != 0, true, F8_MISC != 0, 0x79797979, 0x7D7D7D7D>(lds + RING_OFF, g, S, E);
    })
#ifndef CLK_PROBE
#define CLK_PROBE 0
#endif
#if CLK_PROBE
    if (bid == 0 && tid == 0) { const unsigned long long c = __builtin_amdgcn_s_memtime(), w = __builtin_amdgcn_s_memrealtime(); MISC[20] = (unsigned)c; MISC[21] = (unsigned)(c >> 32); MISC[22] = (unsigned)w; MISC[23] = (unsigned)(w >> 32); }
#endif
    MOE_PHASES(1, PH_ROUTER1)
#if CLK_PROBE
    if (bid == 0 && tid == 0) { const unsigned long long c = __builtin_amdgcn_s_memtime(), w = __builtin_amdgcn_s_memrealtime(); MISC[24] = (unsigned)c; MISC[25] = (unsigned)(c >> 32); MISC[26] = (unsigned)w; MISC[27] = (unsigned)(w >> 32); }
#endif
    if (IN(PH_FINAL)) { p_combine<true>(args, lds, 1, lane, wave); }
#if KL_PROBE
    static_assert(pg8::KLP_LDS == MISC_OFF + 4 * 28, "probe words");
    if (bid == 0 && tid == 0) {
        const unsigned long long kl = ((unsigned long long)MISC[29] << 32) | MISC[28]; const unsigned nun = MISC[30] ? MISC[30] : 1u;
        const unsigned long long tot = ((unsigned long long)MISC[37] << 32) | MISC[36];
        const unsigned long long ticks = KL_PROBE == 1 ? kl * 10ull / (8ull * nun) : (tot - kl) * 5ull / nun;
        const unsigned long long t_end = __builtin_amdgcn_s_memrealtime() + (ticks < 100000ull ? ticks : 100000ull);
        while (__builtin_amdgcn_s_memrealtime() < t_end) __builtin_amdgcn_s_sleep(8);
    }
#endif
#if TL_PROBE
    if (bid == 0 && tid == 0) { const unsigned ticks = TL_BODY ? MISC[72 + TL_B] - MISC[48 + TL_B] : MISC[48 + TL_B + 1] - MISC[48 + TL_A + 1];     const unsigned long long t_end = __builtin_amdgcn_s_memrealtime() + 2ull * (ticks < 200000u ? ticks : 200000u); while (__builtin_amdgcn_s_memrealtime() < t_end) __builtin_amdgcn_s_sleep(8); }
#endif
#if CVF_PROBE
    if (bid == 0 && tid == 0) { const unsigned long long t_end = __builtin_amdgcn_s_memrealtime() + 2ull * MISC[40]; while (__builtin_amdgcn_s_memrealtime() < t_end) __builtin_amdgcn_s_sleep(8); }
#endif
#if CLK_PROBE
    if (bid == 0 && tid == 0) {
        const unsigned long long c0 = ((unsigned long long)MISC[21] << 32) | MISC[20], w0 = ((unsigned long long)MISC[23] << 32) | MISC[22], c1 = ((unsigned long long)MISC[25] << 32) | MISC[24], w1 = ((unsigned long long)MISC[27] << 32) | MISC[26];
        const unsigned long long ticks = (c1 - c0) * 1000ull / (w1 - w0 + 1ull);
        const unsigned long long t_end = __builtin_amdgcn_s_memrealtime() + (ticks < 100000ull ? ticks : 100000ull);
        while (__builtin_amdgcn_s_memrealtime() < t_end) __builtin_amdgcn_s_sleep(8);
    }
#endif
#undef MOE_PHASES
#undef PHASE
#undef IN
#undef SEAM
}

extern "C" void kernel_launch(void* const* d_in, const int* in_sizes, int n_in, void* d_out, int out_size, void* d_ws, size_t ws_size, hipStream_t stream) {
    static int grid = 0;
    if (grid == 0) {
        if (n_in != N_IN || in_sizes[0] != NTOK * D || out_size != NTOK * D || ws_size < WS_END) { fprintf(stderr, "kernel_launch: unexpected shapes / workspace (n_in %d, in0 %d, out %d, ws %zu, need %zu); nothing launched\n", n_in, n_in > 0 ? in_sizes[0] : -1, out_size, ws_size, (size_t)WS_END); grid = -1; return; }
        int dev = 0, cus = 0, per_cu = 0;
        if (hipGetDevice(&dev) != hipSuccess || hipDeviceGetAttribute(&cus, hipDeviceAttributeMultiprocessorCount, dev) != hipSuccess) { grid = -1; return; }
        if (hipFuncSetAttribute((const void*)fwd_kernel, hipFuncAttributeMaxDynamicSharedMemorySize, LDS_BYTES) != hipSuccess) { fprintf(stderr, "kernel_launch: hipFuncSetAttribute failed\n"); grid = -1; return; }
        if (hipOccupancyMaxActiveBlocksPerMultiprocessor(&per_cu, (const void*)fwd_kernel, NTHR, LDS_BYTES) != hipSuccess || per_cu < 1) { fprintf(stderr, "kernel_launch: occupancy query reports %d workgroups per CU\n", per_cu); }
        (void)hipGetLastError();
        grid = cus;
    }
    if (grid < 0) return;
    if (hipMemsetAsync((char*)d_ws + WS_CTL, 0, CTL_ZERO_BYTES, stream) != hipSuccess) return;
#ifdef DIAG_MEMSET
    (void)hipMemsetAsync((char*)d_ws + WS_SP, 0, (WS_WIN - WS_SP), stream); (void)hipMemsetAsync((char*)d_ws + WS_OF, 0, (WS_YIN - WS_OF), stream);
#endif
    Args a{};
    for (int i = 0; i < N_IN; ++i) a.in[i] = (const float*)d_in[i];
    a.out = (float*)d_out; a.ws = (unsigned char*)d_ws; a.pad = 0;
#ifndef MK_CUTS
    a.ph_lo = 0; a.ph_hi = NPH; a.li = 0;
    hipLaunchKernelGGL(fwd_kernel, dim3(grid), dim3(NTHR), LDS_BYTES, stream, a);
#else
    const int cuts[] = {MK_CUTS};
    const int nc = (int)(sizeof(cuts) / sizeof(cuts[0]));
    for (int li = 0; li + 1 < nc; ++li) { a.ph_lo = cuts[li]; a.ph_hi = cuts[li + 1]; a.li = li; hipLaunchKernelGGL(fwd_kernel, dim3(grid), dim3(NTHR), LDS_BYTES, stream, a); }
#endif
}
```

```cpp
#include <hip/hip_runtime.h>
#include <cstdio>
#include <cstdint>
__device__ __forceinline__ void wg_sync_() { __builtin_amdgcn_fence(__ATOMIC_RELEASE, "workgroup"); __builtin_amdgcn_s_barrier(); __builtin_amdgcn_fence(__ATOMIC_ACQUIRE, "workgroup"); }
#define __syncthreads() wg_sync_()
#define __ballot(p) __builtin_amdgcn_ballot_w64((p) != 0)
#define __all(p) (__builtin_amdgcn_ballot_w64(!(p)) == 0ull)
#define __shfl(v, src) __builtin_amdgcn_ds_bpermute((int)(src) << 2, (int)(v))
#define __popcll(x) __builtin_popcountll(x)

namespace pg8 {
#define PG8_LAS __attribute__((address_space(3)))
typedef unsigned short bf16_t;
typedef short bf16x8 __attribute__((ext_vector_type(8)));
typedef float f32x4 __attribute__((ext_vector_type(4)));
typedef unsigned u32x4 __attribute__((ext_vector_type(4)));
typedef unsigned u32x2 __attribute__((ext_vector_type(2)));
typedef int i32x4 __attribute__((ext_vector_type(4)));
typedef int i32x8 __attribute__((ext_vector_type(8)));
#ifndef KL_PROBE
#define KL_PROBE 0
#endif
constexpr int KLP_LDS = 139264 + 320 + 4 * 28;
constexpr int BM = 256, BK = 64, HALF = 128, HTB = HALF * BK * 2  , STAGE_BYTES = 8 * HTB, NXCD = 8, WGM = 8;

__host__ __device__ __forceinline__ int lds_byte(int r, int c) { const int st = (r >> 4) * 2 + (c >> 5), rr = r & 15, cc = c & 31, ob = rr * 64 + cc * 2; return st * 1024 + (ob ^ (((ob >> 9) & 1) << 5)); }
__host__ __device__ __forceinline__ void stage_rc(int b, int& R, int& C) { const int st = b / 1024, sb = b % 1024, swz = sb ^ (((sb >> 9) & 1) << 5); R = (st >> 1) * 16 + swz / 64; C = (st & 1) * 32 + (swz % 64) / 2; }
__host__ __device__ __forceinline__ int perm32(int rho) { const int n = rho >> 4, i = rho & 15; return 8 * (i >> 2) + 4 * n + (i & 3); }

struct Unit { int pm, pn, e; };
struct Gemm { const bf16_t* A; const bf16_t* Bt; int K; size_t estride; const PG8_LAS unsigned short* tt; };

struct TileOrder {
    int nM, nN, nwg, G, c; const PG8_LAS int* tile_e;
    __device__ __forceinline__ void init(int nM_, int nN_, int G_, int c_, const PG8_LAS int* te) { nM = nM_; nN = nN_; nwg = nM * nN; G = G_; c = c_; tile_e = te; }
    __device__ __forceinline__ bool next(int i, Unit& u) const {
        const long L = (long)i * G + c; if (L >= nwg) return false;
        int wgid = (int)L; { const int q = nwg / NXCD, r = nwg % NXCD, xcd = wgid % NXCD, off = wgid / NXCD; wgid = (xcd < r ? xcd * (q + 1) : r * (q + 1) + (xcd - r) * q) + off; }
        const int nig = WGM * nN, gid = wgid / nig, fm = gid * WGM, gsz = (nM - fm) < WGM ? (nM - fm) : WGM;
        u.pm = fm + ((wgid % nig) % gsz); u.pn = (wgid % nig) / gsz;
        u.e = tile_e ? __builtin_amdgcn_readfirstlane(tile_e[u.pm]) : 0; return true;
    }
    static constexpr bool PUBLISH = false;
    __device__ __forceinline__ bool probe_on() const { return false; }
    __device__ __forceinline__ void a_ready(const Unit&, int) const {}
    __device__ __forceinline__ void done(const Unit&) const {}
    __device__ __forceinline__ void publish(int, int) const {}
};

struct MoeOrder {
    static constexpr bool PUBLISH = true;
    const PG8_LAS int* ut; int nu;
    unsigned* cnt; unsigned rdy; int mode;
    static __device__ __forceinline__ bool unit_of(int xl, int nM, int nN, int G, int c, int rrot, int i, int& pm, int& pn) {
        if (!xl) { TileOrder T; T.init(nM, nN, G, c, nullptr); Unit u; if (!T.next(i, u)) return false; pm = u.pm; pn = u.pn; return true; }
        const int v = c & 7, T0 = (v * nM) >> 3, Tv = (((v + 1) * nM) >> 3) - T0;
        const int Lx = i * 32 + rrot; if (Lx >= Tv * nN) return false;
        const int nig = WGM * nN, gid = Lx / nig, fm = gid * WGM, gsz = (Tv - fm) < WGM ? (Tv - fm) : WGM, w = Lx % nig;
        pm = T0 + fm + (w % gsz); pn = w / gsz; return true;
    }
    __device__ __forceinline__ bool next(int i, Unit& u) const {
        if (i >= nu) return false;
        const int v = __builtin_amdgcn_readfirstlane(ut[i]); u.pm = v & 0xFFFF; u.pn = (v >> 16) & 0xFF; u.e = (v >> 24) & 0xFF; return true;
    }
    __device__ __forceinline__ bool probe_on() const { return mode == 0; }
    __device__ __forceinline__ void done(const Unit&) const {}
    __device__ __forceinline__ void publish(int pm, int lane) const {
        if (mode == 0 && lane == 0) (void)__hip_atomic_fetch_add(cnt + 32 * pm, 1u, __ATOMIC_RELAXED, __HIP_MEMORY_SCOPE_AGENT);
    }
    __device__ __forceinline__ void a_ready(const Unit& u, int i) const {
        if (mode != 1 || ((rdy >> i) & 1u)) return;
        if (__builtin_amdgcn_readfirstlane(threadIdx.x >> 6) == 0) {
            unsigned sp = 0;
            while (__hip_atomic_load(cnt + 32 * u.pm, __ATOMIC_RELAXED, __HIP_MEMORY_SCOPE_AGENT) < 64u) { __builtin_amdgcn_s_sleep(1); if (++sp > (1u << 20)) break; }
            __builtin_amdgcn_fence(__ATOMIC_ACQUIRE, "agent");
            asm volatile("s_waitcnt vmcnt(0)" ::: "memory");
        }
        __builtin_amdgcn_s_barrier();
    }
};

struct OneUnit {
    int pm, pn;
    __device__ __forceinline__ bool next(int i, Unit& u) const { if (i != 0) return false; u.pm = pm; u.pn = pn; u.e = 0; return true; }
    static constexpr bool PUBLISH = false;
    __device__ __forceinline__ bool probe_on() const { return false; }
    __device__ __forceinline__ void a_ready(const Unit&, int) const {}
    __device__ __forceinline__ void done(const Unit&) const {}
    __device__ __forceinline__ void publish(int, int) const {}
};

__device__ __forceinline__ unsigned cvt_pk_bf16(float lo, float hi) { unsigned r; asm volatile("v_cvt_pk_bf16_f32 %0, %1, %2" : "=v"(r) : "v"(lo), "v"(hi)); return r; }
__device__ __forceinline__ float fsigmoid(float x) { return __builtin_amdgcn_rcpf(1.0f + __expf(-x)); }


struct EpiHgrnIn {
    static constexpr bool PERM = true, AFTER_DRAIN = false, LDS_BIAS = false;
    bf16_t* Q; size_t qstride; _Float16* LFF; size_t lfstride; const float* gamma; int mode;
    static __device__ __forceinline__ f32x4 vexp2(f32x4 t) { f32x4 e; e[0] = __builtin_amdgcn_exp2f(t[0]); e[1] = __builtin_amdgcn_exp2f(t[1]); e[2] = __builtin_amdgcn_exp2f(t[2]); e[3] = __builtin_amdgcn_exp2f(t[3]); return e; }
    static __device__ __forceinline__ f32x4 vrcp(f32x4 d) { f32x4 r; r[0] = __builtin_amdgcn_rcpf(d[0]); r[1] = __builtin_amdgcn_rcpf(d[1]); r[2] = __builtin_amdgcn_rcpf(d[2]); r[3] = __builtin_amdgcn_rcpf(d[3]); return r; }
    static __device__ __forceinline__ f32x4 vlog2(f32x4 d) { f32x4 r; r[0] = __builtin_amdgcn_logf(d[0]); r[1] = __builtin_amdgcn_logf(d[1]); r[2] = __builtin_amdgcn_logf(d[2]); r[3] = __builtin_amdgcn_logf(d[3]); return r; }
    __device__ __forceinline__ void operator()(const f32x4 (&acc)[2][2][4][2], const Unit& u, int wr, int wc, int fr, int fq) const {
        const int sg_ = u.pn >> 2, seg = mode == 0 ? sg_ : (mode == 1 ? (sg_ < 2 ? sg_ : 4) : 2 + sg_), cb = (u.pn & 3) * 256 + wc * 32 + 8 * fq;
        const int row0 = u.pm * BM + wr * 64 + fr;
        if (seg == 2 || seg == 3) {
            _Float16* O = LFF + (size_t)(seg - 2) * lfstride; const float* g0 = gamma + (seg - 2) * 2048 + cb;
            f32x4 lb[2][2];
#pragma unroll
            for (int bj = 0; bj < 2; ++bj)
#pragma unroll
                for (int n = 0; n < 2; ++n) { const f32x4 d = *(const f32x4*)(g0 + bj * HALF + 4 * n) - *(const f32x4*)(g0 + 1024 + bj * HALF + 4 * n);
                    lb[bj][n] = vrcp(vexp2(d * -1.4426950408889634f) + 1.0f); }
#pragma unroll
            for (int ai = 0; ai < 2; ++ai)
#pragma unroll
                for (int m = 0; m < 4; ++m) { _Float16* rowp = O + (size_t)(row0 + ai * HALF + m * 16) * 1024 + cb;
#pragma unroll
                    for (int bj = 0; bj < 2; ++bj) { typedef _Float16 h16x8 __attribute__((ext_vector_type(8))); h16x8 o;
#pragma unroll
                        for (int n = 0; n < 2; ++n) { const f32x4 sg = vrcp(vexp2(acc[ai][bj][m][n] * -1.4426950408889634f) + 1.0f);
                            const f32x4 lf = vlog2(lb[bj][n] + (1.0f - lb[bj][n]) * sg);
                            o[4 * n + 0] = (_Float16)lf[0]; o[4 * n + 1] = (_Float16)lf[1]; o[4 * n + 2] = (_Float16)lf[2]; o[4 * n + 3] = (_Float16)lf[3]; }
                        *(h16x8*)(rowp + bj * HALF) = o; } }
        } else {
            bf16_t* O = Q + (size_t)(seg - (seg >> 2) * 2) * qstride;
#pragma unroll
            for (int ai = 0; ai < 2; ++ai)
#pragma unroll
                for (int m = 0; m < 4; ++m) { bf16_t* rowp = O + (size_t)(row0 + ai * HALF + m * 16) * 1024 + cb;
#pragma unroll
                    for (int bj = 0; bj < 2; ++bj) { f32x4 v0 = acc[ai][bj][m][0], v1 = acc[ai][bj][m][1];
                        if (seg == 4) { v0 = v0 * vrcp(vexp2(v0 * -1.4426950408889634f) + 1.0f); v1 = v1 * vrcp(vexp2(v1 * -1.4426950408889634f) + 1.0f); }
                        u32x4 w; w.x = cvt_pk_bf16(v0[0], v0[1]); w.y = cvt_pk_bf16(v0[2], v0[3]); w.z = cvt_pk_bf16(v1[0], v1[1]); w.w = cvt_pk_bf16(v1[2], v1[3]);
                        *(u32x4*)(rowp + bj * HALF) = w; } }
        }
    }
};
template <bool B16> struct RawOf { typedef u32x4 T; };
template <> struct RawOf<true> { typedef u32x2 T; };
template <bool BASE16, bool OUT16> struct EpiResGate {
    static constexpr bool PERM = false, AFTER_DRAIN = false, LDS_BIAS = false;
    const void* base; void* out; const float* gate; int gate_bstride; int rows_per_batch; const float* bias;
    __device__ __forceinline__ void operator()(const f32x4 (&acc)[2][2][4][2], const Unit& u, int wr, int wc, int fr, int fq) const {
        const int row0 = u.pm * BM + wr * 64 + fr, col0 = u.pn * BM + wc * 32 + 4 * fq;
        const float* gv_ = gate + (size_t)((u.pm * BM) / rows_per_batch) * gate_bstride;
        f32x4 gv[2][2], bv[2][2];
#pragma unroll
        for (int bj = 0; bj < 2; ++bj)
#pragma unroll
            for (int n = 0; n < 2; ++n) { gv[bj][n] = *(const f32x4*)(gv_ + col0 + bj * HALF + n * 16); bv[bj][n] = bias ? *(const f32x4*)(bias + col0 + bj * HALF + n * 16) : (f32x4){0.f, 0.f, 0.f, 0.f}; }
        typedef typename RawOf<BASE16>::T raw_t;
        raw_t rb[2][8];
#define ERG_LOAD(b_, dst_) do { _Pragma("unroll") for (int mm = 0; mm < 2; ++mm) _Pragma("unroll") for (int bj = 0; bj < 2; ++bj) _Pragma("unroll") for (int n = 0; n < 2; ++n) { \
            const size_t o = (size_t)(row0 + ((b_) >> 1) * HALF + (2 * ((b_) & 1) + mm) * 16) * 1024 + col0 + bj * HALF + n * 16; \
            if constexpr (BASE16) dst_[mm * 4 + bj * 2 + n] = *(const raw_t*)((const bf16_t*)base + o); else dst_[mm * 4 + bj * 2 + n] = *(const raw_t*)((const float*)base + o); } } while (0)
        ERG_LOAD(0, rb[0]);
#pragma unroll
        for (int b = 0; b < 4; ++b) {
            if (b < 3) ERG_LOAD(b + 1, rb[(b + 1) & 1]);
            const int ai = b >> 1;
#pragma unroll
            for (int mm = 0; mm < 2; ++mm) { const int m = 2 * (b & 1) + mm;
#pragma unroll
                for (int bj = 0; bj < 2; ++bj)
#pragma unroll
                    for (int n = 0; n < 2; ++n) { const size_t o = (size_t)(row0 + ai * HALF + m * 16) * 1024 + col0 + bj * HALF + n * 16; f32x4 bs; const raw_t w = rb[b & 1][mm * 4 + bj * 2 + n];
                        if constexpr (BASE16) bs = (f32x4){__builtin_bit_cast(float, w[0] << 16), __builtin_bit_cast(float, w[0] & 0xffff0000u), __builtin_bit_cast(float, w[1] << 16), __builtin_bit_cast(float, w[1] & 0xffff0000u)};
                        else bs = __builtin_bit_cast(f32x4, w);
                        const f32x4 r = bs + gv[bj][n] * (acc[ai][bj][m][n] + bv[bj][n]);
                        if constexpr (OUT16) *(u32x2*)((bf16_t*)out + o) = (u32x2){cvt_pk_bf16(r[0], r[1]), cvt_pk_bf16(r[2], r[3])};
                        else *(f32x4*)((float*)out + o) = r; } }
        }
#undef ERG_LOAD
    }
};
template <int MODE, bool OUT8 = false, int OSCALE = 1, bool WT = false, bool LB = false> struct EpiPair {
    static constexpr bool PERM = true, AFTER_DRAIN = false, LDS_BIAS = LB;
    bf16_t* O; const float* bias0; const PG8_LAS float* lb;
    __device__ __forceinline__ void stage_bias(const Unit& u, int lane) const {
        const float* src = bias0 + (MODE == 0 ? (size_t)u.e * 2048 : 0) + (lane < 32 ? 0 : 1024 - 128) + u.pn * HALF + lane * 4;
        __builtin_amdgcn_global_load_lds((const unsigned*)src, (PG8_LAS unsigned*)lb, 16, 0, 0);
    }
    static __device__ __forceinline__ f32x4 vsig(f32x4 x, float negscale) {
        const f32x4 t = x * negscale; f32x4 e; e[0] = __builtin_amdgcn_exp2f(t[0]); e[1] = __builtin_amdgcn_exp2f(t[1]); e[2] = __builtin_amdgcn_exp2f(t[2]); e[3] = __builtin_amdgcn_exp2f(t[3]);
        const f32x4 d = e + 1.0f; f32x4 r; r[0] = __builtin_amdgcn_rcpf(d[0]); r[1] = __builtin_amdgcn_rcpf(d[1]); r[2] = __builtin_amdgcn_rcpf(d[2]); r[3] = __builtin_amdgcn_rcpf(d[3]); return r; }
    __device__ __forceinline__ void operator()(const f32x4 (&acc)[2][2][4][2], const Unit& u, int wr, int wc, int fr, int fq) const {
        const float* bias = bias0 + (MODE == 0 ? (size_t)u.e * 2048 : 0);
        const int row0 = u.pm * BM + wr * 64 + fr, cg = u.pn * HALF + wc * 32 + 8 * fq;
        f32x4 b0[2], b1[2];
#pragma unroll
        for (int n = 0; n < 2; ++n) {
            if constexpr (LB) { b0[n] = *(const PG8_LAS f32x4*)(lb + wc * 32 + 8 * fq + 4 * n); b1[n] = *(const PG8_LAS f32x4*)(lb + 128 + wc * 32 + 8 * fq + 4 * n); }
            else { b0[n] = *(const f32x4*)(bias + cg + 4 * n); b1[n] = *(const f32x4*)(bias + 1024 + cg + 4 * n); } }
#pragma unroll
        for (int ai = 0; ai < 2; ++ai)
#pragma unroll
            for (int m = 0; m < 4; ++m) { bf16_t* rowp = O + (size_t)(row0 + ai * HALF + m * 16) * 1024 + cg; f32x4 r[2];
#pragma unroll
                for (int n = 0; n < 2; ++n) { const f32x4 g = acc[ai][0][m][n] + b0[n], up = acc[ai][1][m][n] + b1[n];
                    if (MODE == 0) { const f32x4 gg = __builtin_elementwise_min(g, (f32x4){7.0f, 7.0f, 7.0f, 7.0f});
                        const f32x4 uu = __builtin_elementwise_min(__builtin_elementwise_max(up, (f32x4){-7.0f, -7.0f, -7.0f, -7.0f}), (f32x4){7.0f, 7.0f, 7.0f, 7.0f});
                        r[n] = (uu * (float)OSCALE + (float)OSCALE) * (gg * vsig(gg, -1.702f * 1.4426950408889634f)); }
                    else r[n] = (g * (float)OSCALE) * vsig(up, -1.4426950408889634f); }
                if constexpr (OUT8) {
                    int w0 = 0, w1 = 0;
                    w0 = __builtin_amdgcn_cvt_pk_fp8_f32(r[0][0], r[0][1], w0, false); w0 = __builtin_amdgcn_cvt_pk_fp8_f32(r[0][2], r[0][3], w0, true);
                    w1 = __builtin_amdgcn_cvt_pk_fp8_f32(r[1][0], r[1][1], w1, false); w1 = __builtin_amdgcn_cvt_pk_fp8_f32(r[1][2], r[1][3], w1, true);
                    if constexpr (WT) __hip_atomic_store((unsigned long long*)((unsigned char*)O + (size_t)(row0 + ai * HALF + m * 16) * 1024 + cg), ((unsigned long long)(unsigned)w1 << 32) | (unsigned)w0, __ATOMIC_RELAXED, __HIP_MEMORY_SCOPE_AGENT);
                    else *(u32x2*)((unsigned char*)O + (size_t)(row0 + ai * HALF + m * 16) * 1024 + cg) = (u32x2){(unsigned)w0, (unsigned)w1};
                } else {
                u32x4 w; w.x = cvt_pk_bf16(r[0][0], r[0][1]); w.y = cvt_pk_bf16(r[0][2], r[0][3]); w.z = cvt_pk_bf16(r[1][0], r[1][1]); w.w = cvt_pk_bf16(r[1][2], r[1][3]);
                *(u32x4*)rowp = w; } }
    }
};
template <bool OUT8, int OSCALE, bool LB = false> struct EpiMoeOut {
    static constexpr bool PERM = true, AFTER_DRAIN = false, LDS_BIAS = LB;
    bf16_t* O; const float* bias0; const PG8_LAS float* lb;
    __device__ __forceinline__ void stage_bias(const Unit& u, int lane) const {
        __builtin_amdgcn_global_load_lds((const unsigned*)(bias0 + (size_t)u.e * 1024 + u.pn * BM + lane * 4), (PG8_LAS unsigned*)lb, 16, 0, 0);
    }
    __device__ __forceinline__ void operator()(const f32x4 (&acc)[2][2][4][2], const Unit& u, int wr, int wc, int fr, int fq) const {
        const float* bias = bias0 + (size_t)u.e * 1024;
        const int row0 = u.pm * BM + wr * 64 + fr, col0 = u.pn * BM + wc * 32 + 8 * fq;
        f32x4 bv[2][2];
#pragma unroll
        for (int bj = 0; bj < 2; ++bj)
#pragma unroll
            for (int n = 0; n < 2; ++n) {
                if constexpr (LB) bv[bj][n] = *(const PG8_LAS f32x4*)(lb + wc * 32 + 8 * fq + bj * HALF + 4 * n);
                else bv[bj][n] = *(const f32x4*)(bias + col0 + bj * HALF + 4 * n); }
#pragma unroll
        for (int ai = 0; ai < 2; ++ai)
#pragma unroll
            for (int m = 0; m < 4; ++m) { const int r = row0 + ai * HALF + m * 16;
#pragma unroll
                for (int bj = 0; bj < 2; ++bj) { const f32x4 v0 = acc[ai][bj][m][0] + bv[bj][0], v1 = acc[ai][bj][m][1] + bv[bj][1];
                    if constexpr (OUT8) { const f32x4 lim = (f32x4){448.0f, 448.0f, 448.0f, 448.0f};
                        const f32x4 s0 = __builtin_elementwise_min(__builtin_elementwise_max(v0 * (float)OSCALE, -lim), lim), s1 = __builtin_elementwise_min(__builtin_elementwise_max(v1 * (float)OSCALE, -lim), lim); int w0 = 0, w1 = 0;
                        w0 = __builtin_amdgcn_cvt_pk_fp8_f32(s0[0], s0[1], w0, false); w0 = __builtin_amdgcn_cvt_pk_fp8_f32(s0[2], s0[3], w0, true);
                        w1 = __builtin_amdgcn_cvt_pk_fp8_f32(s1[0], s1[1], w1, false); w1 = __builtin_amdgcn_cvt_pk_fp8_f32(s1[2], s1[3], w1, true);
                        *(u32x2*)((unsigned char*)O + (size_t)r * 1024 + col0 + bj * HALF) = (u32x2){(unsigned)w0, (unsigned)w1};
                    } else { u32x4 w; w.x = cvt_pk_bf16(v0[0], v0[1]); w.y = cvt_pk_bf16(v0[2], v0[3]); w.z = cvt_pk_bf16(v1[0], v1[1]); w.w = cvt_pk_bf16(v1[2], v1[3]);
                        *(u32x4*)(O + (size_t)r * 1024 + col0 + bj * HALF) = w; } } }
    }
};

template <class Epi, class Sched, bool ALIGN_EPI = false, bool SP2 = false, bool F8 = false, int SCW = 0x7F7F7F7F, int SCA = 0x7F7F7F7F, bool GATHER = false, int NS = 0, bool ZC = F8>
__device__ __forceinline__ void gemm_phase(PG8_LAS unsigned char* lds, const Gemm g, const Sched& S, const Epi& E) {
    const int tid = threadIdx.x, wid = __builtin_amdgcn_readfirstlane(tid >> 6), lane = tid & 63, wr = wid >> 2, wc = wid & 3, fr = lane & 15, fq = lane >> 4;
    const int K = g.K, nt = K / BK;
    unsigned voffA[2], voffB[2]; int stR[2], stC[2];
#pragma unroll
    for (int i = 0; i < 2; ++i) { int R, C; stage_rc(tid * 16 + i * 8192, R, C); const int Rb = Epi::PERM ? ((R & ~31) + perm32(R & 31)) : R; stR[i] = R; stC[i] = C;
        voffA[i] = (unsigned)(R * K + C) * 2u; voffB[i] = (unsigned)(Rb * K + C) * 2u; }
    const size_t kstep = (size_t)(BK * 2);
    const size_t hstep = (size_t)HALF * K * 2;
    const size_t tstep = 2 * hstep;
    unsigned vc[2][2], vn[2][2];
#pragma unroll
    for (int h = 0; h < 2; ++h)
#pragma unroll
        for (int i = 0; i < 2; ++i) {
            if constexpr (GATHER) vc[h][i] = (unsigned)g.tt[h * HALF + stR[i]] * (unsigned)(K * 2) + (unsigned)stC[i] * 2u;
            else vc[h][i] = voffA[i] + (unsigned)h * (unsigned)hstep;
            vn[h][i] = vc[h][i]; }
    const unsigned ldsw = (unsigned)wid * 1024u;
    const int aoff = lds_byte(wr * 64 + fr, fq * 8), boff = lds_byte(wc * 32 + fr, fq * 8);
#define PG8_SA(b, h) (((b) * 2 + (h)) * HTB)
#define PG8_SB(b, h) ((4 + (b) * 2 + (h)) * HTB)
#define PG8_STAGE(bufoff, gbase, voff) do { _Pragma("unroll") for (int _i = 0; _i < 2; ++_i) \
        __builtin_amdgcn_global_load_lds((const unsigned*)((const char*)(gbase) + (voff)[_i]), (PG8_LAS unsigned*)(lds + (bufoff) + ldsw + _i * 8192), 16, 0, 0); } while (0)
#define PG8_LDA(dst, b, h) do { _Pragma("unroll") for (int m = 0; m < 4; ++m) _Pragma("unroll") for (int k = 0; k < 2; ++k) dst[m][k] = *(const PG8_LAS bf16x8*)(lds + PG8_SA(b, h) + aoff + m * 2048 + k * 1024); } while (0)
#define PG8_LDB(dst, b, h) do { _Pragma("unroll") for (int n = 0; n < 2; ++n) _Pragma("unroll") for (int k = 0; k < 2; ++k) dst[n][k] = *(const PG8_LAS bf16x8*)(lds + PG8_SB(b, h) + boff + n * 2048 + k * 1024); } while (0)
#define PG8_MMA(ai, bj, At, Bt) do { __builtin_amdgcn_s_setprio(1); \
        if constexpr (!F8) { _Pragma("unroll") for (int m = 0; m < 4; ++m) _Pragma("unroll") for (int n = 0; n < 2; ++n) _Pragma("unroll") for (int k = 0; k < 2; ++k) \
            acc[ai][bj][m][n] = __builtin_amdgcn_mfma_f32_16x16x32_bf16(Bt[n][k], At[m][k], acc[ai][bj][m][n], 0, 0, 0); } \
        else { const int scw_ = SCW, sca_ = SCA; _Pragma("unroll") for (int m = 0; m < 4; ++m) _Pragma("unroll") for (int n = 0; n < 2; ++n) { \
            const i32x8 wf_ = __builtin_shufflevector(__builtin_bit_cast(i32x4, Bt[n][0]), __builtin_bit_cast(i32x4, Bt[n][1]), 0, 1, 2, 3, 4, 5, 6, 7); \
            const i32x8 af_ = __builtin_shufflevector(__builtin_bit_cast(i32x4, At[m][0]), __builtin_bit_cast(i32x4, At[m][1]), 0, 1, 2, 3, 4, 5, 6, 7); \
            asm volatile("v_mfma_scale_f32_16x16x128_f8f6f4 %0, %1, %2, %0, %3, %4 op_sel_hi:[0,0,0]" : "+v"(acc[ai][bj][m][n]) : "v"(wf_), "v"(af_), "v"(scw_), "v"(sca_)); } } \
        __builtin_amdgcn_s_setprio(0); } while (0)
#define PG8_MMAZ(ai, bj, At, Bt) do { __builtin_amdgcn_s_setprio(1); \
        if constexpr (!F8) { _Pragma("unroll") for (int m = 0; m < 4; ++m) _Pragma("unroll") for (int n = 0; n < 2; ++n) { \
            acc[ai][bj][m][n] = __builtin_amdgcn_mfma_f32_16x16x32_bf16(Bt[n][0], At[m][0], (f32x4){0.f, 0.f, 0.f, 0.f}, 0, 0, 0); \
            acc[ai][bj][m][n] = __builtin_amdgcn_mfma_f32_16x16x32_bf16(Bt[n][1], At[m][1], acc[ai][bj][m][n], 0, 0, 0); } } \
        else { const int scw_ = SCW, sca_ = SCA; _Pragma("unroll") for (int m = 0; m < 4; ++m) _Pragma("unroll") for (int n = 0; n < 2; ++n) { \
            const i32x8 wf_ = __builtin_shufflevector(__builtin_bit_cast(i32x4, Bt[n][0]), __builtin_bit_cast(i32x4, Bt[n][1]), 0, 1, 2, 3, 4, 5, 6, 7); \
            const i32x8 af_ = __builtin_shufflevector(__builtin_bit_cast(i32x4, At[m][0]), __builtin_bit_cast(i32x4, At[m][1]), 0, 1, 2, 3, 4, 5, 6, 7); \
            asm volatile("v_mfma_scale_f32_16x16x128_f8f6f4 %0, %1, %2, 0, %3, %4 op_sel_hi:[0,0,0]" : "=&v"(acc[ai][bj][m][n]) : "v"(wf_), "v"(af_), "v"(scw_), "v"(sca_)); } } \
        __builtin_amdgcn_s_setprio(0); } while (0)
#define PG8_WAIT_V(n) asm volatile("s_waitcnt vmcnt(" #n ")" ::: "memory")
#define PG8_WAIT_VN(n) asm volatile("s_waitcnt vmcnt(%0)" :: "n"(n) : "memory")
#define PG8_WAIT_L(n) asm volatile("s_waitcnt lgkmcnt(" #n ")" ::: "memory")
#define PG8_BAR __builtin_amdgcn_s_barrier()
#define PG8_SCHED __builtin_amdgcn_sched_barrier(0)
    Unit cur, nxt; int ui = 0, ppm = 0;
    if (!S.next(0, cur)) return;
#if KL_PROBE
    if (Sched::PUBLISH && S.probe_on() && blockIdx.x == 0 && wid == 0) { const unsigned long long t0_ = __builtin_amdgcn_s_memtime(); if (lane == 0) { PG8_LAS unsigned* kp = (PG8_LAS unsigned*)(unsigned)KLP_LDS; kp[6] = (unsigned)t0_; kp[7] = (unsigned)(t0_ >> 32); } }
#endif
    static_assert(SP2, "this build keeps only the SP2 K-loop");
    f32x4 acc[2][2][4][2];
    if constexpr (!ZC) {
#pragma unroll
    for (int a = 0; a < 2; ++a)
#pragma unroll
        for (int b = 0; b < 2; ++b)
#pragma unroll
            for (int m = 0; m < 4; ++m)
#pragma unroll
                for (int n = 0; n < 2; ++n) acc[a][b][m][n] = (f32x4){0.f, 0.f, 0.f, 0.f};
    }
    bf16x8 At[4][2], B0[2][2], B1[2][2];
    const char* cA = (const char*)g.A + (GATHER ? (size_t)0 : (size_t)cur.pm * tstep); const char* cB = (const char*)g.Bt + (size_t)cur.e * g.estride + (size_t)cur.pn * tstep;
    S.a_ready(cur, 0);
    if constexpr (SP2) {
        PG8_STAGE(PG8_SB(0, 0), cB, voffB); PG8_STAGE(PG8_SB(0, 1), cB + hstep, voffB); PG8_STAGE(PG8_SA(0, 0), cA, vc[0]); PG8_STAGE(PG8_SA(0, 1), cA, vc[1]);
        if (wr == 1) PG8_BAR;
        PG8_WAIT_V(2); PG8_BAR;
        PG8_STAGE(PG8_SB(1, 0), cB + kstep, voffB); PG8_STAGE(PG8_SA(1, 0), cA + kstep, vc[0]); PG8_STAGE(PG8_SB(1, 1), cB + hstep + kstep, voffB);
        PG8_WAIT_V(6); PG8_BAR;
    } else {
        PG8_STAGE(PG8_SB(0, 0), cB, voffB); PG8_STAGE(PG8_SA(0, 0), cA, vc[0]); PG8_STAGE(PG8_SB(0, 1), cB + hstep, voffB); PG8_STAGE(PG8_SA(0, 1), cA, vc[1]);
        if (wr == 1) PG8_BAR;
        PG8_WAIT_V(4); PG8_BAR;
        PG8_STAGE(PG8_SB(1, 0), cB + kstep, voffB); PG8_STAGE(PG8_SA(1, 0), cA + kstep, vc[0]); PG8_STAGE(PG8_SB(1, 1), cB + hstep + kstep, voffB);
        PG8_WAIT_V(6); PG8_BAR;
    }
    for (;;) {
        const bool has_next = S.next(ui + 1, nxt);
        if constexpr (GATHER) { if (has_next) {
#pragma unroll
            for (int h = 0; h < 2; ++h)
#pragma unroll
                for (int i = 0; i < 2; ++i) vn[h][i] = (unsigned)g.tt[(ui + 1) * BM + h * HALF + stR[i]] * (unsigned)(K * 2) + (unsigned)stC[i] * 2u; } }
        const char* nA = (has_next && !GATHER) ? (const char*)g.A + (size_t)nxt.pm * tstep : cA; const char* nB = has_next ? (const char*)g.Bt + (size_t)nxt.e * g.estride + (size_t)nxt.pn * tstep : cB;
#if KL_PROBE
        if (Sched::PUBLISH && S.probe_on() && blockIdx.x == 0 && wid == 0) { const unsigned long long t0_ = __builtin_amdgcn_s_memtime(); if (lane == 0) { PG8_LAS unsigned* kp = (PG8_LAS unsigned*)(unsigned)KLP_LDS; kp[4] = (unsigned)t0_; kp[5] = (unsigned)(t0_ >> 32); } }
#endif
#define PG8_WAIT_V8R do { if constexpr (NS > 0) { PG8_WAIT_VN(8 + NS); if (!rlx) PG8_WAIT_V(8); } else PG8_WAIT_V(8); } while (0)
#define PG8_TRIP(MMAK_, FIRST_) { \
            const bool last = (t == nt - 2); \
            unsigned vs[2][2]; \
            _Pragma("unroll") for (int h = 0; h < 2; ++h) _Pragma("unroll") for (int i = 0; i < 2; ++i) vs[h][i] = (GATHER && last) ? vn[h][i] : vc[h][i]; \
            const char* a1 = cA + (size_t)(t + 1) * kstep;                                             \
            const char* a2 = last ? nA : cA + (size_t)(t + 2) * kstep; const char* b2 = last ? nB : cB + (size_t)(t + 2) * kstep;     \
            const char* a3 = a2 + kstep; const char* b3 = b2 + kstep;                                \
            if (last && has_next) S.a_ready(nxt, ui + 1); \
            if constexpr (Epi::LDS_BIAS) { if (last && wid == 0) E.stage_bias(cur, lane); }     \
            if constexpr (Sched::PUBLISH) { if (t == 2 && ui > 0) S.publish(ppm, lane); }     \
            const bool rlx = (NS > 0) && (FIRST_) && (ui > 0); \
              \
            PG8_LDB(B0, 0, 0); PG8_LDB(B1, 0, 1); PG8_SCHED; PG8_LDA(At, 0, 0); if (!rlx) PG8_STAGE(PG8_SA(1, 1), a1, vc[1]); \
            PG8_WAIT_V8R; PG8_WAIT_L(0); PG8_BAR; MMAK_(0, 0, At, B0); MMAK_(0, 1, At, B1); PG8_BAR; PG8_SCHED; \
              \
            PG8_LDA(At, 0, 1); PG8_STAGE(PG8_SB(0, 0), b2, voffB); PG8_STAGE(PG8_SB(0, 1), b2 + hstep, voffB); PG8_STAGE(PG8_SA(0, 0), a2, vs[0]); \
            PG8_WAIT_V8R; PG8_WAIT_L(0); PG8_BAR; MMAK_(1, 0, At, B0); MMAK_(1, 1, At, B1); PG8_BAR; PG8_SCHED; \
              \
            PG8_LDB(B0, 1, 0); PG8_LDB(B1, 1, 1); PG8_SCHED; PG8_LDA(At, 1, 0); PG8_STAGE(PG8_SA(0, 1), a2, vs[1]); \
            PG8_WAIT_V8R; PG8_WAIT_L(0); PG8_BAR; PG8_MMA(0, 0, At, B0); PG8_MMA(0, 1, At, B1); PG8_BAR; PG8_SCHED; \
              \
            PG8_LDA(At, 1, 1); PG8_STAGE(PG8_SB(1, 0), b3, voffB); PG8_STAGE(PG8_SB(1, 1), b3 + hstep, voffB); PG8_STAGE(PG8_SA(1, 0), a3, vs[0]); \
            PG8_WAIT_V(8); PG8_WAIT_L(0); PG8_BAR; PG8_MMA(1, 0, At, B0); PG8_MMA(1, 1, At, B1); PG8_BAR; PG8_SCHED; }
        if constexpr (ZC) {
            { const int t = 0; PG8_TRIP(PG8_MMAZ, true) }
            for (int t = 2; t < nt; t += 2) PG8_TRIP(PG8_MMA, false)
        } else {
            for (int t = 0; t < nt; t += 2) PG8_TRIP(PG8_MMA, t == 0)
        }
#if KL_PROBE
        if (Sched::PUBLISH && S.probe_on() && blockIdx.x == 0 && wid == 0) { const unsigned long long t1_ = __builtin_amdgcn_s_memtime(); if (lane == 0) { PG8_LAS unsigned* kp = (PG8_LAS unsigned*)(unsigned)KLP_LDS; const unsigned long long d = t1_ - (((unsigned long long)kp[5] << 32) | kp[4]); const unsigned long long acc_ = (((unsigned long long)kp[1] << 32) | kp[0]) + d; kp[0] = (unsigned)acc_; kp[1] = (unsigned)(acc_ >> 32); kp[2] += 1u; } }
#endif
        if constexpr (ALIGN_EPI) { if (wr == 0) PG8_BAR; }
        if constexpr (NS > 0) { static_assert(SP2 && ALIGN_EPI, "NS needs SP2 and ALIGN_EPI"); if (has_next) PG8_STAGE(PG8_SA(1, 1), nA + kstep, vn[1]); }
        if constexpr (!Epi::AFTER_DRAIN) { E(acc, cur, wr, wc, fr, fq); S.done(cur); ppm = cur.pm; }
        if (!has_next) break;
        if constexpr (!ZC) {
#pragma unroll
        for (int a = 0; a < 2; ++a)
#pragma unroll
            for (int b = 0; b < 2; ++b)
#pragma unroll
                for (int m = 0; m < 4; ++m)
#pragma unroll
                    for (int n = 0; n < 2; ++n) acc[a][b][m][n] = (f32x4){0.f, 0.f, 0.f, 0.f};
        }
        cur = nxt; cA = nA; cB = nB; ++ui;
        if constexpr (GATHER) {
#pragma unroll
            for (int h = 0; h < 2; ++h)
#pragma unroll
                for (int i = 0; i < 2; ++i) vc[h][i] = vn[h][i]; }
        if constexpr (ALIGN_EPI) { if (wr == 1) PG8_BAR; }
    }
#if KL_PROBE
    if (Sched::PUBLISH && S.probe_on() && blockIdx.x == 0 && wid == 0) { const unsigned long long t1_ = __builtin_amdgcn_s_memtime(); if (lane == 0) { PG8_LAS unsigned* kp = (PG8_LAS unsigned*)(unsigned)KLP_LDS; const unsigned long long d = t1_ - (((unsigned long long)kp[7] << 32) | kp[6]); const unsigned long long acc_ = (((unsigned long long)kp[9] << 32) | kp[8]) + d; kp[8] = (unsigned)acc_; kp[9] = (unsigned)(acc_ >> 32); } }
#endif
    PG8_WAIT_V(0); if constexpr (Sched::PUBLISH) S.publish(ppm, lane);
    if constexpr (!ALIGN_EPI) { if (wr == 0) PG8_BAR; }
    PG8_BAR;
    if constexpr (Epi::AFTER_DRAIN) { E.fused(acc, cur, wr, wc, fr, fq, lds, wid, lane); S.done(cur); }
#undef PG8_SA
#undef PG8_SB
#undef PG8_STAGE
#undef PG8_LDA
#undef PG8_LDB
#undef PG8_MMA
#undef PG8_MMAZ
#undef PG8_TRIP
#undef PG8_WAIT_V
#undef PG8_WAIT_VN
#undef PG8_WAIT_V8R
#undef PG8_WAIT_L
#undef PG8_BAR
#undef PG8_SCHED
}
}


constexpr int D = 1024, NBATCH = 2, SEQ = 16384, NTOK = NBATCH * SEQ, CTXL = 256, NCTX = NBATCH * CTXL, MROWS = NTOK + NCTX;
constexpr int NHEAD = 8, DK = 128, NE = 32, TOPK = 4, CONVW = 31, GRIDW = 64, GRIDR = SEQ / GRIDW;
constexpr int NWAVES = 8, NTHR = NWAVES * 64;
constexpr int MAXTILES = 544;
constexpr float EPS = 1e-6f;
enum { I_X = 0, I_C, I_CTX, I_CCTX, I_WADA, I_BADA, I_GMIX, I_GFFN, I_WHIN, I_HGAMMA, I_GHOUT, I_WHOUT, I_WCVIN, I_BCVIN, I_WCVDW, I_BCVDW, I_GCVLN, I_BCVLN, I_WCVOUT, I_BCVOUT,
       I_WR, I_BR, I_WE1, I_BE1, I_WE2, I_BE2, I_GFINAL, N_IN };

constexpr size_t MiB = 1u << 20;
constexpr size_t WS_CTL = 0, CTL_ZERO_BYTES = 1 * MiB;
constexpr size_t WS_MODS = 1 * MiB;
constexpr size_t WS_TOPE = 2 * MiB, WS_TOPW = 2 * MiB + 512 * 1024, WS_POS = 3 * MiB, WS_BCNT = 3 * MiB + 512 * 1024, WS_TILEE = WS_BCNT + 64 * 1024, WS_SLOTW = 4 * MiB;
constexpr size_t WS_SP = 5 * MiB, WS_SD = 8 * MiB;
constexpr size_t WS_WIN = 48 * MiB, WS_WOUT = 58 * MiB, WS_WCVIN = 60 * MiB, WS_WCVOUT = 64 * MiB, WS_W1 = 66 * MiB, WS_W2 = 322 * MiB;
constexpr size_t WS_X = 450 * MiB;
constexpr size_t WS_H = 578 * MiB;
constexpr size_t WS_Q = 644 * MiB, WS_V = 709 * MiB, WS_SG = 774 * MiB, WS_LFF = 839 * MiB, WS_LFB = 969 * MiB, WS_OF = 1099 * MiB, WS_OB = 1227 * MiB, WS_YIN = 1355 * MiB;
constexpr size_t WS_AS = 1419 * MiB, WS_ACT = 1555 * MiB, WS_YS = 1691 * MiB, WS_END = 1963 * MiB;
#ifndef F8_IN
#define F8_IN 0
#endif
#ifndef SPLIT_IN
#define SPLIT_IN 1
#endif
#ifndef TL_PROBE
#define TL_PROBE 0
#define TL_A (-1)
#define TL_B 0
#define TL_BODY 0
#endif
#ifndef CVF_PROBE
#define CVF_PROBE 0
#endif
#ifndef G_F8
#define G_F8 1
#endif
#ifndef F8_Y
#define F8_Y 1
#endif
constexpr int YSCALE = 16;
#ifndef F8_MISC
#define F8_MISC 1
#endif
constexpr size_t WS_H8 = WS_OF + 64 * MiB;
constexpr size_t WS_WIN8 = WS_WIN + 6 * MiB;
constexpr size_t WS_STOK = WS_AS;
constexpr int CW_MODF = 3200;
constexpr int CW_FLAT = 3072;
constexpr int CW_GCNT = 2048;
constexpr float W8SCALE = 64.0f;
constexpr size_t WS_U = WS_Q, WS_ZP = WS_V, WS_Z = WS_SG;
constexpr int CW_BAR = 4096;
constexpr int CW_XMAP = 32768;
constexpr int CW_TCNT = 65536;

constexpr int RING_OFF = 0, RING_BYTES = 131072;
constexpr int LDSCTL_OFF = 139264, MISC_OFF = LDSCTL_OFF + 320, EXTRA_OFF = LDSCTL_OFF + 1024;
constexpr int LDS_BYTES = 155648;

#define LAS __attribute__((address_space(3)))
typedef unsigned short bf16;
typedef unsigned v4u __attribute__((ext_vector_type(4)));
typedef unsigned v2u __attribute__((ext_vector_type(2)));
typedef float f32x4 __attribute__((ext_vector_type(4)));
typedef int v4i __attribute__((ext_vector_type(4)));
#define LDS_WAIT() asm volatile("s_waitcnt lgkmcnt(0)" ::: "memory")
#define VM_WAIT() asm volatile("s_waitcnt vmcnt(0)" ::: "memory")
__device__ __forceinline__ unsigned f2bf(float f) { unsigned u = __builtin_bit_cast(unsigned, f); return (u + 0x7fffu + ((u >> 16) & 1u)) >> 16; }
__device__ __forceinline__ unsigned pk2(float lo, float hi) { return f2bf(lo) | (f2bf(hi) << 16); }
__device__ __forceinline__ float bf_lo(unsigned u) { return __builtin_bit_cast(float, u << 16); }
__device__ __forceinline__ float bf_hi(unsigned u) { return __builtin_bit_cast(float, u & 0xffff0000u); }
__device__ __forceinline__ float bf2f(bf16 h) { return __builtin_bit_cast(float, ((unsigned)h) << 16); }
__device__ __forceinline__ float fsig(float x) { return __builtin_amdgcn_rcpf(1.0f + __expf(-x)); }
__device__ __forceinline__ float wave_sum(float v) {
#define WS_DPP(x, ctrl) __builtin_bit_cast(float, __builtin_amdgcn_update_dpp(0, __builtin_bit_cast(int, x), ctrl, 0xF, 0xF, true))
    v += WS_DPP(v, 0xB1);
    v += WS_DPP(v, 0x4E);
    v += WS_DPP(v, 0x141);
    v += WS_DPP(v, 0x140);
#undef WS_DPP
    const int vi = __builtin_bit_cast(int, v);
    return (__builtin_bit_cast(float, __builtin_amdgcn_readlane(vi, 0)) + __builtin_bit_cast(float, __builtin_amdgcn_readlane(vi, 16)))
         + (__builtin_bit_cast(float, __builtin_amdgcn_readlane(vi, 32)) + __builtin_bit_cast(float, __builtin_amdgcn_readlane(vi, 48)));
}

__device__ __forceinline__ float half_sum(float v) {
#define WS_DPP(x, ctrl) __builtin_bit_cast(float, __builtin_amdgcn_update_dpp(0, __builtin_bit_cast(int, x), ctrl, 0xF, 0xF, true))
    v += WS_DPP(v, 0xB1); v += WS_DPP(v, 0x4E); v += WS_DPP(v, 0x141); v += WS_DPP(v, 0x140);
#undef WS_DPP
    return v + __shfl_xor(v, 16);
}
__device__ __forceinline__ float sat8(float x) { return __builtin_amdgcn_fmed3f(x, -448.0f, 448.0f); }
__device__ __forceinline__ unsigned pk4_fp8(float a, float b, float c, float d) { int w = 0; w = __builtin_amdgcn_cvt_pk_fp8_f32(sat8(a), sat8(b), w, false); w = __builtin_amdgcn_cvt_pk_fp8_f32(sat8(c), sat8(d), w, true); return (unsigned)w; }
template <bool OUT8> __device__ __forceinline__ void store_row4(void* orow, int lane, int j, f32x4 y, float scale) {
    if constexpr (OUT8) ((unsigned*)orow)[lane + 64 * j] = pk4_fp8(y.x * scale, y.y * scale, y.z * scale, y.w * scale);
    else { v2u w; w.x = pk2(y.x, y.y); w.y = pk2(y.z, y.w); ((v2u*)orow)[lane + 64 * j] = w; }
}

#define XB_TMO      128
#define XB_XCNT(j)  (256  + 64 * (j))
#define XB_XSUB(j)  (1280 + 64 * (j))
#define XB_XGEN(j)  (2304 + 64 * (j))
#define XB_TOP      3328
#define XB_TOPGEN   3392
#define XCD_BAR_WORDS 3456
#define XB_SPIN_CAP (1u << 18)

__device__ __forceinline__ unsigned xb_ld(unsigned* p)              { return __hip_atomic_load(p, __ATOMIC_RELAXED, __HIP_MEMORY_SCOPE_AGENT); }
__device__ __forceinline__ unsigned xb_add(unsigned* p, unsigned v) { return __hip_atomic_fetch_add(p, v, __ATOMIC_RELAXED, __HIP_MEMORY_SCOPE_AGENT); }
__device__ __forceinline__ unsigned xb_xcc_id() { return (unsigned)__builtin_amdgcn_s_getreg((3 << 11) | 20) & 0xFu; }
#define XB_SPIN(cond, bar) do { unsigned _sp = 0; while (cond) { __builtin_amdgcn_s_sleep(1); \
    if ((++_sp & 255u) == 0u) { if (xb_ld(&(bar)[XB_TMO])) break; if (_sp > XB_SPIN_CAP) { atomicAdd(&(bar)[XB_TMO], 1u); break; } } } } while (0)

struct XcdBarrier {
    unsigned* bar; unsigned x;
    volatile LAS unsigned* st;
};

__device__ __forceinline__ XcdBarrier xcd_barrier_post(unsigned* bar, volatile LAS unsigned* st) {
    XcdBarrier b; b.bar = bar; b.x = xb_xcc_id(); b.st = st;
    if (threadIdx.x == 0) (void)xb_add(&bar[XB_XCNT(b.x)], 1u);
    return b;
}
__device__ __forceinline__ void xcd_barrier_complete(unsigned* bar, unsigned x, unsigned& nloc, unsigned& nx) {
    const unsigned G = gridDim.x * gridDim.y * gridDim.z;
    unsigned sum, cnt, mine, sp = 0u;
    for (;;) {
        sum = 0u; cnt = 0u; mine = 0u;
#pragma unroll
        for (unsigned j = 0; j < 16; ++j) { const unsigned c = xb_ld(&bar[XB_XCNT(j)]); sum += c; cnt += (c > 0u) ? 1u : 0u; mine = (j == x) ? c : mine; }
        if (sum == G) break;
        __builtin_amdgcn_s_sleep(1);
        if ((++sp & 255u) == 0u) { if (xb_ld(&bar[XB_TMO])) break; if (sp > XB_SPIN_CAP) { atomicAdd(&bar[XB_TMO], 1u); break; } }
    }
    nloc = mine > 0u ? mine : 1u; nx = cnt > 0u ? cnt : 1u;
}

__device__ __forceinline__ void xcd_barrier(const XcdBarrier& b) {
    asm volatile("s_waitcnt vmcnt(0)" ::: "memory");
    __syncthreads();
    if (threadIdx.x == 0) {
        unsigned* bar = b.bar;
        __builtin_amdgcn_s_waitcnt(0);
        unsigned nloc = b.st[0], nx = b.st[1];
        if (nloc == 0u) { xcd_barrier_complete(bar, b.x, nloc, nx); b.st[0] = nloc; b.st[1] = nx; }
        const unsigned old = xb_add(&bar[XB_XSUB(b.x)], 1u);
        const unsigned gen = old / nloc;
        if (old + 1u == (gen + 1u) * nloc) {
            __builtin_amdgcn_fence(__ATOMIC_RELEASE, "agent");
            asm volatile("s_waitcnt vmcnt(0)" ::: "memory");
            const unsigned og = xb_add(&bar[XB_TOP], 1u);
            const unsigned tg = og / nx;
            if (og + 1u == (tg + 1u) * nx) xb_add(&bar[XB_TOPGEN], 1u);
            else XB_SPIN(xb_ld(&bar[XB_TOPGEN]) == tg, bar);
            __builtin_amdgcn_fence(__ATOMIC_ACQUIRE, "agent");
            xb_add(&bar[XB_XGEN(b.x)], 1u);
            asm volatile("s_waitcnt vmcnt(0)" ::: "memory");
        } else {
            XB_SPIN(xb_ld(&bar[XB_XGEN(b.x)]) == gen, bar);
            __builtin_amdgcn_fence(__ATOMIC_ACQUIRE, "agent");
            asm volatile("s_waitcnt vmcnt(0)" ::: "memory");
        }
    }
    __syncthreads();
}

struct Args { const float* in[N_IN]; float* out; unsigned char* ws; int ph_lo, ph_hi, li, pad; };

__device__ __forceinline__ void p_mods(const Args& a, LAS unsigned char* lds, int tid, int lane, int wave) {
    LAS float* sc = (LAS float*)lds;
    LAS float* part = sc + 3 * D;
    float* MODS = (float*)(a.ws + WS_MODS);
    for (int i = tid; i < 3 * D; i += NTHR) { const int r = i >> 10, k = i & 1023; const float v = r < 2 ? a.in[I_C][r * D + k] : a.in[I_CCTX][k]; sc[i] = v * fsig(v); }
    __syncthreads();
    for (int item = blockIdx.x; item < 2 * 96; item += gridDim.x) {
        const int l = item / 96, cb = item % 96;
        const float* W = a.in[I_WADA] + (size_t)l * D * 6 * D + cb * 64 + lane;
        float a0 = 0.f, a1 = 0.f, a2 = 0.f;
#pragma unroll 16
        for (int kk = 0; kk < 128; ++kk) { const int k = wave * 128 + kk; const float w = W[(size_t)k * (6 * D)]; a0 += sc[k] * w; a1 += sc[D + k] * w; a2 += sc[2 * D + k] * w; }
        part[(wave * 3 + 0) * 64 + lane] = a0; part[(wave * 3 + 1) * 64 + lane] = a1; part[(wave * 3 + 2) * 64 + lane] = a2;
        __syncthreads();
        if (tid < 192) { const int r = tid >> 6, ln = tid & 63; float s = 0.f;
#pragma unroll
            for (int w = 0; w < 8; ++w) s += part[(w * 3 + r) * 64 + ln];
            __hip_atomic_store(&MODS[(size_t)(l * 3 + r) * (6 * D) + cb * 64 + ln], s + a.in[I_BADA][l * 6 * D + cb * 64 + ln], __ATOMIC_RELAXED, __HIP_MEMORY_SCOPE_AGENT); }
        asm volatile("s_waitcnt vmcnt(0)" ::: "memory");
        __syncthreads();
        if (item < 32 && tid == 0) (void)__hip_atomic_fetch_add((unsigned*)(a.ws + WS_CTL) + CW_MODF, 1u, __ATOMIC_RELAXED, __HIP_MEMORY_SCOPE_AGENT);
    }
}
__device__ __forceinline__ void wait_mods0(const Args& a, int tid) {
    if (tid == 0) { unsigned* f = (unsigned*)(a.ws + WS_CTL) + CW_MODF; unsigned sp = 0;
        while (__hip_atomic_load(f, __ATOMIC_RELAXED, __HIP_MEMORY_SCOPE_AGENT) < 32u) { __builtin_amdgcn_s_sleep(2); if (++sp > (1u << 22)) break; }
        __builtin_amdgcn_fence(__ATOMIC_ACQUIRE, "agent");
        asm volatile("s_waitcnt vmcnt(0)" ::: "memory"); }
    __syncthreads();
}
template <bool OUT8> __device__ __forceinline__ void transpose_item(const float* W, int K, int N, bf16* WT, bool paired, LAS float* scr, int item, int lane, int row_adj = 0) {
    const int nblk = N / 32, kb = item / nblk, nb = item % nblk, k0 = 64 * kb, n0 = 32 * nb;
    int d0 = n0 + row_adj; if (paired) { const int half = n0 >> 10, c = n0 & 1023; d0 = (c >> 7) * 256 + half * 128 + (c & 127); }
    float t[32];
#pragma unroll
    for (int i = 0; i < 32; ++i) { const int kk = 2 * i + (lane >> 5); t[i] = __builtin_nontemporal_load(&W[(size_t)(k0 + kk) * N + n0 + (lane & 31)]); }
#pragma unroll
    for (int i = 0; i < 32; ++i) { const int kk = 2 * i + (lane >> 5); scr[kk * 33 + (lane & 31)] = t[i]; }
    LDS_WAIT(); asm volatile("" ::: "memory");
    const int c = lane & 7;
#pragma unroll
    for (int j = 0; j < 4; ++j) { const int n = (lane >> 3) + 8 * j; const LAS float* s = scr + (8 * c) * 33 + n;
        if constexpr (OUT8) {
            int w0 = 0, w1 = 0;
            w0 = __builtin_amdgcn_cvt_pk_fp8_f32(s[0 * 33] * W8SCALE, s[1 * 33] * W8SCALE, w0, false); w0 = __builtin_amdgcn_cvt_pk_fp8_f32(s[2 * 33] * W8SCALE, s[3 * 33] * W8SCALE, w0, true);
            w1 = __builtin_amdgcn_cvt_pk_fp8_f32(s[4 * 33] * W8SCALE, s[5 * 33] * W8SCALE, w1, false); w1 = __builtin_amdgcn_cvt_pk_fp8_f32(s[6 * 33] * W8SCALE, s[7 * 33] * W8SCALE, w1, true);
            *(v2u*)((unsigned char*)WT + (size_t)(d0 + n) * K + k0 + 8 * c) = (v2u){(unsigned)w0, (unsigned)w1};
        } else {
        v4u o; o.x = pk2(s[0 * 33], s[1 * 33]); o.y = pk2(s[2 * 33], s[3 * 33]); o.z = pk2(s[4 * 33], s[5 * 33]); o.w = pk2(s[6 * 33], s[7 * 33]);
        *(v4u*)(WT + (size_t)(d0 + n) * K + k0 + 8 * c) = o; } }
    LDS_WAIT(); asm volatile("" ::: "memory");
}
__device__ __forceinline__ void p_weights(const Args& a, LAS unsigned char* lds, int lane, int wave) {
    LAS float* scr = (LAS float*)(lds + RING_OFF + wave * 16384);
    const int gw = blockIdx.x * NWAVES + wave, NGW = gridDim.x * NWAVES;
    constexpr int I_IN = 16 * 160, I_SQ = 16 * 32, I_CV = 16 * 64, I_E1 = 64 * 1024, I_E2 = 64 * 512;
    constexpr int NITEMS = I_IN + I_SQ + I_CV + I_SQ + I_E1 + I_E2;
    unsigned char* ws = a.ws;
    for (int it = (gridDim.x == 256 ? I_E1 + I_E2 : 0) + gw; it < NITEMS; it += NGW) {
        int r = it;
        if (r < I_E1) { const int mi = r >> 10; transpose_item<true>(a.in[I_WE1] + (size_t)mi * D * 2 * D, D, 2 * D, (bf16*)(ws + WS_W1 + (size_t)mi * 2 * D * D), true, scr, r & 1023, lane); continue; } r -= I_E1;
        if (r < I_E2) { const int mi = r >> 9; transpose_item<true>(a.in[I_WE2] + (size_t)mi * D * D, D, D, (bf16*)(ws + WS_W2 + (size_t)mi * D * D), false, scr, r & 511, lane); continue; } r -= I_E2;
        if (r < I_IN) {
            if (SPLIT_IN) { const int sgm = ((r % 160) * 32) >> 10;
                if (sgm == 2 || sgm == 3 || (G_F8 && sgm == 4)) transpose_item<true>(a.in[I_WHIN], D, 5 * D, (bf16*)(ws + WS_WIN8), false, scr, r, lane, -2 * D);
                else transpose_item<false>(a.in[I_WHIN], D, 5 * D, (bf16*)(ws + WS_WIN), false, scr, r, lane, sgm == 4 ? -2 * D : 0);
            } else transpose_item<F8_IN != 0>(a.in[I_WHIN], D, 5 * D, (bf16*)(ws + WS_WIN), false, scr, r, lane);
            continue; } r -= I_IN;
        if (r < I_SQ) { transpose_item<F8_MISC != 0>(a.in[I_WHOUT], D, D, (bf16*)(ws + WS_WOUT), false, scr, r, lane); continue; } r -= I_SQ;
        if (r < I_CV) { transpose_item<F8_MISC != 0>(a.in[I_WCVIN], D, 2 * D, (bf16*)(ws + WS_WCVIN), true, scr, r, lane); continue; } r -= I_CV;
        transpose_item<F8_MISC != 0>(a.in[I_WCVOUT], D, D, (bf16*)(ws + WS_WCVOUT), false, scr, r, lane);
    }
}
constexpr int CV_WAVES = 7, CV_L0 = 32 * 512 + 32 * 256, CV_ALL = 2 * CV_L0;
__device__ __forceinline__ void transpose_item64(const float* W, int K, int N, unsigned char* WT, bool paired, LAS float* scr, int item, int lane) {
    const int nblk = N / 64, kb = item / nblk, nb = item % nblk, k0 = 64 * kb, n0 = 64 * nb;
    int d0 = n0; if (paired) { const int half = n0 >> 10, c = n0 & 1023; d0 = (c >> 7) * 256 + half * 128 + (c & 127); }
    float t[64];
#pragma unroll
    for (int i = 0; i < 64; ++i) t[i] = __builtin_nontemporal_load(&W[(size_t)(k0 + i) * N + n0 + lane]);
#pragma unroll
    for (int i = 0; i < 64; ++i) scr[i * 65 + lane] = t[i];
    LDS_WAIT(); asm volatile("" ::: "memory");
    const int c = lane & 3;
#pragma unroll
    for (int j = 0; j < 4; ++j) { const int n = (lane >> 2) + 16 * j; const LAS float* s = scr + (16 * c) * 65 + n;
        v4u o;
        o.x = pk4_fp8(s[0 * 65] * W8SCALE, s[1 * 65] * W8SCALE, s[2 * 65] * W8SCALE, s[3 * 65] * W8SCALE); o.y = pk4_fp8(s[4 * 65] * W8SCALE, s[5 * 65] * W8SCALE, s[6 * 65] * W8SCALE, s[7 * 65] * W8SCALE);
        o.z = pk4_fp8(s[8 * 65] * W8SCALE, s[9 * 65] * W8SCALE, s[10 * 65] * W8SCALE, s[11 * 65] * W8SCALE); o.w = pk4_fp8(s[12 * 65] * W8SCALE, s[13 * 65] * W8SCALE, s[14 * 65] * W8SCALE, s[15 * 65] * W8SCALE);
        *(v4u*)(WT + (size_t)(d0 + n) * K + k0 + 16 * c) = o; }
    LDS_WAIT(); asm volatile("" ::: "memory");
}
__device__ __forceinline__ void cv_do_item(const Args& a, LAS float* scr, int g, int lane) {
    const int l = g >= CV_L0 ? 1 : 0; const int r = g - l * CV_L0;
    if (r < 32 * 512) { const int mi = l * 32 + (r >> 9); transpose_item64(a.in[I_WE1] + (size_t)mi * D * 2 * D, D, 2 * D, a.ws + WS_W1 + (size_t)mi * 2 * D * D, true, scr, r & 511, lane); }
    else { const int r2 = r - 32 * 512; const int mi = l * 32 + (r2 >> 8); transpose_item64(a.in[I_WE2] + (size_t)mi * D * D, D, D, a.ws + WS_W2 + (size_t)mi * D * D, false, scr, r2 & 255, lane); }
}
__device__ __forceinline__ void cv_finish(const Args& a, LAS unsigned char* lds, int wave, int lane, int& cv_n, int limit) {
    if (gridDim.x == 256 && wave >= 1 && wave <= CV_WAVES) {
        const int ww = blockIdx.x * CV_WAVES + (wave - 1), NW = 256 * CV_WAVES; LAS float* scr = (LAS float*)(lds + RING_OFF + wave * 16640);
#if CVF_PROBE
        const unsigned long long t0_ = __builtin_amdgcn_s_memrealtime();
#endif
        for (;;) { const int g = cv_n * NW + ww; if (g >= limit) break; cv_do_item(a, scr, g, lane); ++cv_n; }
#if CVF_PROBE
        if (blockIdx.x == 0 && wave == 1 && lane == 0) { asm volatile("s_waitcnt vmcnt(0)" ::: "memory"); ((volatile LAS unsigned*)(lds + MISC_OFF))[40] += (unsigned)(__builtin_amdgcn_s_memrealtime() - t0_); }
#endif
    }
}
__device__ __forceinline__ void xcd_barrier_work(const XcdBarrier& b, const Args& a, LAS unsigned char* lds, int wave, int lane, int& cv_n, volatile LAS unsigned* flag, unsigned seq) {
    asm volatile("s_waitcnt vmcnt(0)" ::: "memory");
    __syncthreads();
    if (wave == 0) {
        if (threadIdx.x == 0) {
            unsigned* bar = b.bar;
            __builtin_amdgcn_s_waitcnt(0);
            unsigned nloc = b.st[0], nx = b.st[1];
            if (nloc == 0u) { xcd_barrier_complete(bar, b.x, nloc, nx); b.st[0] = nloc; b.st[1] = nx; }
            const unsigned old = xb_add(&bar[XB_XSUB(b.x)], 1u);
            const unsigned gen = old / nloc;
            if (old + 1u == (gen + 1u) * nloc) {
                __builtin_amdgcn_fence(__ATOMIC_RELEASE, "agent");
                asm volatile("s_waitcnt vmcnt(0)" ::: "memory");
                const unsigned og = xb_add(&bar[XB_TOP], 1u);
                const unsigned tg = og / nx;
                if (og + 1u == (tg + 1u) * nx) xb_add(&bar[XB_TOPGEN], 1u);
                else XB_SPIN(xb_ld(&bar[XB_TOPGEN]) == tg, bar);
                __builtin_amdgcn_fence(__ATOMIC_ACQUIRE, "agent");
                xb_add(&bar[XB_XGEN(b.x)], 1u);
                asm volatile("s_waitcnt vmcnt(0)" ::: "memory");
            } else {
                XB_SPIN(xb_ld(&bar[XB_XGEN(b.x)]) == gen, bar);
                __builtin_amdgcn_fence(__ATOMIC_ACQUIRE, "agent");
                asm volatile("s_waitcnt vmcnt(0)" ::: "memory");
            }
            flag[0] = seq;
        }
    } else if (gridDim.x == 256 && wave <= CV_WAVES) {
        const int ww = blockIdx.x * CV_WAVES + (wave - 1), NW = 256 * CV_WAVES; LAS float* scr = (LAS float*)(lds + RING_OFF + wave * 16640);
        for (;;) { const int g = cv_n * NW + ww; if (g >= CV_ALL) break; if (flag[0] == seq) break; cv_do_item(a, scr, g, lane); ++cv_n; }
        asm volatile("s_waitcnt vmcnt(0)" ::: "memory");
    }
    __syncthreads();
}
__device__ __forceinline__ void flat_barrier_work(unsigned* cnt, const Args& a, LAS unsigned char* lds, int wave, int lane, int& cv_n, volatile LAS unsigned* flag, unsigned seq) {
    asm volatile("s_waitcnt vmcnt(0)" ::: "memory");
    __syncthreads();
    if (wave == 0) {
        if (threadIdx.x == 0) {
            __builtin_amdgcn_s_waitcnt(0);
            __builtin_amdgcn_fence(__ATOMIC_RELEASE, "agent");
            asm volatile("s_waitcnt vmcnt(0)" ::: "memory");
            (void)__hip_atomic_fetch_add(cnt, 1u, __ATOMIC_RELAXED, __HIP_MEMORY_SCOPE_AGENT);
            const unsigned target = gridDim.x * seq; unsigned sp = 0;
            while (__hip_atomic_load(cnt, __ATOMIC_RELAXED, __HIP_MEMORY_SCOPE_AGENT) < target) { __builtin_amdgcn_s_sleep(1); if (++sp > (1u << 22)) break; }
            __builtin_amdgcn_fence(__ATOMIC_ACQUIRE, "agent");
            asm volatile("s_waitcnt vmcnt(0)" ::: "memory");
            flag[0] = seq;
        }
    } else if (gridDim.x == 256 && wave <= CV_WAVES) {
        const int ww = blockIdx.x * CV_WAVES + (wave - 1), NW = 256 * CV_WAVES; LAS float* scr = (LAS float*)(lds + RING_OFF + wave * 16640);
        for (;;) { const int g = cv_n * NW + ww; if (g >= CV_ALL) break; if (flag[0] == seq) break; cv_do_item(a, scr, g, lane); ++cv_n; }
        asm volatile("s_waitcnt vmcnt(0)" ::: "memory");
    }
    __syncthreads();
}
template <bool OUT8> __device__ __forceinline__ void norm_mod_store(f32x4 (&v)[4], const float* g, const float* sc, const float* sh, void* orow, int lane) {
    float s = 0.f;
#pragma unroll
    for (int j = 0; j < 4; ++j) s += (v[j].x * v[j].x + v[j].y * v[j].y) + (v[j].z * v[j].z + v[j].w * v[j].w);
    const float r = 1.0f / sqrtf(wave_sum(s) * (1.0f / D) + EPS);
#pragma unroll
    for (int j = 0; j < 4; ++j) { const f32x4 gg = ((const f32x4*)g)[lane + 64 * j], ss = ((const f32x4*)sc)[lane + 64 * j], hh = ((const f32x4*)sh)[lane + 64 * j];
        const f32x4 y = (v[j] * r * gg) * (ss + 1.0f) + hh; v[j] = y;
        store_row4<OUT8>(orow, lane, j, y, 1.0f); }
}
__device__ __forceinline__ void p_norm0(const Args& a, int lane, int gw, int NGW, int m_begin, int m_end) {
    const float* MODS = (const float*)(a.ws + WS_MODS); bf16* H = (bf16*)(a.ws + WS_H);
    for (int m0 = m_begin + gw * 2; m0 < m_end; m0 += NGW * 2) {
        f32x4 v[2][4]; int rr[2];
#pragma unroll
        for (int r = 0; r < 2; ++r) { const int m = m0 + r; const float* xr;
            if (m < NTOK) { xr = a.in[I_X] + (size_t)m * D; rr[r] = m / SEQ; } else { xr = a.in[I_CTX] + (size_t)(m - NTOK) * D; rr[r] = 2; }
#pragma unroll
            for (int j = 0; j < 4; ++j) v[r][j] = __builtin_nontemporal_load(&((const f32x4*)xr)[lane + 64 * j]); }
#pragma unroll
        for (int r = 0; r < 2; ++r) { const float* md = MODS + (size_t)rr[r] * 6 * D;
            norm_mod_store<F8_IN != 0>(v[r], a.in[I_GMIX], md + 1 * D, md + 0 * D, (unsigned char*)H + (size_t)(m0 + r) * D * (F8_IN ? 1 : 2), lane);
            if (SPLIT_IN) {
#pragma unroll
                for (int j = 0; j < 4; ++j) store_row4<true>(a.ws + WS_H8 + (size_t)(m0 + r) * D, lane, j, v[r][j], 1.0f); } }
    }
}
__device__ __forceinline__ void p_scan_naive(const Args& a, LAS unsigned char* lds, int tid) {
    LAS float* sf = (LAS float*)lds;
    LAS float* sq = sf + 64 * 128;
    LAS float* sv = sq + 64 * 128;
    LAS float* so = sv + 64 * 16;
    const bf16* Q = (const bf16*)(a.ws + WS_Q); const bf16* V = (const bf16*)(a.ws + WS_V);
    const int vl = tid >> 5, kq = tid & 31;
    for (int unit = blockIdx.x; unit < 256; unit += gridDim.x) {
        const int chain = unit >> 3, vb = unit & 7, b = chain >> 4, h = (chain >> 1) & 7, dir = chain & 1;
        const float* LF = (const float*)(a.ws + (dir ? WS_LFB : WS_LFF)); float* O = (float*)(a.ws + (dir ? WS_OB : WS_OF));
        float S0 = 0.f, S1 = 0.f, S2 = 0.f, S3 = 0.f;
        for (int blk = 0; blk < 260; ++blk) {
            const bool isctx = blk < 4; int base, step;
            if (!dir) { base = isctx ? (NTOK + b * CTXL + blk * 64) : (b * SEQ + (blk - 4) * 64); step = 1; }
            else { base = isctx ? (NTOK + b * CTXL + CTXL - 1 - blk * 64) : (b * SEQ + SEQ - 1 - (blk - 4) * 64); step = -1; }
            for (int e = tid; e < 64 * 128; e += NTHR) { const int i = e >> 7, k = e & 127; const size_t off = (size_t)(base + step * i) * D + h * DK + k; sf[e] = __expf(LF[off]); sq[e] = bf2f(Q[off]); }
            for (int e = tid; e < 64 * 16; e += NTHR) { const int i = e >> 4, vv = e & 15; sv[e] = bf2f(V[(size_t)(base + step * i) * D + h * DK + vb * 16 + vv]); }
            __syncthreads();
            for (int i = 0; i < 64; ++i) {
                const f32x4 f = *(const LAS f32x4*)(sf + i * 128 + kq * 4), q = *(const LAS f32x4*)(sq + i * 128 + kq * 4); const float vv = sv[i * 16 + vl];
                S0 = f.x * S0 + (1.0f - f.x) * vv; S1 = f.y * S1 + (1.0f - f.y) * vv; S2 = f.z * S2 + (1.0f - f.z) * vv; S3 = f.w * S3 + (1.0f - f.w) * vv;
                float p = (S0 * q.x + S1 * q.y) + (S2 * q.z + S3 * q.w);
                p += __shfl_xor(p, 1); p += __shfl_xor(p, 2); p += __shfl_xor(p, 4); p += __shfl_xor(p, 8); p += __shfl_xor(p, 16);
                if (kq == 0) so[i * 16 + vl] = p;
            }
            __syncthreads();
            if (!isctx) for (int e = tid; e < 64 * 16; e += NTHR) { const int i = e >> 4, vv = e & 15; O[(size_t)(base + step * i) * D + h * DK + vb * 16 + vv] = so[e]; }
            __syncthreads();
        }
    }
}
constexpr int SC_QT = 0, SC_KU = 4352, SC_KB = 8704, SC_VT = 12800, SC_ET = 16896, SC_SUB = 17408, SC_BUF = 4 * SC_SUB;
constexpr int NSLOT = 17;
typedef short s16x4 __attribute__((ext_vector_type(4)));
typedef short s16x8 __attribute__((ext_vector_type(8)));
struct ScanUnit { int h, rowbase, sgn, nchunks, chain, slot; };
__device__ __forceinline__ ScanUnit scan_unit(int b, int h, int dir, int slot) {
    ScanUnit u; u.h = h; u.sgn = dir ? -1 : 1; u.chain = (b * NHEAD + h) * 2 + dir; u.slot = slot;
    if (slot == 0) { u.rowbase = NTOK + b * CTXL + (dir ? CTXL - 1 : 0); u.nchunks = CTXL / 64; }
    else { const int so = (slot - 1) * 1024; u.rowbase = b * SEQ + (dir ? SEQ - 1 - so : so); u.nchunks = 16; }
    return u;
}
typedef float f32x2_t __attribute__((ext_vector_type(2)));
typedef __bf16 bf16x2_t __attribute__((ext_vector_type(2)));
__device__ __forceinline__ unsigned cvtpk(float lo, float hi) { const f32x2_t f = {lo, hi}; return __builtin_bit_cast(unsigned, __builtin_convertvector(f, bf16x2_t)); }
template <bool FULL> __device__ __forceinline__ void scan_load(const ScanUnit& u, int pos0, const bf16* LF, const bf16* Q, const bf16* V, int k, int i, unsigned (&lf)[16], unsigned (&qr)[16], unsigned (&vr)[16]) {
#pragma unroll
    for (int t = 0; t < 16; ++t) {
        const unsigned o = (unsigned)(u.rowbase + u.sgn * (pos0 + 16 * i + t)) * D + u.h * DK + k;
        lf[t] = LF[o]; vr[t] = V[o]; if (FULL) qr[t] = Q[o];
    }
}
template <bool FULL> __device__ __forceinline__ float scan_prep(LAS unsigned char* buf, int k, int i, const unsigned (&lfr)[16], const unsigned (&qr)[16], const unsigned (&vr)[16]) {
    LAS unsigned char* sb = buf + i * SC_SUB;
    float f[16], pre[16], suf[16]; float T = 0.f;
#pragma unroll
    for (int t = 0; t < 16; ++t) { const float lf = (float)__builtin_bit_cast(_Float16, (unsigned short)lfr[t]); T += lf; f[t] = __builtin_amdgcn_exp2f(lf); }
    pre[0] = f[0];
#pragma unroll
    for (int t = 1; t < 16; ++t) pre[t] = pre[t - 1] * f[t];
    suf[15] = 1.0f;
#pragma unroll
    for (int t = 14; t >= 0; --t) suf[t] = suf[t + 1] * f[t + 1];
    unsigned kbw[8], vtw[8], qqw[8], kuw[8];
    const float invp = __builtin_amdgcn_rcpf(fmaxf(pre[15], 1e-30f));
#pragma unroll
    for (int t = 0; t < 16; t += 2) {
        const float kk0 = 1.0f - f[t], kk1 = 1.0f - f[t + 1];
        kbw[t >> 1] = cvtpk(kk0 * suf[t], kk1 * suf[t + 1]);
        vtw[t >> 1] = vr[t] | (vr[t + 1] << 16);
        if (FULL) {
            qqw[t >> 1] = cvtpk(__builtin_bit_cast(float, qr[t] << 16) * pre[t], __builtin_bit_cast(float, qr[t + 1] << 16) * pre[t + 1]);
            kuw[t >> 1] = cvtpk(kk0 * suf[t] * invp, kk1 * suf[t + 1] * invp);
        }
    }
    if (FULL) {
        const int rho = k ^ (((k >> 3) & 1) << 2);
        *(LAS v4u*)(sb + SC_QT + rho * 32) = (v4u){qqw[0], qqw[1], qqw[2], qqw[3]}; *(LAS v4u*)(sb + SC_QT + rho * 32 + 16) = (v4u){qqw[4], qqw[5], qqw[6], qqw[7]};
        *(LAS v4u*)(sb + SC_KU + rho * 32) = (v4u){kuw[0], kuw[1], kuw[2], kuw[3]}; *(LAS v4u*)(sb + SC_KU + rho * 32 + 16) = (v4u){kuw[4], kuw[5], kuw[6], kuw[7]};
    }
    *(LAS v4u*)(sb + SC_KB + k * 32) = (v4u){kbw[0], kbw[1], kbw[2], kbw[3]}; *(LAS v4u*)(sb + SC_KB + k * 32 + 16) = (v4u){kbw[4], kbw[5], kbw[6], kbw[7]};
    *(LAS v4u*)(sb + SC_VT + k * 32) = (v4u){vtw[0], vtw[1], vtw[2], vtw[3]}; *(LAS v4u*)(sb + SC_VT + k * 32 + 16) = (v4u){vtw[4], vtw[5], vtw[6], vtw[7]};
    *(LAS float*)(sb + SC_ET + 4 * k) = pre[15];
    return T;
}
__device__ __forceinline__ f32x4 mfma_k16(s16x4 a, s16x4 b, f32x4 c) {
    const v2u av = __builtin_bit_cast(v2u, a), bv = __builtin_bit_cast(v2u, b);
    return __builtin_amdgcn_mfma_f32_16x16x32_bf16(__builtin_bit_cast(s16x8, (v4u){av.x, av.y, 0u, 0u}), __builtin_bit_cast(s16x8, (v4u){bv.x, bv.y, 0u, 0u}), c, 0, 0, 0);
}
template <bool FULL> __device__ __forceinline__ void scan_compute2(const LAS unsigned char* buf, int wq, int lane, f32x4 (&S)[2][8], bf16* Ocol, const ScanUnit& u, int pos0) {
    const int fr = lane & 15, g = lane >> 4;
#pragma unroll 1
    for (int i = 0; i < 2; ++i) {
        const LAS unsigned char* sb = buf + i * SC_SUB;
        const s16x4 vt0 = *(const LAS s16x4*)(sb + SC_VT + (32 * wq + fr) * 32 + 8 * g), vt1 = *(const LAS s16x4*)(sb + SC_VT + (32 * wq + 16 + fr) * 32 + 8 * g);
        s16x8 ka[4], qa[4]; f32x4 et[8]; s16x4 kb[8];
        if (FULL) {
            const int q_ = (lane & 15) >> 2, p_ = lane & 3;
            const LAS unsigned char* b0_ = sb + (8 * g + q_) * 32 + p_ * 8 + 128 * (g & 1);
            const LAS unsigned char* b1_ = sb + (8 * g + q_) * 32 + p_ * 8 + 128 * (1 - (g & 1));
#pragma unroll
            for (int c = 0; c < 4; ++c) {
                const s16x4 k0_ = __builtin_amdgcn_ds_read_tr16_b64_v4i16((LAS s16x4*)(b0_ + SC_KU + 1024 * c)), k1_ = __builtin_amdgcn_ds_read_tr16_b64_v4i16((LAS s16x4*)(b1_ + SC_KU + 1024 * c));
                const s16x4 q0_ = __builtin_amdgcn_ds_read_tr16_b64_v4i16((LAS s16x4*)(b0_ + SC_QT + 1024 * c)), q1_ = __builtin_amdgcn_ds_read_tr16_b64_v4i16((LAS s16x4*)(b1_ + SC_QT + 1024 * c));
                ka[c] = __builtin_shufflevector(k0_, k1_, 0, 1, 2, 3, 4, 5, 6, 7); qa[c] = __builtin_shufflevector(q0_, q1_, 0, 1, 2, 3, 4, 5, 6, 7); }
        }
#pragma unroll
        for (int j = 0; j < 8; ++j) { et[j] = *(const LAS f32x4*)(sb + SC_ET + (32 * (j >> 1) + 8 * g + 4 * (j & 1)) * 4); kb[j] = *(const LAS s16x4*)(sb + SC_KB + (32 * (j >> 1) + 8 * (fr >> 2) + 4 * (j & 1) + (fr & 3)) * 32 + 8 * g); }
        __builtin_amdgcn_sched_barrier(0);
        if (FULL) {
            f32x4 aT = (f32x4){0.f, 0.f, 0.f, 0.f};
#pragma unroll
            for (int c = 0; c < 4; ++c) aT = __builtin_amdgcn_mfma_f32_16x16x32_bf16(ka[c], qa[c], aT, 0, 0, 0);
#pragma unroll
            for (int r = 0; r < 4; ++r) if (4 * g + r > fr) aT[r] = 0.f;
            const s16x4 ab = __builtin_bit_cast(s16x4, (v2u){cvtpk(aT[0], aT[1]), cvtpk(aT[2], aT[3])});
            f32x4 o0 = mfma_k16(vt0, ab, (f32x4){0.f, 0.f, 0.f, 0.f}), o1 = mfma_k16(vt1, ab, (f32x4){0.f, 0.f, 0.f, 0.f});
#pragma unroll
            for (int c = 0; c < 4; ++c) {
                const v4u s0 = (v4u){cvtpk(S[0][2 * c][0], S[0][2 * c][1]), cvtpk(S[0][2 * c][2], S[0][2 * c][3]), cvtpk(S[0][2 * c + 1][0], S[0][2 * c + 1][1]), cvtpk(S[0][2 * c + 1][2], S[0][2 * c + 1][3])};
                const v4u s1 = (v4u){cvtpk(S[1][2 * c][0], S[1][2 * c][1]), cvtpk(S[1][2 * c][2], S[1][2 * c][3]), cvtpk(S[1][2 * c + 1][0], S[1][2 * c + 1][1]), cvtpk(S[1][2 * c + 1][2], S[1][2 * c + 1][3])};
                o0 = __builtin_amdgcn_mfma_f32_16x16x32_bf16(__builtin_bit_cast(s16x8, s0), qa[c], o0, 0, 0, 0);
                o1 = __builtin_amdgcn_mfma_f32_16x16x32_bf16(__builtin_bit_cast(s16x8, s1), qa[c], o1, 0, 0, 0);
            }
            bf16* orow = Ocol + (size_t)(u.rowbase + u.sgn * (pos0 + 16 * i + fr)) * D;
            *(v2u*)orow = (v2u){cvtpk(o0[0], o0[1]), cvtpk(o0[2], o0[3])}; *(v2u*)(orow + 16) = (v2u){cvtpk(o1[0], o1[1]), cvtpk(o1[2], o1[3])};
        }
#pragma unroll
        for (int j = 0; j < 8; ++j) { S[0][j] = mfma_k16(kb[j], vt0, S[0][j] * et[j]); S[1][j] = mfma_k16(kb[j], vt1, S[1][j] * et[j]); }
    }
}
template <bool FULL> __device__ __forceinline__ void scan_pair(const Args& a, LAS unsigned char* lds, const ScanUnit& uA, const ScanUnit& uB, int tid, int lane, int wave) {
    const int grp = wave >> 2, wq = wave & 3, t = tid & 255, k = t & 127, i0 = t >> 7;
    ScanUnit u; u.h = grp ? uB.h : uA.h; u.rowbase = grp ? uB.rowbase : uA.rowbase; u.sgn = grp ? uB.sgn : uA.sgn; u.nchunks = grp ? uB.nchunks : uA.nchunks; u.chain = grp ? uB.chain : uA.chain; u.slot = grp ? uB.slot : uA.slot;
    LAS unsigned char* buf = lds + grp * SC_BUF;
    const int dir = u.sgn < 0;
    const bf16* LF = (const bf16*)(a.ws + (dir ? WS_LFB : WS_LFF)); const bf16* Q = (const bf16*)(a.ws + WS_Q); const bf16* V = (const bf16*)(a.ws + WS_V);
    f32x4* SD = (f32x4*)(a.ws + WS_SD) + (size_t)u.chain * NSLOT * 4096; float* SP = (float*)(a.ws + WS_SP) + (size_t)u.chain * NSLOT * DK;
    const int g = lane >> 4;
    bf16* Ocol = (bf16*)(a.ws + (dir ? WS_OB : WS_OF)) + u.h * DK + 32 * wq + 4 * g;
    f32x4 S[2][8];
#pragma unroll
    for (int vb = 0; vb < 2; ++vb)
#pragma unroll
        for (int j = 0; j < 8; ++j) S[vb][j] = (f32x4){0.f, 0.f, 0.f, 0.f};
    if (FULL) {
        for (int s = 0; s < u.slot; ++s) {
            const f32x4* d = SD + (size_t)s * 4096 + (wq * 16) * 64 + lane; const float* pp = SP + s * DK + 8 * g;
#pragma unroll
            for (int j = 0; j < 8; ++j) { const f32x4 pv = *(const f32x4*)(pp + 32 * (j >> 1) + 4 * (j & 1)); const f32x4 ev = (f32x4){__builtin_amdgcn_exp2f(pv.x), __builtin_amdgcn_exp2f(pv.y), __builtin_amdgcn_exp2f(pv.z), __builtin_amdgcn_exp2f(pv.w)};
                S[0][j] = S[0][j] * ev + d[j * 64]; S[1][j] = S[1][j] * ev + d[(8 + j) * 64]; }
        }
    }
    unsigned lf[16], q[16], v[16]; float psum = 0.f;
    const int nsteps = u.nchunks * 2;
    scan_load<FULL>(u, 0, LF, Q, V, k, i0, lf, q, v);
    constexpr int NST = 32, PB = 2 * SC_SUB;
    if (nsteps > 0) psum += scan_prep<FULL>(buf, k, i0, lf, q, v);
    for (int c = 0; c < NST; ++c) {
        __syncthreads();
        if (c < nsteps) {
            const int cn = (c + 1 < nsteps) ? c + 1 : c;
            scan_load<FULL>(u, cn * 32, LF, Q, V, k, i0, lf, q, v);
            scan_compute2<FULL>(buf + (c & 1) * PB, wq, lane, S, Ocol, u, c * 32);
            if (c + 1 < nsteps) psum += scan_prep<FULL>(buf + ((c + 1) & 1) * PB, k, i0, lf, q, v);
        }
    }
    __syncthreads();
    if (!FULL) {
        f32x4* d = SD + (size_t)u.slot * 4096 + (wq * 16) * 64 + lane;
#pragma unroll
        for (int j = 0; j < 8; ++j) { d[j * 64] = S[0][j]; d[(8 + j) * 64] = S[1][j]; }
        LAS float* ps = (LAS float*)(lds + EXTRA_OFF + 2560);
        ps[(grp * 2 + i0) * 128 + k] = psum;
        __syncthreads();
        if (t < 128) SP[u.slot * DK + t] = ps[(grp * 2) * 128 + t] + ps[(grp * 2 + 1) * 128 + t];
        __syncthreads();
    }
}
__device__ __forceinline__ void p_scan_a(const Args& a, LAS unsigned char* lds, int tid, int lane, int wave) {
    for (int it = blockIdx.x; it < 256; it += gridDim.x) {
        const int b = it >> 7, h = (it >> 4) & 7, seg = it & 15;
        const ScanUnit uA = scan_unit(b, h, 0, seg == 15 ? 0 : 1 + seg);
        const ScanUnit uB = scan_unit(b, h, 1, seg == 0 ? 0 : 16 - seg);
        scan_pair<false>(a, lds, uA, uB, tid, lane, wave);
    }
}
__device__ __forceinline__ void p_scan_c(const Args& a, LAS unsigned char* lds, int tid, int lane, int wave) {
    for (int it = blockIdx.x; it < 256; it += gridDim.x) {
        const int b = it >> 7, h = (it >> 4) & 7, seg = it & 15;
        const ScanUnit uA = scan_unit(b, h, 0, 1 + seg), uB = scan_unit(b, h, 1, 16 - seg);
        scan_pair<true>(a, lds, uA, uB, tid, lane, wave);
    }
}
__device__ __forceinline__ void p_readout(const Args& a, int lane, int wave) {
    const int gw = blockIdx.x * NWAVES + wave, NGW = gridDim.x * NWAVES;
    const bf16* OF = (const bf16*)(a.ws + WS_OF); const bf16* OB = (const bf16*)(a.ws + WS_OB); const bf16* SG = (const bf16*)(a.ws + WS_SG); bf16* Y = (bf16*)(a.ws + WS_YIN);
    f32x4 gh[4];
#pragma unroll
    for (int j = 0; j < 4; ++j) gh[j] = ((const f32x4*)a.in[I_GHOUT])[lane + 64 * j];
    v2u ra[2][4], rb[2][4], sg[2][4];
    if (gw * 2 < NTOK) {
#pragma unroll
        for (int r = 0; r < 2; ++r)
#pragma unroll
            for (int j = 0; j < 4; ++j) { const size_t m = gw * 2 + r; ra[r][j] = ((const v2u*)(OF + m * D))[lane + 64 * j]; rb[r][j] = ((const v2u*)(OB + m * D))[lane + 64 * j]; sg[r][j] = ((const v2u*)(SG + m * D))[lane + 64 * j]; }
    }
    for (int m0 = gw * 2; m0 < NTOK; m0 += NGW * 2) {
        v2u na[2][4], nb[2][4], ns[2][4]; const int mn = m0 + NGW * 2;
#pragma unroll
        for (int r = 0; r < 2; ++r)
#pragma unroll
            for (int j = 0; j < 4; ++j) { const size_t m = (size_t)mn + r; const v2u z2 = (v2u){0u, 0u};
                na[r][j] = mn < NTOK ? ((const v2u*)(OF + m * D))[lane + 64 * j] : z2; nb[r][j] = mn < NTOK ? ((const v2u*)(OB + m * D))[lane + 64 * j] : z2; ns[r][j] = mn < NTOK ? ((const v2u*)(SG + m * D))[lane + 64 * j] : z2; }
#pragma unroll
        for (int r = 0; r < 2; ++r)
#pragma unroll
            for (int j = 0; j < 4; ++j) { const v2u a_ = ra[r][j], b_ = rb[r][j];
                const f32x4 oo = (f32x4){bf_lo(a_.x) + bf_lo(b_.x), bf_hi(a_.x) + bf_hi(b_.x), bf_lo(a_.y) + bf_lo(b_.y), bf_hi(a_.y) + bf_hi(b_.y)};
                float s = (oo.x * oo.x + oo.y * oo.y) + (oo.z * oo.z + oo.w * oo.w);
                s = half_sum(s);
                const float rs = 1.0f / sqrtf(s * (1.0f / DK) + EPS);
                store_row4<F8_MISC != 0>((unsigned char*)Y + (size_t)(m0 + r) * D * (F8_MISC ? 1 : 2), lane, j,
                    (f32x4){oo.x * rs * gh[j].x * bf_lo(sg[r][j].x), oo.y * rs * gh[j].y * bf_hi(sg[r][j].x), oo.z * rs * gh[j].z * bf_lo(sg[r][j].y), oo.w * rs * gh[j].w * bf_hi(sg[r][j].y)}, 4.0f); }
#pragma unroll
        for (int r = 0; r < 2; ++r)
#pragma unroll
            for (int j = 0; j < 4; ++j) { ra[r][j] = na[r][j]; rb[r][j] = nb[r][j]; sg[r][j] = ns[r][j]; }
    }
}
__device__ __forceinline__ void p_router(const Args& a, LAS unsigned char* lds, int l, int tid, int lane, int wave) {
    typedef _Float16 h16x8 __attribute__((ext_vector_type(8))); typedef _Float16 h16x4 __attribute__((ext_vector_type(4)));
    constexpr int PITCH = 2064, TILE_BYTES = 16 * PITCH, P_OFF = 2 * TILE_BYTES, P_BYTES = 8 * 16 * 32 * 4;
    LAS int* s_cnt = (LAS int*)(lds + EXTRA_OFF);
    LAS int* s_gb = s_cnt + 32;
    LAS int* s_sel = (LAS int*)(lds + EXTRA_OFF + 2560);
    unsigned* GCNT = (unsigned*)(a.ws + WS_CTL) + CW_GCNT + l * 32;
    const float* WR = a.in[I_WR] + (size_t)l * D * NE; const float* BR = a.in[I_BR] + l * NE;
    const bf16* X = (const bf16*)(a.ws + WS_X); unsigned char* H = a.ws + WS_H;
    const int fr = lane & 15, g = lane >> 4;
    v2u nx[2][4];
    if (blockIdx.x < NTOK / 128) {
#pragma unroll
        for (int t = 0; t < 2; ++t)
#pragma unroll
            for (int j = 0; j < 4; ++j) nx[t][j] = ((const v2u*)(X + (size_t)(blockIdx.x * 128 + 2 * wave + t) * D))[lane + 64 * j];
    }
    h16x8 wb0[4], wb1[4];
#pragma unroll
    for (int c = 0; c < 4; ++c)
#pragma unroll
        for (int i = 0; i < 8; ++i) { const float* wp = WR + (size_t)(128 * wave + 32 * c + 8 * g + i) * NE + fr; wb0[c][i] = (_Float16)wp[0]; wb1[c][i] = (_Float16)wp[16]; }
    const float* MODS = (const float*)(a.ws + WS_MODS);
    int* TOPS = (int*)(a.ws + WS_TOPE); float* TOPW = (float*)(a.ws + WS_TOPW); int* STOK = (int*)(a.ws + WS_STOK);
    for (int ch = blockIdx.x; ch < NTOK / 128; ch += gridDim.x) {
        if (tid < 32) s_cnt[tid] = 0;
        const int b = (ch * 128) / SEQ; const float* md = MODS + (size_t)(l * 3 + b) * 6 * D;
        if (ch != (int)blockIdx.x) {
#pragma unroll
        for (int t = 0; t < 2; ++t)
#pragma unroll
            for (int j = 0; j < 4; ++j) nx[t][j] = ((const v2u*)(X + (size_t)(ch * 128 + 2 * wave + t) * D))[lane + 64 * j];
        }
#define ROUTER_A(it_) do { const int tokA = ch * 128 + (it_) * 16 + 2 * wave; f32x4 hf[2][4]; \
            _Pragma("unroll") for (int t = 0; t < 2; ++t) _Pragma("unroll") for (int j = 0; j < 4; ++j) hf[t][j] = (f32x4){bf_lo(nx[t][j].x), bf_hi(nx[t][j].x), bf_lo(nx[t][j].y), bf_hi(nx[t][j].y)}; \
            if ((it_) + 1 < 8) { _Pragma("unroll") for (int t = 0; t < 2; ++t) _Pragma("unroll") for (int j = 0; j < 4; ++j) nx[t][j] = ((const v2u*)(X + (size_t)(tokA + 16 + t) * D))[lane + 64 * j]; } \
            _Pragma("unroll") for (int t = 0; t < 2; ++t) { \
                norm_mod_store<true>(hf[t], a.in[I_GFFN] + l * D, md + 4 * D, md + 3 * D, H + (size_t)(tokA + t) * D, lane); \
                _Pragma("unroll") for (int j = 0; j < 4; ++j) { const h16x4 hv = {(_Float16)hf[t][j].x, (_Float16)hf[t][j].y, (_Float16)hf[t][j].z, (_Float16)hf[t][j].w}; \
                    *(LAS h16x4*)(lds + ((it_) & 1) * TILE_BYTES + (2 * wave + t) * PITCH + (4 * lane + 256 * j) * 2) = hv; } } } while (0)
#define ROUTER_B(it_) do { f32x4 acc0 = (f32x4){0.f, 0.f, 0.f, 0.f}, acc1 = acc0; \
            _Pragma("unroll") for (int c = 0; c < 4; ++c) { const h16x8 av = *(const LAS h16x8*)(lds + ((it_) & 1) * TILE_BYTES + fr * PITCH + (128 * wave + 32 * c + 8 * g) * 2); \
                acc0 = __builtin_amdgcn_mfma_f32_16x16x32_f16(av, wb0[c], acc0, 0, 0, 0); acc1 = __builtin_amdgcn_mfma_f32_16x16x32_f16(av, wb1[c], acc1, 0, 0, 0); } \
            LAS float* Pw = (LAS float*)(lds + P_OFF + ((it_) & 1) * P_BYTES); \
            _Pragma("unroll") for (int r = 0; r < 4; ++r) { Pw[(wave * 16 + 4 * g + r) * 32 + fr] = acc0[r]; Pw[(wave * 16 + 4 * g + r) * 32 + 16 + fr] = acc1[r]; } } while (0)
#define ROUTER_C(it_) do { const int t = lane >> 5, e0 = lane & 31; const LAS float* Pr = (const LAS float*)(lds + P_OFF + ((it_) & 1) * P_BYTES); \
            float v0 = BR[e0]; \
            _Pragma("unroll") for (int w = 0; w < 8; ++w) v0 += Pr[(w * 16 + 2 * wave + t) * 32 + e0]; \
            float selv[4]; int seli[4]; \
            { const unsigned ub = __builtin_bit_cast(unsigned, v0); unsigned key = (ub & 0x80000000u) ? ~ub : (ub | 0x80000000u); key = (key & ~31u) | (unsigned)(31 - e0); \
              _Pragma("unroll") for (int r = 0; r < 4; ++r) { unsigned m = key, o; \
                  o = (unsigned)__builtin_amdgcn_update_dpp(0, (int)m, 0xB1, 0xF, 0xF, true); m = o > m ? o : m; \
                  o = (unsigned)__builtin_amdgcn_update_dpp(0, (int)m, 0x4E, 0xF, 0xF, true); m = o > m ? o : m; \
                  o = (unsigned)__builtin_amdgcn_update_dpp(0, (int)m, 0x141, 0xF, 0xF, true); m = o > m ? o : m; \
                  o = (unsigned)__builtin_amdgcn_update_dpp(0, (int)m, 0x140, 0xF, 0xF, true); m = o > m ? o : m; \
                  o = (unsigned)__shfl_xor((int)m, 16); m = o > m ? o : m; \
                  const int bi = 31 - (int)(m & 31u); seli[r] = bi; \
                  if (bi == e0) key = 0u; } \
              _Pragma("unroll") for (int r = 0; r < 4; ++r) selv[r] = __builtin_bit_cast(float, __builtin_amdgcn_ds_bpermute(((lane & 32) + seli[r]) << 2, __builtin_bit_cast(int, v0))); } \
            if ((lane & 31) == 0) { \
                const float e1 = __expf(selv[1] - selv[0]), e2 = __expf(selv[2] - selv[0]), e3 = __expf(selv[3] - selv[0]); const float inv = 1.0f / (1.0f + e1 + e2 + e3); \
                *(f32x4*)(TOPW + (size_t)(ch * 128 + (it_) * 16 + 2 * wave + t) * 4) = (f32x4){inv, e1 * inv, e2 * inv, e3 * inv}; \
                _Pragma("unroll") for (int r = 0; r < 4; ++r) s_sel[((it_) * 16 + 2 * wave + t) * 4 + r] = (seli[r] << 16) | __hip_atomic_fetch_add(&s_cnt[seli[r]], 1, __ATOMIC_RELAXED, __HIP_MEMORY_SCOPE_WORKGROUP); \
            } } while (0)
        ROUTER_A(0);
        for (int k = 0; k < 8; ++k) {
            __syncthreads();
            ROUTER_B(k);
            if (k > 0) ROUTER_C(k - 1);
            if (k < 7) ROUTER_A(k + 1);
        }
        __syncthreads();
        ROUTER_C(7);
#undef ROUTER_A
#undef ROUTER_B
#undef ROUTER_C
        __syncthreads();
        if (tid < 32) s_gb[tid] = (int)__hip_atomic_fetch_add(GCNT + tid, (unsigned)s_cnt[tid], __ATOMIC_RELAXED, __HIP_MEMORY_SCOPE_AGENT);
        __syncthreads();
        { const int sv = s_sel[tid], e = sv >> 16, vi = s_gb[e] + (sv & 0xffff); TOPS[(size_t)ch * 512 + tid] = e * NTOK + vi; STOK[(size_t)e * NTOK + vi] = ch * 128 + (tid >> 2); }
        __syncthreads();
    }
}
__device__ __forceinline__ void moe_tables(const Args& a, LAS unsigned char* lds, int l, int tid) {
    LAS int* s_tb = (LAS int*)(lds + EXTRA_OFF + 256); LAS int* s_ce = s_tb + 40; LAS int* tab = (LAS int*)(lds + EXTRA_OFF + 640);
    const unsigned* GCNT = (const unsigned*)(a.ws + WS_CTL) + CW_GCNT + l * 32;
    if (tid < 32) s_ce[tid] = (int)__hip_atomic_load(GCNT + tid, __ATOMIC_RELAXED, __HIP_MEMORY_SCOPE_AGENT);
    __syncthreads();
    if (tid == 0) { int run = 0; for (int e = 0; e < 32; ++e) { s_tb[e] = run; run += (s_ce[e] + 255) >> 8; } s_tb[32] = run; }
    __syncthreads();
    if (tid < 32) { const int t0 = s_tb[tid], t1 = s_tb[tid + 1]; for (int t = t0; t < t1; ++t) tab[t] = tid; }
    __syncthreads();
}
template <bool FINAL> __device__ __forceinline__ void p_combine(const Args& a, LAS unsigned char* lds, int l, int lane, int wave) {
    const int gw = blockIdx.x * NWAVES + wave, NGW = gridDim.x * NWAVES;
    bf16* X = (bf16*)(a.ws + WS_X); const bf16* YS = (const bf16*)(a.ws + WS_YS); const int* TOPS = (const int*)(a.ws + WS_TOPE); const float* TOPW = (const float*)(a.ws + WS_TOPW);
    const LAS int* s_tb = (const LAS int*)(lds + EXTRA_OFF + 256);
    const float* MODS = (const float*)(a.ws + WS_MODS); bf16* H = (bf16*)(a.ws + WS_H);
    const int S2 = NGW * 2;
    auto load_idx = [&](int m, v4i (&ps)[2], f32x4 (&tws)[2]) {
#pragma unroll
        for (int r = 0; r < 2; ++r) { ps[r] = *(const v4i*)(TOPS + (size_t)(m + r) * 4); tws[r] = *(const f32x4*)(TOPW + (size_t)(m + r) * 4); } };
    auto load_rows = [&](int m, v4i (&ps)[2], v2u (&xr_)[2][4], v2u (&y_)[2][4][4]) {
#pragma unroll
        for (int r = 0; r < 2; ++r) {
#pragma unroll
            for (int k = 0; k < 4; ++k) { const int e = ps[r][k] >> 15; ps[r][k] = s_tb[e] * 256 + (ps[r][k] & (NTOK - 1)); }
#pragma unroll
            for (int j = 0; j < 4; ++j) { xr_[r][j] = ((const v2u*)(X + (size_t)(m + r) * D))[lane + 64 * j];
#pragma unroll
                for (int k = 0; k < 4; ++k) {
                    if (F8_Y) { y_[r][j][k].x = ((const unsigned*)((const unsigned char*)YS + (size_t)ps[r][k] * D))[lane + 64 * j]; y_[r][j][k].y = 0u; }
                    else y_[r][j][k] = ((const v2u*)(YS + (size_t)ps[r][k] * D))[lane + 64 * j]; } } } };
    v2u xr[2][4]; v2u y[2][4][4]; f32x4 tw[2]; v4i nps[2]; f32x4 ntw[2];
    if (gw * 2 < NTOK) { v4i cps[2]; load_idx(gw * 2, cps, tw); load_rows(gw * 2, cps, xr, y); if (gw * 2 + S2 < NTOK) load_idx(gw * 2 + S2, nps, ntw); }
    for (int m0 = gw * 2; m0 < NTOK; m0 += S2) {
        const int b = m0 / SEQ; const float* gt = MODS + (size_t)(l * 3 + b) * 6 * D + 5 * D;
        const int mn = m0 + S2, mnn = m0 + 2 * S2;
        v2u xn[2][4]; v2u yn[2][4][4]; v4i pps[2]; f32x4 ptw[2];
        if (mn < NTOK) load_rows(mn, nps, xn, yn);
        if (mnn < NTOK) load_idx(mnn, pps, ptw);
        f32x4 v[2][4];
#pragma unroll
        for (int r = 0; r < 2; ++r)
#pragma unroll
            for (int j = 0; j < 4; ++j) v[r][j] = (f32x4){bf_lo(xr[r][j].x), bf_hi(xr[r][j].x), bf_lo(xr[r][j].y), bf_hi(xr[r][j].y)};
#pragma unroll
        for (int r = 0; r < 2; ++r) { const int m = m0 + r;
#pragma unroll
            for (int j = 0; j < 4; ++j) { f32x4 s = (f32x4){0.f, 0.f, 0.f, 0.f};
#pragma unroll
                for (int k = 0; k < 4; ++k) {
                    if (F8_Y) { const int w = (int)y[r][j][k].x; const f32x2_t lo = __builtin_amdgcn_cvt_pk_f32_fp8(w, false), hi = __builtin_amdgcn_cvt_pk_f32_fp8(w, true);
                        s += (f32x4){lo.x, lo.y, hi.x, hi.y} * (tw[r][k] * (1.0f / YSCALE)); }
                    else s += (f32x4){bf_lo(y[r][j][k].x), bf_hi(y[r][j][k].x), bf_lo(y[r][j][k].y), bf_hi(y[r][j][k].y)} * tw[r][k]; }
                v[r][j] = v[r][j] + ((const f32x4*)gt)[lane + 64 * j] * s; }
            if (!FINAL) {
#pragma unroll
                for (int j = 0; j < 4; ++j) ((v2u*)(X + (size_t)m * D))[lane + 64 * j] = (v2u){pk2(v[r][j].x, v[r][j].y), pk2(v[r][j].z, v[r][j].w)};
                const float* md = MODS + (size_t)((l + 1) * 3 + b) * 6 * D;
                norm_mod_store<F8_MISC != 0>(v[r], a.in[I_GMIX] + (l + 1) * D, md + 1 * D, md + 0 * D, (unsigned char*)H + (size_t)m * D * (F8_MISC ? 1 : 2), lane);
            } else {
                float s = 0.f;
#pragma unroll
                for (int j = 0; j < 4; ++j) s += (v[r][j].x * v[r][j].x + v[r][j].y * v[r][j].y) + (v[r][j].z * v[r][j].z + v[r][j].w * v[r][j].w);
                const float rs = 1.0f / sqrtf(wave_sum(s) * (1.0f / D) + EPS);
#pragma unroll
                for (int j = 0; j < 4; ++j) __builtin_nontemporal_store(v[r][j] * rs * ((const f32x4*)a.in[I_GFINAL])[lane + 64 * j], &((f32x4*)(a.out + (size_t)m * D))[lane + 64 * j]);
            }
        }
#pragma unroll
        for (int r = 0; r < 2; ++r) { tw[r] = ntw[r]; nps[r] = pps[r]; ntw[r] = ptw[r];
#pragma unroll
            for (int j = 0; j < 4; ++j) { xr[r][j] = xn[r][j];
#pragma unroll
                for (int k = 0; k < 4; ++k) y[r][j][k] = yn[r][j][k]; } }
    }
}
__device__ __forceinline__ void p_dwconv(const Args& a, int tid) {
    const bf16* U = (const bf16*)(a.ws + WS_U); bf16* ZP = (bf16*)(a.ws + WS_ZP);
    const float* WDW = a.in[I_WCVDW]; const float* BDW = a.in[I_BCVDW];
    const int half = tid >> 8, cp = tid & 255;
    typedef float f32x2v __attribute__((ext_vector_type(2)));
    auto line_of = [&](int unit, int& c, int& len, int& p0, size_t& base, size_t& stride) {
        const int hu = unit * 2 + half;
        if (hu < 2048) { c = 2 * cp; len = GRIDW; p0 = (hu & 3) * 16; base = (size_t)(hu >> 2) * GRIDW * D; stride = D; }
        else { const int v = hu - 2048; const int b = v >> 10, w = (v >> 4) & 63; c = 512 + 2 * cp; len = GRIDR; p0 = (v & 15) * 16; base = ((size_t)b * SEQ + w) * D; stride = (size_t)GRIDW * D; } };
    auto load_in = [&](int c, int len, int p0, size_t base, size_t stride, unsigned (&u)[46]) {
#pragma unroll
        for (int i = 0; i < 46; ++i) { const int pp = p0 - 15 + i; u[i] = (pp >= 0 && pp < len) ? *(const unsigned*)(U + base + (size_t)pp * stride + c) : 0u; } };
    int c, len, p0; size_t base, stride; unsigned u[46];
    f32x2v w2[CONVW]; f32x2v bb = (f32x2v){0.f, 0.f}; int wc = -1;
    if ((int)blockIdx.x < 2048) { line_of(blockIdx.x, c, len, p0, base, stride); load_in(c, len, p0, base, stride, u); }
    for (int unit = blockIdx.x; unit < 2048; unit += gridDim.x) {
        int cn = 0, lenn = 0, p0n = 0; size_t basen = 0, striden = 0; unsigned un[46]; const int nu = unit + gridDim.x;
        if (nu < 2048) { line_of(nu, cn, lenn, p0n, basen, striden); load_in(cn, lenn, p0n, basen, striden, un); }
        if (wc != c) { wc = c;
#pragma unroll
            for (int j = 0; j < CONVW; ++j) w2[j] = *(const f32x2v*)(WDW + j * D + c);
            bb = *(const f32x2v*)(BDW + c); }
        f32x2v in2[46];
#pragma unroll
        for (int i = 0; i < 46; ++i) in2[i] = (f32x2v){bf_lo(u[i]), bf_hi(u[i])};
#pragma unroll
        for (int i = 0; i < 16; ++i) { f32x2v acc2 = bb;
#pragma unroll
            for (int j = 0; j < CONVW; ++j) acc2 = __builtin_elementwise_fma(in2[i + j], w2[j], acc2);
            *(unsigned*)(ZP + base + (size_t)(p0 + i) * stride + c) = pk2(acc2.x, acc2.y); }
        c = cn; len = lenn; p0 = p0n; base = basen; stride = striden;
#pragma unroll
        for (int i = 0; i < 46; ++i) u[i] = un[i];
    }
}
__device__ __forceinline__ void p_ln_silu(const Args& a, int lane, int wave) {
    const int gw = blockIdx.x * NWAVES + wave, NGW = gridDim.x * NWAVES;
    const bf16* ZP = (const bf16*)(a.ws + WS_ZP); bf16* Z = (bf16*)(a.ws + WS_Z);
    f32x4 gg[4], bb[4];
#pragma unroll
    for (int j = 0; j < 4; ++j) { gg[j] = ((const f32x4*)a.in[I_GCVLN])[lane + 64 * j]; bb[j] = ((const f32x4*)a.in[I_BCVLN])[lane + 64 * j]; }
    v2u y[2][4];
    if (gw * 2 < NTOK) {
#pragma unroll
        for (int r = 0; r < 2; ++r)
#pragma unroll
            for (int j = 0; j < 4; ++j) y[r][j] = ((const v2u*)(ZP + (size_t)(gw * 2 + r) * D))[lane + 64 * j];
    }
    for (int m0 = gw * 2; m0 < NTOK; m0 += NGW * 2) {
        v2u yn[2][4]; const int mn = m0 + NGW * 2;
#pragma unroll
        for (int r = 0; r < 2; ++r)
#pragma unroll
            for (int j = 0; j < 4; ++j) yn[r][j] = mn < NTOK ? ((const v2u*)(ZP + (size_t)(mn + r) * D))[lane + 64 * j] : (v2u){0u, 0u};
#pragma unroll
        for (int r = 0; r < 2; ++r) {
            f32x4 v[4]; float s = 0.f;
#pragma unroll
            for (int j = 0; j < 4; ++j) { v[j] = (f32x4){bf_lo(y[r][j].x), bf_hi(y[r][j].x), bf_lo(y[r][j].y), bf_hi(y[r][j].y)}; s += (v[j].x + v[j].y) + (v[j].z + v[j].w); }
            const float mean = wave_sum(s) * (1.0f / D); float s2 = 0.f;
#pragma unroll
            for (int j = 0; j < 4; ++j) { v[j] = v[j] - mean; s2 += (v[j].x * v[j].x + v[j].y * v[j].y) + (v[j].z * v[j].z + v[j].w * v[j].w); }
            const float rstd = 1.0f / sqrtf(wave_sum(s2) * (1.0f / D) + EPS);
#pragma unroll
            for (int j = 0; j < 4; ++j) {
                f32x4 yy = v[j] * rstd * gg[j] + bb[j]; yy.x *= fsig(yy.x); yy.y *= fsig(yy.y); yy.z *= fsig(yy.z); yy.w *= fsig(yy.w);
                store_row4<F8_MISC != 0>((unsigned char*)Z + (size_t)(m0 + r) * D * (F8_MISC ? 1 : 2), lane, j, yy, 4.0f); }
        }
#pragma unroll
        for (int r = 0; r < 2; ++r)
#pragma unroll
            for (int j = 0; j < 4; ++j) y[r][j] = yn[r][j];
    }
}


enum { PH_PRO = 0, PH_NORM0, PH_INPROJ, PH_SCANA, PH_SCANC, PH_READOUT, PH_OUTPROJ, PH_ROUTER0, PH_G1_0, PH_G2_0, PH_COMB0, PH_CVIN, PH_DWCONV, PH_LN, PH_CVOUT, PH_ROUTER1, PH_G1_1, PH_G2_1, PH_FINAL, NPH };
#ifndef AEPI
#define AEPI 1
#endif
#ifndef REPMASK
#define REPMASK 0ull
#endif
#ifndef SCAN_NAIVE
#define SCAN_NAIVE 0
#endif
#if defined(__HIP_DEVICE_COMPILE__)
#define NO_PK_F32
#else
#define NO_PK_F32
#endif
__global__ void NO_PK_F32 __launch_bounds__(NTHR, 2) fwd_kernel(Args args) {
    extern __shared__ __attribute__((aligned(16))) unsigned char lds_raw[];
    LAS unsigned char* lds = (LAS unsigned char*)lds_raw;
    const int tid = threadIdx.x, lane = tid & 63, wave = __builtin_amdgcn_readfirstlane(tid >> 6);
    const int G = gridDim.x, bid = blockIdx.x;
    unsigned char* ws = args.ws;
    for (int u = tid; u < (LDS_BYTES - LDSCTL_OFF) / 4; u += NTHR) ((LAS unsigned*)(lds + LDSCTL_OFF))[u] = 0u;
    __syncthreads();
    volatile LAS unsigned* MISC = (volatile LAS unsigned*)(lds + MISC_OFF);
    XcdBarrier bar = xcd_barrier_post((unsigned*)(ws + WS_CTL) + CW_BAR + args.li * XCD_BAR_WORDS, MISC + 8);
    const int lo = args.ph_lo, hi = args.ph_hi;
    if (TL_PROBE && tid == 0) MISC[48] = (unsigned)__builtin_amdgcn_s_memrealtime();
    if (tid == 0) __hip_atomic_store((unsigned*)(ws + WS_CTL) + CW_XMAP + bid, xb_xcc_id() + 1u, __ATOMIC_RELAXED, __HIP_MEMORY_SCOPE_AGENT);
#define IN(k) (lo <= (k) && (k) < hi)
    int cv_n = 0; unsigned bseq = 0;
#ifndef FLAT_BARRIER
#define FLAT_BARRIER 0
#endif
#define SEAM(k) do { if (IN(k) && IN((k) + 1)) { ++bseq; if (FLAT_BARRIER) flat_barrier_work((unsigned*)(ws + WS_CTL) + CW_FLAT, args, lds, wave, lane, cv_n, MISC + 12, bseq); else xcd_barrier_work(bar, args, lds, wave, lane, cv_n, MISC + 12, bseq); \
        if (TL_PROBE && tid == 0) MISC[48 + (k) + 1] = (unsigned)__builtin_amdgcn_s_memrealtime(); } } while (0)
#define PHASE(k, ...) if (IN(k)) { __VA_ARGS__; if ((REPMASK >> (k)) & 1ull) { __syncthreads(); __VA_ARGS__; } if (TL_PROBE && tid == 0) MISC[72 + (k)] = (unsigned)__builtin_amdgcn_s_memrealtime(); } SEAM(k);
    typedef pg8::bf16_t pbf;

    const bool merge_pro = false && (G >= 32) && IN(PH_PRO) && IN(PH_NORM0);
    if (IN(PH_PRO)) { p_mods(args, lds, tid, lane, wave); p_weights(args, lds, lane, wave); if (merge_pro) wait_mods0(args, tid); }
    if (!merge_pro) SEAM(PH_PRO);
    const bool ctx_early = SPLIT_IN && (G == 256);
    PHASE(PH_NORM0, {
        if (ctx_early && bid < 24) {
            const int cb = bid / 12, cj = bid % 12;
            p_norm0(args, lane, wave, NWAVES, NTOK + cb * CTXL, NTOK + cb * CTXL + CTXL);
            VM_WAIT(); __syncthreads();
            if (cj < 8) {
                pg8::Gemm g{(const pbf*)(ws + WS_H8), (const pbf*)(ws + WS_WIN8), D / 2, 0};
                pg8::OneUnit S1{NTOK / 256 + cb, cj};
                pg8::EpiHgrnIn E{(pbf*)(ws + WS_Q), (WS_V - WS_Q) / 2, (_Float16*)(ws + WS_LFF), (WS_LFB - WS_LFF) / 2, args.in[I_HGAMMA], 2};
                pg8::gemm_phase<pg8::EpiHgrnIn, pg8::OneUnit, AEPI != 0, true, true, 0x79797979, 0x7F7F7F7F>(lds + RING_OFF, g, S1, E);
            } else {
                pg8::Gemm g{(const pbf*)(ws + WS_H), (const pbf*)(ws + WS_WIN), D, 0};
                pg8::OneUnit S1{NTOK / 256 + cb, 4 + (cj - 8)};
                pg8::EpiHgrnIn E{(pbf*)(ws + WS_Q), (WS_V - WS_Q) / 2, (_Float16*)(ws + WS_LFF), (WS_LFB - WS_LFF) / 2, args.in[I_HGAMMA], 1};
                pg8::gemm_phase<pg8::EpiHgrnIn, pg8::OneUnit, AEPI != 0, true, false>(lds + RING_OFF, g, S1, E);
            }
        } else if (ctx_early) p_norm0(args, lane, (bid - 24) * NWAVES + wave, (G - 24) * NWAVES, 0, NTOK);
        else p_norm0(args, lane, bid * NWAVES + wave, G * NWAVES, 0, MROWS);
    })
    PHASE(PH_INPROJ, {
        static_assert(WS_V - WS_Q == WS_SG - WS_V, "Q|V|SG equally spaced");
        if (SPLIT_IN) {
            const int nMi = ctx_early ? NTOK / 256 : MROWS / 256;
            {
                pg8::Gemm g{(const pbf*)(ws + WS_H8), (const pbf*)(ws + WS_WIN8), D / 2, 0};
                pg8::TileOrder S; S.init(nMi, (G_F8 ? 3 : 2) * D / 256, G, bid, nullptr);
                pg8::EpiHgrnIn E{(pbf*)(ws + WS_Q), (WS_V - WS_Q) / 2, (_Float16*)(ws + WS_LFF), (WS_LFB - WS_LFF) / 2, args.in[I_HGAMMA], 2};
                pg8::gemm_phase<pg8::EpiHgrnIn, pg8::TileOrder, AEPI != 0, true, true, 0x79797979, 0x7F7F7F7F>(lds + RING_OFF, g, S, E);
            }
            {
                pg8::Gemm g{(const pbf*)(ws + WS_H), (const pbf*)(ws + WS_WIN), D, 0};
                pg8::TileOrder S; S.init(nMi, (G_F8 ? 2 : 3) * D / 256, G, bid, nullptr);
                pg8::EpiHgrnIn E{(pbf*)(ws + WS_Q), (WS_V - WS_Q) / 2, (_Float16*)(ws + WS_LFF), (WS_LFB - WS_LFF) / 2, args.in[I_HGAMMA], 1};
                pg8::gemm_phase<pg8::EpiHgrnIn, pg8::TileOrder, AEPI != 0, true, false>(lds + RING_OFF, g, S, E);
            }
        } else {
            pg8::Gemm g{(const pbf*)(ws + WS_H), (const pbf*)(ws + WS_WIN), F8_IN ? D / 2 : D, 0};
            pg8::TileOrder S; S.init(MROWS / 256, 5 * D / 256, G, bid, nullptr);
            pg8::EpiHgrnIn E{(pbf*)(ws + WS_Q), (WS_V - WS_Q) / 2, (_Float16*)(ws + WS_LFF), (WS_LFB - WS_LFF) / 2, args.in[I_HGAMMA], 0};
            pg8::gemm_phase<pg8::EpiHgrnIn, pg8::TileOrder, AEPI != 0, true, F8_IN != 0, 0x79797979, 0x7F7F7F7F>(lds + RING_OFF, g, S, E);
        }
    })
#if SCAN_NAIVE
    PHASE(PH_SCANA, { p_scan_naive(args, lds, tid); })
    PHASE(PH_SCANC, { })
#else
    PHASE(PH_SCANA, { p_scan_a(args, lds, tid, lane, wave); })
    PHASE(PH_SCANC, { p_scan_c(args, lds, tid, lane, wave); })
#endif
    PHASE(PH_READOUT, { p_readout(args, lane, wave); })
    PHASE(PH_OUTPROJ, {
        pg8::Gemm g{(const pbf*)(ws + WS_YIN), (const pbf*)(ws + WS_WOUT), F8_MISC ? D / 2 : D, 0};
        pg8::TileOrder S; S.init(NTOK / 256, D / 256, G, bid, nullptr);
        pg8::EpiResGate<false, true> E{args.in[I_X], (void*)(ws + WS_X), (const float*)(ws + WS_MODS) + 2 * D, 6 * D, SEQ, nullptr};
        pg8::gemm_phase<pg8::EpiResGate<false, true>, pg8::TileOrder, AEPI != 0, true, F8_MISC != 0, 0x79797979, 0x7D7D7D7D>(lds + RING_OFF, g, S, E);
    })
#ifndef LDSB
#define LDSB 1
#endif
#ifndef XBAR_PROBE
#define XBAR_PROBE 0
#endif
#ifndef G2_NS
#define G2_NS 0
#endif
#ifndef G1_NS
#define G1_NS 0
#endif
#ifndef MOE_HANDOFF
#define MOE_HANDOFF 1
#endif
#ifndef MOE_WT
#define MOE_WT 0
#endif
#define MOE_PHASES(l, pb) \
    if (IN(pb + 0)) { p_router(args, lds, l, tid, lane, wave); cv_finish(args, lds, wave, lane, cv_n, (l + 1) * CV_L0); } SEAM(pb + 0); \
    if ((l) == 1) { if (XBAR_PROBE >= 1) SEAM(pb + 0); if (XBAR_PROBE >= 2) SEAM(pb + 0); if (XBAR_PROBE >= 3) SEAM(pb + 0); if (XBAR_PROBE >= 4) SEAM(pb + 0); }     \
    if (IN(pb + 1) || IN(pb + 2) || IN(pb + 3)) { \
        moe_tables(args, lds, l, tid); \
        LAS int* tab = (LAS int*)(lds + EXTRA_OFF + 640); \
        const LAS int* s_tb = (const LAS int*)(lds + EXTRA_OFF + 256); const LAS int* s_ce = s_tb + 40; \
        const int ntiles = __builtin_amdgcn_readfirstlane(s_tb[32]); \
        const bool hand = MOE_HANDOFF && (G == 256) && IN(pb + 1) && IN(pb + 2) && !((REPMASK >> (pb + 1)) & 3ull) && (MOE_WT || xmap_ok); \
        const int xl = (hand && !MOE_WT) ? 1 : 0; \
        unsigned* tcnt = (unsigned*)(ws + WS_CTL) + CW_TCNT + l * 32768; \
        const int c2 = (hand && MOE_WT) ? ((bid - ((((ntiles * 8) & 255) + 7) & ~7)) & 255) : bid;     \
        const int tv = (((bid & 7) + 1) * ntiles >> 3) - ((bid & 7) * ntiles >> 3);                   \
        LAS int* ut1 = (LAS int*)(lds + EXTRA_OFF + 13824); LAS int* ut2 = ut1 + 32;                  \
        if (wave == 0) { \
            int pm_ = 0, pn_ = 0; \
            const bool h1 = lane < 32 && pg8::MoeOrder::unit_of(xl, ntiles, 2 * D / 256, G, bid, bid >> 3, lane, pm_, pn_); \
            if (lane < 32) ut1[lane] = h1 ? (pm_ | (pn_ << 16) | (tab[pm_] << 24)) : 0; \
            const bool h2 = lane < 32 && pg8::MoeOrder::unit_of(xl, ntiles, D / 256, G, c2, ((bid >> 3) - ((tv * 8) & 31)) & 31, lane, pm_, pn_); \
            if (lane < 32) ut2[lane] = h2 ? (pm_ | (pn_ << 16) | (tab[pm_] << 24)) : 0; \
            const int n1 = __popcll(__ballot(h1)), n2 = __popcll(__ballot(h2)); \
            if (lane == 0) { ut1[64] = n1; ut1[65] = n2; } \
        } \
        __syncthreads(); \
        const int nu1 = __builtin_amdgcn_readfirstlane(ut1[64]), nu2 = __builtin_amdgcn_readfirstlane(ut1[65]); \
        if (IN(pb + 1)) { \
            LAS unsigned short* tt = (LAS unsigned short*)(lds + EXTRA_OFF + 2816);     \
            pg8::MoeOrder S; S.ut = ut1; S.nu = nu1; S.cnt = tcnt; S.rdy = 0u; S.mode = hand ? 0 : 2; \
            { const int* STOK = (const int*)(ws + WS_STOK); int tv_[10];                         \
              _Pragma("unroll") for (int n_ = 0; n_ < 10; ++n_) { const int idx = tid + NTHR * n_; tv_[n_] = 0; \
                  if (idx < nu1 * 256) { const int uw = ut1[idx >> 8], pm_ = uw & 0xFFFF, e_ = (uw >> 24) & 0xFF, vi = (pm_ - s_tb[e_]) * 256 + (idx & 255); if (vi < s_ce[e_]) tv_[n_] = STOK[(size_t)e_ * NTOK + vi]; } } \
              _Pragma("unroll") for (int n_ = 0; n_ < 10; ++n_) { const int idx = tid + NTHR * n_; if (idx < nu1 * 256) tt[idx] = (unsigned short)tv_[n_]; } } \
            __syncthreads(); \
            pg8::Gemm g{(const pbf*)(ws + WS_H), (const pbf*)(ws + WS_W1 + (size_t)l * NE * 2 * D * D), D / 2, (size_t)2 * D * D, tt};   \
            pg8::EpiPair<0, true, 4, MOE_WT != 0, LDSB != 0> E{(pbf*)(ws + WS_ACT), args.in[I_BE1] + (size_t)l * NE * 2 * D, (const LAS float*)(lds + EXTRA_OFF + 14336)}; \
            pg8::gemm_phase<pg8::EpiPair<0, true, 4, MOE_WT != 0, LDSB != 0>, pg8::MoeOrder, AEPI != 0, true, true, 0x79797979, 0x7F7F7F7F, true, G1_NS>(lds + RING_OFF, g, S, E); \
            if ((REPMASK >> (pb + 1)) & 1ull) { __syncthreads(); pg8::gemm_phase<pg8::EpiPair<0, true, 4, MOE_WT != 0, LDSB != 0>, pg8::MoeOrder, AEPI != 0, true, true, 0x79797979, 0x7F7F7F7F, true, G1_NS>(lds + RING_OFF, g, S, E); } \
        } \
        pg8::MoeOrder S2; S2.ut = ut2; S2.nu = nu2; S2.cnt = tcnt; S2.rdy = 0u; S2.mode = hand ? 1 : 2; \
        if (hand) {                                                          \
            if (wave == 0) { \
                const unsigned v = lane < nu2 ? __hip_atomic_load(tcnt + 32 * (ut2[lane & 31] & 0xFFFF), __ATOMIC_RELAXED, __HIP_MEMORY_SCOPE_AGENT) : 64u; \
                const unsigned long long m = __ballot(v >= 64u); \
                __builtin_amdgcn_fence(__ATOMIC_ACQUIRE, "agent"); asm volatile("s_waitcnt vmcnt(0)" ::: "memory"); \
                if (lane == 0) MISC[16] = (unsigned)m; \
            } \
            __syncthreads(); \
            S2.rdy = __builtin_amdgcn_readfirstlane(MISC[16]); \
        } else SEAM(pb + 1); \
        PHASE(pb + 2, { \
            pg8::Gemm g{(const pbf*)(ws + WS_ACT), (const pbf*)(ws + WS_W2 + (size_t)l * NE * D * D), D / 2, (size_t)D * D}; \
            pg8::EpiMoeOut<F8_Y != 0, YSCALE, LDSB != 0> E{(pbf*)(ws + WS_YS), args.in[I_BE2] + (size_t)l * NE * D, (const LAS float*)(lds + EXTRA_OFF + 14336)}; \
            pg8::gemm_phase<pg8::EpiMoeOut<F8_Y != 0, YSCALE, LDSB != 0>, pg8::MoeOrder, AEPI != 0, true, true, 0x79797979, 0x7D7D7D7D, false, G2_NS>(lds + RING_OFF, g, S2, E);   \
        }) \
    }
    bool xmap_ok = false;
    if (MOE_HANDOFF && !MOE_WT && G == 256 && lo == 0) {
        if (wave == 0) {
            const unsigned* xm = (const unsigned*)(ws + WS_CTL) + CW_XMAP; bool ok = true;
#pragma unroll
            for (int k = 0; k < 4; ++k) { const int b = lane + 64 * k; const unsigned mine = __hip_atomic_load(xm + b, __ATOMIC_RELAXED, __HIP_MEMORY_SCOPE_AGENT), cls = __hip_atomic_load(xm + (b & 7), __ATOMIC_RELAXED, __HIP_MEMORY_SCOPE_AGENT);
                ok = ok && mine != 0u && mine == cls; }
            const unsigned me = __hip_atomic_load(xm + (lane & 7), __ATOMIC_RELAXED, __HIP_MEMORY_SCOPE_AGENT);
#pragma unroll
            for (int j = 1; j < 8; ++j) { const unsigned other = (unsigned)__shfl((int)me, (lane + j) & 7); ok = ok && other != me; }
            const bool all_ok = __all(ok);
            if (lane == 0) MISC[17] = all_ok ? 1u : 0u;
        }
        __syncthreads();
        xmap_ok = __builtin_amdgcn_readfirstlane(MISC[17]) != 0u;
    }
    MOE_PHASES(0, PH_ROUTER0)
    PHASE(PH_COMB0, { p_combine<false>(args, lds, 0, lane, wave); })
    PHASE(PH_CVIN, {
        pg8::Gemm g{(const pbf*)(ws + WS_H), (const pbf*)(ws + WS_WCVIN), F8_MISC ? D / 2 : D, 0};
        pg8::TileOrder S; S.init(NTOK / 256, 2 * D / 256, G, bid, nullptr);
        pg8::EpiPair<1> E{(pbf*)(ws + WS_U), args.in[I_BCVIN]};
        pg8::gemm_phase<pg8::EpiPair<1>, pg8::TileOrder, AEPI != 0, true, F8_MISC != 0, 0x79797979, 0x7F7F7F7F>(lds + RING_OFF, g, S, E);
    })
    PHASE(PH_DWCONV, { p_dwconv(args, tid); })
    PHASE(PH_LN, { p_ln_silu(args, lane, wave); })
    PHASE(PH_CVOUT, {
        pg8::Gemm g{(const pbf*)(ws + WS_Z), (const pbf*)(ws + WS_WCVOUT), F8_MISC ? D / 2 : D, 0};
        pg8::TileOrder S; S.init(NTOK / 256, D / 256, G, bid, nullptr);
        pg8::EpiResGate<true, true> E{(const void*)(ws + WS_X), (void*)(ws + WS_X), (const float*)(ws + WS_MODS) + 3 * 6 * D + 2 * D, 6 * D, SEQ, args.in[I_BCVOUT]};
        pg8::gemm_phase<pg8::EpiResGate<true, true>, pg8::TileOrder, AEPI != 0, true, F8_MISC != 0, 0x79797979, 0x7D7D7D7D>(lds + RING_OFF, g, S, E);
    })
#ifndef CLK_PROBE
#define CLK_PROBE 0
#endif
#if CLK_PROBE
    if (bid == 0 && tid == 0) { const unsigned long long c = __builtin_amdgcn_s_memtime(), w = __builtin_amdgcn_s_memrealtime(); MISC[20] = (unsigned)c; MISC[21] = (unsigned)(c >> 32); MISC[22] = (unsigned)w; MISC[23] = (unsigned)(w >> 32); }
#endif
    MOE_PHASES(1, PH_ROUTER1)
#if CLK_PROBE
    if (bid == 0 && tid == 0) { const unsigned long long c = __builtin_amdgcn_s_memtime(), w = __builtin_amdgcn_s_memrealtime(); MISC[24] = (unsigned)c; MISC[25] = (unsigned)(c >> 32); MISC[26] = (unsigned)w; MISC[27] = (unsigned)(w >> 32); }
#endif
    if (IN(PH_FINAL)) { p_combine<true>(args, lds, 1, lane, wave); }
#if KL_PROBE
    static_assert(pg8::KLP_LDS == MISC_OFF + 4 * 28, "probe words");
    if (bid == 0 && tid == 0) {
        const unsigned long long kl = ((unsigned long long)MISC[29] << 32) | MISC[28]; const unsigned nun = MISC[30] ? MISC[30] : 1u;
        const unsigned long long tot = ((unsigned long long)MISC[37] << 32) | MISC[36];
        const unsigned long long ticks = KL_PROBE == 1 ? kl * 10ull / (8ull * nun) : (tot - kl) * 5ull / nun;
        const unsigned long long t_end = __builtin_amdgcn_s_memrealtime() + (ticks < 100000ull ? ticks : 100000ull);
        while (__builtin_amdgcn_s_memrealtime() < t_end) __builtin_amdgcn_s_sleep(8);
    }
#endif
#if TL_PROBE
    if (bid == 0 && tid == 0) { const unsigned ticks = TL_BODY ? MISC[72 + TL_B] - MISC[48 + TL_B] : MISC[48 + TL_B + 1] - MISC[48 + TL_A + 1];     const unsigned long long t_end = __builtin_amdgcn_s_memrealtime() + 2ull * (ticks < 200000u ? ticks : 200000u); while (__builtin_amdgcn_s_memrealtime() < t_end) __builtin_amdgcn_s_sleep(8); }
#endif
#if CVF_PROBE
    if (bid == 0 && tid == 0) { const unsigned long long t_end = __builtin_amdgcn_s_memrealtime() + 2ull * MISC[40]; while (__builtin_amdgcn_s_memrealtime() < t_end) __builtin_amdgcn_s_sleep(8); }
#endif
#if CLK_PROBE
    if (bid == 0 && tid == 0) {
        const unsigned long long c0 = ((unsigned long long)MISC[21] << 32) | MISC[20], w0 = ((unsigned long long)MISC[23] << 32) | MISC[22], c1 = ((unsigned long long)MISC[25] << 32) | MISC[24], w1 = ((unsigned long long)MISC[27] << 32) | MISC[26];
        const unsigned long long ticks = (c1 - c0) * 1000ull / (w1 - w0 + 1ull);
        const unsigned long long t_end = __builtin_amdgcn_s_memrealtime() + (ticks < 100000ull ? ticks : 100000ull);
        while (__builtin_amdgcn_s_memrealtime() < t_end) __builtin_amdgcn_s_sleep(8);
    }
#endif
#undef MOE_PHASES
#undef PHASE
#undef IN
#undef SEAM
}

extern "C" void kernel_launch(void* const* d_in, const int* in_sizes, int n_in, void* d_out, int out_size, void* d_ws, size_t ws_size, hipStream_t stream) {
    static int grid = 0;
    if (grid == 0) {
        if (n_in != N_IN || in_sizes[0] != NTOK * D || out_size != NTOK * D || ws_size < WS_END) { fprintf(stderr, "kernel_launch: unexpected shapes / workspace (n_in %d, in0 %d, out %d, ws %zu, need %zu); nothing launched\n", n_in, n_in > 0 ? in_sizes[0] : -1, out_size, ws_size, (size_t)WS_END); grid = -1; return; }
        int dev = 0, cus = 0, per_cu = 0;
        if (hipGetDevice(&dev) != hipSuccess || hipDeviceGetAttribute(&cus, hipDeviceAttributeMultiprocessorCount, dev) != hipSuccess) { grid = -1; return; }
        if (hipFuncSetAttribute((const void*)fwd_kernel, hipFuncAttributeMaxDynamicSharedMemorySize, LDS_BYTES) != hipSuccess) { fprintf(stderr, "kernel_launch: hipFuncSetAttribute failed\n"); grid = -1; return; }
        if (hipOccupancyMaxActiveBlocksPerMultiprocessor(&per_cu, (const void*)fwd_kernel, NTHR, LDS_BYTES) != hipSuccess || per_cu < 1) { fprintf(stderr, "kernel_launch: occupancy query reports %d workgroups per CU\n", per_cu); }
        (void)hipGetLastError();
        grid = cus;
    }
    if (grid < 0) return;
    if (hipMemsetAsync((char*)d_ws + WS_CTL, 0, CTL_ZERO_BYTES, stream) != hipSuccess) return;
#ifdef DIAG_MEMSET
    (void)hipMemsetAsync((char*)d_ws + WS_SP, 0, (WS_WIN - WS_SP), stream); (void)hipMemsetAsync((char*)d_ws + WS_OF, 0, (WS_YIN - WS_OF), stream);
#endif
    Args a{};
    for (int i = 0; i < N_IN; ++i) a.in[i] = (const float*)d_in[i];
    a.out = (float*)d_out; a.ws = (unsigned char*)d_ws; a.pad = 0;
#ifndef MK_CUTS
    a.ph_lo = 0; a.ph_hi = NPH; a.li = 0;
    hipLaunchKernelGGL(fwd_kernel, dim3(grid), dim3(NTHR), LDS_BYTES, stream, a);
#else
    const int cuts[] = {MK_CUTS};
    const int nc = (int)(sizeof(cuts) / sizeof(cuts[0]));
    for (int li = 0; li + 1 < nc; ++li) { a.ph_lo = cuts[li]; a.ph_hi = cuts[li + 1]; a.li = li; hipLaunchKernelGGL(fwd_kernel, dim3(grid), dim3(NTHR), LDS_BYTES, stream, a); }
#endif
}
```

```cpp
#include <hip/hip_runtime.h>
#include <cstdio>
#include <cstdint>
__device__ __forceinline__ void wg_sync_() { __builtin_amdgcn_fence(__ATOMIC_RELEASE, "workgroup"); __builtin_amdgcn_s_barrier(); __builtin_amdgcn_fence(__ATOMIC_ACQUIRE, "workgroup"); }
#define __syncthreads() wg_sync_()
#define __ballot(p) __builtin_amdgcn_ballot_w64((p) != 0)
#define __all(p) (__builtin_amdgcn_ballot_w64(!(p)) == 0ull)
#define __shfl(v, src) __builtin_amdgcn_ds_bpermute((int)(src) << 2, (int)(v))
#define __popcll(x) __builtin_popcountll(x)

namespace pg8 {
#define PG8_LAS __attribute__((address_space(3)))
typedef unsigned short bf16_t;
typedef short bf16x8 __attribute__((ext_vector_type(8)));
typedef float f32x4 __attribute__((ext_vector_type(4)));
typedef unsigned u32x4 __attribute__((ext_vector_type(4)));
typedef unsigned u32x2 __attribute__((ext_vector_type(2)));
typedef int i32x4 __attribute__((ext_vector_type(4)));
typedef int i32x8 __attribute__((ext_vector_type(8)));
#ifndef KL_PROBE
#define KL_PROBE 0
#endif
constexpr int KLP_LDS = 139264 + 320 + 4 * 28;
constexpr int BM = 256, BK = 64, HALF = 128, HTB = HALF * BK * 2  , STAGE_BYTES = 8 * HTB, NXCD = 8, WGM = 8;

__host__ __device__ __forceinline__ int lds_byte(int r, int c) { const int st = (r >> 4) * 2 + (c >> 5), rr = r & 15, cc = c & 31, ob = rr * 64 + cc * 2; return st * 1024 + (ob ^ (((ob >> 9) & 1) << 5)); }
__host__ __device__ __forceinline__ void stage_rc(int b, int& R, int& C) { const int st = b / 1024, sb = b % 1024, swz = sb ^ (((sb >> 9) & 1) << 5); R = (st >> 1) * 16 + swz / 64; C = (st & 1) * 32 + (swz % 64) / 2; }
__host__ __device__ __forceinline__ int perm32(int rho) { const int n = rho >> 4, i = rho & 15; return 8 * (i >> 2) + 4 * n + (i & 3); }

struct Unit { int pm, pn, e; };
struct Gemm { const bf16_t* A; const bf16_t* Bt; int K; size_t estride; const PG8_LAS unsigned short* tt; };

struct TileOrder {
    int nM, nN, nwg, G, c; const PG8_LAS int* tile_e;
    __device__ __forceinline__ void init(int nM_, int nN_, int G_, int c_, const PG8_LAS int* te) { nM = nM_; nN = nN_; nwg = nM * nN; G = G_; c = c_; tile_e = te; }
    __device__ __forceinline__ bool next(int i, Unit& u) const {
        const long L = (long)i * G + c; if (L >= nwg) return false;
        int wgid = (int)L; { const int q = nwg / NXCD, r = nwg % NXCD, xcd = wgid % NXCD, off = wgid / NXCD; wgid = (xcd < r ? xcd * (q + 1) : r * (q + 1) + (xcd - r) * q) + off; }
        const int nig = WGM * nN, gid = wgid / nig, fm = gid * WGM, gsz = (nM - fm) < WGM ? (nM - fm) : WGM;
        u.pm = fm + ((wgid % nig) % gsz); u.pn = (wgid % nig) / gsz;
        u.e = tile_e ? __builtin_amdgcn_readfirstlane(tile_e[u.pm]) : 0; return true;
    }
    static constexpr bool PUBLISH = false;
    __device__ __forceinline__ bool probe_on() const { return false; }
    __device__ __forceinline__ void a_ready(const Unit&, int) const {}
    __device__ __forceinline__ void done(const Unit&) const {}
    __device__ __forceinline__ void publish(int, int) const {}
};

struct MoeOrder {
    static constexpr bool PUBLISH = true;
    const PG8_LAS int* ut; int nu;
    unsigned* cnt; unsigned rdy; int mode;
    static __device__ __forceinline__ bool unit_of(int xl, int nM, int nN, int G, int c, int rrot, int i, int& pm, int& pn) {
        if (!xl) { TileOrder T; T.init(nM, nN, G, c, nullptr); Unit u; if (!T.next(i, u)) return false; pm = u.pm; pn = u.pn; return true; }
        const int v = c & 7, T0 = (v * nM) >> 3, Tv = (((v + 1) * nM) >> 3) - T0;
        const int Lx = i * 32 + rrot; if (Lx >= Tv * nN) return false;
        const int nig = WGM * nN, gid = Lx / nig, fm = gid * WGM, gsz = (Tv - fm) < WGM ? (Tv - fm) : WGM, w = Lx % nig;
        pm = T0 + fm + (w % gsz); pn = w / gsz; return true;
    }
    __device__ __forceinline__ bool next(int i, Unit& u) const {
        if (i >= nu) return false;
        const int v = __builtin_amdgcn_readfirstlane(ut[i]); u.pm = v & 0xFFFF; u.pn = (v >> 16) & 0xFF; u.e = (v >> 24) & 0xFF; return true;
    }
    __device__ __forceinline__ bool probe_on() const { return mode == 0; }
    __device__ __forceinline__ void done(const Unit&) const {}
    __device__ __forceinline__ void publish(int pm, int lane) const {
        if (mode == 0 && lane == 0) (void)__hip_atomic_fetch_add(cnt + 32 * pm, 1u, __ATOMIC_RELAXED, __HIP_MEMORY_SCOPE_AGENT);
    }
    __device__ __forceinline__ void a_ready(const Unit& u, int i) const {
        if (mode != 1 || ((rdy >> i) & 1u)) return;
        if (__builtin_amdgcn_readfirstlane(threadIdx.x >> 6) == 0) {
            unsigned sp = 0;
            while (__hip_atomic_load(cnt + 32 * u.pm, __ATOMIC_RELAXED, __HIP_MEMORY_SCOPE_AGENT) < 64u) { __builtin_amdgcn_s_sleep(1); if (++sp > (1u << 20)) break; }
            __builtin_amdgcn_fence(__ATOMIC_ACQUIRE, "agent");
            asm volatile("s_waitcnt vmcnt(0)" ::: "memory");
        }
        __builtin_amdgcn_s_barrier();
    }
};

struct OneUnit {
    int pm, pn;
    __device__ __forceinline__ bool next(int i, Unit& u) const { if (i != 0) return false; u.pm = pm; u.pn = pn; u.e = 0; return true; }
    static constexpr bool PUBLISH = false;
    __device__ __forceinline__ bool probe_on() const { return false; }
    __device__ __forceinline__ void a_ready(const Unit&, int) const {}
    __device__ __forceinline__ void done(const Unit&) const {}
    __device__ __forceinline__ void publish(int, int) const {}
};

__device__ __forceinline__ unsigned cvt_pk_bf16(float lo, float hi) { unsigned r; asm volatile("v_cvt_pk_bf16_f32 %0, %1, %2" : "=v"(r) : "v"(lo), "v"(hi)); return r; }
__device__ __forceinline__ float fsigmoid(float x) { return __builtin_amdgcn_rcpf(1.0f + __expf(-x)); }


struct EpiHgrnIn {
    static constexpr bool PERM = true, AFTER_DRAIN = false, LDS_BIAS = false;
    bf16_t* Q; size_t qstride; _Float16* LFF; size_t lfstride; const float* gamma; int mode;
    static __device__ __forceinline__ f32x4 vexp2(f32x4 t) { f32x4 e; e[0] = __builtin_amdgcn_exp2f(t[0]); e[1] = __builtin_amdgcn_exp2f(t[1]); e[2] = __builtin_amdgcn_exp2f(t[2]); e[3] = __builtin_amdgcn_exp2f(t[3]); return e; }
    static __device__ __forceinline__ f32x4 vrcp(f32x4 d) { f32x4 r; r[0] = __builtin_amdgcn_rcpf(d[0]); r[1] = __builtin_amdgcn_rcpf(d[1]); r[2] = __builtin_amdgcn_rcpf(d[2]); r[3] = __builtin_amdgcn_rcpf(d[3]); return r; }
    static __device__ __forceinline__ f32x4 vlog2(f32x4 d) { f32x4 r; r[0] = __builtin_amdgcn_logf(d[0]); r[1] = __builtin_amdgcn_logf(d[1]); r[2] = __builtin_amdgcn_logf(d[2]); r[3] = __builtin_amdgcn_logf(d[3]); return r; }
    __device__ __forceinline__ void operator()(const f32x4 (&acc)[2][2][4][2], const Unit& u, int wr, int wc, int fr, int fq) const {
        const int sg_ = u.pn >> 2, seg = mode == 0 ? sg_ : (mode == 1 ? (sg_ < 2 ? sg_ : 4) : 2 + sg_), cb = (u.pn & 3) * 256 + wc * 32 + 8 * fq;
        const int row0 = u.pm * BM + wr * 64 + fr;
        if (seg == 2 || seg == 3) {
            _Float16* O = LFF + (size_t)(seg - 2) * lfstride; const float* g0 = gamma + (seg - 2) * 2048 + cb;
            f32x4 lb[2][2];
#pragma unroll
            for (int bj = 0; bj < 2; ++bj)
#pragma unroll
                for (int n = 0; n < 2; ++n) { const f32x4 d = *(const f32x4*)(g0 + bj * HALF + 4 * n) - *(const f32x4*)(g0 + 1024 + bj * HALF + 4 * n);
                    lb[bj][n] = vrcp(vexp2(d * -1.4426950408889634f) + 1.0f); }
#pragma unroll
            for (int ai = 0; ai < 2; ++ai)
#pragma unroll
                for (int m = 0; m < 4; ++m) { _Float16* rowp = O + (size_t)(row0 + ai * HALF + m * 16) * 1024 + cb;
#pragma unroll
                    for (int bj = 0; bj < 2; ++bj) { typedef _Float16 h16x8 __attribute__((ext_vector_type(8))); h16x8 o;
#pragma unroll
                        for (int n = 0; n < 2; ++n) { const f32x4 sg = vrcp(vexp2(acc[ai][bj][m][n] * -1.4426950408889634f) + 1.0f);
                            const f32x4 lf = vlog2(lb[bj][n] + (1.0f - lb[bj][n]) * sg);
                            o[4 * n + 0] = (_Float16)lf[0]; o[4 * n + 1] = (_Float16)lf[1]; o[4 * n + 2] = (_Float16)lf[2]; o[4 * n + 3] = (_Float16)lf[3]; }
                        *(h16x8*)(rowp + bj * HALF) = o; } }
        } else {
            bf16_t* O = Q + (size_t)(seg - (seg >> 2) * 2) * qstride;
#pragma unroll
            for (int ai = 0; ai < 2; ++ai)
#pragma unroll
                for (int m = 0; m < 4; ++m) { bf16_t* rowp = O + (size_t)(row0 + ai * HALF + m * 16) * 1024 + cb;
#pragma unroll
                    for (int bj = 0; bj < 2; ++bj) { f32x4 v0 = acc[ai][bj][m][0], v1 = acc[ai][bj][m][1];
                        if (seg == 4) { v0 = v0 * vrcp(vexp2(v0 * -1.4426950408889634f) + 1.0f); v1 = v1 * vrcp(vexp2(v1 * -1.4426950408889634f) + 1.0f); }
                        u32x4 w; w.x = cvt_pk_bf16(v0[0], v0[1]); w.y = cvt_pk_bf16(v0[2], v0[3]); w.z = cvt_pk_bf16(v1[0], v1[1]); w.w = cvt_pk_bf16(v1[2], v1[3]);
                        *(u32x4*)(rowp + bj * HALF) = w; } }
        }
    }
};
template <bool B16> struct RawOf { typedef u32x4 T; };
template <> struct RawOf<true> { typedef u32x2 T; };
template <bool BASE16, bool OUT16> struct EpiResGate {
    static constexpr bool PERM = false, AFTER_DRAIN = false, LDS_BIAS = false;
    const void* base; void* out; const float* gate; int gate_bstride; int rows_per_batch; const float* bias;
    __device__ __forceinline__ void operator()(const f32x4 (&acc)[2][2][4][2], const Unit& u, int wr, int wc, int fr, int fq) const {
        const int row0 = u.pm * BM + wr * 64 + fr, col0 = u.pn * BM + wc * 32 + 4 * fq;
        const float* gv_ = gate + (size_t)((u.pm * BM) / rows_per_batch) * gate_bstride;
        f32x4 gv[2][2], bv[2][2];
#pragma unroll
        for (int bj = 0; bj < 2; ++bj)
#pragma unroll
            for (int n = 0; n < 2; ++n) { gv[bj][n] = *(const f32x4*)(gv_ + col0 + bj * HALF + n * 16); bv[bj][n] = bias ? *(const f32x4*)(bias + col0 + bj * HALF + n * 16) : (f32x4){0.f, 0.f, 0.f, 0.f}; }
        typedef typename RawOf<BASE16>::T raw_t;
        raw_t rb[2][8];
#define ERG_LOAD(b_, dst_) do { _Pragma("unroll") for (int mm = 0; mm < 2; ++mm) _Pragma("unroll") for (int bj = 0; bj < 2; ++bj) _Pragma("unroll") for (int n = 0; n < 2; ++n) { \
            const size_t o = (size_t)(row0 + ((b_) >> 1) * HALF + (2 * ((b_) & 1) + mm) * 16) * 1024 + col0 + bj * HALF + n * 16; \
            if constexpr (BASE16) dst_[mm * 4 + bj * 2 + n] = *(const raw_t*)((const bf16_t*)base + o); else dst_[mm * 4 + bj * 2 + n] = *(const raw_t*)((const float*)base + o); } } while (0)
        ERG_LOAD(0, rb[0]);
#pragma unroll
        for (int b = 0; b < 4; ++b) {
            if (b < 3) ERG_LOAD(b + 1, rb[(b + 1) & 1]);
            const int ai = b >> 1;
#pragma unroll
            for (int mm = 0; mm < 2; ++mm) { const int m = 2 * (b & 1) + mm;
#pragma unroll
                for (int bj = 0; bj < 2; ++bj)
#pragma unroll
                    for (int n = 0; n < 2; ++n) { const size_t o = (size_t)(row0 + ai * HALF + m * 16) * 1024 + col0 + bj * HALF + n * 16; f32x4 bs; const raw_t w = rb[b & 1][mm * 4 + bj * 2 + n];
                        if constexpr (BASE16) bs = (f32x4){__builtin_bit_cast(float, w[0] << 16), __builtin_bit_cast(float, w[0] & 0xffff0000u), __builtin_bit_cast(float, w[1] << 16), __builtin_bit_cast(float, w[1] & 0xffff0000u)};
                        else bs = __builtin_bit_cast(f32x4, w);
                        const f32x4 r = bs + gv[bj][n] * (acc[ai][bj][m][n] + bv[bj][n]);
                        if constexpr (OUT16) *(u32x2*)((bf16_t*)out + o) = (u32x2){cvt_pk_bf16(r[0], r[1]), cvt_pk_bf16(r[2], r[3])};
                        else *(f32x4*)((float*)out + o) = r; } }
        }
#undef ERG_LOAD
    }
};
template <int MODE, bool OUT8 = false, int OSCALE = 1, bool WT = false, bool LB = false> struct EpiPair {
    static constexpr bool PERM = true, AFTER_DRAIN = false, LDS_BIAS = LB;
    bf16_t* O; const float* bias0; const PG8_LAS float* lb;
    __device__ __forceinline__ void stage_bias(const Unit& u, int lane) const {
        const float* src = bias0 + (MODE == 0 ? (size_t)u.e * 2048 : 0) + (lane < 32 ? 0 : 1024 - 128) + u.pn * HALF + lane * 4;
        __builtin_amdgcn_global_load_lds((const unsigned*)src, (PG8_LAS unsigned*)lb, 16, 0, 0);
    }
    static __device__ __forceinline__ f32x4 vsig(f32x4 x, float negscale) {
        const f32x4 t = x * negscale; f32x4 e; e[0] = __builtin_amdgcn_exp2f(t[0]); e[1] = __builtin_amdgcn_exp2f(t[1]); e[2] = __builtin_amdgcn_exp2f(t[2]); e[3] = __builtin_amdgcn_exp2f(t[3]);
        const f32x4 d = e + 1.0f; f32x4 r; r[0] = __builtin_amdgcn_rcpf(d[0]); r[1] = __builtin_amdgcn_rcpf(d[1]); r[2] = __builtin_amdgcn_rcpf(d[2]); r[3] = __builtin_amdgcn_rcpf(d[3]); return r; }
    __device__ __forceinline__ void operator()(const f32x4 (&acc)[2][2][4][2], const Unit& u, int wr, int wc, int fr, int fq) const {
        const float* bias = bias0 + (MODE == 0 ? (size_t)u.e * 2048 : 0);
        const int row0 = u.pm * BM + wr * 64 + fr, cg = u.pn * HALF + wc * 32 + 8 * fq;
        f32x4 b0[2], b1[2];
#pragma unroll
        for (int n = 0; n < 2; ++n) {
            if constexpr (LB) { b0[n] = *(const PG8_LAS f32x4*)(lb + wc * 32 + 8 * fq + 4 * n); b1[n] = *(const PG8_LAS f32x4*)(lb + 128 + wc * 32 + 8 * fq + 4 * n); }
            else { b0[n] = *(const f32x4*)(bias + cg + 4 * n); b1[n] = *(const f32x4*)(bias + 1024 + cg + 4 * n); } }
#pragma unroll
        for (int ai = 0; ai < 2; ++ai)
#pragma unroll
            for (int m = 0; m < 4; ++m) { bf16_t* rowp = O + (size_t)(row0 + ai * HALF + m * 16) * 1024 + cg; f32x4 r[2];
#pragma unroll
                for (int n = 0; n < 2; ++n) { const f32x4 g = acc[ai][0][m][n] + b0[n], up = acc[ai][1][m][n] + b1[n];
                    if (MODE == 0) { const f32x4 gg = __builtin_elementwise_min(g, (f32x4){7.0f, 7.0f, 7.0f, 7.0f});
                        const f32x4 uu = __builtin_elementwise_min(__builtin_elementwise_max(up, (f32x4){-7.0f, -7.0f, -7.0f, -7.0f}), (f32x4){7.0f, 7.0f, 7.0f, 7.0f});
                        r[n] = (uu * (float)OSCALE + (float)OSCALE) * (gg * vsig(gg, -1.702f * 1.4426950408889634f)); }
                    else r[n] = (g * (float)OSCALE) * vsig(up, -1.4426950408889634f); }
                if constexpr (OUT8) {
                    int w0 = 0, w1 = 0;
                    w0 = __builtin_amdgcn_cvt_pk_fp8_f32(r[0][0], r[0][1], w0, false); w0 = __builtin_amdgcn_cvt_pk_fp8_f32(r[0][2], r[0][3], w0, true);
                    w1 = __builtin_amdgcn_cvt_pk_fp8_f32(r[1][0], r[1][1], w1, false); w1 = __builtin_amdgcn_cvt_pk_fp8_f32(r[1][2], r[1][3], w1, true);
                    if constexpr (WT) __hip_atomic_store((unsigned long long*)((unsigned char*)O + (size_t)(row0 + ai * HALF + m * 16) * 1024 + cg), ((unsigned long long)(unsigned)w1 << 32) | (unsigned)w0, __ATOMIC_RELAXED, __HIP_MEMORY_SCOPE_AGENT);
                    else *(u32x2*)((unsigned char*)O + (size_t)(row0 + ai * HALF + m * 16) * 1024 + cg) = (u32x2){(unsigned)w0, (unsigned)w1};
                } else {
                u32x4 w; w.x = cvt_pk_bf16(r[0][0], r[0][1]); w.y = cvt_pk_bf16(r[0][2], r[0][3]); w.z = cvt_pk_bf16(r[1][0], r[1][1]); w.w = cvt_pk_bf16(r[1][2], r[1][3]);
                *(u32x4*)rowp = w; } }
    }
};
template <bool OUT8, int OSCALE, bool LB = false> struct EpiMoeOut {
    static constexpr bool PERM = true, AFTER_DRAIN = false, LDS_BIAS = LB;
    bf16_t* O; const float* bias0; const PG8_LAS float* lb;
    __device__ __forceinline__ void stage_bias(const Unit& u, int lane) const {
        __builtin_amdgcn_global_load_lds((const unsigned*)(bias0 + (size_t)u.e * 1024 + u.pn * BM + lane * 4), (PG8_LAS unsigned*)lb, 16, 0, 0);
    }
    __device__ __forceinline__ void operator()(const f32x4 (&acc)[2][2][4][2], const Unit& u, int wr, int wc, int fr, int fq) const {
        const float* bias = bias0 + (size_t)u.e * 1024;
        const int row0 = u.pm * BM + wr * 64 + fr, col0 = u.pn * BM + wc * 32 + 8 * fq;
        f32x4 bv[2][2];
#pragma unroll
        for (int bj = 0; bj < 2; ++bj)
#pragma unroll
            for (int n = 0; n < 2; ++n) {
                if constexpr (LB) bv[bj][n] = *(const PG8_LAS f32x4*)(lb + wc * 32 + 8 * fq + bj * HALF + 4 * n);
                else bv[bj][n] = *(const f32x4*)(bias + col0 + bj * HALF + 4 * n); }
#pragma unroll
        for (int ai = 0; ai < 2; ++ai)
#pragma unroll
            for (int m = 0; m < 4; ++m) { const int r = row0 + ai * HALF + m * 16;
#pragma unroll
                for (int bj = 0; bj < 2; ++bj) { const f32x4 v0 = acc[ai][bj][m][0] + bv[bj][0], v1 = acc[ai][bj][m][1] + bv[bj][1];
                    if constexpr (OUT8) { const f32x4 lim = (f32x4){448.0f, 448.0f, 448.0f, 448.0f};
                        const f32x4 s0 = __builtin_elementwise_min(__builtin_elementwise_max(v0 * (float)OSCALE, -lim), lim), s1 = __builtin_elementwise_min(__builtin_elementwise_max(v1 * (float)OSCALE, -lim), lim); int w0 = 0, w1 = 0;
                        w0 = __builtin_amdgcn_cvt_pk_fp8_f32(s0[0], s0[1], w0, false); w0 = __builtin_amdgcn_cvt_pk_fp8_f32(s0[2], s0[3], w0, true);
                        w1 = __builtin_amdgcn_cvt_pk_fp8_f32(s1[0], s1[1], w1, false); w1 = __builtin_amdgcn_cvt_pk_fp8_f32(s1[2], s1[3], w1, true);
                        *(u32x2*)((unsigned char*)O + (size_t)r * 1024 + col0 + bj * HALF) = (u32x2){(unsigned)w0, (unsigned)w1};
                    } else { u32x4 w; w.x = cvt_pk_bf16(v0[0], v0[1]); w.y = cvt_pk_bf16(v0[2], v0[3]); w.z = cvt_pk_bf16(v1[0], v1[1]); w.w = cvt_pk_bf16(v1[2], v1[3]);
                        *(u32x4*)(O + (size_t)r * 1024 + col0 + bj * HALF) = w; } } }
    }
};

template <class Epi, class Sched, bool ALIGN_EPI = false, bool SP2 = false, bool F8 = false, int SCW = 0x7F7F7F7F, int SCA = 0x7F7F7F7F, bool GATHER = false, int NS = 0, bool ZC = F8>
__device__ __forceinline__ void gemm_phase(PG8_LAS unsigned char* lds, const Gemm g, const Sched& S, const Epi& E) {
    const int tid = threadIdx.x, wid = __builtin_amdgcn_readfirstlane(tid >> 6), lane = tid & 63, wr = wid >> 2, wc = wid & 3, fr = lane & 15, fq = lane >> 4;
    const int K = g.K, nt = K / BK;
    unsigned voffA[2], voffB[2]; int stR[2], stC[2];
#pragma unroll
    for (int i = 0; i < 2; ++i) { int R, C; stage_rc(tid * 16 + i * 8192, R, C); const int Rb = Epi::PERM ? ((R & ~31) + perm32(R & 31)) : R; stR[i] = R; stC[i] = C;
        voffA[i] = (unsigned)(R * K + C) * 2u; voffB[i] = (unsigned)(Rb * K + C) * 2u; }
    const size_t kstep = (size_t)(BK * 2);
    const size_t hstep = (size_t)HALF * K * 2;
    const size_t tstep = 2 * hstep;
    unsigned vc[2][2], vn[2][2];
#pragma unroll
    for (int h = 0; h < 2; ++h)
#pragma unroll
        for (int i = 0; i < 2; ++i) {
            if constexpr (GATHER) vc[h][i] = (unsigned)g.tt[h * HALF + stR[i]] * (unsigned)(K * 2) + (unsigned)stC[i] * 2u;
            else vc[h][i] = voffA[i] + (unsigned)h * (unsigned)hstep;
            vn[h][i] = vc[h][i]; }
    const unsigned ldsw = (unsigned)wid * 1024u;
    const int aoff = lds_byte(wr * 64 + fr, fq * 8), boff = lds_byte(wc * 32 + fr, fq * 8);
#define PG8_SA(b, h) (((b) * 2 + (h)) * HTB)
#define PG8_SB(b, h) ((4 + (b) * 2 + (h)) * HTB)
#define PG8_STAGE(bufoff, gbase, voff) do { _Pragma("unroll") for (int _i = 0; _i < 2; ++_i) \
        __builtin_amdgcn_global_load_lds((const unsigned*)((const char*)(gbase) + (voff)[_i]), (PG8_LAS unsigned*)(lds + (bufoff) + ldsw + _i * 8192), 16, 0, 0); } while (0)
#define PG8_LDA(dst, b, h) do { _Pragma("unroll") for (int m = 0; m < 4; ++m) _Pragma("unroll") for (int k = 0; k < 2; ++k) dst[m][k] = *(const PG8_LAS bf16x8*)(lds + PG8_SA(b, h) + aoff + m * 2048 + k * 1024); } while (0)
#define PG8_LDB(dst, b, h) do { _Pragma("unroll") for (int n = 0; n < 2; ++n) _Pragma("unroll") for (int k = 0; k < 2; ++k) dst[n][k] = *(const PG8_LAS bf16x8*)(lds + PG8_SB(b, h) + boff + n * 2048 + k * 1024); } while (0)
#define PG8_MMA(ai, bj, At, Bt) do { __builtin_amdgcn_s_setprio(1); \
        if constexpr (!F8) { _Pragma("unroll") for (int m = 0; m < 4; ++m) _Pragma("unroll") for (int n = 0; n < 2; ++n) _Pragma("unroll") for (int k = 0; k < 2; ++k) \
            acc[ai][bj][m][n] = __builtin_amdgcn_mfma_f32_16x16x32_bf16(Bt[n][k], At[m][k], acc[ai][bj][m][n], 0, 0, 0); } \
        else { const int scw_ = SCW, sca_ = SCA; _Pragma("unroll") for (int m = 0; m < 4; ++m) _Pragma("unroll") for (int n = 0; n < 2; ++n) { \
            const i32x8 wf_ = __builtin_shufflevector(__builtin_bit_cast(i32x4, Bt[n][0]), __builtin_bit_cast(i32x4, Bt[n][1]), 0, 1, 2, 3, 4, 5, 6, 7); \
            const i32x8 af_ = __builtin_shufflevector(__builtin_bit_cast(i32x4, At[m][0]), __builtin_bit_cast(i32x4, At[m][1]), 0, 1, 2, 3, 4, 5, 6, 7); \
            asm volatile("v_mfma_scale_f32_16x16x128_f8f6f4 %0, %1, %2, %0, %3, %4 op_sel_hi:[0,0,0]" : "+v"(acc[ai][bj][m][n]) : "v"(wf_), "v"(af_), "v"(scw_), "v"(sca_)); } } \
        __builtin_amdgcn_s_setprio(0); } while (0)
#define PG8_MMAZ(ai, bj, At, Bt) do { __builtin_amdgcn_s_setprio(1); \
        if constexpr (!F8) { _Pragma("unroll") for (int m = 0; m < 4; ++m) _Pragma("unroll") for (int n = 0; n < 2; ++n) { \
            acc[ai][bj][m][n] = __builtin_amdgcn_mfma_f32_16x16x32_bf16(Bt[n][0], At[m][0], (f32x4){0.f, 0.f, 0.f, 0.f}, 0, 0, 0); \
            acc[ai][bj][m][n] = __builtin_amdgcn_mfma_f32_16x16x32_bf16(Bt[n][1], At[m][1], acc[ai][bj][m][n], 0, 0, 0); } } \
        else { const int scw_ = SCW, sca_ = SCA; _Pragma("unroll") for (int m = 0; m < 4; ++m) _Pragma("unroll") for (int n = 0; n < 2; ++n) { \
            const i32x8 wf_ = __builtin_shufflevector(__builtin_bit_cast(i32x4, Bt[n][0]), __builtin_bit_cast(i32x4, Bt[n][1]), 0, 1, 2, 3, 4, 5, 6, 7); \
            const i32x8 af_ = __builtin_shufflevector(__builtin_bit_cast(i32x4, At[m][0]), __builtin_bit_cast(i32x4, At[m][1]), 0, 1, 2, 3, 4, 5, 6, 7); \
            asm volatile("v_mfma_scale_f32_16x16x128_f8f6f4 %0, %1, %2, 0, %3, %4 op_sel_hi:[0,0,0]" : "=&v"(acc[ai][bj][m][n]) : "v"(wf_), "v"(af_), "v"(scw_), "v"(sca_)); } } \
        __builtin_amdgcn_s_setprio(0); } while (0)
#define PG8_WAIT_V(n) asm volatile("s_waitcnt vmcnt(" #n ")" ::: "memory")
#define PG8_WAIT_VN(n) asm volatile("s_waitcnt vmcnt(%0)" :: "n"(n) : "memory")
#define PG8_WAIT_L(n) asm volatile("s_waitcnt lgkmcnt(" #n ")" ::: "memory")
#define PG8_BAR __builtin_amdgcn_s_barrier()
#define PG8_SCHED __builtin_amdgcn_sched_barrier(0)
    Unit cur, nxt; int ui = 0, ppm = 0;
    if (!S.next(0, cur)) return;
#if KL_PROBE
    if (Sched::PUBLISH && S.probe_on() && blockIdx.x == 0 && wid == 0) { const unsigned long long t0_ = __builtin_amdgcn_s_memtime(); if (lane == 0) { PG8_LAS unsigned* kp = (PG8_LAS unsigned*)(unsigned)KLP_LDS; kp[6] = (unsigned)t0_; kp[7] = (unsigned)(t0_ >> 32); } }
#endif
    static_assert(SP2, "this build keeps only the SP2 K-loop");
    f32x4 acc[2][2][4][2];
    if constexpr (!ZC) {
#pragma unroll
    for (int a = 0; a < 2; ++a)
#pragma unroll
        for (int b = 0; b < 2; ++b)
#pragma unroll
            for (int m = 0; m < 4; ++m)
#pragma unroll
                for (int n = 0; n < 2; ++n) acc[a][b][m][n] = (f32x4){0.f, 0.f, 0.f, 0.f};
    }
    bf16x8 At[4][2], B0[2][2], B1[2][2];
    const char* cA = (const char*)g.A + (GATHER ? (size_t)0 : (size_t)cur.pm * tstep); const char* cB = (const char*)g.Bt + (size_t)cur.e * g.estride + (size_t)cur.pn * tstep;
    S.a_ready(cur, 0);
    if constexpr (SP2) {
        PG8_STAGE(PG8_SB(0, 0), cB, voffB); PG8_STAGE(PG8_SB(0, 1), cB + hstep, voffB); PG8_STAGE(PG8_SA(0, 0), cA, vc[0]); PG8_STAGE(PG8_SA(0, 1), cA, vc[1]);
        if (wr == 1) PG8_BAR;
        PG8_WAIT_V(2); PG8_BAR;
        PG8_STAGE(PG8_SB(1, 0), cB + kstep, voffB); PG8_STAGE(PG8_SA(1, 0), cA + kstep, vc[0]); PG8_STAGE(PG8_SB(1, 1), cB + hstep + kstep, voffB);
        PG8_WAIT_V(6); PG8_BAR;
    } else {
        PG8_STAGE(PG8_SB(0, 0), cB, voffB); PG8_STAGE(PG8_SA(0, 0), cA, vc[0]); PG8_STAGE(PG8_SB(0, 1), cB + hstep, voffB); PG8_STAGE(PG8_SA(0, 1), cA, vc[1]);
        if (wr == 1) PG8_BAR;
        PG8_WAIT_V(4); PG8_BAR;
        PG8_STAGE(PG8_SB(1, 0), cB + kstep, voffB); PG8_STAGE(PG8_SA(1, 0), cA + kstep, vc[0]); PG8_STAGE(PG8_SB(1, 1), cB + hstep + kstep, voffB);
        PG8_WAIT_V(6); PG8_BAR;
    }
    for (;;) {
        const bool has_next = S.next(ui + 1, nxt);
        if constexpr (GATHER) { if (has_next) {
#pragma unroll
            for (int h = 0; h < 2; ++h)
#pragma unroll
                for (int i = 0; i < 2; ++i) vn[h][i] = (unsigned)g.tt[(ui + 1) * BM + h * HALF + stR[i]] * (unsigned)(K * 2) + (unsigned)stC[i] * 2u; } }
        const char* nA = (has_next && !GATHER) ? (const char*)g.A + (size_t)nxt.pm * tstep : cA; const char* nB = has_next ? (const char*)g.Bt + (size_t)nxt.e * g.estride + (size_t)nxt.pn * tstep : cB;
#if KL_PROBE
        if (Sched::PUBLISH && S.probe_on() && blockIdx.x == 0 && wid == 0) { const unsigned long long t0_ = __builtin_amdgcn_s_memtime(); if (lane == 0) { PG8_LAS unsigned* kp = (PG8_LAS unsigned*)(unsigned)KLP_LDS; kp[4] = (unsigned)t0_; kp[5] = (unsigned)(t0_ >> 32); } }
#endif
#define PG8_WAIT_V8R do { if constexpr (NS > 0) { PG8_WAIT_VN(8 + NS); if (!rlx) PG8_WAIT_V(8); } else PG8_WAIT_V(8); } while (0)
#define PG8_TRIP(MMAK_, FIRST_) { \
            const bool last = (t == nt - 2); \
            unsigned vs[2][2]; \
            _Pragma("unroll") for (int h = 0; h < 2; ++h) _Pragma("unroll") for (int i = 0; i < 2; ++i) vs[h][i] = (GATHER && last) ? vn[h][i] : vc[h][i]; \
            const char* a1 = cA + (size_t)(t + 1) * kstep;                                             \
            const char* a2 = last ? nA : cA + (size_t)(t + 2) * kstep; const char* b2 = last ? nB : cB + (size_t)(t + 2) * kstep;     \
            const char* a3 = a2 + kstep; const char* b3 = b2 + kstep;                                \
            if (last && has_next) S.a_ready(nxt, ui + 1); \
            if constexpr (Epi::LDS_BIAS) { if (last && wid == 0) E.stage_bias(cur, lane); }     \
            if constexpr (Sched::PUBLISH) { if (t == 2 && ui > 0) S.publish(ppm, lane); }     \
            const bool rlx = (NS > 0) && (FIRST_) && (ui > 0); \
              \
            PG8_LDB(B0, 0, 0); PG8_LDB(B1, 0, 1); PG8_SCHED; PG8_LDA(At, 0, 0); if (!rlx) PG8_STAGE(PG8_SA(1, 1), a1, vc[1]); \
            PG8_WAIT_V8R; PG8_WAIT_L(0); PG8_BAR; MMAK_(0, 0, At, B0); MMAK_(0, 1, At, B1); PG8_BAR; PG8_SCHED; \
              \
            PG8_LDA(At, 0, 1); PG8_STAGE(PG8_SB(0, 0), b2, voffB); PG8_STAGE(PG8_SB(0, 1), b2 + hstep, voffB); PG8_STAGE(PG8_SA(0, 0), a2, vs[0]); \
            PG8_WAIT_V8R; PG8_WAIT_L(0); PG8_BAR; MMAK_(1, 0, At, B0); MMAK_(1, 1, At, B1); PG8_BAR; PG8_SCHED; \
              \
            PG8_LDB(B0, 1, 0); PG8_LDB(B1, 1, 1); PG8_SCHED; PG8_LDA(At, 1, 0); PG8_STAGE(PG8_SA(0, 1), a2, vs[1]); \
            PG8_WAIT_V8R; PG8_WAIT_L(0); PG8_BAR; PG8_MMA(0, 0, At, B0); PG8_MMA(0, 1, At, B1); PG8_BAR; PG8_SCHED; \
              \
            PG8_LDA(At, 1, 1); PG8_STAGE(PG8_SB(1, 0), b3, voffB); PG8_STAGE(PG8_SB(1, 1), b3 + hstep, voffB); PG8_STAGE(PG8_SA(1, 0), a3, vs[0]); \
            PG8_WAIT_V(8); PG8_WAIT_L(0); PG8_BAR; PG8_MMA(1, 0, At, B0); PG8_MMA(1, 1, At, B1); PG8_BAR; PG8_SCHED; }
        if constexpr (ZC) {
            { const int t = 0; PG8_TRIP(PG8_MMAZ, true) }
            for (int t = 2; t < nt; t += 2) PG8_TRIP(PG8_MMA, false)
        } else {
            for (int t = 0; t < nt; t += 2) PG8_TRIP(PG8_MMA, t == 0)
        }
#if KL_PROBE
        if (Sched::PUBLISH && S.probe_on() && blockIdx.x == 0 && wid == 0) { const unsigned long long t1_ = __builtin_amdgcn_s_memtime(); if (lane == 0) { PG8_LAS unsigned* kp = (PG8_LAS unsigned*)(unsigned)KLP_LDS; const unsigned long long d = t1_ - (((unsigned long long)kp[5] << 32) | kp[4]); const unsigned long long acc_ = (((unsigned long long)kp[1] << 32) | kp[0]) + d; kp[0] = (unsigned)acc_; kp[1] = (unsigned)(acc_ >> 32); kp[2] += 1u; } }
#endif
        if constexpr (ALIGN_EPI) { if (wr == 0) PG8_BAR; }
        if constexpr (NS > 0) { static_assert(SP2 && ALIGN_EPI, "NS needs SP2 and ALIGN_EPI"); if (has_next) PG8_STAGE(PG8_SA(1, 1), nA + kstep, vn[1]); }
        if constexpr (!Epi::AFTER_DRAIN) { E(acc, cur, wr, wc, fr, fq); S.done(cur); ppm = cur.pm; }
        if (!has_next) break;
        if constexpr (!ZC) {
#pragma unroll
        for (int a = 0; a < 2; ++a)
#pragma unroll
            for (int b = 0; b < 2; ++b)
#pragma unroll
                for (int m = 0; m < 4; ++m)
#pragma unroll
                    for (int n = 0; n < 2; ++n) acc[a][b][m][n] = (f32x4){0.f, 0.f, 0.f, 0.f};
        }
        cur = nxt; cA = nA; cB = nB; ++ui;
        if constexpr (GATHER) {
#pragma unroll
            for (int h = 0; h < 2; ++h)
#pragma unroll
                for (int i = 0; i < 2; ++i) vc[h][i] = vn[h][i]; }
        if constexpr (ALIGN_EPI) { if (wr == 1) PG8_BAR; }
    }
#if KL_PROBE
    if (Sched::PUBLISH && S.probe_on() && blockIdx.x == 0 && wid == 0) { const unsigned long long t1_ = __builtin_amdgcn_s_memtime(); if (lane == 0) { PG8_LAS unsigned* kp = (PG8_LAS unsigned*)(unsigned)KLP_LDS; const unsigned long long d = t1_ - (((unsigned long long)kp[7] << 32) | kp[6]); const unsigned long long acc_ = (((unsigned long long)kp[9] << 32) | kp[8]) + d; kp[8] = (unsigned)acc_; kp[9] = (unsigned)(acc_ >> 32); } }
#endif
    PG8_WAIT_V(0); if constexpr (Sched::PUBLISH) S.publish(ppm, lane);
    if constexpr (!ALIGN_EPI) { if (wr == 0) PG8_BAR; }
    PG8_BAR;
    if constexpr (Epi::AFTER_DRAIN) { E.fused(acc, cur, wr, wc, fr, fq, lds, wid, lane); S.done(cur); }
#undef PG8_SA
#undef PG8_SB
#undef PG8_STAGE
#undef PG8_LDA
#undef PG8_LDB
#undef PG8_MMA
#undef PG8_MMAZ
#undef PG8_TRIP
#undef PG8_WAIT_V
#undef PG8_WAIT_VN
#undef PG8_WAIT_V8R
#undef PG8_WAIT_L
#undef PG8_BAR
#undef PG8_SCHED
}
}


constexpr int D = 1024, NBATCH = 2, SEQ = 16384, NTOK = NBATCH * SEQ, CTXL = 256, NCTX = NBATCH * CTXL, MROWS = NTOK + NCTX;
constexpr int NHEAD = 8, DK = 128, NE = 32, TOPK = 4, CONVW = 31, GRIDW = 64, GRIDR = SEQ / GRIDW;
constexpr int NWAVES = 8, NTHR = NWAVES * 64;
constexpr int MAXTILES = 544;
constexpr float EPS = 1e-6f;
enum { I_X = 0, I_C, I_CTX, I_CCTX, I_WADA, I_BADA, I_GMIX, I_GFFN, I_WHIN, I_HGAMMA, I_GHOUT, I_WHOUT, I_WCVIN, I_BCVIN, I_WCVDW, I_BCVDW, I_GCVLN, I_BCVLN, I_WCVOUT, I_BCVOUT,
       I_WR, I_BR, I_WE1, I_BE1, I_WE2, I_BE2, I_GFINAL, N_IN };

constexpr size_t MiB = 1u << 20;
constexpr size_t WS_CTL = 0, CTL_ZERO_BYTES = 1 * MiB;
constexpr size_t WS_MODS = 1 * MiB;
constexpr size_t WS_TOPE = 2 * MiB, WS_TOPW = 2 * MiB + 512 * 1024, WS_POS = 3 * MiB, WS_BCNT = 3 * MiB + 512 * 1024, WS_TILEE = WS_BCNT + 64 * 1024, WS_SLOTW = 4 * MiB;
constexpr size_t WS_SP = 5 * MiB, WS_SD = 8 * MiB;
constexpr size_t WS_WIN = 48 * MiB, WS_WOUT = 58 * MiB, WS_WCVIN = 60 * MiB, WS_WCVOUT = 64 * MiB, WS_W1 = 66 * MiB, WS_W2 = 322 * MiB;
constexpr size_t WS_X = 450 * MiB;
constexpr size_t WS_H = 578 * MiB;
constexpr size_t WS_Q = 644 * MiB, WS_V = 709 * MiB, WS_SG = 774 * MiB, WS_LFF = 839 * MiB, WS_LFB = 969 * MiB, WS_OF = 1099 * MiB, WS_OB = 1227 * MiB, WS_YIN = 1355 * MiB;
constexpr size_t WS_AS = 1419 * MiB, WS_ACT = 1555 * MiB, WS_YS = 1691 * MiB, WS_END = 1963 * MiB;
#ifndef F8_IN
#define F8_IN 0
#endif
#ifndef SPLIT_IN
#define SPLIT_IN 1
#endif
#ifndef TL_PROBE
#define TL_PROBE 0
#define TL_A (-1)
#define TL_B 0
#define TL_BODY 0
#endif
#ifndef CVF_PROBE
#define CVF_PROBE 0
#endif
#ifndef G_F8
#define G_F8 1
#endif
#ifndef F8_Y
#define F8_Y 1
#endif
constexpr int YSCALE = 16;
#ifndef F8_MISC
#define F8_MISC 1
#endif
constexpr size_t WS_H8 = WS_OF + 64 * MiB;
constexpr size_t WS_WIN8 = WS_WIN + 6 * MiB;
constexpr size_t WS_STOK = WS_AS;
constexpr int CW_MODF = 3200;
constexpr int CW_FLAT = 3072;
constexpr int CW_GCNT = 2048;
constexpr float W8SCALE = 64.0f;
constexpr size_t WS_U = WS_Q, WS_ZP = WS_V, WS_Z = WS_SG;
constexpr int CW_BAR = 4096;
constexpr int CW_XMAP = 32768;
constexpr int CW_TCNT = 65536;

constexpr int RING_OFF = 0, RING_BYTES = 131072;
constexpr int LDSCTL_OFF = 139264, MISC_OFF = LDSCTL_OFF + 320, EXTRA_OFF = LDSCTL_OFF + 1024;
constexpr int LDS_BYTES = 155648;

#define LAS __attribute__((address_space(3)))
typedef unsigned short bf16;
typedef unsigned v4u __attribute__((ext_vector_type(4)));
typedef unsigned v2u __attribute__((ext_vector_type(2)));
typedef float f32x4 __attribute__((ext_vector_type(4)));
typedef int v4i __attribute__((ext_vector_type(4)));
#define LDS_WAIT() asm volatile("s_waitcnt lgkmcnt(0)" ::: "memory")
#define VM_WAIT() asm volatile("s_waitcnt vmcnt(0)" ::: "memory")
__device__ __forceinline__ unsigned f2bf(float f) { unsigned u = __builtin_bit_cast(unsigned, f); return (u + 0x7fffu + ((u >> 16) & 1u)) >> 16; }
__device__ __forceinline__ unsigned pk2(float lo, float hi) { return f2bf(lo) | (f2bf(hi) << 16); }
__device__ __forceinline__ float bf_lo(unsigned u) { return __builtin_bit_cast(float, u << 16); }
__device__ __forceinline__ float bf_hi(unsigned u) { return __builtin_bit_cast(float, u & 0xffff0000u); }
__device__ __forceinline__ float bf2f(bf16 h) { return __builtin_bit_cast(float, ((unsigned)h) << 16); }
__device__ __forceinline__ float fsig(float x) { return __builtin_amdgcn_rcpf(1.0f + __expf(-x)); }
__device__ __forceinline__ float wave_sum(float v) {
#define WS_DPP(x, ctrl) __builtin_bit_cast(float, __builtin_amdgcn_update_dpp(0, __builtin_bit_cast(int, x), ctrl, 0xF, 0xF, true))
    v += WS_DPP(v, 0xB1);
    v += WS_DPP(v, 0x4E);
    v += WS_DPP(v, 0x141);
    v += WS_DPP(v, 0x140);
#undef WS_DPP
    const int vi = __builtin_bit_cast(int, v);
    return (__builtin_bit_cast(float, __builtin_amdgcn_readlane(vi, 0)) + __builtin_bit_cast(float, __builtin_amdgcn_readlane(vi, 16)))
         + (__builtin_bit_cast(float, __builtin_amdgcn_readlane(vi, 32)) + __builtin_bit_cast(float, __builtin_amdgcn_readlane(vi, 48)));
}

__device__ __forceinline__ float half_sum(float v) {
#define WS_DPP(x, ctrl) __builtin_bit_cast(float, __builtin_amdgcn_update_dpp(0, __builtin_bit_cast(int, x), ctrl, 0xF, 0xF, true))
    v += WS_DPP(v, 0xB1); v += WS_DPP(v, 0x4E); v += WS_DPP(v, 0x141); v += WS_DPP(v, 0x140);
#undef WS_DPP
    return v + __shfl_xor(v, 16);
}
__device__ __forceinline__ float sat8(float x) { return __builtin_amdgcn_fmed3f(x, -448.0f, 448.0f); }
__device__ __forceinline__ unsigned pk4_fp8(float a, float b, float c, float d) { int w = 0; w = __builtin_amdgcn_cvt_pk_fp8_f32(sat8(a), sat8(b), w, false); w = __builtin_amdgcn_cvt_pk_fp8_f32(sat8(c), sat8(d), w, true); return (unsigned)w; }
template <bool OUT8> __device__ __forceinline__ void store_row4(void* orow, int lane, int j, f32x4 y, float scale) {
    if constexpr (OUT8) ((unsigned*)orow)[lane + 64 * j] = pk4_fp8(y.x * scale, y.y * scale, y.z * scale, y.w * scale);
    else { v2u w; w.x = pk2(y.x, y.y); w.y = pk2(y.z, y.w); ((v2u*)orow)[lane + 64 * j] = w; }
}

#define XB_TMO      128
#define XB_XCNT(j)  (256  + 64 * (j))
#define XB_XSUB(j)  (1280 + 64 * (j))
#define XB_XGEN(j)  (2304 + 64 * (j))
#define XB_TOP      3328
#define XB_TOPGEN   3392
#define XCD_BAR_WORDS 3456
#define XB_SPIN_CAP (1u << 18)

__device__ __forceinline__ unsigned xb_ld(unsigned* p)              { return __hip_atomic_load(p, __ATOMIC_RELAXED, __HIP_MEMORY_SCOPE_AGENT); }
__device__ __forceinline__ unsigned xb_add(unsigned* p, unsigned v) { return __hip_atomic_fetch_add(p, v, __ATOMIC_RELAXED, __HIP_MEMORY_SCOPE_AGENT); }
__device__ __forceinline__ unsigned xb_xcc_id() { return (unsigned)__builtin_amdgcn_s_getreg((3 << 11) | 20) & 0xFu; }
#define XB_SPIN(cond, bar) do { unsigned _sp = 0; while (cond) { __builtin_amdgcn_s_sleep(1); \
    if ((++_sp & 255u) == 0u) { if (xb_ld(&(bar)[XB_TMO])) break; if (_sp > XB_SPIN_CAP) { atomicAdd(&(bar)[XB_TMO], 1u); break; } } } } while (0)

struct XcdBarrier {
    unsigned* bar; unsigned x;
    volatile LAS unsigned* st;
};

__device__ __forceinline__ XcdBarrier xcd_barrier_post(unsigned* bar, volatile LAS unsigned* st) {
    XcdBarrier b; b.bar = bar; b.x = xb_xcc_id(); b.st = st;
    if (threadIdx.x == 0) (void)xb_add(&bar[XB_XCNT(b.x)], 1u);
    return b;
}
__device__ __forceinline__ void xcd_barrier_complete(unsigned* bar, unsigned x, unsigned& nloc, unsigned& nx) {
    const unsigned G = gridDim.x * gridDim.y * gridDim.z;
    unsigned sum, cnt, mine, sp = 0u;
    for (;;) {
        sum = 0u; cnt = 0u; mine = 0u;
#pragma unroll
        for (unsigned j = 0; j < 16; ++j) { const unsigned c = xb_ld(&bar[XB_XCNT(j)]); sum += c; cnt += (c > 0u) ? 1u : 0u; mine = (j == x) ? c : mine; }
        if (sum == G) break;
        __builtin_amdgcn_s_sleep(1);
        if ((++sp & 255u) == 0u) { if (xb_ld(&bar[XB_TMO])) break; if (sp > XB_SPIN_CAP) { atomicAdd(&bar[XB_TMO], 1u); break; } }
    }
    nloc = mine > 0u ? mine : 1u; nx = cnt > 0u ? cnt : 1u;
}

__device__ __forceinline__ void xcd_barrier(const XcdBarrier& b) {
    asm volatile("s_waitcnt vmcnt(0)" ::: "memory");
    __syncthreads();
    if (threadIdx.x == 0) {
        unsigned* bar = b.bar;
        __builtin_amdgcn_s_waitcnt(0);
        unsigned nloc = b.st[0], nx = b.st[1];
        if (nloc == 0u) { xcd_barrier_complete(bar, b.x, nloc, nx); b.st[0] = nloc; b.st[1] = nx; }
        const unsigned old = xb_add(&bar[XB_XSUB(b.x)], 1u);
        const unsigned gen = old / nloc;
        if (old + 1u == (gen + 1u) * nloc) {
            __builtin_amdgcn_fence(__ATOMIC_RELEASE, "agent");
            asm volatile("s_waitcnt vmcnt(0)" ::: "memory");
            const unsigned og = xb_add(&bar[XB_TOP], 1u);
            const unsigned tg = og / nx;
            if (og + 1u == (tg + 1u) * nx) xb_add(&bar[XB_TOPGEN], 1u);
            else XB_SPIN(xb_ld(&bar[XB_TOPGEN]) == tg, bar);
            __builtin_amdgcn_fence(__ATOMIC_ACQUIRE, "agent");
            xb_add(&bar[XB_XGEN(b.x)], 1u);
            asm volatile("s_waitcnt vmcnt(0)" ::: "memory");
        } else {
            XB_SPIN(xb_ld(&bar[XB_XGEN(b.x)]) == gen, bar);
            __builtin_amdgcn_fence(__ATOMIC_ACQUIRE, "agent");
            asm volatile("s_waitcnt vmcnt(0)" ::: "memory");
        }
    }
    __syncthreads();
}

struct Args { const float* in[N_IN]; float* out; unsigned char* ws; int ph_lo, ph_hi, li, pad; };

__device__ __forceinline__ void p_mods(const Args& a, LAS unsigned char* lds, int tid, int lane, int wave) {
    LAS float* sc = (LAS float*)lds;
    LAS float* part = sc + 3 * D;
    float* MODS = (float*)(a.ws + WS_MODS);
    for (int i = tid; i < 3 * D; i += NTHR) { const int r = i >> 10, k = i & 1023; const float v = r < 2 ? a.in[I_C][r * D + k] : a.in[I_CCTX][k]; sc[i] = v * fsig(v); }
    __syncthreads();
    for (int item = blockIdx.x; item < 2 * 96; item += gridDim.x) {
        const int l = item / 96, cb = item % 96;
        const float* W = a.in[I_WADA] + (size_t)l * D * 6 * D + cb * 64 + lane;
        float a0 = 0.f, a1 = 0.f, a2 = 0.f;
#pragma unroll 16
        for (int kk = 0; kk < 128; ++kk) { const int k = wave * 128 + kk; const float w = W[(size_t)k * (6 * D)]; a0 += sc[k] * w; a1 += sc[D + k] * w; a2 += sc[2 * D + k] * w; }
        part[(wave * 3 + 0) * 64 + lane] = a0; part[(wave * 3 + 1) * 64 + lane] = a1; part[(wave * 3 + 2) * 64 + lane] = a2;
        __syncthreads();
        if (tid < 192) { const int r = tid >> 6, ln = tid & 63; float s = 0.f;
#pragma unroll
            for (int w = 0; w < 8; ++w) s += part[(w * 3 + r) * 64 + ln];
            __hip_atomic_store(&MODS[(size_t)(l * 3 + r) * (6 * D) + cb * 64 + ln], s + a.in[I_BADA][l * 6 * D + cb * 64 + ln], __ATOMIC_RELAXED, __HIP_MEMORY_SCOPE_AGENT); }
        asm volatile("s_waitcnt vmcnt(0)" ::: "memory");
        __syncthreads();
        if (item < 32 && tid == 0) (void)__hip_atomic_fetch_add((unsigned*)(a.ws + WS_CTL) + CW_MODF, 1u, __ATOMIC_RELAXED, __HIP_MEMORY_SCOPE_AGENT);
    }
}
__device__ __forceinline__ void wait_mods0(const Args& a, int tid) {
    if (tid == 0) { unsigned* f = (unsigned*)(a.ws + WS_CTL) + CW_MODF; unsigned sp = 0;
        while (__hip_atomic_load(f, __ATOMIC_RELAXED, __HIP_MEMORY_SCOPE_AGENT) < 32u) { __builtin_amdgcn_s_sleep(2); if (++sp > (1u << 22)) break; }
        __builtin_amdgcn_fence(__ATOMIC_ACQUIRE, "agent");
        asm volatile("s_waitcnt vmcnt(0)" ::: "memory"); }
    __syncthreads();
}
template <bool OUT8> __device__ __forceinline__ void transpose_item(const float* W, int K, int N, bf16* WT, bool paired, LAS float* scr, int item, int lane, int row_adj = 0) {
    const int nblk = N / 32, kb = item / nblk, nb = item % nblk, k0 = 64 * kb, n0 = 32 * nb;
    int d0 = n0 + row_adj; if (paired) { const int half = n0 >> 10, c = n0 & 1023; d0 = (c >> 7) * 256 + half * 128 + (c & 127); }
    float t[32];
#pragma unroll
    for (int i = 0; i < 32; ++i) { const int kk = 2 * i + (lane >> 5); t[i] = __builtin_nontemporal_load(&W[(size_t)(k0 + kk) * N + n0 + (lane & 31)]); }
#pragma unroll
    for (int i = 0; i < 32; ++i) { const int kk = 2 * i + (lane >> 5); scr[kk * 33 + (lane & 31)] = t[i]; }
    LDS_WAIT(); asm volatile("" ::: "memory");
    const int c = lane & 7;
#pragma unroll
    for (int j = 0; j < 4; ++j) { const int n = (lane >> 3) + 8 * j; const LAS float* s = scr + (8 * c) * 33 + n;
        if constexpr (OUT8) {
            int w0 = 0, w1 = 0;
            w0 = __builtin_amdgcn_cvt_pk_fp8_f32(s[0 * 33] * W8SCALE, s[1 * 33] * W8SCALE, w0, false); w0 = __builtin_amdgcn_cvt_pk_fp8_f32(s[2 * 33] * W8SCALE, s[3 * 33] * W8SCALE, w0, true);
            w1 = __builtin_amdgcn_cvt_pk_fp8_f32(s[4 * 33] * W8SCALE, s[5 * 33] * W8SCALE, w1, false); w1 = __builtin_amdgcn_cvt_pk_fp8_f32(s[6 * 33] * W8SCALE, s[7 * 33] * W8SCALE, w1, true);
            *(v2u*)((unsigned char*)WT + (size_t)(d0 + n) * K + k0 + 8 * c) = (v2u){(unsigned)w0, (unsigned)w1};
        } else {
        v4u o; o.x = pk2(s[0 * 33], s[1 * 33]); o.y = pk2(s[2 * 33], s[3 * 33]); o.z = pk2(s[4 * 33], s[5 * 33]); o.w = pk2(s[6 * 33], s[7 * 33]);
        *(v4u*)(WT + (size_t)(d0 + n) * K + k0 + 8 * c) = o; } }
    LDS_WAIT(); asm volatile("" ::: "memory");
}
__device__ __forceinline__ void p_weights(const Args& a, LAS unsigned char* lds, int lane, int wave) {
    LAS float* scr = (LAS float*)(lds + RING_OFF + wave * 16384);
    const int gw = blockIdx.x * NWAVES + wave, NGW = gridDim.x * NWAVES;
    constexpr int I_IN = 16 * 160, I_SQ = 16 * 32, I_CV = 16 * 64, I_E1 = 64 * 1024, I_E2 = 64 * 512;
    constexpr int NITEMS = I_IN + I_SQ + I_CV + I_SQ + I_E1 + I_E2;
    unsigned char* ws = a.ws;
    for (int it = (gridDim.x == 256 ? I_E1 + I_E2 : 0) + gw; it < NITEMS; it += NGW) {
        int r = it;
        if (r < I_E1) { const int mi = r >> 10; transpose_item<true>(a.in[I_WE1] + (size_t)mi * D * 2 * D, D, 2 * D, (bf16*)(ws + WS_W1 + (size_t)mi * 2 * D * D), true, scr, r & 1023, lane); continue; } r -= I_E1;
        if (r < I_E2) { const int mi = r >> 9; transpose_item<true>(a.in[I_WE2] + (size_t)mi * D * D, D, D, (bf16*)(ws + WS_W2 + (size_t)mi * D * D), false, scr, r & 511, lane); continue; } r -= I_E2;
        if (r < I_IN) {
            if (SPLIT_IN) { const int sgm = ((r % 160) * 32) >> 10;
                if (sgm == 2 || sgm == 3 || (G_F8 && sgm == 4)) transpose_item<true>(a.in[I_WHIN], D, 5 * D, (bf16*)(ws + WS_WIN8), false, scr, r, lane, -2 * D);
                else transpose_item<false>(a.in[I_WHIN], D, 5 * D, (bf16*)(ws + WS_WIN), false, scr, r, lane, sgm == 4 ? -2 * D : 0);
            } else transpose_item<F8_IN != 0>(a.in[I_WHIN], D, 5 * D, (bf16*)(ws + WS_WIN), false, scr, r, lane);
            continue; } r -= I_IN;
        if (r < I_SQ) { transpose_item<F8_MISC != 0>(a.in[I_WHOUT], D, D, (bf16*)(ws + WS_WOUT), false, scr, r, lane); continue; } r -= I_SQ;
        if (r < I_CV) { transpose_item<F8_MISC != 0>(a.in[I_WCVIN], D, 2 * D, (bf16*)(ws + WS_WCVIN), true, scr, r, lane); continue; } r -= I_CV;
        transpose_item<F8_MISC != 0>(a.in[I_WCVOUT], D, D, (bf16*)(ws + WS_WCVOUT), false, scr, r, lane);
    }
}
constexpr int CV_WAVES = 7, CV_L0 = 32 * 512 + 32 * 256, CV_ALL = 2 * CV_L0;
__device__ __forceinline__ void transpose_item64(const float* W, int K, int N, unsigned char* WT, bool paired, LAS float* scr, int item, int lane) {
    const int nblk = N / 64, kb = item / nblk, nb = item % nblk, k0 = 64 * kb, n0 = 64 * nb;
    int d0 = n0; if (paired) { const int half = n0 >> 10, c = n0 & 1023; d0 = (c >> 7) * 256 + half * 128 + (c & 127); }
    float t[64];
#pragma unroll
    for (int i = 0; i < 64; ++i) t[i] = __builtin_nontemporal_load(&W[(size_t)(k0 + i) * N + n0 + lane]);
#pragma unroll
    for (int i = 0; i < 64; ++i) scr[i * 65 + lane] = t[i];
    LDS_WAIT(); asm volatile("" ::: "memory");
    const int c = lane & 3;
#pragma unroll
    for (int j = 0; j < 4; ++j) { const int n = (lane >> 2) + 16 * j; const LAS float* s = scr + (16 * c) * 65 + n;
        v4u o;
        o.x = pk4_fp8(s[0 * 65] * W8SCALE, s[1 * 65] * W8SCALE, s[2 * 65] * W8SCALE, s[3 * 65] * W8SCALE); o.y = pk4_fp8(s[4 * 65] * W8SCALE, s[5 * 65] * W8SCALE, s[6 * 65] * W8SCALE, s[7 * 65] * W8SCALE);
        o.z = pk4_fp8(s[8 * 65] * W8SCALE, s[9 * 65] * W8SCALE, s[10 * 65] * W8SCALE, s[11 * 65] * W8SCALE); o.w = pk4_fp8(s[12 * 65] * W8SCALE, s[13 * 65] * W8SCALE, s[14 * 65] * W8SCALE, s[15 * 65] * W8SCALE);
        *(v4u*)(WT + (size_t)(d0 + n) * K + k0 + 16 * c) = o; }
    LDS_WAIT(); asm volatile("" ::: "memory");
}
__device__ __forceinline__ void cv_do_item(const Args& a, LAS float* scr, int g, int lane) {
    const int l = g >= CV_L0 ? 1 : 0; const int r = g - l * CV_L0;
    if (r < 32 * 512) { const int mi = l * 32 + (r >> 9); transpose_item64(a.in[I_WE1] + (size_t)mi * D * 2 * D, D, 2 * D, a.ws + WS_W1 + (size_t)mi * 2 * D * D, true, scr, r & 511, lane); }
    else { const int r2 = r - 32 * 512; const int mi = l * 32 + (r2 >> 8); transpose_item64(a.in[I_WE2] + (size_t)mi * D * D, D, D, a.ws + WS_W2 + (size_t)mi * D * D, false, scr, r2 & 255, lane); }
}
__device__ __forceinline__ void cv_finish(const Args& a, LAS unsigned char* lds, int wave, int lane, int& cv_n, int limit) {
    if (gridDim.x == 256 && wave >= 1 && wave <= CV_WAVES) {
        const int ww = blockIdx.x * CV_WAVES + (wave - 1), NW = 256 * CV_WAVES; LAS float* scr = (LAS float*)(lds + RING_OFF + wave * 16640);
#if CVF_PROBE
        const unsigned long long t0_ = __builtin_amdgcn_s_memrealtime();
#endif
        for (;;) { const int g = cv_n * NW + ww; if (g >= limit) break; cv_do_item(a, scr, g, lane); ++cv_n; }
#if CVF_PROBE
        if (blockIdx.x == 0 && wave == 1 && lane == 0) { asm volatile("s_waitcnt vmcnt(0)" ::: "memory"); ((volatile LAS unsigned*)(lds + MISC_OFF))[40] += (unsigned)(__builtin_amdgcn_s_memrealtime() - t0_); }
#endif
    }
}
__device__ __forceinline__ void xcd_barrier_work(const XcdBarrier& b, const Args& a, LAS unsigned char* lds, int wave, int lane, int& cv_n, volatile LAS unsigned* flag, unsigned seq) {
    asm volatile("s_waitcnt vmcnt(0)" ::: "memory");
    __syncthreads();
    if (wave == 0) {
        if (threadIdx.x == 0) {
            unsigned* bar = b.bar;
            __builtin_amdgcn_s_waitcnt(0);
            unsigned nloc = b.st[0], nx = b.st[1];
            if (nloc == 0u) { xcd_barrier_complete(bar, b.x, nloc, nx); b.st[0] = nloc; b.st[1] = nx; }
            const unsigned old = xb_add(&bar[XB_XSUB(b.x)], 1u);
            const unsigned gen = old / nloc;
            if (old + 1u == (gen + 1u) * nloc) {
                __builtin_amdgcn_fence(__ATOMIC_RELEASE, "agent");
                asm volatile("s_waitcnt vmcnt(0)" ::: "memory");
                const unsigned og = xb_add(&bar[XB_TOP], 1u);
                const unsigned tg = og / nx;
                if (og + 1u == (tg + 1u) * nx) xb_add(&bar[XB_TOPGEN], 1u);
                else XB_SPIN(xb_ld(&bar[XB_TOPGEN]) == tg, bar);
                __builtin_amdgcn_fence(__ATOMIC_ACQUIRE, "agent");
                xb_add(&bar[XB_XGEN(b.x)], 1u);
                asm volatile("s_waitcnt vmcnt(0)" ::: "memory");
            } else {
                XB_SPIN(xb_ld(&bar[XB_XGEN(b.x)]) == gen, bar);
                __builtin_amdgcn_fence(__ATOMIC_ACQUIRE, "agent");
                asm volatile("s_waitcnt vmcnt(0)" ::: "memory");
            }
            flag[0] = seq;
        }
    } else if (gridDim.x == 256 && wave <= CV_WAVES) {
        const int ww = blockIdx.x * CV_WAVES + (wave - 1), NW = 256 * CV_WAVES; LAS float* scr = (LAS float*)(lds + RING_OFF + wave * 16640);
        for (;;) { const int g = cv_n * NW + ww; if (g >= CV_ALL) break; if (flag[0] == seq) break; cv_do_item(a, scr, g, lane); ++cv_n; }
        asm volatile("s_waitcnt vmcnt(0)" ::: "memory");
    }
    __syncthreads();
}
__device__ __forceinline__ void flat_barrier_work(unsigned* cnt, const Args& a, LAS unsigned char* lds, int wave, int lane, int& cv_n, volatile LAS unsigned* flag, unsigned seq) {
    asm volatile("s_waitcnt vmcnt(0)" ::: "memory");
    __syncthreads();
    if (wave == 0) {
        if (threadIdx.x == 0) {
            __builtin_amdgcn_s_waitcnt(0);
            __builtin_amdgcn_fence(__ATOMIC_RELEASE, "agent");
            asm volatile("s_waitcnt vmcnt(0)" ::: "memory");
            (void)__hip_atomic_fetch_add(cnt, 1u, __ATOMIC_RELAXED, __HIP_MEMORY_SCOPE_AGENT);
            const unsigned target = gridDim.x * seq; unsigned sp = 0;
            while (__hip_atomic_load(cnt, __ATOMIC_RELAXED, __HIP_MEMORY_SCOPE_AGENT) < target) { __builtin_amdgcn_s_sleep(1); if (++sp > (1u << 22)) break; }
            __builtin_amdgcn_fence(__ATOMIC_ACQUIRE, "agent");
            asm volatile("s_waitcnt vmcnt(0)" ::: "memory");
            flag[0] = seq;
        }
    } else if (gridDim.x == 256 && wave <= CV_WAVES) {
        const int ww = blockIdx.x * CV_WAVES + (wave - 1), NW = 256 * CV_WAVES; LAS float* scr = (LAS float*)(lds + RING_OFF + wave * 16640);
        for (;;) { const int g = cv_n * NW + ww; if (g >= CV_ALL) break; if (flag[0] == seq) break; cv_do_item(a, scr, g, lane); ++cv_n; }
        asm volatile("s_waitcnt vmcnt(0)" ::: "memory");
    }
    __syncthreads();
}
template <bool OUT8> __device__ __forceinline__ void norm_mod_store(f32x4 (&v)[4], const float* g, const float* sc, const float* sh, void* orow, int lane) {
    float s = 0.f;
#pragma unroll
    for (int j = 0; j < 4; ++j) s += (v[j].x * v[j].x + v[j].y * v[j].y) + (v[j].z * v[j].z + v[j].w * v[j].w);
    const float r = 1.0f / sqrtf(wave_sum(s) * (1.0f / D) + EPS);
#pragma unroll
    for (int j = 0; j < 4; ++j) { const f32x4 gg = ((const f32x4*)g)[lane + 64 * j], ss = ((const f32x4*)sc)[lane + 64 * j], hh = ((const f32x4*)sh)[lane + 64 * j];
        const f32x4 y = (v[j] * r * gg) * (ss + 1.0f) + hh; v[j] = y;
        store_row4<OUT8>(orow, lane, j, y, 1.0f); }
}
__device__ __forceinline__ void p_norm0(const Args& a, int lane, int gw, int NGW, int m_begin, int m_end) {
    const float* MODS = (const float*)(a.ws + WS_MODS); bf16* H = (bf16*)(a.ws + WS_H);
    for (int m0 = m_begin + gw * 2; m0 < m_end; m0 += NGW * 2) {
        f32x4 v[2][4]; int rr[2];
#pragma unroll
        for (int r = 0; r < 2; ++r) { const int m = m0 + r; const float* xr;
            if (m < NTOK) { xr = a.in[I_X] + (size_t)m * D; rr[r] = m / SEQ; } else { xr = a.in[I_CTX] + (size_t)(m - NTOK) * D; rr[r] = 2; }
#pragma unroll
            for (int j = 0; j < 4; ++j) v[r][j] = __builtin_nontemporal_load(&((const f32x4*)xr)[lane + 64 * j]); }
#pragma unroll
        for (int r = 0; r < 2; ++r) { const float* md = MODS + (size_t)rr[r] * 6 * D;
            norm_mod_store<F8_IN != 0>(v[r], a.in[I_GMIX], md + 1 * D, md + 0 * D, (unsigned char*)H + (size_t)(m0 + r) * D * (F8_IN ? 1 : 2), lane);
            if (SPLIT_IN) {
#pragma unroll
                for (int j = 0; j < 4; ++j) store_row4<true>(a.ws + WS_H8 + (size_t)(m0 + r) * D, lane, j, v[r][j], 1.0f); } }
    }
}
__device__ __forceinline__ void p_scan_naive(const Args& a, LAS unsigned char* lds, int tid) {
    LAS float* sf = (LAS float*)lds;
    LAS float* sq = sf + 64 * 128;
    LAS float* sv = sq + 64 * 128;
    LAS float* so = sv + 64 * 16;
    const bf16* Q = (const bf16*)(a.ws + WS_Q); const bf16* V = (const bf16*)(a.ws + WS_V);
    const int vl = tid >> 5, kq = tid & 31;
    for (int unit = blockIdx.x; unit < 256; unit += gridDim.x) {
        const int chain = unit >> 3, vb = unit & 7, b = chain >> 4, h = (chain >> 1) & 7, dir = chain & 1;
        const float* LF = (const float*)(a.ws + (dir ? WS_LFB : WS_LFF)); float* O = (float*)(a.ws + (dir ? WS_OB : WS_OF));
        float S0 = 0.f, S1 = 0.f, S2 = 0.f, S3 = 0.f;
        for (int blk = 0; blk < 260; ++blk) {
            const bool isctx = blk < 4; int base, step;
            if (!dir) { base = isctx ? (NTOK + b * CTXL + blk * 64) : (b * SEQ + (blk - 4) * 64); step = 1; }
            else { base = isctx ? (NTOK + b * CTXL + CTXL - 1 - blk * 64) : (b * SEQ + SEQ - 1 - (blk - 4) * 64); step = -1; }
            for (int e = tid; e < 64 * 128; e += NTHR) { const int i = e >> 7, k = e & 127; const size_t off = (size_t)(base + step * i) * D + h * DK + k; sf[e] = __expf(LF[off]); sq[e] = bf2f(Q[off]); }
            for (int e = tid; e < 64 * 16; e += NTHR) { const int i = e >> 4, vv = e & 15; sv[e] = bf2f(V[(size_t)(base + step * i) * D + h * DK + vb * 16 + vv]); }
            __syncthreads();
            for (int i = 0; i < 64; ++i) {
                const f32x4 f = *(const LAS f32x4*)(sf + i * 128 + kq * 4), q = *(const LAS f32x4*)(sq + i * 128 + kq * 4); const float vv = sv[i * 16 + vl];
                S0 = f.x * S0 + (1.0f - f.x) * vv; S1 = f.y * S1 + (1.0f - f.y) * vv; S2 = f.z * S2 + (1.0f - f.z) * vv; S3 = f.w * S3 + (1.0f - f.w) * vv;
                float p = (S0 * q.x + S1 * q.y) + (S2 * q.z + S3 * q.w);
                p += __shfl_xor(p, 1); p += __shfl_xor(p, 2); p += __shfl_xor(p, 4); p += __shfl_xor(p, 8); p += __shfl_xor(p, 16);
                if (kq == 0) so[i * 16 + vl] = p;
            }
            __syncthreads();
            if (!isctx) for (int e = tid; e < 64 * 16; e += NTHR) { const int i = e >> 4, vv = e & 15; O[(size_t)(base + step * i) * D + h * DK + vb * 16 + vv] = so[e]; }
            __syncthreads();
        }
    }
}
constexpr int SC_QT = 0, SC_KU = 4352, SC_KB = 8704, SC_VT = 12800, SC_ET = 16896, SC_SUB = 17408, SC_BUF = 4 * SC_SUB;
constexpr int NSLOT = 17;
typedef short s16x4 __attribute__((ext_vector_type(4)));
typedef short s16x8 __attribute__((ext_vector_type(8)));
struct ScanUnit { int h, rowbase, sgn, nchunks, chain, slot; };
__device__ __forceinline__ ScanUnit scan_unit(int b, int h, int dir, int slot) {
    ScanUnit u; u.h = h; u.sgn = dir ? -1 : 1; u.chain = (b * NHEAD + h) * 2 + dir; u.slot = slot;
    if (slot == 0) { u.rowbase = NTOK + b * CTXL + (dir ? CTXL - 1 : 0); u.nchunks = CTXL / 64; }
    else { const int so = (slot - 1) * 1024; u.rowbase = b * SEQ + (dir ? SEQ - 1 - so : so); u.nchunks = 16; }
    return u;
}
typedef float f32x2_t __attribute__((ext_vector_type(2)));
typedef __bf16 bf16x2_t __attribute__((ext_vector_type(2)));
__device__ __forceinline__ unsigned cvtpk(float lo, float hi) { const f32x2_t f = {lo, hi}; return __builtin_bit_cast(unsigned, __builtin_convertvector(f, bf16x2_t)); }
template <bool FULL> __device__ __forceinline__ void scan_load(const ScanUnit& u, int pos0, const bf16* LF, const bf16* Q, const bf16* V, int k, int i, unsigned (&lf)[16], unsigned (&qr)[16], unsigned (&vr)[16]) {
#pragma unroll
    for (int t = 0; t < 16; ++t) {
        const unsigned o = (unsigned)(u.rowbase + u.sgn * (pos0 + 16 * i + t)) * D + u.h * DK + k;
        lf[t] = LF[o]; vr[t] = V[o]; if (FULL) qr[t] = Q[o];
    }
}
template <bool FULL> __device__ __forceinline__ float scan_prep(LAS unsigned char* buf, int k, int i, const unsigned (&lfr)[16], const unsigned (&qr)[16], const unsigned (&vr)[16]) {
    LAS unsigned char* sb = buf + i * SC_SUB;
    float f[16], pre[16], suf[16]; float T = 0.f;
#pragma unroll
    for (int t = 0; t < 16; ++t) { const float lf = (float)__builtin_bit_cast(_Float16, (unsigned short)lfr[t]); T += lf; f[t] = __builtin_amdgcn_exp2f(lf); }
    pre[0] = f[0];
#pragma unroll
    for (int t = 1; t < 16; ++t) pre[t] = pre[t - 1] * f[t];
    suf[15] = 1.0f;
#pragma unroll
    for (int t = 14; t >= 0; --t) suf[t] = suf[t + 1] * f[t + 1];
    unsigned kbw[8], vtw[8], qqw[8], kuw[8];
    const float invp = __builtin_amdgcn_rcpf(fmaxf(pre[15], 1e-30f));
#pragma unroll
    for (int t = 0; t < 16; t += 2) {
        const float kk0 = 1.0f - f[t], kk1 = 1.0f - f[t + 1];
        kbw[t >> 1] = cvtpk(kk0 * suf[t], kk1 * suf[t + 1]);
        vtw[t >> 1] = vr[t] | (vr[t + 1] << 16);
        if (FULL) {
            qqw[t >> 1] = cvtpk(__builtin_bit_cast(float, qr[t] << 16) * pre[t], __builtin_bit_cast(float, qr[t + 1] << 16) * pre[t + 1]);
            kuw[t >> 1] = cvtpk(kk0 * suf[t] * invp, kk1 * suf[t + 1] * invp);
        }
    }
    if (FULL) {
        const int rho = k ^ (((k >> 3) & 1) << 2);
        *(LAS v4u*)(sb + SC_QT + rho * 32) = (v4u){qqw[0], qqw[1], qqw[2], qqw[3]}; *(LAS v4u*)(sb + SC_QT + rho * 32 + 16) = (v4u){qqw[4], qqw[5], qqw[6], qqw[7]};
        *(LAS v4u*)(sb + SC_KU + rho * 32) = (v4u){kuw[0], kuw[1], kuw[2], kuw[3]}; *(LAS v4u*)(sb + SC_KU + rho * 32 + 16) = (v4u){kuw[4], kuw[5], kuw[6], kuw[7]};
    }
    *(LAS v4u*)(sb + SC_KB + k * 32) = (v4u){kbw[0], kbw[1], kbw[2], kbw[3]}; *(LAS v4u*)(sb + SC_KB + k * 32 + 16) = (v4u){kbw[4], kbw[5], kbw[6], kbw[7]};
    *(LAS v4u*)(sb + SC_VT + k * 32) = (v4u){vtw[0], vtw[1], vtw[2], vtw[3]}; *(LAS v4u*)(sb + SC_VT + k * 32 + 16) = (v4u){vtw[4], vtw[5], vtw[6], vtw[7]};
    *(LAS float*)(sb + SC_ET + 4 * k) = pre[15];
    return T;
}
__device__ __forceinline__ f32x4 mfma_k16(s16x4 a, s16x4 b, f32x4 c) {
    const v2u av = __builtin_bit_cast(v2u, a), bv = __builtin_bit_cast(v2u, b);
    return __builtin_amdgcn_mfma_f32_16x16x32_bf16(__builtin_bit_cast(s16x8, (v4u){av.x, av.y, 0u, 0u}), __builtin_bit_cast(s16x8, (v4u){bv.x, bv.y, 0u, 0u}), c, 0, 0, 0);
}
template <bool FULL> __device__ __forceinline__ void scan_compute2(const LAS unsigned char* buf, int wq, int lane, f32x4 (&S)[2][8], bf16* Ocol, const ScanUnit& u, int pos0) {
    const int fr = lane & 15, g = lane >> 4;
#pragma unroll 1
    for (int i = 0; i < 2; ++i) {
        const LAS unsigned char* sb = buf + i * SC_SUB;
        const s16x4 vt0 = *(const LAS s16x4*)(sb + SC_VT + (32 * wq + fr) * 32 + 8 * g), vt1 = *(const LAS s16x4*)(sb + SC_VT + (32 * wq + 16 + fr) * 32 + 8 * g);
        s16x8 ka[4], qa[4]; f32x4 et[8]; s16x4 kb[8];
        if (FULL) {
            const int q_ = (lane & 15) >> 2, p_ = lane & 3;
            const LAS unsigned char* b0_ = sb + (8 * g + q_) * 32 + p_ * 8 + 128 * (g & 1);
            const LAS unsigned char* b1_ = sb + (8 * g + q_) * 32 + p_ * 8 + 128 * (1 - (g & 1));
#pragma unroll
            for (int c = 0; c < 4; ++c) {
                const s16x4 k0_ = __builtin_amdgcn_ds_read_tr16_b64_v4i16((LAS s16x4*)(b0_ + SC_KU + 1024 * c)), k1_ = __builtin_amdgcn_ds_read_tr16_b64_v4i16((LAS s16x4*)(b1_ + SC_KU + 1024 * c));
                const s16x4 q0_ = __builtin_amdgcn_ds_read_tr16_b64_v4i16((LAS s16x4*)(b0_ + SC_QT + 1024 * c)), q1_ = __builtin_amdgcn_ds_read_tr16_b64_v4i16((LAS s16x4*)(b1_ + SC_QT + 1024 * c));
                ka[c] = __builtin_shufflevector(k0_, k1_, 0, 1, 2, 3, 4, 5, 6, 7); qa[c] = __builtin_shufflevector(q0_, q1_, 0, 1, 2, 3, 4, 5, 6, 7); }
        }
#pragma unroll
        for (int j = 0; j < 8; ++j) { et[j] = *(const LAS f32x4*)(sb + SC_ET + (32 * (j >> 1) + 8 * g + 4 * (j & 1)) * 4); kb[j] = *(const LAS s16x4*)(sb + SC_KB + (32 * (j >> 1) + 8 * (fr >> 2) + 4 * (j & 1) + (fr & 3)) * 32 + 8 * g); }
        __builtin_amdgcn_sched_barrier(0);
        if (FULL) {
            f32x4 aT = (f32x4){0.f, 0.f, 0.f, 0.f};
#pragma unroll
            for (int c = 0; c < 4; ++c) aT = __builtin_amdgcn_mfma_f32_16x16x32_bf16(ka[c], qa[c], aT, 0, 0, 0);
#pragma unroll
            for (int r = 0; r < 4; ++r) if (4 * g + r > fr) aT[r] = 0.f;
            const s16x4 ab = __builtin_bit_cast(s16x4, (v2u){cvtpk(aT[0], aT[1]), cvtpk(aT[2], aT[3])});
            f32x4 o0 = mfma_k16(vt0, ab, (f32x4){0.f, 0.f, 0.f, 0.f}), o1 = mfma_k16(vt1, ab, (f32x4){0.f, 0.f, 0.f, 0.f});
#pragma unroll
            for (int c = 0; c < 4; ++c) {
                const v4u s0 = (v4u){cvtpk(S[0][2 * c][0], S[0][2 * c][1]), cvtpk(S[0][2 * c][2], S[0][2 * c][3]), cvtpk(S[0][2 * c + 1][0], S[0][2 * c + 1][1]), cvtpk(S[0][2 * c + 1][2], S[0][2 * c + 1][3])};
                const v4u s1 = (v4u){cvtpk(S[1][2 * c][0], S[1][2 * c][1]), cvtpk(S[1][2 * c][2], S[1][2 * c][3]), cvtpk(S[1][2 * c + 1][0], S[1][2 * c + 1][1]), cvtpk(S[1][2 * c + 1][2], S[1][2 * c + 1][3])};
                o0 = __builtin_amdgcn_mfma_f32_16x16x32_bf16(__builtin_bit_cast(s16x8, s0), qa[c], o0, 0, 0, 0);
                o1 = __builtin_amdgcn_mfma_f32_16x16x32_bf16(__builtin_bit_cast(s16x8, s1), qa[c], o1, 0, 0, 0);
            }
            bf16* orow = Ocol + (size_t)(u.rowbase + u.sgn * (pos0 + 16 * i + fr)) * D;
            *(v2u*)orow = (v2u){cvtpk(o0[0], o0[1]), cvtpk(o0[2], o0[3])}; *(v2u*)(orow + 16) = (v2u){cvtpk(o1[0], o1[1]), cvtpk(o1[2], o1[3])};
        }
#pragma unroll
        for (int j = 0; j < 8; ++j) { S[0][j] = mfma_k16(kb[j], vt0, S[0][j] * et[j]); S[1][j] = mfma_k16(kb[j], vt1, S[1][j] * et[j]); }
    }
}
template <bool FULL> __device__ __forceinline__ void scan_pair(const Args& a, LAS unsigned char* lds, const ScanUnit& uA, const ScanUnit& uB, int tid, int lane, int wave) {
    const int grp = wave >> 2, wq = wave & 3, t = tid & 255, k = t & 127, i0 = t >> 7;
    ScanUnit u; u.h = grp ? uB.h : uA.h; u.rowbase = grp ? uB.rowbase : uA.rowbase; u.sgn = grp ? uB.sgn : uA.sgn; u.nchunks = grp ? uB.nchunks : uA.nchunks; u.chain = grp ? uB.chain : uA.chain; u.slot = grp ? uB.slot : uA.slot;
    LAS unsigned char* buf = lds + grp * SC_BUF;
    const int dir = u.sgn < 0;
    const bf16* LF = (const bf16*)(a.ws + (dir ? WS_LFB : WS_LFF)); const bf16* Q = (const bf16*)(a.ws + WS_Q); const bf16* V = (const bf16*)(a.ws + WS_V);
    f32x4* SD = (f32x4*)(a.ws + WS_SD) + (size_t)u.chain * NSLOT * 4096; float* SP = (float*)(a.ws + WS_SP) + (size_t)u.chain * NSLOT * DK;
    const int g = lane >> 4;
    bf16* Ocol = (bf16*)(a.ws + (dir ? WS_OB : WS_OF)) + u.h * DK + 32 * wq + 4 * g;
    f32x4 S[2][8];
#pragma unroll
    for (int vb = 0; vb < 2; ++vb)
#pragma unroll
        for (int j = 0; j < 8; ++j) S[vb][j] = (f32x4){0.f, 0.f, 0.f, 0.f};
    if (FULL) {
        for (int s = 0; s < u.slot; ++s) {
            const f32x4* d = SD + (size_t)s * 4096 + (wq * 16) * 64 + lane; const float* pp = SP + s * DK + 8 * g;
#pragma unroll
            for (int j = 0; j < 8; ++j) { const f32x4 pv = *(const f32x4*)(pp + 32 * (j >> 1) + 4 * (j & 1)); const f32x4 ev = (f32x4){__builtin_amdgcn_exp2f(pv.x), __builtin_amdgcn_exp2f(pv.y), __builtin_amdgcn_exp2f(pv.z), __builtin_amdgcn_exp2f(pv.w)};
                S[0][j] = S[0][j] * ev + d[j * 64]; S[1][j] = S[1][j] * ev + d[(8 + j) * 64]; }
        }
    }
    unsigned lf[16], q[16], v[16]; float psum = 0.f;
    const int nsteps = u.nchunks * 2;
    scan_load<FULL>(u, 0, LF, Q, V, k, i0, lf, q, v);
    constexpr int NST = 32, PB = 2 * SC_SUB;
    if (nsteps > 0) psum += scan_prep<FULL>(buf, k, i0, lf, q, v);
    if (grp == 1) scan_load<FULL>(u, (nsteps > 1 ? 1 : 0) * 32, LF, Q, V, k, i0, lf, q, v);
    for (int c = 0; c < NST; ++c) {
        __syncthreads();
        if (c < nsteps) {
            if (grp == 1 && c + 1 < nsteps) psum += scan_prep<FULL>(buf + ((c + 1) & 1) * PB, k, i0, lf, q, v);
            const int cw = c + 1 + grp, cn = cw < nsteps ? cw : nsteps - 1;
            scan_load<FULL>(u, cn * 32, LF, Q, V, k, i0, lf, q, v);
            scan_compute2<FULL>(buf + (c & 1) * PB, wq, lane, S, Ocol, u, c * 32);
            if (grp == 0 && c + 1 < nsteps) psum += scan_prep<FULL>(buf + ((c + 1) & 1) * PB, k, i0, lf, q, v);
        }
    }
    __syncthreads();
    if (!FULL) {
        f32x4* d = SD + (size_t)u.slot * 4096 + (wq * 16) * 64 + lane;
#pragma unroll
        for (int j = 0; j < 8; ++j) { d[j * 64] = S[0][j]; d[(8 + j) * 64] = S[1][j]; }
        LAS float* ps = (LAS float*)(lds + EXTRA_OFF + 2560);
        ps[(grp * 2 + i0) * 128 + k] = psum;
        __syncthreads();
        if (t < 128) SP[u.slot * DK + t] = ps[(grp * 2) * 128 + t] + ps[(grp * 2 + 1) * 128 + t];
        __syncthreads();
    }
}
__device__ __forceinline__ void p_scan_a(const Args& a, LAS unsigned char* lds, int tid, int lane, int wave) {
    for (int it = blockIdx.x; it < 256; it += gridDim.x) {
        const int b = it >> 7, h = (it >> 4) & 7, seg = it & 15;
        const ScanUnit uA = scan_unit(b, h, 0, seg == 15 ? 0 : 1 + seg);
        const ScanUnit uB = scan_unit(b, h, 1, seg == 0 ? 0 : 16 - seg);
        scan_pair<false>(a, lds, uA, uB, tid, lane, wave);
    }
}
__device__ __forceinline__ void p_scan_c(const Args& a, LAS unsigned char* lds, int tid, int lane, int wave) {
    for (int it = blockIdx.x; it < 256; it += gridDim.x) {
        const int b = it >> 7, h = (it >> 4) & 7, seg = it & 15;
        const ScanUnit uA = scan_unit(b, h, 0, 1 + seg), uB = scan_unit(b, h, 1, 16 - seg);
        scan_pair<true>(a, lds, uA, uB, tid, lane, wave);
    }
}
__device__ __forceinline__ void p_readout(const Args& a, int lane, int wave) {
    const int gw = blockIdx.x * NWAVES + wave, NGW = gridDim.x * NWAVES;
    const bf16* OF = (const bf16*)(a.ws + WS_OF); const bf16* OB = (const bf16*)(a.ws + WS_OB); const bf16* SG = (const bf16*)(a.ws + WS_SG); bf16* Y = (bf16*)(a.ws + WS_YIN);
    f32x4 gh[4];
#pragma unroll
    for (int j = 0; j < 4; ++j) gh[j] = ((const f32x4*)a.in[I_GHOUT])[lane + 64 * j];
    v2u ra[2][4], rb[2][4], sg[2][4];
    if (gw * 2 < NTOK) {
#pragma unroll
        for (int r = 0; r < 2; ++r)
#pragma unroll
            for (int j = 0; j < 4; ++j) { const size_t m = gw * 2 + r; ra[r][j] = ((const v2u*)(OF + m * D))[lane + 64 * j]; rb[r][j] = ((const v2u*)(OB + m * D))[lane + 64 * j]; sg[r][j] = ((const v2u*)(SG + m * D))[lane + 64 * j]; }
    }
    for (int m0 = gw * 2; m0 < NTOK; m0 += NGW * 2) {
        v2u na[2][4], nb[2][4], ns[2][4]; const int mn = m0 + NGW * 2;
#pragma unroll
        for (int r = 0; r < 2; ++r)
#pragma unroll
            for (int j = 0; j < 4; ++j) { const size_t m = (size_t)mn + r; const v2u z2 = (v2u){0u, 0u};
                na[r][j] = mn < NTOK ? ((const v2u*)(OF + m * D))[lane + 64 * j] : z2; nb[r][j] = mn < NTOK ? ((const v2u*)(OB + m * D))[lane + 64 * j] : z2; ns[r][j] = mn < NTOK ? ((const v2u*)(SG + m * D))[lane + 64 * j] : z2; }
#pragma unroll
        for (int r = 0; r < 2; ++r)
#pragma unroll
            for (int j = 0; j < 4; ++j) { const v2u a_ = ra[r][j], b_ = rb[r][j];
                const f32x4 oo = (f32x4){bf_lo(a_.x) + bf_lo(b_.x), bf_hi(a_.x) + bf_hi(b_.x), bf_lo(a_.y) + bf_lo(b_.y), bf_hi(a_.y) + bf_hi(b_.y)};
                float s = (oo.x * oo.x + oo.y * oo.y) + (oo.z * oo.z + oo.w * oo.w);
                s = half_sum(s);
                const float rs = 1.0f / sqrtf(s * (1.0f / DK) + EPS);
                store_row4<F8_MISC != 0>((unsigned char*)Y + (size_t)(m0 + r) * D * (F8_MISC ? 1 : 2), lane, j,
                    (f32x4){oo.x * rs * gh[j].x * bf_lo(sg[r][j].x), oo.y * rs * gh[j].y * bf_hi(sg[r][j].x), oo.z * rs * gh[j].z * bf_lo(sg[r][j].y), oo.w * rs * gh[j].w * bf_hi(sg[r][j].y)}, 4.0f); }
#pragma unroll
        for (int r = 0; r < 2; ++r)
#pragma unroll
            for (int j = 0; j < 4; ++j) { ra[r][j] = na[r][j]; rb[r][j] = nb[r][j]; sg[r][j] = ns[r][j]; }
    }
}
__device__ __forceinline__ void p_router(const Args& a, LAS unsigned char* lds, int l, int tid, int lane, int wave) {
    typedef _Float16 h16x8 __attribute__((ext_vector_type(8))); typedef _Float16 h16x4 __attribute__((ext_vector_type(4)));
    constexpr int PITCH = 2064, TILE_BYTES = 16 * PITCH, P_OFF = 2 * TILE_BYTES, P_BYTES = 8 * 16 * 32 * 4;
    LAS int* s_cnt = (LAS int*)(lds + EXTRA_OFF);
    LAS int* s_gb = s_cnt + 32;
    LAS int* s_sel = (LAS int*)(lds + EXTRA_OFF + 2560);
    unsigned* GCNT = (unsigned*)(a.ws + WS_CTL) + CW_GCNT + l * 32;
    const float* WR = a.in[I_WR] + (size_t)l * D * NE; const float* BR = a.in[I_BR] + l * NE;
    const bf16* X = (const bf16*)(a.ws + WS_X); unsigned char* H = a.ws + WS_H;
    const int fr = lane & 15, g = lane >> 4;
    v2u nx[2][4];
    if (blockIdx.x < NTOK / 128) {
#pragma unroll
        for (int t = 0; t < 2; ++t)
#pragma unroll
            for (int j = 0; j < 4; ++j) nx[t][j] = ((const v2u*)(X + (size_t)(blockIdx.x * 128 + 2 * wave + t) * D))[lane + 64 * j];
    }
    h16x8 wb0[4], wb1[4];
#pragma unroll
    for (int c = 0; c < 4; ++c)
#pragma unroll
        for (int i = 0; i < 8; ++i) { const float* wp = WR + (size_t)(128 * wave + 32 * c + 8 * g + i) * NE + fr; wb0[c][i] = (_Float16)wp[0]; wb1[c][i] = (_Float16)wp[16]; }
    const float* MODS = (const float*)(a.ws + WS_MODS);
    int* TOPS = (int*)(a.ws + WS_TOPE); float* TOPW = (float*)(a.ws + WS_TOPW); int* STOK = (int*)(a.ws + WS_STOK);
    for (int ch = blockIdx.x; ch < NTOK / 128; ch += gridDim.x) {
        if (tid < 32) s_cnt[tid] = 0;
        const int b = (ch * 128) / SEQ; const float* md = MODS + (size_t)(l * 3 + b) * 6 * D;
        if (ch != (int)blockIdx.x) {
#pragma unroll
        for (int t = 0; t < 2; ++t)
#pragma unroll
            for (int j = 0; j < 4; ++j) nx[t][j] = ((const v2u*)(X + (size_t)(ch * 128 + 2 * wave + t) * D))[lane + 64 * j];
        }
#define ROUTER_A(it_) do { const int tokA = ch * 128 + (it_) * 16 + 2 * wave; f32x4 hf[2][4]; \
            _Pragma("unroll") for (int t = 0; t < 2; ++t) _Pragma("unroll") for (int j = 0; j < 4; ++j) hf[t][j] = (f32x4){bf_lo(nx[t][j].x), bf_hi(nx[t][j].x), bf_lo(nx[t][j].y), bf_hi(nx[t][j].y)}; \
            if ((it_) + 1 < 8) { _Pragma("unroll") for (int t = 0; t < 2; ++t) _Pragma("unroll") for (int j = 0; j < 4; ++j) nx[t][j] = ((const v2u*)(X + (size_t)(tokA + 16 + t) * D))[lane + 64 * j]; } \
            _Pragma("unroll") for (int t = 0; t < 2; ++t) { \
                norm_mod_store<true>(hf[t], a.in[I_GFFN] + l * D, md + 4 * D, md + 3 * D, H + (size_t)(tokA + t) * D, lane); \
                _Pragma("unroll") for (int j = 0; j < 4; ++j) { const h16x4 hv = {(_Float16)hf[t][j].x, (_Float16)hf[t][j].y, (_Float16)hf[t][j].z, (_Float16)hf[t][j].w}; \
                    *(LAS h16x4*)(lds + ((it_) & 1) * TILE_BYTES + (2 * wave + t) * PITCH + (4 * lane + 256 * j) * 2) = hv; } } } while (0)
#define ROUTER_B(it_) do { f32x4 acc0 = (f32x4){0.f, 0.f, 0.f, 0.f}, acc1 = acc0; \
            _Pragma("unroll") for (int c = 0; c < 4; ++c) { const h16x8 av = *(const LAS h16x8*)(lds + ((it_) & 1) * TILE_BYTES + fr * PITCH + (128 * wave + 32 * c + 8 * g) * 2); \
                acc0 = __builtin_amdgcn_mfma_f32_16x16x32_f16(av, wb0[c], acc0, 0, 0, 0); acc1 = __builtin_amdgcn_mfma_f32_16x16x32_f16(av, wb1[c], acc1, 0, 0, 0); } \
            LAS float* Pw = (LAS float*)(lds + P_OFF + ((it_) & 1) * P_BYTES); \
            _Pragma("unroll") for (int r = 0; r < 4; ++r) { Pw[(wave * 16 + 4 * g + r) * 32 + fr] = acc0[r]; Pw[(wave * 16 + 4 * g + r) * 32 + 16 + fr] = acc1[r]; } } while (0)
#define ROUTER_C(it_) do { const int t = lane >> 5, e0 = lane & 31; const LAS float* Pr = (const LAS float*)(lds + P_OFF + ((it_) & 1) * P_BYTES); \
            float v0 = BR[e0]; \
            _Pragma("unroll") for (int w = 0; w < 8; ++w) v0 += Pr[(w * 16 + 2 * wave + t) * 32 + e0]; \
            float selv[4]; int seli[4]; \
            { const unsigned ub = __builtin_bit_cast(unsigned, v0); unsigned key = (ub & 0x80000000u) ? ~ub : (ub | 0x80000000u); key = (key & ~31u) | (unsigned)(31 - e0); \
              _Pragma("unroll") for (int r = 0; r < 4; ++r) { unsigned m = key, o; \
                  o = (unsigned)__builtin_amdgcn_update_dpp(0, (int)m, 0xB1, 0xF, 0xF, true); m = o > m ? o : m; \
                  o = (unsigned)__builtin_amdgcn_update_dpp(0, (int)m, 0x4E, 0xF, 0xF, true); m = o > m ? o : m; \
                  o = (unsigned)__builtin_amdgcn_update_dpp(0, (int)m, 0x141, 0xF, 0xF, true); m = o > m ? o : m; \
                  o = (unsigned)__builtin_amdgcn_update_dpp(0, (int)m, 0x140, 0xF, 0xF, true); m = o > m ? o : m; \
                  o = (unsigned)__shfl_xor((int)m, 16); m = o > m ? o : m; \
                  const int bi = 31 - (int)(m & 31u); seli[r] = bi; \
                  if (bi == e0) key = 0u; } \
              _Pragma("unroll") for (int r = 0; r < 4; ++r) selv[r] = __builtin_bit_cast(float, __builtin_amdgcn_ds_bpermute(((lane & 32) + seli[r]) << 2, __builtin_bit_cast(int, v0))); } \
            if ((lane & 31) == 0) { \
                const float e1 = __expf(selv[1] - selv[0]), e2 = __expf(selv[2] - selv[0]), e3 = __expf(selv[3] - selv[0]); const float inv = 1.0f / (1.0f + e1 + e2 + e3); \
                *(f32x4*)(TOPW + (size_t)(ch * 128 + (it_) * 16 + 2 * wave + t) * 4) = (f32x4){inv, e1 * inv, e2 * inv, e3 * inv}; \
                _Pragma("unroll") for (int r = 0; r < 4; ++r) s_sel[((it_) * 16 + 2 * wave + t) * 4 + r] = (seli[r] << 16) | __hip_atomic_fetch_add(&s_cnt[seli[r]], 1, __ATOMIC_RELAXED, __HIP_MEMORY_SCOPE_WORKGROUP); \
            } } while (0)
        ROUTER_A(0);
        for (int k = 0; k < 8; ++k) {
            __syncthreads();
            ROUTER_B(k);
            if (k > 0) ROUTER_C(k - 1);
            if (k < 7) ROUTER_A(k + 1);
        }
        __syncthreads();
        ROUTER_C(7);
#undef ROUTER_A
#undef ROUTER_B
#undef ROUTER_C
        __syncthreads();
        if (tid < 32) s_gb[tid] = (int)__hip_atomic_fetch_add(GCNT + tid, (unsigned)s_cnt[tid], __ATOMIC_RELAXED, __HIP_MEMORY_SCOPE_AGENT);
        __syncthreads();
        { const int sv = s_sel[tid], e = sv >> 16, vi = s_gb[e] + (sv & 0xffff); TOPS[(size_t)ch * 512 + tid] = e * NTOK + vi; STOK[(size_t)e * NTOK + vi] = ch * 128 + (tid >> 2); }
        __syncthreads();
    }
}
__device__ __forceinline__ void moe_tables(const Args& a, LAS unsigned char* lds, int l, int tid) {
    LAS int* s_tb = (LAS int*)(lds + EXTRA_OFF + 256); LAS int* s_ce = s_tb + 40; LAS int* tab = (LAS int*)(lds + EXTRA_OFF + 640);
    const unsigned* GCNT = (const unsigned*)(a.ws + WS_CTL) + CW_GCNT + l * 32;
    if (tid < 32) s_ce[tid] = (int)__hip_atomic_load(GCNT + tid, __ATOMIC_RELAXED, __HIP_MEMORY_SCOPE_AGENT);
    __syncthreads();
    if (tid == 0) { int run = 0; for (int e = 0; e < 32; ++e) { s_tb[e] = run; run += (s_ce[e] + 255) >> 8; } s_tb[32] = run; }
    __syncthreads();
    if (tid < 32) { const int t0 = s_tb[tid], t1 = s_tb[tid + 1]; for (int t = t0; t < t1; ++t) tab[t] = tid; }
    __syncthreads();
}
template <bool FINAL> __device__ __forceinline__ void p_combine(const Args& a, LAS unsigned char* lds, int l, int lane, int wave) {
    const int gw = blockIdx.x * NWAVES + wave, NGW = gridDim.x * NWAVES;
    bf16* X = (bf16*)(a.ws + WS_X); const bf16* YS = (const bf16*)(a.ws + WS_YS); const int* TOPS = (const int*)(a.ws + WS_TOPE); const float* TOPW = (const float*)(a.ws + WS_TOPW);
    const LAS int* s_tb = (const LAS int*)(lds + EXTRA_OFF + 256);
    const float* MODS = (const float*)(a.ws + WS_MODS); bf16* H = (bf16*)(a.ws + WS_H);
    const int S2 = NGW * 2;
    auto load_idx = [&](int m, v4i (&ps)[2], f32x4 (&tws)[2]) {
#pragma unroll
        for (int r = 0; r < 2; ++r) { ps[r] = *(const v4i*)(TOPS + (size_t)(m + r) * 4); tws[r] = *(const f32x4*)(TOPW + (size_t)(m + r) * 4); } };
    auto load_rows = [&](int m, v4i (&ps)[2], v2u (&xr_)[2][4], v2u (&y_)[2][4][4]) {
#pragma unroll
        for (int r = 0; r < 2; ++r) {
#pragma unroll
            for (int k = 0; k < 4; ++k) { const int e = ps[r][k] >> 15; ps[r][k] = s_tb[e] * 256 + (ps[r][k] & (NTOK - 1)); }
#pragma unroll
            for (int j = 0; j < 4; ++j) { xr_[r][j] = ((const v2u*)(X + (size_t)(m + r) * D))[lane + 64 * j];
#pragma unroll
                for (int k = 0; k < 4; ++k) {
                    if (F8_Y) { y_[r][j][k].x = ((const unsigned*)((const unsigned char*)YS + (size_t)ps[r][k] * D))[lane + 64 * j]; y_[r][j][k].y = 0u; }
                    else y_[r][j][k] = ((const v2u*)(YS + (size_t)ps[r][k] * D))[lane + 64 * j]; } } } };
    v2u xr[2][4]; v2u y[2][4][4]; f32x4 tw[2]; v4i nps[2]; f32x4 ntw[2];
    if (gw * 2 < NTOK) { v4i cps[2]; load_idx(gw * 2, cps, tw); load_rows(gw * 2, cps, xr, y); if (gw * 2 + S2 < NTOK) load_idx(gw * 2 + S2, nps, ntw); }
    for (int m0 = gw * 2; m0 < NTOK; m0 += S2) {
        const int b = m0 / SEQ; const float* gt = MODS + (size_t)(l * 3 + b) * 6 * D + 5 * D;
        const int mn = m0 + S2, mnn = m0 + 2 * S2;
        v2u xn[2][4]; v2u yn[2][4][4]; v4i pps[2]; f32x4 ptw[2];
        if (mn < NTOK) load_rows(mn, nps, xn, yn);
        if (mnn < NTOK) load_idx(mnn, pps, ptw);
        f32x4 v[2][4];
#pragma unroll
        for (int r = 0; r < 2; ++r)
#pragma unroll
            for (int j = 0; j < 4; ++j) v[r][j] = (f32x4){bf_lo(xr[r][j].x), bf_hi(xr[r][j].x), bf_lo(xr[r][j].y), bf_hi(xr[r][j].y)};
#pragma unroll
        for (int r = 0; r < 2; ++r) { const int m = m0 + r;
#pragma unroll
            for (int j = 0; j < 4; ++j) { f32x4 s = (f32x4){0.f, 0.f, 0.f, 0.f};
#pragma unroll
                for (int k = 0; k < 4; ++k) {
                    if (F8_Y) { const int w = (int)y[r][j][k].x; const f32x2_t lo = __builtin_amdgcn_cvt_pk_f32_fp8(w, false), hi = __builtin_amdgcn_cvt_pk_f32_fp8(w, true);
                        s += (f32x4){lo.x, lo.y, hi.x, hi.y} * (tw[r][k] * (1.0f / YSCALE)); }
                    else s += (f32x4){bf_lo(y[r][j][k].x), bf_hi(y[r][j][k].x), bf_lo(y[r][j][k].y), bf_hi(y[r][j][k].y)} * tw[r][k]; }
                v[r][j] = v[r][j] + ((const f32x4*)gt)[lane + 64 * j] * s; }
            if (!FINAL) {
#pragma unroll
                for (int j = 0; j < 4; ++j) ((v2u*)(X + (size_t)m * D))[lane + 64 * j] = (v2u){pk2(v[r][j].x, v[r][j].y), pk2(v[r][j].z, v[r][j].w)};
                const float* md = MODS + (size_t)((l + 1) * 3 + b) * 6 * D;
                norm_mod_store<F8_MISC != 0>(v[r], a.in[I_GMIX] + (l + 1) * D, md + 1 * D, md + 0 * D, (unsigned char*)H + (size_t)m * D * (F8_MISC ? 1 : 2), lane);
            } else {
                float s = 0.f;
#pragma unroll
                for (int j = 0; j < 4; ++j) s += (v[r][j].x * v[r][j].x + v[r][j].y * v[r][j].y) + (v[r][j].z * v[r][j].z + v[r][j].w * v[r][j].w);
                const float rs = 1.0f / sqrtf(wave_sum(s) * (1.0f / D) + EPS);
#pragma unroll
                for (int j = 0; j < 4; ++j) __builtin_nontemporal_store(v[r][j] * rs * ((const f32x4*)a.in[I_GFINAL])[lane + 64 * j], &((f32x4*)(a.out + (size_t)m * D))[lane + 64 * j]);
            }
        }
#pragma unroll
        for (int r = 0; r < 2; ++r) { tw[r] = ntw[r]; nps[r] = pps[r]; ntw[r] = ptw[r];
#pragma unroll
            for (int j = 0; j < 4; ++j) { xr[r][j] = xn[r][j];
#pragma unroll
                for (int k = 0; k < 4; ++k) y[r][j][k] = yn[r][j][k]; } }
    }
}
__device__ __forceinline__ void p_dwconv(const Args& a, int tid) {
    const bf16* U = (const bf16*)(a.ws + WS_U); bf16* ZP = (bf16*)(a.ws + WS_ZP);
    const float* WDW = a.in[I_WCVDW]; const float* BDW = a.in[I_BCVDW];
    const int half = tid >> 8, cp = tid & 255;
    typedef float f32x2v __attribute__((ext_vector_type(2)));
    auto line_of = [&](int unit, int& c, int& len, int& p0, size_t& base, size_t& stride) {
        const int hu = unit * 2 + half;
        if (hu < 2048) { c = 2 * cp; len = GRIDW; p0 = (hu & 3) * 16; base = (size_t)(hu >> 2) * GRIDW * D; stride = D; }
        else { const int v = hu - 2048; const int b = v >> 10, w = (v >> 4) & 63; c = 512 + 2 * cp; len = GRIDR; p0 = (v & 15) * 16; base = ((size_t)b * SEQ + w) * D; stride = (size_t)GRIDW * D; } };
    auto load_in = [&](int c, int len, int p0, size_t base, size_t stride, unsigned (&u)[46]) {
#pragma unroll
        for (int i = 0; i < 46; ++i) { const int pp = p0 - 15 + i; u[i] = (pp >= 0 && pp < len) ? *(const unsigned*)(U + base + (size_t)pp * stride + c) : 0u; } };
    int c, len, p0; size_t base, stride; unsigned u[46];
    f32x2v w2[CONVW]; f32x2v bb = (f32x2v){0.f, 0.f}; int wc = -1;
    if ((int)blockIdx.x < 2048) { line_of(blockIdx.x, c, len, p0, base, stride); load_in(c, len, p0, base, stride, u); }
    for (int unit = blockIdx.x; unit < 2048; unit += gridDim.x) {
        int cn = 0, lenn = 0, p0n = 0; size_t basen = 0, striden = 0; unsigned un[46]; const int nu = unit + gridDim.x;
        if (nu < 2048) { line_of(nu, cn, lenn, p0n, basen, striden); load_in(cn, lenn, p0n, basen, striden, un); }
        if (wc != c) { wc = c;
#pragma unroll
            for (int j = 0; j < CONVW; ++j) w2[j] = *(const f32x2v*)(WDW + j * D + c);
            bb = *(const f32x2v*)(BDW + c); }
        f32x2v in2[46];
#pragma unroll
        for (int i = 0; i < 46; ++i) in2[i] = (f32x2v){bf_lo(u[i]), bf_hi(u[i])};
#pragma unroll
        for (int i = 0; i < 16; ++i) { f32x2v acc2 = bb;
#pragma unroll
            for (int j = 0; j < CONVW; ++j) acc2 = __builtin_elementwise_fma(in2[i + j], w2[j], acc2);
            *(unsigned*)(ZP + base + (size_t)(p0 + i) * stride + c) = pk2(acc2.x, acc2.y); }
        c = cn; len = lenn; p0 = p0n; base = basen; stride = striden;
#pragma unroll
        for (int i = 0; i < 46; ++i) u[i] = un[i];
    }
}
__device__ __forceinline__ void p_ln_silu(const Args& a, int lane, int wave) {
    const int gw = blockIdx.x * NWAVES + wave, NGW = gridDim.x * NWAVES;
    const bf16* ZP = (const bf16*)(a.ws + WS_ZP); bf16* Z = (bf16*)(a.ws + WS_Z);
    f32x4 gg[4], bb[4];
#pragma unroll
    for (int j = 0; j < 4; ++j) { gg[j] = ((const f32x4*)a.in[I_GCVLN])[lane + 64 * j]; bb[j] = ((const f32x4*)a.in[I_BCVLN])[lane + 64 * j]; }
    v2u y[2][4];
    if (gw * 2 < NTOK) {
#pragma unroll
        for (int r = 0; r < 2; ++r)
#pragma unroll
            for (int j = 0; j < 4; ++j) y[r][j] = ((const v2u*)(ZP + (size_t)(gw * 2 + r) * D))[lane + 64 * j];
    }
    for (int m0 = gw * 2; m0 < NTOK; m0 += NGW * 2) {
        v2u yn[2][4]; const int mn = m0 + NGW * 2;
#pragma unroll
        for (int r = 0; r < 2; ++r)
#pragma unroll
            for (int j = 0; j < 4; ++j) yn[r][j] = mn < NTOK ? ((const v2u*)(ZP + (size_t)(mn + r) * D))[lane + 64 * j] : (v2u){0u, 0u};
#pragma unroll
        for (int r = 0; r < 2; ++r) {
            f32x4 v[4]; float s = 0.f;
#pragma unroll
            for (int j = 0; j < 4; ++j) { v[j] = (f32x4){bf_lo(y[r][j].x), bf_hi(y[r][j].x), bf_lo(y[r][j].y), bf_hi(y[r][j].y)}; s += (v[j].x + v[j].y) + (v[j].z + v[j].w); }
            const float mean = wave_sum(s) * (1.0f / D); float s2 = 0.f;
#pragma unroll
            for (int j = 0; j < 4; ++j) { v[j] = v[j] - mean; s2 += (v[j].x * v[j].x + v[j].y * v[j].y) + (v[j].z * v[j].z + v[j].w * v[j].w); }
            const float rstd = 1.0f / sqrtf(wave_sum(s2) * (1.0f / D) + EPS);
#pragma unroll
            for (int j = 0; j < 4; ++j) {
                f32x4 yy = v[j] * rstd * gg[j] + bb[j]; yy.x *= fsig(yy.x); yy.y *= fsig(yy.y); yy.z *= fsig(yy.z); yy.w *= fsig(yy.w);
                store_row4<F8_MISC != 0>((unsigned char*)Z + (size_t)(m0 + r) * D * (F8_MISC ? 1 : 2), lane, j, yy, 4.0f); }
        }
#pragma unroll
        for (int r = 0; r < 2; ++r)
#pragma unroll
            for (int j = 0; j < 4; ++j) y[r][j] = yn[r][j];
    }
}


enum { PH_PRO = 0, PH_NORM0, PH_INPROJ, PH_SCANA, PH_SCANC, PH_READOUT, PH_OUTPROJ, PH_ROUTER0, PH_G1_0, PH_G2_0, PH_COMB0, PH_CVIN, PH_DWCONV, PH_LN, PH_CVOUT, PH_ROUTER1, PH_G1_1, PH_G2_1, PH_FINAL, NPH };
#ifndef AEPI
#define AEPI 1
#endif
#ifndef REPMASK
#define REPMASK 0ull
#endif
#ifndef SCAN_NAIVE
#define SCAN_NAIVE 0
#endif
#if defined(__HIP_DEVICE_COMPILE__)
#define NO_PK_F32
#else
#define NO_PK_F32
#endif
__global__ void NO_PK_F32 __launch_bounds__(NTHR, 2) fwd_kernel(Args args) {
    extern __shared__ __attribute__((aligned(16))) unsigned char lds_raw[];
    LAS unsigned char* lds = (LAS unsigned char*)lds_raw;
    const int tid = threadIdx.x, lane = tid & 63, wave = __builtin_amdgcn_readfirstlane(tid >> 6);
    const int G = gridDim.x, bid = blockIdx.x;
    unsigned char* ws = args.ws;
    for (int u = tid; u < (LDS_BYTES - LDSCTL_OFF) / 4; u += NTHR) ((LAS unsigned*)(lds + LDSCTL_OFF))[u] = 0u;
    __syncthreads();
    volatile LAS unsigned* MISC = (volatile LAS unsigned*)(lds + MISC_OFF);
    XcdBarrier bar = xcd_barrier_post((unsigned*)(ws + WS_CTL) + CW_BAR + args.li * XCD_BAR_WORDS, MISC + 8);
    const int lo = args.ph_lo, hi = args.ph_hi;
    if (TL_PROBE && tid == 0) MISC[48] = (unsigned)__builtin_amdgcn_s_memrealtime();
    if (tid == 0) __hip_atomic_store((unsigned*)(ws + WS_CTL) + CW_XMAP + bid, xb_xcc_id() + 1u, __ATOMIC_RELAXED, __HIP_MEMORY_SCOPE_AGENT);
#define IN(k) (lo <= (k) && (k) < hi)
    int cv_n = 0; unsigned bseq = 0;
#ifndef FLAT_BARRIER
#define FLAT_BARRIER 0
#endif
#define SEAM(k) do { if (IN(k) && IN((k) + 1)) { ++bseq; if (FLAT_BARRIER) flat_barrier_work((unsigned*)(ws + WS_CTL) + CW_FLAT, args, lds, wave, lane, cv_n, MISC + 12, bseq); else xcd_barrier_work(bar, args, lds, wave, lane, cv_n, MISC + 12, bseq); \
        if (TL_PROBE && tid == 0) MISC[48 + (k) + 1] = (unsigned)__builtin_amdgcn_s_memrealtime(); } } while (0)
#define PHASE(k, ...) if (IN(k)) { __VA_ARGS__; if ((REPMASK >> (k)) & 1ull) { __syncthreads(); __VA_ARGS__; } if (TL_PROBE && tid == 0) MISC[72 + (k)] = (unsigned)__builtin_amdgcn_s_memrealtime(); } SEAM(k);
    typedef pg8::bf16_t pbf;

    const bool merge_pro = false && (G >= 32) && IN(PH_PRO) && IN(PH_NORM0);
    if (IN(PH_PRO)) { p_mods(args, lds, tid, lane, wave); p_weights(args, lds, lane, wave); if (merge_pro) wait_mods0(args, tid); }
    if (!merge_pro) SEAM(PH_PRO);
    const bool ctx_early = SPLIT_IN && (G == 256);
    PHASE(PH_NORM0, {
        if (ctx_early && bid < 24) {
            const int cb = bid / 12, cj = bid % 12;
            p_norm0(args, lane, wave, NWAVES, NTOK + cb * CTXL, NTOK + cb * CTXL + CTXL);
            VM_WAIT(); __syncthreads();
            if (cj < 8) {
                pg8::Gemm g{(const pbf*)(ws + WS_H8), (const pbf*)(ws + WS_WIN8), D / 2, 0};
                pg8::OneUnit S1{NTOK / 256 + cb, cj};
                pg8::EpiHgrnIn E{(pbf*)(ws + WS_Q), (WS_V - WS_Q) / 2, (_Float16*)(ws + WS_LFF), (WS_LFB - WS_LFF) / 2, args.in[I_HGAMMA], 2};
                pg8::gemm_phase<pg8::EpiHgrnIn, pg8::OneUnit, AEPI != 0, true, true, 0x79797979, 0x7F7F7F7F>(lds + RING_OFF, g, S1, E);
            } else {
                pg8::Gemm g{(const pbf*)(ws + WS_H), (const pbf*)(ws + WS_WIN), D, 0};
                pg8::OneUnit S1{NTOK / 256 + cb, 4 + (cj - 8)};
                pg8::EpiHgrnIn E{(pbf*)(ws + WS_Q), (WS_V - WS_Q) / 2, (_Float16*)(ws + WS_LFF), (WS_LFB - WS_LFF) / 2, args.in[I_HGAMMA], 1};
                pg8::gemm_phase<pg8::EpiHgrnIn, pg8::OneUnit, AEPI != 0, true, false>(lds + RING_OFF, g, S1, E);
            }
        } else if (ctx_early) p_norm0(args, lane, (bid - 24) * NWAVES + wave, (G - 24) * NWAVES, 0, NTOK);
        else p_norm0(args, lane, bid * NWAVES + wave, G * NWAVES, 0, MROWS);
    })
    PHASE(PH_INPROJ, {
        static_assert(WS_V - WS_Q == WS_SG - WS_V, "Q|V|SG equally spaced");
        if (SPLIT_IN) {
            const int nMi = ctx_early ? NTOK / 256 : MROWS / 256;
            {
                pg8::Gemm g{(const pbf*)(ws + WS_H8), (const pbf*)(ws + WS_WIN8), D / 2, 0};
                pg8::TileOrder S; S.init(nMi, (G_F8 ? 3 : 2) * D / 256, G, bid, nullptr);
                pg8::EpiHgrnIn E{(pbf*)(ws + WS_Q), (WS_V - WS_Q) / 2, (_Float16*)(ws + WS_LFF), (WS_LFB - WS_LFF) / 2, args.in[I_HGAMMA], 2};
                pg8::gemm_phase<pg8::EpiHgrnIn, pg8::TileOrder, AEPI != 0, true, true, 0x79797979, 0x7F7F7F7F>(lds + RING_OFF, g, S, E);
            }
            {
                pg8::Gemm g{(const pbf*)(ws + WS_H), (const pbf*)(ws + WS_WIN), D, 0};
                pg8::TileOrder S; S.init(nMi, (G_F8 ? 2 : 3) * D / 256, G, bid, nullptr);
                pg8::EpiHgrnIn E{(pbf*)(ws + WS_Q), (WS_V - WS_Q) / 2, (_Float16*)(ws + WS_LFF), (WS_LFB - WS_LFF) / 2, args.in[I_HGAMMA], 1};
                pg8::gemm_phase<pg8::EpiHgrnIn, pg8::TileOrder, AEPI != 0, true, false>(lds + RING_OFF, g, S, E);
            }
        } else {
            pg8::Gemm g{(const pbf*)(ws + WS_H), (const pbf*)(ws + WS_WIN), F8_IN ? D / 2 : D, 0};
            pg8::TileOrder S; S.init(MROWS / 256, 5 * D / 256, G, bid, nullptr);
            pg8::EpiHgrnIn E{(pbf*)(ws + WS_Q), (WS_V - WS_Q) / 2, (_Float16*)(ws + WS_LFF), (WS_LFB - WS_LFF) / 2, args.in[I_HGAMMA], 0};
            pg8::gemm_phase<pg8::EpiHgrnIn, pg8::TileOrder, AEPI != 0, true, F8_IN != 0, 0x79797979, 0x7F7F7F7F>(lds + RING_OFF, g, S, E);
        }
    })
#if SCAN_NAIVE
    PHASE(PH_SCANA, { p_scan_naive(args, lds, tid); })
    PHASE(PH_SCANC, { })
#else
    PHASE(PH_SCANA, { p_scan_a(args, lds, tid, lane, wave); })
    PHASE(PH_SCANC, { p_scan_c(args, lds, tid, lane, wave); })
#endif
    PHASE(PH_READOUT, { p_readout(args, lane, wave); })
    PHASE(PH_OUTPROJ, {
        pg8::Gemm g{(const pbf*)(ws + WS_YIN), (const pbf*)(ws + WS_WOUT), F8_MISC ? D / 2 : D, 0};
        pg8::TileOrder S; S.init(NTOK / 256, D / 256, G, bid, nullptr);
        pg8::EpiResGate<false, true> E{args.in[I_X], (void*)(ws + WS_X), (const float*)(ws + WS_MODS) + 2 * D, 6 * D, SEQ, nullptr};
        pg8::gemm_phase<pg8::EpiResGate<false, true>, pg8::TileOrder, AEPI != 0, true, F8_MISC != 0, 0x79797979, 0x7D7D7D7D>(lds + RING_OFF, g, S, E);
    })
#ifndef LDSB
#define LDSB 1
#endif
#ifndef XBAR_PROBE
#define XBAR_PROBE 0
#endif
#ifndef G2_NS
#define G2_NS 0
#endif
#ifndef G1_NS
#define G1_NS 0
#endif
#ifndef MOE_HANDOFF
#define MOE_HANDOFF 1
#endif
#ifndef MOE_WT
#define MOE_WT 0
#endif
#define MOE_PHASES(l, pb) \
    if (IN(pb + 0)) { p_router(args, lds, l, tid, lane, wave); cv_finish(args, lds, wave, lane, cv_n, (l + 1) * CV_L0); } SEAM(pb + 0); \
    if ((l) == 1) { if (XBAR_PROBE >= 1) SEAM(pb + 0); if (XBAR_PROBE >= 2) SEAM(pb + 0); if (XBAR_PROBE >= 3) SEAM(pb + 0); if (XBAR_PROBE >= 4) SEAM(pb + 0); }     \
    if (IN(pb + 1) || IN(pb + 2) || IN(pb + 3)) { \
        moe_tables(args, lds, l, tid); \
        LAS int* tab = (LAS int*)(lds + EXTRA_OFF + 640); \
        const LAS int* s_tb = (const LAS int*)(lds + EXTRA_OFF + 256); const LAS int* s_ce = s_tb + 40; \
        const int ntiles = __builtin_amdgcn_readfirstlane(s_tb[32]); \
        const bool hand = MOE_HANDOFF && (G == 256) && IN(pb + 1) && IN(pb + 2) && !((REPMASK >> (pb + 1)) & 3ull) && (MOE_WT || xmap_ok); \
        const int xl = (hand && !MOE_WT) ? 1 : 0; \
        unsigned* tcnt = (unsigned*)(ws + WS_CTL) + CW_TCNT + l * 32768; \
        const int c2 = (hand && MOE_WT) ? ((bid - ((((ntiles * 8) & 255) + 7) & ~7)) & 255) : bid;     \
        const int tv = (((bid & 7) + 1) * ntiles >> 3) - ((bid & 7) * ntiles >> 3);                   \
        LAS int* ut1 = (LAS int*)(lds + EXTRA_OFF + 13824); LAS int* ut2 = ut1 + 32;                  \
        if (wave == 0) { \
            int pm_ = 0, pn_ = 0; \
            const bool h1 = lane < 32 && pg8::MoeOrder::unit_of(xl, ntiles, 2 * D / 256, G, bid, bid >> 3, lane, pm_, pn_); \
            if (lane < 32) ut1[lane] = h1 ? (pm_ | (pn_ << 16) | (tab[pm_] << 24)) : 0; \
            const bool h2 = lane < 32 && pg8::MoeOrder::unit_of(xl, ntiles, D / 256, G, c2, ((bid >> 3) - ((tv * 8) & 31)) & 31, lane, pm_, pn_); \
            if (lane < 32) ut2[lane] = h2 ? (pm_ | (pn_ << 16) | (tab[pm_] << 24)) : 0; \
            const int n1 = __popcll(__ballot(h1)), n2 = __popcll(__ballot(h2)); \
            if (lane == 0) { ut1[64] = n1; ut1[65] = n2; } \
        } \
        __syncthreads(); \
        const int nu1 = __builtin_amdgcn_readfirstlane(ut1[64]), nu2 = __builtin_amdgcn_readfirstlane(ut1[65]); \
        if (IN(pb + 1)) { \
            LAS unsigned short* tt = (LAS unsigned short*)(lds + EXTRA_OFF + 2816);     \
            pg8::MoeOrder S; S.ut = ut1; S.nu = nu1; S.cnt = tcnt; S.rdy = 0u; S.mode = hand ? 0 : 2; \
            { const int* STOK = (const int*)(ws + WS_STOK); int tv_[10];                         \
              _Pragma("unroll") for (int n_ = 0; n_ < 10; ++n_) { const int idx = tid + NTHR * n_; tv_[n_] = 0; \
                  if (idx < nu1 * 256) { const int uw = ut1[idx >> 8], pm_ = uw & 0xFFFF, e_ = (uw >> 24) & 0xFF, vi = (pm_ - s_tb[e_]) * 256 + (idx & 255); if (vi < s_ce[e_]) tv_[n_] = STOK[(size_t)e_ * NTOK + vi]; } } \
              _Pragma("unroll") for (int n_ = 0; n_ < 10; ++n_) { const int idx = tid + NTHR * n_; if (idx < nu1 * 256) tt[idx] = (unsigned short)tv_[n_]; } } \
            __syncthreads(); \
            pg8::Gemm g{(const pbf*)(ws + WS_H), (const pbf*)(ws + WS_W1 + (size_t)l * NE * 2 * D * D), D / 2, (size_t)2 * D * D, tt};   \
            pg8::EpiPair<0, true, 4, MOE_WT != 0, LDSB != 0> E{(pbf*)(ws + WS_ACT), args.in[I_BE1] + (size_t)l * NE * 2 * D, (const LAS float*)(lds + EXTRA_OFF + 14336)}; \
            pg8::gemm_phase<pg8::EpiPair<0, true, 4, MOE_WT != 0, LDSB != 0>, pg8::MoeOrder, AEPI != 0, true, true, 0x79797979, 0x7F7F7F7F, true, G1_NS>(lds + RING_OFF, g, S, E); \
            if ((REPMASK >> (pb + 1)) & 1ull) { __syncthreads(); pg8::gemm_phase<pg8::EpiPair<0, true, 4, MOE_WT != 0, LDSB != 0>, pg8::MoeOrder, AEPI != 0, true, true, 0x79797979, 0x7F7F7F7F, true, G1_NS>(lds + RING_OFF, g, S, E); } \
        } \
        pg8::MoeOrder S2; S2.ut = ut2; S2.nu = nu2; S2.cnt = tcnt; S2.rdy = 0u; S2.mode = hand ? 1 : 2; \
        if (hand) {                                                          \
            if (wave == 0) { \
                const unsigned v = lane < nu2 ? __hip_atomic_load(tcnt + 32 * (ut2[lane & 31] & 0xFFFF), __ATOMIC_RELAXED, __HIP_MEMORY_SCOPE_AGENT) : 64u; \
                const unsigned long long m = __ballot(v >= 64u); \
                __builtin_amdgcn_fence(__ATOMIC_ACQUIRE, "agent"); asm volatile("s_waitcnt vmcnt(0)" ::: "memory"); \
                if (lane == 0) MISC[16] = (unsigned)m; \
            } \
            __syncthreads(); \
            S2.rdy = __builtin_amdgcn_readfirstlane(MISC[16]); \
        } else SEAM(pb + 1); \
        PHASE(pb + 2, { \
            pg8::Gemm g{(const pbf*)(ws + WS_ACT), (const pbf*)(ws + WS_W2 + (size_t)l * NE * D * D), D / 2, (size_t)D * D}; \
            pg8::EpiMoeOut<F8_Y != 0, YSCALE, LDSB != 0> E{(pbf*)(ws + WS_YS), args.in[I_BE2] + (size_t)l * NE * D, (const LAS float*)(lds + EXTRA_OFF + 14336)}; \
            pg8::gemm_phase<pg8::EpiMoeOut<F8_Y != 0, YSCALE, LDSB != 0>, pg8::MoeOrder, AEPI != 0, true, true, 0x79797979, 0x7D7D7D7D, false, G2_NS>(lds + RING_OFF, g, S2, E);   \
        }) \
    }
    bool xmap_ok = false;
    if (MOE_HANDOFF && !MOE_WT && G == 256 && lo == 0) {
        if (wave == 0) {
            const unsigned* xm = (const unsigned*)(ws + WS_CTL) + CW_XMAP; bool ok = true;
#pragma unroll
            for (int k = 0; k < 4; ++k) { const int b = lane + 64 * k; const unsigned mine = __hip_atomic_load(xm + b, __ATOMIC_RELAXED, __HIP_MEMORY_SCOPE_AGENT), cls = __hip_atomic_load(xm + (b & 7), __ATOMIC_RELAXED, __HIP_MEMORY_SCOPE_AGENT);
                ok = ok && mine != 0u && mine == cls; }
            const unsigned me = __hip_atomic_load(xm + (lane & 7), __ATOMIC_RELAXED, __HIP_MEMORY_SCOPE_AGENT);
#pragma unroll
            for (int j = 1; j < 8; ++j) { const unsigned other = (unsigned)__shfl((int)me, (lane + j) & 7); ok = ok && other != me; }
            const bool all_ok = __all(ok);
            if (lane == 0) MISC[17] = all_ok ? 1u : 0u;
        }
        __syncthreads();
        xmap_ok = __builtin_amdgcn_readfirstlane(MISC[17]) != 0u;
    }
    MOE_PHASES(0, PH_ROUTER0)
    PHASE(PH_COMB0, { p_combine<false>(args, lds, 0, lane, wave); })
    PHASE(PH_CVIN, {
        pg8::Gemm g{(const pbf*)(ws + WS_H), (const pbf*)(ws + WS_WCVIN), F8_MISC ? D / 2 : D, 0};
        pg8::TileOrder S; S.init(NTOK / 256, 2 * D / 256, G, bid, nullptr);
        pg8::EpiPair<1> E{(pbf*)(ws + WS_U), args.in[I_BCVIN]};
        pg8::gemm_phase<pg8::EpiPair<1>, pg8::TileOrder, AEPI != 0, true, F8_MISC != 0, 0x79797979, 0x7F7F7F7F>(lds + RING_OFF, g, S, E);
    })
    PHASE(PH_DWCONV, { p_dwconv(args, tid); })
    PHASE(PH_LN, { p_ln_silu(args, lane, wave); })
    PHASE(PH_CVOUT, {
        pg8::Gemm g{(const pbf*)(ws + WS_Z), (const pbf*)(ws + WS_WCVOUT), F8_MISC ? D / 2 : D, 0};
        pg8::TileOrder S; S.init(NTOK / 256, D / 256, G, bid, nullptr);
        pg8::EpiResGate<true, true> E{(const void*)(ws + WS_X), (void*)(ws + WS_X), (const float*)(ws + WS_MODS) + 3 * 6 * D + 2 * D, 6 * D, SEQ, args.in[I_BCVOUT]};
        pg8::gemm_phase<pg8::EpiResGate<true, true>, pg8::TileOrder, AEPI != 0, true, F8_MISC != 0, 0x79797979, 0x7D7D7D7D>(lds + RING_OFF, g, S, E);
    })
#ifndef CLK_PROBE
#define CLK_PROBE 0
#endif
#if CLK_PROBE
    if (bid == 0 && tid == 0) { const unsigned long long c = __builtin_amdgcn_s_memtime(), w = __builtin_amdgcn_s_memrealtime(); MISC[20] = (unsigned)c; MISC[21] = (unsigned)(c >> 32); MISC[22] = (unsigned)w; MISC[23] = (unsigned)(w >> 32); }
#endif
    MOE_PHASES(1, PH_ROUTER1)
#if CLK_PROBE
    if (bid == 0 && tid == 0) { const unsigned long long c = __builtin_amdgcn_s_memtime(), w = __builtin_amdgcn_s_memrealtime(); MISC[24] = (unsigned)c; MISC[25] = (unsigned)(c >> 32); MISC[26] = (unsigned)w; MISC[27] = (unsigned)(w >> 32); }
#endif
    if (IN(PH_FINAL)) { p_combine<true>(args, lds, 1, lane, wave); }
#if KL_PROBE
    static_assert(pg8::KLP_LDS == MISC_OFF + 4 * 28, "probe words");
    if (bid == 0 && tid == 0) {
        const unsigned long long kl = ((unsigned long long)MISC[29] << 32) | MISC[28]; const unsigned nun = MISC[30] ? MISC[30] : 1u;
        const unsigned long long tot = ((unsigned long long)MISC[37] << 32) | MISC[36];
        const unsigned long long ticks = KL_PROBE == 1 ? kl * 10ull / (8ull * nun) : (tot - kl) * 5ull / nun;
        const unsigned long long t_end = __builtin_amdgcn_s_memrealtime() + (ticks < 100000ull ? ticks : 100000ull);
        while (__builtin_amdgcn_s_memrealtime() < t_end) __builtin_amdgcn_s_sleep(8);
    }
#endif
#if TL_PROBE
    if (bid == 0 && tid == 0) { const unsigned ticks = TL_BODY ? MISC[72 + TL_B] - MISC[48 + TL_B] : MISC[48 + TL_B + 1] - MISC[48 + TL_A + 1];     const unsigned long long t_end = __builtin_amdgcn_s_memrealtime() + 2ull * (ticks < 200000u ? ticks : 200000u); while (__builtin_amdgcn_s_memrealtime() < t_end) __builtin_amdgcn_s_sleep(8); }
#endif
#if CVF_PROBE
    if (bid == 0 && tid == 0) { const unsigned long long t_end = __builtin_amdgcn_s_memrealtime() + 2ull * MISC[40]; while (__builtin_amdgcn_s_memrealtime() < t_end) __builtin_amdgcn_s_sleep(8); }
#endif
#if CLK_PROBE
    if (bid == 0 && tid == 0) {
        const unsigned long long c0 = ((unsigned long long)MISC[21] << 32) | MISC[20], w0 = ((unsigned long long)MISC[23] << 32) | MISC[22], c1 = ((unsigned long long)MISC[25] << 32) | MISC[24], w1 = ((unsigned long long)MISC[27] << 32) | MISC[26];
        const unsigned long long ticks = (c1 - c0) * 1000ull / (w1 - w0 + 1ull);
        const unsigned long long t_end = __builtin_amdgcn_s_memrealtime() + (ticks < 100000ull ? ticks : 100000ull);
        while (__builtin_amdgcn_s_memrealtime() < t_end) __builtin_amdgcn_s_sleep(8);
    }
#endif
#undef MOE_PHASES
#undef PHASE
#undef IN
#undef SEAM
}

extern "C" void kernel_launch(void* const* d_in, const int* in_sizes, int n_in, void* d_out, int out_size, void* d_ws, size_t ws_size, hipStream_t stream) {
    static int grid = 0;
    if (grid == 0) {
        if (n_in != N_IN || in_sizes[0] != NTOK * D || out_size != NTOK * D || ws_size < WS_END) { fprintf(stderr, "kernel_launch: unexpected shapes / workspace (n_in %d, in0 %d, out %d, ws %zu, need %zu); nothing launched\n", n_in, n_in > 0 ? in_sizes[0] : -1, out_size, ws_size, (size_t)WS_END); grid = -1; return; }
        int dev = 0, cus = 0, per_cu = 0;
        if (hipGetDevice(&dev) != hipSuccess || hipDeviceGetAttribute(&cus, hipDeviceAttributeMultiprocessorCount, dev) != hipSuccess) { grid = -1; return; }
        if (hipFuncSetAttribute((const void*)fwd_kernel, hipFuncAttributeMaxDynamicSharedMemorySize, LDS_BYTES) != hipSuccess) { fprintf(stderr, "kernel_launch: hipFuncSetAttribute failed\n"); grid = -1; return; }
        if (hipOccupancyMaxActiveBlocksPerMultiprocessor(&per_cu, (const void*)fwd_kernel, NTHR, LDS_BYTES) != hipSuccess || per_cu < 1) { fprintf(stderr, "kernel_launch: occupancy query reports %d workgroups per CU\n", per_cu); }
        (void)hipGetLastError();
        grid = cus;
    }
    if (grid < 0) return;
    if (hipMemsetAsync((char*)d_ws + WS_CTL, 0, CTL_ZERO_BYTES, stream) != hipSuccess) return;
#ifdef DIAG_MEMSET
    (void)hipMemsetAsync((char*)d_ws + WS_SP, 0, (WS_WIN - WS_SP), stream); (void)hipMemsetAsync((char*)d_ws + WS_OF, 0, (WS_YIN - WS_OF), stream);
#endif
    Args a{};
    for (int i = 0; i < N_IN; ++i) a.in[i] = (const float*)d_in[i];
    a.out = (float*)d_out; a.ws = (unsigned char*)d_ws; a.pad = 0;
#ifndef MK_CUTS
    a.ph_lo = 0; a.ph_hi = NPH; a.li = 0;
    hipLaunchKernelGGL(fwd_kernel, dim3(grid), dim3(NTHR), LDS_BYTES, stream, a);
#else
    const int cuts[] = {MK_CUTS};
    const int nc = (int)(sizeof(cuts) / sizeof(cuts[0]));
    for (int li = 0; li + 1 < nc; ++li) { a.ph_lo = cuts[li]; a.ph_hi = cuts[li + 1]; a.li = li; hipLaunchKernelGGL(fwd_kernel, dim3(grid), dim3(NTHR), LDS_BYTES, stream, a); }
#endif
}
```

```cpp
#include <hip/hip_runtime.h>
#include <cstdio>
#include <cstdint>
__device__ __forceinline__ void wg_sync_() { __builtin_amdgcn_fence(__ATOMIC_RELEASE, "workgroup"); __builtin_amdgcn_s_barrier(); __builtin_amdgcn_fence(__ATOMIC_ACQUIRE, "workgroup"); }
#define __syncthreads() wg_sync_()
#define __ballot(p) __builtin_amdgcn_ballot_w64((p) != 0)
#define __all(p) (__builtin_amdgcn_ballot_w64(!(p)) == 0ull)
#define __shfl(v, src) __builtin_amdgcn_ds_bpermute((int)(src) << 2, (int)(v))
#define __popcll(x) __builtin_popcountll(x)

namespace pg8 {
#define PG8_LAS __attribute__((address_space(3)))
typedef unsigned short bf16_t;
typedef short bf16x8 __attribute__((ext_vector_type(8)));
typedef float f32x4 __attribute__((ext_vector_type(4)));
typedef unsigned u32x4 __attribute__((ext_vector_type(4)));
typedef unsigned u32x2 __attribute__((ext_vector_type(2)));
typedef int i32x4 __attribute__((ext_vector_type(4)));
typedef int i32x8 __attribute__((ext_vector_type(8)));
#ifndef KL_PROBE
#define KL_PROBE 0
#endif
constexpr int KLP_LDS = 139264 + 320 + 4 * 28;
constexpr int BM = 256, BK = 64, HALF = 128, HTB = HALF * BK * 2  , STAGE_BYTES = 8 * HTB, NXCD = 8, WGM = 8;

__host__ __device__ __forceinline__ int lds_byte(int r, int c) { const int st = (r >> 4) * 2 + (c >> 5), rr = r & 15, cc = c & 31, ob = rr * 64 + cc * 2; return st * 1024 + (ob ^ (((ob >> 9) & 1) << 5)); }
__host__ __device__ __forceinline__ void stage_rc(int b, int& R, int& C) { const int st = b / 1024, sb = b % 1024, swz = sb ^ (((sb >> 9) & 1) << 5); R = (st >> 1) * 16 + swz / 64; C = (st & 1) * 32 + (swz % 64) / 2; }
__host__ __device__ __forceinline__ int perm32(int rho) { const int n = rho >> 4, i = rho & 15; return 8 * (i >> 2) + 4 * n + (i & 3); }

struct Unit { int pm, pn, e; };
struct Gemm { const bf16_t* A; const bf16_t* Bt; int K; size_t estride; const PG8_LAS unsigned short* tt; };

struct TileOrder {
    int nM, nN, nwg, G, c; const PG8_LAS int* tile_e;
    __device__ __forceinline__ void init(int nM_, int nN_, int G_, int c_, const PG8_LAS int* te) { nM = nM_; nN = nN_; nwg = nM * nN; G = G_; c = c_; tile_e = te; }
    __device__ __forceinline__ bool next(int i, Unit& u) const {
        const long L = (long)i * G + c; if (L >= nwg) return false;
        int wgid = (int)L; { const int q = nwg / NXCD, r = nwg % NXCD, xcd = wgid % NXCD, off = wgid / NXCD; wgid = (xcd < r ? xcd * (q + 1) : r * (q + 1) + (xcd - r) * q) + off; }
        const int nig = WGM * nN, gid = wgid / nig, fm = gid * WGM, gsz = (nM - fm) < WGM ? (nM - fm) : WGM;
        u.pm = fm + ((wgid % nig) % gsz); u.pn = (wgid % nig) / gsz;
        u.e = tile_e ? __builtin_amdgcn_readfirstlane(tile_e[u.pm]) : 0; return true;
    }
    static constexpr bool PUBLISH = false;
    __device__ __forceinline__ bool probe_on() const { return false; }
    __device__ __forceinline__ void a_ready(const Unit&, int) const {}
    __device__ __forceinline__ void done(const Unit&) const {}
    __device__ __forceinline__ void publish(int, int) const {}
};

struct MoeOrder {
    static constexpr bool PUBLISH = true;
    const PG8_LAS int* ut; int nu;
    unsigned* cnt; unsigned rdy; int mode;
    static __device__ __forceinline__ bool unit_of(int xl, int nM, int nN, int G, int c, int rrot, int i, int& pm, int& pn) {
        if (!xl) { TileOrder T; T.init(nM, nN, G, c, nullptr); Unit u; if (!T.next(i, u)) return false; pm = u.pm; pn = u.pn; return true; }
        const int v = c & 7, T0 = (v * nM) >> 3, Tv = (((v + 1) * nM) >> 3) - T0;
        const int Lx = i * 32 + rrot; if (Lx >= Tv * nN) return false;
        const int nig = WGM * nN, gid = Lx / nig, fm = gid * WGM, gsz = (Tv - fm) < WGM ? (Tv - fm) : WGM, w = Lx % nig;
        pm = T0 + fm + (w % gsz); pn = w / gsz; return true;
    }
    __device__ __forceinline__ bool next(int i, Unit& u) const {
        if (i >= nu) return false;
        const int v = __builtin_amdgcn_readfirstlane(ut[i]); u.pm = v & 0xFFFF; u.pn = (v >> 16) & 0xFF; u.e = (v >> 24) & 0xFF; return true;
    }
    __device__ __forceinline__ bool probe_on() const { return mode == 0; }
    __device__ __forceinline__ void done(const Unit&) const {}
    __device__ __forceinline__ void publish(int pm, int lane) const {
        if (mode == 0 && lane == 0) (void)__hip_atomic_fetch_add(cnt + 32 * pm, 1u, __ATOMIC_RELAXED, __HIP_MEMORY_SCOPE_AGENT);
    }
    __device__ __forceinline__ void a_ready(const Unit& u, int i) const {
        if (mode != 1 || ((rdy >> i) & 1u)) return;
        if (__builtin_amdgcn_readfirstlane(threadIdx.x >> 6) == 0) {
            unsigned sp = 0;
            while (__hip_atomic_load(cnt + 32 * u.pm, __ATOMIC_RELAXED, __HIP_MEMORY_SCOPE_AGENT) < 64u) { __builtin_amdgcn_s_sleep(1); if (++sp > (1u << 20)) break; }
            __builtin_amdgcn_fence(__ATOMIC_ACQUIRE, "agent");
            asm volatile("s_waitcnt vmcnt(0)" ::: "memory");
        }
        __builtin_amdgcn_s_barrier();
    }
};

struct OneUnit {
    int pm, pn;
    __device__ __forceinline__ bool next(int i, Unit& u) const { if (i != 0) return false; u.pm = pm; u.pn = pn; u.e = 0; return true; }
    static constexpr bool PUBLISH = false;
    __device__ __forceinline__ bool probe_on() const { return false; }
    __device__ __forceinline__ void a_ready(const Unit&, int) const {}
    __device__ __forceinline__ void done(const Unit&) const {}
    __device__ __forceinline__ void publish(int, int) const {}
};

__device__ __forceinline__ unsigned cvt_pk_bf16(float lo, float hi) { unsigned r; asm volatile("v_cvt_pk_bf16_f32 %0, %1, %2" : "=v"(r) : "v"(lo), "v"(hi)); return r; }
__device__ __forceinline__ float fsigmoid(float x) { return __builtin_amdgcn_rcpf(1.0f + __expf(-x)); }


struct EpiHgrnIn {
    static constexpr bool PERM = true, AFTER_DRAIN = false, LDS_BIAS = false;
    bf16_t* Q; size_t qstride; _Float16* LFF; size_t lfstride; const float* gamma; int mode;
    static __device__ __forceinline__ f32x4 vexp2(f32x4 t) { f32x4 e; e[0] = __builtin_amdgcn_exp2f(t[0]); e[1] = __builtin_amdgcn_exp2f(t[1]); e[2] = __builtin_amdgcn_exp2f(t[2]); e[3] = __builtin_amdgcn_exp2f(t[3]); return e; }
    static __device__ __forceinline__ f32x4 vrcp(f32x4 d) { f32x4 r; r[0] = __builtin_amdgcn_rcpf(d[0]); r[1] = __builtin_amdgcn_rcpf(d[1]); r[2] = __builtin_amdgcn_rcpf(d[2]); r[3] = __builtin_amdgcn_rcpf(d[3]); return r; }
    static __device__ __forceinline__ f32x4 vlog2(f32x4 d) { f32x4 r; r[0] = __builtin_amdgcn_logf(d[0]); r[1] = __builtin_amdgcn_logf(d[1]); r[2] = __builtin_amdgcn_logf(d[2]); r[3] = __builtin_amdgcn_logf(d[3]); return r; }
    __device__ __forceinline__ void operator()(const f32x4 (&acc)[2][2][4][2], const Unit& u, int wr, int wc, int fr, int fq) const {
        const int sg_ = u.pn >> 2, seg = mode == 0 ? sg_ : (mode == 1 ? (sg_ < 2 ? sg_ : 4) : 2 + sg_), cb = (u.pn & 3) * 256 + wc * 32 + 8 * fq;
        const int row0 = u.pm * BM + wr * 64 + fr;
        if (seg == 2 || seg == 3) {
            _Float16* O = LFF + (size_t)(seg - 2) * lfstride; const float* g0 = gamma + (seg - 2) * 2048 + cb;
            f32x4 lb[2][2];
#pragma unroll
            for (int bj = 0; bj < 2; ++bj)
#pragma unroll
                for (int n = 0; n < 2; ++n) { const f32x4 d = *(const f32x4*)(g0 + bj * HALF + 4 * n) - *(const f32x4*)(g0 + 1024 + bj * HALF + 4 * n);
                    lb[bj][n] = vrcp(vexp2(d * -1.4426950408889634f) + 1.0f); }
#pragma unroll
            for (int ai = 0; ai < 2; ++ai)
#pragma unroll
                for (int m = 0; m < 4; ++m) { _Float16* rowp = O + (size_t)(row0 + ai * HALF + m * 16) * 1024 + cb;
#pragma unroll
                    for (int bj = 0; bj < 2; ++bj) { typedef _Float16 h16x8 __attribute__((ext_vector_type(8))); h16x8 o;
#pragma unroll
                        for (int n = 0; n < 2; ++n) { const f32x4 sg = vrcp(vexp2(acc[ai][bj][m][n] * -1.4426950408889634f) + 1.0f);
                            const f32x4 lf = vlog2(lb[bj][n] + (1.0f - lb[bj][n]) * sg);
                            o[4 * n + 0] = (_Float16)lf[0]; o[4 * n + 1] = (_Float16)lf[1]; o[4 * n + 2] = (_Float16)lf[2]; o[4 * n + 3] = (_Float16)lf[3]; }
                        *(h16x8*)(rowp + bj * HALF) = o; } }
        } else {
            bf16_t* O = Q + (size_t)(seg - (seg >> 2) * 2) * qstride;
#pragma unroll
            for (int ai = 0; ai < 2; ++ai)
#pragma unroll
                for (int m = 0; m < 4; ++m) { bf16_t* rowp = O + (size_t)(row0 + ai * HALF + m * 16) * 1024 + cb;
#pragma unroll
                    for (int bj = 0; bj < 2; ++bj) { f32x4 v0 = acc[ai][bj][m][0], v1 = acc[ai][bj][m][1];
                        if (seg == 4) { v0 = v0 * vrcp(vexp2(v0 * -1.4426950408889634f) + 1.0f); v1 = v1 * vrcp(vexp2(v1 * -1.4426950408889634f) + 1.0f); }
                        u32x4 w; w.x = cvt_pk_bf16(v0[0], v0[1]); w.y = cvt_pk_bf16(v0[2], v0[3]); w.z = cvt_pk_bf16(v1[0], v1[1]); w.w = cvt_pk_bf16(v1[2], v1[3]);
                        *(u32x4*)(rowp + bj * HALF) = w; } }
        }
    }
};
template <bool B16> struct RawOf { typedef u32x4 T; };
template <> struct RawOf<true> { typedef u32x2 T; };
template <bool BASE16, bool OUT16> struct EpiResGate {
    static constexpr bool PERM = false, AFTER_DRAIN = false, LDS_BIAS = false;
    const void* base; void* out; const float* gate; int gate_bstride; int rows_per_batch; const float* bias;
    __device__ __forceinline__ void operator()(const f32x4 (&acc)[2][2][4][2], const Unit& u, int wr, int wc, int fr, int fq) const {
        const int row0 = u.pm * BM + wr * 64 + fr, col0 = u.pn * BM + wc * 32 + 4 * fq;
        const float* gv_ = gate + (size_t)((u.pm * BM) / rows_per_batch) * gate_bstride;
        f32x4 gv[2][2], bv[2][2];
#pragma unroll
        for (int bj = 0; bj < 2; ++bj)
#pragma unroll
            for (int n = 0; n < 2; ++n) { gv[bj][n] = *(const f32x4*)(gv_ + col0 + bj * HALF + n * 16); bv[bj][n] = bias ? *(const f32x4*)(bias + col0 + bj * HALF + n * 16) : (f32x4){0.f, 0.f, 0.f, 0.f}; }
        typedef typename RawOf<BASE16>::T raw_t;
        raw_t rb[2][8];
#define ERG_LOAD(b_, dst_) do { _Pragma("unroll") for (int mm = 0; mm < 2; ++mm) _Pragma("unroll") for (int bj = 0; bj < 2; ++bj) _Pragma("unroll") for (int n = 0; n < 2; ++n) { \
            const size_t o = (size_t)(row0 + ((b_) >> 1) * HALF + (2 * ((b_) & 1) + mm) * 16) * 1024 + col0 + bj * HALF + n * 16; \
            if constexpr (BASE16) dst_[mm * 4 + bj * 2 + n] = *(const raw_t*)((const bf16_t*)base + o); else dst_[mm * 4 + bj * 2 + n] = *(const raw_t*)((const float*)base + o); } } while (0)
        ERG_LOAD(0, rb[0]);
#pragma unroll
        for (int b = 0; b < 4; ++b) {
            if (b < 3) ERG_LOAD(b + 1, rb[(b + 1) & 1]);
            const int ai = b >> 1;
#pragma unroll
            for (int mm = 0; mm < 2; ++mm) { const int m = 2 * (b & 1) + mm;
#pragma unroll
                for (int bj = 0; bj < 2; ++bj)
#pragma unroll
                    for (int n = 0; n < 2; ++n) { const size_t o = (size_t)(row0 + ai * HALF + m * 16) * 1024 + col0 + bj * HALF + n * 16; f32x4 bs; const raw_t w = rb[b & 1][mm * 4 + bj * 2 + n];
                        if constexpr (BASE16) bs = (f32x4){__builtin_bit_cast(float, w[0] << 16), __builtin_bit_cast(float, w[0] & 0xffff0000u), __builtin_bit_cast(float, w[1] << 16), __builtin_bit_cast(float, w[1] & 0xffff0000u)};
                        else bs = __builtin_bit_cast(f32x4, w);
                        const f32x4 r = bs + gv[bj][n] * (acc[ai][bj][m][n] + bv[bj][n]);
                        if constexpr (OUT16) *(u32x2*)((bf16_t*)out + o) = (u32x2){cvt_pk_bf16(r[0], r[1]), cvt_pk_bf16(r[2], r[3])};
                        else *(f32x4*)((float*)out + o) = r; } }
        }
#undef ERG_LOAD
    }
};
template <int MODE, bool OUT8 = false, int OSCALE = 1, bool WT = false, bool LB = false> struct EpiPair {
    static constexpr bool PERM = true, AFTER_DRAIN = false, LDS_BIAS = LB;
    bf16_t* O; const float* bias0; const PG8_LAS float* lb;
    __device__ __forceinline__ void stage_bias(const Unit& u, int lane) const {
        const float* src = bias0 + (MODE == 0 ? (size_t)u.e * 2048 : 0) + (lane < 32 ? 0 : 1024 - 128) + u.pn * HALF + lane * 4;
        __builtin_amdgcn_global_load_lds((const unsigned*)src, (PG8_LAS unsigned*)lb, 16, 0, 0);
    }
    static __device__ __forceinline__ f32x4 vsig(f32x4 x, float negscale) {
        const f32x4 t = x * negscale; f32x4 e; e[0] = __builtin_amdgcn_exp2f(t[0]); e[1] = __builtin_amdgcn_exp2f(t[1]); e[2] = __builtin_amdgcn_exp2f(t[2]); e[3] = __builtin_amdgcn_exp2f(t[3]);
        const f32x4 d = e + 1.0f; f32x4 r; r[0] = __builtin_amdgcn_rcpf(d[0]); r[1] = __builtin_amdgcn_rcpf(d[1]); r[2] = __builtin_amdgcn_rcpf(d[2]); r[3] = __builtin_amdgcn_rcpf(d[3]); return r; }
    __device__ __forceinline__ void operator()(const f32x4 (&acc)[2][2][4][2], const Unit& u, int wr, int wc, int fr, int fq) const {
        const float* bias = bias0 + (MODE == 0 ? (size_t)u.e * 2048 : 0);
        const int row0 = u.pm * BM + wr * 64 + fr, cg = u.pn * HALF + wc * 32 + 8 * fq;
        f32x4 b0[2], b1[2];
#pragma unroll
        for (int n = 0; n < 2; ++n) {
            if constexpr (LB) { b0[n] = *(const PG8_LAS f32x4*)(lb + wc * 32 + 8 * fq + 4 * n); b1[n] = *(const PG8_LAS f32x4*)(lb + 128 + wc * 32 + 8 * fq + 4 * n); }
            else { b0[n] = *(const f32x4*)(bias + cg + 4 * n); b1[n] = *(const f32x4*)(bias + 1024 + cg + 4 * n); } }
#pragma unroll
        for (int ai = 0; ai < 2; ++ai)
#pragma unroll
            for (int m = 0; m < 4; ++m) { bf16_t* rowp = O + (size_t)(row0 + ai * HALF + m * 16) * 1024 + cg; f32x4 r[2];
#pragma unroll
                for (int n = 0; n < 2; ++n) { const f32x4 g = acc[ai][0][m][n] + b0[n], up = acc[ai][1][m][n] + b1[n];
                    if (MODE == 0) { const f32x4 gg = __builtin_elementwise_min(g, (f32x4){7.0f, 7.0f, 7.0f, 7.0f});
                        const f32x4 uu = __builtin_elementwise_min(__builtin_elementwise_max(up, (f32x4){-7.0f, -7.0f, -7.0f, -7.0f}), (f32x4){7.0f, 7.0f, 7.0f, 7.0f});
                        r[n] = (uu * (float)OSCALE + (float)OSCALE) * (gg * vsig(gg, -1.702f * 1.4426950408889634f)); }
                    else r[n] = (g * (float)OSCALE) * vsig(up, -1.4426950408889634f); }
                if constexpr (OUT8) {
                    int w0 = 0, w1 = 0;
                    w0 = __builtin_amdgcn_cvt_pk_fp8_f32(r[0][0], r[0][1], w0, false); w0 = __builtin_amdgcn_cvt_pk_fp8_f32(r[0][2], r[0][3], w0, true);
                    w1 = __builtin_amdgcn_cvt_pk_fp8_f32(r[1][0], r[1][1], w1, false); w1 = __builtin_amdgcn_cvt_pk_fp8_f32(r[1][2], r[1][3], w1, true);
                    if constexpr (WT) __hip_atomic_store((unsigned long long*)((unsigned char*)O + (size_t)(row0 + ai * HALF + m * 16) * 1024 + cg), ((unsigned long long)(unsigned)w1 << 32) | (unsigned)w0, __ATOMIC_RELAXED, __HIP_MEMORY_SCOPE_AGENT);
                    else *(u32x2*)((unsigned char*)O + (size_t)(row0 + ai * HALF + m * 16) * 1024 + cg) = (u32x2){(unsigned)w0, (unsigned)w1};
                } else {
                u32x4 w; w.x = cvt_pk_bf16(r[0][0], r[0][1]); w.y = cvt_pk_bf16(r[0][2], r[0][3]); w.z = cvt_pk_bf16(r[1][0], r[1][1]); w.w = cvt_pk_bf16(r[1][2], r[1][3]);
                *(u32x4*)rowp = w; } }
    }
};
template <bool OUT8, int OSCALE, bool LB = false> struct EpiMoeOut {
    static constexpr bool PERM = true, AFTER_DRAIN = false, LDS_BIAS = LB;
    bf16_t* O; const float* bias0; const PG8_LAS float* lb;
    __device__ __forceinline__ void stage_bias(const Unit& u, int lane) const {
        __builtin_amdgcn_global_load_lds((const unsigned*)(bias0 + (size_t)u.e * 1024 + u.pn * BM + lane * 4), (PG8_LAS unsigned*)lb, 16, 0, 0);
    }
    __device__ __forceinline__ void operator()(const f32x4 (&acc)[2][2][4][2], const Unit& u, int wr, int wc, int fr, int fq) const {
        const float* bias = bias0 + (size_t)u.e * 1024;
        const int row0 = u.pm * BM + wr * 64 + fr, col0 = u.pn * BM + wc * 32 + 8 * fq;
        f32x4 bv[2][2];
#pragma unroll
        for (int bj = 0; bj < 2; ++bj)
#pragma unroll
            for (int n = 0; n < 2; ++n) {
                if constexpr (LB) bv[bj][n] = *(const PG8_LAS f32x4*)(lb + wc * 32 + 8 * fq + bj * HALF + 4 * n);
                else bv[bj][n] = *(const f32x4*)(bias + col0 + bj * HALF + 4 * n); }
#pragma unroll
        for (int ai = 0; ai < 2; ++ai)
#pragma unroll
            for (int m = 0; m < 4; ++m) { const int r = row0 + ai * HALF + m * 16;
#pragma unroll
                for (int bj = 0; bj < 2; ++bj) { const f32x4 v0 = acc[ai][bj][m][0] + bv[bj][0], v1 = acc[ai][bj][m][1] + bv[bj][1];
                    if constexpr (OUT8) { const f32x4 lim = (f32x4){448.0f, 448.0f, 448.0f, 448.0f};
                        const f32x4 s0 = __builtin_elementwise_min(__builtin_elementwise_max(v0 * (float)OSCALE, -lim), lim), s1 = __builtin_elementwise_min(__builtin_elementwise_max(v1 * (float)OSCALE, -lim), lim); int w0 = 0, w1 = 0;
                        w0 = __builtin_amdgcn_cvt_pk_fp8_f32(s0[0], s0[1], w0, false); w0 = __builtin_amdgcn_cvt_pk_fp8_f32(s0[2], s0[3], w0, true);
                        w1 = __builtin_amdgcn_cvt_pk_fp8_f32(s1[0], s1[1], w1, false); w1 = __builtin_amdgcn_cvt_pk_fp8_f32(s1[2], s1[3], w1, true);
                        *(u32x2*)((unsigned char*)O + (size_t)r * 1024 + col0 + bj * HALF) = (u32x2){(unsigned)w0, (unsigned)w1};
                    } else { u32x4 w; w.x = cvt_pk_bf16(v0[0], v0[1]); w.y = cvt_pk_bf16(v0[2], v0[3]); w.z = cvt_pk_bf16(v1[0], v1[1]); w.w = cvt_pk_bf16(v1[2], v1[3]);
                        *(u32x4*)(O + (size_t)r * 1024 + col0 + bj * HALF) = w; } } }
    }
};

template <class Epi, class Sched, bool ALIGN_EPI = false, bool SP2 = false, bool F8 = false, int SCW = 0x7F7F7F7F, int SCA = 0x7F7F7F7F, bool GATHER = false, int NS = 0, bool ZC = F8>
__device__ __forceinline__ void gemm_phase(PG8_LAS unsigned char* lds, const Gemm g, const Sched& S, const Epi& E) {
    const int tid = threadIdx.x, wid = __builtin_amdgcn_readfirstlane(tid >> 6), lane = tid & 63, wr = wid >> 2, wc = wid & 3, fr = lane & 15, fq = lane >> 4;
    const int K = g.K, nt = K / BK;
    unsigned voffA[2], voffB[2]; int stR[2], stC[2];
#pragma unroll
    for (int i = 0; i < 2; ++i) { int R, C; stage_rc(tid * 16 + i * 8192, R, C); const int Rb = Epi::PERM ? ((R & ~31) + perm32(R & 31)) : R; stR[i] = R; stC[i] = C;
        voffA[i] = (unsigned)(R * K + C) * 2u; voffB[i] = (unsigned)(Rb * K + C) * 2u; }
    const size_t kstep = (size_t)(BK * 2);
    const size_t hstep = (size_t)HALF * K * 2;
    const size_t tstep = 2 * hstep;
    unsigned vc[2][2], vn[2][2];
#pragma unroll
    for (int h = 0; h < 2; ++h)
#pragma unroll
        for (int i = 0; i < 2; ++i) {
            if constexpr (GATHER) vc[h][i] = (unsigned)g.tt[h * HALF + stR[i]] * (unsigned)(K * 2) + (unsigned)stC[i] * 2u;
            else vc[h][i] = voffA[i] + (unsigned)h * (unsigned)hstep;
            vn[h][i] = vc[h][i]; }
    const unsigned ldsw = (unsigned)wid * 1024u;
    const int aoff = lds_byte(wr * 64 + fr, fq * 8), boff = lds_byte(wc * 32 + fr, fq * 8);
#define PG8_SA(b, h) (((b) * 2 + (h)) * HTB)
#define PG8_SB(b, h) ((4 + (b) * 2 + (h)) * HTB)
#define PG8_STAGE(bufoff, gbase, voff) do { _Pragma("unroll") for (int _i = 0; _i < 2; ++_i) \
        __builtin_amdgcn_global_load_lds((const unsigned*)((const char*)(gbase) + (voff)[_i]), (PG8_LAS unsigned*)(lds + (bufoff) + ldsw + _i * 8192), 16, 0, 0); } while (0)
#define PG8_LDA(dst, b, h) do { _Pragma("unroll") for (int m = 0; m < 4; ++m) _Pragma("unroll") for (int k = 0; k < 2; ++k) dst[m][k] = *(const PG8_LAS bf16x8*)(lds + PG8_SA(b, h) + aoff + m * 2048 + k * 1024); } while (0)
#define PG8_LDB(dst, b, h) do { _Pragma("unroll") for (int n = 0; n < 2; ++n) _Pragma("unroll") for (int k = 0; k < 2; ++k) dst[n][k] = *(const PG8_LAS bf16x8*)(lds + PG8_SB(b, h) + boff + n * 2048 + k * 1024); } while (0)
#define PG8_MMA(ai, bj, At, Bt) do { __builtin_amdgcn_s_setprio(1); \
        if constexpr (!F8) { _Pragma("unroll") for (int m = 0; m < 4; ++m) _Pragma("unroll") for (int n = 0; n < 2; ++n) _Pragma("unroll") for (int k = 0; k < 2; ++k) \
            acc[ai][bj][m][n] = __builtin_amdgcn_mfma_f32_16x16x32_bf16(Bt[n][k], At[m][k], acc[ai][bj][m][n], 0, 0, 0); } \
        else { const int scw_ = SCW, sca_ = SCA; _Pragma("unroll") for (int m = 0; m < 4; ++m) _Pragma("unroll") for (int n = 0; n < 2; ++n) { \
            const i32x8 wf_ = __builtin_shufflevector(__builtin_bit_cast(i32x4, Bt[n][0]), __builtin_bit_cast(i32x4, Bt[n][1]), 0, 1, 2, 3, 4, 5, 6, 7); \
            const i32x8 af_ = __builtin_shufflevector(__builtin_bit_cast(i32x4, At[m][0]), __builtin_bit_cast(i32x4, At[m][1]), 0, 1, 2, 3, 4, 5, 6, 7); \
            asm volatile("v_mfma_scale_f32_16x16x128_f8f6f4 %0, %1, %2, %0, %3, %4 op_sel_hi:[0,0,0]" : "+v"(acc[ai][bj][m][n]) : "v"(wf_), "v"(af_), "v"(scw_), "v"(sca_)); } } \
        __builtin_amdgcn_s_setprio(0); } while (0)
#define PG8_MMAZ(ai, bj, At, Bt) do { __builtin_amdgcn_s_setprio(1); \
        if constexpr (!F8) { _Pragma("unroll") for (int m = 0; m < 4; ++m) _Pragma("unroll") for (int n = 0; n < 2; ++n) { \
            acc[ai][bj][m][n] = __builtin_amdgcn_mfma_f32_16x16x32_bf16(Bt[n][0], At[m][0], (f32x4){0.f, 0.f, 0.f, 0.f}, 0, 0, 0); \
            acc[ai][bj][m][n] = __builtin_amdgcn_mfma_f32_16x16x32_bf16(Bt[n][1], At[m][1], acc[ai][bj][m][n], 0, 0, 0); } } \
        else { const int scw_ = SCW, sca_ = SCA; _Pragma("unroll") for (int m = 0; m < 4; ++m) _Pragma("unroll") for (int n = 0; n < 2; ++n) { \
            const i32x8 wf_ = __builtin_shufflevector(__builtin_bit_cast(i32x4, Bt[n][0]), __builtin_bit_cast(i32x4, Bt[n][1]), 0, 1, 2, 3, 4, 5, 6, 7); \
            const i32x8 af_ = __builtin_shufflevector(__builtin_bit_cast(i32x4, At[m][0]), __builtin_bit_cast(i32x4, At[m][1]), 0, 1, 2, 3, 4, 5, 6, 7); \
            asm volatile("v_mfma_scale_f32_16x16x128_f8f6f4 %0, %1, %2, 0, %3, %4 op_sel_hi:[0,0,0]" : "=&v"(acc[ai][bj][m][n]) : "v"(wf_), "v"(af_), "v"(scw_), "v"(sca_)); } } \
        __builtin_amdgcn_s_setprio(0); } while (0)
#define PG8_WAIT_V(n) asm volatile("s_waitcnt vmcnt(" #n ")" ::: "memory")
#define PG8_WAIT_VN(n) asm volatile("s_waitcnt vmcnt(%0)" :: "n"(n) : "memory")
#define PG8_WAIT_L(n) asm volatile("s_waitcnt lgkmcnt(" #n ")" ::: "memory")
#define PG8_BAR __builtin_amdgcn_s_barrier()
#define PG8_SCHED __builtin_amdgcn_sched_barrier(0)
    Unit cur, nxt; int ui = 0, ppm = 0;
    if (!S.next(0, cur)) return;
#if KL_PROBE
    if (Sched::PUBLISH && S.probe_on() && blockIdx.x == 0 && wid == 0) { const unsigned long long t0_ = __builtin_amdgcn_s_memtime(); if (lane == 0) { PG8_LAS unsigned* kp = (PG8_LAS unsigned*)(unsigned)KLP_LDS; kp[6] = (unsigned)t0_; kp[7] = (unsigned)(t0_ >> 32); } }
#endif
    static_assert(SP2, "this build keeps only the SP2 K-loop");
    f32x4 acc[2][2][4][2];
    if constexpr (!ZC) {
#pragma unroll
    for (int a = 0; a < 2; ++a)
#pragma unroll
        for (int b = 0; b < 2; ++b)
#pragma unroll
            for (int m = 0; m < 4; ++m)
#pragma unroll
                for (int n = 0; n < 2; ++n) acc[a][b][m][n] = (f32x4){0.f, 0.f, 0.f, 0.f};
    }
    bf16x8 At[4][2], B0[2][2], B1[2][2];
    const char* cA = (const char*)g.A + (GATHER ? (size_t)0 : (size_t)cur.pm * tstep); const char* cB = (const char*)g.Bt + (size_t)cur.e * g.estride + (size_t)cur.pn * tstep;
    S.a_ready(cur, 0);
    if constexpr (SP2) {
        PG8_STAGE(PG8_SB(0, 0), cB, voffB); PG8_STAGE(PG8_SB(0, 1), cB + hstep, voffB); PG8_STAGE(PG8_SA(0, 0), cA, vc[0]); PG8_STAGE(PG8_SA(0, 1), cA, vc[1]);
        if (wr == 1) PG8_BAR;
        PG8_WAIT_V(2); PG8_BAR;
        PG8_STAGE(PG8_SB(1, 0), cB + kstep, voffB); PG8_STAGE(PG8_SA(1, 0), cA + kstep, vc[0]); PG8_STAGE(PG8_SB(1, 1), cB + hstep + kstep, voffB);
        PG8_WAIT_V(6); PG8_BAR;
    } else {
        PG8_STAGE(PG8_SB(0, 0), cB, voffB); PG8_STAGE(PG8_SA(0, 0), cA, vc[0]); PG8_STAGE(PG8_SB(0, 1), cB + hstep, voffB); PG8_STAGE(PG8_SA(0, 1), cA, vc[1]);
        if (wr == 1) PG8_BAR;
        PG8_WAIT_V(4); PG8_BAR;
        PG8_STAGE(PG8_SB(1, 0), cB + kstep, voffB); PG8_STAGE(PG8_SA(1, 0), cA + kstep, vc[0]); PG8_STAGE(PG8_SB(1, 1), cB + hstep + kstep, voffB);
        PG8_WAIT_V(6); PG8_BAR;
    }
    for (;;) {
        const bool has_next = S.next(ui + 1, nxt);
        if constexpr (GATHER) { if (has_next) {
#pragma unroll
            for (int h = 0; h < 2; ++h)
#pragma unroll
                for (int i = 0; i < 2; ++i) vn[h][i] = (unsigned)g.tt[(ui + 1) * BM + h * HALF + stR[i]] * (unsigned)(K * 2) + (unsigned)stC[i] * 2u; } }
        const char* nA = (has_next && !GATHER) ? (const char*)g.A + (size_t)nxt.pm * tstep : cA; const char* nB = has_next ? (const char*)g.Bt + (size_t)nxt.e * g.estride + (size_t)nxt.pn * tstep : cB;
#if KL_PROBE
        if (Sched::PUBLISH && S.probe_on() && blockIdx.x == 0 && wid == 0) { const unsigned long long t0_ = __builtin_amdgcn_s_memtime(); if (lane == 0) { PG8_LAS unsigned* kp = (PG8_LAS unsigned*)(unsigned)KLP_LDS; kp[4] = (unsigned)t0_; kp[5] = (unsigned)(t0_ >> 32); } }
#endif
#define PG8_WAIT_V8R do { if constexpr (NS > 0) { PG8_WAIT_VN(8 + NS); if (!rlx) PG8_WAIT_V(8); } else PG8_WAIT_V(8); } while (0)
#define PG8_TRIP(MMAK_, FIRST_) { \
            const bool last = (t == nt - 2); \
            unsigned vs[2][2]; \
            _Pragma("unroll") for (int h = 0; h < 2; ++h) _Pragma("unroll") for (int i = 0; i < 2; ++i) vs[h][i] = (GATHER && last) ? vn[h][i] : vc[h][i]; \
            const char* a1 = cA + (size_t)(t + 1) * kstep;                                             \
            const char* a2 = last ? nA : cA + (size_t)(t + 2) * kstep; const char* b2 = last ? nB : cB + (size_t)(t + 2) * kstep;     \
            const char* a3 = a2 + kstep; const char* b3 = b2 + kstep;                                \
            if (last && has_next) S.a_ready(nxt, ui + 1); \
            if constexpr (Epi::LDS_BIAS) { if (last && wid == 0) E.stage_bias(cur, lane); }     \
            if constexpr (Sched::PUBLISH) { if (t == 2 && ui > 0) S.publish(ppm, lane); }     \
            const bool rlx = (NS > 0) && (FIRST_) && (ui > 0); \
              \
            PG8_LDB(B0, 0, 0); PG8_LDB(B1, 0, 1); PG8_SCHED; PG8_LDA(At, 0, 0); if (!rlx) PG8_STAGE(PG8_SA(1, 1), a1, vc[1]); \
            PG8_WAIT_V8R; PG8_WAIT_L(0); PG8_BAR; MMAK_(0, 0, At, B0); MMAK_(0, 1, At, B1); PG8_BAR; PG8_SCHED; \
              \
            PG8_LDA(At, 0, 1); PG8_STAGE(PG8_SB(0, 0), b2, voffB); PG8_STAGE(PG8_SB(0, 1), b2 + hstep, voffB); PG8_STAGE(PG8_SA(0, 0), a2, vs[0]); \
            PG8_WAIT_V8R; PG8_WAIT_L(0); PG8_BAR; MMAK_(1, 0, At, B0); MMAK_(1, 1, At, B1); PG8_BAR; PG8_SCHED; \
              \
            PG8_LDB(B0, 1, 0); PG8_LDB(B1, 1, 1); PG8_SCHED; PG8_LDA(At, 1, 0); PG8_STAGE(PG8_SA(0, 1), a2, vs[1]); \
            PG8_WAIT_V8R; PG8_WAIT_L(0); PG8_BAR; PG8_MMA(0, 0, At, B0); PG8_MMA(0, 1, At, B1); PG8_BAR; PG8_SCHED; \
              \
            PG8_LDA(At, 1, 1); PG8_STAGE(PG8_SB(1, 0), b3, voffB); PG8_STAGE(PG8_SB(1, 1), b3 + hstep, voffB); PG8_STAGE(PG8_SA(1, 0), a3, vs[0]); \
            PG8_WAIT_V(8); PG8_WAIT_L(0); PG8_BAR; PG8_MMA(1, 0, At, B0); PG8_MMA(1, 1, At, B1); PG8_BAR; PG8_SCHED; }
        if constexpr (ZC) {
            { const int t = 0; PG8_TRIP(PG8_MMAZ, true) }
            for (int t = 2; t < nt; t += 2) PG8_TRIP(PG8_MMA, false)
        } else {
            for (int t = 0; t < nt; t += 2) PG8_TRIP(PG8_MMA, t == 0)
        }
#if KL_PROBE
        if (Sched::PUBLISH && S.probe_on() && blockIdx.x == 0 && wid == 0) { const unsigned long long t1_ = __builtin_amdgcn_s_memtime(); if (lane == 0) { PG8_LAS unsigned* kp = (PG8_LAS unsigned*)(unsigned)KLP_LDS; const unsigned long long d = t1_ - (((unsigned long long)kp[5] << 32) | kp[4]); const unsigned long long acc_ = (((unsigned long long)kp[1] << 32) | kp[0]) + d; kp[0] = (unsigned)acc_; kp[1] = (unsigned)(acc_ >> 32); kp[2] += 1u; } }
#endif
        if constexpr (ALIGN_EPI) { if (wr == 0) PG8_BAR; }
        if constexpr (NS > 0) { static_assert(SP2 && ALIGN_EPI, "NS needs SP2 and ALIGN_EPI"); if (has_next) PG8_STAGE(PG8_SA(1, 1), nA + kstep, vn[1]); }
        if constexpr (!Epi::AFTER_DRAIN) { E(acc, cur, wr, wc, fr, fq); S.done(cur); ppm = cur.pm; }
        if (!has_next) break;
        if constexpr (!ZC) {
#pragma unroll
        for (int a = 0; a < 2; ++a)
#pragma unroll
            for (int b = 0; b < 2; ++b)
#pragma unroll
                for (int m = 0; m < 4; ++m)
#pragma unroll
                    for (int n = 0; n < 2; ++n) acc[a][b][m][n] = (f32x4){0.f, 0.f, 0.f, 0.f};
        }
        cur = nxt; cA = nA; cB = nB; ++ui;
        if constexpr (GATHER) {
#pragma unroll
            for (int h = 0; h < 2; ++h)
#pragma unroll
                for (int i = 0; i < 2; ++i) vc[h][i] = vn[h][i]; }
        if constexpr (ALIGN_EPI) { if (wr == 1) PG8_BAR; }
    }
#if KL_PROBE
    if (Sched::PUBLISH && S.probe_on() && blockIdx.x == 0 && wid == 0) { const unsigned long long t1_ = __builtin_amdgcn_s_memtime(); if (lane == 0) { PG8_LAS unsigned* kp = (PG8_LAS unsigned*)(unsigned)KLP_LDS; const unsigned long long d = t1_ - (((unsigned long long)kp[7] << 32) | kp[6]); const unsigned long long acc_ = (((unsigned long long)kp[9] << 32) | kp[8]) + d; kp[8] = (unsigned)acc_; kp[9] = (unsigned)(acc_ >> 32); } }
#endif
    PG8_WAIT_V(0); if constexpr (Sched::PUBLISH) S.publish(ppm, lane);
    if constexpr (!ALIGN_EPI) { if (wr == 0) PG8_BAR; }
    PG8_BAR;
    if constexpr (Epi::AFTER_DRAIN) { E.fused(acc, cur, wr, wc, fr, fq, lds, wid, lane); S.done(cur); }
#undef PG8_SA
#undef PG8_SB
#undef PG8_STAGE
#undef PG8_LDA
#undef PG8_LDB
#undef PG8_MMA
#undef PG8_MMAZ
#undef PG8_TRIP
#undef PG8_WAIT_V
#undef PG8_WAIT_VN
#undef PG8_WAIT_V8R
#undef PG8_WAIT_L
#undef PG8_BAR
#undef PG8_SCHED
}
}


constexpr int D = 1024, NBATCH = 2, SEQ = 16384, NTOK = NBATCH * SEQ, CTXL = 256, NCTX = NBATCH * CTXL, MROWS = NTOK + NCTX;
constexpr int NHEAD = 8, DK = 128, NE = 32, TOPK = 4, CONVW = 31, GRIDW = 64, GRIDR = SEQ / GRIDW;
constexpr int NWAVES = 8, NTHR = NWAVES * 64;
constexpr int MAXTILES = 544;
constexpr float EPS = 1e-6f;
enum { I_X = 0, I_C, I_CTX, I_CCTX, I_WADA, I_BADA, I_GMIX, I_GFFN, I_WHIN, I_HGAMMA, I_GHOUT, I_WHOUT, I_WCVIN, I_BCVIN, I_WCVDW, I_BCVDW, I_GCVLN, I_BCVLN, I_WCVOUT, I_BCVOUT,
       I_WR, I_BR, I_WE1, I_BE1, I_WE2, I_BE2, I_GFINAL, N_IN };

constexpr size_t MiB = 1u << 20;
constexpr size_t WS_CTL = 0, CTL_ZERO_BYTES = 1 * MiB;
constexpr size_t WS_MODS = 1 * MiB;
constexpr size_t WS_TOPE = 2 * MiB, WS_TOPW = 2 * MiB + 512 * 1024, WS_POS = 3 * MiB, WS_BCNT = 3 * MiB + 512 * 1024, WS_TILEE = WS_BCNT + 64 * 1024, WS_SLOTW = 4 * MiB;
constexpr size_t WS_SP = 5 * MiB, WS_SD = 8 * MiB;
constexpr size_t WS_WIN = 48 * MiB, WS_WOUT = 58 * MiB, WS_WCVIN = 60 * MiB, WS_WCVOUT = 64 * MiB, WS_W1 = 66 * MiB, WS_W2 = 322 * MiB;
constexpr size_t WS_X = 450 * MiB;
constexpr size_t WS_H = 578 * MiB;
constexpr size_t WS_Q = 644 * MiB, WS_V = 709 * MiB, WS_SG = 774 * MiB, WS_LFF = 839 * MiB, WS_LFB = 969 * MiB, WS_OF = 1099 * MiB, WS_OB = 1227 * MiB, WS_YIN = 1355 * MiB;
constexpr size_t WS_AS = 1419 * MiB, WS_ACT = 1555 * MiB, WS_YS = 1691 * MiB, WS_END = 1963 * MiB;
#ifndef F8_IN
#define F8_IN 0
#endif
#ifndef SPLIT_IN
#define SPLIT_IN 1
#endif
#ifndef TL_PROBE
#define TL_PROBE 0
#define TL_A (-1)
#define TL_B 0
#define TL_BODY 0
#endif
#ifndef CVF_PROBE
#define CVF_PROBE 0
#endif
#ifndef G_F8
#define G_F8 1
#endif
#ifndef F8_Y
#define F8_Y 1
#endif
constexpr int YSCALE = 16;
#ifndef F8_MISC
#define F8_MISC 1
#endif
constexpr size_t WS_H8 = WS_OF + 64 * MiB;
constexpr size_t WS_WIN8 = WS_WIN + 6 * MiB;
constexpr size_t WS_STOK = WS_AS;
constexpr int CW_MODF = 3200;
constexpr int CW_FLAT = 3072;
constexpr int CW_GCNT = 2048;
constexpr float W8SCALE = 64.0f;
constexpr size_t WS_U = WS_Q, WS_ZP = WS_V, WS_Z = WS_SG;
constexpr int CW_BAR = 4096;
constexpr int CW_XMAP = 32768;
constexpr int CW_TCNT = 65536;

constexpr int RING_OFF = 0, RING_BYTES = 131072;
constexpr int LDSCTL_OFF = 139264, MISC_OFF = LDSCTL_OFF + 320, EXTRA_OFF = LDSCTL_OFF + 1024;
constexpr int LDS_BYTES = 155648;

#define LAS __attribute__((address_space(3)))
typedef unsigned short bf16;
typedef unsigned v4u __attribute__((ext_vector_type(4)));
typedef unsigned v2u __attribute__((ext_vector_type(2)));
typedef float f32x4 __attribute__((ext_vector_type(4)));
typedef int v4i __attribute__((ext_vector_type(4)));
#define LDS_WAIT() asm volatile("s_waitcnt lgkmcnt(0)" ::: "memory")
#define VM_WAIT() asm volatile("s_waitcnt vmcnt(0)" ::: "memory")
__device__ __forceinline__ unsigned f2bf(float f) { unsigned u = __builtin_bit_cast(unsigned, f); return (u + 0x7fffu + ((u >> 16) & 1u)) >> 16; }
__device__ __forceinline__ unsigned pk2(float lo, float hi) { return f2bf(lo) | (f2bf(hi) << 16); }
__device__ __forceinline__ float bf_lo(unsigned u) { return __builtin_bit_cast(float, u << 16); }
__device__ __forceinline__ float bf_hi(unsigned u) { return __builtin_bit_cast(float, u & 0xffff0000u); }
__device__ __forceinline__ float bf2f(bf16 h) { return __builtin_bit_cast(float, ((unsigned)h) << 16); }
__device__ __forceinline__ float fsig(float x) { return __builtin_amdgcn_rcpf(1.0f + __expf(-x)); }
__device__ __forceinline__ float wave_sum(float v) {
#define WS_DPP(x, ctrl) __builtin_bit_cast(float, __builtin_amdgcn_update_dpp(0, __builtin_bit_cast(int, x), ctrl, 0xF, 0xF, true))
    v += WS_DPP(v, 0xB1);
    v += WS_DPP(v, 0x4E);
    v += WS_DPP(v, 0x141);
    v += WS_DPP(v, 0x140);
#undef WS_DPP
    const int vi = __builtin_bit_cast(int, v);
    return (__builtin_bit_cast(float, __builtin_amdgcn_readlane(vi, 0)) + __builtin_bit_cast(float, __builtin_amdgcn_readlane(vi, 16)))
         + (__builtin_bit_cast(float, __builtin_amdgcn_readlane(vi, 32)) + __builtin_bit_cast(float, __builtin_amdgcn_readlane(vi, 48)));
}

__device__ __forceinline__ float half_sum(float v) {
#define WS_DPP(x, ctrl) __builtin_bit_cast(float, __builtin_amdgcn_update_dpp(0, __builtin_bit_cast(int, x), ctrl, 0xF, 0xF, true))
    v += WS_DPP(v, 0xB1); v += WS_DPP(v, 0x4E); v += WS_DPP(v, 0x141); v += WS_DPP(v, 0x140);
#undef WS_DPP
    return v + __shfl_xor(v, 16);
}
__device__ __forceinline__ float sat8(float x) { return __builtin_amdgcn_fmed3f(x, -448.0f, 448.0f); }
__device__ __forceinline__ unsigned pk4_fp8(float a, float b, float c, float d) { int w = 0; w = __builtin_amdgcn_cvt_pk_fp8_f32(sat8(a), sat8(b), w, false); w = __builtin_amdgcn_cvt_pk_fp8_f32(sat8(c), sat8(d), w, true); return (unsigned)w; }
template <bool OUT8> __device__ __forceinline__ void store_row4(void* orow, int lane, int j, f32x4 y, float scale) {
    if constexpr (OUT8) ((unsigned*)orow)[lane + 64 * j] = pk4_fp8(y.x * scale, y.y * scale, y.z * scale, y.w * scale);
    else { v2u w; w.x = pk2(y.x, y.y); w.y = pk2(y.z, y.w); ((v2u*)orow)[lane + 64 * j] = w; }
}

#define XB_TMO      128
#define XB_XCNT(j)  (256  + 64 * (j))
#define XB_XSUB(j)  (1280 + 64 * (j))
#define XB_XGEN(j)  (2304 + 64 * (j))
#define XB_TOP      3328
#define XB_TOPGEN   3392
#define XCD_BAR_WORDS 3456
#define XB_SPIN_CAP (1u << 18)

__device__ __forceinline__ unsigned xb_ld(unsigned* p)              { return __hip_atomic_load(p, __ATOMIC_RELAXED, __HIP_MEMORY_SCOPE_AGENT); }
__device__ __forceinline__ unsigned xb_add(unsigned* p, unsigned v) { return __hip_atomic_fetch_add(p, v, __ATOMIC_RELAXED, __HIP_MEMORY_SCOPE_AGENT); }
__device__ __forceinline__ unsigned xb_xcc_id() { return (unsigned)__builtin_amdgcn_s_getreg((3 << 11) | 20) & 0xFu; }
#define XB_SPIN(cond, bar) do { unsigned _sp = 0; while (cond) { __builtin_amdgcn_s_sleep(1); \
    if ((++_sp & 255u) == 0u) { if (xb_ld(&(bar)[XB_TMO])) break; if (_sp > XB_SPIN_CAP) { atomicAdd(&(bar)[XB_TMO], 1u); break; } } } } while (0)

struct XcdBarrier {
    unsigned* bar; unsigned x;
    volatile LAS unsigned* st;
};

__device__ __forceinline__ XcdBarrier xcd_barrier_post(unsigned* bar, volatile LAS unsigned* st) {
    XcdBarrier b; b.bar = bar; b.x = xb_xcc_id(); b.st = st;
    if (threadIdx.x == 0) (void)xb_add(&bar[XB_XCNT(b.x)], 1u);
    return b;
}
__device__ __forceinline__ void xcd_barrier_complete(unsigned* bar, unsigned x, unsigned& nloc, unsigned& nx) {
    const unsigned G = gridDim.x * gridDim.y * gridDim.z;
    unsigned sum, cnt, mine, sp = 0u;
    for (;;) {
        sum = 0u; cnt = 0u; mine = 0u;
#pragma unroll
        for (unsigned j = 0; j < 16; ++j) { const unsigned c = xb_ld(&bar[XB_XCNT(j)]); sum += c; cnt += (c > 0u) ? 1u : 0u; mine = (j == x) ? c : mine; }
        if (sum == G) break;
        __builtin_amdgcn_s_sleep(1);
        if ((++sp & 255u) == 0u) { if (xb_ld(&bar[XB_TMO])) break; if (sp > XB_SPIN_CAP) { atomicAdd(&bar[XB_TMO], 1u); break; } }
    }
    nloc = mine > 0u ? mine : 1u; nx = cnt > 0u ? cnt : 1u;
}

__device__ __forceinline__ void xcd_barrier(const XcdBarrier& b) {
    asm volatile("s_waitcnt vmcnt(0)" ::: "memory");
    __syncthreads();
    if (threadIdx.x == 0) {
        unsigned* bar = b.bar;
        __builtin_amdgcn_s_waitcnt(0);
        unsigned nloc = b.st[0], nx = b.st[1];
        if (nloc == 0u) { xcd_barrier_complete(bar, b.x, nloc, nx); b.st[0] = nloc; b.st[1] = nx; }
        const unsigned old = xb_add(&bar[XB_XSUB(b.x)], 1u);
        const unsigned gen = old / nloc;
        if (old + 1u == (gen + 1u) * nloc) {
            __builtin_amdgcn_fence(__ATOMIC_RELEASE, "agent");
            asm volatile("s_waitcnt vmcnt(0)" ::: "memory");
            const unsigned og = xb_add(&bar[XB_TOP], 1u);
            const unsigned tg = og / nx;
            if (og + 1u == (tg + 1u) * nx) xb_add(&bar[XB_TOPGEN], 1u);
            else XB_SPIN(xb_ld(&bar[XB_TOPGEN]) == tg, bar);
            __builtin_amdgcn_fence(__ATOMIC_ACQUIRE, "agent");
            xb_add(&bar[XB_XGEN(b.x)], 1u);
            asm volatile("s_waitcnt vmcnt(0)" ::: "memory");
        } else {
            XB_SPIN(xb_ld(&bar[XB_XGEN(b.x)]) == gen, bar);
            __builtin_amdgcn_fence(__ATOMIC_ACQUIRE, "agent");
            asm volatile("s_waitcnt vmcnt(0)" ::: "memory");
        }
    }
    __syncthreads();
}

struct Args { const float* in[N_IN]; float* out; unsigned char* ws; int ph_lo, ph_hi, li, pad; };

__device__ __forceinline__ void p_mods(const Args& a, LAS unsigned char* lds, int tid, int lane, int wave) {
    LAS float* sc = (LAS float*)lds;
    LAS float* part = sc + 3 * D;
    float* MODS = (float*)(a.ws + WS_MODS);
    for (int i = tid; i < 3 * D; i += NTHR) { const int r = i >> 10, k = i & 1023; const float v = r < 2 ? a.in[I_C][r * D + k] : a.in[I_CCTX][k]; sc[i] = v * fsig(v); }
    __syncthreads();
    for (int item = blockIdx.x; item < 2 * 96; item += gridDim.x) {
        const int l = item / 96, cb = item % 96;
        const float* W = a.in[I_WADA] + (size_t)l * D * 6 * D + cb * 64 + lane;
        float a0 = 0.f, a1 = 0.f, a2 = 0.f;
#pragma unroll 16
        for (int kk = 0; kk < 128; ++kk) { const int k = wave * 128 + kk; const float w = W[(size_t)k * (6 * D)]; a0 += sc[k] * w; a1 += sc[D + k] * w; a2 += sc[2 * D + k] * w; }
        part[(wave * 3 + 0) * 64 + lane] = a0; part[(wave * 3 + 1) * 64 + lane] = a1; part[(wave * 3 + 2) * 64 + lane] = a2;
        __syncthreads();
        if (tid < 192) { const int r = tid >> 6, ln = tid & 63; float s = 0.f;
#pragma unroll
            for (int w = 0; w < 8; ++w) s += part[(w * 3 + r) * 64 + ln];
            __hip_atomic_store(&MODS[(size_t)(l * 3 + r) * (6 * D) + cb * 64 + ln], s + a.in[I_BADA][l * 6 * D + cb * 64 + ln], __ATOMIC_RELAXED, __HIP_MEMORY_SCOPE_AGENT); }
        asm volatile("s_waitcnt vmcnt(0)" ::: "memory");
        __syncthreads();
        if (item < 32 && tid == 0) (void)__hip_atomic_fetch_add((unsigned*)(a.ws + WS_CTL) + CW_MODF, 1u, __ATOMIC_RELAXED, __HIP_MEMORY_SCOPE_AGENT);
    }
}
__device__ __forceinline__ void wait_mods0(const Args& a, int tid) {
    if (tid == 0) { unsigned* f = (unsigned*)(a.ws + WS_CTL) + CW_MODF; unsigned sp = 0;
        while (__hip_atomic_load(f, __ATOMIC_RELAXED, __HIP_MEMORY_SCOPE_AGENT) < 32u) { __builtin_amdgcn_s_sleep(2); if (++sp > (1u << 22)) break; }
        __builtin_amdgcn_fence(__ATOMIC_ACQUIRE, "agent");
        asm volatile("s_waitcnt vmcnt(0)" ::: "memory"); }
    __syncthreads();
}
template <bool OUT8> __device__ __forceinline__ void transpose_item(const float* W, int K, int N, bf16* WT, bool paired, LAS float* scr, int item, int lane, int row_adj = 0) {
    const int nblk = N / 32, kb = item / nblk, nb = item % nblk, k0 = 64 * kb, n0 = 32 * nb;
    int d0 = n0 + row_adj; if (paired) { const int half = n0 >> 10, c = n0 & 1023; d0 = (c >> 7) * 256 + half * 128 + (c & 127); }
    float t[32];
#pragma unroll
    for (int i = 0; i < 32; ++i) { const int kk = 2 * i + (lane >> 5); t[i] = __builtin_nontemporal_load(&W[(size_t)(k0 + kk) * N + n0 + (lane & 31)]); }
#pragma unroll
    for (int i = 0; i < 32; ++i) { const int kk = 2 * i + (lane >> 5); scr[kk * 33 + (lane & 31)] = t[i]; }
    LDS_WAIT(); asm volatile("" ::: "memory");
    const int c = lane & 7;
#pragma unroll
    for (int j = 0; j < 4; ++j) { const int n = (lane >> 3) + 8 * j; const LAS float* s = scr + (8 * c) * 33 + n;
        if constexpr (OUT8) {
            int w0 = 0, w1 = 0;
            w0 = __builtin_amdgcn_cvt_pk_fp8_f32(s[0 * 33] * W8SCALE, s[1 * 33] * W8SCALE, w0, false); w0 = __builtin_amdgcn_cvt_pk_fp8_f32(s[2 * 33] * W8SCALE, s[3 * 33] * W8SCALE, w0, true);
            w1 = __builtin_amdgcn_cvt_pk_fp8_f32(s[4 * 33] * W8SCALE, s[5 * 33] * W8SCALE, w1, false); w1 = __builtin_amdgcn_cvt_pk_fp8_f32(s[6 * 33] * W8SCALE, s[7 * 33] * W8SCALE, w1, true);
            *(v2u*)((unsigned char*)WT + (size_t)(d0 + n) * K + k0 + 8 * c) = (v2u){(unsigned)w0, (unsigned)w1};
        } else {
        v4u o; o.x = pk2(s[0 * 33], s[1 * 33]); o.y = pk2(s[2 * 33], s[3 * 33]); o.z = pk2(s[4 * 33], s[5 * 33]); o.w = pk2(s[6 * 33], s[7 * 33]);
        *(v4u*)(WT + (size_t)(d0 + n) * K + k0 + 8 * c) = o; } }
    LDS_WAIT(); asm volatile("" ::: "memory");
}
__device__ __forceinline__ void p_weights(const Args& a, LAS unsigned char* lds, int lane, int wave) {
    LAS float* scr = (LAS float*)(lds + RING_OFF + wave * 16384);
    const int gw = blockIdx.x * NWAVES + wave, NGW = gridDim.x * NWAVES;
    constexpr int I_IN = 16 * 160, I_SQ = 16 * 32, I_CV = 16 * 64, I_E1 = 64 * 1024, I_E2 = 64 * 512;
    constexpr int NITEMS = I_IN + I_SQ + I_CV + I_SQ + I_E1 + I_E2;
    unsigned char* ws = a.ws;
    for (int it = (gridDim.x == 256 ? I_E1 + I_E2 : 0) + gw; it < NITEMS; it += NGW) {
        int r = it;
        if (r < I_E1) { const int mi = r >> 10; transpose_item<true>(a.in[I_WE1] + (size_t)mi * D * 2 * D, D, 2 * D, (bf16*)(ws + WS_W1 + (size_t)mi * 2 * D * D), true, scr, r & 1023, lane); continue; } r -= I_E1;
        if (r < I_E2) { const int mi = r >> 9; transpose_item<true>(a.in[I_WE2] + (size_t)mi * D * D, D, D, (bf16*)(ws + WS_W2 + (size_t)mi * D * D), false, scr, r & 511, lane); continue; } r -= I_E2;
        if (r < I_IN) {
            if (SPLIT_IN) { const int sgm = ((r % 160) * 32) >> 10;
                if (sgm == 2 || sgm == 3 || (G_F8 && sgm == 4)) transpose_item<true>(a.in[I_WHIN], D, 5 * D, (bf16*)(ws + WS_WIN8), false, scr, r, lane, -2 * D);
                else transpose_item<false>(a.in[I_WHIN], D, 5 * D, (bf16*)(ws + WS_WIN), false, scr, r, lane, sgm == 4 ? -2 * D : 0);
            } else transpose_item<F8_IN != 0>(a.in[I_WHIN], D, 5 * D, (bf16*)(ws + WS_WIN), false, scr, r, lane);
            continue; } r -= I_IN;
        if (r < I_SQ) { transpose_item<F8_MISC != 0>(a.in[I_WHOUT], D, D, (bf16*)(ws + WS_WOUT), false, scr, r, lane); continue; } r -= I_SQ;
        if (r < I_CV) { transpose_item<F8_MISC != 0>(a.in[I_WCVIN], D, 2 * D, (bf16*)(ws + WS_WCVIN), true, scr, r, lane); continue; } r -= I_CV;
        transpose_item<F8_MISC != 0>(a.in[I_WCVOUT], D, D, (bf16*)(ws + WS_WCVOUT), false, scr, r, lane);
    }
}
constexpr int CV_WAVES = 7, CV_L0 = 32 * 512 + 32 * 256, CV_ALL = 2 * CV_L0;
__device__ __forceinline__ void transpose_item64(const float* W, int K, int N, unsigned char* WT, bool paired, LAS float* scr, int item, int lane) {
    const int nblk = N / 64, kb = item / nblk, nb = item % nblk, k0 = 64 * kb, n0 = 64 * nb;
    int d0 = n0; if (paired) { const int half = n0 >> 10, c = n0 & 1023; d0 = (c >> 7) * 256 + half * 128 + (c & 127); }
    float t[64];
#pragma unroll
    for (int i = 0; i < 64; ++i) t[i] = __builtin_nontemporal_load(&W[(size_t)(k0 + i) * N + n0 + lane]);
#pragma unroll
    for (int i = 0; i < 64; ++i) scr[i * 65 + lane] = t[i];
    LDS_WAIT(); asm volatile("" ::: "memory");
    const int c = lane & 3;
#pragma unroll
    for (int j = 0; j < 4; ++j) { const int n = (lane >> 2) + 16 * j; const LAS float* s = scr + (16 * c) * 65 + n;
        v4u o;
        o.x = pk4_fp8(s[0 * 65] * W8SCALE, s[1 * 65] * W8SCALE, s[2 * 65] * W8SCALE, s[3 * 65] * W8SCALE); o.y = pk4_fp8(s[4 * 65] * W8SCALE, s[5 * 65] * W8SCALE, s[6 * 65] * W8SCALE, s[7 * 65] * W8SCALE);
        o.z = pk4_fp8(s[8 * 65] * W8SCALE, s[9 * 65] * W8SCALE, s[10 * 65] * W8SCALE, s[11 * 65] * W8SCALE); o.w = pk4_fp8(s[12 * 65] * W8SCALE, s[13 * 65] * W8SCALE, s[14 * 65] * W8SCALE, s[15 * 65] * W8SCALE);
        *(v4u*)(WT + (size_t)(d0 + n) * K + k0 + 16 * c) = o; }
    LDS_WAIT(); asm volatile("" ::: "memory");
}
__device__ __forceinline__ void cv_do_item(const Args& a, LAS float* scr, int g, int lane) {
    const int l = g >= CV_L0 ? 1 : 0; const int r = g - l * CV_L0;
    if (r < 32 * 512) { const int mi = l * 32 + (r >> 9); transpose_item64(a.in[I_WE1] + (size_t)mi * D * 2 * D, D, 2 * D, a.ws + WS_W1 + (size_t)mi * 2 * D * D, true, scr, r & 511, lane); }
    else { const int r2 = r - 32 * 512; const int mi = l * 32 + (r2 >> 8); transpose_item64(a.in[I_WE2] + (size_t)mi * D * D, D, D, a.ws + WS_W2 + (size_t)mi * D * D, false, scr, r2 & 255, lane); }
}
__device__ __forceinline__ void cv_finish(const Args& a, LAS unsigned char* lds, int wave, int lane, int& cv_n, int limit) {
    if (gridDim.x == 256 && wave >= 1 && wave <= CV_WAVES) {
        const int ww = blockIdx.x * CV_WAVES + (wave - 1), NW = 256 * CV_WAVES; LAS float* scr = (LAS float*)(lds + RING_OFF + wave * 16640);
#if CVF_PROBE
        const unsigned long long t0_ = __builtin_amdgcn_s_memrealtime();
#endif
        for (;;) { const int g = cv_n * NW + ww; if (g >= limit) break; cv_do_item(a, scr, g, lane); ++cv_n; }
#if CVF_PROBE
        if (blockIdx.x == 0 && wave == 1 && lane == 0) { asm volatile("s_waitcnt vmcnt(0)" ::: "memory"); ((volatile LAS unsigned*)(lds + MISC_OFF))[40] += (unsigned)(__builtin_amdgcn_s_memrealtime() - t0_); }
#endif
    }
}
__device__ __forceinline__ void xcd_barrier_work(const XcdBarrier& b, const Args& a, LAS unsigned char* lds, int wave, int lane, int& cv_n, volatile LAS unsigned* flag, unsigned seq) {
    asm volatile("s_waitcnt vmcnt(0)" ::: "memory");
    __syncthreads();
    if (wave == 0) {
        if (threadIdx.x == 0) {
            unsigned* bar = b.bar;
            __builtin_amdgcn_s_waitcnt(0);
            unsigned nloc = b.st[0], nx = b.st[1];
            if (nloc == 0u) { xcd_barrier_complete(bar, b.x, nloc, nx); b.st[0] = nloc; b.st[1] = nx; }
            const unsigned old = xb_add(&bar[XB_XSUB(b.x)], 1u);
            const unsigned gen = old / nloc;
            if (old + 1u == (gen + 1u) * nloc) {
                __builtin_amdgcn_fence(__ATOMIC_RELEASE, "agent");
                asm volatile("s_waitcnt vmcnt(0)" ::: "memory");
                const unsigned og = xb_add(&bar[XB_TOP], 1u);
                const unsigned tg = og / nx;
                if (og + 1u == (tg + 1u) * nx) xb_add(&bar[XB_TOPGEN], 1u);
                else XB_SPIN(xb_ld(&bar[XB_TOPGEN]) == tg, bar);
                __builtin_amdgcn_fence(__ATOMIC_ACQUIRE, "agent");
                xb_add(&bar[XB_XGEN(b.x)], 1u);
                asm volatile("s_waitcnt vmcnt(0)" ::: "memory");
            } else {
                XB_SPIN(xb_ld(&bar[XB_XGEN(b.x)]) == gen, bar);
                __builtin_amdgcn_fence(__ATOMIC_ACQUIRE, "agent");
                asm volatile("s_waitcnt vmcnt(0)" ::: "memory");
            }
            flag[0] = seq;
        }
    } else if (gridDim.x == 256 && wave <= CV_WAVES) {
        const int ww = blockIdx.x * CV_WAVES + (wave - 1), NW = 256 * CV_WAVES; LAS float* scr = (LAS float*)(lds + RING_OFF + wave * 16640);
        for (;;) { const int g = cv_n * NW + ww; if (g >= CV_ALL) break; if (flag[0] == seq) break; cv_do_item(a, scr, g, lane); ++cv_n; }
        asm volatile("s_waitcnt vmcnt(0)" ::: "memory");
    }
    __syncthreads();
}
__device__ __forceinline__ void flat_barrier_work(unsigned* cnt, const Args& a, LAS unsigned char* lds, int wave, int lane, int& cv_n, volatile LAS unsigned* flag, unsigned seq) {
    asm volatile("s_waitcnt vmcnt(0)" ::: "memory");
    __syncthreads();
    if (wave == 0) {
        if (threadIdx.x == 0) {
            __builtin_amdgcn_s_waitcnt(0);
            __builtin_amdgcn_fence(__ATOMIC_RELEASE, "agent");
            asm volatile("s_waitcnt vmcnt(0)" ::: "memory");
            (void)__hip_atomic_fetch_add(cnt, 1u, __ATOMIC_RELAXED, __HIP_MEMORY_SCOPE_AGENT);
            const unsigned target = gridDim.x * seq; unsigned sp = 0;
            while (__hip_atomic_load(cnt, __ATOMIC_RELAXED, __HIP_MEMORY_SCOPE_AGENT) < target) { __builtin_amdgcn_s_sleep(1); if (++sp > (1u << 22)) break; }
            __builtin_amdgcn_fence(__ATOMIC_ACQUIRE, "agent");
            asm volatile("s_waitcnt vmcnt(0)" ::: "memory");
            flag[0] = seq;
        }
    } else if (gridDim.x == 256 && wave <= CV_WAVES) {
        const int ww = blockIdx.x * CV_WAVES + (wave - 1), NW = 256 * CV_WAVES; LAS float* scr = (LAS float*)(lds + RING_OFF + wave * 16640);
        for (;;) { const int g = cv_n * NW + ww; if (g >= CV_ALL) break; if (flag[0] == seq) break; cv_do_item(a, scr, g, lane); ++cv_n; }
        asm volatile("s_waitcnt vmcnt(0)" ::: "memory");
    }
    __syncthreads();
}
template <bool OUT8> __device__ __forceinline__ void norm_mod_store(f32x4 (&v)[4], const float* g, const float* sc, const float* sh, void* orow, int lane) {
    float s = 0.f;
#pragma unroll
    for (int j = 0; j < 4; ++j) s += (v[j].x * v[j].x + v[j].y * v[j].y) + (v[j].z * v[j].z + v[j].w * v[j].w);
    const float r = 1.0f / sqrtf(wave_sum(s) * (1.0f / D) + EPS);
#pragma unroll
    for (int j = 0; j < 4; ++j) { const f32x4 gg = ((const f32x4*)g)[lane + 64 * j], ss = ((const f32x4*)sc)[lane + 64 * j], hh = ((const f32x4*)sh)[lane + 64 * j];
        const f32x4 y = (v[j] * r * gg) * (ss + 1.0f) + hh; v[j] = y;
        store_row4<OUT8>(orow, lane, j, y, 1.0f); }
}
__device__ __forceinline__ void p_norm0(const Args& a, int lane, int gw, int NGW, int m_begin, int m_end) {
    const float* MODS = (const float*)(a.ws + WS_MODS); bf16* H = (bf16*)(a.ws + WS_H);
    for (int m0 = m_begin + gw * 2; m0 < m_end; m0 += NGW * 2) {
        f32x4 v[2][4]; int rr[2];
#pragma unroll
        for (int r = 0; r < 2; ++r) { const int m = m0 + r; const float* xr;
            if (m < NTOK) { xr = a.in[I_X] + (size_t)m * D; rr[r] = m / SEQ; } else { xr = a.in[I_CTX] + (size_t)(m - NTOK) * D; rr[r] = 2; }
#pragma unroll
            for (int j = 0; j < 4; ++j) v[r][j] = __builtin_nontemporal_load(&((const f32x4*)xr)[lane + 64 * j]); }
#pragma unroll
        for (int r = 0; r < 2; ++r) { const float* md = MODS + (size_t)rr[r] * 6 * D;
            norm_mod_store<F8_IN != 0>(v[r], a.in[I_GMIX], md + 1 * D, md + 0 * D, (unsigned char*)H + (size_t)(m0 + r) * D * (F8_IN ? 1 : 2), lane);
            if (SPLIT_IN) {
#pragma unroll
                for (int j = 0; j < 4; ++j) store_row4<true>(a.ws + WS_H8 + (size_t)(m0 + r) * D, lane, j, v[r][j], 1.0f); } }
    }
}
__device__ __forceinline__ void p_scan_naive(const Args& a, LAS unsigned char* lds, int tid) {
    LAS float* sf = (LAS float*)lds;
    LAS float* sq = sf + 64 * 128;
    LAS float* sv = sq + 64 * 128;
    LAS float* so = sv + 64 * 16;
    const bf16* Q = (const bf16*)(a.ws + WS_Q); const bf16* V = (const bf16*)(a.ws + WS_V);
    const int vl = tid >> 5, kq = tid & 31;
    for (int unit = blockIdx.x; unit < 256; unit += gridDim.x) {
        const int chain = unit >> 3, vb = unit & 7, b = chain >> 4, h = (chain >> 1) & 7, dir = chain & 1;
        const float* LF = (const float*)(a.ws + (dir ? WS_LFB : WS_LFF)); float* O = (float*)(a.ws + (dir ? WS_OB : WS_OF));
        float S0 = 0.f, S1 = 0.f, S2 = 0.f, S3 = 0.f;
        for (int blk = 0; blk < 260; ++blk) {
            const bool isctx = blk < 4; int base, step;
            if (!dir) { base = isctx ? (NTOK + b * CTXL + blk * 64) : (b * SEQ + (blk - 4) * 64); step = 1; }
            else { base = isctx ? (NTOK + b * CTXL + CTXL - 1 - blk * 64) : (b * SEQ + SEQ - 1 - (blk - 4) * 64); step = -1; }
            for (int e = tid; e < 64 * 128; e += NTHR) { const int i = e >> 7, k = e & 127; const size_t off = (size_t)(base + step * i) * D + h * DK + k; sf[e] = __expf(LF[off]); sq[e] = bf2f(Q[off]); }
            for (int e = tid; e < 64 * 16; e += NTHR) { const int i = e >> 4, vv = e & 15; sv[e] = bf2f(V[(size_t)(base + step * i) * D + h * DK + vb * 16 + vv]); }
            __syncthreads();
            for (int i = 0; i < 64; ++i) {
                const f32x4 f = *(const LAS f32x4*)(sf + i * 128 + kq * 4), q = *(const LAS f32x4*)(sq + i * 128 + kq * 4); const float vv = sv[i * 16 + vl];
                S0 = f.x * S0 + (1.0f - f.x) * vv; S1 = f.y * S1 + (1.0f - f.y) * vv; S2 = f.z * S2 + (1.0f - f.z) * vv; S3 = f.w * S3 + (1.0f - f.w) * vv;
                float p = (S0 * q.x + S1 * q.y) + (S2 * q.z + S3 * q.w);
                p += __shfl_xor(p, 1); p += __shfl_xor(p, 2); p += __shfl_xor(p, 4); p += __shfl_xor(p, 8); p += __shfl_xor(p, 16);
                if (kq == 0) so[i * 16 + vl] = p;
            }
            __syncthreads();
            if (!isctx) for (int e = tid; e < 64 * 16; e += NTHR) { const int i = e >> 4, vv = e & 15; O[(size_t)(base + step * i) * D + h * DK + vb * 16 + vv] = so[e]; }
            __syncthreads();
        }
    }
}
constexpr int SC_QT = 0, SC_KU = 4352, SC_KB = 8704, SC_VT = 12800, SC_ET = 16896, SC_SUB = 17408, SC_BUF = 4 * SC_SUB;
constexpr int NSLOT = 17;
typedef short s16x4 __attribute__((ext_vector_type(4)));
typedef short s16x8 __attribute__((ext_vector_type(8)));
struct ScanUnit { int h, rowbase, sgn, nchunks, chain, slot; };
__device__ __forceinline__ ScanUnit scan_unit(int b, int h, int dir, int slot) {
    ScanUnit u; u.h = h; u.sgn = dir ? -1 : 1; u.chain = (b * NHEAD + h) * 2 + dir; u.slot = slot;
    if (slot == 0) { u.rowbase = NTOK + b * CTXL + (dir ? CTXL - 1 : 0); u.nchunks = CTXL / 64; }
    else { const int so = (slot - 1) * 1024; u.rowbase = b * SEQ + (dir ? SEQ - 1 - so : so); u.nchunks = 16; }
    return u;
}
typedef float f32x2_t __attribute__((ext_vector_type(2)));
typedef __bf16 bf16x2_t __attribute__((ext_vector_type(2)));
__device__ __forceinline__ unsigned cvtpk(float lo, float hi) { const f32x2_t f = {lo, hi}; return __builtin_bit_cast(unsigned, __builtin_convertvector(f, bf16x2_t)); }
template <bool FULL> __device__ __forceinline__ void scan_load(const ScanUnit& u, int pos0, const bf16* LF, const bf16* Q, const bf16* V, int k, int i, unsigned (&lf)[16], unsigned (&qr)[16], unsigned (&vr)[16]) {
#pragma unroll
    for (int t = 0; t < 16; ++t) {
        const unsigned o = (unsigned)(u.rowbase + u.sgn * (pos0 + 16 * i + t)) * D + u.h * DK + k;
        lf[t] = LF[o]; vr[t] = V[o]; if (FULL) qr[t] = Q[o];
    }
}
template <bool FULL> __device__ __forceinline__ float scan_prep(LAS unsigned char* buf, int k, int i, const unsigned (&lfr)[16], const unsigned (&qr)[16], const unsigned (&vr)[16]) {
    LAS unsigned char* sb = buf + i * SC_SUB;
    float f[16], pre[16], suf[16]; float T = 0.f;
#pragma unroll
    for (int t = 0; t < 16; ++t) { const float lf = (float)__builtin_bit_cast(_Float16, (unsigned short)lfr[t]); T += lf; f[t] = __builtin_amdgcn_exp2f(lf); }
    pre[0] = f[0];
#pragma unroll
    for (int t = 1; t < 16; ++t) pre[t] = pre[t - 1] * f[t];
    suf[15] = 1.0f;
#pragma unroll
    for (int t = 14; t >= 0; --t) suf[t] = suf[t + 1] * f[t + 1];
    unsigned kbw[8], vtw[8], qqw[8], kuw[8];
    const float invp = __builtin_amdgcn_rcpf(fmaxf(pre[15], 1e-30f));
#pragma unroll
    for (int t = 0; t < 16; t += 2) {
        const float kk0 = 1.0f - f[t], kk1 = 1.0f - f[t + 1];
        kbw[t >> 1] = cvtpk(kk0 * suf[t], kk1 * suf[t + 1]);
        vtw[t >> 1] = vr[t] | (vr[t + 1] << 16);
        if (FULL) {
            qqw[t >> 1] = cvtpk(__builtin_bit_cast(float, qr[t] << 16) * pre[t], __builtin_bit_cast(float, qr[t + 1] << 16) * pre[t + 1]);
            kuw[t >> 1] = cvtpk(kk0 * suf[t] * invp, kk1 * suf[t + 1] * invp);
        }
    }
    if (FULL) {
        const int rho = k ^ (((k >> 3) & 1) << 2);
        *(LAS v4u*)(sb + SC_QT + rho * 32) = (v4u){qqw[0], qqw[1], qqw[2], qqw[3]}; *(LAS v4u*)(sb + SC_QT + rho * 32 + 16) = (v4u){qqw[4], qqw[5], qqw[6], qqw[7]};
        *(LAS v4u*)(sb + SC_KU + rho * 32) = (v4u){kuw[0], kuw[1], kuw[2], kuw[3]}; *(LAS v4u*)(sb + SC_KU + rho * 32 + 16) = (v4u){kuw[4], kuw[5], kuw[6], kuw[7]};
    }
    *(LAS v4u*)(sb + SC_KB + k * 32) = (v4u){kbw[0], kbw[1], kbw[2], kbw[3]}; *(LAS v4u*)(sb + SC_KB + k * 32 + 16) = (v4u){kbw[4], kbw[5], kbw[6], kbw[7]};
    *(LAS v4u*)(sb + SC_VT + k * 32) = (v4u){vtw[0], vtw[1], vtw[2], vtw[3]}; *(LAS v4u*)(sb + SC_VT + k * 32 + 16) = (v4u){vtw[4], vtw[5], vtw[6], vtw[7]};
    *(LAS float*)(sb + SC_ET + 4 * k) = pre[15];
    return T;
}
__device__ __forceinline__ f32x4 mfma_k16(s16x4 a, s16x4 b, f32x4 c) {
    const v2u av = __builtin_bit_cast(v2u, a), bv = __builtin_bit_cast(v2u, b);
    return __builtin_amdgcn_mfma_f32_16x16x32_bf16(__builtin_bit_cast(s16x8, (v4u){av.x, av.y, 0u, 0u}), __builtin_bit_cast(s16x8, (v4u){bv.x, bv.y, 0u, 0u}), c, 0, 0, 0);
}
template <bool FULL> __device__ __forceinline__ void scan_compute2(const LAS unsigned char* buf, int wq, int lane, f32x4 (&S)[2][8], bf16* Ocol, const ScanUnit& u, int pos0) {
    const int fr = lane & 15, g = lane >> 4;
#pragma unroll
    for (int i = 0; i < 2; ++i) {
        const LAS unsigned char* sb = buf + i * SC_SUB;
        const s16x4 vt0 = *(const LAS s16x4*)(sb + SC_VT + (32 * wq + fr) * 32 + 8 * g), vt1 = *(const LAS s16x4*)(sb + SC_VT + (32 * wq + 16 + fr) * 32 + 8 * g);
        s16x8 ka[4], qa[4]; f32x4 et[8]; s16x4 kb[8];
        if (FULL) {
            const int q_ = (lane & 15) >> 2, p_ = lane & 3;
            const LAS unsigned char* b0_ = sb + (8 * g + q_) * 32 + p_ * 8 + 128 * (g & 1);
            const LAS unsigned char* b1_ = sb + (8 * g + q_) * 32 + p_ * 8 + 128 * (1 - (g & 1));
#pragma unroll
            for (int c = 0; c < 4; ++c) {
                const s16x4 k0_ = __builtin_amdgcn_ds_read_tr16_b64_v4i16((LAS s16x4*)(b0_ + SC_KU + 1024 * c)), k1_ = __builtin_amdgcn_ds_read_tr16_b64_v4i16((LAS s16x4*)(b1_ + SC_KU + 1024 * c));
                const s16x4 q0_ = __builtin_amdgcn_ds_read_tr16_b64_v4i16((LAS s16x4*)(b0_ + SC_QT + 1024 * c)), q1_ = __builtin_amdgcn_ds_read_tr16_b64_v4i16((LAS s16x4*)(b1_ + SC_QT + 1024 * c));
                ka[c] = __builtin_shufflevector(k0_, k1_, 0, 1, 2, 3, 4, 5, 6, 7); qa[c] = __builtin_shufflevector(q0_, q1_, 0, 1, 2, 3, 4, 5, 6, 7); }
        }
#pragma unroll
        for (int j = 0; j < 8; ++j) { et[j] = *(const LAS f32x4*)(sb + SC_ET + (32 * (j >> 1) + 8 * g + 4 * (j & 1)) * 4); kb[j] = *(const LAS s16x4*)(sb + SC_KB + (32 * (j >> 1) + 8 * (fr >> 2) + 4 * (j & 1) + (fr & 3)) * 32 + 8 * g); }
        __builtin_amdgcn_sched_barrier(0);
        if (FULL) {
            f32x4 aT = (f32x4){0.f, 0.f, 0.f, 0.f};
#pragma unroll
            for (int c = 0; c < 4; ++c) aT = __builtin_amdgcn_mfma_f32_16x16x32_bf16(ka[c], qa[c], aT, 0, 0, 0);
#pragma unroll
            for (int r = 0; r < 4; ++r) if (4 * g + r > fr) aT[r] = 0.f;
            const s16x4 ab = __builtin_bit_cast(s16x4, (v2u){cvtpk(aT[0], aT[1]), cvtpk(aT[2], aT[3])});
            f32x4 o0 = mfma_k16(vt0, ab, (f32x4){0.f, 0.f, 0.f, 0.f}), o1 = mfma_k16(vt1, ab, (f32x4){0.f, 0.f, 0.f, 0.f});
#pragma unroll
            for (int c = 0; c < 4; ++c) {
                const v4u s0 = (v4u){cvtpk(S[0][2 * c][0], S[0][2 * c][1]), cvtpk(S[0][2 * c][2], S[0][2 * c][3]), cvtpk(S[0][2 * c + 1][0], S[0][2 * c + 1][1]), cvtpk(S[0][2 * c + 1][2], S[0][2 * c + 1][3])};
                const v4u s1 = (v4u){cvtpk(S[1][2 * c][0], S[1][2 * c][1]), cvtpk(S[1][2 * c][2], S[1][2 * c][3]), cvtpk(S[1][2 * c + 1][0], S[1][2 * c + 1][1]), cvtpk(S[1][2 * c + 1][2], S[1][2 * c + 1][3])};
                o0 = __builtin_amdgcn_mfma_f32_16x16x32_bf16(__builtin_bit_cast(s16x8, s0), qa[c], o0, 0, 0, 0);
                o1 = __builtin_amdgcn_mfma_f32_16x16x32_bf16(__builtin_bit_cast(s16x8, s1), qa[c], o1, 0, 0, 0);
            }
            bf16* orow = Ocol + (size_t)(u.rowbase + u.sgn * (pos0 + 16 * i + fr)) * D;
            *(v2u*)orow = (v2u){cvtpk(o0[0], o0[1]), cvtpk(o0[2], o0[3])}; *(v2u*)(orow + 16) = (v2u){cvtpk(o1[0], o1[1]), cvtpk(o1[2], o1[3])};
        }
#pragma unroll
        for (int j = 0; j < 8; ++j) { S[0][j] = mfma_k16(kb[j], vt0, S[0][j] * et[j]); S[1][j] = mfma_k16(kb[j], vt1, S[1][j] * et[j]); }
    }
}
template <bool FULL> __device__ __forceinline__ void scan_pair(const Args& a, LAS unsigned char* lds, const ScanUnit& uA, const ScanUnit& uB, int tid, int lane, int wave) {
    const int grp = wave >> 2, wq = wave & 3, t = tid & 255, k = t & 127, i0 = t >> 7;
    ScanUnit u; u.h = grp ? uB.h : uA.h; u.rowbase = grp ? uB.rowbase : uA.rowbase; u.sgn = grp ? uB.sgn : uA.sgn; u.nchunks = grp ? uB.nchunks : uA.nchunks; u.chain = grp ? uB.chain : uA.chain; u.slot = grp ? uB.slot : uA.slot;
    LAS unsigned char* buf = lds + grp * SC_BUF;
    const int dir = u.sgn < 0;
    const bf16* LF = (const bf16*)(a.ws + (dir ? WS_LFB : WS_LFF)); const bf16* Q = (const bf16*)(a.ws + WS_Q); const bf16* V = (const bf16*)(a.ws + WS_V);
    f32x4* SD = (f32x4*)(a.ws + WS_SD) + (size_t)u.chain * NSLOT * 4096; float* SP = (float*)(a.ws + WS_SP) + (size_t)u.chain * NSLOT * DK;
    const int g = lane >> 4;
    bf16* Ocol = (bf16*)(a.ws + (dir ? WS_OB : WS_OF)) + u.h * DK + 32 * wq + 4 * g;
    f32x4 S[2][8];
#pragma unroll
    for (int vb = 0; vb < 2; ++vb)
#pragma unroll
        for (int j = 0; j < 8; ++j) S[vb][j] = (f32x4){0.f, 0.f, 0.f, 0.f};
    if (FULL) {
        for (int s = 0; s < u.slot; ++s) {
            const f32x4* d = SD + (size_t)s * 4096 + (wq * 16) * 64 + lane; const float* pp = SP + s * DK + 8 * g;
#pragma unroll
            for (int j = 0; j < 8; ++j) { const f32x4 pv = *(const f32x4*)(pp + 32 * (j >> 1) + 4 * (j & 1)); const f32x4 ev = (f32x4){__builtin_amdgcn_exp2f(pv.x), __builtin_amdgcn_exp2f(pv.y), __builtin_amdgcn_exp2f(pv.z), __builtin_amdgcn_exp2f(pv.w)};
                S[0][j] = S[0][j] * ev + d[j * 64]; S[1][j] = S[1][j] * ev + d[(8 + j) * 64]; }
        }
    }
    unsigned lf[16], q[16], v[16]; float psum = 0.f;
    const int nsteps = u.nchunks * 2;
    scan_load<FULL>(u, 0, LF, Q, V, k, i0, lf, q, v);
    constexpr int NST = 32, PB = 2 * SC_SUB;
    if (nsteps > 0) psum += scan_prep<FULL>(buf, k, i0, lf, q, v);
    if (grp == 1) scan_load<FULL>(u, (nsteps > 1 ? 1 : 0) * 32, LF, Q, V, k, i0, lf, q, v);
    for (int c = 0; c < NST; ++c) {
        __syncthreads();
        if (c < nsteps) {
            if (grp == 1 && c + 1 < nsteps) psum += scan_prep<FULL>(buf + ((c + 1) & 1) * PB, k, i0, lf, q, v);
            const int cw = c + 1 + grp, cn = cw < nsteps ? cw : nsteps - 1;
            scan_load<FULL>(u, cn * 32, LF, Q, V, k, i0, lf, q, v);
            scan_compute2<FULL>(buf + (c & 1) * PB, wq, lane, S, Ocol, u, c * 32);
            if (grp == 0 && c + 1 < nsteps) psum += scan_prep<FULL>(buf + ((c + 1) & 1) * PB, k, i0, lf, q, v);
        }
    }
    __syncthreads();
    if (!FULL) {
        f32x4* d = SD + (size_t)u.slot * 4096 + (wq * 16) * 64 + lane;
#pragma unroll
        for (int j = 0; j < 8; ++j) { d[j * 64] = S[0][j]; d[(8 + j) * 64] = S[1][j]; }
        LAS float* ps = (LAS float*)(lds + EXTRA_OFF + 2560);
        ps[(grp * 2 + i0) * 128 + k] = psum;
        __syncthreads();
        if (t < 128) SP[u.slot * DK + t] = ps[(grp * 2) * 128 + t] + ps[(grp * 2 + 1) * 128 + t];
        __syncthreads();
    }
}
__device__ __forceinline__ void p_scan_a(const Args& a, LAS unsigned char* lds, int tid, int lane, int wave) {
    for (int it = blockIdx.x; it < 256; it += gridDim.x) {
        const int b = it >> 7, h = (it >> 4) & 7, seg = it & 15;
        const ScanUnit uA = scan_unit(b, h, 0, seg == 15 ? 0 : 1 + seg);
        const ScanUnit uB = scan_unit(b, h, 1, seg == 0 ? 0 : 16 - seg);
        scan_pair<false>(a, lds, uA, uB, tid, lane, wave);
    }
}
__device__ __forceinline__ void p_scan_c(const Args& a, LAS unsigned char* lds, int tid, int lane, int wave) {
    for (int it = blockIdx.x; it < 256; it += gridDim.x) {
        const int b = it >> 7, h = (it >> 4) & 7, seg = it & 15;
        const ScanUnit uA = scan_unit(b, h, 0, 1 + seg), uB = scan_unit(b, h, 1, 16 - seg);
        scan_pair<true>(a, lds, uA, uB, tid, lane, wave);
    }
}
__device__ __forceinline__ void p_readout(const Args& a, int lane, int wave) {
    const int gw = blockIdx.x * NWAVES + wave, NGW = gridDim.x * NWAVES;
    const bf16* OF = (const bf16*)(a.ws + WS_OF); const bf16* OB = (const bf16*)(a.ws + WS_OB); const bf16* SG = (const bf16*)(a.ws + WS_SG); bf16* Y = (bf16*)(a.ws + WS_YIN);
    f32x4 gh[4];
#pragma unroll
    for (int j = 0; j < 4; ++j) gh[j] = ((const f32x4*)a.in[I_GHOUT])[lane + 64 * j];
    v2u ra[2][4], rb[2][4], sg[2][4];
    if (gw * 2 < NTOK) {
#pragma unroll
        for (int r = 0; r < 2; ++r)
#pragma unroll
            for (int j = 0; j < 4; ++j) { const size_t m = gw * 2 + r; ra[r][j] = ((const v2u*)(OF + m * D))[lane + 64 * j]; rb[r][j] = ((const v2u*)(OB + m * D))[lane + 64 * j]; sg[r][j] = ((const v2u*)(SG + m * D))[lane + 64 * j]; }
    }
    for (int m0 = gw * 2; m0 < NTOK; m0 += NGW * 2) {
        v2u na[2][4], nb[2][4], ns[2][4]; const int mn = m0 + NGW * 2;
#pragma unroll
        for (int r = 0; r < 2; ++r)
#pragma unroll
            for (int j = 0; j < 4; ++j) { const size_t m = (size_t)mn + r; const v2u z2 = (v2u){0u, 0u};
                na[r][j] = mn < NTOK ? ((const v2u*)(OF + m * D))[lane + 64 * j] : z2; nb[r][j] = mn < NTOK ? ((const v2u*)(OB + m * D))[lane + 64 * j] : z2; ns[r][j] = mn < NTOK ? ((const v2u*)(SG + m * D))[lane + 64 * j] : z2; }
#pragma unroll
        for (int r = 0; r < 2; ++r)
#pragma unroll
            for (int j = 0; j < 4; ++j) { const v2u a_ = ra[r][j], b_ = rb[r][j];
                const f32x4 oo = (f32x4){bf_lo(a_.x) + bf_lo(b_.x), bf_hi(a_.x) + bf_hi(b_.x), bf_lo(a_.y) + bf_lo(b_.y), bf_hi(a_.y) + bf_hi(b_.y)};
                float s = (oo.x * oo.x + oo.y * oo.y) + (oo.z * oo.z + oo.w * oo.w);
                s = half_sum(s);
                const float rs = 1.0f / sqrtf(s * (1.0f / DK) + EPS);
                store_row4<F8_MISC != 0>((unsigned char*)Y + (size_t)(m0 + r) * D * (F8_MISC ? 1 : 2), lane, j,
                    (f32x4){oo.x * rs * gh[j].x * bf_lo(sg[r][j].x), oo.y * rs * gh[j].y * bf_hi(sg[r][j].x), oo.z * rs * gh[j].z * bf_lo(sg[r][j].y), oo.w * rs * gh[j].w * bf_hi(sg[r][j].y)}, 4.0f); }
#pragma unroll
        for (int r = 0; r < 2; ++r)
#pragma unroll
            for (int j = 0; j < 4; ++j) { ra[r][j] = na[r][j]; rb[r][j] = nb[r][j]; sg[r][j] = ns[r][j]; }
    }
}
__device__ __forceinline__ void p_router(const Args& a, LAS unsigned char* lds, int l, int tid, int lane, int wave) {
    typedef _Float16 h16x8 __attribute__((ext_vector_type(8))); typedef _Float16 h16x4 __attribute__((ext_vector_type(4)));
    constexpr int PITCH = 2064, TILE_BYTES = 16 * PITCH, P_OFF = 2 * TILE_BYTES, P_BYTES = 8 * 16 * 32 * 4;
    LAS int* s_cnt = (LAS int*)(lds + EXTRA_OFF);
    LAS int* s_gb = s_cnt + 32;
    LAS int* s_sel = (LAS int*)(lds + EXTRA_OFF + 2560);
    unsigned* GCNT = (unsigned*)(a.ws + WS_CTL) + CW_GCNT + l * 32;
    const float* WR = a.in[I_WR] + (size_t)l * D * NE; const float* BR = a.in[I_BR] + l * NE;
    const bf16* X = (const bf16*)(a.ws + WS_X); unsigned char* H = a.ws + WS_H;
    const int fr = lane & 15, g = lane >> 4;
    v2u nx[2][4];
    if (blockIdx.x < NTOK / 128) {
#pragma unroll
        for (int t = 0; t < 2; ++t)
#pragma unroll
            for (int j = 0; j < 4; ++j) nx[t][j] = ((const v2u*)(X + (size_t)(blockIdx.x * 128 + 2 * wave + t) * D))[lane + 64 * j];
    }
    h16x8 wb0[4], wb1[4];
#pragma unroll
    for (int c = 0; c < 4; ++c)
#pragma unroll
        for (int i = 0; i < 8; ++i) { const float* wp = WR + (size_t)(128 * wave + 32 * c + 8 * g + i) * NE + fr; wb0[c][i] = (_Float16)wp[0]; wb1[c][i] = (_Float16)wp[16]; }
    const float* MODS = (const float*)(a.ws + WS_MODS);
    int* TOPS = (int*)(a.ws + WS_TOPE); float* TOPW = (float*)(a.ws + WS_TOPW); int* STOK = (int*)(a.ws + WS_STOK);
    for (int ch = blockIdx.x; ch < NTOK / 128; ch += gridDim.x) {
        if (tid < 32) s_cnt[tid] = 0;
        const int b = (ch * 128) / SEQ; const float* md = MODS + (size_t)(l * 3 + b) * 6 * D;
        if (ch != (int)blockIdx.x) {
#pragma unroll
        for (int t = 0; t < 2; ++t)
#pragma unroll
            for (int j = 0; j < 4; ++j) nx[t][j] = ((const v2u*)(X + (size_t)(ch * 128 + 2 * wave + t) * D))[lane + 64 * j];
        }
#define ROUTER_A(it_) do { const int tokA = ch * 128 + (it_) * 16 + 2 * wave; f32x4 hf[2][4]; \
            _Pragma("unroll") for (int t = 0; t < 2; ++t) _Pragma("unroll") for (int j = 0; j < 4; ++j) hf[t][j] = (f32x4){bf_lo(nx[t][j].x), bf_hi(nx[t][j].x), bf_lo(nx[t][j].y), bf_hi(nx[t][j].y)}; \
            if ((it_) + 1 < 8) { _Pragma("unroll") for (int t = 0; t < 2; ++t) _Pragma("unroll") for (int j = 0; j < 4; ++j) nx[t][j] = ((const v2u*)(X + (size_t)(tokA + 16 + t) * D))[lane + 64 * j]; } \
            _Pragma("unroll") for (int t = 0; t < 2; ++t) { \
                norm_mod_store<true>(hf[t], a.in[I_GFFN] + l * D, md + 4 * D, md + 3 * D, H + (size_t)(tokA + t) * D, lane); \
                _Pragma("unroll") for (int j = 0; j < 4; ++j) { const h16x4 hv = {(_Float16)hf[t][j].x, (_Float16)hf[t][j].y, (_Float16)hf[t][j].z, (_Float16)hf[t][j].w}; \
                    *(LAS h16x4*)(lds + ((it_) & 1) * TILE_BYTES + (2 * wave + t) * PITCH + (4 * lane + 256 * j) * 2) = hv; } } } while (0)
#define ROUTER_B(it_) do { f32x4 acc0 = (f32x4){0.f, 0.f, 0.f, 0.f}, acc1 = acc0; \
            _Pragma("unroll") for (int c = 0; c < 4; ++c) { const h16x8 av = *(const LAS h16x8*)(lds + ((it_) & 1) * TILE_BYTES + fr * PITCH + (128 * wave + 32 * c + 8 * g) * 2); \
                acc0 = __builtin_amdgcn_mfma_f32_16x16x32_f16(av, wb0[c], acc0, 0, 0, 0); acc1 = __builtin_amdgcn_mfma_f32_16x16x32_f16(av, wb1[c], acc1, 0, 0, 0); } \
            LAS float* Pw = (LAS float*)(lds + P_OFF + ((it_) & 1) * P_BYTES); \
            _Pragma("unroll") for (int r = 0; r < 4; ++r) { Pw[(wave * 16 + 4 * g + r) * 32 + fr] = acc0[r]; Pw[(wave * 16 + 4 * g + r) * 32 + 16 + fr] = acc1[r]; } } while (0)
#define ROUTER_C(it_) do { const int t = lane >> 5, e0 = lane & 31; const LAS float* Pr = (const LAS float*)(lds + P_OFF + ((it_) & 1) * P_BYTES); \
            float v0 = BR[e0]; \
            _Pragma("unroll") for (int w = 0; w < 8; ++w) v0 += Pr[(w * 16 + 2 * wave + t) * 32 + e0]; \
            float selv[4]; int seli[4]; \
            { const unsigned ub = __builtin_bit_cast(unsigned, v0); unsigned key = (ub & 0x80000000u) ? ~ub : (ub | 0x80000000u); key = (key & ~31u) | (unsigned)(31 - e0); \
              _Pragma("unroll") for (int r = 0; r < 4; ++r) { unsigned m = key, o; \
                  o = (unsigned)__builtin_amdgcn_update_dpp(0, (int)m, 0xB1, 0xF, 0xF, true); m = o > m ? o : m; \
                  o = (unsigned)__builtin_amdgcn_update_dpp(0, (int)m, 0x4E, 0xF, 0xF, true); m = o > m ? o : m; \
                  o = (unsigned)__builtin_amdgcn_update_dpp(0, (int)m, 0x141, 0xF, 0xF, true); m = o > m ? o : m; \
                  o = (unsigned)__builtin_amdgcn_update_dpp(0, (int)m, 0x140, 0xF, 0xF, true); m = o > m ? o : m; \
                  o = (unsigned)__shfl_xor((int)m, 16); m = o > m ? o : m; \
                  const int bi = 31 - (int)(m & 31u); seli[r] = bi; \
                  if (bi == e0) key = 0u; } \
              _Pragma("unroll") for (int r = 0; r < 4; ++r) selv[r] = __builtin_bit_cast(float, __builtin_amdgcn_ds_bpermute(((lane & 32) + seli[r]) << 2, __builtin_bit_cast(int, v0))); } \
            if ((lane & 31) == 0) { \
                const float e1 = __expf(selv[1] - selv[0]), e2 = __expf(selv[2] - selv[0]), e3 = __expf(selv[3] - selv[0]); const float inv = 1.0f / (1.0f + e1 + e2 + e3); \
                *(f32x4*)(TOPW + (size_t)(ch * 128 + (it_) * 16 + 2 * wave + t) * 4) = (f32x4){inv, e1 * inv, e2 * inv, e3 * inv}; \
                _Pragma("unroll") for (int r = 0; r < 4; ++r) s_sel[((it_) * 16 + 2 * wave + t) * 4 + r] = (seli[r] << 16) | __hip_atomic_fetch_add(&s_cnt[seli[r]], 1, __ATOMIC_RELAXED, __HIP_MEMORY_SCOPE_WORKGROUP); \
            } } while (0)
        ROUTER_A(0);
        for (int k = 0; k < 8; ++k) {
            __syncthreads();
            ROUTER_B(k);
            if (k > 0) ROUTER_C(k - 1);
            if (k < 7) ROUTER_A(k + 1);
        }
        __syncthreads();
        ROUTER_C(7);
#undef ROUTER_A
#undef ROUTER_B
#undef ROUTER_C
        __syncthreads();
        if (tid < 32) s_gb[tid] = (int)__hip_atomic_fetch_add(GCNT + tid, (unsigned)s_cnt[tid], __ATOMIC_RELAXED, __HIP_MEMORY_SCOPE_AGENT);
        __syncthreads();
        { const int sv = s_sel[tid], e = sv >> 16, vi = s_gb[e] + (sv & 0xffff); TOPS[(size_t)ch * 512 + tid] = e * NTOK + vi; STOK[(size_t)e * NTOK + vi] = ch * 128 + (tid >> 2); }
        __syncthreads();
    }
}
__device__ __forceinline__ void moe_tables(const Args& a, LAS unsigned char* lds, int l, int tid) {
    LAS int* s_tb = (LAS int*)(lds + EXTRA_OFF + 256); LAS int* s_ce = s_tb + 40; LAS int* tab = (LAS int*)(lds + EXTRA_OFF + 640);
    const unsigned* GCNT = (const unsigned*)(a.ws + WS_CTL) + CW_GCNT + l * 32;
    if (tid < 32) s_ce[tid] = (int)__hip_atomic_load(GCNT + tid, __ATOMIC_RELAXED, __HIP_MEMORY_SCOPE_AGENT);
    __syncthreads();
    if (tid == 0) { int run = 0; for (int e = 0; e < 32; ++e) { s_tb[e] = run; run += (s_ce[e] + 255) >> 8; } s_tb[32] = run; }
    __syncthreads();
    if (tid < 32) { const int t0 = s_tb[tid], t1 = s_tb[tid + 1]; for (int t = t0; t < t1; ++t) tab[t] = tid; }
    __syncthreads();
}
template <bool FINAL> __device__ __forceinline__ void p_combine(const Args& a, LAS unsigned char* lds, int l, int lane, int wave) {
    const int gw = blockIdx.x * NWAVES + wave, NGW = gridDim.x * NWAVES;
    bf16* X = (bf16*)(a.ws + WS_X); const bf16* YS = (const bf16*)(a.ws + WS_YS); const int* TOPS = (const int*)(a.ws + WS_TOPE); const float* TOPW = (const float*)(a.ws + WS_TOPW);
    const LAS int* s_tb = (const LAS int*)(lds + EXTRA_OFF + 256);
    const float* MODS = (const float*)(a.ws + WS_MODS); bf16* H = (bf16*)(a.ws + WS_H);
    const int S2 = NGW * 2;
    auto load_idx = [&](int m, v4i (&ps)[2], f32x4 (&tws)[2]) {
#pragma unroll
        for (int r = 0; r < 2; ++r) { ps[r] = *(const v4i*)(TOPS + (size_t)(m + r) * 4); tws[r] = *(const f32x4*)(TOPW + (size_t)(m + r) * 4); } };
    auto load_rows = [&](int m, v4i (&ps)[2], v2u (&xr_)[2][4], v2u (&y_)[2][4][4]) {
#pragma unroll
        for (int r = 0; r < 2; ++r) {
#pragma unroll
            for (int k = 0; k < 4; ++k) { const int e = ps[r][k] >> 15; ps[r][k] = s_tb[e] * 256 + (ps[r][k] & (NTOK - 1)); }
#pragma unroll
            for (int j = 0; j < 4; ++j) { xr_[r][j] = ((const v2u*)(X + (size_t)(m + r) * D))[lane + 64 * j];
#pragma unroll
                for (int k = 0; k < 4; ++k) {
                    if (F8_Y) { y_[r][j][k].x = ((const unsigned*)((const unsigned char*)YS + (size_t)ps[r][k] * D))[lane + 64 * j]; y_[r][j][k].y = 0u; }
                    else y_[r][j][k] = ((const v2u*)(YS + (size_t)ps[r][k] * D))[lane + 64 * j]; } } } };
    v2u xr[2][4]; v2u y[2][4][4]; f32x4 tw[2]; v4i nps[2]; f32x4 ntw[2];
    if (gw * 2 < NTOK) { v4i cps[2]; load_idx(gw * 2, cps, tw); load_rows(gw * 2, cps, xr, y); if (gw * 2 + S2 < NTOK) load_idx(gw * 2 + S2, nps, ntw); }
    for (int m0 = gw * 2; m0 < NTOK; m0 += S2) {
        const int b = m0 / SEQ; const float* gt = MODS + (size_t)(l * 3 + b) * 6 * D + 5 * D;
        const int mn = m0 + S2, mnn = m0 + 2 * S2;
        v2u xn[2][4]; v2u yn[2][4][4]; v4i pps[2]; f32x4 ptw[2];
        if (mn < NTOK) load_rows(mn, nps, xn, yn);
        if (mnn < NTOK) load_idx(mnn, pps, ptw);
        f32x4 v[2][4];
#pragma unroll
        for (int r = 0; r < 2; ++r)
#pragma unroll
            for (int j = 0; j < 4; ++j) v[r][j] = (f32x4){bf_lo(xr[r][j].x), bf_hi(xr[r][j].x), bf_lo(xr[r][j].y), bf_hi(xr[r][j].y)};
#pragma unroll
        for (int r = 0; r < 2; ++r) { const int m = m0 + r;
#pragma unroll
            for (int j = 0; j < 4; ++j) { f32x4 s = (f32x4){0.f, 0.f, 0.f, 0.f};
#pragma unroll
                for (int k = 0; k < 4; ++k) {
                    if (F8_Y) { const int w = (int)y[r][j][k].x; const f32x2_t lo = __builtin_amdgcn_cvt_pk_f32_fp8(w, false), hi = __builtin_amdgcn_cvt_pk_f32_fp8(w, true);
                        s += (f32x4){lo.x, lo.y, hi.x, hi.y} * (tw[r][k] * (1.0f / YSCALE)); }
                    else s += (f32x4){bf_lo(y[r][j][k].x), bf_hi(y[r][j][k].x), bf_lo(y[r][j][k].y), bf_hi(y[r][j][k].y)} * tw[r][k]; }
                v[r][j] = v[r][j] + ((const f32x4*)gt)[lane + 64 * j] * s; }
            if (!FINAL) {
#pragma unroll
                for (int j = 0; j < 4; ++j) ((v2u*)(X + (size_t)m * D))[lane + 64 * j] = (v2u){pk2(v[r][j].x, v[r][j].y), pk2(v[r][j].z, v[r][j].w)};
                const float* md = MODS + (size_t)((l + 1) * 3 + b) * 6 * D;
                norm_mod_store<F8_MISC != 0>(v[r], a.in[I_GMIX] + (l + 1) * D, md + 1 * D, md + 0 * D, (unsigned char*)H + (size_t)m * D * (F8_MISC ? 1 : 2), lane);
            } else {
                float s = 0.f;
#pragma unroll
                for (int j = 0; j < 4; ++j) s += (v[r][j].x * v[r][j].x + v[r][j].y * v[r][j].y) + (v[r][j].z * v[r][j].z + v[r][j].w * v[r][j].w);
                const float rs = 1.0f / sqrtf(wave_sum(s) * (1.0f / D) + EPS);
#pragma unroll
                for (int j = 0; j < 4; ++j) __builtin_nontemporal_store(v[r][j] * rs * ((const f32x4*)a.in[I_GFINAL])[lane + 64 * j], &((f32x4*)(a.out + (size_t)m * D))[lane + 64 * j]);
            }
        }
#pragma unroll
        for (int r = 0; r < 2; ++r) { tw[r] = ntw[r]; nps[r] = pps[r]; ntw[r] = ptw[r];
#pragma unroll
            for (int j = 0; j < 4; ++j) { xr[r][j] = xn[r][j];
#pragma unroll
                for (int k = 0; k < 4; ++k) y[r][j][k] = yn[r][j][k]; } }
    }
}
__device__ __forceinline__ void p_dwconv(const Args& a, int tid) {
    const bf16* U = (const bf16*)(a.ws + WS_U); bf16* ZP = (bf16*)(a.ws + WS_ZP);
    const float* WDW = a.in[I_WCVDW]; const float* BDW = a.in[I_BCVDW];
    const int half = tid >> 8, cp = tid & 255;
    typedef float f32x2v __attribute__((ext_vector_type(2)));
    auto line_of = [&](int unit, int& c, int& len, int& p0, size_t& base, size_t& stride) {
        const int hu = unit * 2 + half;
        if (hu < 2048) { c = 2 * cp; len = GRIDW; p0 = (hu & 3) * 16; base = (size_t)(hu >> 2) * GRIDW * D; stride = D; }
        else { const int v = hu - 2048; const int b = v >> 10, w = (v >> 4) & 63; c = 512 + 2 * cp; len = GRIDR; p0 = (v & 15) * 16; base = ((size_t)b * SEQ + w) * D; stride = (size_t)GRIDW * D; } };
    auto load_in = [&](int c, int len, int p0, size_t base, size_t stride, unsigned (&u)[46]) {
#pragma unroll
        for (int i = 0; i < 46; ++i) { const int pp = p0 - 15 + i; u[i] = (pp >= 0 && pp < len) ? *(const unsigned*)(U + base + (size_t)pp * stride + c) : 0u; } };
    int c, len, p0; size_t base, stride; unsigned u[46];
    f32x2v w2[CONVW]; f32x2v bb = (f32x2v){0.f, 0.f}; int wc = -1;
    if ((int)blockIdx.x < 2048) { line_of(blockIdx.x, c, len, p0, base, stride); load_in(c, len, p0, base, stride, u); }
    for (int unit = blockIdx.x; unit < 2048; unit += gridDim.x) {
        int cn = 0, lenn = 0, p0n = 0; size_t basen = 0, striden = 0; unsigned un[46]; const int nu = unit + gridDim.x;
        if (nu < 2048) { line_of(nu, cn, lenn, p0n, basen, striden); load_in(cn, lenn, p0n, basen, striden, un); }
        if (wc != c) { wc = c;
#pragma unroll
            for (int j = 0; j < CONVW; ++j) w2[j] = *(const f32x2v*)(WDW + j * D + c);
            bb = *(const f32x2v*)(BDW + c); }
        f32x2v in2[46];
#pragma unroll
        for (int i = 0; i < 46; ++i) in2[i] = (f32x2v){bf_lo(u[i]), bf_hi(u[i])};
#pragma unroll
        for (int i = 0; i < 16; ++i) { f32x2v acc2 = bb;
#pragma unroll
            for (int j = 0; j < CONVW; ++j) acc2 = __builtin_elementwise_fma(in2[i + j], w2[j], acc2);
            *(unsigned*)(ZP + base + (size_t)(p0 + i) * stride + c) = pk2(acc2.x, acc2.y); }
        c = cn; len = lenn; p0 = p0n; base = basen; stride = striden;
#pragma unroll
        for (int i = 0; i < 46; ++i) u[i] = un[i];
    }
}
__device__ __forceinline__ void p_ln_silu(const Args& a, int lane, int wave) {
    const int gw = blockIdx.x * NWAVES + wave, NGW = gridDim.x * NWAVES;
    const bf16* ZP = (const bf16*)(a.ws + WS_ZP); bf16* Z = (bf16*)(a.ws + WS_Z);
    f32x4 gg[4], bb[4];
#pragma unroll
    for (int j = 0; j < 4; ++j) { gg[j] = ((const f32x4*)a.in[I_GCVLN])[lane + 64 * j]; bb[j] = ((const f32x4*)a.in[I_BCVLN])[lane + 64 * j]; }
    v2u y[2][4];
    if (gw * 2 < NTOK) {
#pragma unroll
        for (int r = 0; r < 2; ++r)
#pragma unroll
            for (int j = 0; j < 4; ++j) y[r][j] = ((const v2u*)(ZP + (size_t)(gw * 2 + r) * D))[lane + 64 * j];
    }
    for (int m0 = gw * 2; m0 < NTOK; m0 += NGW * 2) {
        v2u yn[2][4]; const int mn = m0 + NGW * 2;
#pragma unroll
        for (int r = 0; r < 2; ++r)
#pragma unroll
            for (int j = 0; j < 4; ++j) yn[r][j] = mn < NTOK ? ((const v2u*)(ZP + (size_t)(mn + r) * D))[lane + 64 * j] : (v2u){0u, 0u};
#pragma unroll
        for (int r = 0; r < 2; ++r) {
            f32x4 v[4]; float s = 0.f;
#pragma unroll
            for (int j = 0; j < 4; ++j) { v[j] = (f32x4){bf_lo(y[r][j].x), bf_hi(y[r][j].x), bf_lo(y[r][j].y), bf_hi(y[r][j].y)}; s += (v[j].x + v[j].y) + (v[j].z + v[j].w); }
            const float mean = wave_sum(s) * (1.0f / D); float s2 = 0.f;
#pragma unroll
            for (int j = 0; j < 4; ++j) { v[j] = v[j] - mean; s2 += (v[j].x * v[j].x + v[j].y * v[j].y) + (v[j].z * v[j].z + v[j].w * v[j].w); }
            const float rstd = 1.0f / sqrtf(wave_sum(s2) * (1.0f / D) + EPS);
#pragma unroll
            for (int j = 0; j < 4; ++j) {
                f32x4 yy = v[j] * rstd * gg[j] + bb[j]; yy.x *= fsig(yy.x); yy.y *= fsig(yy.y); yy.z *= fsig(yy.z); yy.w *= fsig(yy.w);
                store_row4<F8_MISC != 0>((unsigned char*)Z + (size_t)(m0 + r) * D * (F8_MISC ? 1 : 2), lane, j, yy, 4.0f); }
        }
#pragma unroll
        for (int r = 0; r < 2; ++r)
#pragma unroll
            for (int j = 0; j < 4; ++j) y[r][j] = yn[r][j];
    }
}


enum { PH_PRO = 0, PH_NORM0, PH_INPROJ, PH_SCANA, PH_SCANC, PH_READOUT, PH_OUTPROJ, PH_ROUTER0, PH_G1_0, PH_G2_0, PH_COMB0, PH_CVIN, PH_DWCONV, PH_LN, PH_CVOUT, PH_ROUTER1, PH_G1_1, PH_G2_1, PH_FINAL, NPH };
#ifndef AEPI
#define AEPI 1
#endif
#ifndef REPMASK
#define REPMASK 0ull
#endif
#ifndef SCAN_NAIVE
#define SCAN_NAIVE 0
#endif
#if defined(__HIP_DEVICE_COMPILE__)
#define NO_PK_F32
#else
#define NO_PK_F32
#endif
__global__ void NO_PK_F32 __launch_bounds__(NTHR, 2) fwd_kernel(Args args) {
    extern __shared__ __attribute__((aligned(16))) unsigned char lds_raw[];
    LAS unsigned char* lds = (LAS unsigned char*)lds_raw;
    const int tid = threadIdx.x, lane = tid & 63, wave = __builtin_amdgcn_readfirstlane(tid >> 6);
    const int G = gridDim.x, bid = blockIdx.x;
    unsigned char* ws = args.ws;
    for (int u = tid; u < (LDS_BYTES - LDSCTL_OFF) / 4; u += NTHR) ((LAS unsigned*)(lds + LDSCTL_OFF))[u] = 0u;
    __syncthreads();
    volatile LAS unsigned* MISC = (volatile LAS unsigned*)(lds + MISC_OFF);
    XcdBarrier bar = xcd_barrier_post((unsigned*)(ws + WS_CTL) + CW_BAR + args.li * XCD_BAR_WORDS, MISC + 8);
    const int lo = args.ph_lo, hi = args.ph_hi;
    if (TL_PROBE && tid == 0) MISC[48] = (unsigned)__builtin_amdgcn_s_memrealtime();
    if (tid == 0) __hip_atomic_store((unsigned*)(ws + WS_CTL) + CW_XMAP + bid, xb_xcc_id() + 1u, __ATOMIC_RELAXED, __HIP_MEMORY_SCOPE_AGENT);
#define IN(k) (lo <= (k) && (k) < hi)
    int cv_n = 0; unsigned bseq = 0;
#ifndef FLAT_BARRIER
#define FLAT_BARRIER 0
#endif
#define SEAM(k) do { if (IN(k) && IN((k) + 1)) { ++bseq; if (FLAT_BARRIER) flat_barrier_work((unsigned*)(ws + WS_CTL) + CW_FLAT, args, lds, wave, lane, cv_n, MISC + 12, bseq); else xcd_barrier_work(bar, args, lds, wave, lane, cv_n, MISC + 12, bseq); \
        if (TL_PROBE && tid == 0) MISC[48 + (k) + 1] = (unsigned)__builtin_amdgcn_s_memrealtime(); } } while (0)
#define PHASE(k, ...) if (IN(k)) { __VA_ARGS__; if ((REPMASK >> (k)) & 1ull) { __syncthreads(); __VA_ARGS__; } if (TL_PROBE && tid == 0) MISC[72 + (k)] = (unsigned)__builtin_amdgcn_s_memrealtime(); } SEAM(k);
    typedef pg8::bf16_t pbf;

    const bool merge_pro = false && (G >= 32) && IN(PH_PRO) && IN(PH_NORM0);
    if (IN(PH_PRO)) { p_mods(args, lds, tid, lane, wave); p_weights(args, lds, lane, wave); if (merge_pro) wait_mods0(args, tid); }
    if (!merge_pro) SEAM(PH_PRO);
    const bool ctx_early = SPLIT_IN && (G == 256);
    PHASE(PH_NORM0, {
        if (ctx_early && bid < 24) {
            const int cb = bid / 12, cj = bid % 12;
            p_norm0(args, lane, wave, NWAVES, NTOK + cb * CTXL, NTOK + cb * CTXL + CTXL);
            VM_WAIT(); __syncthreads();
            if (cj < 8) {
                pg8::Gemm g{(const pbf*)(ws + WS_H8), (const pbf*)(ws + WS_WIN8), D / 2, 0};
                pg8::OneUnit S1{NTOK / 256 + cb, cj};
                pg8::EpiHgrnIn E{(pbf*)(ws + WS_Q), (WS_V - WS_Q) / 2, (_Float16*)(ws + WS_LFF), (WS_LFB - WS_LFF) / 2, args.in[I_HGAMMA], 2};
                pg8::gemm_phase<pg8::EpiHgrnIn, pg8::OneUnit, AEPI != 0, true, true, 0x79797979, 0x7F7F7F7F>(lds + RING_OFF, g, S1, E);
            } else {
                pg8::Gemm g{(const pbf*)(ws + WS_H), (const pbf*)(ws + WS_WIN), D, 0};
                pg8::OneUnit S1{NTOK / 256 + cb, 4 + (cj - 8)};
                pg8::EpiHgrnIn E{(pbf*)(ws + WS_Q), (WS_V - WS_Q) / 2, (_Float16*)(ws + WS_LFF), (WS_LFB - WS_LFF) / 2, args.in[I_HGAMMA], 1};
                pg8::gemm_phase<pg8::EpiHgrnIn, pg8::OneUnit, AEPI != 0, true, false>(lds + RING_OFF, g, S1, E);
            }
        } else if (ctx_early) p_norm0(args, lane, (bid - 24) * NWAVES + wave, (G - 24) * NWAVES, 0, NTOK);
        else p_norm0(args, lane, bid * NWAVES + wave, G * NWAVES, 0, MROWS);
    })
    PHASE(PH_INPROJ, {
        static_assert(WS_V - WS_Q == WS_SG - WS_V, "Q|V|SG equally spaced");
        if (SPLIT_IN) {
            const int nMi = ctx_early ? NTOK / 256 : MROWS / 256;
            {
                pg8::Gemm g{(const pbf*)(ws + WS_H8), (const pbf*)(ws + WS_WIN8), D / 2, 0};
                pg8::TileOrder S; S.init(nMi, (G_F8 ? 3 : 2) * D / 256, G, bid, nullptr);
                pg8::EpiHgrnIn E{(pbf*)(ws + WS_Q), (WS_V - WS_Q) / 2, (_Float16*)(ws + WS_LFF), (WS_LFB - WS_LFF) / 2, args.in[I_HGAMMA], 2};
                pg8::gemm_phase<pg8::EpiHgrnIn, pg8::TileOrder, AEPI != 0, true, true, 0x79797979, 0x7F7F7F7F>(lds + RING_OFF, g, S, E);
            }
            {
                pg8::Gemm g{(const pbf*)(ws + WS_H), (const pbf*)(ws + WS_WIN), D, 0};
                pg8::TileOrder S; S.init(nMi, (G_F8 ? 2 : 3) * D / 256, G, bid, nullptr);
                pg8::EpiHgrnIn E{(pbf*)(ws + WS_Q), (WS_V - WS_Q) / 2, (_Float16*)(ws + WS_LFF), (WS_LFB - WS_LFF) / 2, args.in[I_HGAMMA], 1};
                pg8::gemm_phase<pg8::EpiHgrnIn, pg8::TileOrder, AEPI != 0, true, false>(lds + RING_OFF, g, S, E);
            }
        } else {
            pg8::Gemm g{(const pbf*)(ws + WS_H), (const pbf*)(ws + WS_WIN), F8_IN ? D / 2 : D, 0};
            pg8::TileOrder S; S.init(MROWS / 256, 5 * D / 256, G, bid, nullptr);
            pg8::EpiHgrnIn E{(pbf*)(ws + WS_Q), (WS_V - WS_Q) / 2, (_Float16*)(ws + WS_LFF), (WS_LFB - WS_LFF) / 2, args.in[I_HGAMMA], 0};
            pg8::gemm_phase<pg8::EpiHgrnIn, pg8::TileOrder, AEPI != 0, true, F8_IN != 0, 0x79797979, 0x7F7F7F7F>(lds + RING_OFF, g, S, E);
        }
    })
#if SCAN_NAIVE
    PHASE(PH_SCANA, { p_scan_naive(args, lds, tid); })
    PHASE(PH_SCANC, { })
#else
    PHASE(PH_SCANA, { p_scan_a(args, lds, tid, lane, wave); })
    PHASE(PH_SCANC, { p_scan_c(args, lds, tid, lane, wave); })
#endif
    PHASE(PH_READOUT, { p_readout(args, lane, wave); })
    PHASE(PH_OUTPROJ, {
        pg8::Gemm g{(const pbf*)(ws + WS_YIN), (const pbf*)(ws + WS_WOUT), F8_MISC ? D / 2 : D, 0};
        pg8::TileOrder S; S.init(NTOK / 256, D / 256, G, bid, nullptr);
        pg8::EpiResGate<false, true> E{args.in[I_X], (void*)(ws + WS_X), (const float*)(ws + WS_MODS) + 2 * D, 6 * D, SEQ, nullptr};
        pg8::gemm_phase<pg8::EpiResGate<false, true>, pg8::TileOrder, AEPI != 0, true, F8_MISC != 0, 0x79797979, 0x7D7D7D7D>(lds + RING_OFF, g, S, E);
    })
#ifndef LDSB
#define LDSB 1
#endif
#ifndef XBAR_PROBE
#define XBAR_PROBE 0
#endif
#ifndef G2_NS
#define G2_NS 0
#endif
#ifndef G1_NS
#define G1_NS 0
#endif
#ifndef MOE_HANDOFF
#define MOE_HANDOFF 1
#endif
#ifndef MOE_WT
#define MOE_WT 0
#endif
#define MOE_PHASES(l, pb) \
    if (IN(pb + 0)) { p_router(args, lds, l, tid, lane, wave); cv_finish(args, lds, wave, lane, cv_n, (l + 1) * CV_L0); } SEAM(pb + 0); \
    if ((l) == 1) { if (XBAR_PROBE >= 1) SEAM(pb + 0); if (XBAR_PROBE >= 2) SEAM(pb + 0); if (XBAR_PROBE >= 3) SEAM(pb + 0); if (XBAR_PROBE >= 4) SEAM(pb + 0); }     \
    if (IN(pb + 1) || IN(pb + 2) || IN(pb + 3)) { \
        moe_tables(args, lds, l, tid); \
        LAS int* tab = (LAS int*)(lds + EXTRA_OFF + 640); \
        const LAS int* s_tb = (const LAS int*)(lds + EXTRA_OFF + 256); const LAS int* s_ce = s_tb + 40; \
        const int ntiles = __builtin_amdgcn_readfirstlane(s_tb[32]); \
        const bool hand = MOE_HANDOFF && (G == 256) && IN(pb + 1) && IN(pb + 2) && !((REPMASK >> (pb + 1)) & 3ull) && (MOE_WT || xmap_ok); \
        const int xl = (hand && !MOE_WT) ? 1 : 0; \
        unsigned* tcnt = (unsigned*)(ws + WS_CTL) + CW_TCNT + l * 32768; \
        const int c2 = (hand && MOE_WT) ? ((bid - ((((ntiles * 8) & 255) + 7) & ~7)) & 255) : bid;     \
        const int tv = (((bid & 7) + 1) * ntiles >> 3) - ((bid & 7) * ntiles >> 3);                   \
        LAS int* ut1 = (LAS int*)(lds + EXTRA_OFF + 13824); LAS int* ut2 = ut1 + 32;                  \
        if (wave == 0) { \
            int pm_ = 0, pn_ = 0; \
            const bool h1 = lane < 32 && pg8::MoeOrder::unit_of(xl, ntiles, 2 * D / 256, G, bid, bid >> 3, lane, pm_, pn_); \
            if (lane < 32) ut1[lane] = h1 ? (pm_ | (pn_ << 16) | (tab[pm_] << 24)) : 0; \
            const bool h2 = lane < 32 && pg8::MoeOrder::unit_of(xl, ntiles, D / 256, G, c2, ((bid >> 3) - ((tv * 8) & 31)) & 31, lane, pm_, pn_); \
            if (lane < 32) ut2[lane] = h2 ? (pm_ | (pn_ << 16) | (tab[pm_] << 24)) : 0; \
            const int n1 = __popcll(__ballot(h1)), n2 = __popcll(__ballot(h2)); \
            if (lane == 0) { ut1[64] = n1; ut1[65] = n2; } \
        } \
        __syncthreads(); \
        const int nu1 = __builtin_amdgcn_readfirstlane(ut1[64]), nu2 = __builtin_amdgcn_readfirstlane(ut1[65]); \
        if (IN(pb + 1)) { \
            LAS unsigned short* tt = (LAS unsigned short*)(lds + EXTRA_OFF + 2816);     \
            pg8::MoeOrder S; S.ut = ut1; S.nu = nu1; S.cnt = tcnt; S.rdy = 0u; S.mode = hand ? 0 : 2; \
            { const int* STOK = (const int*)(ws + WS_STOK); int tv_[10];                         \
              _Pragma("unroll") for (int n_ = 0; n_ < 10; ++n_) { const int idx = tid + NTHR * n_; tv_[n_] = 0; \
                  if (idx < nu1 * 256) { const int uw = ut1[idx >> 8], pm_ = uw & 0xFFFF, e_ = (uw >> 24) & 0xFF, vi = (pm_ - s_tb[e_]) * 256 + (idx & 255); if (vi < s_ce[e_]) tv_[n_] = STOK[(size_t)e_ * NTOK + vi]; } } \
              _Pragma("unroll") for (int n_ = 0; n_ < 10; ++n_) { const int idx = tid + NTHR * n_; if (idx < nu1 * 256) tt[idx] = (unsigned short)tv_[n_]; } } \
            __syncthreads(); \
            pg8::Gemm g{(const pbf*)(ws + WS_H), (const pbf*)(ws + WS_W1 + (size_t)l * NE * 2 * D * D), D / 2, (size_t)2 * D * D, tt};   \
            pg8::EpiPair<0, true, 4, MOE_WT != 0, LDSB != 0> E{(pbf*)(ws + WS_ACT), args.in[I_BE1] + (size_t)l * NE * 2 * D, (const LAS float*)(lds + EXTRA_OFF + 14336)}; \
            pg8::gemm_phase<pg8::EpiPair<0, true, 4, MOE_WT != 0, LDSB != 0>, pg8::MoeOrder, AEPI != 0, true, true, 0x79797979, 0x7F7F7F7F, true, G1_NS>(lds + RING_OFF, g, S, E); \
            if ((REPMASK >> (pb + 1)) & 1ull) { __syncthreads(); pg8::gemm_phase<pg8::EpiPair<0, true, 4, MOE_WT != 0, LDSB != 0>, pg8::MoeOrder, AEPI != 0, true, true, 0x79797979, 0x7F7F7F7F, true, G1_NS>(lds + RING_OFF, g, S, E); } \
        } \
        pg8::MoeOrder S2; S2.ut = ut2; S2.nu = nu2; S2.cnt = tcnt; S2.rdy = 0u; S2.mode = hand ? 1 : 2; \
        if (hand) {                                                          \
            if (wave == 0) { \
                const unsigned v = lane < nu2 ? __hip_atomic_load(tcnt + 32 * (ut2[lane & 31] & 0xFFFF), __ATOMIC_RELAXED, __HIP_MEMORY_SCOPE_AGENT) : 64u; \
                const unsigned long long m = __ballot(v >= 64u); \
                __builtin_amdgcn_fence(__ATOMIC_ACQUIRE, "agent"); asm volatile("s_waitcnt vmcnt(0)" ::: "memory"); \
                if (lane == 0) MISC[16] = (unsigned)m; \
            } \
            __syncthreads(); \
            S2.rdy = __builtin_amdgcn_readfirstlane(MISC[16]); \
        } else SEAM(pb + 1); \
        PHASE(pb + 2, { \
            pg8::Gemm g{(const pbf*)(ws + WS_ACT), (const pbf*)(ws + WS_W2 + (size_t)l * NE * D * D), D / 2, (size_t)D * D}; \
            pg8::EpiMoeOut<F8_Y != 0, YSCALE, LDSB != 0> E{(pbf*)(ws + WS_YS), args.in[I_BE2] + (size_t)l * NE * D, (const LAS float*)(lds + EXTRA_OFF + 14336)}; \
            pg8::gemm_phase<pg8::EpiMoeOut<F8_Y != 0, YSCALE, LDSB != 0>, pg8::MoeOrder, AEPI != 0, true, true, 0x79797979, 0x7D7D7D7D, false, G2_NS>(lds + RING_OFF, g, S2, E);   \
        }) \
    }
    bool xmap_ok = false;
    if (MOE_HANDOFF && !MOE_WT && G == 256 && lo == 0) {
        if (wave == 0) {
            const unsigned* xm = (const unsigned*)(ws + WS_CTL) + CW_XMAP; bool ok = true;
#pragma unroll
            for (int k = 0; k < 4; ++k) { const int b = lane + 64 * k; const unsigned mine = __hip_atomic_load(xm + b, __ATOMIC_RELAXED, __HIP_MEMORY_SCOPE_AGENT), cls = __hip_atomic_load(xm + (b & 7), __ATOMIC_RELAXED, __HIP_MEMORY_SCOPE_AGENT);
                ok = ok && mine != 0u && mine == cls; }
            const unsigned me = __hip_atomic_load(xm + (lane & 7), __ATOMIC_RELAXED, __HIP_MEMORY_SCOPE_AGENT);
#pragma unroll
            for (int j = 1; j < 8; ++j) { const unsigned other = (unsigned)__shfl((int)me, (lane + j) & 7); ok = ok && other != me; }
            const bool all_ok = __all(ok);
            if (lane == 0) MISC[17] = all_ok ? 1u : 0u;
        }
        __syncthreads();
        xmap_ok = __builtin_amdgcn_readfirstlane(MISC[17]) != 0u;
    }
    MOE_PHASES(0, PH_ROUTER0)
    PHASE(PH_COMB0, { p_combine<false>(args, lds, 0, lane, wave); })
    PHASE(PH_CVIN, {
        pg8::Gemm g{(const pbf*)(ws + WS_H), (const pbf*)(ws + WS_WCVIN), F8_MISC ? D / 2 : D, 0};
        pg8::TileOrder S; S.init(NTOK / 256, 2 * D / 256, G, bid, nullptr);
        pg8::EpiPair<1> E{(pbf*)(ws + WS_U), args.in[I_BCVIN]};
        pg8::gemm_phase<pg8::EpiPair<1>, pg8::TileOrder, AEPI != 0, true, F8_MISC != 0, 0x79797979, 0x7F7F7F7F>(lds + RING_OFF, g, S, E);
    })
    PHASE(PH_DWCONV, { p_dwconv(args, tid); })
    PHASE(PH_LN, { p_ln_silu(args, lane, wave); })
    PHASE(PH_CVOUT, {
        pg8::Gemm g{(const pbf*)(ws + WS_Z), (const pbf*)(ws + WS_WCVOUT), F8_MISC ? D / 2 : D, 0};
        pg8::TileOrder S; S.init(NTOK / 256, D / 256, G, bid, nullptr);
        pg8::EpiResGate<true, true> E{(const void*)(ws + WS_X), (void*)(ws + WS_X), (const float*)(ws + WS_MODS) + 3 * 6 * D + 2 * D, 6 * D, SEQ, args.in[I_BCVOUT]};
        pg8::gemm_phase<pg8::EpiResGate<true, true>, pg8::TileOrder, AEPI != 0, true, F8_MISC != 0, 0x79797979, 0x7D7D7D7D>(lds + RING_OFF, g, S, E);
    })
#ifndef CLK_PROBE
#define CLK_PROBE 0
#endif
#if CLK_PROBE
    if (bid == 0 && tid == 0) { const unsigned long long c = __builtin_amdgcn_s_memtime(), w = __builtin_amdgcn_s_memrealtime(); MISC[20] = (unsigned)c; MISC[21] = (unsigned)(c >> 32); MISC[22] = (unsigned)w; MISC[23] = (unsigned)(w >> 32); }
#endif
    MOE_PHASES(1, PH_ROUTER1)
#if CLK_PROBE
    if (bid == 0 && tid == 0) { const unsigned long long c = __builtin_amdgcn_s_memtime(), w = __builtin_amdgcn_s_memrealtime(); MISC[24] = (unsigned)c; MISC[25] = (unsigned)(c >> 32); MISC[26] = (unsigned)w; MISC[27] = (unsigned)(w >> 32); }
#endif
    if (IN(PH_FINAL)) { p_combine<true>(args, lds, 1, lane, wave); }
#if KL_PROBE
    static_assert(pg8::KLP_LDS == MISC_OFF + 4 * 28, "probe words");
    if (bid == 0 && tid == 0) {
        const unsigned long long kl = ((unsigned long long)MISC[29] << 32) | MISC[28]; const unsigned nun = MISC[30] ? MISC[30] : 1u;
        const unsigned long long tot = ((unsigned long long)MISC[37] << 32) | MISC[36];
        const unsigned long long ticks = KL_PROBE == 1 ? kl * 10ull / (8ull * nun) : (tot - kl) * 5ull / nun;
        const unsigned long long t_end = __builtin_amdgcn_s_memrealtime() + (ticks < 100000ull ? ticks : 100000ull);
        while (__builtin_amdgcn_s_memrealtime() < t_end) __builtin_amdgcn_s_sleep(8);
    }
#endif
#if TL_PROBE
    if (bid == 0 && tid == 0) { const unsigned ticks = TL_BODY ? MISC[72 + TL_B] - MISC[48 + TL_B] : MISC[48 + TL_B + 1] - MISC[48 + TL_A + 1];     const unsigned long long t_end = __builtin_amdgcn_s_memrealtime() + 2ull * (ticks < 200000u ? ticks : 200000u); while (__builtin_amdgcn_s_memrealtime() < t_end) __builtin_amdgcn_s_sleep(8); }
#endif
#if CVF_PROBE
    if (bid == 0 && tid == 0) { const unsigned long long t_end = __builtin_amdgcn_s_memrealtime() + 2ull * MISC[40]; while (__builtin_amdgcn_s_memrealtime() < t_end) __builtin_amdgcn_s_sleep(8); }
#endif
#if CLK_PROBE
    if (bid == 0 && tid == 0) {
        const unsigned long long c0 = ((unsigned long long)MISC[21] << 32) | MISC[20], w0 = ((unsigned long long)MISC[23] << 32) | MISC[22], c1 = ((unsigned long long)MISC[25] << 32) | MISC[24], w1 = ((unsigned long long)MISC[27] << 32) | MISC[26];
        const unsigned long long ticks = (c1 - c0) * 1000ull / (w1 - w0 + 1ull);
        const unsigned long long t_end = __builtin_amdgcn_s_memrealtime() + (ticks < 100000ull ? ticks : 100000ull);
        while (__builtin_amdgcn_s_memrealtime() < t_end) __builtin_amdgcn_s_sleep(8);
    }
#endif
#undef MOE_PHASES
#undef PHASE
#undef IN
#undef SEAM
}

extern "C" void kernel_launch(void* const* d_in, const int* in_sizes, int n_in, void* d_out, int out_size, void* d_ws, size_t ws_size, hipStream_t stream) {
    static int grid = 0;
    if (grid == 0) {
        if (n_in != N_IN || in_sizes[0] != NTOK * D || out_size != NTOK * D || ws_size < WS_END) { fprintf(stderr, "kernel_launch: unexpected shapes / workspace (n_in %d, in0 %d, out %d, ws %zu, need %zu); nothing launched\n", n_in, n_in > 0 ? in_sizes[0] : -1, out_size, ws_size, (size_t)WS_END); grid = -1; return; }
        int dev = 0, cus = 0, per_cu = 0;
        if (hipGetDevice(&dev) != hipSuccess || hipDeviceGetAttribute(&cus, hipDeviceAttributeMultiprocessorCount, dev) != hipSuccess) { grid = -1; return; }
        if (hipFuncSetAttribute((const void*)fwd_kernel, hipFuncAttributeMaxDynamicSharedMemorySize, LDS_BYTES) != hipSuccess) { fprintf(stderr, "kernel_launch: hipFuncSetAttribute failed\n"); grid = -1; return; }
        if (hipOccupancyMaxActiveBlocksPerMultiprocessor(&per_cu, (const void*)fwd_kernel, NTHR, LDS_BYTES) != hipSuccess || per_cu < 1) { fprintf(stderr, "kernel_launch: occupancy query reports %d workgroups per CU\n", per_cu); }
        (void)hipGetLastError();
        grid = cus;
    }
    if (grid < 0) return;
    if (hipMemsetAsync((char*)d_ws + WS_CTL, 0, CTL_ZERO_BYTES, stream) != hipSuccess) return;
#ifdef DIAG_MEMSET
    (void)hipMemsetAsync((char*)d_ws + WS_SP, 0, (WS_WIN - WS_SP), stream); (void)hipMemsetAsync((char*)d_ws + WS_OF, 0, (WS_YIN - WS_OF), stream);
#endif
    Args a{};
    for (int i = 0; i < N_IN; ++i) a.in[i] = (const float*)d_in[i];
    a.out = (float*)d_out; a.ws = (unsigned char*)d_ws; a.pad = 0;
#ifndef MK_CUTS
    a.ph_lo = 0; a.ph_hi = NPH; a.li = 0;
    hipLaunchKernelGGL(fwd_kernel, dim3(grid), dim3(NTHR), LDS_BYTES, stream, a);
#else
    const int cuts[] = {MK_CUTS};
    const int nc = (int)(sizeof(cuts) / sizeof(cuts[0]));
    for (int li = 0; li + 1 < nc; ++li) { a.ph_lo = cuts[li]; a.ph_hi = cuts[li + 1]; a.li = li; hipLaunchKernelGGL(fwd_kernel, dim3(grid), dim3(NTHR), LDS_BYTES, stream, a); }
#endif
}
```

```cpp
#include <hip/hip_runtime.h>
#include <cstdio>
#include <cstdint>
__device__ __forceinline__ void wg_sync_() { __builtin_amdgcn_fence(__ATOMIC_RELEASE, "workgroup"); __builtin_amdgcn_s_barrier(); __builtin_amdgcn_fence(__ATOMIC_ACQUIRE, "workgroup"); }
#define __syncthreads() wg_sync_()
#define __ballot(p) __builtin_amdgcn_ballot_w64((p) != 0)
#define __all(p) (__builtin_amdgcn_ballot_w64(!(p)) == 0ull)
#define __shfl(v, src) __builtin_amdgcn_ds_bpermute((int)(src) << 2, (int)(v))
#define __popcll(x) __builtin_popcountll(x)

namespace pg8 {
#define PG8_LAS __attribute__((address_space(3)))
typedef unsigned short bf16_t;
typedef short bf16x8 __attribute__((ext_vector_type(8)));
typedef float f32x4 __attribute__((ext_vector_type(4)));
typedef unsigned u32x4 __attribute__((ext_vector_type(4)));
typedef unsigned u32x2 __attribute__((ext_vector_type(2)));
typedef int i32x4 __attribute__((ext_vector_type(4)));
typedef int i32x8 __attribute__((ext_vector_type(8)));
#ifndef KL_PROBE
#define KL_PROBE 0
#endif
constexpr int KLP_LDS = 139264 + 320 + 4 * 28;
constexpr int BM = 256, BK = 64, HALF = 128, HTB = HALF * BK * 2  , STAGE_BYTES = 8 * HTB, NXCD = 8, WGM = 8;

__host__ __device__ __forceinline__ int lds_byte(int r, int c) { const int st = (r >> 4) * 2 + (c >> 5), rr = r & 15, cc = c & 31, ob = rr * 64 + cc * 2; return st * 1024 + (ob ^ (((ob >> 9) & 1) << 5)); }
__host__ __device__ __forceinline__ void stage_rc(int b, int& R, int& C) { const int st = b / 1024, sb = b % 1024, swz = sb ^ (((sb >> 9) & 1) << 5); R = (st >> 1) * 16 + swz / 64; C = (st & 1) * 32 + (swz % 64) / 2; }
__host__ __device__ __forceinline__ int perm32(int rho) { const int n = rho >> 4, i = rho & 15; return 8 * (i >> 2) + 4 * n + (i & 3); }

struct Unit { int pm, pn, e; };
struct Gemm { const bf16_t* A; const bf16_t* Bt; int K; size_t estride; const PG8_LAS unsigned short* tt; };

struct TileOrder {
    int nM, nN, nwg, G, c; const PG8_LAS int* tile_e;
    __device__ __forceinline__ void init(int nM_, int nN_, int G_, int c_, const PG8_LAS int* te) { nM = nM_; nN = nN_; nwg = nM * nN; G = G_; c = c_; tile_e = te; }
    __device__ __forceinline__ bool next(int i, Unit& u) const {
        const long L = (long)i * G + c; if (L >= nwg) return false;
        int wgid = (int)L; { const int q = nwg / NXCD, r = nwg % NXCD, xcd = wgid % NXCD, off = wgid / NXCD; wgid = (xcd < r ? xcd * (q + 1) : r * (q + 1) + (xcd - r) * q) + off; }
        const int nig = WGM * nN, gid = wgid / nig, fm = gid * WGM, gsz = (nM - fm) < WGM ? (nM - fm) : WGM;
        u.pm = fm + ((wgid % nig) % gsz); u.pn = (wgid % nig) / gsz;
        u.e = tile_e ? __builtin_amdgcn_readfirstlane(tile_e[u.pm]) : 0; return true;
    }
    static constexpr bool PUBLISH = false;
    __device__ __forceinline__ bool probe_on() const { return false; }
    __device__ __forceinline__ void a_ready(const Unit&, int) const {}
    __device__ __forceinline__ void done(const Unit&) const {}
    __device__ __forceinline__ void publish(int, int) const {}
};

struct MoeOrder {
    static constexpr bool PUBLISH = true;
    const PG8_LAS int* ut; int nu;
    unsigned* cnt; unsigned rdy; int mode;
    static __device__ __forceinline__ bool unit_of(int xl, int nM, int nN, int G, int c, int rrot, int i, int& pm, int& pn) {
        if (!xl) { TileOrder T; T.init(nM, nN, G, c, nullptr); Unit u; if (!T.next(i, u)) return false; pm = u.pm; pn = u.pn; return true; }
        const int v = c & 7, T0 = (v * nM) >> 3, Tv = (((v + 1) * nM) >> 3) - T0;
        const int Lx = i * 32 + rrot; if (Lx >= Tv * nN) return false;
        const int nig = WGM * nN, gid = Lx / nig, fm = gid * WGM, gsz = (Tv - fm) < WGM ? (Tv - fm) : WGM, w = Lx % nig;
        pm = T0 + fm + (w % gsz); pn = w / gsz; return true;
    }
    __device__ __forceinline__ bool next(int i, Unit& u) const {
        if (i >= nu) return false;
        const int v = __builtin_amdgcn_readfirstlane(ut[i]); u.pm = v & 0xFFFF; u.pn = (v >> 16) & 0xFF; u.e = (v >> 24) & 0xFF; return true;
    }
    __device__ __forceinline__ bool probe_on() const { return mode == 0; }
    __device__ __forceinline__ void done(const Unit&) const {}
    __device__ __forceinline__ void publish(int pm, int lane) const {
        if (mode == 0 && lane == 0) (void)__hip_atomic_fetch_add(cnt + 32 * pm, 1u, __ATOMIC_RELAXED, __HIP_MEMORY_SCOPE_AGENT);
    }
    __device__ __forceinline__ void a_ready(const Unit& u, int i) const {
        if (mode != 1 || ((rdy >> i) & 1u)) return;
        if (__builtin_amdgcn_readfirstlane(threadIdx.x >> 6) == 0) {
            unsigned sp = 0;
            while (__hip_atomic_load(cnt + 32 * u.pm, __ATOMIC_RELAXED, __HIP_MEMORY_SCOPE_AGENT) < 64u) { __builtin_amdgcn_s_sleep(1); if (++sp > (1u << 20)) break; }
            __builtin_amdgcn_fence(__ATOMIC_ACQUIRE, "agent");
            asm volatile("s_waitcnt vmcnt(0)" ::: "memory");
        }
        __builtin_amdgcn_s_barrier();
    }
};

struct OneUnit {
    int pm, pn;
    __device__ __forceinline__ bool next(int i, Unit& u) const { if (i != 0) return false; u.pm = pm; u.pn = pn; u.e = 0; return true; }
    static constexpr bool PUBLISH = false;
    __device__ __forceinline__ bool probe_on() const { return false; }
    __device__ __forceinline__ void a_ready(const Unit&, int) const {}
    __device__ __forceinline__ void done(const Unit&) const {}
    __device__ __forceinline__ void publish(int, int) const {}
};

__device__ __forceinline__ unsigned cvt_pk_bf16(float lo, float hi) { unsigned r; asm volatile("v_cvt_pk_bf16_f32 %0, %1, %2" : "=v"(r) : "v"(lo), "v"(hi)); return r; }
__device__ __forceinline__ float fsigmoid(float x) { return __builtin_amdgcn_rcpf(1.0f + __expf(-x)); }


struct EpiHgrnIn {
    static constexpr bool PERM = true, AFTER_DRAIN = false, LDS_BIAS = false;
    bf16_t* Q; size_t qstride; _Float16* LFF; size_t lfstride; const float* gamma; int mode;
    static __device__ __forceinline__ f32x4 vexp2(f32x4 t) { f32x4 e; e[0] = __builtin_amdgcn_exp2f(t[0]); e[1] = __builtin_amdgcn_exp2f(t[1]); e[2] = __builtin_amdgcn_exp2f(t[2]); e[3] = __builtin_amdgcn_exp2f(t[3]); return e; }
    static __device__ __forceinline__ f32x4 vrcp(f32x4 d) { f32x4 r; r[0] = __builtin_amdgcn_rcpf(d[0]); r[1] = __builtin_amdgcn_rcpf(d[1]); r[2] = __builtin_amdgcn_rcpf(d[2]); r[3] = __builtin_amdgcn_rcpf(d[3]); return r; }
    static __device__ __forceinline__ f32x4 vlog2(f32x4 d) { f32x4 r; r[0] = __builtin_amdgcn_logf(d[0]); r[1] = __builtin_amdgcn_logf(d[1]); r[2] = __builtin_amdgcn_logf(d[2]); r[3] = __builtin_amdgcn_logf(d[3]); return r; }
    __device__ __forceinline__ void operator()(const f32x4 (&acc)[2][2][4][2], const Unit& u, int wr, int wc, int fr, int fq) const {
        const int sg_ = u.pn >> 2, seg = mode == 0 ? sg_ : (mode == 1 ? (sg_ < 2 ? sg_ : 4) : 2 + sg_), cb = (u.pn & 3) * 256 + wc * 32 + 8 * fq;
        const int row0 = u.pm * BM + wr * 64 + fr;
        if (seg == 2 || seg == 3) {
            _Float16* O = LFF + (size_t)(seg - 2) * lfstride; const float* g0 = gamma + (seg - 2) * 2048 + cb;
            f32x4 lb[2][2];
#pragma unroll
            for (int bj = 0; bj < 2; ++bj)
#pragma unroll
                for (int n = 0; n < 2; ++n) { const f32x4 d = *(const f32x4*)(g0 + bj * HALF + 4 * n) - *(const f32x4*)(g0 + 1024 + bj * HALF + 4 * n);
                    lb[bj][n] = vrcp(vexp2(d * -1.4426950408889634f) + 1.0f); }
#pragma unroll
            for (int ai = 0; ai < 2; ++ai)
#pragma unroll
                for (int m = 0; m < 4; ++m) { _Float16* rowp = O + (size_t)(row0 + ai * HALF + m * 16) * 1024 + cb;
#pragma unroll
                    for (int bj = 0; bj < 2; ++bj) { typedef _Float16 h16x8 __attribute__((ext_vector_type(8))); h16x8 o;
#pragma unroll
                        for (int n = 0; n < 2; ++n) { const f32x4 sg = vrcp(vexp2(acc[ai][bj][m][n] * -1.4426950408889634f) + 1.0f);
                            const f32x4 lf = vlog2(lb[bj][n] + (1.0f - lb[bj][n]) * sg);
                            o[4 * n + 0] = (_Float16)lf[0]; o[4 * n + 1] = (_Float16)lf[1]; o[4 * n + 2] = (_Float16)lf[2]; o[4 * n + 3] = (_Float16)lf[3]; }
                        *(h16x8*)(rowp + bj * HALF) = o; } }
        } else {
            bf16_t* O = Q + (size_t)(seg - (seg >> 2) * 2) * qstride;
#pragma unroll
            for (int ai = 0; ai < 2; ++ai)
#pragma unroll
                for (int m = 0; m < 4; ++m) { bf16_t* rowp = O + (size_t)(row0 + ai * HALF + m * 16) * 1024 + cb;
#pragma unroll
                    for (int bj = 0; bj < 2; ++bj) { f32x4 v0 = acc[ai][bj][m][0], v1 = acc[ai][bj][m][1];
                        if (seg == 4) { v0 = v0 * vrcp(vexp2(v0 * -1.4426950408889634f) + 1.0f); v1 = v1 * vrcp(vexp2(v1 * -1.4426950408889634f) + 1.0f); }
                        u32x4 w; w.x = cvt_pk_bf16(v0[0], v0[1]); w.y = cvt_pk_bf16(v0[2], v0[3]); w.z = cvt_pk_bf16(v1[0], v1[1]); w.w = cvt_pk_bf16(v1[2], v1[3]);
                        *(u32x4*)(rowp + bj * HALF) = w; } }
        }
    }
};
template <bool B16> struct RawOf { typedef u32x4 T; };
template <> struct RawOf<true> { typedef u32x2 T; };
template <bool BASE16, bool OUT16> struct EpiResGate {
    static constexpr bool PERM = false, AFTER_DRAIN = false, LDS_BIAS = false;
    const void* base; void* out; const float* gate; int gate_bstride; int rows_per_batch; const float* bias;
    __device__ __forceinline__ void operator()(const f32x4 (&acc)[2][2][4][2], const Unit& u, int wr, int wc, int fr, int fq) const {
        const int row0 = u.pm * BM + wr * 64 + fr, col0 = u.pn * BM + wc * 32 + 4 * fq;
        const float* gv_ = gate + (size_t)((u.pm * BM) / rows_per_batch) * gate_bstride;
        f32x4 gv[2][2], bv[2][2];
#pragma unroll
        for (int bj = 0; bj < 2; ++bj)
#pragma unroll
            for (int n = 0; n < 2; ++n) { gv[bj][n] = *(const f32x4*)(gv_ + col0 + bj * HALF + n * 16); bv[bj][n] = bias ? *(const f32x4*)(bias + col0 + bj * HALF + n * 16) : (f32x4){0.f, 0.f, 0.f, 0.f}; }
        typedef typename RawOf<BASE16>::T raw_t;
        raw_t rb[2][8];
#define ERG_LOAD(b_, dst_) do { _Pragma("unroll") for (int mm = 0; mm < 2; ++mm) _Pragma("unroll") for (int bj = 0; bj < 2; ++bj) _Pragma("unroll") for (int n = 0; n < 2; ++n) { \
            const size_t o = (size_t)(row0 + ((b_) >> 1) * HALF + (2 * ((b_) & 1) + mm) * 16) * 1024 + col0 + bj * HALF + n * 16; \
            if constexpr (BASE16) dst_[mm * 4 + bj * 2 + n] = *(const raw_t*)((const bf16_t*)base + o); else dst_[mm * 4 + bj * 2 + n] = *(const raw_t*)((const float*)base + o); } } while (0)
        ERG_LOAD(0, rb[0]);
#pragma unroll
        for (int b = 0; b < 4; ++b) {
            if (b < 3) ERG_LOAD(b + 1, rb[(b + 1) & 1]);
            const int ai = b >> 1;
#pragma unroll
            for (int mm = 0; mm < 2; ++mm) { const int m = 2 * (b & 1) + mm;
#pragma unroll
                for (int bj = 0; bj < 2; ++bj)
#pragma unroll
                    for (int n = 0; n < 2; ++n) { const size_t o = (size_t)(row0 + ai * HALF + m * 16) * 1024 + col0 + bj * HALF + n * 16; f32x4 bs; const raw_t w = rb[b & 1][mm * 4 + bj * 2 + n];
                        if constexpr (BASE16) bs = (f32x4){__builtin_bit_cast(float, w[0] << 16), __builtin_bit_cast(float, w[0] & 0xffff0000u), __builtin_bit_cast(float, w[1] << 16), __builtin_bit_cast(float, w[1] & 0xffff0000u)};
                        else bs = __builtin_bit_cast(f32x4, w);
                        const f32x4 r = bs + gv[bj][n] * (acc[ai][bj][m][n] + bv[bj][n]);
                        if constexpr (OUT16) *(u32x2*)((bf16_t*)out + o) = (u32x2){cvt_pk_bf16(r[0], r[1]), cvt_pk_bf16(r[2], r[3])};
                        else *(f32x4*)((float*)out + o) = r; } }
        }
#undef ERG_LOAD
    }
};
template <int MODE, bool OUT8 = false, int OSCALE = 1, bool WT = false, bool LB = false> struct EpiPair {
    static constexpr bool PERM = true, AFTER_DRAIN = false, LDS_BIAS = LB;
    bf16_t* O; const float* bias0; const PG8_LAS float* lb;
    __device__ __forceinline__ void stage_bias(const Unit& u, int lane) const {
        const float* src = bias0 + (MODE == 0 ? (size_t)u.e * 2048 : 0) + (lane < 32 ? 0 : 1024 - 128) + u.pn * HALF + lane * 4;
        __builtin_amdgcn_global_load_lds((const unsigned*)src, (PG8_LAS unsigned*)lb, 16, 0, 0);
    }
    static __device__ __forceinline__ f32x4 vsig(f32x4 x, float negscale) {
        const f32x4 t = x * negscale; f32x4 e; e[0] = __builtin_amdgcn_exp2f(t[0]); e[1] = __builtin_amdgcn_exp2f(t[1]); e[2] = __builtin_amdgcn_exp2f(t[2]); e[3] = __builtin_amdgcn_exp2f(t[3]);
        const f32x4 d = e + 1.0f; f32x4 r; r[0] = __builtin_amdgcn_rcpf(d[0]); r[1] = __builtin_amdgcn_rcpf(d[1]); r[2] = __builtin_amdgcn_rcpf(d[2]); r[3] = __builtin_amdgcn_rcpf(d[3]); return r; }
    __device__ __forceinline__ void operator()(const f32x4 (&acc)[2][2][4][2], const Unit& u, int wr, int wc, int fr, int fq) const {
        const float* bias = bias0 + (MODE == 0 ? (size_t)u.e * 2048 : 0);
        const int row0 = u.pm * BM + wr * 64 + fr, cg = u.pn * HALF + wc * 32 + 8 * fq;
        f32x4 b0[2], b1[2];
#pragma unroll
        for (int n = 0; n < 2; ++n) {
            if constexpr (LB) { b0[n] = *(const PG8_LAS f32x4*)(lb + wc * 32 + 8 * fq + 4 * n); b1[n] = *(const PG8_LAS f32x4*)(lb + 128 + wc * 32 + 8 * fq + 4 * n); }
            else { b0[n] = *(const f32x4*)(bias + cg + 4 * n); b1[n] = *(const f32x4*)(bias + 1024 + cg + 4 * n); } }
#pragma unroll
        for (int ai = 0; ai < 2; ++ai)
#pragma unroll
            for (int m = 0; m < 4; ++m) { bf16_t* rowp = O + (size_t)(row0 + ai * HALF + m * 16) * 1024 + cg; f32x4 r[2];
#pragma unroll
                for (int n = 0; n < 2; ++n) { const f32x4 g = acc[ai][0][m][n] + b0[n], up = acc[ai][1][m][n] + b1[n];
                    if (MODE == 0) { const f32x4 gg = __builtin_elementwise_min(g, (f32x4){7.0f, 7.0f, 7.0f, 7.0f});
                        const f32x4 uu = __builtin_elementwise_min(__builtin_elementwise_max(up, (f32x4){-7.0f, -7.0f, -7.0f, -7.0f}), (f32x4){7.0f, 7.0f, 7.0f, 7.0f});
                        r[n] = (uu * (float)OSCALE + (float)OSCALE) * (gg * vsig(gg, -1.702f * 1.4426950408889634f)); }
                    else r[n] = (g * (float)OSCALE) * vsig(up, -1.4426950408889634f); }
                if constexpr (OUT8) {
                    int w0 = 0, w1 = 0;
                    w0 = __builtin_amdgcn_cvt_pk_fp8_f32(r[0][0], r[0][1], w0, false); w0 = __builtin_amdgcn_cvt_pk_fp8_f32(r[0][2], r[0][3], w0, true);
                    w1 = __builtin_amdgcn_cvt_pk_fp8_f32(r[1][0], r[1][1], w1, false); w1 = __builtin_amdgcn_cvt_pk_fp8_f32(r[1][2], r[1][3], w1, true);
                    if constexpr (WT) __hip_atomic_store((unsigned long long*)((unsigned char*)O + (size_t)(row0 + ai * HALF + m * 16) * 1024 + cg), ((unsigned long long)(unsigned)w1 << 32) | (unsigned)w0, __ATOMIC_RELAXED, __HIP_MEMORY_SCOPE_AGENT);
                    else *(u32x2*)((unsigned char*)O + (size_t)(row0 + ai * HALF + m * 16) * 1024 + cg) = (u32x2){(unsigned)w0, (unsigned)w1};
                } else {
                u32x4 w; w.x = cvt_pk_bf16(r[0][0], r[0][1]); w.y = cvt_pk_bf16(r[0][2], r[0][3]); w.z = cvt_pk_bf16(r[1][0], r[1][1]); w.w = cvt_pk_bf16(r[1][2], r[1][3]);
                *(u32x4*)rowp = w; } }
    }
};
template <bool OUT8, int OSCALE, bool LB = false> struct EpiMoeOut {
    static constexpr bool PERM = true, AFTER_DRAIN = false, LDS_BIAS = LB;
    bf16_t* O; const float* bias0; const PG8_LAS float* lb;
    __device__ __forceinline__ void stage_bias(const Unit& u, int lane) const {
        __builtin_amdgcn_global_load_lds((const unsigned*)(bias0 + (size_t)u.e * 1024 + u.pn * BM + lane * 4), (PG8_LAS unsigned*)lb, 16, 0, 0);
    }
    __device__ __forceinline__ void operator()(const f32x4 (&acc)[2][2][4][2], const Unit& u, int wr, int wc, int fr, int fq) const {
        const float* bias = bias0 + (size_t)u.e * 1024;
        const int row0 = u.pm * BM + wr * 64 + fr, col0 = u.pn * BM + wc * 32 + 8 * fq;
        f32x4 bv[2][2];
#pragma unroll
        for (int bj = 0; bj < 2; ++bj)
#pragma unroll
            for (int n = 0; n < 2; ++n) {
                if constexpr (LB) bv[bj][n] = *(const PG8_LAS f32x4*)(lb + wc * 32 + 8 * fq + bj * HALF + 4 * n);
                else bv[bj][n] = *(const f32x4*)(bias + col0 + bj * HALF + 4 * n); }
#pragma unroll
        for (int ai = 0; ai < 2; ++ai)
#pragma unroll
            for (int m = 0; m < 4; ++m) { const int r = row0 + ai * HALF + m * 16;
#pragma unroll
                for (int bj = 0; bj < 2; ++bj) { const f32x4 v0 = acc[ai][bj][m][0] + bv[bj][0], v1 = acc[ai][bj][m][1] + bv[bj][1];
                    if constexpr (OUT8) { const f32x4 lim = (f32x4){448.0f, 448.0f, 448.0f, 448.0f};
                        const f32x4 s0 = __builtin_elementwise_min(__builtin_elementwise_max(v0 * (float)OSCALE, -lim), lim), s1 = __builtin_elementwise_min(__builtin_elementwise_max(v1 * (float)OSCALE, -lim), lim); int w0 = 0, w1 = 0;
                        w0 = __builtin_amdgcn_cvt_pk_fp8_f32(s0[0], s0[1], w0, false); w0 = __builtin_amdgcn_cvt_pk_fp8_f32(s0[2], s0[3], w0, true);
                        w1 = __builtin_amdgcn_cvt_pk_fp8_f32(s1[0], s1[1], w1, false); w1 = __builtin_amdgcn_cvt_pk_fp8_f32(s1[2], s1[3], w1, true);
                        *(u32x2*)((unsigned char*)O + (size_t)r * 1024 + col0 + bj * HALF) = (u32x2){(unsigned)w0, (unsigned)w1};
                    } else { u32x4 w; w.x = cvt_pk_bf16(v0[0], v0[1]); w.y = cvt_pk_bf16(v0[2], v0[3]); w.z = cvt_pk_bf16(v1[0], v1[1]); w.w = cvt_pk_bf16(v1[2], v1[3]);
                        *(u32x4*)(O + (size_t)r * 1024 + col0 + bj * HALF) = w; } } }
    }
};

template <class Epi, class Sched, bool ALIGN_EPI = false, bool SP2 = false, bool F8 = false, int SCW = 0x7F7F7F7F, int SCA = 0x7F7F7F7F, bool GATHER = false, int NS = 0, bool ZC = F8>
__device__ __forceinline__ void gemm_phase(PG8_LAS unsigned char* lds, const Gemm g, const Sched& S, const Epi& E) {
    const int tid = threadIdx.x, wid = __builtin_amdgcn_readfirstlane(tid >> 6), lane = tid & 63, wr = wid >> 2, wc = wid & 3, fr = lane & 15, fq = lane >> 4;
    const int K = g.K, nt = K / BK;
    unsigned voffA[2], voffB[2]; int stR[2], stC[2];
#pragma unroll
    for (int i = 0; i < 2; ++i) { int R, C; stage_rc(tid * 16 + i * 8192, R, C); const int Rb = Epi::PERM ? ((R & ~31) + perm32(R & 31)) : R; stR[i] = R; stC[i] = C;
        voffA[i] = (unsigned)(R * K + C) * 2u; voffB[i] = (unsigned)(Rb * K + C) * 2u; }
    const size_t kstep = (size_t)(BK * 2);
    const size_t hstep = (size_t)HALF * K * 2;
    const size_t tstep = 2 * hstep;
    unsigned vc[2][2], vn[2][2];
#pragma unroll
    for (int h = 0; h < 2; ++h)
#pragma unroll
        for (int i = 0; i < 2; ++i) {
            if constexpr (GATHER) vc[h][i] = (unsigned)g.tt[h * HALF + stR[i]] * (unsigned)(K * 2) + (unsigned)stC[i] * 2u;
            else vc[h][i] = voffA[i] + (unsigned)h * (unsigned)hstep;
            vn[h][i] = vc[h][i]; }
    const unsigned ldsw = (unsigned)wid * 1024u;
    const int aoff = lds_byte(wr * 64 + fr, fq * 8), boff = lds_byte(wc * 32 + fr, fq * 8);
#define PG8_SA(b, h) (((b) * 2 + (h)) * HTB)
#define PG8_SB(b, h) ((4 + (b) * 2 + (h)) * HTB)
#define PG8_STAGE(bufoff, gbase, voff) do { _Pragma("unroll") for (int _i = 0; _i < 2; ++_i) \
        __builtin_amdgcn_global_load_lds((const unsigned*)((const char*)(gbase) + (voff)[_i]), (PG8_LAS unsigned*)(lds + (bufoff) + ldsw + _i * 8192), 16, 0, 0); } while (0)
#define PG8_LDA(dst, b, h) do { _Pragma("unroll") for (int m = 0; m < 4; ++m) _Pragma("unroll") for (int k = 0; k < 2; ++k) dst[m][k] = *(const PG8_LAS bf16x8*)(lds + PG8_SA(b, h) + aoff + m * 2048 + k * 1024); } while (0)
#define PG8_LDB(dst, b, h) do { _Pragma("unroll") for (int n = 0; n < 2; ++n) _Pragma("unroll") for (int k = 0; k < 2; ++k) dst[n][k] = *(const PG8_LAS bf16x8*)(lds + PG8_SB(b, h) + boff + n * 2048 + k * 1024); } while (0)
#define PG8_MMA(ai, bj, At, Bt) do { __builtin_amdgcn_s_setprio(1); \
        if constexpr (!F8) { _Pragma("unroll") for (int m = 0; m < 4; ++m) _Pragma("unroll") for (int n = 0; n < 2; ++n) _Pragma("unroll") for (int k = 0; k < 2; ++k) \
            acc[ai][bj][m][n] = __builtin_amdgcn_mfma_f32_16x16x32_bf16(Bt[n][k], At[m][k], acc[ai][bj][m][n], 0, 0, 0); } \
        else { const int scw_ = SCW, sca_ = SCA; _Pragma("unroll") for (int m = 0; m < 4; ++m) _Pragma("unroll") for (int n = 0; n < 2; ++n) { \
            const i32x8 wf_ = __builtin_shufflevector(__builtin_bit_cast(i32x4, Bt[n][0]), __builtin_bit_cast(i32x4, Bt[n][1]), 0, 1, 2, 3, 4, 5, 6, 7); \
            const i32x8 af_ = __builtin_shufflevector(__builtin_bit_cast(i32x4, At[m][0]), __builtin_bit_cast(i32x4, At[m][1]), 0, 1, 2, 3, 4, 5, 6, 7); \
            asm volatile("v_mfma_scale_f32_16x16x128_f8f6f4 %0, %1, %2, %0, %3, %4 op_sel_hi:[0,0,0]" : "+v"(acc[ai][bj][m][n]) : "v"(wf_), "v"(af_), "v"(scw_), "v"(sca_)); } } \
        __builtin_amdgcn_s_setprio(0); } while (0)
#define PG8_MMAZ(ai, bj, At, Bt) do { __builtin_amdgcn_s_setprio(1); \
        if constexpr (!F8) { _Pragma("unroll") for (int m = 0; m < 4; ++m) _Pragma("unroll") for (int n = 0; n < 2; ++n) { \
            acc[ai][bj][m][n] = __builtin_amdgcn_mfma_f32_16x16x32_bf16(Bt[n][0], At[m][0], (f32x4){0.f, 0.f, 0.f, 0.f}, 0, 0, 0); \
            acc[ai][bj][m][n] = __builtin_amdgcn_mfma_f32_16x16x32_bf16(Bt[n][1], At[m][1], acc[ai][bj][m][n], 0, 0, 0); } } \
        else { const int scw_ = SCW, sca_ = SCA; _Pragma("unroll") for (int m = 0; m < 4; ++m) _Pragma("unroll") for (int n = 0; n < 2; ++n) { \
            const i32x8 wf_ = __builtin_shufflevector(__builtin_bit_cast(i32x4, Bt[n][0]), __builtin_bit_cast(i32x4, Bt[n][1]), 0, 1, 2, 3, 4, 5, 6, 7); \
            const i32x8 af_ = __builtin_shufflevector(__builtin_bit_cast(i32x4, At[m][0]), __builtin_bit_cast(i32x4, At[m][1]), 0, 1, 2, 3, 4, 5, 6, 7); \
            asm volatile("v_mfma_scale_f32_16x16x128_f8f6f4 %0, %1, %2, 0, %3, %4 op_sel_hi:[0,0,0]" : "=&v"(acc[ai][bj][m][n]) : "v"(wf_), "v"(af_), "v"(scw_), "v"(sca_)); } } \
        __builtin_amdgcn_s_setprio(0); } while (0)
#define PG8_WAIT_V(n) asm volatile("s_waitcnt vmcnt(" #n ")" ::: "memory")
#define PG8_WAIT_VN(n) asm volatile("s_waitcnt vmcnt(%0)" :: "n"(n) : "memory")
#define PG8_WAIT_L(n) asm volatile("s_waitcnt lgkmcnt(" #n ")" ::: "memory")
#define PG8_BAR __builtin_amdgcn_s_barrier()
#define PG8_SCHED __builtin_amdgcn_sched_barrier(0)
    Unit cur, nxt; int ui = 0, ppm = 0;
    if (!S.next(0, cur)) return;
#if KL_PROBE
    if (Sched::PUBLISH && S.probe_on() && blockIdx.x == 0 && wid == 0) { const unsigned long long t0_ = __builtin_amdgcn_s_memtime(); if (lane == 0) { PG8_LAS unsigned* kp = (PG8_LAS unsigned*)(unsigned)KLP_LDS; kp[6] = (unsigned)t0_; kp[7] = (unsigned)(t0_ >> 32); } }
#endif
    static_assert(SP2, "this build keeps only the SP2 K-loop");
    f32x4 acc[2][2][4][2];
    if constexpr (!ZC) {
#pragma unroll
    for (int a = 0; a < 2; ++a)
#pragma unroll
        for (int b = 0; b < 2; ++b)
#pragma unroll
            for (int m = 0; m < 4; ++m)
#pragma unroll
                for (int n = 0; n < 2; ++n) acc[a][b][m][n] = (f32x4){0.f, 0.f, 0.f, 0.f};
    }
    bf16x8 At[4][2], B0[2][2], B1[2][2];
    const char* cA = (const char*)g.A + (GATHER ? (size_t)0 : (size_t)cur.pm * tstep); const char* cB = (const char*)g.Bt + (size_t)cur.e * g.estride + (size_t)cur.pn * tstep;
    S.a_ready(cur, 0);
    if constexpr (SP2) {
        PG8_STAGE(PG8_SB(0, 0), cB, voffB); PG8_STAGE(PG8_SB(0, 1), cB + hstep, voffB); PG8_STAGE(PG8_SA(0, 0), cA, vc[0]); PG8_STAGE(PG8_SA(0, 1), cA, vc[1]);
        if (wr == 1) PG8_BAR;
        PG8_WAIT_V(2); PG8_BAR;
        PG8_STAGE(PG8_SB(1, 0), cB + kstep, voffB); PG8_STAGE(PG8_SA(1, 0), cA + kstep, vc[0]); PG8_STAGE(PG8_SB(1, 1), cB + hstep + kstep, voffB);
        PG8_WAIT_V(6); PG8_BAR;
    } else {
        PG8_STAGE(PG8_SB(0, 0), cB, voffB); PG8_STAGE(PG8_SA(0, 0), cA, vc[0]); PG8_STAGE(PG8_SB(0, 1), cB + hstep, voffB); PG8_STAGE(PG8_SA(0, 1), cA, vc[1]);
        if (wr == 1) PG8_BAR;
        PG8_WAIT_V(4); PG8_BAR;
        PG8_STAGE(PG8_SB(1, 0), cB + kstep, voffB); PG8_STAGE(PG8_SA(1, 0), cA + kstep, vc[0]); PG8_STAGE(PG8_SB(1, 1), cB + hstep + kstep, voffB);
        PG8_WAIT_V(6); PG8_BAR;
    }
    for (;;) {
        const bool has_next = S.next(ui + 1, nxt);
        if constexpr (GATHER) { if (has_next) {
#pragma unroll
            for (int h = 0; h < 2; ++h)
#pragma unroll
                for (int i = 0; i < 2; ++i) vn[h][i] = (unsigned)g.tt[(ui + 1) * BM + h * HALF + stR[i]] * (unsigned)(K * 2) + (unsigned)stC[i] * 2u; } }
        const char* nA = (has_next && !GATHER) ? (const char*)g.A + (size_t)nxt.pm * tstep : cA; const char* nB = has_next ? (const char*)g.Bt + (size_t)nxt.e * g.estride + (size_t)nxt.pn * tstep : cB;
#if KL_PROBE
        if (Sched::PUBLISH && S.probe_on() && blockIdx.x == 0 && wid == 0) { const unsigned long long t0_ = __builtin_amdgcn_s_memtime(); if (lane == 0) { PG8_LAS unsigned* kp = (PG8_LAS unsigned*)(unsigned)KLP_LDS; kp[4] = (unsigned)t0_; kp[5] = (unsigned)(t0_ >> 32); } }
#endif
#define PG8_WAIT_V8R do { if constexpr (NS > 0) { PG8_WAIT_VN(8 + NS); if (!rlx) PG8_WAIT_V(8); } else PG8_WAIT_V(8); } while (0)
#define PG8_TRIP(MMAK_, FIRST_) { \
            const bool last = (t == nt - 2); \
            unsigned vs[2][2]; \
            _Pragma("unroll") for (int h = 0; h < 2; ++h) _Pragma("unroll") for (int i = 0; i < 2; ++i) vs[h][i] = (GATHER && last) ? vn[h][i] : vc[h][i]; \
            const char* a1 = cA + (size_t)(t + 1) * kstep;                                             \
            const char* a2 = last ? nA : cA + (size_t)(t + 2) * kstep; const char* b2 = last ? nB : cB + (size_t)(t + 2) * kstep;     \
            const char* a3 = a2 + kstep; const char* b3 = b2 + kstep;                                \
            if (last && has_next) S.a_ready(nxt, ui + 1); \
            if constexpr (Epi::LDS_BIAS) { if (last && wid == 0) E.stage_bias(cur, lane); }     \
            if constexpr (Sched::PUBLISH) { if (t == 2 && ui > 0) S.publish(ppm, lane); }     \
            const bool rlx = (NS > 0) && (FIRST_) && (ui > 0); \
              \
            PG8_LDB(B0, 0, 0); PG8_LDB(B1, 0, 1); PG8_SCHED; PG8_LDA(At, 0, 0); if (!rlx) PG8_STAGE(PG8_SA(1, 1), a1, vc[1]); \
            PG8_WAIT_V8R; PG8_WAIT_L(0); PG8_BAR; MMAK_(0, 0, At, B0); MMAK_(0, 1, At, B1); PG8_BAR; PG8_SCHED; \
              \
            PG8_LDA(At, 0, 1); PG8_STAGE(PG8_SB(0, 0), b2, voffB); PG8_STAGE(PG8_SB(0, 1), b2 + hstep, voffB); PG8_STAGE(PG8_SA(0, 0), a2, vs[0]); \
            PG8_WAIT_V8R; PG8_WAIT_L(0); PG8_BAR; MMAK_(1, 0, At, B0); MMAK_(1, 1, At, B1); PG8_BAR; PG8_SCHED; \
              \
            PG8_LDB(B0, 1, 0); PG8_LDB(B1, 1, 1); PG8_SCHED; PG8_LDA(At, 1, 0); PG8_STAGE(PG8_SA(0, 1), a2, vs[1]); \
            PG8_WAIT_V8R; PG8_WAIT_L(0); PG8_BAR; PG8_MMA(0, 0, At, B0); PG8_MMA(0, 1, At, B1); PG8_BAR; PG8_SCHED; \
              \
            PG8_LDA(At, 1, 1); PG8_STAGE(PG8_SB(1, 0), b3, voffB); PG8_STAGE(PG8_SB(1, 1), b3 + hstep, voffB); PG8_STAGE(PG8_SA(1, 0), a3, vs[0]); \
            PG8_WAIT_V(8); PG8_WAIT_L(0); PG8_BAR; PG8_MMA(1, 0, At, B0); PG8_MMA(1, 1, At, B1); PG8_BAR; PG8_SCHED; }
        if constexpr (ZC) {
            { const int t = 0; PG8_TRIP(PG8_MMAZ, true) }
            for (int t = 2; t < nt; t += 2) PG8_TRIP(PG8_MMA, false)
        } else {
            for (int t = 0; t < nt; t += 2) PG8_TRIP(PG8_MMA, t == 0)
        }
#if KL_PROBE
        if (Sched::PUBLISH && S.probe_on() && blockIdx.x == 0 && wid == 0) { const unsigned long long t1_ = __builtin_amdgcn_s_memtime(); if (lane == 0) { PG8_LAS unsigned* kp = (PG8_LAS unsigned*)(unsigned)KLP_LDS; const unsigned long long d = t1_ - (((unsigned long long)kp[5] << 32) | kp[4]); const unsigned long long acc_ = (((unsigned long long)kp[1] << 32) | kp[0]) + d; kp[0] = (unsigned)acc_; kp[1] = (unsigned)(acc_ >> 32); kp[2] += 1u; } }
#endif
        if constexpr (ALIGN_EPI) { if (wr == 0) PG8_BAR; }
        if constexpr (NS > 0) { static_assert(SP2 && ALIGN_EPI, "NS needs SP2 and ALIGN_EPI"); if (has_next) PG8_STAGE(PG8_SA(1, 1), nA + kstep, vn[1]); }
        if constexpr (!Epi::AFTER_DRAIN) { E(acc, cur, wr, wc, fr, fq); S.done(cur); ppm = cur.pm; }
        if (!has_next) break;
        if constexpr (!ZC) {
#pragma unroll
        for (int a = 0; a < 2; ++a)
#pragma unroll
            for (int b = 0; b < 2; ++b)
#pragma unroll
                for (int m = 0; m < 4; ++m)
#pragma unroll
                    for (int n = 0; n < 2; ++n) acc[a][b][m][n] = (f32x4){0.f, 0.f, 0.f, 0.f};
        }
        cur = nxt; cA = nA; cB = nB; ++ui;
        if constexpr (GATHER) {
#pragma unroll
            for (int h = 0; h < 2; ++h)
#pragma unroll
                for (int i = 0; i < 2; ++i) vc[h][i] = vn[h][i]; }
        if constexpr (ALIGN_EPI) { if (wr == 1) PG8_BAR; }
    }
#if KL_PROBE
    if (Sched::PUBLISH && S.probe_on() && blockIdx.x == 0 && wid == 0) { const unsigned long long t1_ = __builtin_amdgcn_s_memtime(); if (lane == 0) { PG8_LAS unsigned* kp = (PG8_LAS unsigned*)(unsigned)KLP_LDS; const unsigned long long d = t1_ - (((unsigned long long)kp[7] << 32) | kp[6]); const unsigned long long acc_ = (((unsigned long long)kp[9] << 32) | kp[8]) + d; kp[8] = (unsigned)acc_; kp[9] = (unsigned)(acc_ >> 32); } }
#endif
    PG8_WAIT_V(0); if constexpr (Sched::PUBLISH) S.publish(ppm, lane);
    if constexpr (!ALIGN_EPI) { if (wr == 0) PG8_BAR; }
    PG8_BAR;
    if constexpr (Epi::AFTER_DRAIN) { E.fused(acc, cur, wr, wc, fr, fq, lds, wid, lane); S.done(cur); }
#undef PG8_SA
#undef PG8_SB
#undef PG8_STAGE
#undef PG8_LDA
#undef PG8_LDB
#undef PG8_MMA
#undef PG8_MMAZ
#undef PG8_TRIP
#undef PG8_WAIT_V
#undef PG8_WAIT_VN
#undef PG8_WAIT_V8R
#undef PG8_WAIT_L
#undef PG8_BAR
#undef PG8_SCHED
}
}


constexpr int D = 1024, NBATCH = 2, SEQ = 16384, NTOK = NBATCH * SEQ, CTXL = 256, NCTX = NBATCH * CTXL, MROWS = NTOK + NCTX;
constexpr int NHEAD = 8, DK = 128, NE = 32, TOPK = 4, CONVW = 31, GRIDW = 64, GRIDR = SEQ / GRIDW;
constexpr int NWAVES = 8, NTHR = NWAVES * 64;
constexpr int MAXTILES = 544;
constexpr float EPS = 1e-6f;
enum { I_X = 0, I_C, I_CTX, I_CCTX, I_WADA, I_BADA, I_GMIX, I_GFFN, I_WHIN, I_HGAMMA, I_GHOUT, I_WHOUT, I_WCVIN, I_BCVIN, I_WCVDW, I_BCVDW, I_GCVLN, I_BCVLN, I_WCVOUT, I_BCVOUT,
       I_WR, I_BR, I_WE1, I_BE1, I_WE2, I_BE2, I_GFINAL, N_IN };

constexpr size_t MiB = 1u << 20;
constexpr size_t WS_CTL = 0, CTL_ZERO_BYTES = 1 * MiB;
constexpr size_t WS_MODS = 1 * MiB;
constexpr size_t WS_TOPE = 2 * MiB, WS_TOPW = 2 * MiB + 512 * 1024, WS_POS = 3 * MiB, WS_BCNT = 3 * MiB + 512 * 1024, WS_TILEE = WS_BCNT + 64 * 1024, WS_SLOTW = 4 * MiB;
constexpr size_t WS_SP = 5 * MiB, WS_SD = 8 * MiB;
constexpr size_t WS_WIN = 48 * MiB, WS_WOUT = 58 * MiB, WS_WCVIN = 60 * MiB, WS_WCVOUT = 64 * MiB, WS_W1 = 66 * MiB, WS_W2 = 322 * MiB;
constexpr size_t WS_X = 450 * MiB;
constexpr size_t WS_H = 578 * MiB;
constexpr size_t WS_Q = 644 * MiB, WS_V = 709 * MiB, WS_SG = 774 * MiB, WS_LFF = 839 * MiB, WS_LFB = 969 * MiB, WS_OF = 1099 * MiB, WS_OB = 1227 * MiB, WS_YIN = 1355 * MiB;
constexpr size_t WS_AS = 1419 * MiB, WS_ACT = 1555 * MiB, WS_YS = 1691 * MiB, WS_END = 1963 * MiB;
#ifndef F8_IN
#define F8_IN 0
#endif
#ifndef SPLIT_IN
#define SPLIT_IN 1
#endif
#ifndef TL_PROBE
#define TL_PROBE 0
#define TL_A (-1)
#define TL_B 0
#define TL_BODY 0
#endif
#ifndef CVF_PROBE
#define CVF_PROBE 0
#endif
#ifndef G_F8
#define G_F8 1
#endif
#ifndef F8_Y
#define F8_Y 1
#endif
constexpr int YSCALE = 16;
#ifndef F8_MISC
#define F8_MISC 1
#endif
constexpr size_t WS_H8 = WS_OF + 64 * MiB;
constexpr size_t WS_WIN8 = WS_WIN + 6 * MiB;
constexpr size_t WS_STOK = WS_AS;
constexpr int CW_MODF = 3200;
constexpr int CW_FLAT = 3072;
constexpr int CW_GCNT = 2048;
constexpr float W8SCALE = 64.0f;
constexpr size_t WS_U = WS_Q, WS_ZP = WS_V, WS_Z = WS_SG;
constexpr int CW_BAR = 4096;
constexpr int CW_XMAP = 32768;
constexpr int CW_TCNT = 65536;

constexpr int RING_OFF = 0, RING_BYTES = 131072;
constexpr int LDSCTL_OFF = 139264, MISC_OFF = LDSCTL_OFF + 320, EXTRA_OFF = LDSCTL_OFF + 1024;
constexpr int LDS_BYTES = 155648;

#define LAS __attribute__((address_space(3)))
typedef unsigned short bf16;
typedef unsigned v4u __attribute__((ext_vector_type(4)));
typedef unsigned v2u __attribute__((ext_vector_type(2)));
typedef float f32x4 __attribute__((ext_vector_type(4)));
typedef int v4i __attribute__((ext_vector_type(4)));
#define LDS_WAIT() asm volatile("s_waitcnt lgkmcnt(0)" ::: "memory")
#define VM_WAIT() asm volatile("s_waitcnt vmcnt(0)" ::: "memory")
__device__ __forceinline__ unsigned f2bf(float f) { unsigned u = __builtin_bit_cast(unsigned, f); return (u + 0x7fffu + ((u >> 16) & 1u)) >> 16; }
__device__ __forceinline__ unsigned pk2(float lo, float hi) { return f2bf(lo) | (f2bf(hi) << 16); }
__device__ __forceinline__ float bf_lo(unsigned u) { return __builtin_bit_cast(float, u << 16); }
__device__ __forceinline__ float bf_hi(unsigned u) { return __builtin_bit_cast(float, u & 0xffff0000u); }
__device__ __forceinline__ float bf2f(bf16 h) { return __builtin_bit_cast(float, ((unsigned)h) << 16); }
__device__ __forceinline__ float fsig(float x) { return __builtin_amdgcn_rcpf(1.0f + __expf(-x)); }
__device__ __forceinline__ float wave_sum(float v) {
#define WS_DPP(x, ctrl) __builtin_bit_cast(float, __builtin_amdgcn_update_dpp(0, __builtin_bit_cast(int, x), ctrl, 0xF, 0xF, true))
    v += WS_DPP(v, 0xB1);
    v += WS_DPP(v, 0x4E);
    v += WS_DPP(v, 0x141);
    v += WS_DPP(v, 0x140);
#undef WS_DPP
    const int vi = __builtin_bit_cast(int, v);
    return (__builtin_bit_cast(float, __builtin_amdgcn_readlane(vi, 0)) + __builtin_bit_cast(float, __builtin_amdgcn_readlane(vi, 16)))
         + (__builtin_bit_cast(float, __builtin_amdgcn_readlane(vi, 32)) + __builtin_bit_cast(float, __builtin_amdgcn_readlane(vi, 48)));
}

__device__ __forceinline__ float half_sum(float v) {
#define WS_DPP(x, ctrl) __builtin_bit_cast(float, __builtin_amdgcn_update_dpp(0, __builtin_bit_cast(int, x), ctrl, 0xF, 0xF, true))
    v += WS_DPP(v, 0xB1); v += WS_DPP(v, 0x4E); v += WS_DPP(v, 0x141); v += WS_DPP(v, 0x140);
#undef WS_DPP
    return v + __shfl_xor(v, 16);
}
__device__ __forceinline__ float sat8(float x) { return __builtin_amdgcn_fmed3f(x, -448.0f, 448.0f); }
__device__ __forceinline__ unsigned pk4_fp8(float a, float b, float c, float d) { int w = 0; w = __builtin_amdgcn_cvt_pk_fp8_f32(sat8(a), sat8(b), w, false); w = __builtin_amdgcn_cvt_pk_fp8_f32(sat8(c), sat8(d), w, true); return (unsigned)w; }
template <bool OUT8> __device__ __forceinline__ void store_row4(void* orow, int lane, int j, f32x4 y, float scale) {
    if constexpr (OUT8) ((unsigned*)orow)[lane + 64 * j] = pk4_fp8(y.x * scale, y.y * scale, y.z * scale, y.w * scale);
    else { v2u w; w.x = pk2(y.x, y.y); w.y = pk2(y.z, y.w); ((v2u*)orow)[lane + 64 * j] = w; }
}

#define XB_TMO      128
#define XB_XCNT(j)  (256  + 64 * (j))
#define XB_XSUB(j)  (1280 + 64 * (j))
#define XB_XGEN(j)  (2304 + 64 * (j))
#define XB_TOP      3328
#define XB_TOPGEN   3392
#define XCD_BAR_WORDS 3456
#define XB_SPIN_CAP (1u << 18)

__device__ __forceinline__ unsigned xb_ld(unsigned* p)              { return __hip_atomic_load(p, __ATOMIC_RELAXED, __HIP_MEMORY_SCOPE_AGENT); }
__device__ __forceinline__ unsigned xb_add(unsigned* p, unsigned v) { return __hip_atomic_fetch_add(p, v, __ATOMIC_RELAXED, __HIP_MEMORY_SCOPE_AGENT); }
__device__ __forceinline__ unsigned xb_xcc_id() { return (unsigned)__builtin_amdgcn_s_getreg((3 << 11) | 20) & 0xFu; }
#define XB_SPIN(cond, bar) do { unsigned _sp = 0; while (cond) { __builtin_amdgcn_s_sleep(1); \
    if ((++_sp & 255u) == 0u) { if (xb_ld(&(bar)[XB_TMO])) break; if (_sp > XB_SPIN_CAP) { atomicAdd(&(bar)[XB_TMO], 1u); break; } } } } while (0)

struct XcdBarrier {
    unsigned* bar; unsigned x;
    volatile LAS unsigned* st;
};

__device__ __forceinline__ XcdBarrier xcd_barrier_post(unsigned* bar, volatile LAS unsigned* st) {
    XcdBarrier b; b.bar = bar; b.x = xb_xcc_id(); b.st = st;
    if (threadIdx.x == 0) (void)xb_add(&bar[XB_XCNT(b.x)], 1u);
    return b;
}
__device__ __forceinline__ void xcd_barrier_complete(unsigned* bar, unsigned x, unsigned& nloc, unsigned& nx) {
    const unsigned G = gridDim.x * gridDim.y * gridDim.z;
    unsigned sum, cnt, mine, sp = 0u;
    for (;;) {
        sum = 0u; cnt = 0u; mine = 0u;
#pragma unroll
        for (unsigned j = 0; j < 16; ++j) { const unsigned c = xb_ld(&bar[XB_XCNT(j)]); sum += c; cnt += (c > 0u) ? 1u : 0u; mine = (j == x) ? c : mine; }
        if (sum == G) break;
        __builtin_amdgcn_s_sleep(1);
        if ((++sp & 255u) == 0u) { if (xb_ld(&bar[XB_TMO])) break; if (sp > XB_SPIN_CAP) { atomicAdd(&bar[XB_TMO], 1u); break; } }
    }
    nloc = mine > 0u ? mine : 1u; nx = cnt > 0u ? cnt : 1u;
}

__device__ __forceinline__ void xcd_barrier(const XcdBarrier& b) {
    asm volatile("s_waitcnt vmcnt(0)" ::: "memory");
    __syncthreads();
    if (threadIdx.x == 0) {
        unsigned* bar = b.bar;
        __builtin_amdgcn_s_waitcnt(0);
        unsigned nloc = b.st[0], nx = b.st[1];
        if (nloc == 0u) { xcd_barrier_complete(bar, b.x, nloc, nx); b.st[0] = nloc; b.st[1] = nx; }
        const unsigned old = xb_add(&bar[XB_XSUB(b.x)], 1u);
        const unsigned gen = old / nloc;
        if (old + 1u == (gen + 1u) * nloc) {
            __builtin_amdgcn_fence(__ATOMIC_RELEASE, "agent");
            asm volatile("s_waitcnt vmcnt(0)" ::: "memory");
            const unsigned og = xb_add(&bar[XB_TOP], 1u);
            const unsigned tg = og / nx;
            if (og + 1u == (tg + 1u) * nx) xb_add(&bar[XB_TOPGEN], 1u);
            else XB_SPIN(xb_ld(&bar[XB_TOPGEN]) == tg, bar);
            __builtin_amdgcn_fence(__ATOMIC_ACQUIRE, "agent");
            xb_add(&bar[XB_XGEN(b.x)], 1u);
            asm volatile("s_waitcnt vmcnt(0)" ::: "memory");
        } else {
            XB_SPIN(xb_ld(&bar[XB_XGEN(b.x)]) == gen, bar);
            __builtin_amdgcn_fence(__ATOMIC_ACQUIRE, "agent");
            asm volatile("s_waitcnt vmcnt(0)" ::: "memory");
        }
    }
    __syncthreads();
}

struct Args { const float* in[N_IN]; float* out; unsigned char* ws; int ph_lo, ph_hi, li, pad; };

__device__ __forceinline__ void p_mods(const Args& a, LAS unsigned char* lds, int tid, int lane, int wave) {
    LAS float* sc = (LAS float*)lds;
    LAS float* part = sc + 3 * D;
    float* MODS = (float*)(a.ws + WS_MODS);
    for (int i = tid; i < 3 * D; i += NTHR) { const int r = i >> 10, k = i & 1023; const float v = r < 2 ? a.in[I_C][r * D + k] : a.in[I_CCTX][k]; sc[i] = v * fsig(v); }
    __syncthreads();
    for (int item = blockIdx.x; item < 2 * 96; item += gridDim.x) {
        const int l = item / 96, cb = item % 96;
        const float* W = a.in[I_WADA] + (size_t)l * D * 6 * D + cb * 64 + lane;
        float a0 = 0.f, a1 = 0.f, a2 = 0.f;
#pragma unroll 16
        for (int kk = 0; kk < 128; ++kk) { const int k = wave * 128 + kk; const float w = W[(size_t)k * (6 * D)]; a0 += sc[k] * w; a1 += sc[D + k] * w; a2 += sc[2 * D + k] * w; }
        part[(wave * 3 + 0) * 64 + lane] = a0; part[(wave * 3 + 1) * 64 + lane] = a1; part[(wave * 3 + 2) * 64 + lane] = a2;
        __syncthreads();
        if (tid < 192) { const int r = tid >> 6, ln = tid & 63; float s = 0.f;
#pragma unroll
            for (int w = 0; w < 8; ++w) s += part[(w * 3 + r) * 64 + ln];
            __hip_atomic_store(&MODS[(size_t)(l * 3 + r) * (6 * D) + cb * 64 + ln], s + a.in[I_BADA][l * 6 * D + cb * 64 + ln], __ATOMIC_RELAXED, __HIP_MEMORY_SCOPE_AGENT); }
        asm volatile("s_waitcnt vmcnt(0)" ::: "memory");
        __syncthreads();
        if (item < 32 && tid == 0) (void)__hip_atomic_fetch_add((unsigned*)(a.ws + WS_CTL) + CW_MODF, 1u, __ATOMIC_RELAXED, __HIP_MEMORY_SCOPE_AGENT);
    }
}
__device__ __forceinline__ void wait_mods0(const Args& a, int tid) {
    if (tid == 0) { unsigned* f = (unsigned*)(a.ws + WS_CTL) + CW_MODF; unsigned sp = 0;
        while (__hip_atomic_load(f, __ATOMIC_RELAXED, __HIP_MEMORY_SCOPE_AGENT) < 32u) { __builtin_amdgcn_s_sleep(2); if (++sp > (1u << 22)) break; }
        __builtin_amdgcn_fence(__ATOMIC_ACQUIRE, "agent");
        asm volatile("s_waitcnt vmcnt(0)" ::: "memory"); }
    __syncthreads();
}
template <bool OUT8> __device__ __forceinline__ void transpose_item(const float* W, int K, int N, bf16* WT, bool paired, LAS float* scr, int item, int lane, int row_adj = 0) {
    const int nblk = N / 32, kb = item / nblk, nb = item % nblk, k0 = 64 * kb, n0 = 32 * nb;
    int d0 = n0 + row_adj; if (paired) { const int half = n0 >> 10, c = n0 & 1023; d0 = (c >> 7) * 256 + half * 128 + (c & 127); }
    float t[32];
#pragma unroll
    for (int i = 0; i < 32; ++i) { const int kk = 2 * i + (lane >> 5); t[i] = __builtin_nontemporal_load(&W[(size_t)(k0 + kk) * N + n0 + (lane & 31)]); }
#pragma unroll
    for (int i = 0; i < 32; ++i) { const int kk = 2 * i + (lane >> 5); scr[kk * 33 + (lane & 31)] = t[i]; }
    LDS_WAIT(); asm volatile("" ::: "memory");
    const int c = lane & 7;
#pragma unroll
    for (int j = 0; j < 4; ++j) { const int n = (lane >> 3) + 8 * j; const LAS float* s = scr + (8 * c) * 33 + n;
        if constexpr (OUT8) {
            int w0 = 0, w1 = 0;
            w0 = __builtin_amdgcn_cvt_pk_fp8_f32(s[0 * 33] * W8SCALE, s[1 * 33] * W8SCALE, w0, false); w0 = __builtin_amdgcn_cvt_pk_fp8_f32(s[2 * 33] * W8SCALE, s[3 * 33] * W8SCALE, w0, true);
            w1 = __builtin_amdgcn_cvt_pk_fp8_f32(s[4 * 33] * W8SCALE, s[5 * 33] * W8SCALE, w1, false); w1 = __builtin_amdgcn_cvt_pk_fp8_f32(s[6 * 33] * W8SCALE, s[7 * 33] * W8SCALE, w1, true);
            *(v2u*)((unsigned char*)WT + (size_t)(d0 + n) * K + k0 + 8 * c) = (v2u){(unsigned)w0, (unsigned)w1};
        } else {
        v4u o; o.x = pk2(s[0 * 33], s[1 * 33]); o.y = pk2(s[2 * 33], s[3 * 33]); o.z = pk2(s[4 * 33], s[5 * 33]); o.w = pk2(s[6 * 33], s[7 * 33]);
        *(v4u*)(WT + (size_t)(d0 + n) * K + k0 + 8 * c) = o; } }
    LDS_WAIT(); asm volatile("" ::: "memory");
}
__device__ __forceinline__ void p_weights(const Args& a, LAS unsigned char* lds, int lane, int wave) {
    LAS float* scr = (LAS float*)(lds + RING_OFF + wave * 16384);
    const int gw = blockIdx.x * NWAVES + wave, NGW = gridDim.x * NWAVES;
    constexpr int I_IN = 16 * 160, I_SQ = 16 * 32, I_CV = 16 * 64, I_E1 = 64 * 1024, I_E2 = 64 * 512;
    constexpr int NITEMS = I_IN + I_SQ + I_CV + I_SQ + I_E1 + I_E2;
    unsigned char* ws = a.ws;
    for (int it = (gridDim.x == 256 ? I_E1 + I_E2 : 0) + gw; it < NITEMS; it += NGW) {
        int r = it;
        if (r < I_E1) { const int mi = r >> 10; transpose_item<true>(a.in[I_WE1] + (size_t)mi * D * 2 * D, D, 2 * D, (bf16*)(ws + WS_W1 + (size_t)mi * 2 * D * D), true, scr, r & 1023, lane); continue; } r -= I_E1;
        if (r < I_E2) { const int mi = r >> 9; transpose_item<true>(a.in[I_WE2] + (size_t)mi * D * D, D, D, (bf16*)(ws + WS_W2 + (size_t)mi * D * D), false, scr, r & 511, lane); continue; } r -= I_E2;
        if (r < I_IN) {
            if (SPLIT_IN) { const int sgm = ((r % 160) * 32) >> 10;
                if (sgm == 2 || sgm == 3 || (G_F8 && sgm == 4)) transpose_item<true>(a.in[I_WHIN], D, 5 * D, (bf16*)(ws + WS_WIN8), false, scr, r, lane, -2 * D);
                else transpose_item<false>(a.in[I_WHIN], D, 5 * D, (bf16*)(ws + WS_WIN), false, scr, r, lane, sgm == 4 ? -2 * D : 0);
            } else transpose_item<F8_IN != 0>(a.in[I_WHIN], D, 5 * D, (bf16*)(ws + WS_WIN), false, scr, r, lane);
            continue; } r -= I_IN;
        if (r < I_SQ) { transpose_item<F8_MISC != 0>(a.in[I_WHOUT], D, D, (bf16*)(ws + WS_WOUT), false, scr, r, lane); continue; } r -= I_SQ;
        if (r < I_CV) { transpose_item<F8_MISC != 0>(a.in[I_WCVIN], D, 2 * D, (bf16*)(ws + WS_WCVIN), true, scr, r, lane); continue; } r -= I_CV;
        transpose_item<F8_MISC != 0>(a.in[I_WCVOUT], D, D, (bf16*)(ws + WS_WCVOUT), false, scr, r, lane);
    }
}
constexpr int CV_WAVES = 7, CV_L0 = 32 * 512 + 32 * 256, CV_ALL = 2 * CV_L0;
__device__ __forceinline__ void transpose_item64(const float* W, int K, int N, unsigned char* WT, bool paired, LAS float* scr, int item, int lane) {
    const int nblk = N / 64, kb = item / nblk, nb = item % nblk, k0 = 64 * kb, n0 = 64 * nb;
    int d0 = n0; if (paired) { const int half = n0 >> 10, c = n0 & 1023; d0 = (c >> 7) * 256 + half * 128 + (c & 127); }
    float t[64];
#pragma unroll
    for (int i = 0; i < 64; ++i) t[i] = __builtin_nontemporal_load(&W[(size_t)(k0 + i) * N + n0 + lane]);
#pragma unroll
    for (int i = 0; i < 64; ++i) scr[i * 65 + lane] = t[i];
    LDS_WAIT(); asm volatile("" ::: "memory");
    const int c = lane & 3;
#pragma unroll
    for (int j = 0; j < 4; ++j) { const int n = (lane >> 2) + 16 * j; const LAS float* s = scr + (16 * c) * 65 + n;
        v4u o;
        o.x = pk4_fp8(s[0 * 65] * W8SCALE, s[1 * 65] * W8SCALE, s[2 * 65] * W8SCALE, s[3 * 65] * W8SCALE); o.y = pk4_fp8(s[4 * 65] * W8SCALE, s[5 * 65] * W8SCALE, s[6 * 65] * W8SCALE, s[7 * 65] * W8SCALE);
        o.z = pk4_fp8(s[8 * 65] * W8SCALE, s[9 * 65] * W8SCALE, s[10 * 65] * W8SCALE, s[11 * 65] * W8SCALE); o.w = pk4_fp8(s[12 * 65] * W8SCALE, s[13 * 65] * W8SCALE, s[14 * 65] * W8SCALE, s[15 * 65] * W8SCALE);
        *(v4u*)(WT + (size_t)(d0 + n) * K + k0 + 16 * c) = o; }
    LDS_WAIT(); asm volatile("" ::: "memory");
}
__device__ __forceinline__ void cv_do_item(const Args& a, LAS float* scr, int g, int lane) {
    const int l = g >= CV_L0 ? 1 : 0; const int r = g - l * CV_L0;
    if (r < 32 * 512) { const int mi = l * 32 + (r >> 9); transpose_item64(a.in[I_WE1] + (size_t)mi * D * 2 * D, D, 2 * D, a.ws + WS_W1 + (size_t)mi * 2 * D * D, true, scr, r & 511, lane); }
    else { const int r2 = r - 32 * 512; const int mi = l * 32 + (r2 >> 8); transpose_item64(a.in[I_WE2] + (size_t)mi * D * D, D, D, a.ws + WS_W2 + (size_t)mi * D * D, false, scr, r2 & 255, lane); }
}
__device__ __forceinline__ void cv_finish(const Args& a, LAS unsigned char* lds, int wave, int lane, int& cv_n, int limit) {
    if (gridDim.x == 256 && wave >= 1 && wave <= CV_WAVES) {
        const int ww = blockIdx.x * CV_WAVES + (wave - 1), NW = 256 * CV_WAVES; LAS float* scr = (LAS float*)(lds + RING_OFF + wave * 16640);
#if CVF_PROBE
        const unsigned long long t0_ = __builtin_amdgcn_s_memrealtime();
#endif
        for (;;) { const int g = cv_n * NW + ww; if (g >= limit) break; cv_do_item(a, scr, g, lane); ++cv_n; }
#if CVF_PROBE
        if (blockIdx.x == 0 && wave == 1 && lane == 0) { asm volatile("s_waitcnt vmcnt(0)" ::: "memory"); ((volatile LAS unsigned*)(lds + MISC_OFF))[40] += (unsigned)(__builtin_amdgcn_s_memrealtime() - t0_); }
#endif
    }
}
__device__ __forceinline__ void xcd_barrier_work(const XcdBarrier& b, const Args& a, LAS unsigned char* lds, int wave, int lane, int& cv_n, volatile LAS unsigned* flag, unsigned seq) {
    asm volatile("s_waitcnt vmcnt(0)" ::: "memory");
    __syncthreads();
    if (wave == 0) {
        if (threadIdx.x == 0) {
            unsigned* bar = b.bar;
            __builtin_amdgcn_s_waitcnt(0);
            unsigned nloc = b.st[0], nx = b.st[1];
            if (nloc == 0u) { xcd_barrier_complete(bar, b.x, nloc, nx); b.st[0] = nloc; b.st[1] = nx; }
            const unsigned old = xb_add(&bar[XB_XSUB(b.x)], 1u);
            const unsigned gen = old / nloc;
            if (old + 1u == (gen + 1u) * nloc) {
                __builtin_amdgcn_fence(__ATOMIC_RELEASE, "agent");
                asm volatile("s_waitcnt vmcnt(0)" ::: "memory");
                const unsigned og = xb_add(&bar[XB_TOP], 1u);
                const unsigned tg = og / nx;
                if (og + 1u == (tg + 1u) * nx) xb_add(&bar[XB_TOPGEN], 1u);
                else XB_SPIN(xb_ld(&bar[XB_TOPGEN]) == tg, bar);
                __builtin_amdgcn_fence(__ATOMIC_ACQUIRE, "agent");
                xb_add(&bar[XB_XGEN(b.x)], 1u);
                asm volatile("s_waitcnt vmcnt(0)" ::: "memory");
            } else {
                XB_SPIN(xb_ld(&bar[XB_XGEN(b.x)]) == gen, bar);
                __builtin_amdgcn_fence(__ATOMIC_ACQUIRE, "agent");
                asm volatile("s_waitcnt vmcnt(0)" ::: "memory");
            }
            flag[0] = seq;
        }
    } else if (gridDim.x == 256 && wave <= CV_WAVES) {
        const int ww = blockIdx.x * CV_WAVES + (wave - 1), NW = 256 * CV_WAVES; LAS float* scr = (LAS float*)(lds + RING_OFF + wave * 16640);
        for (;;) { const int g = cv_n * NW + ww; if (g >= CV_ALL) break; if (flag[0] == seq) break; cv_do_item(a, scr, g, lane); ++cv_n; }
        asm volatile("s_waitcnt vmcnt(0)" ::: "memory");
    }
    __syncthreads();
}
__device__ __forceinline__ void flat_barrier_work(unsigned* cnt, const Args& a, LAS unsigned char* lds, int wave, int lane, int& cv_n, volatile LAS unsigned* flag, unsigned seq) {
    asm volatile("s_waitcnt vmcnt(0)" ::: "memory");
    __syncthreads();
    if (wave == 0) {
        if (threadIdx.x == 0) {
            __builtin_amdgcn_s_waitcnt(0);
            __builtin_amdgcn_fence(__ATOMIC_RELEASE, "agent");
            asm volatile("s_waitcnt vmcnt(0)" ::: "memory");
            (void)__hip_atomic_fetch_add(cnt, 1u, __ATOMIC_RELAXED, __HIP_MEMORY_SCOPE_AGENT);
            const unsigned target = gridDim.x * seq; unsigned sp = 0;
            while (__hip_atomic_load(cnt, __ATOMIC_RELAXED, __HIP_MEMORY_SCOPE_AGENT) < target) { __builtin_amdgcn_s_sleep(1); if (++sp > (1u << 22)) break; }
            __builtin_amdgcn_fence(__ATOMIC_ACQUIRE, "agent");
            asm volatile("s_waitcnt vmcnt(0)" ::: "memory");
            flag[0] = seq;
        }
    } else if (gridDim.x == 256 && wave <= CV_WAVES) {
        const int ww = blockIdx.x * CV_WAVES + (wave - 1), NW = 256 * CV_WAVES; LAS float* scr = (LAS float*)(lds + RING_OFF + wave * 16640);
        for (;;) { const int g = cv_n * NW + ww; if (g >= CV_ALL) break; if (flag[0] == seq) break; cv_do_item(a, scr, g, lane); ++cv_n; }
        asm volatile("s_waitcnt vmcnt(0)" ::: "memory");
    }
    __syncthreads();
}
template <bool OUT8> __device__ __forceinline__ void norm_mod_store(f32x4 (&v)[4], const float* g, const float* sc, const float* sh, void* orow, int lane) {
    float s = 0.f;
#pragma unroll
    for (int j = 0; j < 4; ++j) s += (v[j].x * v[j].x + v[j].y * v[j].y) + (v[j].z * v[j].z + v[j].w * v[j].w);
    const float r = 1.0f / sqrtf(wave_sum(s) * (1.0f / D) + EPS);
#pragma unroll
    for (int j = 0; j < 4; ++j) { const f32x4 gg = ((const f32x4*)g)[lane + 64 * j], ss = ((const f32x4*)sc)[lane + 64 * j], hh = ((const f32x4*)sh)[lane + 64 * j];
        const f32x4 y = (v[j] * r * gg) * (ss + 1.0f) + hh; v[j] = y;
        store_row4<OUT8>(orow, lane, j, y, 1.0f); }
}
__device__ __forceinline__ void p_norm0(const Args& a, int lane, int gw, int NGW, int m_begin, int m_end) {
    const float* MODS = (const float*)(a.ws + WS_MODS); bf16* H = (bf16*)(a.ws + WS_H);
    for (int m0 = m_begin + gw * 2; m0 < m_end; m0 += NGW * 2) {
        f32x4 v[2][4]; int rr[2];
#pragma unroll
        for (int r = 0; r < 2; ++r) { const int m = m0 + r; const float* xr;
            if (m < NTOK) { xr = a.in[I_X] + (size_t)m * D; rr[r] = m / SEQ; } else { xr = a.in[I_CTX] + (size_t)(m - NTOK) * D; rr[r] = 2; }
#pragma unroll
            for (int j = 0; j < 4; ++j) v[r][j] = __builtin_nontemporal_load(&((const f32x4*)xr)[lane + 64 * j]); }
#pragma unroll
        for (int r = 0; r < 2; ++r) { const float* md = MODS + (size_t)rr[r] * 6 * D;
            norm_mod_store<F8_IN != 0>(v[r], a.in[I_GMIX], md + 1 * D, md + 0 * D, (unsigned char*)H + (size_t)(m0 + r) * D * (F8_IN ? 1 : 2), lane);
            if (SPLIT_IN) {
#pragma unroll
                for (int j = 0; j < 4; ++j) store_row4<true>(a.ws + WS_H8 + (size_t)(m0 + r) * D, lane, j, v[r][j], 1.0f); } }
    }
}
__device__ __forceinline__ void p_scan_naive(const Args& a, LAS unsigned char* lds, int tid) {
    LAS float* sf = (LAS float*)lds;
    LAS float* sq = sf + 64 * 128;
    LAS float* sv = sq + 64 * 128;
    LAS float* so = sv + 64 * 16;
    const bf16* Q = (const bf16*)(a.ws + WS_Q); const bf16* V = (const bf16*)(a.ws + WS_V);
    const int vl = tid >> 5, kq = tid & 31;
    for (int unit = blockIdx.x; unit < 256; unit += gridDim.x) {
        const int chain = unit >> 3, vb = unit & 7, b = chain >> 4, h = (chain >> 1) & 7, dir = chain & 1;
        const float* LF = (const float*)(a.ws + (dir ? WS_LFB : WS_LFF)); float* O = (float*)(a.ws + (dir ? WS_OB : WS_OF));
        float S0 = 0.f, S1 = 0.f, S2 = 0.f, S3 = 0.f;
        for (int blk = 0; blk < 260; ++blk) {
            const bool isctx = blk < 4; int base, step;
            if (!dir) { base = isctx ? (NTOK + b * CTXL + blk * 64) : (b * SEQ + (blk - 4) * 64); step = 1; }
            else { base = isctx ? (NTOK + b * CTXL + CTXL - 1 - blk * 64) : (b * SEQ + SEQ - 1 - (blk - 4) * 64); step = -1; }
            for (int e = tid; e < 64 * 128; e += NTHR) { const int i = e >> 7, k = e & 127; const size_t off = (size_t)(base + step * i) * D + h * DK + k; sf[e] = __expf(LF[off]); sq[e] = bf2f(Q[off]); }
            for (int e = tid; e < 64 * 16; e += NTHR) { const int i = e >> 4, vv = e & 15; sv[e] = bf2f(V[(size_t)(base + step * i) * D + h * DK + vb * 16 + vv]); }
            __syncthreads();
            for (int i = 0; i < 64; ++i) {
                const f32x4 f = *(const LAS f32x4*)(sf + i * 128 + kq * 4), q = *(const LAS f32x4*)(sq + i * 128 + kq * 4); const float vv = sv[i * 16 + vl];
                S0 = f.x * S0 + (1.0f - f.x) * vv; S1 = f.y * S1 + (1.0f - f.y) * vv; S2 = f.z * S2 + (1.0f - f.z) * vv; S3 = f.w * S3 + (1.0f - f.w) * vv;
                float p = (S0 * q.x + S1 * q.y) + (S2 * q.z + S3 * q.w);
                p += __shfl_xor(p, 1); p += __shfl_xor(p, 2); p += __shfl_xor(p, 4); p += __shfl_xor(p, 8); p += __shfl_xor(p, 16);
                if (kq == 0) so[i * 16 + vl] = p;
            }
            __syncthreads();
            if (!isctx) for (int e = tid; e < 64 * 16; e += NTHR) { const int i = e >> 4, vv = e & 15; O[(size_t)(base + step * i) * D + h * DK + vb * 16 + vv] = so[e]; }
            __syncthreads();
        }
    }
}
constexpr int SC_QT = 0, SC_KU = 4352, SC_KB = 8704, SC_VT = 12800, SC_ET = 16896, SC_SUB = 17408, SC_BUF = 4 * SC_SUB;
constexpr int NSLOT = 17;
typedef short s16x4 __attribute__((ext_vector_type(4)));
typedef short s16x8 __attribute__((ext_vector_type(8)));
struct ScanUnit { int h, rowbase, sgn, nchunks, chain, slot; };
__device__ __forceinline__ ScanUnit scan_unit(int b, int h, int dir, int slot) {
    ScanUnit u; u.h = h; u.sgn = dir ? -1 : 1; u.chain = (b * NHEAD + h) * 2 + dir; u.slot = slot;
    if (slot == 0) { u.rowbase = NTOK + b * CTXL + (dir ? CTXL - 1 : 0); u.nchunks = CTXL / 64; }
    else { const int so = (slot - 1) * 1024; u.rowbase = b * SEQ + (dir ? SEQ - 1 - so : so); u.nchunks = 16; }
    return u;
}
typedef float f32x2_t __attribute__((ext_vector_type(2)));
typedef __bf16 bf16x2_t __attribute__((ext_vector_type(2)));
__device__ __forceinline__ unsigned cvtpk(float lo, float hi) { const f32x2_t f = {lo, hi}; return __builtin_bit_cast(unsigned, __builtin_convertvector(f, bf16x2_t)); }
template <bool FULL> __device__ __forceinline__ void scan_load(const ScanUnit& u, int pos0, const bf16* LF, const bf16* Q, const bf16* V, int k, int i, unsigned (&lf)[16], unsigned (&qr)[16], unsigned (&vr)[16]) {
#pragma unroll
    for (int t = 0; t < 16; ++t) {
        const size_t ro = (size_t)((u.rowbase + u.sgn * (pos0 + 16 * i + t)) * D + u.h * DK);
        lf[t] = (LF + ro)[k]; vr[t] = (V + ro)[k]; if (FULL) qr[t] = (Q + ro)[k];
    }
}
template <bool FULL> __device__ __forceinline__ float scan_prep(LAS unsigned char* buf, int k, int i, const unsigned (&lfr)[16], const unsigned (&qr)[16], const unsigned (&vr)[16]) {
    LAS unsigned char* sb = buf + i * SC_SUB;
    float f[16], pre[16], suf[16]; float T = 0.f;
#pragma unroll
    for (int t = 0; t < 16; ++t) { const float lf = (float)__builtin_bit_cast(_Float16, (unsigned short)lfr[t]); T += lf; f[t] = __builtin_amdgcn_exp2f(lf); }
    pre[0] = f[0];
#pragma unroll
    for (int t = 1; t < 16; ++t) pre[t] = pre[t - 1] * f[t];
    suf[15] = 1.0f;
#pragma unroll
    for (int t = 14; t >= 0; --t) suf[t] = suf[t + 1] * f[t + 1];
    unsigned kbw[8], vtw[8], qqw[8], kuw[8];
    const float invp = __builtin_amdgcn_rcpf(fmaxf(pre[15], 1e-30f));
#pragma unroll
    for (int t = 0; t < 16; t += 2) {
        const float kk0 = 1.0f - f[t], kk1 = 1.0f - f[t + 1];
        kbw[t >> 1] = cvtpk(kk0 * suf[t], kk1 * suf[t + 1]);
        vtw[t >> 1] = vr[t] | (vr[t + 1] << 16);
        if (FULL) {
            qqw[t >> 1] = cvtpk(__builtin_bit_cast(float, qr[t] << 16) * pre[t], __builtin_bit_cast(float, qr[t + 1] << 16) * pre[t + 1]);
            kuw[t >> 1] = cvtpk(kk0 * suf[t] * invp, kk1 * suf[t + 1] * invp);
        }
    }
    if (FULL) {
        const int rho = k ^ (((k >> 3) & 1) << 2);
        *(LAS v4u*)(sb + SC_QT + rho * 32) = (v4u){qqw[0], qqw[1], qqw[2], qqw[3]}; *(LAS v4u*)(sb + SC_QT + rho * 32 + 16) = (v4u){qqw[4], qqw[5], qqw[6], qqw[7]};
        *(LAS v4u*)(sb + SC_KU + rho * 32) = (v4u){kuw[0], kuw[1], kuw[2], kuw[3]}; *(LAS v4u*)(sb + SC_KU + rho * 32 + 16) = (v4u){kuw[4], kuw[5], kuw[6], kuw[7]};
    }
    *(LAS v4u*)(sb + SC_KB + k * 32) = (v4u){kbw[0], kbw[1], kbw[2], kbw[3]}; *(LAS v4u*)(sb + SC_KB + k * 32 + 16) = (v4u){kbw[4], kbw[5], kbw[6], kbw[7]};
    *(LAS v4u*)(sb + SC_VT + k * 32) = (v4u){vtw[0], vtw[1], vtw[2], vtw[3]}; *(LAS v4u*)(sb + SC_VT + k * 32 + 16) = (v4u){vtw[4], vtw[5], vtw[6], vtw[7]};
    *(LAS float*)(sb + SC_ET + 4 * k) = pre[15];
    return T;
}
__device__ __forceinline__ f32x4 mfma_k16(s16x4 a, s16x4 b, f32x4 c) {
    const v2u av = __builtin_bit_cast(v2u, a), bv = __builtin_bit_cast(v2u, b);
    return __builtin_amdgcn_mfma_f32_16x16x32_bf16(__builtin_bit_cast(s16x8, (v4u){av.x, av.y, 0u, 0u}), __builtin_bit_cast(s16x8, (v4u){bv.x, bv.y, 0u, 0u}), c, 0, 0, 0);
}
template <bool FULL> __device__ __forceinline__ void scan_compute2(const LAS unsigned char* buf, int wq, int lane, f32x4 (&S)[2][8], bf16* Ocol, const ScanUnit& u, int pos0) {
    const int fr = lane & 15, g = lane >> 4;
#pragma unroll
    for (int i = 0; i < 2; ++i) {
        const LAS unsigned char* sb = buf + i * SC_SUB;
        const s16x4 vt0 = *(const LAS s16x4*)(sb + SC_VT + (32 * wq + fr) * 32 + 8 * g), vt1 = *(const LAS s16x4*)(sb + SC_VT + (32 * wq + 16 + fr) * 32 + 8 * g);
        s16x8 ka[4], qa[4]; f32x4 et[8]; s16x4 kb[8];
        if (FULL) {
            const int q_ = (lane & 15) >> 2, p_ = lane & 3;
            const LAS unsigned char* b0_ = sb + (8 * g + q_) * 32 + p_ * 8 + 128 * (g & 1);
            const LAS unsigned char* b1_ = sb + (8 * g + q_) * 32 + p_ * 8 + 128 * (1 - (g & 1));
#pragma unroll
            for (int c = 0; c < 4; ++c) {
                const s16x4 k0_ = __builtin_amdgcn_ds_read_tr16_b64_v4i16((LAS s16x4*)(b0_ + SC_KU + 1024 * c)), k1_ = __builtin_amdgcn_ds_read_tr16_b64_v4i16((LAS s16x4*)(b1_ + SC_KU + 1024 * c));
                const s16x4 q0_ = __builtin_amdgcn_ds_read_tr16_b64_v4i16((LAS s16x4*)(b0_ + SC_QT + 1024 * c)), q1_ = __builtin_amdgcn_ds_read_tr16_b64_v4i16((LAS s16x4*)(b1_ + SC_QT + 1024 * c));
                ka[c] = __builtin_shufflevector(k0_, k1_, 0, 1, 2, 3, 4, 5, 6, 7); qa[c] = __builtin_shufflevector(q0_, q1_, 0, 1, 2, 3, 4, 5, 6, 7); }
        }
#pragma unroll
        for (int j = 0; j < 8; ++j) { et[j] = *(const LAS f32x4*)(sb + SC_ET + (32 * (j >> 1) + 8 * g + 4 * (j & 1)) * 4); kb[j] = *(const LAS s16x4*)(sb + SC_KB + (32 * (j >> 1) + 8 * (fr >> 2) + 4 * (j & 1) + (fr & 3)) * 32 + 8 * g); }
        __builtin_amdgcn_sched_barrier(0);
        if (FULL) {
            f32x4 aT = (f32x4){0.f, 0.f, 0.f, 0.f};
#pragma unroll
            for (int c = 0; c < 4; ++c) aT = __builtin_amdgcn_mfma_f32_16x16x32_bf16(ka[c], qa[c], aT, 0, 0, 0);
#pragma unroll
            for (int r = 0; r < 4; ++r) if (4 * g + r > fr) aT[r] = 0.f;
            const s16x4 ab = __builtin_bit_cast(s16x4, (v2u){cvtpk(aT[0], aT[1]), cvtpk(aT[2], aT[3])});
            f32x4 o0 = mfma_k16(vt0, ab, (f32x4){0.f, 0.f, 0.f, 0.f}), o1 = mfma_k16(vt1, ab, (f32x4){0.f, 0.f, 0.f, 0.f});
#pragma unroll
            for (int c = 0; c < 4; ++c) {
                const v4u s0 = (v4u){cvtpk(S[0][2 * c][0], S[0][2 * c][1]), cvtpk(S[0][2 * c][2], S[0][2 * c][3]), cvtpk(S[0][2 * c + 1][0], S[0][2 * c + 1][1]), cvtpk(S[0][2 * c + 1][2], S[0][2 * c + 1][3])};
                const v4u s1 = (v4u){cvtpk(S[1][2 * c][0], S[1][2 * c][1]), cvtpk(S[1][2 * c][2], S[1][2 * c][3]), cvtpk(S[1][2 * c + 1][0], S[1][2 * c + 1][1]), cvtpk(S[1][2 * c + 1][2], S[1][2 * c + 1][3])};
                o0 = __builtin_amdgcn_mfma_f32_16x16x32_bf16(__builtin_bit_cast(s16x8, s0), qa[c], o0, 0, 0, 0);
                o1 = __builtin_amdgcn_mfma_f32_16x16x32_bf16(__builtin_bit_cast(s16x8, s1), qa[c], o1, 0, 0, 0);
            }
            bf16* orow = Ocol + (size_t)(u.rowbase + u.sgn * (pos0 + 16 * i + fr)) * D;
            *(v2u*)orow = (v2u){cvtpk(o0[0], o0[1]), cvtpk(o0[2], o0[3])}; *(v2u*)(orow + 16) = (v2u){cvtpk(o1[0], o1[1]), cvtpk(o1[2], o1[3])};
        }
#pragma unroll
        for (int j = 0; j < 8; ++j) { S[0][j] = mfma_k16(kb[j], vt0, S[0][j] * et[j]); S[1][j] = mfma_k16(kb[j], vt1, S[1][j] * et[j]); }
    }
}
template <bool FULL> __device__ __forceinline__ void scan_pair(const Args& a, LAS unsigned char* lds, const ScanUnit& uA, const ScanUnit& uB, int tid, int lane, int wave) {
    const int grp = wave >> 2, wq = wave & 3, t = tid & 255, k = t & 127, i0 = (wave >> 1) & 1;
    ScanUnit u; u.h = grp ? uB.h : uA.h; u.rowbase = grp ? uB.rowbase : uA.rowbase; u.sgn = grp ? uB.sgn : uA.sgn; u.nchunks = grp ? uB.nchunks : uA.nchunks; u.chain = grp ? uB.chain : uA.chain; u.slot = grp ? uB.slot : uA.slot;
    LAS unsigned char* buf = lds + grp * SC_BUF;
    const int dir = u.sgn < 0;
    const bf16* LF = (const bf16*)(a.ws + (dir ? WS_LFB : WS_LFF)); const bf16* Q = (const bf16*)(a.ws + WS_Q); const bf16* V = (const bf16*)(a.ws + WS_V);
    f32x4* SD = (f32x4*)(a.ws + WS_SD) + (size_t)u.chain * NSLOT * 4096; float* SP = (float*)(a.ws + WS_SP) + (size_t)u.chain * NSLOT * DK;
    const int g = lane >> 4;
    bf16* Ocol = (bf16*)(a.ws + (dir ? WS_OB : WS_OF)) + u.h * DK + 32 * wq + 4 * g;
    f32x4 S[2][8];
#pragma unroll
    for (int vb = 0; vb < 2; ++vb)
#pragma unroll
        for (int j = 0; j < 8; ++j) S[vb][j] = (f32x4){0.f, 0.f, 0.f, 0.f};
    if (FULL) {
        for (int s = 0; s < u.slot; ++s) {
            const f32x4* d = SD + (size_t)s * 4096 + (wq * 16) * 64 + lane; const float* pp = SP + s * DK + 8 * g;
#pragma unroll
            for (int j = 0; j < 8; ++j) { const f32x4 pv = *(const f32x4*)(pp + 32 * (j >> 1) + 4 * (j & 1)); const f32x4 ev = (f32x4){__builtin_amdgcn_exp2f(pv.x), __builtin_amdgcn_exp2f(pv.y), __builtin_amdgcn_exp2f(pv.z), __builtin_amdgcn_exp2f(pv.w)};
                S[0][j] = S[0][j] * ev + d[j * 64]; S[1][j] = S[1][j] * ev + d[(8 + j) * 64]; }
        }
    }
    unsigned lf[16], q[16], v[16]; float psum = 0.f;
    const int nsteps = u.nchunks * 2;
    scan_load<FULL>(u, 0, LF, Q, V, k, i0, lf, q, v);
    constexpr int NST = 32, PB = 2 * SC_SUB;
    if (nsteps > 0) psum += scan_prep<FULL>(buf, k, i0, lf, q, v);
    if (grp == 1) scan_load<FULL>(u, (nsteps > 1 ? 1 : 0) * 32, LF, Q, V, k, i0, lf, q, v);
    for (int c = 0; c < NST; ++c) {
        __syncthreads();
        if (c < nsteps) {
            if (grp == 1 && c + 1 < nsteps) psum += scan_prep<FULL>(buf + ((c + 1) & 1) * PB, k, i0, lf, q, v);
            const int cw = c + 1 + grp, cn = cw < nsteps ? cw : nsteps - 1;
            scan_load<FULL>(u, cn * 32, LF, Q, V, k, i0, lf, q, v);
            scan_compute2<FULL>(buf + (c & 1) * PB, wq, lane, S, Ocol, u, c * 32);
            if (grp == 0 && c + 1 < nsteps) psum += scan_prep<FULL>(buf + ((c + 1) & 1) * PB, k, i0, lf, q, v);
        }
    }
    __syncthreads();
    if (!FULL) {
        f32x4* d = SD + (size_t)u.slot * 4096 + (wq * 16) * 64 + lane;
#pragma unroll
        for (int j = 0; j < 8; ++j) { d[j * 64] = S[0][j]; d[(8 + j) * 64] = S[1][j]; }
        LAS float* ps = (LAS float*)(lds + EXTRA_OFF + 2560);
        ps[(grp * 2 + i0) * 128 + k] = psum;
        __syncthreads();
        if (t < 128) SP[u.slot * DK + t] = ps[(grp * 2) * 128 + t] + ps[(grp * 2 + 1) * 128 + t];
        __syncthreads();
    }
}
__device__ __forceinline__ void p_scan_a(const Args& a, LAS unsigned char* lds, int tid, int lane, int wave) {
    for (int it = blockIdx.x; it < 256; it += gridDim.x) {
        const int b = it >> 7, h = (it >> 4) & 7, seg = it & 15;
        const ScanUnit uA = scan_unit(b, h, 0, seg == 15 ? 0 : 1 + seg);
        const ScanUnit uB = scan_unit(b, h, 1, seg == 0 ? 0 : 16 - seg);
        scan_pair<false>(a, lds, uA, uB, tid, lane, wave);
    }
}
__device__ __forceinline__ void p_scan_c(const Args& a, LAS unsigned char* lds, int tid, int lane, int wave) {
    for (int it = blockIdx.x; it < 256; it += gridDim.x) {
        const int b = it >> 7, h = (it >> 4) & 7, seg = it & 15;
        const ScanUnit uA = scan_unit(b, h, 0, 1 + seg), uB = scan_unit(b, h, 1, 16 - seg);
        scan_pair<true>(a, lds, uA, uB, tid, lane, wave);
    }
}
__device__ __forceinline__ void p_readout(const Args& a, int lane, int wave) {
    const int gw = blockIdx.x * NWAVES + wave, NGW = gridDim.x * NWAVES;
    const bf16* OF = (const bf16*)(a.ws + WS_OF); const bf16* OB = (const bf16*)(a.ws + WS_OB); const bf16* SG = (const bf16*)(a.ws + WS_SG); bf16* Y = (bf16*)(a.ws + WS_YIN);
    f32x4 gh[4];
#pragma unroll
    for (int j = 0; j < 4; ++j) gh[j] = ((const f32x4*)a.in[I_GHOUT])[lane + 64 * j];
    v2u ra[2][4], rb[2][4], sg[2][4];
    if (gw * 2 < NTOK) {
#pragma unroll
        for (int r = 0; r < 2; ++r)
#pragma unroll
            for (int j = 0; j < 4; ++j) { const size_t m = gw * 2 + r; ra[r][j] = ((const v2u*)(OF + m * D))[lane + 64 * j]; rb[r][j] = ((const v2u*)(OB + m * D))[lane + 64 * j]; sg[r][j] = ((const v2u*)(SG + m * D))[lane + 64 * j]; }
    }
    for (int m0 = gw * 2; m0 < NTOK; m0 += NGW * 2) {
        v2u na[2][4], nb[2][4], ns[2][4]; const int mn = m0 + NGW * 2;
#pragma unroll
        for (int r = 0; r < 2; ++r)
#pragma unroll
            for (int j = 0; j < 4; ++j) { const size_t m = (size_t)mn + r; const v2u z2 = (v2u){0u, 0u};
                na[r][j] = mn < NTOK ? ((const v2u*)(OF + m * D))[lane + 64 * j] : z2; nb[r][j] = mn < NTOK ? ((const v2u*)(OB + m * D))[lane + 64 * j] : z2; ns[r][j] = mn < NTOK ? ((const v2u*)(SG + m * D))[lane + 64 * j] : z2; }
#pragma unroll
        for (int r = 0; r < 2; ++r)
#pragma unroll
            for (int j = 0; j < 4; ++j) { const v2u a_ = ra[r][j], b_ = rb[r][j];
                const f32x4 oo = (f32x4){bf_lo(a_.x) + bf_lo(b_.x), bf_hi(a_.x) + bf_hi(b_.x), bf_lo(a_.y) + bf_lo(b_.y), bf_hi(a_.y) + bf_hi(b_.y)};
                float s = (oo.x * oo.x + oo.y * oo.y) + (oo.z * oo.z + oo.w * oo.w);
                s = half_sum(s);
                const float rs = 1.0f / sqrtf(s * (1.0f / DK) + EPS);
                store_row4<F8_MISC != 0>((unsigned char*)Y + (size_t)(m0 + r) * D * (F8_MISC ? 1 : 2), lane, j,
                    (f32x4){oo.x * rs * gh[j].x * bf_lo(sg[r][j].x), oo.y * rs * gh[j].y * bf_hi(sg[r][j].x), oo.z * rs * gh[j].z * bf_lo(sg[r][j].y), oo.w * rs * gh[j].w * bf_hi(sg[r][j].y)}, 4.0f); }
#pragma unroll
        for (int r = 0; r < 2; ++r)
#pragma unroll
            for (int j = 0; j < 4; ++j) { ra[r][j] = na[r][j]; rb[r][j] = nb[r][j]; sg[r][j] = ns[r][j]; }
    }
}
__device__ __forceinline__ void p_router(const Args& a, LAS unsigned char* lds, int l, int tid, int lane, int wave) {
    typedef _Float16 h16x8 __attribute__((ext_vector_type(8))); typedef _Float16 h16x4 __attribute__((ext_vector_type(4)));
    constexpr int PITCH = 2064, TILE_BYTES = 16 * PITCH, P_OFF = 2 * TILE_BYTES, P_BYTES = 8 * 16 * 32 * 4;
    LAS int* s_cnt = (LAS int*)(lds + EXTRA_OFF);
    LAS int* s_gb = s_cnt + 32;
    LAS int* s_sel = (LAS int*)(lds + EXTRA_OFF + 2560);
    unsigned* GCNT = (unsigned*)(a.ws + WS_CTL) + CW_GCNT + l * 32;
    const float* WR = a.in[I_WR] + (size_t)l * D * NE; const float* BR = a.in[I_BR] + l * NE;
    const bf16* X = (const bf16*)(a.ws + WS_X); unsigned char* H = a.ws + WS_H;
    const int fr = lane & 15, g = lane >> 4;
    v2u nx[2][4];
    if (blockIdx.x < NTOK / 128) {
#pragma unroll
        for (int t = 0; t < 2; ++t)
#pragma unroll
            for (int j = 0; j < 4; ++j) nx[t][j] = ((const v2u*)(X + (size_t)(blockIdx.x * 128 + 2 * wave + t) * D))[lane + 64 * j];
    }
    h16x8 wb0[4], wb1[4];
#pragma unroll
    for (int c = 0; c < 4; ++c)
#pragma unroll
        for (int i = 0; i < 8; ++i) { const float* wp = WR + (size_t)(128 * wave + 32 * c + 8 * g + i) * NE + fr; wb0[c][i] = (_Float16)wp[0]; wb1[c][i] = (_Float16)wp[16]; }
    const float* MODS = (const float*)(a.ws + WS_MODS);
    int* TOPS = (int*)(a.ws + WS_TOPE); float* TOPW = (float*)(a.ws + WS_TOPW); int* STOK = (int*)(a.ws + WS_STOK);
    for (int ch = blockIdx.x; ch < NTOK / 128; ch += gridDim.x) {
        if (tid < 32) s_cnt[tid] = 0;
        const int b = (ch * 128) / SEQ; const float* md = MODS + (size_t)(l * 3 + b) * 6 * D;
        if (ch != (int)blockIdx.x) {
#pragma unroll
        for (int t = 0; t < 2; ++t)
#pragma unroll
            for (int j = 0; j < 4; ++j) nx[t][j] = ((const v2u*)(X + (size_t)(ch * 128 + 2 * wave + t) * D))[lane + 64 * j];
        }
#define ROUTER_A(it_) do { const int tokA = ch * 128 + (it_) * 16 + 2 * wave; f32x4 hf[2][4]; \
            _Pragma("unroll") for (int t = 0; t < 2; ++t) _Pragma("unroll") for (int j = 0; j < 4; ++j) hf[t][j] = (f32x4){bf_lo(nx[t][j].x), bf_hi(nx[t][j].x), bf_lo(nx[t][j].y), bf_hi(nx[t][j].y)}; \
            if ((it_) + 1 < 8) { _Pragma("unroll") for (int t = 0; t < 2; ++t) _Pragma("unroll") for (int j = 0; j < 4; ++j) nx[t][j] = ((const v2u*)(X + (size_t)(tokA + 16 + t) * D))[lane + 64 * j]; } \
            _Pragma("unroll") for (int t = 0; t < 2; ++t) { \
                norm_mod_store<true>(hf[t], a.in[I_GFFN] + l * D, md + 4 * D, md + 3 * D, H + (size_t)(tokA + t) * D, lane); \
                _Pragma("unroll") for (int j = 0; j < 4; ++j) { const h16x4 hv = {(_Float16)hf[t][j].x, (_Float16)hf[t][j].y, (_Float16)hf[t][j].z, (_Float16)hf[t][j].w}; \
                    *(LAS h16x4*)(lds + ((it_) & 1) * TILE_BYTES + (2 * wave + t) * PITCH + (4 * lane + 256 * j) * 2) = hv; } } } while (0)
#define ROUTER_B(it_) do { f32x4 acc0 = (f32x4){0.f, 0.f, 0.f, 0.f}, acc1 = acc0; \
            _Pragma("unroll") for (int c = 0; c < 4; ++c) { const h16x8 av = *(const LAS h16x8*)(lds + ((it_) & 1) * TILE_BYTES + fr * PITCH + (128 * wave + 32 * c + 8 * g) * 2); \
                acc0 = __builtin_amdgcn_mfma_f32_16x16x32_f16(av, wb0[c], acc0, 0, 0, 0); acc1 = __builtin_amdgcn_mfma_f32_16x16x32_f16(av, wb1[c], acc1, 0, 0, 0); } \
            LAS float* Pw = (LAS float*)(lds + P_OFF + ((it_) & 1) * P_BYTES); \
            _Pragma("unroll") for (int r = 0; r < 4; ++r) { Pw[(wave * 16 + 4 * g + r) * 32 + fr] = acc0[r]; Pw[(wave * 16 + 4 * g + r) * 32 + 16 + fr] = acc1[r]; } } while (0)
#define ROUTER_C(it_) do { const int t = lane >> 5, e0 = lane & 31; const LAS float* Pr = (const LAS float*)(lds + P_OFF + ((it_) & 1) * P_BYTES); \
            float v0 = BR[e0]; \
            _Pragma("unroll") for (int w = 0; w < 8; ++w) v0 += Pr[(w * 16 + 2 * wave + t) * 32 + e0]; \
            float selv[4]; int seli[4]; \
            { const unsigned ub = __builtin_bit_cast(unsigned, v0); unsigned key = (ub & 0x80000000u) ? ~ub : (ub | 0x80000000u); key = (key & ~31u) | (unsigned)(31 - e0); \
              _Pragma("unroll") for (int r = 0; r < 4; ++r) { unsigned m = key, o; \
                  o = (unsigned)__builtin_amdgcn_update_dpp(0, (int)m, 0xB1, 0xF, 0xF, true); m = o > m ? o : m; \
                  o = (unsigned)__builtin_amdgcn_update_dpp(0, (int)m, 0x4E, 0xF, 0xF, true); m = o > m ? o : m; \
                  o = (unsigned)__builtin_amdgcn_update_dpp(0, (int)m, 0x141, 0xF, 0xF, true); m = o > m ? o : m; \
                  o = (unsigned)__builtin_amdgcn_update_dpp(0, (int)m, 0x140, 0xF, 0xF, true); m = o > m ? o : m; \
                  o = (unsigned)__shfl_xor((int)m, 16); m = o > m ? o : m; \
                  const int bi = 31 - (int)(m & 31u); seli[r] = bi; \
                  if (bi == e0) key = 0u; } \
              _Pragma("unroll") for (int r = 0; r < 4; ++r) selv[r] = __builtin_bit_cast(float, __builtin_amdgcn_ds_bpermute(((lane & 32) + seli[r]) << 2, __builtin_bit_cast(int, v0))); } \
            if ((lane & 31) == 0) { \
                const float e1 = __expf(selv[1] - selv[0]), e2 = __expf(selv[2] - selv[0]), e3 = __expf(selv[3] - selv[0]); const float inv = 1.0f / (1.0f + e1 + e2 + e3); \
                *(f32x4*)(TOPW + (size_t)(ch * 128 + (it_) * 16 + 2 * wave + t) * 4) = (f32x4){inv, e1 * inv, e2 * inv, e3 * inv}; \
                _Pragma("unroll") for (int r = 0; r < 4; ++r) s_sel[((it_) * 16 + 2 * wave + t) * 4 + r] = (seli[r] << 16) | __hip_atomic_fetch_add(&s_cnt[seli[r]], 1, __ATOMIC_RELAXED, __HIP_MEMORY_SCOPE_WORKGROUP); \
            } } while (0)
        ROUTER_A(0);
        for (int k = 0; k < 8; ++k) {
            __syncthreads();
            ROUTER_B(k);
            if (k > 0) ROUTER_C(k - 1);
            if (k < 7) ROUTER_A(k + 1);
        }
        __syncthreads();
        ROUTER_C(7);
#undef ROUTER_A
#undef ROUTER_B
#undef ROUTER_C
        __syncthreads();
        if (tid < 32) s_gb[tid] = (int)__hip_atomic_fetch_add(GCNT + tid, (unsigned)s_cnt[tid], __ATOMIC_RELAXED, __HIP_MEMORY_SCOPE_AGENT);
        __syncthreads();
        { const int sv = s_sel[tid], e = sv >> 16, vi = s_gb[e] + (sv & 0xffff); TOPS[(size_t)ch * 512 + tid] = e * NTOK + vi; STOK[(size_t)e * NTOK + vi] = ch * 128 + (tid >> 2); }
        __syncthreads();
    }
}
__device__ __forceinline__ void moe_tables(const Args& a, LAS unsigned char* lds, int l, int tid) {
    LAS int* s_tb = (LAS int*)(lds + EXTRA_OFF + 256); LAS int* s_ce = s_tb + 40; LAS int* tab = (LAS int*)(lds + EXTRA_OFF + 640);
    const unsigned* GCNT = (const unsigned*)(a.ws + WS_CTL) + CW_GCNT + l * 32;
    if (tid < 32) s_ce[tid] = (int)__hip_atomic_load(GCNT + tid, __ATOMIC_RELAXED, __HIP_MEMORY_SCOPE_AGENT);
    __syncthreads();
    if (tid == 0) { int run = 0; for (int e = 0; e < 32; ++e) { s_tb[e] = run; run += (s_ce[e] + 255) >> 8; } s_tb[32] = run; }
    __syncthreads();
    if (tid < 32) { const int t0 = s_tb[tid], t1 = s_tb[tid + 1]; for (int t = t0; t < t1; ++t) tab[t] = tid; }
    __syncthreads();
}
template <bool FINAL> __device__ __forceinline__ void p_combine(const Args& a, LAS unsigned char* lds, int l, int lane, int wave) {
    const int gw = blockIdx.x * NWAVES + wave, NGW = gridDim.x * NWAVES;
    bf16* X = (bf16*)(a.ws + WS_X); const bf16* YS = (const bf16*)(a.ws + WS_YS); const int* TOPS = (const int*)(a.ws + WS_TOPE); const float* TOPW = (const float*)(a.ws + WS_TOPW);
    const LAS int* s_tb = (const LAS int*)(lds + EXTRA_OFF + 256);
    const float* MODS = (const float*)(a.ws + WS_MODS); bf16* H = (bf16*)(a.ws + WS_H);
    const int S2 = NGW * 2;
    auto load_idx = [&](int m, v4i (&ps)[2], f32x4 (&tws)[2]) {
#pragma unroll
        for (int r = 0; r < 2; ++r) { ps[r] = *(const v4i*)(TOPS + (size_t)(m + r) * 4); tws[r] = *(const f32x4*)(TOPW + (size_t)(m + r) * 4); } };
    auto load_rows = [&](int m, v4i (&ps)[2], v2u (&xr_)[2][4], v2u (&y_)[2][4][4]) {
#pragma unroll
        for (int r = 0; r < 2; ++r) {
#pragma unroll
            for (int k = 0; k < 4; ++k) { const int e = ps[r][k] >> 15; ps[r][k] = s_tb[e] * 256 + (ps[r][k] & (NTOK - 1)); }
#pragma unroll
            for (int j = 0; j < 4; ++j) { xr_[r][j] = ((const v2u*)(X + (size_t)(m + r) * D))[lane + 64 * j];
#pragma unroll
                for (int k = 0; k < 4; ++k) {
                    if (F8_Y) { y_[r][j][k].x = ((const unsigned*)((const unsigned char*)YS + (size_t)ps[r][k] * D))[lane + 64 * j]; y_[r][j][k].y = 0u; }
                    else y_[r][j][k] = ((const v2u*)(YS + (size_t)ps[r][k] * D))[lane + 64 * j]; } } } };
    v2u xr[2][4]; v2u y[2][4][4]; f32x4 tw[2]; v4i nps[2]; f32x4 ntw[2];
    if (gw * 2 < NTOK) { v4i cps[2]; load_idx(gw * 2, cps, tw); load_rows(gw * 2, cps, xr, y); if (gw * 2 + S2 < NTOK) load_idx(gw * 2 + S2, nps, ntw); }
    for (int m0 = gw * 2; m0 < NTOK; m0 += S2) {
        const int b = m0 / SEQ; const float* gt = MODS + (size_t)(l * 3 + b) * 6 * D + 5 * D;
        const int mn = m0 + S2, mnn = m0 + 2 * S2;
        v2u xn[2][4]; v2u yn[2][4][4]; v4i pps[2]; f32x4 ptw[2];
        if (mn < NTOK) load_rows(mn, nps, xn, yn);
        if (mnn < NTOK) load_idx(mnn, pps, ptw);
        f32x4 v[2][4];
#pragma unroll
        for (int r = 0; r < 2; ++r)
#pragma unroll
            for (int j = 0; j < 4; ++j) v[r][j] = (f32x4){bf_lo(xr[r][j].x), bf_hi(xr[r][j].x), bf_lo(xr[r][j].y), bf_hi(xr[r][j].y)};
#pragma unroll
        for (int r = 0; r < 2; ++r) { const int m = m0 + r;
#pragma unroll
            for (int j = 0; j < 4; ++j) { f32x4 s = (f32x4){0.f, 0.f, 0.f, 0.f};
#pragma unroll
                for (int k = 0; k < 4; ++k) {
                    if (F8_Y) { const int w = (int)y[r][j][k].x; const f32x2_t lo = __builtin_amdgcn_cvt_pk_f32_fp8(w, false), hi = __builtin_amdgcn_cvt_pk_f32_fp8(w, true);
                        s += (f32x4){lo.x, lo.y, hi.x, hi.y} * (tw[r][k] * (1.0f / YSCALE)); }
                    else s += (f32x4){bf_lo(y[r][j][k].x), bf_hi(y[r][j][k].x), bf_lo(y[r][j][k].y), bf_hi(y[r][j][k].y)} * tw[r][k]; }
                v[r][j] = v[r][j] + ((const f32x4*)gt)[lane + 64 * j] * s; }
            if (!FINAL) {
#pragma unroll
                for (int j = 0; j < 4; ++j) ((v2u*)(X + (size_t)m * D))[lane + 64 * j] = (v2u){pk2(v[r][j].x, v[r][j].y), pk2(v[r][j].z, v[r][j].w)};
                const float* md = MODS + (size_t)((l + 1) * 3 + b) * 6 * D;
                norm_mod_store<F8_MISC != 0>(v[r], a.in[I_GMIX] + (l + 1) * D, md + 1 * D, md + 0 * D, (unsigned char*)H + (size_t)m * D * (F8_MISC ? 1 : 2), lane);
            } else {
                float s = 0.f;
#pragma unroll
                for (int j = 0; j < 4; ++j) s += (v[r][j].x * v[r][j].x + v[r][j].y * v[r][j].y) + (v[r][j].z * v[r][j].z + v[r][j].w * v[r][j].w);
                const float rs = 1.0f / sqrtf(wave_sum(s) * (1.0f / D) + EPS);
#pragma unroll
                for (int j = 0; j < 4; ++j) __builtin_nontemporal_store(v[r][j] * rs * ((const f32x4*)a.in[I_GFINAL])[lane + 64 * j], &((f32x4*)(a.out + (size_t)m * D))[lane + 64 * j]);
            }
        }
#pragma unroll
        for (int r = 0; r < 2; ++r) { tw[r] = ntw[r]; nps[r] = pps[r]; ntw[r] = ptw[r];
#pragma unroll
            for (int j = 0; j < 4; ++j) { xr[r][j] = xn[r][j];
#pragma unroll
                for (int k = 0; k < 4; ++k) y[r][j][k] = yn[r][j][k]; } }
    }
}
__device__ __forceinline__ void p_dwconv(const Args& a, int tid) {
    const bf16* U = (const bf16*)(a.ws + WS_U); bf16* ZP = (bf16*)(a.ws + WS_ZP);
    const float* WDW = a.in[I_WCVDW]; const float* BDW = a.in[I_BCVDW];
    const int half = tid >> 8, cp = tid & 255;
    typedef float f32x2v __attribute__((ext_vector_type(2)));
    auto line_of = [&](int unit, int& c, int& len, int& p0, size_t& base, size_t& stride) {
        const int hu = unit * 2 + half;
        if (hu < 2048) { c = 2 * cp; len = GRIDW; p0 = (hu & 3) * 16; base = (size_t)(hu >> 2) * GRIDW * D; stride = D; }
        else { const int v = hu - 2048; const int b = v >> 10, w = (v >> 4) & 63; c = 512 + 2 * cp; len = GRIDR; p0 = (v & 15) * 16; base = ((size_t)b * SEQ + w) * D; stride = (size_t)GRIDW * D; } };
    auto load_in = [&](int c, int len, int p0, size_t base, size_t stride, unsigned (&u)[46]) {
#pragma unroll
        for (int i = 0; i < 46; ++i) { const int pp = p0 - 15 + i; u[i] = (pp >= 0 && pp < len) ? *(const unsigned*)(U + base + (size_t)pp * stride + c) : 0u; } };
    int c, len, p0; size_t base, stride; unsigned u[46];
    f32x2v w2[CONVW]; f32x2v bb = (f32x2v){0.f, 0.f}; int wc = -1;
    if ((int)blockIdx.x < 2048) { line_of(blockIdx.x, c, len, p0, base, stride); load_in(c, len, p0, base, stride, u); }
    for (int unit = blockIdx.x; unit < 2048; unit += gridDim.x) {
        int cn = 0, lenn = 0, p0n = 0; size_t basen = 0, striden = 0; unsigned un[46]; const int nu = unit + gridDim.x;
        if (nu < 2048) { line_of(nu, cn, lenn, p0n, basen, striden); load_in(cn, lenn, p0n, basen, striden, un); }
        if (wc != c) { wc = c;
#pragma unroll
            for (int j = 0; j < CONVW; ++j) w2[j] = *(const f32x2v*)(WDW + j * D + c);
            bb = *(const f32x2v*)(BDW + c); }
        f32x2v in2[46];
#pragma unroll
        for (int i = 0; i < 46; ++i) in2[i] = (f32x2v){bf_lo(u[i]), bf_hi(u[i])};
#pragma unroll
        for (int i = 0; i < 16; ++i) { f32x2v acc2 = bb;
#pragma unroll
            for (int j = 0; j < CONVW; ++j) acc2 = __builtin_elementwise_fma(in2[i + j], w2[j], acc2);
            *(unsigned*)(ZP + base + (size_t)(p0 + i) * stride + c) = pk2(acc2.x, acc2.y); }
        c = cn; len = lenn; p0 = p0n; base = basen; stride = striden;
#pragma unroll
        for (int i = 0; i < 46; ++i) u[i] = un[i];
    }
}
__device__ __forceinline__ void p_ln_silu(const Args& a, int lane, int wave) {
    const int gw = blockIdx.x * NWAVES + wave, NGW = gridDim.x * NWAVES;
    const bf16* ZP = (const bf16*)(a.ws + WS_ZP); bf16* Z = (bf16*)(a.ws + WS_Z);
    f32x4 gg[4], bb[4];
#pragma unroll
    for (int j = 0; j < 4; ++j) { gg[j] = ((const f32x4*)a.in[I_GCVLN])[lane + 64 * j]; bb[j] = ((const f32x4*)a.in[I_BCVLN])[lane + 64 * j]; }
    v2u y[2][4];
    if (gw * 2 < NTOK) {
#pragma unroll
        for (int r = 0; r < 2; ++r)
#pragma unroll
            for (int j = 0; j < 4; ++j) y[r][j] = ((const v2u*)(ZP + (size_t)(gw * 2 + r) * D))[lane + 64 * j];
    }
    for (int m0 = gw * 2; m0 < NTOK; m0 += NGW * 2) {
        v2u yn[2][4]; const int mn = m0 + NGW * 2;
#pragma unroll
        for (int r = 0; r < 2; ++r)
#pragma unroll
            for (int j = 0; j < 4; ++j) yn[r][j] = mn < NTOK ? ((const v2u*)(ZP + (size_t)(mn + r) * D))[lane + 64 * j] : (v2u){0u, 0u};
#pragma unroll
        for (int r = 0; r < 2; ++r) {
            f32x4 v[4]; float s = 0.f;
#pragma unroll
            for (int j = 0; j < 4; ++j) { v[j] = (f32x4){bf_lo(y[r][j].x), bf_hi(y[r][j].x), bf_lo(y[r][j].y), bf_hi(y[r][j].y)}; s += (v[j].x + v[j].y) + (v[j].z + v[j].w); }
            const float mean = wave_sum(s) * (1.0f / D); float s2 = 0.f;
#pragma unroll
            for (int j = 0; j < 4; ++j) { v[j] = v[j] - mean; s2 += (v[j].x * v[j].x + v[j].y * v[j].y) + (v[j].z * v[j].z + v[j].w * v[j].w); }
            const float rstd = 1.0f / sqrtf(wave_sum(s2) * (1.0f / D) + EPS);
#pragma unroll
            for (int j = 0; j < 4; ++j) {
                f32x4 yy = v[j] * rstd * gg[j] + bb[j]; yy.x *= fsig(yy.x); yy.y *= fsig(yy.y); yy.z *= fsig(yy.z); yy.w *= fsig(yy.w);
                store_row4<F8_MISC != 0>((unsigned char*)Z + (size_t)(m0 + r) * D * (F8_MISC ? 1 : 2), lane, j, yy, 4.0f); }
        }
#pragma unroll
        for (int r = 0; r < 2; ++r)
#pragma unroll
            for (int j = 0; j < 4; ++j) y[r][j] = yn[r][j];
    }
}


enum { PH_PRO = 0, PH_NORM0, PH_INPROJ, PH_SCANA, PH_SCANC, PH_READOUT, PH_OUTPROJ, PH_ROUTER0, PH_G1_0, PH_G2_0, PH_COMB0, PH_CVIN, PH_DWCONV, PH_LN, PH_CVOUT, PH_ROUTER1, PH_G1_1, PH_G2_1, PH_FINAL, NPH };
#ifndef AEPI
#define AEPI 1
#endif
#ifndef REPMASK
#define REPMASK 0ull
#endif
#ifndef SCAN_NAIVE
#define SCAN_NAIVE 0
#endif
#if defined(__HIP_DEVICE_COMPILE__)
#define NO_PK_F32
#else
#define NO_PK_F32
#endif
__global__ void NO_PK_F32 __launch_bounds__(NTHR, 2) fwd_kernel(Args args) {
    extern __shared__ __attribute__((aligned(16))) unsigned char lds_raw[];
    LAS unsigned char* lds = (LAS unsigned char*)lds_raw;
    const int tid = threadIdx.x, lane = tid & 63, wave = __builtin_amdgcn_readfirstlane(tid >> 6);
    const int G = gridDim.x, bid = blockIdx.x;
    unsigned char* ws = args.ws;
    for (int u = tid; u < (LDS_BYTES - LDSCTL_OFF) / 4; u += NTHR) ((LAS unsigned*)(lds + LDSCTL_OFF))[u] = 0u;
    __syncthreads();
    volatile LAS unsigned* MISC = (volatile LAS unsigned*)(lds + MISC_OFF);
    XcdBarrier bar = xcd_barrier_post((unsigned*)(ws + WS_CTL) + CW_BAR + args.li * XCD_BAR_WORDS, MISC + 8);
    const int lo = args.ph_lo, hi = args.ph_hi;
    if (TL_PROBE && tid == 0) MISC[48] = (unsigned)__builtin_amdgcn_s_memrealtime();
    if (tid == 0) __hip_atomic_store((unsigned*)(ws + WS_CTL) + CW_XMAP + bid, xb_xcc_id() + 1u, __ATOMIC_RELAXED, __HIP_MEMORY_SCOPE_AGENT);
#define IN(k) (lo <= (k) && (k) < hi)
    int cv_n = 0; unsigned bseq = 0;
#ifndef FLAT_BARRIER
#define FLAT_BARRIER 0
#endif
#define SEAM(k) do { if (IN(k) && IN((k) + 1)) { ++bseq; if (FLAT_BARRIER) flat_barrier_work((unsigned*)(ws + WS_CTL) + CW_FLAT, args, lds, wave, lane, cv_n, MISC + 12, bseq); else xcd_barrier_work(bar, args, lds, wave, lane, cv_n, MISC + 12, bseq); \
        if (TL_PROBE && tid == 0) MISC[48 + (k) + 1] = (unsigned)__builtin_amdgcn_s_memrealtime(); } } while (0)
#define PHASE(k, ...) if (IN(k)) { __VA_ARGS__; if ((REPMASK >> (k)) & 1ull) { __syncthreads(); __VA_ARGS__; } if (TL_PROBE && tid == 0) MISC[72 + (k)] = (unsigned)__builtin_amdgcn_s_memrealtime(); } SEAM(k);
    typedef pg8::bf16_t pbf;

    const bool merge_pro = false && (G >= 32) && IN(PH_PRO) && IN(PH_NORM0);
    if (IN(PH_PRO)) { p_mods(args, lds, tid, lane, wave); p_weights(args, lds, lane, wave); if (merge_pro) wait_mods0(args, tid); }
    if (!merge_pro) SEAM(PH_PRO);
    const bool ctx_early = SPLIT_IN && (G == 256);
    PHASE(PH_NORM0, {
        if (ctx_early && bid < 24) {
            const int cb = bid / 12, cj = bid % 12;
            p_norm0(args, lane, wave, NWAVES, NTOK + cb * CTXL, NTOK + cb * CTXL + CTXL);
            VM_WAIT(); __syncthreads();
            if (cj < 8) {
                pg8::Gemm g{(const pbf*)(ws + WS_H8), (const pbf*)(ws + WS_WIN8), D / 2, 0};
                pg8::OneUnit S1{NTOK / 256 + cb, cj};
                pg8::EpiHgrnIn E{(pbf*)(ws + WS_Q), (WS_V - WS_Q) / 2, (_Float16*)(ws + WS_LFF), (WS_LFB - WS_LFF) / 2, args.in[I_HGAMMA], 2};
                pg8::gemm_phase<pg8::EpiHgrnIn, pg8::OneUnit, AEPI != 0, true, true, 0x79797979, 0x7F7F7F7F>(lds + RING_OFF, g, S1, E);
            } else {
                pg8::Gemm g{(const pbf*)(ws + WS_H), (const pbf*)(ws + WS_WIN), D, 0};
                pg8::OneUnit S1{NTOK / 256 + cb, 4 + (cj - 8)};
                pg8::EpiHgrnIn E{(pbf*)(ws + WS_Q), (WS_V - WS_Q) / 2, (_Float16*)(ws + WS_LFF), (WS_LFB - WS_LFF) / 2, args.in[I_HGAMMA], 1};
                pg8::gemm_phase<pg8::EpiHgrnIn, pg8::OneUnit, AEPI != 0, true, false>(lds + RING_OFF, g, S1, E);
            }
        } else if (ctx_early) p_norm0(args, lane, (bid - 24) * NWAVES + wave, (G - 24) * NWAVES, 0, NTOK);
        else p_norm0(args, lane, bid * NWAVES + wave, G * NWAVES, 0, MROWS);
    })
    PHASE(PH_INPROJ, {
        static_assert(WS_V - WS_Q == WS_SG - WS_V, "Q|V|SG equally spaced");
        if (SPLIT_IN) {
            const int nMi = ctx_early ? NTOK / 256 : MROWS / 256;
            {
                pg8::Gemm g{(const pbf*)(ws + WS_H8), (const pbf*)(ws + WS_WIN8), D / 2, 0};
                pg8::TileOrder S; S.init(nMi, (G_F8 ? 3 : 2) * D / 256, G, bid, nullptr);
                pg8::EpiHgrnIn E{(pbf*)(ws + WS_Q), (WS_V - WS_Q) / 2, (_Float16*)(ws + WS_LFF), (WS_LFB - WS_LFF) / 2, args.in[I_HGAMMA], 2};
                pg8::gemm_phase<pg8::EpiHgrnIn, pg8::TileOrder, AEPI != 0, true, true, 0x79797979, 0x7F7F7F7F>(lds + RING_OFF, g, S, E);
            }
            {
                pg8::Gemm g{(const pbf*)(ws + WS_H), (const pbf*)(ws + WS_WIN), D, 0};
                pg8::TileOrder S; S.init(nMi, (G_F8 ? 2 : 3) * D / 256, G, bid, nullptr);
                pg8::EpiHgrnIn E{(pbf*)(ws + WS_Q), (WS_V - WS_Q) / 2, (_Float16*)(ws + WS_LFF), (WS_LFB - WS_LFF) / 2, args.in[I_HGAMMA], 1};
                pg8::gemm_phase<pg8::EpiHgrnIn, pg8::TileOrder, AEPI != 0, true, false>(lds + RING_OFF, g, S, E);
            }
        } else {
            pg8::Gemm g{(const pbf*)(ws + WS_H), (const pbf*)(ws + WS_WIN), F8_IN ? D / 2 : D, 0};
            pg8::TileOrder S; S.init(MROWS / 256, 5 * D / 256, G, bid, nullptr);
            pg8::EpiHgrnIn E{(pbf*)(ws + WS_Q), (WS_V - WS_Q) / 2, (_Float16*)(ws + WS_LFF), (WS_LFB - WS_LFF) / 2, args.in[I_HGAMMA], 0};
            pg8::gemm_phase<pg8::EpiHgrnIn, pg8::TileOrder, AEPI != 0, true, F8_IN != 0, 0x79797979, 0x7F7F7F7F>(lds + RING_OFF, g, S, E);
        }
    })
#if SCAN_NAIVE
    PHASE(PH_SCANA, { p_scan_naive(args, lds, tid); })
    PHASE(PH_SCANC, { })
#else
    PHASE(PH_SCANA, { p_scan_a(args, lds, tid, lane, wave); })
    PHASE(PH_SCANC, { p_scan_c(args, lds, tid, lane, wave); })
#endif
    PHASE(PH_READOUT, { p_readout(args, lane, wave); })
    PHASE(PH_OUTPROJ, {
        pg8::Gemm g{(const pbf*)(ws + WS_YIN), (const pbf*)(ws + WS_WOUT), F8_MISC ? D / 2 : D, 0};
        pg8::TileOrder S; S.init(NTOK / 256, D / 256, G, bid, nullptr);
        pg8::EpiResGate<false, true> E{args.in[I_X], (void*)(ws + WS_X), (const float*)(ws + WS_MODS) + 2 * D, 6 * D, SEQ, nullptr};
        pg8::gemm_phase<pg8::EpiResGate<false, true>, pg8::TileOrder, AEPI != 0, true, F8_MISC != 0, 0x79797979, 0x7D7D7D7D>(lds + RING_OFF, g, S, E);
    })
#ifndef LDSB
#define LDSB 1
#endif
#ifndef XBAR_PROBE
#define XBAR_PROBE 0
#endif
#ifndef G2_NS
#define G2_NS 0
#endif
#ifndef G1_NS
#define G1_NS 0
#endif
#ifndef MOE_HANDOFF
#define MOE_HANDOFF 1
#endif
#ifndef MOE_WT
#define MOE_WT 0
#endif
#define MOE_PHASES(l, pb) \
    if (IN(pb + 0)) { p_router(args, lds, l, tid, lane, wave); cv_finish(args, lds, wave, lane, cv_n, (l + 1) * CV_L0); } SEAM(pb + 0); \
    if ((l) == 1) { if (XBAR_PROBE >= 1) SEAM(pb + 0); if (XBAR_PROBE >= 2) SEAM(pb + 0); if (XBAR_PROBE >= 3) SEAM(pb + 0); if (XBAR_PROBE >= 4) SEAM(pb + 0); }     \
    if (IN(pb + 1) || IN(pb + 2) || IN(pb + 3)) { \
        moe_tables(args, lds, l, tid); \
        LAS int* tab = (LAS int*)(lds + EXTRA_OFF + 640); \
        const LAS int* s_tb = (const LAS int*)(lds + EXTRA_OFF + 256); const LAS int* s_ce = s_tb + 40; \
        const int ntiles = __builtin_amdgcn_readfirstlane(s_tb[32]); \
        const bool hand = MOE_HANDOFF && (G == 256) && IN(pb + 1) && IN(pb + 2) && !((REPMASK >> (pb + 1)) & 3ull) && (MOE_WT || xmap_ok); \
        const int xl = (hand && !MOE_WT) ? 1 : 0; \
        unsigned* tcnt = (unsigned*)(ws + WS_CTL) + CW_TCNT + l * 32768; \
        const int c2 = (hand && MOE_WT) ? ((bid - ((((ntiles * 8) & 255) + 7) & ~7)) & 255) : bid;     \
        const int tv = (((bid & 7) + 1) * ntiles >> 3) - ((bid & 7) * ntiles >> 3);                   \
        LAS int* ut1 = (LAS int*)(lds + EXTRA_OFF + 13824); LAS int* ut2 = ut1 + 32;                  \
        if (wave == 0) { \
            int pm_ = 0, pn_ = 0; \
            const bool h1 = lane < 32 && pg8::MoeOrder::unit_of(xl, ntiles, 2 * D / 256, G, bid, bid >> 3, lane, pm_, pn_); \
            if (lane < 32) ut1[lane] = h1 ? (pm_ | (pn_ << 16) | (tab[pm_] << 24)) : 0; \
            const bool h2 = lane < 32 && pg8::MoeOrder::unit_of(xl, ntiles, D / 256, G, c2, ((bid >> 3) - ((tv * 8) & 31)) & 31, lane, pm_, pn_); \
            if (lane < 32) ut2[lane] = h2 ? (pm_ | (pn_ << 16) | (tab[pm_] << 24)) : 0; \
            const int n1 = __popcll(__ballot(h1)), n2 = __popcll(__ballot(h2)); \
            if (lane == 0) { ut1[64] = n1; ut1[65] = n2; } \
        } \
        __syncthreads(); \
        const int nu1 = __builtin_amdgcn_readfirstlane(ut1[64]), nu2 = __builtin_amdgcn_readfirstlane(ut1[65]); \
        if (IN(pb + 1)) { \
            LAS unsigned short* tt = (LAS unsigned short*)(lds + EXTRA_OFF + 2816);     \
            pg8::MoeOrder S; S.ut = ut1; S.nu = nu1; S.cnt = tcnt; S.rdy = 0u; S.mode = hand ? 0 : 2; \
            { const int* STOK = (const int*)(ws + WS_STOK); int tv_[10];                         \
              _Pragma("unroll") for (int n_ = 0; n_ < 10; ++n_) { const int idx = tid + NTHR * n_; tv_[n_] = 0; \
                  if (idx < nu1 * 256) { const int uw = ut1[idx >> 8], pm_ = uw & 0xFFFF, e_ = (uw >> 24) & 0xFF, vi = (pm_ - s_tb[e_]) * 256 + (idx & 255); if (vi < s_ce[e_]) tv_[n_] = STOK[(size_t)e_ * NTOK + vi]; } } \
              _Pragma("unroll") for (int n_ = 0; n_ < 10; ++n_) { const int idx = tid + NTHR * n_; if (idx < nu1 * 256) tt[idx] = (unsigned short)tv_[n_]; } } \
            __syncthreads(); \
            pg8::Gemm g{(const pbf*)(ws + WS_H), (const pbf*)(ws + WS_W1 + (size_t)l * NE * 2 * D * D), D / 2, (size_t)2 * D * D, tt};   \
            pg8::EpiPair<0, true, 4, MOE_WT != 0, LDSB != 0> E{(pbf*)(ws + WS_ACT), args.in[I_BE1] + (size_t)l * NE * 2 * D, (const LAS float*)(lds + EXTRA_OFF + 14336)}; \
            pg8::gemm_phase<pg8::EpiPair<0, true, 4, MOE_WT != 0, LDSB != 0>, pg8::MoeOrder, AEPI != 0, true, true, 0x79797979, 0x7F7F7F7F, true, G1_NS>(lds + RING_OFF, g, S, E); \
            if ((REPMASK >> (pb + 1)) & 1ull) { __syncthreads(); pg8::gemm_phase<pg8::EpiPair<0, true, 4, MOE_WT != 0, LDSB != 0>, pg8::MoeOrder, AEPI != 0, true, true, 0x79797979, 0x7F7F7F7F, true, G1_NS>(lds + RING_OFF, g, S, E); } \
        } \
        pg8::MoeOrder S2; S2.ut = ut2; S2.nu = nu2; S2.cnt = tcnt; S2.rdy = 0u; S2.mode = hand ? 1 : 2; \
        if (hand) {                                                          \
            if (wave == 0) { \
                const unsigned v = lane < nu2 ? __hip_atomic_load(tcnt + 32 * (ut2[lane & 31] & 0xFFFF), __ATOMIC_RELAXED, __HIP_MEMORY_SCOPE_AGENT) : 64u; \
                const unsigned long long m = __ballot(v >= 64u); \
                __builtin_amdgcn_fence(__ATOMIC_ACQUIRE, "agent"); asm volatile("s_waitcnt vmcnt(0)" ::: "memory"); \
                if (lane == 0) MISC[16] = (unsigned)m; \
            } \
            __syncthreads(); \
            S2.rdy = __builtin_amdgcn_readfirstlane(MISC[16]); \
        } else SEAM(pb + 1); \
        PHASE(pb + 2, { \
            pg8::Gemm g{(const pbf*)(ws + WS_ACT), (const pbf*)(ws + WS_W2 + (size_t)l * NE * D * D), D / 2, (size_t)D * D}; \
            pg8::EpiMoeOut<F8_Y != 0, YSCALE, LDSB != 0> E{(pbf*)(ws + WS_YS), args.in[I_BE2] + (size_t)l * NE * D, (const LAS float*)(lds + EXTRA_OFF + 14336)}; \
            pg8::gemm_phase<pg8::EpiMoeOut<F8_Y != 0, YSCALE, LDSB != 0>, pg8::MoeOrder, AEPI != 0, true, true, 0x79797979, 0x7D7D7D7D, false, G2_NS>(lds + RING_OFF, g, S2, E);   \
        }) \
    }
    bool xmap_ok = false;
    if (MOE_HANDOFF && !MOE_WT && G == 256 && lo == 0) {
        if (wave == 0) {
            const unsigned* xm = (const unsigned*)(ws + WS_CTL) + CW_XMAP; bool ok = true;
#pragma unroll
            for (int k = 0; k < 4; ++k) { const int b = lane + 64 * k; const unsigned mine = __hip_atomic_load(xm + b, __ATOMIC_RELAXED, __HIP_MEMORY_SCOPE_AGENT), cls = __hip_atomic_load(xm + (b & 7), __ATOMIC_RELAXED, __HIP_MEMORY_SCOPE_AGENT);
                ok = ok && mine != 0u && mine == cls; }
            const unsigned me = __hip_atomic_load(xm + (lane & 7), __ATOMIC_RELAXED, __HIP_MEMORY_SCOPE_AGENT);
#pragma unroll
            for (int j = 1; j < 8; ++j) { const unsigned other = (unsigned)__shfl((int)me, (lane + j) & 7); ok = ok && other != me; }
            const bool all_ok = __all(ok);
            if (lane == 0) MISC[17] = all_ok ? 1u : 0u;
        }
        __syncthreads();
        xmap_ok = __builtin_amdgcn_readfirstlane(MISC[17]) != 0u;
    }
    MOE_PHASES(0, PH_ROUTER0)
    PHASE(PH_COMB0, { p_combine<false>(args, lds, 0, lane, wave); })
    PHASE(PH_CVIN, {
        pg8::Gemm g{(const pbf*)(ws + WS_H), (const pbf*)(ws + WS_WCVIN), F8_MISC ? D / 2 : D, 0};
        pg8::TileOrder S; S.init(NTOK / 256, 2 * D / 256, G, bid, nullptr);
        pg8::EpiPair<1> E{(pbf*)(ws + WS_U), args.in[I_BCVIN]};
        pg8::gemm_phase<pg8::EpiPair<1>, pg8::TileOrder, AEPI != 0, true, F8_MISC != 0, 0x79797979, 0x7F7F7F7F>(lds + RING_OFF, g, S, E);
    })
    PHASE(PH_DWCONV, { p_dwconv(args, tid); })
    PHASE(PH_LN, { p_ln_silu(args, lane, wave); })
    PHASE(PH_CVOUT, {
        pg8::Gemm g{(const pbf*)(ws + WS_Z), (const pbf*)(ws + WS_WCVOUT), F8_MISC ? D / 2 : D, 0};
        pg8::TileOrder S; S.init(NTOK / 256, D / 256, G, bid, nullptr);
        pg8::EpiResGate<true, true> E{(const void*)(ws + WS_X), (void*)(ws + WS_X), (const float*)(ws + WS_MODS) + 3 * 6 * D + 2 * D, 6 * D, SEQ, args.in[I_BCVOUT]};
        pg8::gemm_phase<pg8::EpiResGate<true, true>, pg8::TileOrder, AEPI != 0, true, F8_MISC != 0, 0x79797979, 0x7D7D7D7D>(lds + RING_OFF, g, S, E);
    })
#ifndef CLK_PROBE
#define CLK_PROBE 0
#endif
#if CLK_PROBE
    if (bid == 0 && tid == 0) { const unsigned long long c = __builtin_amdgcn_s_memtime(), w = __builtin_amdgcn_s_memrealtime(); MISC[20] = (unsigned)c; MISC[21] = (unsigned)(c >> 32); MISC[22] = (unsigned)w; MISC[23] = (unsigned)(w >> 32); }
#endif
    MOE_PHASES(1, PH_ROUTER1)
#if CLK_PROBE
    if (bid == 0 && tid == 0) { const unsigned long long c = __builtin_amdgcn_s_memtime(), w = __builtin_amdgcn_s_memrealtime(); MISC[24] = (unsigned)c; MISC[25] = (unsigned)(c >> 32); MISC[26] = (unsigned)w; MISC[27] = (unsigned)(w >> 32); }
#endif
    if (IN(PH_FINAL)) { p_combine<true>(args, lds, 1, lane, wave); }
#if KL_PROBE
    static_assert(pg8::KLP_LDS == MISC_OFF + 4 * 28, "probe words");
    if (bid == 0 && tid == 0) {
        const unsigned long long kl = ((unsigned long long)MISC[29] << 32) | MISC[28]; const unsigned nun = MISC[30] ? MISC[30] : 1u;
        const unsigned long long tot = ((unsigned long long)MISC[37] << 32) | MISC[36];
        const unsigned long long ticks = KL_PROBE == 1 ? kl * 10ull / (8ull * nun) : (tot - kl) * 5ull / nun;
        const unsigned long long t_end = __builtin_amdgcn_s_memrealtime() + (ticks < 100000ull ? ticks : 100000ull);
        while (__builtin_amdgcn_s_memrealtime() < t_end) __builtin_amdgcn_s_sleep(8);
    }
#endif
#if TL_PROBE
    if (bid == 0 && tid == 0) { const unsigned ticks = TL_BODY ? MISC[72 + TL_B] - MISC[48 + TL_B] : MISC[48 + TL_B + 1] - MISC[48 + TL_A + 1];     const unsigned long long t_end = __builtin_amdgcn_s_memrealtime() + 2ull * (ticks < 200000u ? ticks : 200000u); while (__builtin_amdgcn_s_memrealtime() < t_end) __builtin_amdgcn_s_sleep(8); }
#endif
#if CVF_PROBE
    if (bid == 0 && tid == 0) { const unsigned long long t_end = __builtin_amdgcn_s_memrealtime() + 2ull * MISC[40]; while (__builtin_amdgcn_s_memrealtime() < t_end) __builtin_amdgcn_s_sleep(8); }
#endif
#if CLK_PROBE
    if (bid == 0 && tid == 0) {
        const unsigned long long c0 = ((unsigned long long)MISC[21] << 32) | MISC[20], w0 = ((unsigned long long)MISC[23] << 32) | MISC[22], c1 = ((unsigned long long)MISC[25] << 32) | MISC[24], w1 = ((unsigned long long)MISC[27] << 32) | MISC[26];
        const unsigned long long ticks = (c1 - c0) * 1000ull / (w1 - w0 + 1ull);
        const unsigned long long t_end = __builtin_amdgcn_s_memrealtime() + (ticks < 100000ull ? ticks : 100000ull);
        while (__builtin_amdgcn_s_memrealtime() < t_end) __builtin_amdgcn_s_sleep(8);
    }
#endif
#undef MOE_PHASES
#undef PHASE
#undef IN
#undef SEAM
}

extern "C" void kernel_launch(void* const* d_in, const int* in_sizes, int n_in, void* d_out, int out_size, void* d_ws, size_t ws_size, hipStream_t stream) {
    static int grid = 0;
    if (grid == 0) {
        if (n_in != N_IN || in_sizes[0] != NTOK * D || out_size != NTOK * D || ws_size < WS_END) { fprintf(stderr, "kernel_launch: unexpected shapes / workspace (n_in %d, in0 %d, out %d, ws %zu, need %zu); nothing launched\n", n_in, n_in > 0 ? in_sizes[0] : -1, out_size, ws_size, (size_t)WS_END); grid = -1; return; }
        int dev = 0, cus = 0, per_cu = 0;
        if (hipGetDevice(&dev) != hipSuccess || hipDeviceGetAttribute(&cus, hipDeviceAttributeMultiprocessorCount, dev) != hipSuccess) { grid = -1; return; }
        if (hipFuncSetAttribute((const void*)fwd_kernel, hipFuncAttributeMaxDynamicSharedMemorySize, LDS_BYTES) != hipSuccess) { fprintf(stderr, "kernel_launch: hipFuncSetAttribute failed\n"); grid = -1; return; }
        if (hipOccupancyMaxActiveBlocksPerMultiprocessor(&per_cu, (const void*)fwd_kernel, NTHR, LDS_BYTES) != hipSuccess || per_cu < 1) { fprintf(stderr, "kernel_launch: occupancy query reports %d workgroups per CU\n", per_cu); }
        (void)hipGetLastError();
        grid = cus;
    }
    if (grid < 0) return;
    if (hipMemsetAsync((char*)d_ws + WS_CTL, 0, CTL_ZERO_BYTES, stream) != hipSuccess) return;
#ifdef DIAG_MEMSET
    (void)hipMemsetAsync((char*)d_ws + WS_SP, 0, (WS_WIN - WS_SP), stream); (void)hipMemsetAsync((char*)d_ws + WS_OF, 0, (WS_YIN - WS_OF), stream);
#endif
    Args a{};
    for (int i = 0; i < N_IN; ++i) a.in[i] = (const float*)d_in[i];
    a.out = (float*)d_out; a.ws = (unsigned char*)d_ws; a.pad = 0;
#ifndef MK_CUTS
    a.ph_lo = 0; a.ph_hi = NPH; a.li = 0;
    hipLaunchKernelGGL(fwd_kernel, dim3(grid), dim3(NTHR), LDS_BYTES, stream, a);
#else
    const int cuts[] = {MK_CUTS};
    const int nc = (int)(sizeof(cuts) / sizeof(cuts[0]));
    for (int li = 0; li + 1 < nc; ++li) { a.ph_lo = cuts[li]; a.ph_hi = cuts[li + 1]; a.li = li; hipLaunchKernelGGL(fwd_kernel, dim3(grid), dim3(NTHR), LDS_BYTES, stream, a); }
#endif
}
```

```cpp
#include <hip/hip_runtime.h>
#include <cstdio>
#include <cstdint>
__device__ __forceinline__ void wg_sync_() { __builtin_amdgcn_fence(__ATOMIC_RELEASE, "workgroup"); __builtin_amdgcn_s_barrier(); __builtin_amdgcn_fence(__ATOMIC_ACQUIRE, "workgroup"); }
#define __syncthreads() wg_sync_()
#define __ballot(p) __builtin_amdgcn_ballot_w64((p) != 0)
#define __all(p) (__builtin_amdgcn_ballot_w64(!(p)) == 0ull)
#define __shfl(v, src) __builtin_amdgcn_ds_bpermute((int)(src) << 2, (int)(v))
#define __popcll(x) __builtin_popcountll(x)

namespace pg8 {
#define PG8_LAS __attribute__((address_space(3)))
typedef unsigned short bf16_t;
typedef short bf16x8 __attribute__((ext_vector_type(8)));
typedef float f32x4 __attribute__((ext_vector_type(4)));
typedef unsigned u32x4 __attribute__((ext_vector_type(4)));
typedef unsigned u32x2 __attribute__((ext_vector_type(2)));
typedef int i32x4 __attribute__((ext_vector_type(4)));
typedef int i32x8 __attribute__((ext_vector_type(8)));
#ifndef KL_PROBE
#define KL_PROBE 0
#endif
constexpr int KLP_LDS = 139264 + 320 + 4 * 28;
constexpr int BM = 256, BK = 64, HALF = 128, HTB = HALF * BK * 2  , STAGE_BYTES = 8 * HTB, NXCD = 8, WGM = 8;

__host__ __device__ __forceinline__ int lds_byte(int r, int c) { const int st = (r >> 4) * 2 + (c >> 5), rr = r & 15, cc = c & 31, ob = rr * 64 + cc * 2; return st * 1024 + (ob ^ (((ob >> 9) & 1) << 5)); }
__host__ __device__ __forceinline__ void stage_rc(int b, int& R, int& C) { const int st = b / 1024, sb = b % 1024, swz = sb ^ (((sb >> 9) & 1) << 5); R = (st >> 1) * 16 + swz / 64; C = (st & 1) * 32 + (swz % 64) / 2; }
__host__ __device__ __forceinline__ int perm32(int rho) { const int n = rho >> 4, i = rho & 15; return 8 * (i >> 2) + 4 * n + (i & 3); }

struct Unit { int pm, pn, e; };
struct Gemm { const bf16_t* A; const bf16_t* Bt; int K; size_t estride; const PG8_LAS unsigned short* tt; };

struct TileOrder {
    int nM, nN, nwg, G, c; const PG8_LAS int* tile_e;
    __device__ __forceinline__ void init(int nM_, int nN_, int G_, int c_, const PG8_LAS int* te) { nM = nM_; nN = nN_; nwg = nM * nN; G = G_; c = c_; tile_e = te; }
    __device__ __forceinline__ bool next(int i, Unit& u) const {
        const long L = (long)i * G + c; if (L >= nwg) return false;
        int wgid = (int)L; { const int q = nwg / NXCD, r = nwg % NXCD, xcd = wgid % NXCD, off = wgid / NXCD; wgid = (xcd < r ? xcd * (q + 1) : r * (q + 1) + (xcd - r) * q) + off; }
        const int nig = WGM * nN, gid = wgid / nig, fm = gid * WGM, gsz = (nM - fm) < WGM ? (nM - fm) : WGM;
        u.pm = fm + ((wgid % nig) % gsz); u.pn = (wgid % nig) / gsz;
        u.e = tile_e ? __builtin_amdgcn_readfirstlane(tile_e[u.pm]) : 0; return true;
    }
    static constexpr bool PUBLISH = false;
    __device__ __forceinline__ bool probe_on() const { return false; }
    __device__ __forceinline__ void a_ready(const Unit&, int) const {}
    __device__ __forceinline__ void done(const Unit&) const {}
    __device__ __forceinline__ void publish(int, int) const {}
};

struct MoeOrder {
    static constexpr bool PUBLISH = true;
    const PG8_LAS int* ut; int nu;
    unsigned* cnt; unsigned rdy; int mode;
    static __device__ __forceinline__ bool unit_of(int xl, int nM, int nN, int G, int c, int rrot, int i, int& pm, int& pn) {
        if (!xl) { TileOrder T; T.init(nM, nN, G, c, nullptr); Unit u; if (!T.next(i, u)) return false; pm = u.pm; pn = u.pn; return true; }
        const int v = c & 7, T0 = (v * nM) >> 3, Tv = (((v + 1) * nM) >> 3) - T0;
        const int Lx = i * 32 + rrot; if (Lx >= Tv * nN) return false;
        const int nig = WGM * nN, gid = Lx / nig, fm = gid * WGM, gsz = (Tv - fm) < WGM ? (Tv - fm) : WGM, w = Lx % nig;
        pm = T0 + fm + (w % gsz); pn = w / gsz; return true;
    }
    __device__ __forceinline__ bool next(int i, Unit& u) const {
        if (i >= nu) return false;
        const int v = __builtin_amdgcn_readfirstlane(ut[i]); u.pm = v & 0xFFFF; u.pn = (v >> 16) & 0xFF; u.e = (v >> 24) & 0xFF; return true;
    }
    __device__ __forceinline__ bool probe_on() const { return mode == 0; }
    __device__ __forceinline__ void done(const Unit&) const {}
    __device__ __forceinline__ void publish(int pm, int lane) const {
        if (mode == 0 && lane == 0) (void)__hip_atomic_fetch_add(cnt + 32 * pm, 1u, __ATOMIC_RELAXED, __HIP_MEMORY_SCOPE_AGENT);
    }
    __device__ __forceinline__ void a_ready(const Unit& u, int i) const {
        if (mode != 1 || ((rdy >> i) & 1u)) return;
        if (__builtin_amdgcn_readfirstlane(threadIdx.x >> 6) == 0) {
            unsigned sp = 0;
            while (__hip_atomic_load(cnt + 32 * u.pm, __ATOMIC_RELAXED, __HIP_MEMORY_SCOPE_AGENT) < 64u) { __builtin_amdgcn_s_sleep(1); if (++sp > (1u << 20)) break; }
            __builtin_amdgcn_fence(__ATOMIC_ACQUIRE, "agent");
            asm volatile("s_waitcnt vmcnt(0)" ::: "memory");
        }
        __builtin_amdgcn_s_barrier();
    }
};

struct OneUnit {
    int pm, pn;
    __device__ __forceinline__ bool next(int i, Unit& u) const { if (i != 0) return false; u.pm = pm; u.pn = pn; u.e = 0; return true; }
    static constexpr bool PUBLISH = false;
    __device__ __forceinline__ bool probe_on() const { return false; }
    __device__ __forceinline__ void a_ready(const Unit&, int) const {}
    __device__ __forceinline__ void done(const Unit&) const {}
    __device__ __forceinline__ void publish(int, int) const {}
};

__device__ __forceinline__ unsigned cvt_pk_bf16(float lo, float hi) { unsigned r; asm volatile("v_cvt_pk_bf16_f32 %0, %1, %2" : "=v"(r) : "v"(lo), "v"(hi)); return r; }
__device__ __forceinline__ float fsigmoid(float x) { return __builtin_amdgcn_rcpf(1.0f + __expf(-x)); }


struct EpiHgrnIn {
    static constexpr bool PERM = true, AFTER_DRAIN = false, LDS_BIAS = false;
    bf16_t* Q; size_t qstride; _Float16* LFF; size_t lfstride; const float* gamma; int mode;
    static __device__ __forceinline__ f32x4 vexp2(f32x4 t) { f32x4 e; e[0] = __builtin_amdgcn_exp2f(t[0]); e[1] = __builtin_amdgcn_exp2f(t[1]); e[2] = __builtin_amdgcn_exp2f(t[2]); e[3] = __builtin_amdgcn_exp2f(t[3]); return e; }
    static __device__ __forceinline__ f32x4 vrcp(f32x4 d) { f32x4 r; r[0] = __builtin_amdgcn_rcpf(d[0]); r[1] = __builtin_amdgcn_rcpf(d[1]); r[2] = __builtin_amdgcn_rcpf(d[2]); r[3] = __builtin_amdgcn_rcpf(d[3]); return r; }
    static __device__ __forceinline__ f32x4 vlog2(f32x4 d) { f32x4 r; r[0] = __builtin_amdgcn_logf(d[0]); r[1] = __builtin_amdgcn_logf(d[1]); r[2] = __builtin_amdgcn_logf(d[2]); r[3] = __builtin_amdgcn_logf(d[3]); return r; }
    __device__ __forceinline__ void operator()(const f32x4 (&acc)[2][2][4][2], const Unit& u, int wr, int wc, int fr, int fq) const {
        const int sg_ = u.pn >> 2, seg = mode == 0 ? sg_ : (mode == 1 ? (sg_ < 2 ? sg_ : 4) : 2 + sg_), cb = (u.pn & 3) * 256 + wc * 32 + 8 * fq;
        const int row0 = u.pm * BM + wr * 64 + fr;
        if (seg == 2 || seg == 3) {
            _Float16* O = LFF + (size_t)(seg - 2) * lfstride; const float* g0 = gamma + (seg - 2) * 2048 + cb;
            f32x4 lb[2][2];
#pragma unroll
            for (int bj = 0; bj < 2; ++bj)
#pragma unroll
                for (int n = 0; n < 2; ++n) { const f32x4 d = *(const f32x4*)(g0 + bj * HALF + 4 * n) - *(const f32x4*)(g0 + 1024 + bj * HALF + 4 * n);
                    lb[bj][n] = vrcp(vexp2(d * -1.4426950408889634f) + 1.0f); }
#pragma unroll
            for (int ai = 0; ai < 2; ++ai)
#pragma unroll
                for (int m = 0; m < 4; ++m) { _Float16* rowp = O + (size_t)(row0 + ai * HALF + m * 16) * 1024 + cb;
#pragma unroll
                    for (int bj = 0; bj < 2; ++bj) { typedef _Float16 h16x8 __attribute__((ext_vector_type(8))); h16x8 o;
#pragma unroll
                        for (int n = 0; n < 2; ++n) { const f32x4 sg = vrcp(vexp2(acc[ai][bj][m][n] * -1.4426950408889634f) + 1.0f);
                            const f32x4 lf = vlog2(lb[bj][n] + (1.0f - lb[bj][n]) * sg);
                            o[4 * n + 0] = (_Float16)lf[0]; o[4 * n + 1] = (_Float16)lf[1]; o[4 * n + 2] = (_Float16)lf[2]; o[4 * n + 3] = (_Float16)lf[3]; }
                        *(h16x8*)(rowp + bj * HALF) = o; } }
        } else {
            bf16_t* O = Q + (size_t)(seg - (seg >> 2) * 2) * qstride;
#pragma unroll
            for (int ai = 0; ai < 2; ++ai)
#pragma unroll
                for (int m = 0; m < 4; ++m) { bf16_t* rowp = O + (size_t)(row0 + ai * HALF + m * 16) * 1024 + cb;
#pragma unroll
                    for (int bj = 0; bj < 2; ++bj) { f32x4 v0 = acc[ai][bj][m][0], v1 = acc[ai][bj][m][1];
                        if (seg == 4) { v0 = v0 * vrcp(vexp2(v0 * -1.4426950408889634f) + 1.0f); v1 = v1 * vrcp(vexp2(v1 * -1.4426950408889634f) + 1.0f); }
                        u32x4 w; w.x = cvt_pk_bf16(v0[0], v0[1]); w.y = cvt_pk_bf16(v0[2], v0[3]); w.z = cvt_pk_bf16(v1[0], v1[1]); w.w = cvt_pk_bf16(v1[2], v1[3]);
                        *(u32x4*)(rowp + bj * HALF) = w; } }
        }
    }
};
template <bool B16> struct RawOf { typedef u32x4 T; };
template <> struct RawOf<true> { typedef u32x2 T; };
template <bool BASE16, bool OUT16> struct EpiResGate {
    static constexpr bool PERM = false, AFTER_DRAIN = false, LDS_BIAS = false;
    const void* base; void* out; const float* gate; int gate_bstride; int rows_per_batch; const float* bias;
    __device__ __forceinline__ void operator()(const f32x4 (&acc)[2][2][4][2], const Unit& u, int wr, int wc, int fr, int fq) const {
        const int row0 = u.pm * BM + wr * 64 + fr, col0 = u.pn * BM + wc * 32 + 4 * fq;
        const float* gv_ = gate + (size_t)((u.pm * BM) / rows_per_batch) * gate_bstride;
        f32x4 gv[2][2], bv[2][2];
#pragma unroll
        for (int bj = 0; bj < 2; ++bj)
#pragma unroll
            for (int n = 0; n < 2; ++n) { gv[bj][n] = *(const f32x4*)(gv_ + col0 + bj * HALF + n * 16); bv[bj][n] = bias ? *(const f32x4*)(bias + col0 + bj * HALF + n * 16) : (f32x4){0.f, 0.f, 0.f, 0.f}; }
        typedef typename RawOf<BASE16>::T raw_t;
        raw_t rb[2][8];
#define ERG_LOAD(b_, dst_) do { _Pragma("unroll") for (int mm = 0; mm < 2; ++mm) _Pragma("unroll") for (int bj = 0; bj < 2; ++bj) _Pragma("unroll") for (int n = 0; n < 2; ++n) { \
            const size_t o = (size_t)(row0 + ((b_) >> 1) * HALF + (2 * ((b_) & 1) + mm) * 16) * 1024 + col0 + bj * HALF + n * 16; \
            if constexpr (BASE16) dst_[mm * 4 + bj * 2 + n] = *(const raw_t*)((const bf16_t*)base + o); else dst_[mm * 4 + bj * 2 + n] = *(const raw_t*)((const float*)base + o); } } while (0)
        ERG_LOAD(0, rb[0]);
#pragma unroll
        for (int b = 0; b < 4; ++b) {
            if (b < 3) ERG_LOAD(b + 1, rb[(b + 1) & 1]);
            const int ai = b >> 1;
#pragma unroll
            for (int mm = 0; mm < 2; ++mm) { const int m = 2 * (b & 1) + mm;
#pragma unroll
                for (int bj = 0; bj < 2; ++bj)
#pragma unroll
                    for (int n = 0; n < 2; ++n) { const size_t o = (size_t)(row0 + ai * HALF + m * 16) * 1024 + col0 + bj * HALF + n * 16; f32x4 bs; const raw_t w = rb[b & 1][mm * 4 + bj * 2 + n];
                        if constexpr (BASE16) bs = (f32x4){__builtin_bit_cast(float, w[0] << 16), __builtin_bit_cast(float, w[0] & 0xffff0000u), __builtin_bit_cast(float, w[1] << 16), __builtin_bit_cast(float, w[1] & 0xffff0000u)};
                        else bs = __builtin_bit_cast(f32x4, w);
                        const f32x4 r = bs + gv[bj][n] * (acc[ai][bj][m][n] + bv[bj][n]);
                        if constexpr (OUT16) *(u32x2*)((bf16_t*)out + o) = (u32x2){cvt_pk_bf16(r[0], r[1]), cvt_pk_bf16(r[2], r[3])};
                        else *(f32x4*)((float*)out + o) = r; } }
        }
#undef ERG_LOAD
    }
};
template <int MODE, bool OUT8 = false, int OSCALE = 1, bool WT = false, bool LB = false> struct EpiPair {
    static constexpr bool PERM = true, AFTER_DRAIN = false, LDS_BIAS = LB;
    bf16_t* O; const float* bias0; const PG8_LAS float* lb;
    __device__ __forceinline__ void stage_bias(const Unit& u, int lane) const {
        const float* src = bias0 + (MODE == 0 ? (size_t)u.e * 2048 : 0) + (lane < 32 ? 0 : 1024 - 128) + u.pn * HALF + lane * 4;
        __builtin_amdgcn_global_load_lds((const unsigned*)src, (PG8_LAS unsigned*)lb, 16, 0, 0);
    }
    static __device__ __forceinline__ f32x4 vsig(f32x4 x, float negscale) {
        const f32x4 t = x * negscale; f32x4 e; e[0] = __builtin_amdgcn_exp2f(t[0]); e[1] = __builtin_amdgcn_exp2f(t[1]); e[2] = __builtin_amdgcn_exp2f(t[2]); e[3] = __builtin_amdgcn_exp2f(t[3]);
        const f32x4 d = e + 1.0f; f32x4 r; r[0] = __builtin_amdgcn_rcpf(d[0]); r[1] = __builtin_amdgcn_rcpf(d[1]); r[2] = __builtin_amdgcn_rcpf(d[2]); r[3] = __builtin_amdgcn_rcpf(d[3]); return r; }
    __device__ __forceinline__ void operator()(const f32x4 (&acc)[2][2][4][2], const Unit& u, int wr, int wc, int fr, int fq) const {
        const float* bias = bias0 + (MODE == 0 ? (size_t)u.e * 2048 : 0);
        const int row0 = u.pm * BM + wr * 64 + fr, cg = u.pn * HALF + wc * 32 + 8 * fq;
        f32x4 b0[2], b1[2];
#pragma unroll
        for (int n = 0; n < 2; ++n) {
            if constexpr (LB) { b0[n] = *(const PG8_LAS f32x4*)(lb + wc * 32 + 8 * fq + 4 * n); b1[n] = *(const PG8_LAS f32x4*)(lb + 128 + wc * 32 + 8 * fq + 4 * n); }
            else { b0[n] = *(const f32x4*)(bias + cg + 4 * n); b1[n] = *(const f32x4*)(bias + 1024 + cg + 4 * n); } }
#pragma unroll
        for (int ai = 0; ai < 2; ++ai)
#pragma unroll
            for (int m = 0; m < 4; ++m) { bf16_t* rowp = O + (size_t)(row0 + ai * HALF + m * 16) * 1024 + cg; f32x4 r[2];
#pragma unroll
                for (int n = 0; n < 2; ++n) { const f32x4 g = acc[ai][0][m][n] + b0[n], up = acc[ai][1][m][n] + b1[n];
                    if (MODE == 0) { const f32x4 gg = __builtin_elementwise_min(g, (f32x4){7.0f, 7.0f, 7.0f, 7.0f});
                        const f32x4 uu = __builtin_elementwise_min(__builtin_elementwise_max(up, (f32x4){-7.0f, -7.0f, -7.0f, -7.0f}), (f32x4){7.0f, 7.0f, 7.0f, 7.0f});
                        r[n] = (uu * (float)OSCALE + (float)OSCALE) * (gg * vsig(gg, -1.702f * 1.4426950408889634f)); }
                    else r[n] = (g * (float)OSCALE) * vsig(up, -1.4426950408889634f); }
                if constexpr (OUT8) {
                    int w0 = 0, w1 = 0;
                    w0 = __builtin_amdgcn_cvt_pk_fp8_f32(r[0][0], r[0][1], w0, false); w0 = __builtin_amdgcn_cvt_pk_fp8_f32(r[0][2], r[0][3], w0, true);
                    w1 = __builtin_amdgcn_cvt_pk_fp8_f32(r[1][0], r[1][1], w1, false); w1 = __builtin_amdgcn_cvt_pk_fp8_f32(r[1][2], r[1][3], w1, true);
                    if constexpr (WT) __hip_atomic_store((unsigned long long*)((unsigned char*)O + (size_t)(row0 + ai * HALF + m * 16) * 1024 + cg), ((unsigned long long)(unsigned)w1 << 32) | (unsigned)w0, __ATOMIC_RELAXED, __HIP_MEMORY_SCOPE_AGENT);
                    else *(u32x2*)((unsigned char*)O + (size_t)(row0 + ai * HALF + m * 16) * 1024 + cg) = (u32x2){(unsigned)w0, (unsigned)w1};
                } else {
                u32x4 w; w.x = cvt_pk_bf16(r[0][0], r[0][1]); w.y = cvt_pk_bf16(r[0][2], r[0][3]); w.z = cvt_pk_bf16(r[1][0], r[1][1]); w.w = cvt_pk_bf16(r[1][2], r[1][3]);
                *(u32x4*)rowp = w; } }
    }
};
template <bool OUT8, int OSCALE, bool LB = false> struct EpiMoeOut {
    static constexpr bool PERM = true, AFTER_DRAIN = false, LDS_BIAS = LB;
    bf16_t* O; const float* bias0; const PG8_LAS float* lb;
    __device__ __forceinline__ void stage_bias(const Unit& u, int lane) const {
        __builtin_amdgcn_global_load_lds((const unsigned*)(bias0 + (size_t)u.e * 1024 + u.pn * BM + lane * 4), (PG8_LAS unsigned*)lb, 16, 0, 0);
    }
    __device__ __forceinline__ void operator()(const f32x4 (&acc)[2][2][4][2], const Unit& u, int wr, int wc, int fr, int fq) const {
        const float* bias = bias0 + (size_t)u.e * 1024;
        const int row0 = u.pm * BM + wr * 64 + fr, col0 = u.pn * BM + wc * 32 + 8 * fq;
        f32x4 bv[2][2];
#pragma unroll
        for (int bj = 0; bj < 2; ++bj)
#pragma unroll
            for (int n = 0; n < 2; ++n) {
                if constexpr (LB) bv[bj][n] = *(const PG8_LAS f32x4*)(lb + wc * 32 + 8 * fq + bj * HALF + 4 * n);
                else bv[bj][n] = *(const f32x4*)(bias + col0 + bj * HALF + 4 * n); }
#pragma unroll
        for (int ai = 0; ai < 2; ++ai)
#pragma unroll
            for (int m = 0; m < 4; ++m) { const int r = row0 + ai * HALF + m * 16;
#pragma unroll
                for (int bj = 0; bj < 2; ++bj) { const f32x4 v0 = acc[ai][bj][m][0] + bv[bj][0], v1 = acc[ai][bj][m][1] + bv[bj][1];
                    if constexpr (OUT8) { const f32x4 lim = (f32x4){448.0f, 448.0f, 448.0f, 448.0f};
                        const f32x4 s0 = __builtin_elementwise_min(__builtin_elementwise_max(v0 * (float)OSCALE, -lim), lim), s1 = __builtin_elementwise_min(__builtin_elementwise_max(v1 * (float)OSCALE, -lim), lim); int w0 = 0, w1 = 0;
                        w0 = __builtin_amdgcn_cvt_pk_fp8_f32(s0[0], s0[1], w0, false); w0 = __builtin_amdgcn_cvt_pk_fp8_f32(s0[2], s0[3], w0, true);
                        w1 = __builtin_amdgcn_cvt_pk_fp8_f32(s1[0], s1[1], w1, false); w1 = __builtin_amdgcn_cvt_pk_fp8_f32(s1[2], s1[3], w1, true);
                        *(u32x2*)((unsigned char*)O + (size_t)r * 1024 + col0 + bj * HALF) = (u32x2){(unsigned)w0, (unsigned)w1};
                    } else { u32x4 w; w.x = cvt_pk_bf16(v0[0], v0[1]); w.y = cvt_pk_bf16(v0[2], v0[3]); w.z = cvt_pk_bf16(v1[0], v1[1]); w.w = cvt_pk_bf16(v1[2], v1[3]);
                        *(u32x4*)(O + (size_t)r * 1024 + col0 + bj * HALF) = w; } } }
    }
};

template <class Epi, class Sched, bool ALIGN_EPI = false, bool SP2 = false, bool F8 = false, int SCW = 0x7F7F7F7F, int SCA = 0x7F7F7F7F, bool GATHER = false, int NS = 0, bool ZC = F8>
__device__ __forceinline__ void gemm_phase(PG8_LAS unsigned char* lds, const Gemm g, const Sched& S, const Epi& E) {
    const int tid = threadIdx.x, wid = __builtin_amdgcn_readfirstlane(tid >> 6), lane = tid & 63, wr = wid >> 2, wc = wid & 3, fr = lane & 15, fq = lane >> 4;
    const int K = g.K, nt = K / BK;
    unsigned voffA[2], voffB[2]; int stR[2], stC[2];
#pragma unroll
    for (int i = 0; i < 2; ++i) { int R, C; stage_rc(tid * 16 + i * 8192, R, C); const int Rb = Epi::PERM ? ((R & ~31) + perm32(R & 31)) : R; stR[i] = R; stC[i] = C;
        voffA[i] = (unsigned)(R * K + C) * 2u; voffB[i] = (unsigned)(Rb * K + C) * 2u; }
    const size_t kstep = (size_t)(BK * 2);
    const size_t hstep = (size_t)HALF * K * 2;
    const size_t tstep = 2 * hstep;
    unsigned vc[2][2], vn[2][2];
#pragma unroll
    for (int h = 0; h < 2; ++h)
#pragma unroll
        for (int i = 0; i < 2; ++i) {
            if constexpr (GATHER) vc[h][i] = (unsigned)g.tt[h * HALF + stR[i]] * (unsigned)(K * 2) + (unsigned)stC[i] * 2u;
            else vc[h][i] = voffA[i] + (unsigned)h * (unsigned)hstep;
            vn[h][i] = vc[h][i]; }
    const unsigned ldsw = (unsigned)wid * 1024u;
    const int aoff = lds_byte(wr * 64 + fr, fq * 8), boff = lds_byte(wc * 32 + fr, fq * 8);
#define PG8_SA(b, h) (((b) * 2 + (h)) * HTB)
#define PG8_SB(b, h) ((4 + (b) * 2 + (h)) * HTB)
#define PG8_STAGE(bufoff, gbase, voff) do { _Pragma("unroll") for (int _i = 0; _i < 2; ++_i) \
        __builtin_amdgcn_global_load_lds((const unsigned*)((const char*)(gbase) + (voff)[_i]), (PG8_LAS unsigned*)(lds + (bufoff) + ldsw + _i * 8192), 16, 0, 0); } while (0)
#define PG8_LDA(dst, b, h) do { _Pragma("unroll") for (int m = 0; m < 4; ++m) _Pragma("unroll") for (int k = 0; k < 2; ++k) dst[m][k] = *(const PG8_LAS bf16x8*)(lds + PG8_SA(b, h) + aoff + m * 2048 + k * 1024); } while (0)
#define PG8_LDB(dst, b, h) do { _Pragma("unroll") for (int n = 0; n < 2; ++n) _Pragma("unroll") for (int k = 0; k < 2; ++k) dst[n][k] = *(const PG8_LAS bf16x8*)(lds + PG8_SB(b, h) + boff + n * 2048 + k * 1024); } while (0)
#define PG8_MMA(ai, bj, At, Bt) do { __builtin_amdgcn_s_setprio(1); \
        if constexpr (!F8) { _Pragma("unroll") for (int m = 0; m < 4; ++m) _Pragma("unroll") for (int n = 0; n < 2; ++n) _Pragma("unroll") for (int k = 0; k < 2; ++k) \
            acc[ai][bj][m][n] = __builtin_amdgcn_mfma_f32_16x16x32_bf16(Bt[n][k], At[m][k], acc[ai][bj][m][n], 0, 0, 0); } \
        else { const int scw_ = SCW, sca_ = SCA; _Pragma("unroll") for (int m = 0; m < 4; ++m) _Pragma("unroll") for (int n = 0; n < 2; ++n) { \
            const i32x8 wf_ = __builtin_shufflevector(__builtin_bit_cast(i32x4, Bt[n][0]), __builtin_bit_cast(i32x4, Bt[n][1]), 0, 1, 2, 3, 4, 5, 6, 7); \
            const i32x8 af_ = __builtin_shufflevector(__builtin_bit_cast(i32x4, At[m][0]), __builtin_bit_cast(i32x4, At[m][1]), 0, 1, 2, 3, 4, 5, 6, 7); \
            asm volatile("v_mfma_scale_f32_16x16x128_f8f6f4 %0, %1, %2, %0, %3, %4 op_sel_hi:[0,0,0]" : "+v"(acc[ai][bj][m][n]) : "v"(wf_), "v"(af_), "v"(scw_), "v"(sca_)); } } \
        __builtin_amdgcn_s_setprio(0); } while (0)
#define PG8_MMAZ(ai, bj, At, Bt) do { __builtin_amdgcn_s_setprio(1); \
        if constexpr (!F8) { _Pragma("unroll") for (int m = 0; m < 4; ++m) _Pragma("unroll") for (int n = 0; n < 2; ++n) { \
            acc[ai][bj][m][n] = __builtin_amdgcn_mfma_f32_16x16x32_bf16(Bt[n][0], At[m][0], (f32x4){0.f, 0.f, 0.f, 0.f}, 0, 0, 0); \
            acc[ai][bj][m][n] = __builtin_amdgcn_mfma_f32_16x16x32_bf16(Bt[n][1], At[m][1], acc[ai][bj][m][n], 0, 0, 0); } } \
        else { const int scw_ = SCW, sca_ = SCA; _Pragma("unroll") for (int m = 0; m < 4; ++m) _Pragma("unroll") for (int n = 0; n < 2; ++n) { \
            const i32x8 wf_ = __builtin_shufflevector(__builtin_bit_cast(i32x4, Bt[n][0]), __builtin_bit_cast(i32x4, Bt[n][1]), 0, 1, 2, 3, 4, 5, 6, 7); \
            const i32x8 af_ = __builtin_shufflevector(__builtin_bit_cast(i32x4, At[m][0]), __builtin_bit_cast(i32x4, At[m][1]), 0, 1, 2, 3, 4, 5, 6, 7); \
            asm volatile("v_mfma_scale_f32_16x16x128_f8f6f4 %0, %1, %2, 0, %3, %4 op_sel_hi:[0,0,0]" : "=&v"(acc[ai][bj][m][n]) : "v"(wf_), "v"(af_), "v"(scw_), "v"(sca_)); } } \
        __builtin_amdgcn_s_setprio(0); } while (0)
#define PG8_WAIT_V(n) asm volatile("s_waitcnt vmcnt(" #n ")" ::: "memory")
#define PG8_WAIT_VN(n) asm volatile("s_waitcnt vmcnt(%0)" :: "n"(n) : "memory")
#define PG8_WAIT_L(n) asm volatile("s_waitcnt lgkmcnt(" #n ")" ::: "memory")
#define PG8_BAR __builtin_amdgcn_s_barrier()
#define PG8_SCHED __builtin_amdgcn_sched_barrier(0)
    Unit cur, nxt; int ui = 0, ppm = 0;
    if (!S.next(0, cur)) return;
#if KL_PROBE
    if (Sched::PUBLISH && S.probe_on() && blockIdx.x == 0 && wid == 0) { const unsigned long long t0_ = __builtin_amdgcn_s_memtime(); if (lane == 0) { PG8_LAS unsigned* kp = (PG8_LAS unsigned*)(unsigned)KLP_LDS; kp[6] = (unsigned)t0_; kp[7] = (unsigned)(t0_ >> 32); } }
#endif
    static_assert(SP2, "this build keeps only the SP2 K-loop");
    f32x4 acc[2][2][4][2];
    if constexpr (!ZC) {
#pragma unroll
    for (int a = 0; a < 2; ++a)
#pragma unroll
        for (int b = 0; b < 2; ++b)
#pragma unroll
            for (int m = 0; m < 4; ++m)
#pragma unroll
                for (int n = 0; n < 2; ++n) acc[a][b][m][n] = (f32x4){0.f, 0.f, 0.f, 0.f};
    }
    bf16x8 At[4][2], B0[2][2], B1[2][2];
    const char* cA = (const char*)g.A + (GATHER ? (size_t)0 : (size_t)cur.pm * tstep); const char* cB = (const char*)g.Bt + (size_t)cur.e * g.estride + (size_t)cur.pn * tstep;
    S.a_ready(cur, 0);
    if constexpr (SP2) {
        PG8_STAGE(PG8_SB(0, 0), cB, voffB); PG8_STAGE(PG8_SB(0, 1), cB + hstep, voffB); PG8_STAGE(PG8_SA(0, 0), cA, vc[0]); PG8_STAGE(PG8_SA(0, 1), cA, vc[1]);
        if (wr == 1) PG8_BAR;
        PG8_WAIT_V(2); PG8_BAR;
        PG8_STAGE(PG8_SB(1, 0), cB + kstep, voffB); PG8_STAGE(PG8_SA(1, 0), cA + kstep, vc[0]); PG8_STAGE(PG8_SB(1, 1), cB + hstep + kstep, voffB);
        PG8_WAIT_V(6); PG8_BAR;
    } else {
        PG8_STAGE(PG8_SB(0, 0), cB, voffB); PG8_STAGE(PG8_SA(0, 0), cA, vc[0]); PG8_STAGE(PG8_SB(0, 1), cB + hstep, voffB); PG8_STAGE(PG8_SA(0, 1), cA, vc[1]);
        if (wr == 1) PG8_BAR;
        PG8_WAIT_V(4); PG8_BAR;
        PG8_STAGE(PG8_SB(1, 0), cB + kstep, voffB); PG8_STAGE(PG8_SA(1, 0), cA + kstep, vc[0]); PG8_STAGE(PG8_SB(1, 1), cB + hstep + kstep, voffB);
        PG8_WAIT_V(6); PG8_BAR;
    }
    for (;;) {
        const bool has_next = S.next(ui + 1, nxt);
        if constexpr (GATHER) { if (has_next) {
#pragma unroll
            for (int h = 0; h < 2; ++h)
#pragma unroll
                for (int i = 0; i < 2; ++i) vn[h][i] = (unsigned)g.tt[(ui + 1) * BM + h * HALF + stR[i]] * (unsigned)(K * 2) + (unsigned)stC[i] * 2u; } }
        const char* nA = (has_next && !GATHER) ? (const char*)g.A + (size_t)nxt.pm * tstep : cA; const char* nB = has_next ? (const char*)g.Bt + (size_t)nxt.e * g.estride + (size_t)nxt.pn * tstep : cB;
#if KL_PROBE
        if (Sched::PUBLISH && S.probe_on() && blockIdx.x == 0 && wid == 0) { const unsigned long long t0_ = __builtin_amdgcn_s_memtime(); if (lane == 0) { PG8_LAS unsigned* kp = (PG8_LAS unsigned*)(unsigned)KLP_LDS; kp[4] = (unsigned)t0_; kp[5] = (unsigned)(t0_ >> 32); } }
#endif
#define PG8_WAIT_V8R do { if constexpr (NS > 0) { PG8_WAIT_VN(8 + NS); if (!rlx) PG8_WAIT_V(8); } else PG8_WAIT_V(8); } while (0)
#define PG8_TRIP(MMAK_, FIRST_) { \
            const bool last = (t == nt - 2); \
            unsigned vs[2][2]; \
            _Pragma("unroll") for (int h = 0; h < 2; ++h) _Pragma("unroll") for (int i = 0; i < 2; ++i) vs[h][i] = (GATHER && last) ? vn[h][i] : vc[h][i]; \
            const char* a1 = cA + (size_t)(t + 1) * kstep;                                             \
            const char* a2 = last ? nA : cA + (size_t)(t + 2) * kstep; const char* b2 = last ? nB : cB + (size_t)(t + 2) * kstep;     \
            const char* a3 = a2 + kstep; const char* b3 = b2 + kstep;                                \
            if (last && has_next) S.a_ready(nxt, ui + 1); \
            if constexpr (Epi::LDS_BIAS) { if (last && wid == 0) E.stage_bias(cur, lane); }     \
            if constexpr (Sched::PUBLISH) { if (t == 2 && ui > 0) S.publish(ppm, lane); }     \
            const bool rlx = (NS > 0) && (FIRST_) && (ui > 0); \
              \
            PG8_LDB(B0, 0, 0); PG8_LDB(B1, 0, 1); PG8_SCHED; PG8_LDA(At, 0, 0); if (!rlx) PG8_STAGE(PG8_SA(1, 1), a1, vc[1]); \
            PG8_WAIT_V8R; PG8_WAIT_L(0); PG8_BAR; MMAK_(0, 0, At, B0); MMAK_(0, 1, At, B1); PG8_BAR; PG8_SCHED; \
              \
            PG8_LDA(At, 0, 1); PG8_STAGE(PG8_SB(0, 0), b2, voffB); PG8_STAGE(PG8_SB(0, 1), b2 + hstep, voffB); PG8_STAGE(PG8_SA(0, 0), a2, vs[0]); \
            PG8_WAIT_V8R; PG8_WAIT_L(0); PG8_BAR; MMAK_(1, 0, At, B0); MMAK_(1, 1, At, B1); PG8_BAR; PG8_SCHED; \
              \
            PG8_LDB(B0, 1, 0); PG8_LDB(B1, 1, 1); PG8_SCHED; PG8_LDA(At, 1, 0); PG8_STAGE(PG8_SA(0, 1), a2, vs[1]); \
            PG8_WAIT_V8R; PG8_WAIT_L(0); PG8_BAR; PG8_MMA(0, 0, At, B0); PG8_MMA(0, 1, At, B1); PG8_BAR; PG8_SCHED; \
              \
            PG8_LDA(At, 1, 1); PG8_STAGE(PG8_SB(1, 0), b3, voffB); PG8_STAGE(PG8_SB(1, 1), b3 + hstep, voffB); PG8_STAGE(PG8_SA(1, 0), a3, vs[0]); \
            PG8_WAIT_V(8); PG8_WAIT_L(0); PG8_BAR; PG8_MMA(1, 0, At, B0); PG8_MMA(1, 1, At, B1); PG8_BAR; PG8_SCHED; }
        if constexpr (ZC) {
            { const int t = 0; PG8_TRIP(PG8_MMAZ, true) }
            for (int t = 2; t < nt; t += 2) PG8_TRIP(PG8_MMA, false)
        } else {
            for (int t = 0; t < nt; t += 2) PG8_TRIP(PG8_MMA, t == 0)
        }
#if KL_PROBE
        if (Sched::PUBLISH && S.probe_on() && blockIdx.x == 0 && wid == 0) { const unsigned long long t1_ = __builtin_amdgcn_s_memtime(); if (lane == 0) { PG8_LAS unsigned* kp = (PG8_LAS unsigned*)(unsigned)KLP_LDS; const unsigned long long d = t1_ - (((unsigned long long)kp[5] << 32) | kp[4]); const unsigned long long acc_ = (((unsigned long long)kp[1] << 32) | kp[0]) + d; kp[0] = (unsigned)acc_; kp[1] = (unsigned)(acc_ >> 32); kp[2] += 1u; } }
#endif
        if constexpr (ALIGN_EPI) { if (wr == 0) PG8_BAR; }
        if constexpr (NS > 0) { static_assert(SP2 && ALIGN_EPI, "NS needs SP2 and ALIGN_EPI"); if (has_next) PG8_STAGE(PG8_SA(1, 1), nA + kstep, vn[1]); }
        if constexpr (!Epi::AFTER_DRAIN) { E(acc, cur, wr, wc, fr, fq); S.done(cur); ppm = cur.pm; }
        if (!has_next) break;
        if constexpr (!ZC) {
#pragma unroll
        for (int a = 0; a < 2; ++a)
#pragma unroll
            for (int b = 0; b < 2; ++b)
#pragma unroll
                for (int m = 0; m < 4; ++m)
#pragma unroll
                    for (int n = 0; n < 2; ++n) acc[a][b][m][n] = (f32x4){0.f, 0.f, 0.f, 0.f};
        }
        cur = nxt; cA = nA; cB = nB; ++ui;
        if constexpr (GATHER) {
#pragma unroll
            for (int h = 0; h < 2; ++h)
#pragma unroll
                for (int i = 0; i < 2; ++i) vc[h][i] = vn[h][i]; }
        if constexpr (ALIGN_EPI) { if (wr == 1) PG8_BAR; }
    }
#if KL_PROBE
    if (Sched::PUBLISH && S.probe_on() && blockIdx.x == 0 && wid == 0) { const unsigned long long t1_ = __builtin_amdgcn_s_memtime(); if (lane == 0) { PG8_LAS unsigned* kp = (PG8_LAS unsigned*)(unsigned)KLP_LDS; const unsigned long long d = t1_ - (((unsigned long long)kp[7] << 32) | kp[6]); const unsigned long long acc_ = (((unsigned long long)kp[9] << 32) | kp[8]) + d; kp[8] = (unsigned)acc_; kp[9] = (unsigned)(acc_ >> 32); } }
#endif
    PG8_WAIT_V(0); if constexpr (Sched::PUBLISH) S.publish(ppm, lane);
    if constexpr (!ALIGN_EPI) { if (wr == 0) PG8_BAR; }
    PG8_BAR;
    if constexpr (Epi::AFTER_DRAIN) { E.fused(acc, cur, wr, wc, fr, fq, lds, wid, lane); S.done(cur); }
#undef PG8_SA
#undef PG8_SB
#undef PG8_STAGE
#undef PG8_LDA
#undef PG8_LDB
#undef PG8_MMA
#undef PG8_MMAZ
#undef PG8_TRIP
#undef PG8_WAIT_V
#undef PG8_WAIT_VN
#undef PG8_WAIT_V8R
#undef PG8_WAIT_L
#undef PG8_BAR
#undef PG8_SCHED
}
}


constexpr int D = 1024, NBATCH = 2, SEQ = 16384, NTOK = NBATCH * SEQ, CTXL = 256, NCTX = NBATCH * CTXL, MROWS = NTOK + NCTX;
constexpr int NHEAD = 8, DK = 128, NE = 32, TOPK = 4, CONVW = 31, GRIDW = 64, GRIDR = SEQ / GRIDW;
constexpr int NWAVES = 8, NTHR = NWAVES * 64;
constexpr int MAXTILES = 544;
constexpr float EPS = 1e-6f;
enum { I_X = 0, I_C, I_CTX, I_CCTX, I_WADA, I_BADA, I_GMIX, I_GFFN, I_WHIN, I_HGAMMA, I_GHOUT, I_WHOUT, I_WCVIN, I_BCVIN, I_WCVDW, I_BCVDW, I_GCVLN, I_BCVLN, I_WCVOUT, I_BCVOUT,
       I_WR, I_BR, I_WE1, I_BE1, I_WE2, I_BE2, I_GFINAL, N_IN };

constexpr size_t MiB = 1u << 20;
constexpr size_t WS_CTL = 0, CTL_ZERO_BYTES = 1 * MiB;
constexpr size_t WS_MODS = 1 * MiB;
constexpr size_t WS_TOPE = 2 * MiB, WS_TOPW = 2 * MiB + 512 * 1024, WS_POS = 3 * MiB, WS_BCNT = 3 * MiB + 512 * 1024, WS_TILEE = WS_BCNT + 64 * 1024, WS_SLOTW = 4 * MiB;
constexpr size_t WS_SP = 5 * MiB, WS_SD = 8 * MiB;
constexpr size_t WS_WIN = 48 * MiB, WS_WOUT = 58 * MiB, WS_WCVIN = 60 * MiB, WS_WCVOUT = 64 * MiB, WS_W1 = 66 * MiB, WS_W2 = 322 * MiB;
constexpr size_t WS_X = 450 * MiB;
constexpr size_t WS_H = 578 * MiB;
constexpr size_t WS_Q = 644 * MiB, WS_V = 709 * MiB, WS_SG = 774 * MiB, WS_LFF = 839 * MiB, WS_LFB = 969 * MiB, WS_OF = 1099 * MiB, WS_OB = 1227 * MiB, WS_YIN = 1355 * MiB;
constexpr size_t WS_AS = 1419 * MiB, WS_ACT = 1555 * MiB, WS_YS = 1691 * MiB, WS_END = 1963 * MiB;
#ifndef F8_IN
#define F8_IN 0
#endif
#ifndef SPLIT_IN
#define SPLIT_IN 1
#endif
#ifndef TL_PROBE
#define TL_PROBE 0
#define TL_A (-1)
#define TL_B 0
#define TL_BODY 0
#endif
#ifndef CVF_PROBE
#define CVF_PROBE 0
#endif
#ifndef G_F8
#define G_F8 1
#endif
#ifndef F8_Y
#define F8_Y 1
#endif
constexpr int YSCALE = 16;
#ifndef F8_MISC
#define F8_MISC 1
#endif
constexpr size_t WS_H8 = WS_OF + 64 * MiB;
constexpr size_t WS_WIN8 = WS_WIN + 6 * MiB;
constexpr size_t WS_STOK = WS_AS;
constexpr int CW_MODF = 3200;
constexpr int CW_FLAT = 3072;
constexpr int CW_GCNT = 2048;
constexpr float W8SCALE = 64.0f;
constexpr size_t WS_U = WS_Q, WS_ZP = WS_V, WS_Z = WS_SG;
constexpr int CW_BAR = 4096;
constexpr int CW_XMAP = 32768;
constexpr int CW_TCNT = 65536;

constexpr int RING_OFF = 0, RING_BYTES = 131072;
constexpr int LDSCTL_OFF = 139264, MISC_OFF = LDSCTL_OFF + 320, EXTRA_OFF = LDSCTL_OFF + 1024;
constexpr int LDS_BYTES = 155648;

#define LAS __attribute__((address_space(3)))
typedef unsigned short bf16;
typedef unsigned v4u __attribute__((ext_vector_type(4)));
typedef unsigned v2u __attribute__((ext_vector_type(2)));
typedef float f32x4 __attribute__((ext_vector_type(4)));
typedef int v4i __attribute__((ext_vector_type(4)));
#define LDS_WAIT() asm volatile("s_waitcnt lgkmcnt(0)" ::: "memory")
#define VM_WAIT() asm volatile("s_waitcnt vmcnt(0)" ::: "memory")
__device__ __forceinline__ unsigned f2bf(float f) { unsigned u = __builtin_bit_cast(unsigned, f); return (u + 0x7fffu + ((u >> 16) & 1u)) >> 16; }
__device__ __forceinline__ unsigned pk2(float lo, float hi) { return f2bf(lo) | (f2bf(hi) << 16); }
__device__ __forceinline__ float bf_lo(unsigned u) { return __builtin_bit_cast(float, u << 16); }
__device__ __forceinline__ float bf_hi(unsigned u) { return __builtin_bit_cast(float, u & 0xffff0000u); }
__device__ __forceinline__ float bf2f(bf16 h) { return __builtin_bit_cast(float, ((unsigned)h) << 16); }
__device__ __forceinline__ float fsig(float x) { return __builtin_amdgcn_rcpf(1.0f + __expf(-x)); }
__device__ __forceinline__ float wave_sum(float v) {
#define WS_DPP(x, ctrl) __builtin_bit_cast(float, __builtin_amdgcn_update_dpp(0, __builtin_bit_cast(int, x), ctrl, 0xF, 0xF, true))
    v += WS_DPP(v, 0xB1);
    v += WS_DPP(v, 0x4E);
    v += WS_DPP(v, 0x141);
    v += WS_DPP(v, 0x140);
#undef WS_DPP
    const int vi = __builtin_bit_cast(int, v);
    return (__builtin_bit_cast(float, __builtin_amdgcn_readlane(vi, 0)) + __builtin_bit_cast(float, __builtin_amdgcn_readlane(vi, 16)))
         + (__builtin_bit_cast(float, __builtin_amdgcn_readlane(vi, 32)) + __builtin_bit_cast(float, __builtin_amdgcn_readlane(vi, 48)));
}

__device__ __forceinline__ float half_sum(float v) {
#define WS_DPP(x, ctrl) __builtin_bit_cast(float, __builtin_amdgcn_update_dpp(0, __builtin_bit_cast(int, x), ctrl, 0xF, 0xF, true))
    v += WS_DPP(v, 0xB1); v += WS_DPP(v, 0x4E); v += WS_DPP(v, 0x141); v += WS_DPP(v, 0x140);
#undef WS_DPP
    return v + __shfl_xor(v, 16);
}
__device__ __forceinline__ float sat8(float x) { return __builtin_amdgcn_fmed3f(x, -448.0f, 448.0f); }
__device__ __forceinline__ unsigned pk4_fp8(float a, float b, float c, float d) { int w = 0; w = __builtin_amdgcn_cvt_pk_fp8_f32(sat8(a), sat8(b), w, false); w = __builtin_amdgcn_cvt_pk_fp8_f32(sat8(c), sat8(d), w, true); return (unsigned)w; }
template <bool OUT8> __device__ __forceinline__ void store_row4(void* orow, int lane, int j, f32x4 y, float scale) {
    if constexpr (OUT8) ((unsigned*)orow)[lane + 64 * j] = pk4_fp8(y.x * scale, y.y * scale, y.z * scale, y.w * scale);
    else { v2u w; w.x = pk2(y.x, y.y); w.y = pk2(y.z, y.w); ((v2u*)orow)[lane + 64 * j] = w; }
}

#define XB_TMO      128
#define XB_XCNT(j)  (256  + 64 * (j))
#define XB_XSUB(j)  (1280 + 64 * (j))
#define XB_XGEN(j)  (2304 + 64 * (j))
#define XB_TOP      3328
#define XB_TOPGEN   3392
#define XCD_BAR_WORDS 3456
#define XB_SPIN_CAP (1u << 18)

__device__ __forceinline__ unsigned xb_ld(unsigned* p)              { return __hip_atomic_load(p, __ATOMIC_RELAXED, __HIP_MEMORY_SCOPE_AGENT); }
__device__ __forceinline__ unsigned xb_add(unsigned* p, unsigned v) { return __hip_atomic_fetch_add(p, v, __ATOMIC_RELAXED, __HIP_MEMORY_SCOPE_AGENT); }
__device__ __forceinline__ unsigned xb_xcc_id() { return (unsigned)__builtin_amdgcn_s_getreg((3 << 11) | 20) & 0xFu; }
#define XB_SPIN(cond, bar) do { unsigned _sp = 0; while (cond) { __builtin_amdgcn_s_sleep(1); \
    if ((++_sp & 255u) == 0u) { if (xb_ld(&(bar)[XB_TMO])) break; if (_sp > XB_SPIN_CAP) { atomicAdd(&(bar)[XB_TMO], 1u); break; } } } } while (0)

struct XcdBarrier {
    unsigned* bar; unsigned x;
    volatile LAS unsigned* st;
};

__device__ __forceinline__ XcdBarrier xcd_barrier_post(unsigned* bar, volatile LAS unsigned* st) {
    XcdBarrier b; b.bar = bar; b.x = xb_xcc_id(); b.st = st;
    if (threadIdx.x == 0) (void)xb_add(&bar[XB_XCNT(b.x)], 1u);
    return b;
}
__device__ __forceinline__ void xcd_barrier_complete(unsigned* bar, unsigned x, unsigned& nloc, unsigned& nx) {
    const unsigned G = gridDim.x * gridDim.y * gridDim.z;
    unsigned sum, cnt, mine, sp = 0u;
    for (;;) {
        sum = 0u; cnt = 0u; mine = 0u;
#pragma unroll
        for (unsigned j = 0; j < 16; ++j) { const unsigned c = xb_ld(&bar[XB_XCNT(j)]); sum += c; cnt += (c > 0u) ? 1u : 0u; mine = (j == x) ? c : mine; }
        if (sum == G) break;
        __builtin_amdgcn_s_sleep(1);
        if ((++sp & 255u) == 0u) { if (xb_ld(&bar[XB_TMO])) break; if (sp > XB_SPIN_CAP) { atomicAdd(&bar[XB_TMO], 1u); break; } }
    }
    nloc = mine > 0u ? mine : 1u; nx = cnt > 0u ? cnt : 1u;
}

__device__ __forceinline__ void xcd_barrier(const XcdBarrier& b) {
    asm volatile("s_waitcnt vmcnt(0)" ::: "memory");
    __syncthreads();
    if (threadIdx.x == 0) {
        unsigned* bar = b.bar;
        __builtin_amdgcn_s_waitcnt(0);
        unsigned nloc = b.st[0], nx = b.st[1];
        if (nloc == 0u) { xcd_barrier_complete(bar, b.x, nloc, nx); b.st[0] = nloc; b.st[1] = nx; }
        const unsigned old = xb_add(&bar[XB_XSUB(b.x)], 1u);
        const unsigned gen = old / nloc;
        if (old + 1u == (gen + 1u) * nloc) {
            __builtin_amdgcn_fence(__ATOMIC_RELEASE, "agent");
            asm volatile("s_waitcnt vmcnt(0)" ::: "memory");
            const unsigned og = xb_add(&bar[XB_TOP], 1u);
            const unsigned tg = og / nx;
            if (og + 1u == (tg + 1u) * nx) xb_add(&bar[XB_TOPGEN], 1u);
            else XB_SPIN(xb_ld(&bar[XB_TOPGEN]) == tg, bar);
            __builtin_amdgcn_fence(__ATOMIC_ACQUIRE, "agent");
            xb_add(&bar[XB_XGEN(b.x)], 1u);
            asm volatile("s_waitcnt vmcnt(0)" ::: "memory");
        } else {
            XB_SPIN(xb_ld(&bar[XB_XGEN(b.x)]) == gen, bar);
            __builtin_amdgcn_fence(__ATOMIC_ACQUIRE, "agent");
            asm volatile("s_waitcnt vmcnt(0)" ::: "memory");
        }
    }
    __syncthreads();
}

struct Args { const float* in[N_IN]; float* out; unsigned char* ws; int ph_lo, ph_hi, li, pad; };

__device__ __forceinline__ void p_mods(const Args& a, LAS unsigned char* lds, int tid, int lane, int wave) {
    LAS float* sc = (LAS float*)lds;
    LAS float* part = sc + 3 * D;
    float* MODS = (float*)(a.ws + WS_MODS);
    for (int i = tid; i < 3 * D; i += NTHR) { const int r = i >> 10, k = i & 1023; const float v = r < 2 ? a.in[I_C][r * D + k] : a.in[I_CCTX][k]; sc[i] = v * fsig(v); }
    __syncthreads();
    for (int item = blockIdx.x; item < 2 * 96; item += gridDim.x) {
        const int l = item / 96, cb = item % 96;
        const float* W = a.in[I_WADA] + (size_t)l * D * 6 * D + cb * 64 + lane;
        float a0 = 0.f, a1 = 0.f, a2 = 0.f;
#pragma unroll 16
        for (int kk = 0; kk < 128; ++kk) { const int k = wave * 128 + kk; const float w = W[(size_t)k * (6 * D)]; a0 += sc[k] * w; a1 += sc[D + k] * w; a2 += sc[2 * D + k] * w; }
        part[(wave * 3 + 0) * 64 + lane] = a0; part[(wave * 3 + 1) * 64 + lane] = a1; part[(wave * 3 + 2) * 64 + lane] = a2;
        __syncthreads();
        if (tid < 192) { const int r = tid >> 6, ln = tid & 63; float s = 0.f;
#pragma unroll
            for (int w = 0; w < 8; ++w) s += part[(w * 3 + r) * 64 + ln];
            __hip_atomic_store(&MODS[(size_t)(l * 3 + r) * (6 * D) + cb * 64 + ln], s + a.in[I_BADA][l * 6 * D + cb * 64 + ln], __ATOMIC_RELAXED, __HIP_MEMORY_SCOPE_AGENT); }
        asm volatile("s_waitcnt vmcnt(0)" ::: "memory");
        __syncthreads();
        if (item < 32 && tid == 0) (void)__hip_atomic_fetch_add((unsigned*)(a.ws + WS_CTL) + CW_MODF, 1u, __ATOMIC_RELAXED, __HIP_MEMORY_SCOPE_AGENT);
    }
}
__device__ __forceinline__ void wait_mods0(const Args& a, int tid) {
    if (tid == 0) { unsigned* f = (unsigned*)(a.ws + WS_CTL) + CW_MODF; unsigned sp = 0;
        while (__hip_atomic_load(f, __ATOMIC_RELAXED, __HIP_MEMORY_SCOPE_AGENT) < 32u) { __builtin_amdgcn_s_sleep(2); if (++sp > (1u << 22)) break; }
        __builtin_amdgcn_fence(__ATOMIC_ACQUIRE, "agent");
        asm volatile("s_waitcnt vmcnt(0)" ::: "memory"); }
    __syncthreads();
}
template <bool OUT8> __device__ __forceinline__ void transpose_item(const float* W, int K, int N, bf16* WT, bool paired, LAS float* scr, int item, int lane, int row_adj = 0) {
    const int nblk = N / 32, kb = item / nblk, nb = item % nblk, k0 = 64 * kb, n0 = 32 * nb;
    int d0 = n0 + row_adj; if (paired) { const int half = n0 >> 10, c = n0 & 1023; d0 = (c >> 7) * 256 + half * 128 + (c & 127); }
    float t[32];
#pragma unroll
    for (int i = 0; i < 32; ++i) { const int kk = 2 * i + (lane >> 5); t[i] = __builtin_nontemporal_load(&W[(size_t)(k0 + kk) * N + n0 + (lane & 31)]); }
#pragma unroll
    for (int i = 0; i < 32; ++i) { const int kk = 2 * i + (lane >> 5); scr[kk * 33 + (lane & 31)] = t[i]; }
    LDS_WAIT(); asm volatile("" ::: "memory");
    const int c = lane & 7;
#pragma unroll
    for (int j = 0; j < 4; ++j) { const int n = (lane >> 3) + 8 * j; const LAS float* s = scr + (8 * c) * 33 + n;
        if constexpr (OUT8) {
            int w0 = 0, w1 = 0;
            w0 = __builtin_amdgcn_cvt_pk_fp8_f32(s[0 * 33] * W8SCALE, s[1 * 33] * W8SCALE, w0, false); w0 = __builtin_amdgcn_cvt_pk_fp8_f32(s[2 * 33] * W8SCALE, s[3 * 33] * W8SCALE, w0, true);
            w1 = __builtin_amdgcn_cvt_pk_fp8_f32(s[4 * 33] * W8SCALE, s[5 * 33] * W8SCALE, w1, false); w1 = __builtin_amdgcn_cvt_pk_fp8_f32(s[6 * 33] * W8SCALE, s[7 * 33] * W8SCALE, w1, true);
            *(v2u*)((unsigned char*)WT + (size_t)(d0 + n) * K + k0 + 8 * c) = (v2u){(unsigned)w0, (unsigned)w1};
        } else {
        v4u o; o.x = pk2(s[0 * 33], s[1 * 33]); o.y = pk2(s[2 * 33], s[3 * 33]); o.z = pk2(s[4 * 33], s[5 * 33]); o.w = pk2(s[6 * 33], s[7 * 33]);
        *(v4u*)(WT + (size_t)(d0 + n) * K + k0 + 8 * c) = o; } }
    LDS_WAIT(); asm volatile("" ::: "memory");
}
__device__ __forceinline__ void p_weights(const Args& a, LAS unsigned char* lds, int lane, int wave) {
    LAS float* scr = (LAS float*)(lds + RING_OFF + wave * 16384);
    const int gw = blockIdx.x * NWAVES + wave, NGW = gridDim.x * NWAVES;
    constexpr int I_IN = 16 * 160, I_SQ = 16 * 32, I_CV = 16 * 64, I_E1 = 64 * 1024, I_E2 = 64 * 512;
    constexpr int NITEMS = I_IN + I_SQ + I_CV + I_SQ + I_E1 + I_E2;
    unsigned char* ws = a.ws;
    for (int it = (gridDim.x == 256 ? I_E1 + I_E2 : 0) + gw; it < NITEMS; it += NGW) {
        int r = it;
        if (r < I_E1) { const int mi = r >> 10; transpose_item<true>(a.in[I_WE1] + (size_t)mi * D * 2 * D, D, 2 * D, (bf16*)(ws + WS_W1 + (size_t)mi * 2 * D * D), true, scr, r & 1023, lane); continue; } r -= I_E1;
        if (r < I_E2) { const int mi = r >> 9; transpose_item<true>(a.in[I_WE2] + (size_t)mi * D * D, D, D, (bf16*)(ws + WS_W2 + (size_t)mi * D * D), false, scr, r & 511, lane); continue; } r -= I_E2;
        if (r < I_IN) {
            if (SPLIT_IN) { const int sgm = ((r % 160) * 32) >> 10;
                if (sgm == 2 || sgm == 3 || (G_F8 && sgm == 4)) transpose_item<true>(a.in[I_WHIN], D, 5 * D, (bf16*)(ws + WS_WIN8), false, scr, r, lane, -2 * D);
                else transpose_item<false>(a.in[I_WHIN], D, 5 * D, (bf16*)(ws + WS_WIN), false, scr, r, lane, sgm == 4 ? -2 * D : 0);
            } else transpose_item<F8_IN != 0>(a.in[I_WHIN], D, 5 * D, (bf16*)(ws + WS_WIN), false, scr, r, lane);
            continue; } r -= I_IN;
        if (r < I_SQ) { transpose_item<F8_MISC != 0>(a.in[I_WHOUT], D, D, (bf16*)(ws + WS_WOUT), false, scr, r, lane); continue; } r -= I_SQ;
        if (r < I_CV) { transpose_item<F8_MISC != 0>(a.in[I_WCVIN], D, 2 * D, (bf16*)(ws + WS_WCVIN), true, scr, r, lane); continue; } r -= I_CV;
        transpose_item<F8_MISC != 0>(a.in[I_WCVOUT], D, D, (bf16*)(ws + WS_WCVOUT), false, scr, r, lane);
    }
}
constexpr int CV_WAVES = 7, CV_L0 = 32 * 512 + 32 * 256, CV_ALL = 2 * CV_L0;
__device__ __forceinline__ void transpose_item64(const float* W, int K, int N, unsigned char* WT, bool paired, LAS float* scr, int item, int lane) {
    const int nblk = N / 64, kb = item / nblk, nb = item % nblk, k0 = 64 * kb, n0 = 64 * nb;
    int d0 = n0; if (paired) { const int half = n0 >> 10, c = n0 & 1023; d0 = (c >> 7) * 256 + half * 128 + (c & 127); }
    float t[64];
#pragma unroll
    for (int i = 0; i < 64; ++i) t[i] = __builtin_nontemporal_load(&W[(size_t)(k0 + i) * N + n0 + lane]);
#pragma unroll
    for (int i = 0; i < 64; ++i) scr[i * 65 + lane] = t[i];
    LDS_WAIT(); asm volatile("" ::: "memory");
    const int c = lane & 3;
#pragma unroll
    for (int j = 0; j < 4; ++j) { const int n = (lane >> 2) + 16 * j; const LAS float* s = scr + (16 * c) * 65 + n;
        v4u o;
        o.x = pk4_fp8(s[0 * 65] * W8SCALE, s[1 * 65] * W8SCALE, s[2 * 65] * W8SCALE, s[3 * 65] * W8SCALE); o.y = pk4_fp8(s[4 * 65] * W8SCALE, s[5 * 65] * W8SCALE, s[6 * 65] * W8SCALE, s[7 * 65] * W8SCALE);
        o.z = pk4_fp8(s[8 * 65] * W8SCALE, s[9 * 65] * W8SCALE, s[10 * 65] * W8SCALE, s[11 * 65] * W8SCALE); o.w = pk4_fp8(s[12 * 65] * W8SCALE, s[13 * 65] * W8SCALE, s[14 * 65] * W8SCALE, s[15 * 65] * W8SCALE);
        *(v4u*)(WT + (size_t)(d0 + n) * K + k0 + 16 * c) = o; }
    LDS_WAIT(); asm volatile("" ::: "memory");
}
__device__ __forceinline__ void cv_do_item(const Args& a, LAS float* scr, int g, int lane) {
    const int l = g >= CV_L0 ? 1 : 0; const int r = g - l * CV_L0;
    if (r < 32 * 512) { const int mi = l * 32 + (r >> 9); transpose_item64(a.in[I_WE1] + (size_t)mi * D * 2 * D, D, 2 * D, a.ws + WS_W1 + (size_t)mi * 2 * D * D, true, scr, r & 511, lane); }
    else { const int r2 = r - 32 * 512; const int mi = l * 32 + (r2 >> 8); transpose_item64(a.in[I_WE2] + (size_t)mi * D * D, D, D, a.ws + WS_W2 + (size_t)mi * D * D, false, scr, r2 & 255, lane); }
}
__device__ __forceinline__ void cv_finish(const Args& a, LAS unsigned char* lds, int wave, int lane, int& cv_n, int limit) {
    if (gridDim.x == 256 && wave >= 1 && wave <= CV_WAVES) {
        const int ww = blockIdx.x * CV_WAVES + (wave - 1), NW = 256 * CV_WAVES; LAS float* scr = (LAS float*)(lds + RING_OFF + wave * 16640);
#if CVF_PROBE
        const unsigned long long t0_ = __builtin_amdgcn_s_memrealtime();
#endif
        for (;;) { const int g = cv_n * NW + ww; if (g >= limit) break; cv_do_item(a, scr, g, lane); ++cv_n; }
#if CVF_PROBE
        if (blockIdx.x == 0 && wave == 1 && lane == 0) { asm volatile("s_waitcnt vmcnt(0)" ::: "memory"); ((volatile LAS unsigned*)(lds + MISC_OFF))[40] += (unsigned)(__builtin_amdgcn_s_memrealtime() - t0_); }
#endif
    }
}
__device__ __forceinline__ void xcd_barrier_work(const XcdBarrier& b, const Args& a, LAS unsigned char* lds, int wave, int lane, int& cv_n, volatile LAS unsigned* flag, unsigned seq) {
    asm volatile("s_waitcnt vmcnt(0)" ::: "memory");
    __syncthreads();
    if (wave == 0) {
        if (threadIdx.x == 0) {
            unsigned* bar = b.bar;
            __builtin_amdgcn_s_waitcnt(0);
            unsigned nloc = b.st[0], nx = b.st[1];
            if (nloc == 0u) { xcd_barrier_complete(bar, b.x, nloc, nx); b.st[0] = nloc; b.st[1] = nx; }
            const unsigned old = xb_add(&bar[XB_XSUB(b.x)], 1u);
            const unsigned gen = old / nloc;
            if (old + 1u == (gen + 1u) * nloc) {
                __builtin_amdgcn_fence(__ATOMIC_RELEASE, "agent");
                asm volatile("s_waitcnt vmcnt(0)" ::: "memory");
                const unsigned og = xb_add(&bar[XB_TOP], 1u);
                const unsigned tg = og / nx;
                if (og + 1u == (tg + 1u) * nx) xb_add(&bar[XB_TOPGEN], 1u);
                else XB_SPIN(xb_ld(&bar[XB_TOPGEN]) == tg, bar);
                __builtin_amdgcn_fence(__ATOMIC_ACQUIRE, "agent");
                xb_add(&bar[XB_XGEN(b.x)], 1u);
                asm volatile("s_waitcnt vmcnt(0)" ::: "memory");
            } else {
                XB_SPIN(xb_ld(&bar[XB_XGEN(b.x)]) == gen, bar);
                __builtin_amdgcn_fence(__ATOMIC_ACQUIRE, "agent");
                asm volatile("s_waitcnt vmcnt(0)" ::: "memory");
            }
            flag[0] = seq;
        }
    } else if (gridDim.x == 256 && wave <= CV_WAVES) {
        const int ww = blockIdx.x * CV_WAVES + (wave - 1), NW = 256 * CV_WAVES; LAS float* scr = (LAS float*)(lds + RING_OFF + wave * 16640);
        for (;;) { const int g = cv_n * NW + ww; if (g >= CV_ALL) break; if (flag[0] == seq) break; cv_do_item(a, scr, g, lane); ++cv_n; }
        asm volatile("s_waitcnt vmcnt(0)" ::: "memory");
    }
    __syncthreads();
}
__device__ __forceinline__ void flat_barrier_work(unsigned* cnt, const Args& a, LAS unsigned char* lds, int wave, int lane, int& cv_n, volatile LAS unsigned* flag, unsigned seq) {
    asm volatile("s_waitcnt vmcnt(0)" ::: "memory");
    __syncthreads();
    if (wave == 0) {
        if (threadIdx.x == 0) {
            __builtin_amdgcn_s_waitcnt(0);
            __builtin_amdgcn_fence(__ATOMIC_RELEASE, "agent");
            asm volatile("s_waitcnt vmcnt(0)" ::: "memory");
            (void)__hip_atomic_fetch_add(cnt, 1u, __ATOMIC_RELAXED, __HIP_MEMORY_SCOPE_AGENT);
            const unsigned target = gridDim.x * seq; unsigned sp = 0;
            while (__hip_atomic_load(cnt, __ATOMIC_RELAXED, __HIP_MEMORY_SCOPE_AGENT) < target) { __builtin_amdgcn_s_sleep(1); if (++sp > (1u << 22)) break; }
            __builtin_amdgcn_fence(__ATOMIC_ACQUIRE, "agent");
            asm volatile("s_waitcnt vmcnt(0)" ::: "memory");
            flag[0] = seq;
        }
    } else if (gridDim.x == 256 && wave <= CV_WAVES) {
        const int ww = blockIdx.x * CV_WAVES + (wave - 1), NW = 256 * CV_WAVES; LAS float* scr = (LAS float*)(lds + RING_OFF + wave * 16640);
        for (;;) { const int g = cv_n * NW + ww; if (g >= CV_ALL) break; if (flag[0] == seq) break; cv_do_item(a, scr, g, lane); ++cv_n; }
        asm volatile("s_waitcnt vmcnt(0)" ::: "memory");
    }
    __syncthreads();
}
template <bool OUT8> __device__ __forceinline__ void norm_mod_store(f32x4 (&v)[4], const float* g, const float* sc, const float* sh, void* orow, int lane) {
    float s = 0.f;
#pragma unroll
    for (int j = 0; j < 4; ++j) s += (v[j].x * v[j].x + v[j].y * v[j].y) + (v[j].z * v[j].z + v[j].w * v[j].w);
    const float r = 1.0f / sqrtf(wave_sum(s) * (1.0f / D) + EPS);
#pragma unroll
    for (int j = 0; j < 4; ++j) { const f32x4 gg = ((const f32x4*)g)[lane + 64 * j], ss = ((const f32x4*)sc)[lane + 64 * j], hh = ((const f32x4*)sh)[lane + 64 * j];
        const f32x4 y = (v[j] * r * gg) * (ss + 1.0f) + hh; v[j] = y;
        store_row4<OUT8>(orow, lane, j, y, 1.0f); }
}
__device__ __forceinline__ void p_norm0(const Args& a, int lane, int gw, int NGW, int m_begin, int m_end) {
    const float* MODS = (const float*)(a.ws + WS_MODS); bf16* H = (bf16*)(a.ws + WS_H);
    for (int m0 = m_begin + gw * 2; m0 < m_end; m0 += NGW * 2) {
        f32x4 v[2][4]; int rr[2];
#pragma unroll
        for (int r = 0; r < 2; ++r) { const int m = m0 + r; const float* xr;
            if (m < NTOK) { xr = a.in[I_X] + (size_t)m * D; rr[r] = m / SEQ; } else { xr = a.in[I_CTX] + (size_t)(m - NTOK) * D; rr[r] = 2; }
#pragma unroll
            for (int j = 0; j < 4; ++j) v[r][j] = __builtin_nontemporal_load(&((const f32x4*)xr)[lane + 64 * j]); }
#pragma unroll
        for (int r = 0; r < 2; ++r) { const float* md = MODS + (size_t)rr[r] * 6 * D;
            norm_mod_store<F8_IN != 0>(v[r], a.in[I_GMIX], md + 1 * D, md + 0 * D, (unsigned char*)H + (size_t)(m0 + r) * D * (F8_IN ? 1 : 2), lane);
            if (SPLIT_IN) {
#pragma unroll
                for (int j = 0; j < 4; ++j) store_row4<true>(a.ws + WS_H8 + (size_t)(m0 + r) * D, lane, j, v[r][j], 1.0f); } }
    }
}
__device__ __forceinline__ void p_scan_naive(const Args& a, LAS unsigned char* lds, int tid) {
    LAS float* sf = (LAS float*)lds;
    LAS float* sq = sf + 64 * 128;
    LAS float* sv = sq + 64 * 128;
    LAS float* so = sv + 64 * 16;
    const bf16* Q = (const bf16*)(a.ws + WS_Q); const bf16* V = (const bf16*)(a.ws + WS_V);
    const int vl = tid >> 5, kq = tid & 31;
    for (int unit = blockIdx.x; unit < 256; unit += gridDim.x) {
        const int chain = unit >> 3, vb = unit & 7, b = chain >> 4, h = (chain >> 1) & 7, dir = chain & 1;
        const float* LF = (const float*)(a.ws + (dir ? WS_LFB : WS_LFF)); float* O = (float*)(a.ws + (dir ? WS_OB : WS_OF));
        float S0 = 0.f, S1 = 0.f, S2 = 0.f, S3 = 0.f;
        for (int blk = 0; blk < 260; ++blk) {
            const bool isctx = blk < 4; int base, step;
            if (!dir) { base = isctx ? (NTOK + b * CTXL + blk * 64) : (b * SEQ + (blk - 4) * 64); step = 1; }
            else { base = isctx ? (NTOK + b * CTXL + CTXL - 1 - blk * 64) : (b * SEQ + SEQ - 1 - (blk - 4) * 64); step = -1; }
            for (int e = tid; e < 64 * 128; e += NTHR) { const int i = e >> 7, k = e & 127; const size_t off = (size_t)(base + step * i) * D + h * DK + k; sf[e] = __expf(LF[off]); sq[e] = bf2f(Q[off]); }
            for (int e = tid; e < 64 * 16; e += NTHR) { const int i = e >> 4, vv = e & 15; sv[e] = bf2f(V[(size_t)(base + step * i) * D + h * DK + vb * 16 + vv]); }
            __syncthreads();
            for (int i = 0; i < 64; ++i) {
                const f32x4 f = *(const LAS f32x4*)(sf + i * 128 + kq * 4), q = *(const LAS f32x4*)(sq + i * 128 + kq * 4); const float vv = sv[i * 16 + vl];
                S0 = f.x * S0 + (1.0f - f.x) * vv; S1 = f.y * S1 + (1.0f - f.y) * vv; S2 = f.z * S2 + (1.0f - f.z) * vv; S3 = f.w * S3 + (1.0f - f.w) * vv;
                float p = (S0 * q.x + S1 * q.y) + (S2 * q.z + S3 * q.w);
                p += __shfl_xor(p, 1); p += __shfl_xor(p, 2); p += __shfl_xor(p, 4); p += __shfl_xor(p, 8); p += __shfl_xor(p, 16);
                if (kq == 0) so[i * 16 + vl] = p;
            }
            __syncthreads();
            if (!isctx) for (int e = tid; e < 64 * 16; e += NTHR) { const int i = e >> 4, vv = e & 15; O[(size_t)(base + step * i) * D + h * DK + vb * 16 + vv] = so[e]; }
            __syncthreads();
        }
    }
}
constexpr int SC_QT = 0, SC_KU = 4352, SC_KB = 8704, SC_VT = 12800, SC_ET = 16896, SC_SUB = 17408, SC_BUF = 4 * SC_SUB;
constexpr int NSLOT = 17;
typedef short s16x4 __attribute__((ext_vector_type(4)));
typedef short s16x8 __attribute__((ext_vector_type(8)));
struct ScanUnit { int h, rowbase, sgn, nchunks, chain, slot; };
__device__ __forceinline__ ScanUnit scan_unit(int b, int h, int dir, int slot) {
    ScanUnit u; u.h = h; u.sgn = dir ? -1 : 1; u.chain = (b * NHEAD + h) * 2 + dir; u.slot = slot;
    if (slot == 0) { u.rowbase = NTOK + b * CTXL + (dir ? CTXL - 1 : 0); u.nchunks = CTXL / 64; }
    else { const int so = (slot - 1) * 1024; u.rowbase = b * SEQ + (dir ? SEQ - 1 - so : so); u.nchunks = 16; }
    return u;
}
typedef float f32x2_t __attribute__((ext_vector_type(2)));
typedef __bf16 bf16x2_t __attribute__((ext_vector_type(2)));
__device__ __forceinline__ unsigned cvtpk(float lo, float hi) { const f32x2_t f = {lo, hi}; return __builtin_bit_cast(unsigned, __builtin_convertvector(f, bf16x2_t)); }
template <bool FULL> __device__ __forceinline__ void scan_load(const ScanUnit& u, int pos0, const bf16* LF, const bf16* Q, const bf16* V, int k, int i, unsigned (&lf)[16], unsigned (&qr)[16], unsigned (&vr)[16]) {
#pragma unroll
    for (int t = 0; t < 16; ++t) {
        const size_t ro = (size_t)((u.rowbase + u.sgn * (pos0 + 16 * i + t)) * D + u.h * DK);
        lf[t] = (LF + ro)[k]; vr[t] = (V + ro)[k]; if (FULL) qr[t] = (Q + ro)[k];
    }
}
template <bool FULL> __device__ __forceinline__ float scan_prep(LAS unsigned char* buf, int k, int i, const unsigned (&lfr)[16], const unsigned (&qr)[16], const unsigned (&vr)[16]) {
    LAS unsigned char* sb = buf + i * SC_SUB;
    float f[16], pre[16], suf[16]; float T = 0.f;
#pragma unroll
    for (int t = 0; t < 16; ++t) { const float lf = (float)__builtin_bit_cast(_Float16, (unsigned short)lfr[t]); T += lf; f[t] = __builtin_amdgcn_exp2f(lf); }
    pre[0] = f[0];
#pragma unroll
    for (int t = 1; t < 16; ++t) pre[t] = pre[t - 1] * f[t];
    suf[15] = 1.0f;
#pragma unroll
    for (int t = 14; t >= 0; --t) suf[t] = suf[t + 1] * f[t + 1];
    unsigned kbw[8], vtw[8], qqw[8], kuw[8];
    const float invp = __builtin_amdgcn_rcpf(fmaxf(pre[15], 1e-30f));
#pragma unroll
    for (int t = 0; t < 16; t += 2) {
        const float kk0 = 1.0f - f[t], kk1 = 1.0f - f[t + 1];
        kbw[t >> 1] = cvtpk(kk0 * suf[t], kk1 * suf[t + 1]);
        vtw[t >> 1] = vr[t] | (vr[t + 1] << 16);
        if (FULL) {
            qqw[t >> 1] = cvtpk(__builtin_bit_cast(float, qr[t] << 16) * pre[t], __builtin_bit_cast(float, qr[t + 1] << 16) * pre[t + 1]);
            kuw[t >> 1] = cvtpk(kk0 * suf[t] * invp, kk1 * suf[t + 1] * invp);
        }
    }
    if (FULL) {
        const int rho = k ^ (((k >> 3) & 1) << 2);
        *(LAS v4u*)(sb + SC_QT + rho * 32) = (v4u){qqw[0], qqw[1], qqw[2], qqw[3]}; *(LAS v4u*)(sb + SC_QT + rho * 32 + 16) = (v4u){qqw[4], qqw[5], qqw[6], qqw[7]};
        *(LAS v4u*)(sb + SC_KU + rho * 32) = (v4u){kuw[0], kuw[1], kuw[2], kuw[3]}; *(LAS v4u*)(sb + SC_KU + rho * 32 + 16) = (v4u){kuw[4], kuw[5], kuw[6], kuw[7]};
    }
    *(LAS v4u*)(sb + SC_KB + k * 32) = (v4u){kbw[0], kbw[1], kbw[2], kbw[3]}; *(LAS v4u*)(sb + SC_KB + k * 32 + 16) = (v4u){kbw[4], kbw[5], kbw[6], kbw[7]};
    *(LAS v4u*)(sb + SC_VT + k * 32) = (v4u){vtw[0], vtw[1], vtw[2], vtw[3]}; *(LAS v4u*)(sb + SC_VT + k * 32 + 16) = (v4u){vtw[4], vtw[5], vtw[6], vtw[7]};
    *(LAS float*)(sb + SC_ET + 4 * k) = pre[15];
    return T;
}
__device__ __forceinline__ f32x4 mfma_k16(s16x4 a, s16x4 b, f32x4 c) {
    const v2u av = __builtin_bit_cast(v2u, a), bv = __builtin_bit_cast(v2u, b);
    return __builtin_amdgcn_mfma_f32_16x16x32_bf16(__builtin_bit_cast(s16x8, (v4u){av.x, av.y, 0u, 0u}), __builtin_bit_cast(s16x8, (v4u){bv.x, bv.y, 0u, 0u}), c, 0, 0, 0);
}
template <bool FULL> __device__ __forceinline__ void scan_compute2(const LAS unsigned char* buf, int wq, int lane, f32x4 (&S)[2][8], bf16* Ocol, const ScanUnit& u, int pos0) {
    const int fr = lane & 15, g = lane >> 4;
#pragma unroll
    for (int i = 0; i < 2; ++i) {
        const LAS unsigned char* sb = buf + i * SC_SUB;
        const s16x4 vt0 = *(const LAS s16x4*)(sb + SC_VT + (32 * wq + fr) * 32 + 8 * g), vt1 = *(const LAS s16x4*)(sb + SC_VT + (32 * wq + 16 + fr) * 32 + 8 * g);
        s16x8 ka[4], qa[4]; f32x4 et[8]; s16x4 kb[8];
        if (FULL) {
            const int q_ = (lane & 15) >> 2, p_ = lane & 3;
            const LAS unsigned char* b0_ = sb + (8 * g + q_) * 32 + p_ * 8 + 128 * (g & 1);
            const LAS unsigned char* b1_ = sb + (8 * g + q_) * 32 + p_ * 8 + 128 * (1 - (g & 1));
#pragma unroll
            for (int c = 0; c < 4; ++c) {
                const s16x4 k0_ = __builtin_amdgcn_ds_read_tr16_b64_v4i16((LAS s16x4*)(b0_ + SC_KU + 1024 * c)), k1_ = __builtin_amdgcn_ds_read_tr16_b64_v4i16((LAS s16x4*)(b1_ + SC_KU + 1024 * c));
                const s16x4 q0_ = __builtin_amdgcn_ds_read_tr16_b64_v4i16((LAS s16x4*)(b0_ + SC_QT + 1024 * c)), q1_ = __builtin_amdgcn_ds_read_tr16_b64_v4i16((LAS s16x4*)(b1_ + SC_QT + 1024 * c));
                ka[c] = __builtin_shufflevector(k0_, k1_, 0, 1, 2, 3, 4, 5, 6, 7); qa[c] = __builtin_shufflevector(q0_, q1_, 0, 1, 2, 3, 4, 5, 6, 7); }
        }
#pragma unroll
        for (int j = 0; j < 8; ++j) { et[j] = *(const LAS f32x4*)(sb + SC_ET + (32 * (j >> 1) + 8 * g + 4 * (j & 1)) * 4); kb[j] = *(const LAS s16x4*)(sb + SC_KB + (32 * (j >> 1) + 8 * (fr >> 2) + 4 * (j & 1) + (fr & 3)) * 32 + 8 * g); }
        __builtin_amdgcn_sched_barrier(0);
        if (FULL) {
            f32x4 aT = (f32x4){0.f, 0.f, 0.f, 0.f};
#pragma unroll
            for (int c = 0; c < 4; ++c) aT = __builtin_amdgcn_mfma_f32_16x16x32_bf16(ka[c], qa[c], aT, 0, 0, 0);
#pragma unroll
            for (int r = 0; r < 4; ++r) if (4 * g + r > fr) aT[r] = 0.f;
            const s16x4 ab = __builtin_bit_cast(s16x4, (v2u){cvtpk(aT[0], aT[1]), cvtpk(aT[2], aT[3])});
            f32x4 o0 = mfma_k16(vt0, ab, (f32x4){0.f, 0.f, 0.f, 0.f}), o1 = mfma_k16(vt1, ab, (f32x4){0.f, 0.f, 0.f, 0.f});
#pragma unroll
            for (int c = 0; c < 4; ++c) {
                const v4u s0 = (v4u){cvtpk(S[0][2 * c][0], S[0][2 * c][1]), cvtpk(S[0][2 * c][2], S[0][2 * c][3]), cvtpk(S[0][2 * c + 1][0], S[0][2 * c + 1][1]), cvtpk(S[0][2 * c + 1][2], S[0][2 * c + 1][3])};
                const v4u s1 = (v4u){cvtpk(S[1][2 * c][0], S[1][2 * c][1]), cvtpk(S[1][2 * c][2], S[1][2 * c][3]), cvtpk(S[1][2 * c + 1][0], S[1][2 * c + 1][1]), cvtpk(S[1][2 * c + 1][2], S[1][2 * c + 1][3])};
                o0 = __builtin_amdgcn_mfma_f32_16x16x32_bf16(__builtin_bit_cast(s16x8, s0), qa[c], o0, 0, 0, 0);
                o1 = __builtin_amdgcn_mfma_f32_16x16x32_bf16(__builtin_bit_cast(s16x8, s1), qa[c], o1, 0, 0, 0);
            }
            bf16* orow = Ocol + (size_t)(u.rowbase + u.sgn * (pos0 + 16 * i + fr)) * D;
            *(v2u*)orow = (v2u){cvtpk(o0[0], o0[1]), cvtpk(o0[2], o0[3])}; *(v2u*)(orow + 16) = (v2u){cvtpk(o1[0], o1[1]), cvtpk(o1[2], o1[3])};
        }
#pragma unroll
        for (int j = 0; j < 8; ++j) { S[0][j] = mfma_k16(kb[j], vt0, S[0][j] * et[j]); S[1][j] = mfma_k16(kb[j], vt1, S[1][j] * et[j]); }
    }
}
template <bool FULL> __device__ __forceinline__ void scan_pair(const Args& a, LAS unsigned char* lds, const ScanUnit& uA, const ScanUnit& uB, int tid, int lane, int wave) {
    const int grp = wave >> 2, wq = wave & 3, t = tid & 255, k = t & 127, i0 = (wave >> 1) & 1;
    ScanUnit u; u.h = grp ? uB.h : uA.h; u.rowbase = grp ? uB.rowbase : uA.rowbase; u.sgn = grp ? uB.sgn : uA.sgn; u.nchunks = grp ? uB.nchunks : uA.nchunks; u.chain = grp ? uB.chain : uA.chain; u.slot = grp ? uB.slot : uA.slot;
    LAS unsigned char* buf = lds + grp * SC_BUF;
    const int dir = u.sgn < 0;
    const bf16* LF = (const bf16*)(a.ws + (dir ? WS_LFB : WS_LFF)); const bf16* Q = (const bf16*)(a.ws + WS_Q); const bf16* V = (const bf16*)(a.ws + WS_V);
    f32x4* SD = (f32x4*)(a.ws + WS_SD) + (size_t)u.chain * NSLOT * 4096; float* SP = (float*)(a.ws + WS_SP) + (size_t)u.chain * NSLOT * DK;
    const int g = lane >> 4;
    bf16* Ocol = (bf16*)(a.ws + (dir ? WS_OB : WS_OF)) + u.h * DK + 32 * wq + 4 * g;
    f32x4 S[2][8];
#pragma unroll
    for (int vb = 0; vb < 2; ++vb)
#pragma unroll
        for (int j = 0; j < 8; ++j) S[vb][j] = (f32x4){0.f, 0.f, 0.f, 0.f};
    if (FULL) {
        for (int s = 0; s < u.slot; ++s) {
            const f32x4* d = SD + (size_t)s * 4096 + (wq * 16) * 64 + lane; const float* pp = SP + s * DK + 8 * g;
#pragma unroll
            for (int j = 0; j < 8; ++j) { const f32x4 pv = *(const f32x4*)(pp + 32 * (j >> 1) + 4 * (j & 1)); const f32x4 ev = (f32x4){__builtin_amdgcn_exp2f(pv.x), __builtin_amdgcn_exp2f(pv.y), __builtin_amdgcn_exp2f(pv.z), __builtin_amdgcn_exp2f(pv.w)};
                S[0][j] = S[0][j] * ev + d[j * 64]; S[1][j] = S[1][j] * ev + d[(8 + j) * 64]; }
        }
    }
    unsigned lf[16], q[16], v[16]; float psum = 0.f;
    const int nsteps = u.nchunks * 2;
    scan_load<FULL>(u, 0, LF, Q, V, k, i0, lf, q, v);
    constexpr int NST = 32, PB = 2 * SC_SUB;
    if (nsteps > 0) psum += scan_prep<FULL>(buf, k, i0, lf, q, v);
    if (grp == 1) scan_load<FULL>(u, (nsteps > 1 ? 1 : 0) * 32, LF, Q, V, k, i0, lf, q, v);
    for (int c = 0; c < NST; ++c) {
        __syncthreads();
        if (c < nsteps) {
            if (grp == 1 && c + 1 < nsteps) psum += scan_prep<FULL>(buf + ((c + 1) & 1) * PB, k, i0, lf, q, v);
            const int cw = c + 1 + grp, cn = cw < nsteps ? cw : nsteps - 1;
            scan_load<FULL>(u, cn * 32, LF, Q, V, k, i0, lf, q, v);
            scan_compute2<FULL>(buf + (c & 1) * PB, wq, lane, S, Ocol, u, c * 32);
            if (grp == 0 && c + 1 < nsteps) psum += scan_prep<FULL>(buf + ((c + 1) & 1) * PB, k, i0, lf, q, v);
        }
    }
    __syncthreads();
    if (!FULL) {
        f32x4* d = SD + (size_t)u.slot * 4096 + (wq * 16) * 64 + lane;
#pragma unroll
        for (int j = 0; j < 8; ++j) { d[j * 64] = S[0][j]; d[(8 + j) * 64] = S[1][j]; }
        LAS float* ps = (LAS float*)(lds + EXTRA_OFF + 2560);
        ps[(grp * 2 + i0) * 128 + k] = psum;
        __syncthreads();
        if (t < 128) SP[u.slot * DK + t] = ps[(grp * 2) * 128 + t] + ps[(grp * 2 + 1) * 128 + t];
        __syncthreads();
    }
}
__device__ __forceinline__ void p_scan_a(const Args& a, LAS unsigned char* lds, int tid, int lane, int wave) {
    for (int it = blockIdx.x; it < 256; it += gridDim.x) {
        const int b = it >> 7, h = (it >> 4) & 7, seg = it & 15;
        const ScanUnit uA = scan_unit(b, h, 0, seg == 15 ? 0 : 1 + seg);
        const ScanUnit uB = scan_unit(b, h, 1, seg == 0 ? 0 : 16 - seg);
        scan_pair<false>(a, lds, uA, uB, tid, lane, wave);
    }
}
__device__ __forceinline__ void p_scan_c(const Args& a, LAS unsigned char* lds, int tid, int lane, int wave) {
    for (int it = blockIdx.x; it < 256; it += gridDim.x) {
        const int b = it >> 7, h = (it >> 4) & 7, seg = it & 15;
        const ScanUnit uA = scan_unit(b, h, 0, 1 + seg), uB = scan_unit(b, h, 1, 16 - seg);
        scan_pair<true>(a, lds, uA, uB, tid, lane, wave);
    }
}
__device__ __forceinline__ void p_readout(const Args& a, int lane, int wave) {
    const int gw = blockIdx.x * NWAVES + wave, NGW = gridDim.x * NWAVES;
    const bf16* OF = (const bf16*)(a.ws + WS_OF); const bf16* OB = (const bf16*)(a.ws + WS_OB); const bf16* SG = (const bf16*)(a.ws + WS_SG); bf16* Y = (bf16*)(a.ws + WS_YIN);
    f32x4 gh[4];
#pragma unroll
    for (int j = 0; j < 4; ++j) gh[j] = ((const f32x4*)a.in[I_GHOUT])[lane + 64 * j];
    v2u ra[2][4], rb[2][4], sg[2][4];
    if (gw * 2 < NTOK) {
#pragma unroll
        for (int r = 0; r < 2; ++r)
#pragma unroll
            for (int j = 0; j < 4; ++j) { const size_t m = gw * 2 + r; ra[r][j] = ((const v2u*)(OF + m * D))[lane + 64 * j]; rb[r][j] = ((const v2u*)(OB + m * D))[lane + 64 * j]; sg[r][j] = ((const v2u*)(SG + m * D))[lane + 64 * j]; }
    }
    for (int m0 = gw * 2; m0 < NTOK; m0 += NGW * 2) {
        v2u na[2][4], nb[2][4], ns[2][4]; const int mn = m0 + NGW * 2;
#pragma unroll
        for (int r = 0; r < 2; ++r)
#pragma unroll
            for (int j = 0; j < 4; ++j) { const size_t m = (size_t)mn + r; const v2u z2 = (v2u){0u, 0u};
                na[r][j] = mn < NTOK ? ((const v2u*)(OF + m * D))[lane + 64 * j] : z2; nb[r][j] = mn < NTOK ? ((const v2u*)(OB + m * D))[lane + 64 * j] : z2; ns[r][j] = mn < NTOK ? ((const v2u*)(SG + m * D))[lane + 64 * j] : z2; }
#pragma unroll
        for (int r = 0; r < 2; ++r)
#pragma unroll
            for (int j = 0; j < 4; ++j) { const v2u a_ = ra[r][j], b_ = rb[r][j];
                const f32x4 oo = (f32x4){bf_lo(a_.x) + bf_lo(b_.x), bf_hi(a_.x) + bf_hi(b_.x), bf_lo(a_.y) + bf_lo(b_.y), bf_hi(a_.y) + bf_hi(b_.y)};
                float s = (oo.x * oo.x + oo.y * oo.y) + (oo.z * oo.z + oo.w * oo.w);
                s = half_sum(s);
                const float rs = 1.0f / sqrtf(s * (1.0f / DK) + EPS);
                store_row4<F8_MISC != 0>((unsigned char*)Y + (size_t)(m0 + r) * D * (F8_MISC ? 1 : 2), lane, j,
                    (f32x4){oo.x * rs * gh[j].x * bf_lo(sg[r][j].x), oo.y * rs * gh[j].y * bf_hi(sg[r][j].x), oo.z * rs * gh[j].z * bf_lo(sg[r][j].y), oo.w * rs * gh[j].w * bf_hi(sg[r][j].y)}, 4.0f); }
#pragma unroll
        for (int r = 0; r < 2; ++r)
#pragma unroll
            for (int j = 0; j < 4; ++j) { ra[r][j] = na[r][j]; rb[r][j] = nb[r][j]; sg[r][j] = ns[r][j]; }
    }
}
__device__ __forceinline__ void p_router(const Args& a, LAS unsigned char* lds, int l, int tid, int lane, int wave) {
    typedef _Float16 h16x8 __attribute__((ext_vector_type(8))); typedef _Float16 h16x4 __attribute__((ext_vector_type(4)));
    constexpr int PITCH = 2064, TILE_BYTES = 16 * PITCH, P_OFF = 2 * TILE_BYTES, P_BYTES = 8 * 16 * 32 * 4;
    LAS int* s_cnt = (LAS int*)(lds + EXTRA_OFF);
    LAS int* s_gb = s_cnt + 32;
    LAS int* s_sel = (LAS int*)(lds + EXTRA_OFF + 2560);
    unsigned* GCNT = (unsigned*)(a.ws + WS_CTL) + CW_GCNT + l * 32;
    const float* WR = a.in[I_WR] + (size_t)l * D * NE; const float* BR = a.in[I_BR] + l * NE;
    const bf16* X = (const bf16*)(a.ws + WS_X); unsigned char* H = a.ws + WS_H;
    const int fr = lane & 15, g = lane >> 4;
    v2u nx[2][4];
    if (blockIdx.x < NTOK / 128) {
#pragma unroll
        for (int t = 0; t < 2; ++t)
#pragma unroll
            for (int j = 0; j < 4; ++j) nx[t][j] = ((const v2u*)(X + (size_t)(blockIdx.x * 128 + 2 * wave + t) * D))[lane + 64 * j];
    }
    h16x8 wb0[4], wb1[4];
#pragma unroll
    for (int c = 0; c < 4; ++c)
#pragma unroll
        for (int i = 0; i < 8; ++i) { const float* wp = WR + (size_t)(128 * wave + 32 * c + 8 * g + i) * NE + fr; wb0[c][i] = (_Float16)wp[0]; wb1[c][i] = (_Float16)wp[16]; }
    const float* MODS = (const float*)(a.ws + WS_MODS);
    int* TOPS = (int*)(a.ws + WS_TOPE); float* TOPW = (float*)(a.ws + WS_TOPW); int* STOK = (int*)(a.ws + WS_STOK);
    for (int ch = blockIdx.x; ch < NTOK / 128; ch += gridDim.x) {
        if (tid < 32) s_cnt[tid] = 0;
        const int b = (ch * 128) / SEQ; const float* md = MODS + (size_t)(l * 3 + b) * 6 * D;
        if (ch != (int)blockIdx.x) {
#pragma unroll
        for (int t = 0; t < 2; ++t)
#pragma unroll
            for (int j = 0; j < 4; ++j) nx[t][j] = ((const v2u*)(X + (size_t)(ch * 128 + 2 * wave + t) * D))[lane + 64 * j];
        }
#define ROUTER_A(it_) do { const int tokA = ch * 128 + (it_) * 16 + 2 * wave; f32x4 hf[2][4]; \
            _Pragma("unroll") for (int t = 0; t < 2; ++t) _Pragma("unroll") for (int j = 0; j < 4; ++j) hf[t][j] = (f32x4){bf_lo(nx[t][j].x), bf_hi(nx[t][j].x), bf_lo(nx[t][j].y), bf_hi(nx[t][j].y)}; \
            if ((it_) + 1 < 8) { _Pragma("unroll") for (int t = 0; t < 2; ++t) _Pragma("unroll") for (int j = 0; j < 4; ++j) nx[t][j] = ((const v2u*)(X + (size_t)(tokA + 16 + t) * D))[lane + 64 * j]; } \
            _Pragma("unroll") for (int t = 0; t < 2; ++t) { \
                norm_mod_store<true>(hf[t], a.in[I_GFFN] + l * D, md + 4 * D, md + 3 * D, H + (size_t)(tokA + t) * D, lane); \
                _Pragma("unroll") for (int j = 0; j < 4; ++j) { const h16x4 hv = {(_Float16)hf[t][j].x, (_Float16)hf[t][j].y, (_Float16)hf[t][j].z, (_Float16)hf[t][j].w}; \
                    *(LAS h16x4*)(lds + ((it_) & 1) * TILE_BYTES + (2 * wave + t) * PITCH + (4 * lane + 256 * j) * 2) = hv; } } } while (0)
#define ROUTER_B(it_) do { f32x4 acc0 = (f32x4){0.f, 0.f, 0.f, 0.f}, acc1 = acc0; \
            _Pragma("unroll") for (int c = 0; c < 4; ++c) { const h16x8 av = *(const LAS h16x8*)(lds + ((it_) & 1) * TILE_BYTES + fr * PITCH + (128 * wave + 32 * c + 8 * g) * 2); \
                acc0 = __builtin_amdgcn_mfma_f32_16x16x32_f16(av, wb0[c], acc0, 0, 0, 0); acc1 = __builtin_amdgcn_mfma_f32_16x16x32_f16(av, wb1[c], acc1, 0, 0, 0); } \
            LAS float* Pw = (LAS float*)(lds + P_OFF + ((it_) & 1) * P_BYTES); \
            _Pragma("unroll") for (int r = 0; r < 4; ++r) { Pw[(wave * 16 + 4 * g + r) * 32 + fr] = acc0[r]; Pw[(wave * 16 + 4 * g + r) * 32 + 16 + fr] = acc1[r]; } } while (0)
#define ROUTER_C(it_) do { const int t = lane >> 5, e0 = lane & 31; const LAS float* Pr = (const LAS float*)(lds + P_OFF + ((it_) & 1) * P_BYTES); \
            float v0 = BR[e0]; \
            _Pragma("unroll") for (int w = 0; w < 8; ++w) v0 += Pr[(w * 16 + 2 * wave + t) * 32 + e0]; \
            float selv[4]; int seli[4]; \
            { const unsigned ub = __builtin_bit_cast(unsigned, v0); unsigned key = (ub & 0x80000000u) ? ~ub : (ub | 0x80000000u); key = (key & ~31u) | (unsigned)(31 - e0); \
              _Pragma("unroll") for (int r = 0; r < 4; ++r) { unsigned m = key, o; \
                  o = (unsigned)__builtin_amdgcn_update_dpp(0, (int)m, 0xB1, 0xF, 0xF, true); m = o > m ? o : m; \
                  o = (unsigned)__builtin_amdgcn_update_dpp(0, (int)m, 0x4E, 0xF, 0xF, true); m = o > m ? o : m; \
                  o = (unsigned)__builtin_amdgcn_update_dpp(0, (int)m, 0x141, 0xF, 0xF, true); m = o > m ? o : m; \
                  o = (unsigned)__builtin_amdgcn_update_dpp(0, (int)m, 0x140, 0xF, 0xF, true); m = o > m ? o : m; \
                  o = (unsigned)__shfl_xor((int)m, 16); m = o > m ? o : m; \
                  const int bi = 31 - (int)(m & 31u); seli[r] = bi; \
                  if (bi == e0) key = 0u; } \
              _Pragma("unroll") for (int r = 0; r < 4; ++r) selv[r] = __builtin_bit_cast(float, __builtin_amdgcn_ds_bpermute(((lane & 32) + seli[r]) << 2, __builtin_bit_cast(int, v0))); } \
            if ((lane & 31) == 0) { \
                const float e1 = __expf(selv[1] - selv[0]), e2 = __expf(selv[2] - selv[0]), e3 = __expf(selv[3] - selv[0]); const float inv = 1.0f / (1.0f + e1 + e2 + e3); \
                *(f32x4*)(TOPW + (size_t)(ch * 128 + (it_) * 16 + 2 * wave + t) * 4) = (f32x4){inv, e1 * inv, e2 * inv, e3 * inv}; \
                _Pragma("unroll") for (int r = 0; r < 4; ++r) s_sel[((it_) * 16 + 2 * wave + t) * 4 + r] = (seli[r] << 16) | __hip_atomic_fetch_add(&s_cnt[seli[r]], 1, __ATOMIC_RELAXED, __HIP_MEMORY_SCOPE_WORKGROUP); \
            } } while (0)
        ROUTER_A(0);
        for (int k = 0; k < 8; ++k) {
            __syncthreads();
            ROUTER_B(k);
            if (k > 0) ROUTER_C(k - 1);
            if (k < 7) ROUTER_A(k + 1);
        }
        __syncthreads();
        ROUTER_C(7);
#undef ROUTER_A
#undef ROUTER_B
#undef ROUTER_C
        __syncthreads();
        if (tid < 32) s_gb[tid] = (int)__hip_atomic_fetch_add(GCNT + tid, (unsigned)s_cnt[tid], __ATOMIC_RELAXED, __HIP_MEMORY_SCOPE_AGENT);
        __syncthreads();
        { const int sv = s_sel[tid], e = sv >> 16, vi = s_gb[e] + (sv & 0xffff); TOPS[(size_t)ch * 512 + tid] = e * NTOK + vi; STOK[(size_t)e * NTOK + vi] = ch * 128 + (tid >> 2); }
        __syncthreads();
    }
}
__device__ __forceinline__ void moe_tables(const Args& a, LAS unsigned char* lds, int l, int tid) {
    LAS int* s_tb = (LAS int*)(lds + EXTRA_OFF + 256); LAS int* s_ce = s_tb + 40; LAS int* tab = (LAS int*)(lds + EXTRA_OFF + 640);
    const unsigned* GCNT = (const unsigned*)(a.ws + WS_CTL) + CW_GCNT + l * 32;
    if (tid < 32) s_ce[tid] = (int)__hip_atomic_load(GCNT + tid, __ATOMIC_RELAXED, __HIP_MEMORY_SCOPE_AGENT);
    __syncthreads();
    if (tid == 0) { int run = 0; for (int e = 0; e < 32; ++e) { s_tb[e] = run; run += (s_ce[e] + 255) >> 8; } s_tb[32] = run; }
    __syncthreads();
    if (tid < 32) { const int t0 = s_tb[tid], t1 = s_tb[tid + 1]; for (int t = t0; t < t1; ++t) tab[t] = tid; }
    __syncthreads();
}
template <bool FINAL> __device__ __forceinline__ void p_combine(const Args& a, LAS unsigned char* lds, int l, int lane, int wave) {
    const int gw = blockIdx.x * NWAVES + wave, NGW = gridDim.x * NWAVES;
    bf16* X = (bf16*)(a.ws + WS_X); const bf16* YS = (const bf16*)(a.ws + WS_YS); const int* TOPS = (const int*)(a.ws + WS_TOPE); const float* TOPW = (const float*)(a.ws + WS_TOPW);
    const LAS int* s_tb = (const LAS int*)(lds + EXTRA_OFF + 256);
    const float* MODS = (const float*)(a.ws + WS_MODS); bf16* H = (bf16*)(a.ws + WS_H);
    const int S2 = NGW * 2;
    auto load_idx = [&](int m, v4i (&ps)[2], f32x4 (&tws)[2]) {
#pragma unroll
        for (int r = 0; r < 2; ++r) { ps[r] = *(const v4i*)(TOPS + (size_t)(m + r) * 4); tws[r] = *(const f32x4*)(TOPW + (size_t)(m + r) * 4); } };
    auto load_rows = [&](int m, v4i (&ps)[2], v2u (&xr_)[2][4], v2u (&y_)[2][4][4]) {
#pragma unroll
        for (int r = 0; r < 2; ++r) {
#pragma unroll
            for (int k = 0; k < 4; ++k) { const int e = ps[r][k] >> 15; ps[r][k] = s_tb[e] * 256 + (ps[r][k] & (NTOK - 1)); }
#pragma unroll
            for (int j = 0; j < 4; ++j) { xr_[r][j] = ((const v2u*)(X + (size_t)(m + r) * D))[lane + 64 * j];
#pragma unroll
                for (int k = 0; k < 4; ++k) {
                    if (F8_Y) { y_[r][j][k].x = ((const unsigned*)((const unsigned char*)YS + (size_t)ps[r][k] * D))[lane + 64 * j]; y_[r][j][k].y = 0u; }
                    else y_[r][j][k] = ((const v2u*)(YS + (size_t)ps[r][k] * D))[lane + 64 * j]; } } } };
    v2u xr[2][4]; v2u y[2][4][4]; f32x4 tw[2]; v4i nps[2]; f32x4 ntw[2];
    if (gw * 2 < NTOK) { v4i cps[2]; load_idx(gw * 2, cps, tw); load_rows(gw * 2, cps, xr, y); if (gw * 2 + S2 < NTOK) load_idx(gw * 2 + S2, nps, ntw); }
    for (int m0 = gw * 2; m0 < NTOK; m0 += S2) {
        const int b = m0 / SEQ; const float* gt = MODS + (size_t)(l * 3 + b) * 6 * D + 5 * D;
        const int mn = m0 + S2, mnn = m0 + 2 * S2;
        v2u xn[2][4]; v2u yn[2][4][4]; v4i pps[2]; f32x4 ptw[2];
        if (mn < NTOK) load_rows(mn, nps, xn, yn);
        if (mnn < NTOK) load_idx(mnn, pps, ptw);
        f32x4 v[2][4];
#pragma unroll
        for (int r = 0; r < 2; ++r)
#pragma unroll
            for (int j = 0; j < 4; ++j) v[r][j] = (f32x4){bf_lo(xr[r][j].x), bf_hi(xr[r][j].x), bf_lo(xr[r][j].y), bf_hi(xr[r][j].y)};
#pragma unroll
        for (int r = 0; r < 2; ++r) { const int m = m0 + r;
#pragma unroll
            for (int j = 0; j < 4; ++j) { f32x4 s = (f32x4){0.f, 0.f, 0.f, 0.f};
#pragma unroll
                for (int k = 0; k < 4; ++k) {
                    if (F8_Y) { const int w = (int)y[r][j][k].x; const f32x2_t lo = __builtin_amdgcn_cvt_pk_f32_fp8(w, false), hi = __builtin_amdgcn_cvt_pk_f32_fp8(w, true);
                        s += (f32x4){lo.x, lo.y, hi.x, hi.y} * (tw[r][k] * (1.0f / YSCALE)); }
                    else s += (f32x4){bf_lo(y[r][j][k].x), bf_hi(y[r][j][k].x), bf_lo(y[r][j][k].y), bf_hi(y[r][j][k].y)} * tw[r][k]; }
                v[r][j] = v[r][j] + ((const f32x4*)gt)[lane + 64 * j] * s; }
            if (!FINAL) {
#pragma unroll
                for (int j = 0; j < 4; ++j) ((v2u*)(X + (size_t)m * D))[lane + 64 * j] = (v2u){pk2(v[r][j].x, v[r][j].y), pk2(v[r][j].z, v[r][j].w)};
                const float* md = MODS + (size_t)((l + 1) * 3 + b) * 6 * D;
                norm_mod_store<F8_MISC != 0>(v[r], a.in[I_GMIX] + (l + 1) * D, md + 1 * D, md + 0 * D, (unsigned char*)H + (size_t)m * D * (F8_MISC ? 1 : 2), lane);
            } else {
                float s = 0.f;
#pragma unroll
                for (int j = 0; j < 4; ++j) s += (v[r][j].x * v[r][j].x + v[r][j].y * v[r][j].y) + (v[r][j].z * v[r][j].z + v[r][j].w * v[r][j].w);
                const float rs = 1.0f / sqrtf(wave_sum(s) * (1.0f / D) + EPS);
#pragma unroll
                for (int j = 0; j < 4; ++j) __builtin_nontemporal_store(v[r][j] * rs * ((const f32x4*)a.in[I_GFINAL])[lane + 64 * j], &((f32x4*)(a.out + (size_t)m * D))[lane + 64 * j]);
            }
        }
#pragma unroll
        for (int r = 0; r < 2; ++r) { tw[r] = ntw[r]; nps[r] = pps[r]; ntw[r] = ptw[r];
#pragma unroll
            for (int j = 0; j < 4; ++j) { xr[r][j] = xn[r][j];
#pragma unroll
                for (int k = 0; k < 4; ++k) y[r][j][k] = yn[r][j][k]; } }
    }
}
__device__ __forceinline__ void p_dwconv(const Args& a, int tid) {
    const bf16* U = (const bf16*)(a.ws + WS_U); bf16* ZP = (bf16*)(a.ws + WS_ZP);
    const float* WDW = a.in[I_WCVDW]; const float* BDW = a.in[I_BCVDW];
    const int half = __builtin_amdgcn_readfirstlane(tid >> 8), cp = tid & 255;
    typedef float f32x2v __attribute__((ext_vector_type(2)));
    auto line_of = [&](int unit, int& c, int& len, int& p0, size_t& base, size_t& stride) {
        const int hu = unit * 2 + half;
        if (hu < 2048) { c = 2 * cp; len = GRIDW; p0 = (hu & 3) * 16; base = (size_t)(hu >> 2) * GRIDW * D; stride = D; }
        else { const int v = hu - 2048; const int b = v >> 10, w = (v >> 4) & 63; c = 512 + 2 * cp; len = GRIDR; p0 = (v & 15) * 16; base = ((size_t)b * SEQ + w) * D; stride = (size_t)GRIDW * D; } };
    auto load_in = [&](int c, int len, int p0, size_t base, size_t stride, unsigned (&u)[46]) {
#pragma unroll
        for (int i = 0; i < 46; ++i) { const int pp = p0 - 15 + i; u[i] = (pp >= 0 && pp < len) ? *(const unsigned*)(U + base + (size_t)pp * stride + c) : 0u; } };
    int c, len, p0; size_t base, stride; unsigned u[46];
    f32x2v w2[CONVW]; f32x2v bb = (f32x2v){0.f, 0.f}; int wc = -1;
    if ((int)blockIdx.x < 2048) { line_of(blockIdx.x, c, len, p0, base, stride); load_in(c, len, p0, base, stride, u); }
    for (int unit = blockIdx.x; unit < 2048; unit += gridDim.x) {
        int cn = 0, lenn = 0, p0n = 0; size_t basen = 0, striden = 0; unsigned un[46]; const int nu = unit + gridDim.x;
        if (nu < 2048) { line_of(nu, cn, lenn, p0n, basen, striden); load_in(cn, lenn, p0n, basen, striden, un); }
        if (wc != c) { wc = c;
#pragma unroll
            for (int j = 0; j < CONVW; ++j) w2[j] = *(const f32x2v*)(WDW + j * D + c);
            bb = *(const f32x2v*)(BDW + c); }
        f32x2v in2[46];
#pragma unroll
        for (int i = 0; i < 46; ++i) in2[i] = (f32x2v){bf_lo(u[i]), bf_hi(u[i])};
#pragma unroll
        for (int i = 0; i < 16; ++i) { f32x2v acc2 = bb;
#pragma unroll
            for (int j = 0; j < CONVW; ++j) acc2 = __builtin_elementwise_fma(in2[i + j], w2[j], acc2);
            *(unsigned*)(ZP + base + (size_t)(p0 + i) * stride + c) = pk2(acc2.x, acc2.y); }
        c = cn; len = lenn; p0 = p0n; base = basen; stride = striden;
#pragma unroll
        for (int i = 0; i < 46; ++i) u[i] = un[i];
    }
}
__device__ __forceinline__ void p_ln_silu(const Args& a, int lane, int wave) {
    const int gw = blockIdx.x * NWAVES + wave, NGW = gridDim.x * NWAVES;
    const bf16* ZP = (const bf16*)(a.ws + WS_ZP); bf16* Z = (bf16*)(a.ws + WS_Z);
    f32x4 gg[4], bb[4];
#pragma unroll
    for (int j = 0; j < 4; ++j) { gg[j] = ((const f32x4*)a.in[I_GCVLN])[lane + 64 * j]; bb[j] = ((const f32x4*)a.in[I_BCVLN])[lane + 64 * j]; }
    v2u y[2][4];
    if (gw * 2 < NTOK) {
#pragma unroll
        for (int r = 0; r < 2; ++r)
#pragma unroll
            for (int j = 0; j < 4; ++j) y[r][j] = ((const v2u*)(ZP + (size_t)(gw * 2 + r) * D))[lane + 64 * j];
    }
    for (int m0 = gw * 2; m0 < NTOK; m0 += NGW * 2) {
        v2u yn[2][4]; const int mn = m0 + NGW * 2;
#pragma unroll
        for (int r = 0; r < 2; ++r)
#pragma unroll
            for (int j = 0; j < 4; ++j) yn[r][j] = mn < NTOK ? ((const v2u*)(ZP + (size_t)(mn + r) * D))[lane + 64 * j] : (v2u){0u, 0u};
#pragma unroll
        for (int r = 0; r < 2; ++r) {
            f32x4 v[4]; float s = 0.f;
#pragma unroll
            for (int j = 0; j < 4; ++j) { v[j] = (f32x4){bf_lo(y[r][j].x), bf_hi(y[r][j].x), bf_lo(y[r][j].y), bf_hi(y[r][j].y)}; s += (v[j].x + v[j].y) + (v[j].z + v[j].w); }
            const float mean = wave_sum(s) * (1.0f / D); float s2 = 0.f;
#pragma unroll
            for (int j = 0; j < 4; ++j) { v[j] = v[j] - mean; s2 += (v[j].x * v[j].x + v[j].y * v[j].y) + (v[j].z * v[j].z + v[j].w * v[j].w); }
            const float rstd = 1.0f / sqrtf(wave_sum(s2) * (1.0f / D) + EPS);
#pragma unroll
            for (int j = 0; j < 4; ++j) {
                f32x4 yy = v[j] * rstd * gg[j] + bb[j]; yy.x *= fsig(yy.x); yy.y *= fsig(yy.y); yy.z *= fsig(yy.z); yy.w *= fsig(yy.w);
                store_row4<F8_MISC != 0>((unsigned char*)Z + (size_t)(m0 + r) * D * (F8_MISC ? 1 : 2), lane, j, yy, 4.0f); }
        }
#pragma unroll
        for (int r = 0; r < 2; ++r)
#pragma unroll
            for (int j = 0; j < 4; ++j) y[r][j] = yn[r][j];
    }
}


enum { PH_PRO = 0, PH_NORM0, PH_INPROJ, PH_SCANA, PH_SCANC, PH_READOUT, PH_OUTPROJ, PH_ROUTER0, PH_G1_0, PH_G2_0, PH_COMB0, PH_CVIN, PH_DWCONV, PH_LN, PH_CVOUT, PH_ROUTER1, PH_G1_1, PH_G2_1, PH_FINAL, NPH };
#ifndef AEPI
#define AEPI 1
#endif
#ifndef REPMASK
#define REPMASK 0ull
#endif
#ifndef SCAN_NAIVE
#define SCAN_NAIVE 0
#endif
#if defined(__HIP_DEVICE_COMPILE__)
#define NO_PK_F32
#else
#define NO_PK_F32
#endif
__global__ void NO_PK_F32 __launch_bounds__(NTHR, 2) fwd_kernel(Args args) {
    extern __shared__ __attribute__((aligned(16))) unsigned char lds_raw[];
    LAS unsigned char* lds = (LAS unsigned char*)lds_raw;
    const int tid = threadIdx.x, lane = tid & 63, wave = __builtin_amdgcn_readfirstlane(tid >> 6);
    const int G = gridDim.x, bid = blockIdx.x;
    unsigned char* ws = args.ws;
    for (int u = tid; u < (LDS_BYTES - LDSCTL_OFF) / 4; u += NTHR) ((LAS unsigned*)(lds + LDSCTL_OFF))[u] = 0u;
    __syncthreads();
    volatile LAS unsigned* MISC = (volatile LAS unsigned*)(lds + MISC_OFF);
    XcdBarrier bar = xcd_barrier_post((unsigned*)(ws + WS_CTL) + CW_BAR + args.li * XCD_BAR_WORDS, MISC + 8);
    const int lo = args.ph_lo, hi = args.ph_hi;
    if (TL_PROBE && tid == 0) MISC[48] = (unsigned)__builtin_amdgcn_s_memrealtime();
    if (tid == 0) __hip_atomic_store((unsigned*)(ws + WS_CTL) + CW_XMAP + bid, xb_xcc_id() + 1u, __ATOMIC_RELAXED, __HIP_MEMORY_SCOPE_AGENT);
#define IN(k) (lo <= (k) && (k) < hi)
    int cv_n = 0; unsigned bseq = 0;
#ifndef FLAT_BARRIER
#define FLAT_BARRIER 0
#endif
#define SEAM(k) do { if (IN(k) && IN((k) + 1)) { ++bseq; if (FLAT_BARRIER) flat_barrier_work((unsigned*)(ws + WS_CTL) + CW_FLAT, args, lds, wave, lane, cv_n, MISC + 12, bseq); else xcd_barrier_work(bar, args, lds, wave, lane, cv_n, MISC + 12, bseq); \
        if (TL_PROBE && tid == 0) MISC[48 + (k) + 1] = (unsigned)__builtin_amdgcn_s_memrealtime(); } } while (0)
#define PHASE(k, ...) if (IN(k)) { __VA_ARGS__; if ((REPMASK >> (k)) & 1ull) { __syncthreads(); __VA_ARGS__; } if (TL_PROBE && tid == 0) MISC[72 + (k)] = (unsigned)__builtin_amdgcn_s_memrealtime(); } SEAM(k);
    typedef pg8::bf16_t pbf;

    const bool merge_pro = false && (G >= 32) && IN(PH_PRO) && IN(PH_NORM0);
    if (IN(PH_PRO)) { p_mods(args, lds, tid, lane, wave); p_weights(args, lds, lane, wave); if (merge_pro) wait_mods0(args, tid); }
    if (!merge_pro) SEAM(PH_PRO);
    const bool ctx_early = SPLIT_IN && (G == 256);
    PHASE(PH_NORM0, {
        if (ctx_early && bid < 24) {
            const int cb = bid / 12, cj = bid % 12;
            p_norm0(args, lane, wave, NWAVES, NTOK + cb * CTXL, NTOK + cb * CTXL + CTXL);
            VM_WAIT(); __syncthreads();
            if (cj < 8) {
                pg8::Gemm g{(const pbf*)(ws + WS_H8), (const pbf*)(ws + WS_WIN8), D / 2, 0};
                pg8::OneUnit S1{NTOK / 256 + cb, cj};
                pg8::EpiHgrnIn E{(pbf*)(ws + WS_Q), (WS_V - WS_Q) / 2, (_Float16*)(ws + WS_LFF), (WS_LFB - WS_LFF) / 2, args.in[I_HGAMMA], 2};
                pg8::gemm_phase<pg8::EpiHgrnIn, pg8::OneUnit, AEPI != 0, true, true, 0x79797979, 0x7F7F7F7F>(lds + RING_OFF, g, S1, E);
            } else {
                pg8::Gemm g{(const pbf*)(ws + WS_H), (const pbf*)(ws + WS_WIN), D, 0};
                pg8::OneUnit S1{NTOK / 256 + cb, 4 + (cj - 8)};
                pg8::EpiHgrnIn E{(pbf*)(ws + WS_Q), (WS_V - WS_Q) / 2, (_Float16*)(ws + WS_LFF), (WS_LFB - WS_LFF) / 2, args.in[I_HGAMMA], 1};
                pg8::gemm_phase<pg8::EpiHgrnIn, pg8::OneUnit, AEPI != 0, true, false>(lds + RING_OFF, g, S1, E);
            }
        } else if (ctx_early) p_norm0(args, lane, (bid - 24) * NWAVES + wave, (G - 24) * NWAVES, 0, NTOK);
        else p_norm0(args, lane, bid * NWAVES + wave, G * NWAVES, 0, MROWS);
    })
    PHASE(PH_INPROJ, {
        static_assert(WS_V - WS_Q == WS_SG - WS_V, "Q|V|SG equally spaced");
        if (SPLIT_IN) {
            const int nMi = ctx_early ? NTOK / 256 : MROWS / 256;
            {
                pg8::Gemm g{(const pbf*)(ws + WS_H8), (const pbf*)(ws + WS_WIN8), D / 2, 0};
                pg8::TileOrder S; S.init(nMi, (G_F8 ? 3 : 2) * D / 256, G, bid, nullptr);
                pg8::EpiHgrnIn E{(pbf*)(ws + WS_Q), (WS_V - WS_Q) / 2, (_Float16*)(ws + WS_LFF), (WS_LFB - WS_LFF) / 2, args.in[I_HGAMMA], 2};
                pg8::gemm_phase<pg8::EpiHgrnIn, pg8::TileOrder, AEPI != 0, true, true, 0x79797979, 0x7F7F7F7F>(lds + RING_OFF, g, S, E);
            }
            {
                pg8::Gemm g{(const pbf*)(ws + WS_H), (const pbf*)(ws + WS_WIN), D, 0};
                pg8::TileOrder S; S.init(nMi, (G_F8 ? 2 : 3) * D / 256, G, bid, nullptr);
                pg8::EpiHgrnIn E{(pbf*)(ws + WS_Q), (WS_V - WS_Q) / 2, (_Float16*)(ws + WS_LFF), (WS_LFB - WS_LFF) / 2, args.in[I_HGAMMA], 1};
                pg8::gemm_phase<pg8::EpiHgrnIn, pg8::TileOrder, AEPI != 0, true, false>(lds + RING_OFF, g, S, E);
            }
        } else {
            pg8::Gemm g{(const pbf*)(ws + WS_H), (const pbf*)(ws + WS_WIN), F8_IN ? D / 2 : D, 0};
            pg8::TileOrder S; S.init(MROWS / 256, 5 * D / 256, G, bid, nullptr);
            pg8::EpiHgrnIn E{(pbf*)(ws + WS_Q), (WS_V - WS_Q) / 2, (_Float16*)(ws + WS_LFF), (WS_LFB - WS_LFF) / 2, args.in[I_HGAMMA], 0};
            pg8::gemm_phase<pg8::EpiHgrnIn, pg8::TileOrder, AEPI != 0, true, F8_IN != 0, 0x79797979, 0x7F7F7F7F>(lds + RING_OFF, g, S, E);
        }
    })
#if SCAN_NAIVE
    PHASE(PH_SCANA, { p_scan_naive(args, lds, tid); })
    PHASE(PH_SCANC, { })
#else
    PHASE(PH_SCANA, { p_scan_a(args, lds, tid, lane, wave); })
    PHASE(PH_SCANC, { p_scan_c(args, lds, tid, lane, wave); })
#endif
    PHASE(PH_READOUT, { p_readout(args, lane, wave); })
    PHASE(PH_OUTPROJ, {
        pg8::Gemm g{(const pbf*)(ws + WS_YIN), (const pbf*)(ws + WS_WOUT), F8_MISC ? D / 2 : D, 0};
        pg8::TileOrder S; S.init(NTOK / 256, D / 256, G, bid, nullptr);
        pg8::EpiResGate<false, true> E{args.in[I_X], (void*)(ws + WS_X), (const float*)(ws + WS_MODS) + 2 * D, 6 * D, SEQ, nullptr};
        pg8::gemm_phase<pg8::EpiResGate<false, true>, pg8::TileOrder, AEPI != 0, true, F8_MISC != 0, 0x79797979, 0x7D7D7D7D>(lds + RING_OFF, g, S, E);
    })
#ifndef LDSB
#define LDSB 1
#endif
#ifndef XBAR_PROBE
#define XBAR_PROBE 0
#endif
#ifndef G2_NS
#define G2_NS 0
#endif
#ifndef G1_NS
#define G1_NS 0
#endif
#ifndef MOE_HANDOFF
#define MOE_HANDOFF 1
#endif
#ifndef MOE_WT
#define MOE_WT 0
#endif
#define MOE_PHASES(l, pb) \
    if (IN(pb + 0)) { p_router(args, lds, l, tid, lane, wave); cv_finish(args, lds, wave, lane, cv_n, (l + 1) * CV_L0); } SEAM(pb + 0); \
    if ((l) == 1) { if (XBAR_PROBE >= 1) SEAM(pb + 0); if (XBAR_PROBE >= 2) SEAM(pb + 0); if (XBAR_PROBE >= 3) SEAM(pb + 0); if (XBAR_PROBE >= 4) SEAM(pb + 0); }     \
    if (IN(pb + 1) || IN(pb + 2) || IN(pb + 3)) { \
        moe_tables(args, lds, l, tid); \
        LAS int* tab = (LAS int*)(lds + EXTRA_OFF + 640); \
        const LAS int* s_tb = (const LAS int*)(lds + EXTRA_OFF + 256); const LAS int* s_ce = s_tb + 40; \
        const int ntiles = __builtin_amdgcn_readfirstlane(s_tb[32]); \
        const bool hand = MOE_HANDOFF && (G == 256) && IN(pb + 1) && IN(pb + 2) && !((REPMASK >> (pb + 1)) & 3ull) && (MOE_WT || xmap_ok); \
        const int xl = (hand && !MOE_WT) ? 1 : 0; \
        unsigned* tcnt = (unsigned*)(ws + WS_CTL) + CW_TCNT + l * 32768; \
        const int c2 = (hand && MOE_WT) ? ((bid - ((((ntiles * 8) & 255) + 7) & ~7)) & 255) : bid;     \
        const int tv = (((bid & 7) + 1) * ntiles >> 3) - ((bid & 7) * ntiles >> 3);                   \
        LAS int* ut1 = (LAS int*)(lds + EXTRA_OFF + 13824); LAS int* ut2 = ut1 + 32;                  \
        if (wave == 0) { \
            int pm_ = 0, pn_ = 0; \
            const bool h1 = lane < 32 && pg8::MoeOrder::unit_of(xl, ntiles, 2 * D / 256, G, bid, bid >> 3, lane, pm_, pn_); \
            if (lane < 32) ut1[lane] = h1 ? (pm_ | (pn_ << 16) | (tab[pm_] << 24)) : 0; \
            const bool h2 = lane < 32 && pg8::MoeOrder::unit_of(xl, ntiles, D / 256, G, c2, ((bid >> 3) - ((tv * 8) & 31)) & 31, lane, pm_, pn_); \
            if (lane < 32) ut2[lane] = h2 ? (pm_ | (pn_ << 16) | (tab[pm_] << 24)) : 0; \
            const int n1 = __popcll(__ballot(h1)), n2 = __popcll(__ballot(h2)); \
            if (lane == 0) { ut1[64] = n1; ut1[65] = n2; } \
        } \
        __syncthreads(); \
        const int nu1 = __builtin_amdgcn_readfirstlane(ut1[64]), nu2 = __builtin_amdgcn_readfirstlane(ut1[65]); \
        if (IN(pb + 1)) { \
            LAS unsigned short* tt = (LAS unsigned short*)(lds + EXTRA_OFF + 2816);     \
            pg8::MoeOrder S; S.ut = ut1; S.nu = nu1; S.cnt = tcnt; S.rdy = 0u; S.mode = hand ? 0 : 2; \
            { const int* STOK = (const int*)(ws + WS_STOK); int tv_[10];                         \
              _Pragma("unroll") for (int n_ = 0; n_ < 10; ++n_) { const int idx = tid + NTHR * n_; tv_[n_] = 0; \
                  if (idx < nu1 * 256) { const int uw = ut1[idx >> 8], pm_ = uw & 0xFFFF, e_ = (uw >> 24) & 0xFF, vi = (pm_ - s_tb[e_]) * 256 + (idx & 255); if (vi < s_ce[e_]) tv_[n_] = STOK[(size_t)e_ * NTOK + vi]; } } \
              _Pragma("unroll") for (int n_ = 0; n_ < 10; ++n_) { const int idx = tid + NTHR * n_; if (idx < nu1 * 256) tt[idx] = (unsigned short)tv_[n_]; } } \
            __syncthreads(); \
            pg8::Gemm g{(const pbf*)(ws + WS_H), (const pbf*)(ws + WS_W1 + (size_t)l * NE * 2 * D * D), D / 2, (size_t)2 * D * D, tt};   \
            pg8::EpiPair<0, true, 4, MOE_WT != 0, LDSB != 0> E{(pbf*)(ws + WS_ACT), args.in[I_BE1] + (size_t)l * NE * 2 * D, (const LAS float*)(lds + EXTRA_OFF + 14336)}; \
            pg8::gemm_phase<pg8::EpiPair<0, true, 4, MOE_WT != 0, LDSB != 0>, pg8::MoeOrder, AEPI != 0, true, true, 0x79797979, 0x7F7F7F7F, true, G1_NS>(lds + RING_OFF, g, S, E); \
            if ((REPMASK >> (pb + 1)) & 1ull) { __syncthreads(); pg8::gemm_phase<pg8::EpiPair<0, true, 4, MOE_WT != 0, LDSB != 0>, pg8::MoeOrder, AEPI != 0, true, true, 0x79797979, 0x7F7F7F7F, true, G1_NS>(lds + RING_OFF, g, S, E); } \
        } \
        pg8::MoeOrder S2; S2.ut = ut2; S2.nu = nu2; S2.cnt = tcnt; S2.rdy = 0u; S2.mode = hand ? 1 : 2; \
        if (hand) {                                                          \
            if (wave == 0) { \
                const unsigned v = lane < nu2 ? __hip_atomic_load(tcnt + 32 * (ut2[lane & 31] & 0xFFFF), __ATOMIC_RELAXED, __HIP_MEMORY_SCOPE_AGENT) : 64u; \
                const unsigned long long m = __ballot(v >= 64u); \
                __builtin_amdgcn_fence(__ATOMIC_ACQUIRE, "agent"); asm volatile("s_waitcnt vmcnt(0)" ::: "memory"); \
                if (lane == 0) MISC[16] = (unsigned)m; \
            } \
            __syncthreads(); \
            S2.rdy = __builtin_amdgcn_readfirstlane(MISC[16]); \
        } else SEAM(pb + 1); \
        PHASE(pb + 2, { \
            pg8::Gemm g{(const pbf*)(ws + WS_ACT), (const pbf*)(ws + WS_W2 + (size_t)l * NE * D * D), D / 2, (size_t)D * D}; \
            pg8::EpiMoeOut<F8_Y != 0, YSCALE, LDSB != 0> E{(pbf*)(ws + WS_YS), args.in[I_BE2] + (size_t)l * NE * D, (const LAS float*)(lds + EXTRA_OFF + 14336)}; \
            pg8::gemm_phase<pg8::EpiMoeOut<F8_Y != 0, YSCALE, LDSB != 0>, pg8::MoeOrder, AEPI != 0, true, true, 0x79797979, 0x7D7D7D7D, false, G2_NS>(lds + RING_OFF, g, S2, E);   \
        }) \
    }
    bool xmap_ok = false;
    if (MOE_HANDOFF && !MOE_WT && G == 256 && lo == 0) {
        if (wave == 0) {
            const unsigned* xm = (const unsigned*)(ws + WS_CTL) + CW_XMAP; bool ok = true;
#pragma unroll
            for (int k = 0; k < 4; ++k) { const int b = lane + 64 * k; const unsigned mine = __hip_atomic_load(xm + b, __ATOMIC_RELAXED, __HIP_MEMORY_SCOPE_AGENT), cls = __hip_atomic_load(xm + (b & 7), __ATOMIC_RELAXED, __HIP_MEMORY_SCOPE_AGENT);
                ok = ok && mine != 0u && mine == cls; }
            const unsigned me = __hip_atomic_load(xm + (lane & 7), __ATOMIC_RELAXED, __HIP_MEMORY_SCOPE_AGENT);
#pragma unroll
            for (int j = 1; j < 8; ++j) { const unsigned other = (unsigned)__shfl((int)me, (lane + j) & 7); ok = ok && other != me; }
            const bool all_ok = __all(ok);
            if (lane == 0) MISC[17] = all_ok ? 1u : 0u;
        }
        __syncthreads();
        xmap_ok = __builtin_amdgcn_readfirstlane(MISC[17]) != 0u;
    }
    MOE_PHASES(0, PH_ROUTER0)
    PHASE(PH_COMB0, { p_combine<false>(args, lds, 0, lane, wave); })
    PHASE(PH_CVIN, {
        pg8::Gemm g{(const pbf*)(ws + WS_H), (const pbf*)(ws + WS_WCVIN), F8_MISC ? D / 2 : D, 0};
        pg8::TileOrder S; S.init(NTOK / 256, 2 * D / 256, G, bid, nullptr);
        pg8::EpiPair<1> E{(pbf*)(ws + WS_U), args.in[I_BCVIN]};
        pg8::gemm_phase<pg8::EpiPair<1>, pg8::TileOrder, AEPI != 0, true, F8_MISC != 0, 0x79797979, 0x7F7F7F7F>(lds + RING_OFF, g, S, E);
    })
    PHASE(PH_DWCONV, { p_dwconv(args, tid); })
    PHASE(PH_LN, { p_ln_silu(args, lane, wave); })
    PHASE(PH_CVOUT, {
        pg8::Gemm g{(const pbf*)(ws + WS_Z), (const pbf*)(ws + WS_WCVOUT), F8_MISC ? D / 2 : D, 0};
        pg8::TileOrder S; S.init(NTOK / 256, D / 256, G, bid, nullptr);
        pg8::EpiResGate<true, true> E{(const void*)(ws + WS_X), (void*)(ws + WS_X), (const float*)(ws + WS_MODS) + 3 * 6 * D + 2 * D, 6 * D, SEQ, args.in[I_BCVOUT]};
        pg8::gemm_phase<pg8::EpiResGate<true, true>, pg8::TileOrder, AEPI != 0, true, F8_MISC != 0, 0x79797979, 0x7D7D7D7D>(lds + RING_OFF, g, S, E);
    })
#ifndef CLK_PROBE
#define CLK_PROBE 0
#endif
#if CLK_PROBE
    if (bid == 0 && tid == 0) { const unsigned long long c = __builtin_amdgcn_s_memtime(), w = __builtin_amdgcn_s_memrealtime(); MISC[20] = (unsigned)c; MISC[21] = (unsigned)(c >> 32); MISC[22] = (unsigned)w; MISC[23] = (unsigned)(w >> 32); }
#endif
    MOE_PHASES(1, PH_ROUTER1)
#if CLK_PROBE
    if (bid == 0 && tid == 0) { const unsigned long long c = __builtin_amdgcn_s_memtime(), w = __builtin_amdgcn_s_memrealtime(); MISC[24] = (unsigned)c; MISC[25] = (unsigned)(c >> 32); MISC[26] = (unsigned)w; MISC[27] = (unsigned)(w >> 32); }
#endif
    if (IN(PH_FINAL)) { p_combine<true>(args, lds, 1, lane, wave); }
#if KL_PROBE
    static_assert(pg8::KLP_LDS == MISC_OFF + 4 * 28, "probe words");
    if (bid == 0 && tid == 0) {
        const unsigned long long kl = ((unsigned long long)MISC[29] << 32) | MISC[28]; const unsigned nun = MISC[30] ? MISC[30] : 1u;
        const unsigned long long tot = ((unsigned long long)MISC[37] << 32) | MISC[36];
        const unsigned long long ticks = KL_PROBE == 1 ? kl * 10ull / (8ull * nun) : (tot - kl) * 5ull / nun;
        const unsigned long long t_end = __builtin_amdgcn_s_memrealtime() + (ticks < 100000ull ? ticks : 100000ull);
        while (__builtin_amdgcn_s_memrealtime() < t_end) __builtin_amdgcn_s_sleep(8);
    }
#endif
#if TL_PROBE
    if (bid == 0 && tid == 0) { const unsigned ticks = TL_BODY ? MISC[72 + TL_B] - MISC[48 + TL_B] : MISC[48 + TL_B + 1] - MISC[48 + TL_A + 1];     const unsigned long long t_end = __builtin_amdgcn_s_memrealtime() + 2ull * (ticks < 200000u ? ticks : 200000u); while (__builtin_amdgcn_s_memrealtime() < t_end) __builtin_amdgcn_s_sleep(8); }
#endif
#if CVF_PROBE
    if (bid == 0 && tid == 0) { const unsigned long long t_end = __builtin_amdgcn_s_memrealtime() + 2ull * MISC[40]; while (__builtin_amdgcn_s_memrealtime() < t_end) __builtin_amdgcn_s_sleep(8); }
#endif
#if CLK_PROBE
    if (bid == 0 && tid == 0) {
        const unsigned long long c0 = ((unsigned long long)MISC[21] << 32) | MISC[20], w0 = ((unsigned long long)MISC[23] << 32) | MISC[22], c1 = ((unsigned long long)MISC[25] << 32) | MISC[24], w1 = ((unsigned long long)MISC[27] << 32) | MISC[26];
        const unsigned long long ticks = (c1 - c0) * 1000ull / (w1 - w0 + 1ull);
        const unsigned long long t_end = __builtin_amdgcn_s_memrealtime() + (ticks < 100000ull ? ticks : 100000ull);
        while (__builtin_amdgcn_s_memrealtime() < t_end) __builtin_amdgcn_s_sleep(8);
    }
#endif
#undef MOE_PHASES
#undef PHASE
#undef IN
#undef SEAM
}

extern "C" void kernel_launch(void* const* d_in, const int* in_sizes, int n_in, void* d_out, int out_size, void* d_ws, size_t ws_size, hipStream_t stream) {
    static int grid = 0;
    if (grid == 0) {
        if (n_in != N_IN || in_sizes[0] != NTOK * D || out_size != NTOK * D || ws_size < WS_END) { fprintf(stderr, "kernel_launch: unexpected shapes / workspace (n_in %d, in0 %d, out %d, ws %zu, need %zu); nothing launched\n", n_in, n_in > 0 ? in_sizes[0] : -1, out_size, ws_size, (size_t)WS_END); grid = -1; return; }
        int dev = 0, cus = 0, per_cu = 0;
        if (hipGetDevice(&dev) != hipSuccess || hipDeviceGetAttribute(&cus, hipDeviceAttributeMultiprocessorCount, dev) != hipSuccess) { grid = -1; return; }
        if (hipFuncSetAttribute((const void*)fwd_kernel, hipFuncAttributeMaxDynamicSharedMemorySize, LDS_BYTES) != hipSuccess) { fprintf(stderr, "kernel_launch: hipFuncSetAttribute failed\n"); grid = -1; return; }
        if (hipOccupancyMaxActiveBlocksPerMultiprocessor(&per_cu, (const void*)fwd_kernel, NTHR, LDS_BYTES) != hipSuccess || per_cu < 1) { fprintf(stderr, "kernel_launch: occupancy query reports %d workgroups per CU\n", per_cu); }
        (void)hipGetLastError();
        grid = cus;
    }
    if (grid < 0) return;
    if (hipMemsetAsync((char*)d_ws + WS_CTL, 0, CTL_ZERO_BYTES, stream) != hipSuccess) return;
#ifdef DIAG_MEMSET
    (void)hipMemsetAsync((char*)d_ws + WS_SP, 0, (WS_WIN - WS_SP), stream); (void)hipMemsetAsync((char*)d_ws + WS_OF, 0, (WS_YIN - WS_OF), stream);
#endif
    Args a{};
    for (int i = 0; i < N_IN; ++i) a.in[i] = (const float*)d_in[i];
    a.out = (float*)d_out; a.ws = (unsigned char*)d_ws; a.pad = 0;
#ifndef MK_CUTS
    a.ph_lo = 0; a.ph_hi = NPH; a.li = 0;
    hipLaunchKernelGGL(fwd_kernel, dim3(grid), dim3(NTHR), LDS_BYTES, stream, a);
#else
    const int cuts[] = {MK_CUTS};
    const int nc = (int)(sizeof(cuts) / sizeof(cuts[0]));
    for (int li = 0; li + 1 < nc; ++li) { a.ph_lo = cuts[li]; a.ph_hi = cuts[li + 1]; a.li = li; hipLaunchKernelGGL(fwd_kernel, dim3(grid), dim3(NTHR), LDS_BYTES, stream, a); }
#endif
}
```
